# Optimizing an MI355X kernel written in HIP

```python
import math
import jax, jax.numpy as jnp
from jax import lax
import numpy as np

D_MODEL = 1024
BATCH = 16
SEQ = 4096
DEPTH = 2

RMS_EPS = 1e-6
SSD_D_INNER = D_MODEL
SSD_HEAD_DIM = 64
SSD_HEADS = SSD_D_INNER // SSD_HEAD_DIM
SSD_GROUPS = 2
SSD_HEADS_PER_GROUP = SSD_HEADS // SSD_GROUPS
SSD_STATE = 128
SSD_CONV = 4
SSD_CONV_DIM = SSD_D_INNER + 2 * SSD_GROUPS * SSD_STATE
SSD_CHUNK = 128
SSD_NORM_EPS = 1e-5
RET_HEADS = 4
RET_QK_DIM = D_MODEL // 2
RET_V_DIM = D_MODEL
RET_QK_HEAD = RET_QK_DIM // RET_HEADS
RET_V_HEAD = RET_V_DIM // RET_HEADS
RET_CHUNK = 128
ROPE_BASE = 10000.0
IN_WIDTHS = (SSD_D_INNER, SSD_CONV_DIM, SSD_HEADS, RET_QK_DIM, RET_QK_DIM, RET_V_DIM, RET_V_DIM)
IN_PROJ_DIM = SSD_D_INNER + SSD_CONV_DIM + SSD_HEADS + 2 * RET_QK_DIM + 2 * RET_V_DIM
MIX_WIDTH = SSD_D_INNER + RET_V_DIM
RWKV_HEAD = 64
RWKV_HEADS = D_MODEL // RWKV_HEAD
RWKV_DECAY_LORA = 64
RWKV_A_LORA = 64
RWKV_GATE_LORA = 160
RWKV_LN_EPS = 64e-5
MOE_GROUPS = 4
MOE_EXPERTS_PER_GROUP = 4
MOE_EXPERTS = MOE_GROUPS * MOE_EXPERTS_PER_GROUP
MOE_TOP_K = 2
MOE_D_FF = 512

kernel_name = "hybrid_ssd_retention_rwkv7_hmoe"


def rms_norm(x, w, eps=RMS_EPS):
    xf = x.astype(jnp.float32)
    y = xf * lax.rsqrt(jnp.mean(xf * xf, axis=-1, keepdims=True) + eps)
    return (y * w).astype(x.dtype)


def split_cols(t, widths):
    out, start = [], 0
    for w in widths:
        out.append(t[..., start:start + w])
        start += w
    return out


def to_chunks(t, c):
    b, s = t.shape[:2]
    return jnp.moveaxis(t.reshape(b, s // c, c, *t.shape[2:]), 1, 0)


def from_chunks(t):
    nc, b, c = t.shape[:3]
    return jnp.moveaxis(t, 0, 1).reshape(b, nc * c, *t.shape[3:])


def causal_depthwise_conv(x, w, b):
    K = w.shape[0]
    S = x.shape[1]
    xp = jnp.pad(x, ((0, 0), (K - 1, 0), (0, 0)))
    out = xp[:, 0:S] * w[0]
    for j in range(1, K):
        out = out + xp[:, j:j + S] * w[j]
    return out + b


def rotary(x, pos):
    d = x.shape[-1]
    half = d // 2
    inv_freq = ROPE_BASE ** (-jnp.arange(half, dtype=jnp.float32) / half)
    ang = pos[:, None] * inv_freq[None, :]
    cos = jnp.cos(ang)[None, :, None, :]
    sin = jnp.sin(ang)[None, :, None, :]
    xf = x.astype(jnp.float32)
    x1, x2 = xf[..., :half], xf[..., half:]
    return jnp.concatenate([x1 * cos - x2 * sin, x1 * sin + x2 * cos], axis=-1).astype(x.dtype)


def ssd_mixer(z, xbc, dt_raw, conv_w, conv_b, dt_bias, a_log, d_skip, norm_w):
    Bsz, S, _ = z.shape
    G, Hg, P, N = SSD_GROUPS, SSD_HEADS_PER_GROUP, SSD_HEAD_DIM, SSD_STATE
    xbc = jax.nn.silu(causal_depthwise_conv(xbc, conv_w, conv_b))
    xs, Bm, Cm = split_cols(xbc, (SSD_D_INNER, G * N, G * N))
    xs = xs.reshape(Bsz, S, G, Hg, P)
    Bm = Bm.reshape(Bsz, S, G, N)
    Cm = Cm.reshape(Bsz, S, G, N)
    dt = jax.nn.softplus(dt_raw.astype(jnp.float32) + dt_bias).reshape(Bsz, S, G, Hg)
    A = -jnp.exp(a_log.astype(jnp.float32)).reshape(G, Hg)
    a = dt * A
    xdt = xs * dt[..., None]
    L = SSD_CHUNK
    causal = jnp.tril(jnp.ones((L, L), dtype=bool))[None, :, :, None, None]

    def step(h, inp):
        xc, ac, bc, cc = inp
        acum = jnp.cumsum(ac, axis=1)
        seg = acum[:, :, None] - acum[:, None, :]
        decay = jnp.exp(jnp.where(causal, seg, -jnp.inf))
        cb = jnp.einsum('bign,bjgn->bijg', cc, bc)
        m = cb[..., None] * decay
        y_diag = jnp.einsum('bijgh,bjghp->bighp', m, xc)
        y_off = jnp.einsum('bign,bghpn->bighp', cc, h) * jnp.exp(acum)[..., None]
        decay_end = jnp.exp(acum[:, -1:] - acum)
        h = h * jnp.exp(acum[:, -1])[..., None, None] + jnp.einsum(
            'bjgn,bjghp->bghpn', bc, xc * decay_end[..., None])
        return h, y_diag + y_off

    h0 = jnp.zeros((Bsz, G, Hg, P, N), jnp.float32)
    _, y = lax.scan(step, h0, (to_chunks(xdt, L), to_chunks(a, L), to_chunks(Bm, L), to_chunks(Cm, L)))
    y = from_chunks(y)
    y = y + xs * d_skip.reshape(G, Hg)[..., None]
    y = y.reshape(Bsz, S, SSD_D_INNER) * jax.nn.silu(z.astype(jnp.float32))
    yg = y.reshape(Bsz, S, G, SSD_D_INNER // G)
    yg = yg * lax.rsqrt(jnp.mean(yg * yg, axis=-1, keepdims=True) + SSD_NORM_EPS)
    return (yg.reshape(Bsz, S, SSD_D_INNER) * norm_w).astype(z.dtype)


def retention_mixer(q, k, v, g, pos):
    Bsz, S, _ = q.shape
    H, dk, dv, C = RET_HEADS, RET_QK_HEAD, RET_V_HEAD, RET_CHUNK
    q = rotary(q.reshape(Bsz, S, H, dk), pos)
    k = rotary(k.reshape(Bsz, S, H, dk), pos) * (dk ** -0.5)
    v = v.reshape(Bsz, S, H, dv)
    log_gamma = jnp.log(1.0 - 2.0 ** (-5.0 - jnp.arange(H, dtype=jnp.float32)))
    idx = jnp.arange(C, dtype=jnp.float32)
    diff = idx[:, None] - idx[None, :]
    dmask = jnp.where(diff[None] >= 0, jnp.exp(jnp.maximum(diff, 0.0)[None] * log_gamma[:, None, None]), 0.0)
    q_decay = jnp.exp((idx[:, None] + 1.0) * log_gamma[None, :])
    k_decay = jnp.exp((C - 1.0 - idx[:, None]) * log_gamma[None, :])
    chunk_decay = jnp.exp(C * log_gamma)

    def step(R, inp):
        qc, kc, vc = inp
        s = jnp.einsum('bihd,bjhd->bhij', qc, kc) * dmask[None]
        inner = jnp.einsum('bhij,bjhv->bihv', s, vc)
        cross = jnp.einsum('bihd,bhdv->bihv', qc, R) * q_decay[None, :, :, None]
        R = R * chunk_decay[None, :, None, None] + jnp.einsum(
            'bjhd,bjhv->bhdv', kc * k_decay[None, :, :, None], vc)
        return R, inner + cross

    R0 = jnp.zeros((Bsz, H, dk, dv), jnp.float32)
    _, y = lax.scan(step, R0, (to_chunks(q, C), to_chunks(k, C), to_chunks(v, C)))
    y = from_chunks(y)
    y = y * lax.rsqrt(jnp.mean(y * y, axis=-1, keepdims=True) + RMS_EPS)
    y = y.reshape(Bsz, S, RET_V_DIM) * jax.nn.silu(g.astype(jnp.float32))
    return y.astype(q.dtype)


def ssd_retention_layer(u, pos, w_in, conv_w, conv_b, dt_bias, a_log, d_skip, norm_w, w_out):
    proj = u @ w_in
    z, xbc, dt_raw, q, k, v, g = split_cols(proj, IN_WIDTHS)
    y_a = ssd_mixer(z, xbc, dt_raw, conv_w, conv_b, dt_bias, a_log, d_skip, norm_w)
    y_b = retention_mixer(q, k, v, g, pos)
    return jnp.concatenate([y_a, y_b], axis=-1) @ w_out


def rwkv7_layer(u, mu, w_r, w_k, w_v, w_o, w0, w1, w2, a0, a1, a2, g1, g2, k_k, k_a, r_k, lnx_w, lnx_b):
    Bsz, S, D = u.shape
    H, N = RWKV_HEADS, RWKV_HEAD
    xx = jnp.pad(u, ((0, 0), (1, 0), (0, 0)))[:, :S] - u
    xr, xw, xk, xv, xa, xg = [u + xx * mu[j] for j in range(6)]
    r = xr @ w_r
    k = xk @ w_k
    v = xv @ w_v
    w_log = -jax.nn.softplus(-(w0 + jnp.tanh(xw @ w1) @ w2)) - 0.5
    decay = jnp.exp(-jnp.exp(w_log.astype(jnp.float32)))
    a = jax.nn.sigmoid((a0 + (xa @ a1) @ a2).astype(jnp.float32))
    g = jax.nn.sigmoid(xg @ g1) @ g2
    kk = (k * k_k).reshape(Bsz, S, H, N).astype(jnp.float32)
    kk = kk * lax.rsqrt(jnp.maximum(jnp.sum(kk * kk, axis=-1, keepdims=True), 1e-24))
    k = k * (1.0 + (a - 1.0) * k_a)
    heads = lambda t: t.reshape(Bsz, S, H, N)
    r_h, k_h, v_h, w_h, a_h = heads(r), heads(k), heads(v), heads(decay), heads(a)
    aa = -kk
    bb = kk * a_h

    def step(state, inp):
        r_t, w_t, k_t, v_t, aa_t, bb_t = inp
        sa = jnp.einsum('bhij,bhj->bhi', state, aa_t)
        state = (state * w_t[:, :, None, :] + sa[..., None] * bb_t[:, :, None, :]
                 + v_t[..., None] * k_t[:, :, None, :])
        return state, jnp.einsum('bhij,bhj->bhi', state, r_t)

    seq_first = lambda t: jnp.moveaxis(t, 1, 0)
    state0 = jnp.zeros((Bsz, H, N, N), jnp.float32)
    _, y = lax.scan(step, state0, (seq_first(r_h), seq_first(w_h), seq_first(k_h),
                                   seq_first(v_h), seq_first(aa), seq_first(bb)))
    y = jnp.moveaxis(y, 0, 1)
    mean = jnp.mean(y, axis=-1, keepdims=True)
    var = jnp.mean((y - mean) ** 2, axis=-1, keepdims=True)
    y = ((y - mean) * lax.rsqrt(var + RWKV_LN_EPS)).reshape(Bsz, S, D) * lnx_w + lnx_b
    bonus = jnp.sum(r_h * k_h * r_k, axis=-1, keepdims=True) * v_h
    y = y + bonus.reshape(Bsz, S, D)
    return (y * g).astype(u.dtype) @ w_o


def hier_moe(h, wg, bg, we, be, w1, w3, w2):
    Bsz, S, D = h.shape
    t = h.reshape(-1, D)
    g_logits = (t @ wg + bg).astype(jnp.float32)
    g_prob = jax.nn.softmax(g_logits, axis=-1)
    g_idx = jnp.argmax(g_logits, axis=-1)
    g_gate = jnp.take_along_axis(g_prob, g_idx[:, None], axis=-1)[:, 0]
    e_logits = (t @ we + be).astype(jnp.float32).reshape(-1, MOE_GROUPS, MOE_EXPERTS_PER_GROUP)
    e_sel = jnp.take_along_axis(e_logits, g_idx[:, None, None], axis=1)[:, 0]
    top_v, top_i = lax.top_k(e_sel, MOE_TOP_K)
    top_w = jax.nn.softmax(top_v, axis=-1) * g_gate[:, None]
    expert_id = g_idx[:, None] * MOE_EXPERTS_PER_GROUP + top_i
    combine = jnp.sum(jax.nn.one_hot(expert_id, MOE_EXPERTS, dtype=jnp.float32) * top_w[..., None], axis=1)
    out = jnp.zeros(t.shape, jnp.float32)
    for e in range(MOE_EXPERTS):
        he = jax.nn.silu(t @ w1[e]) * (t @ w3[e])
        out = out + combine[:, e:e + 1] * (he @ w2[e])
    return out.reshape(Bsz, S, D).astype(h.dtype)


def setup_inputs(seed: int = 0) -> dict:
    key = jax.random.key(seed)
    ks = iter(jax.random.split(key, 64))
    f32 = jnp.float32
    nrm = lambda shape, scale: scale * jax.random.normal(next(ks), shape, f32)
    D = D_MODEL
    NE = (DEPTH + 1) // 2
    NO = DEPTH // 2
    x = nrm((BATCH, SEQ, D), 1.0)
    norm_mix_w = 1.0 + nrm((DEPTH, D), 0.02)
    norm_ffn_w = 1.0 + nrm((DEPTH, D), 0.02)
    norm_final_w = 1.0 + nrm((D,), 0.02)
    w_in_e = nrm((NE, D, IN_PROJ_DIM), D ** -0.5)
    ssd_conv_w = nrm((NE, SSD_CONV, SSD_CONV_DIM), SSD_CONV ** -0.5)
    ssd_conv_b = nrm((NE, SSD_CONV_DIM), 0.02)
    dt = jnp.exp(jax.random.uniform(next(ks), (NE, SSD_HEADS), f32, math.log(1e-3), math.log(1e-1)))
    ssd_dt_bias = dt + jnp.log(-jnp.expm1(-dt))
    ssd_a_log = jnp.log(jax.random.uniform(next(ks), (NE, SSD_HEADS), f32, 1.0, 16.0))
    ssd_d = 1.0 + nrm((NE, SSD_HEADS), 0.1)
    ssd_norm_w = 1.0 + nrm((NE, SSD_D_INNER), 0.02)
    w_out_e = nrm((NE, MIX_WIDTH, D), MIX_WIDTH ** -0.5)
    rw_mu = jax.random.uniform(next(ks), (NO, 6, D), f32, 0.0, 1.0)
    rw_wr = nrm((NO, D, D), D ** -0.5)
    rw_wk = nrm((NO, D, D), D ** -0.5)
    rw_wv = nrm((NO, D, D), D ** -0.5)
    rw_wo = nrm((NO, D, D), D ** -0.5)
    ramp = jnp.linspace(0.0, 1.0, D, dtype=f32) ** 0.9
    rw_w0 = -6.0 + 5.0 * ramp + nrm((NO, D), 0.1)
    rw_w1 = nrm((NO, D, RWKV_DECAY_LORA), D ** -0.5)
    rw_w2 = nrm((NO, RWKV_DECAY_LORA, D), 0.1 * RWKV_DECAY_LORA ** -0.5)
    rw_a0 = nrm((NO, D), 0.1)
    rw_a1 = nrm((NO, D, RWKV_A_LORA), D ** -0.5)
    rw_a2 = nrm((NO, RWKV_A_LORA, D), 0.5 * RWKV_A_LORA ** -0.5)
    rw_g1 = nrm((NO, D, RWKV_GATE_LORA), D ** -0.5)
    rw_g2 = nrm((NO, RWKV_GATE_LORA, D), RWKV_GATE_LORA ** -0.5)
    rw_kk = 0.85 + nrm((NO, D), 0.02)
    rw_ka = 1.0 + nrm((NO, D), 0.02)
    rw_rk = nrm((NO, RWKV_HEADS, RWKV_HEAD), 0.1)
    rw_lnx_w = 1.0 + nrm((NO, D), 0.02)
    rw_lnx_b = nrm((NO, D), 0.02)
    moe_wg = nrm((DEPTH, D, MOE_GROUPS), D ** -0.5)
    moe_bg = nrm((DEPTH, MOE_GROUPS), 0.01)
    moe_we = nrm((DEPTH, D, MOE_EXPERTS), D ** -0.5)
    moe_be = nrm((DEPTH, MOE_EXPERTS), 0.01)
    moe_w1 = nrm((DEPTH, MOE_EXPERTS, D, MOE_D_FF), D ** -0.5)
    moe_w3 = nrm((DEPTH, MOE_EXPERTS, D, MOE_D_FF), D ** -0.5)
    moe_w2 = nrm((DEPTH, MOE_EXPERTS, MOE_D_FF, D), MOE_D_FF ** -0.5)
    return {"x": x, "norm_mix_w": norm_mix_w, "norm_ffn_w": norm_ffn_w, "norm_final_w": norm_final_w,
            "w_in_e": w_in_e, "ssd_conv_w": ssd_conv_w, "ssd_conv_b": ssd_conv_b,
            "ssd_dt_bias": ssd_dt_bias, "ssd_a_log": ssd_a_log, "ssd_d": ssd_d,
            "ssd_norm_w": ssd_norm_w, "w_out_e": w_out_e,
            "rw_mu": rw_mu, "rw_wr": rw_wr, "rw_wk": rw_wk, "rw_wv": rw_wv, "rw_wo": rw_wo,
            "rw_w0": rw_w0, "rw_w1": rw_w1, "rw_w2": rw_w2, "rw_a0": rw_a0, "rw_a1": rw_a1,
            "rw_a2": rw_a2, "rw_g1": rw_g1, "rw_g2": rw_g2, "rw_kk": rw_kk, "rw_ka": rw_ka,
            "rw_rk": rw_rk, "rw_lnx_w": rw_lnx_w, "rw_lnx_b": rw_lnx_b,
            "moe_wg": moe_wg, "moe_bg": moe_bg, "moe_we": moe_we, "moe_be": moe_be,
            "moe_w1": moe_w1, "moe_w3": moe_w3, "moe_w2": moe_w2}


def reference(x, norm_mix_w, norm_ffn_w, norm_final_w,
              w_in_e, ssd_conv_w, ssd_conv_b, ssd_dt_bias, ssd_a_log, ssd_d, ssd_norm_w, w_out_e,
              rw_mu, rw_wr, rw_wk, rw_wv, rw_wo, rw_w0, rw_w1, rw_w2, rw_a0, rw_a1, rw_a2,
              rw_g1, rw_g2, rw_kk, rw_ka, rw_rk, rw_lnx_w, rw_lnx_b,
              moe_wg, moe_bg, moe_we, moe_be, moe_w1, moe_w3, moe_w2):
    pos = jnp.arange(x.shape[1], dtype=jnp.float32)
    h = x
    for layer in range(DEPTH):
        i = layer // 2
        u = rms_norm(h, norm_mix_w[layer])
        if layer % 2 == 0:
            mix = ssd_retention_layer(u, pos, w_in_e[i], ssd_conv_w[i], ssd_conv_b[i], ssd_dt_bias[i],
                                      ssd_a_log[i], ssd_d[i], ssd_norm_w[i], w_out_e[i])
        else:
            mix = rwkv7_layer(u, rw_mu[i], rw_wr[i], rw_wk[i], rw_wv[i], rw_wo[i], rw_w0[i], rw_w1[i],
                              rw_w2[i], rw_a0[i], rw_a1[i], rw_a2[i], rw_g1[i], rw_g2[i], rw_kk[i],
                              rw_ka[i], rw_rk[i], rw_lnx_w[i], rw_lnx_b[i])
        h = h + mix
        h = h + hier_moe(rms_norm(h, norm_ffn_w[layer]), moe_wg[layer], moe_bg[layer], moe_we[layer],
                         moe_be[layer], moe_w1[layer], moe_w3[layer], moe_w2[layer])
    return rms_norm(h, norm_final_w)
```

```cpp
#include <hip/hip_runtime.h>
#include <stdint.h>
#include <stdio.h>

#ifndef MK_PER_PHASE
#define MK_PER_PHASE 1
#endif

#define LAS __attribute__((address_space(3)))
typedef unsigned short bf16_t;
typedef short bf16x8 __attribute__((ext_vector_type(8)));
typedef float f32x4 __attribute__((ext_vector_type(4)));
typedef float f32x2 __attribute__((ext_vector_type(2)));
typedef unsigned u32x4 __attribute__((ext_vector_type(4)));
typedef unsigned u32x2 __attribute__((ext_vector_type(2)));

constexpr int T_TOK = 65536, DM = 1024, SEQ = 4096;
constexpr int NPROJ = 5888;
constexpr int PC_Z = 0, PC_XBC = 1024, PC_Q = 2560, PC_K = 3072, PC_V = 3584, PC_G = 4608, PC_DT = 5632;
constexpr int NTHREADS = 512;
constexpr int LDS_BYTES = 147456;
constexpr int LDS_MISC = LDS_BYTES - 256;
constexpr int NSLOT = T_TOK + 24 * 256;
constexpr int NPHASE = 22;

constexpr size_t MiB = 1024 * 1024;
constexpr size_t WS_CTL = 0;
constexpr size_t CTL_ZERO_BYTES = 16384;
constexpr size_t CTL_CNT_OFF = 14336;
constexpr size_t WS_META = 64 * 1024;
constexpr size_t META_STRIDE = 2 * MiB - 32 * 1024;
constexpr size_t MT_RANK = 0, MT_BKT = 262144, MT_C = 524288, MT_STOK = 1048576, MT_SC = 1048576 + 294912, MT_TILE = 1048576 + 294912 + 589824;
constexpr size_t WS_ROPE = 4 * MiB;
constexpr size_t WS_WB = 6 * MiB;
constexpr size_t WB_WIN = 0, WB_WOUT = WB_WIN + (size_t)NPROJ * 1024 * 2, WB_WR = WB_WOUT + (size_t)1024 * 2048 * 2, WB_WK = WB_WR + 2 * MiB, WB_WV = WB_WK + 2 * MiB, WB_WO = WB_WV + 2 * MiB,
                 WB_L1 = WB_WO + 2 * MiB  , WB_L2 = WB_L1 + 3 * 512 * 1024  , WB_W13 = WB_L2 + 3 * 512 * 1024  ,
                 WB_W2 = WB_W13 + (size_t)32 * 2 * MiB  , WB_END = WB_W2 + (size_t)32 * MiB;
constexpr size_t WS_SLAB = 130 * MiB;
constexpr size_t SLAB = 128 * MiB;
constexpr size_t WS_E = WS_SLAB + 6 * SLAB;
constexpr size_t WS_END = WS_E + 96 * MiB;
static_assert(WS_WB + WB_END <= WS_SLAB, "weights overflow");
static_assert(WS_END <= 1024 * MiB, "workspace overflow");

struct Params {
    const float* in[37];
    float* out;
    unsigned char* ws;
    int ph_lo, ph_hi;
};

__device__ __forceinline__ float bf2f(bf16_t v) { return __uint_as_float(((unsigned)v) << 16); }
__device__ __forceinline__ float bflo(unsigned w) { return __uint_as_float(w << 16); }
__device__ __forceinline__ float bfhi(unsigned w) { return __uint_as_float(w & 0xffff0000u); }
__device__ __forceinline__ unsigned cvt_pk_bf16(float lo, float hi) { unsigned r; asm volatile("v_cvt_pk_bf16_f32 %0, %1, %2" : "=v"(r) : "v"(lo), "v"(hi)); return r; }
__device__ __forceinline__ bf16_t f2bf(float f) { return (bf16_t)(cvt_pk_bf16(f, 0.f) & 0xffffu); }
__device__ __forceinline__ float wave_sum(float v) {
#pragma unroll
    for (int o = 32; o >= 1; o >>= 1) v += __shfl_xor(v, o);
    return v;
}
__device__ __forceinline__ float fsilu(float x) { return x / (1.f + __expf(-x)); }
__device__ __forceinline__ float fsigmoid(float x) { return 1.f / (1.f + __expf(-x)); }
__device__ __forceinline__ float fsoftplus(float x) { return x > 20.f ? x : log1pf(__expf(x)); }
__device__ __forceinline__ float ftanh(float x) { const float xc = fminf(fmaxf(x, -15.f), 15.f); const float e = __expf(2.f * xc); return (e - 1.f) / (e + 1.f); }
__device__ __forceinline__ int ld_vec_i32(const int* p) { int r; asm volatile("global_load_dword %0, %1, off\n\ts_waitcnt vmcnt(0)" : "=&v"(r) : "v"(p) : "memory"); return r; }

#define XB_TMO      128
#define XB_XCNT(j)  (256  + 64 * (j))
#define XB_XSUB(j)  (1280 + 64 * (j))
#define XB_XGEN(j)  (2304 + 64 * (j))
#define XB_TOP      3328
#define XB_TOPGEN   3392
#define XCD_BAR_WORDS 3456
#define XB_SPIN_CAP (1u << 24)
__device__ __forceinline__ unsigned xb_ld(unsigned* p)              { return __hip_atomic_load(p, __ATOMIC_RELAXED, __HIP_MEMORY_SCOPE_AGENT); }
__device__ __forceinline__ unsigned xb_add(unsigned* p, unsigned v) { return __hip_atomic_fetch_add(p, v, __ATOMIC_RELAXED, __HIP_MEMORY_SCOPE_AGENT); }
__device__ __forceinline__ unsigned xb_xcc_id() { return (unsigned)__builtin_amdgcn_s_getreg((3 << 11) | 20) & 0xFu; }
#define XB_SPIN(cond, bar) do { unsigned _sp = 0; while (cond) { __builtin_amdgcn_s_sleep(1); \
    if ((++_sp & 255u) == 0u) { if (xb_ld(&(bar)[XB_TMO])) break; if (_sp > XB_SPIN_CAP) { atomicAdd(&(bar)[XB_TMO], 1u); break; } } } } while (0)
struct XcdBarrier { unsigned* bar; unsigned x; volatile LAS unsigned* st; };
__device__ __forceinline__ XcdBarrier xcd_barrier_post(unsigned* bar, volatile LAS unsigned* st) {
    XcdBarrier b; b.bar = bar; b.x = xb_xcc_id(); b.st = st;
    if (threadIdx.x == 0) (void)xb_add(&bar[XB_XCNT(b.x)], 1u);
    return b;
}
__device__ __forceinline__ void xcd_barrier_complete(unsigned* bar, unsigned x, unsigned& nloc, unsigned& nx) {
    const unsigned G = gridDim.x * gridDim.y * gridDim.z;
    unsigned sum, cnt, mine, sp = 0u;
    for (;;) {
        sum = 0u; cnt = 0u; mine = 0u;
#pragma unroll
        for (unsigned j = 0; j < 16; ++j) { const unsigned c = xb_ld(&bar[XB_XCNT(j)]); sum += c; cnt += (c > 0u) ? 1u : 0u; mine = (j == x) ? c : mine; }
        if (sum == G) break;
        __builtin_amdgcn_s_sleep(1);
        if ((++sp & 255u) == 0u) { if (xb_ld(&bar[XB_TMO])) break; if (sp > XB_SPIN_CAP) { atomicAdd(&bar[XB_TMO], 1u); break; } }
    }
    nloc = mine > 0u ? mine : 1u; nx = cnt > 0u ? cnt : 1u;
}
__device__ __forceinline__ void xcd_barrier(const XcdBarrier& b) {
    asm volatile("s_waitcnt vmcnt(0)" ::: "memory");
    __syncthreads();
    if (threadIdx.x == 0) {
        unsigned* bar = b.bar;
        __builtin_amdgcn_s_waitcnt(0);
        unsigned nloc = b.st[0], nx = b.st[1];
        if (nloc == 0u) { xcd_barrier_complete(bar, b.x, nloc, nx); b.st[0] = nloc; b.st[1] = nx; }
        const unsigned old = xb_add(&bar[XB_XSUB(b.x)], 1u);
        const unsigned gen = old / nloc;
        if (old + 1u == (gen + 1u) * nloc) {
            __builtin_amdgcn_fence(__ATOMIC_RELEASE, "agent");
            asm volatile("s_waitcnt vmcnt(0)" ::: "memory");
            const unsigned og = xb_add(&bar[XB_TOP], 1u);
            const unsigned tg = og / nx;
            if (og + 1u == (tg + 1u) * nx) xb_add(&bar[XB_TOPGEN], 1u);
            else XB_SPIN(xb_ld(&bar[XB_TOPGEN]) == tg, bar);
            __builtin_amdgcn_fence(__ATOMIC_ACQUIRE, "agent");
            xb_add(&bar[XB_XGEN(b.x)], 1u);
            asm volatile("s_waitcnt vmcnt(0)" ::: "memory");
        } else {
            XB_SPIN(xb_ld(&bar[XB_XGEN(b.x)]) == gen, bar);
            __builtin_amdgcn_fence(__ATOMIC_ACQUIRE, "agent");
            asm volatile("s_waitcnt vmcnt(0)" ::: "memory");
        }
    }
    __syncthreads();
}

constexpr int BM = 256, BK = 64, HALF = 128, HTB = HALF * BK * 2, STAGE_BYTES = 8 * HTB;
__device__ __forceinline__ int lds_byte(int r, int c) { const int st = (r >> 4) * 2 + (c >> 5), rr = r & 15, cc = c & 31, ob = rr * 64 + cc * 2; return st * 1024 + (ob ^ (((ob >> 9) & 1) << 5)); }
__device__ __forceinline__ void stage_rc(int b, int& R, int& C) { const int st = b / 1024, sb = b % 1024, swz = sb ^ (((sb >> 9) & 1) << 5); R = (st >> 1) * 16 + swz / 64; C = (st & 1) * 32 + (swz % 64) / 2; }
__device__ __forceinline__ int perm32(int rho) { const int n = rho >> 4, i = rho & 15; return 8 * (i >> 2) + 4 * n + (i & 3); }
struct Unit { int pm, pn, prob; };
__device__ __forceinline__ void tile_order(int L, int nM, int nN, int& pm, int& pn) {
    const int nwg = nM * nN; int wgid = L;
    { const int q = nwg / 8, r = nwg % 8, xcd = wgid % 8, off = wgid / 8; wgid = (xcd < r ? xcd * (q + 1) : r * (q + 1) + (xcd - r) * q) + off; }
    const int nig = 8 * nN, gid = wgid / nig, fm = gid * 8, gsz = (nM - fm) < 8 ? (nM - fm) : 8;
    pm = fm + ((wgid % nig) % gsz); pn = (wgid % nig) / gsz;
}

template <class P>
__device__ __forceinline__ void gemm_phase(LAS unsigned char* lds, const P& S) {
    const int tid = threadIdx.x, wid = __builtin_amdgcn_readfirstlane(tid >> 6), lane = tid & 63, wr = wid >> 2, wc = wid & 3, fr = lane & 15, fq = lane >> 4;
    const int K = S.K, nt = K / BK, lda = S.lda, ldb = S.ldb;
    int RA[2], CA[2]; unsigned voffB[2], vAc[2][2], vAn[2][2];
#pragma unroll
    for (int i = 0; i < 2; ++i) { int R, C; stage_rc(tid * 16 + i * 8192, R, C); RA[i] = R; CA[i] = C; const int Rb = P::PERM ? ((R & ~31) + perm32(R & 31)) : R;
        voffB[i] = (unsigned)(Rb * ldb + C) * 2u;
#pragma unroll
        for (int h = 0; h < 2; ++h) { vAc[h][i] = (unsigned)((h * HALF + R) * lda + C) * 2u; vAn[h][i] = vAc[h][i]; } }
    const size_t kstep = (size_t)(BK * 2);
    const size_t hstepB = (size_t)HALF * ldb * 2;
    const unsigned ldsw = (unsigned)wid * 1024u;
    const int aoff = lds_byte(wr * 64 + fr, fq * 8), boff = lds_byte(wc * 32 + fr, fq * 8);
#define PG8_SA(b, h) (((b) * 2 + (h)) * HTB)
#define PG8_SB(b, h) ((4 + (b) * 2 + (h)) * HTB)
#define PG8_STAGE2(bufoff, gbase, v0, v1) do { \
        __builtin_amdgcn_global_load_lds((const unsigned*)((const char*)(gbase) + (v0)), (LAS unsigned*)(lds + (bufoff) + ldsw), 16, 0, 0); \
        __builtin_amdgcn_global_load_lds((const unsigned*)((const char*)(gbase) + (v1)), (LAS unsigned*)(lds + (bufoff) + ldsw + 8192), 16, 0, 0); } while (0)
#define PG8_LDA(dst, b, h) do { _Pragma("unroll") for (int m = 0; m < 4; ++m) _Pragma("unroll") for (int k = 0; k < 2; ++k) dst[m][k] = *(const LAS bf16x8*)(lds + PG8_SA(b, h) + aoff + m * 2048 + k * 1024); } while (0)
#define PG8_LDB(dst, b, h) do { _Pragma("unroll") for (int n = 0; n < 2; ++n) _Pragma("unroll") for (int k = 0; k < 2; ++k) dst[n][k] = *(const LAS bf16x8*)(lds + PG8_SB(b, h) + boff + n * 2048 + k * 1024); } while (0)
#define PG8_MMA(ai, bj, At, Bt) do { __builtin_amdgcn_s_setprio(1); _Pragma("unroll") for (int m = 0; m < 4; ++m) _Pragma("unroll") for (int n = 0; n < 2; ++n) _Pragma("unroll") for (int k = 0; k < 2; ++k) \
        acc[ai][bj][m][n] = __builtin_amdgcn_mfma_f32_16x16x32_bf16(Bt[n][k], At[m][k], acc[ai][bj][m][n], 0, 0, 0); __builtin_amdgcn_s_setprio(0); } while (0)
#define PG8_WAIT_V(n) asm volatile("s_waitcnt vmcnt(" #n ")" ::: "memory")
#define PG8_WAIT_L(n) asm volatile("s_waitcnt lgkmcnt(" #n ")" ::: "memory")
#define PG8_BAR __builtin_amdgcn_s_barrier()
#define PG8_SCHED __builtin_amdgcn_sched_barrier(0)
    Unit cur, nxt; int ui = 0;
    if (!S.next(0, cur)) return;
    if constexpr (P::GATHER) {
#pragma unroll
        for (int h = 0; h < 2; ++h)
#pragma unroll
            for (int i = 0; i < 2; ++i) vAc[h][i] = S.a_voff(cur, h * HALF + RA[i], CA[i]);
    }
    float zf; asm volatile("v_mov_b32 %0, 0" : "=v"(zf));
    f32x4 acc[2][2][4][2];
#pragma unroll
    for (int a = 0; a < 2; ++a)
#pragma unroll
        for (int b = 0; b < 2; ++b)
#pragma unroll
            for (int m = 0; m < 4; ++m)
#pragma unroll
                for (int n = 0; n < 2; ++n) acc[a][b][m][n] = (f32x4){zf, zf, zf, zf};
    bf16x8 At[4][2], B0[2][2], B1[2][2];
    const char* cA = S.a_ptr(cur);
    {
        const char* b0 = S.b_ptr(cur, 0); const char* b1 = S.b_ptr(cur, 1);
        PG8_STAGE2(PG8_SB(0, 0), b0, voffB[0], voffB[1]); PG8_STAGE2(PG8_SA(0, 0), cA, vAc[0][0], vAc[0][1]); PG8_STAGE2(PG8_SB(0, 1), b0 + hstepB, voffB[0], voffB[1]); PG8_STAGE2(PG8_SA(0, 1), cA, vAc[1][0], vAc[1][1]);
        if (wr == 1) PG8_BAR;
        PG8_WAIT_V(4); PG8_BAR;
        PG8_STAGE2(PG8_SB(1, 0), b1, voffB[0], voffB[1]); PG8_STAGE2(PG8_SA(1, 0), cA + kstep, vAc[0][0], vAc[0][1]); PG8_STAGE2(PG8_SB(1, 1), b1 + hstepB, voffB[0], voffB[1]);
        PG8_WAIT_V(6); PG8_BAR;
    }
    for (;;) {
        const bool has_next = S.next(ui + 1, nxt);
        if (!has_next) nxt = cur;
        if constexpr (P::GATHER) {
            if (has_next) {
#pragma unroll
                for (int h = 0; h < 2; ++h)
#pragma unroll
                    for (int i = 0; i < 2; ++i) vAn[h][i] = S.a_voff(nxt, h * HALF + RA[i], CA[i]);
            }
        }
        const char* nA = S.a_ptr(nxt);
        for (int t = 0; t < nt; t += 2) {
            const bool last = (t == nt - 2);
            const char* a1 = cA + (size_t)(t + 1) * kstep;
            const char* a2 = last ? nA : cA + (size_t)(t + 2) * kstep;
            const char* a3 = a2 + kstep;
            const char* b2 = last ? S.b_ptr(nxt, 0) : S.b_ptr(cur, t + 2);
            const char* b3 = last ? S.b_ptr(nxt, 1) : S.b_ptr(cur, t + 3);
            unsigned s00 = vAc[0][0], s01 = vAc[0][1], s10 = vAc[1][0], s11 = vAc[1][1];
            if constexpr (P::GATHER) { if (last) { s00 = vAn[0][0]; s01 = vAn[0][1]; s10 = vAn[1][0]; s11 = vAn[1][1]; } }
            PG8_LDB(B0, 0, 0); PG8_SCHED; PG8_LDA(At, 0, 0); PG8_STAGE2(PG8_SA(1, 1), a1, vAc[1][0], vAc[1][1]);
            PG8_WAIT_L(8); PG8_BAR; PG8_WAIT_L(0); PG8_MMA(0, 0, At, B0); PG8_BAR; PG8_SCHED;
            PG8_LDB(B1, 0, 1); PG8_STAGE2(PG8_SB(0, 0), b2, voffB[0], voffB[1]);
            PG8_BAR; PG8_WAIT_L(0); PG8_MMA(0, 1, At, B1); PG8_BAR;
            PG8_LDA(At, 0, 1); PG8_STAGE2(PG8_SA(0, 0), a2, s00, s01);
            PG8_BAR; PG8_WAIT_L(0); PG8_MMA(1, 0, At, B0); PG8_BAR; PG8_SCHED;
            PG8_STAGE2(PG8_SB(0, 1), b2 + hstepB, voffB[0], voffB[1]);
            PG8_WAIT_V(6); PG8_BAR; PG8_MMA(1, 1, At, B1); PG8_BAR;
            PG8_LDB(B0, 1, 0); PG8_SCHED; PG8_LDA(At, 1, 0); PG8_STAGE2(PG8_SA(0, 1), a2, s10, s11);
            PG8_WAIT_L(8); PG8_BAR; PG8_WAIT_L(0); PG8_MMA(0, 0, At, B0); PG8_BAR; PG8_SCHED;
            PG8_LDB(B1, 1, 1); PG8_STAGE2(PG8_SB(1, 0), b3, voffB[0], voffB[1]);
            PG8_BAR; PG8_WAIT_L(0); PG8_MMA(0, 1, At, B1); PG8_BAR;
            PG8_LDA(At, 1, 1); PG8_STAGE2(PG8_SA(1, 0), a3, s00, s01);
            PG8_BAR; PG8_WAIT_L(0); PG8_MMA(1, 0, At, B0); PG8_BAR; PG8_SCHED;
            PG8_STAGE2(PG8_SB(1, 1), b3 + hstepB, voffB[0], voffB[1]);
            PG8_WAIT_V(6); PG8_BAR; PG8_MMA(1, 1, At, B1); PG8_BAR;
        }
        S.epi(acc, cur, wr, wc, fr, fq);
        if (!has_next) break;
#pragma unroll
        for (int a = 0; a < 2; ++a)
#pragma unroll
            for (int b = 0; b < 2; ++b)
#pragma unroll
                for (int m = 0; m < 4; ++m)
#pragma unroll
                    for (int n = 0; n < 2; ++n) acc[a][b][m][n] = (f32x4){zf, zf, zf, zf};
        cur = nxt; cA = nA; ++ui;
        if constexpr (P::GATHER) {
#pragma unroll
            for (int h = 0; h < 2; ++h)
#pragma unroll
                for (int i = 0; i < 2; ++i) vAc[h][i] = vAn[h][i];
        }
    }
    PG8_WAIT_V(0);
    if (wr == 0) PG8_BAR;
    PG8_BAR;
#undef PG8_SA
#undef PG8_SB
#undef PG8_STAGE2
#undef PG8_LDA
#undef PG8_LDB
#undef PG8_MMA
#undef PG8_WAIT_V
#undef PG8_WAIT_L
#undef PG8_BAR
#undef PG8_SCHED
}

enum { EK_BF16 = 0, EK_LORA1 = 1, EK_LORA2 = 2, EK_F32RES = 3 };
template <int KIND>
struct DenseP {
    static constexpr bool PERM = (KIND != EK_F32RES), GATHER = false;
    int K, lda, ldb, nM, nN, nprob, G, c;
    const bf16_t* A; size_t a_stride;
    const bf16_t* B; size_t b_stride;
    bf16_t* O; size_t o_stride; int ldc;
    bf16_t* Oalt1; bf16_t* Oalt2;
    const float* res; float* Of;
    const float* v0; const float* v1;
    __device__ __forceinline__ bool next(int i, Unit& u) const {
        const long L = (long)i * G + c; const int per = nM * nN; if (L >= (long)per * nprob) return false;
        u.prob = (int)(L / per); tile_order((int)(L % per), nM, nN, u.pm, u.pn); return true;
    }
    __device__ __forceinline__ const char* a_ptr(const Unit& u) const { return (const char*)(A + (size_t)u.prob * a_stride + (size_t)u.pm * BM * lda); }
    __device__ __forceinline__ const char* b_ptr(const Unit& u, int kt) const { return (const char*)(B + (size_t)u.prob * b_stride + (size_t)u.pn * BM * ldb) + (size_t)kt * (BK * 2); }
    __device__ __forceinline__ unsigned a_voff(const Unit&, int, int) const { return 0u; }
    __device__ __forceinline__ void epi(const f32x4 (&acc)[2][2][4][2], const Unit& u, int wr, int wc, int fr, int fq) const {
        const int row0 = u.pm * BM + wr * 64 + fr;
        if constexpr (KIND == EK_F32RES) {
            const int col0 = u.pn * BM + wc * 32 + 4 * fq;
#pragma unroll
            for (int ai = 0; ai < 2; ++ai)
#pragma unroll
                for (int m = 0; m < 4; ++m) { const size_t ro = (size_t)(row0 + ai * HALF + m * 16) * ldc + col0;
#pragma unroll
                    for (int bj = 0; bj < 2; ++bj)
#pragma unroll
                        for (int n = 0; n < 2; ++n) { const f32x4 r = *(const f32x4*)(res + ro + bj * HALF + n * 16); *(f32x4*)(Of + ro + bj * HALF + n * 16) = acc[ai][bj][m][n] + r; } }
        } else {
            const int col0 = u.pn * BM + wc * 32 + 8 * fq;
            bf16_t* base = Oalt1 ? ((u.prob == 0) ? O : (u.prob == 1) ? Oalt1 : Oalt2) : O + (size_t)u.prob * o_stride;
            f32x4 bv[2][2];
#pragma unroll
            for (int bj = 0; bj < 2; ++bj)
#pragma unroll
                for (int n = 0; n < 2; ++n) {
                    if constexpr (KIND == EK_LORA2) { bv[bj][n] = (u.prob == 0) ? *(const f32x4*)(v0 + col0 + bj * HALF + 4 * n) : (u.prob == 1) ? *(const f32x4*)(v1 + col0 + bj * HALF + 4 * n) : (f32x4){0.f, 0.f, 0.f, 0.f}; }
                    else bv[bj][n] = (f32x4){0.f, 0.f, 0.f, 0.f};
                }
#pragma unroll
            for (int ai = 0; ai < 2; ++ai)
#pragma unroll
                for (int m = 0; m < 4; ++m) { bf16_t* rowp = base + (size_t)(row0 + ai * HALF + m * 16) * ldc + col0;
#pragma unroll
                    for (int bj = 0; bj < 2; ++bj) { f32x4 x0 = acc[ai][bj][m][0] + bv[bj][0], x1 = acc[ai][bj][m][1] + bv[bj][1];
                        if constexpr (KIND == EK_LORA1) {
                            const float kx = (u.prob == 0) ? 2.f : 1.f;
#pragma unroll
                            for (int j = 0; j < 4; ++j) { const float s0 = fsigmoid(kx * x0[j]), s1 = fsigmoid(kx * x1[j]);
                                x0[j] = (u.prob == 0) ? 2.f * s0 - 1.f : (u.prob == 2) ? s0 : x0[j]; x1[j] = (u.prob == 0) ? 2.f * s1 - 1.f : (u.prob == 2) ? s1 : x1[j]; } }
                        if constexpr (KIND == EK_LORA2) {
                            const float sc = (u.prob == 0) ? 0.6065306597126334f : 1.f;
#pragma unroll
                            for (int j = 0; j < 4; ++j) { const float s0 = sc * fsigmoid(x0[j]), s1 = sc * fsigmoid(x1[j]); x0[j] = (u.prob == 2) ? x0[j] : s0; x1[j] = (u.prob == 2) ? x1[j] : s1; } }
                        u32x4 w; w.x = cvt_pk_bf16(x0[0], x0[1]); w.y = cvt_pk_bf16(x0[2], x0[3]); w.z = cvt_pk_bf16(x1[0], x1[1]); w.w = cvt_pk_bf16(x1[2], x1[3]);
                        *(u32x4*)(rowp + bj * HALF) = w; } }
        }
    }
};

__device__ __forceinline__ void pair_lohi(int pr, int& lo, int& hi) { lo = (pr < 3) ? 0 : (pr < 5 ? 1 : 2); hi = (pr < 3) ? pr + 1 : (pr < 5 ? pr - 1 : 3); }

struct Moe1P {
    static constexpr bool PERM = true, GATHER = true;
    int K, lda, ldb, G, c, ntiles;
    const bf16_t* A; const bf16_t* W13;
    bf16_t* H; const int* slot_tok; const float* slot_c; const int* tile_bkt;
    __device__ __forceinline__ bool next(int i, Unit& u) const {
        const long L = (long)i * G + c; if (L >= (long)ntiles * 8) return false;
        u.pm = (int)(L >> 3); u.pn = (int)(L & 7); u.prob = __builtin_amdgcn_readfirstlane(ld_vec_i32(tile_bkt + u.pm)); return true;
    }
    __device__ __forceinline__ const char* a_ptr(const Unit&) const { return (const char*)A; }
    __device__ __forceinline__ unsigned a_voff(const Unit& u, int row, int C) const { int tok = ld_vec_i32(slot_tok + u.pm * BM + row); tok = tok < 0 ? 0 : tok; return (unsigned)(tok * lda + C) * 2u; }
    __device__ __forceinline__ const char* b_ptr(const Unit& u, int kt) const {
        int lo, hi; pair_lohi(u.prob % 6, lo, hi); const int e = (u.prob / 6) * 4 + ((u.pn < 4) ? lo : hi);
        return (const char*)(W13 + ((size_t)e * 1024 + (size_t)(u.pn & 3) * BM) * 1024) + (size_t)kt * (BK * 2);
    }
    __device__ __forceinline__ void epi(const f32x4 (&acc)[2][2][4][2], const Unit& u, int wr, int wc, int fr, int fq) const {
        const int row0 = u.pm * BM + wr * 64 + fr, col0 = ((u.pn < 4) ? 0 : 512) + (u.pn & 3) * 128 + wc * 32 + 8 * fq, ci = (u.pn < 4) ? 0 : 1;
#pragma unroll
        for (int ai = 0; ai < 2; ++ai)
#pragma unroll
            for (int m = 0; m < 4; ++m) { const int row = row0 + ai * HALF + m * 16; const float cw = slot_c[(size_t)row * 2 + ci];
                const f32x4 g0 = acc[ai][0][m][0], g1 = acc[ai][0][m][1], u0 = acc[ai][1][m][0], u1 = acc[ai][1][m][1]; f32x4 x0, x1;
#pragma unroll
                for (int j = 0; j < 4; ++j) { x0[j] = fsilu(g0[j]) * u0[j] * cw; x1[j] = fsilu(g1[j]) * u1[j] * cw; }
                u32x4 w; w.x = cvt_pk_bf16(x0[0], x0[1]); w.y = cvt_pk_bf16(x0[2], x0[3]); w.z = cvt_pk_bf16(x1[0], x1[1]); w.w = cvt_pk_bf16(x1[2], x1[3]);
                *(u32x4*)(H + (size_t)row * 1024 + col0) = w; }
    }
};
struct Moe2P {
    static constexpr bool PERM = false, GATHER = false;
    int K, lda, ldb, G, c, ntiles;
    const bf16_t* H; const bf16_t* W2;
    float* hres; const int* slot_tok; const int* tile_bkt;
    __device__ __forceinline__ bool next(int i, Unit& u) const {
        const long L = (long)i * G + c; if (L >= (long)ntiles * 4) return false;
        u.pm = (int)(L >> 2); u.pn = (int)(L & 3); u.prob = __builtin_amdgcn_readfirstlane(ld_vec_i32(tile_bkt + u.pm)); return true;
    }
    __device__ __forceinline__ const char* a_ptr(const Unit& u) const { return (const char*)(H + (size_t)u.pm * BM * 1024); }
    __device__ __forceinline__ unsigned a_voff(const Unit&, int, int) const { return 0u; }
    __device__ __forceinline__ const char* b_ptr(const Unit& u, int kt) const {
        int lo, hi; pair_lohi(u.prob % 6, lo, hi); const int e = (u.prob / 6) * 4 + ((kt < 8) ? lo : hi);
        return (const char*)(W2 + ((size_t)e * 1024 + (size_t)u.pn * BM) * 512) + (size_t)(kt & 7) * (BK * 2);
    }
    __device__ __forceinline__ void epi(const f32x4 (&acc)[2][2][4][2], const Unit& u, int wr, int wc, int fr, int fq) const {
        const int row0 = u.pm * BM + wr * 64 + fr, col0 = u.pn * BM + wc * 32 + 4 * fq;
#pragma unroll
        for (int ai = 0; ai < 2; ++ai)
#pragma unroll
            for (int m = 0; m < 4; ++m) { const int tok = ld_vec_i32(slot_tok + row0 + ai * HALF + m * 16);
                if (tok >= 0) { float* rp = hres + (size_t)tok * 1024 + col0;
#pragma unroll
                    for (int bj = 0; bj < 2; ++bj)
#pragma unroll
                        for (int n = 0; n < 2; ++n) { const f32x4 r = *(const f32x4*)(rp + bj * HALF + n * 16); *(f32x4*)(rp + bj * HALF + n * 16) = acc[ai][bj][m][n] + r; } } }
    }
};

struct Frame {
    LAS unsigned char* lds;
    int tid, lane, wave, G, bid;
    float* out; unsigned char* ws;
};
#define WSP(T, off) ((T*)(F.ws + (off)))

__device__ __forceinline__ void prep_tile(const Frame& F, const float* src, int src_ld, int k0, int kvalid, int c0, int nvalid, bf16_t* dst, int dst_ld) {
    LAS float* tl = (LAS float*)F.lds;
    __syncthreads();
#pragma unroll
    for (int p = 0; p < 2; ++p) { const int kk = (F.tid >> 4) + 32 * p, n4 = (F.tid & 15) * 4;
        f32x4 v = (f32x4){0.f, 0.f, 0.f, 0.f};
        if (kk < kvalid && n4 < nvalid) v = *(const f32x4*)(src + (size_t)(k0 + kk) * src_ld + c0 + n4);
        tl[kk * 65 + n4 + 0] = v[0]; tl[kk * 65 + n4 + 1] = v[1]; tl[kk * 65 + n4 + 2] = v[2]; tl[kk * 65 + n4 + 3] = v[3]; }
    __syncthreads();
    { const int n = F.tid >> 3, kc = (F.tid & 7) * 8; float x[8];
#pragma unroll
        for (int j = 0; j < 8; ++j) x[j] = tl[(kc + j) * 65 + n];
        u32x4 w; w.x = cvt_pk_bf16(x[0], x[1]); w.y = cvt_pk_bf16(x[2], x[3]); w.z = cvt_pk_bf16(x[4], x[5]); w.w = cvt_pk_bf16(x[6], x[7]);
        *(u32x4*)(dst + (size_t)n * dst_ld + k0 + kc) = w; }
}
__device__ __forceinline__ void phase_prep(const Params& p, const Frame& F) {
    bf16_t* wb = WSP(bf16_t, WS_WB);
    constexpr int N0 = 1472, N1 = N0 + 512, N2 = N1 + 1024, N3 = N2 + 192, N4 = N3 + 192, N5 = N4 + 8192, N6 = N5 + 4096;
    for (int id = F.bid; id < N6; id += F.G) {
        if (id < N0) { const int nt = id / 16, kt = id % 16, n0 = nt * 64; int c0, nv;
            if (n0 < PC_Q) { c0 = n0; nv = 64; } else if (n0 < PC_DT) { c0 = n0 + 16; nv = 64; } else if (n0 == PC_DT) { c0 = 2560; nv = 16; } else { c0 = 0; nv = 0; }
            prep_tile(F, p.in[4], 5648, kt * 64, 64, c0, nv, wb + WB_WIN / 2 + (size_t)n0 * 1024, 1024); }
        else if (id < N1) { const int j = id - N0, nt = j / 32, kt = j % 32; prep_tile(F, p.in[11], 1024, kt * 64, 64, nt * 64, 64, wb + WB_WOUT / 2 + (size_t)nt * 64 * 2048, 2048); }
        else if (id < N2) { const int j = id - N1, w = j / 256, r = j % 256, nt = r / 16, kt = r % 16; prep_tile(F, (w == 0) ? p.in[13] : (w == 1) ? p.in[14] : (w == 2) ? p.in[15] : p.in[16], 1024, kt * 64, 64, nt * 64, 64, wb + WB_WR / 2 + (size_t)w * 1048576 + (size_t)nt * 64 * 1024, 1024); }
        else if (id < N3) { const int j = id - N2, w = j / 64, r = j % 64, nt = r / 16, kt = r % 16; const int ncols = (w == 2) ? 160 : 64; int nv = ncols - nt * 64; nv = nv < 0 ? 0 : (nv > 64 ? 64 : nv);
            const float* src = (w == 0) ? p.in[18] : (w == 1) ? p.in[21] : p.in[23];
            prep_tile(F, src, ncols, kt * 64, 64, nt * 64, nv, wb + WB_L1 / 2 + (size_t)w * 262144 + (size_t)nt * 64 * 1024, 1024); }
        else if (id < N4) { const int j = id - N3, w = j / 64, r = j % 64, nt = r / 4, kt = r % 4; const int krows = (w == 2) ? 160 : 64; int kv = krows - kt * 64; kv = kv < 0 ? 0 : (kv > 64 ? 64 : kv);
            const float* src = (w == 0) ? p.in[19] : (w == 1) ? p.in[22] : p.in[24];
            prep_tile(F, src, 1024, kt * 64, kv, nt * 64, 64, wb + WB_L2 / 2 + (size_t)w * 262144 + (size_t)nt * 64 * 256, 256); }
        else if (id < N5) { const int j = id - N4, le = j / 256, r = j % 256, nt = r / 16, kt = r % 16;
            const int pn = nt >> 2, part = (nt >> 1) & 1, c0 = 128 * pn + 64 * (nt & 1);
            const float* src = (part ? p.in[35] : p.in[34]) + (size_t)le * 524288;
            prep_tile(F, src, 512, kt * 64, 64, c0, 64, wb + WB_W13 / 2 + (size_t)le * 1048576 + (size_t)nt * 64 * 1024, 1024); }
        else { const int j = id - N5, le = j / 128, r = j % 128, nt = r / 8, kt = r % 8;
            prep_tile(F, p.in[36] + (size_t)le * 524288, 1024, kt * 64, 64, nt * 64, 64, wb + WB_W2 / 2 + (size_t)le * 524288 + (size_t)nt * 64 * 512, 512); }
    }
    f32x2* rope = WSP(f32x2, WS_ROPE);
    for (int idx = F.bid * NTHREADS + F.tid; idx < SEQ * 64; idx += F.G * NTHREADS) {
        const int pos = idx >> 6, i = idx & 63;
        const float invf = exp2f(-(float)i * (13.287712379549449f / 64.f));
        const float ang = (float)pos * invf;
        const double x = (double)ang;
        const double kq = rint(x * 0.63661977236758134308);
        double r = fma(-kq, 1.57079632679489655800e+00, x); r = fma(-kq, 6.12323399573676603587e-17, r);
        const double r2 = r * r;
        double sp = -7.6471637318198164759e-13; sp = fma(sp, r2, 1.6059043836821614599e-10); sp = fma(sp, r2, -2.5052108385441718775e-08); sp = fma(sp, r2, 2.7557319223985890653e-06);
        sp = fma(sp, r2, -1.9841269841269841270e-04); sp = fma(sp, r2, 8.3333333333333333333e-03); sp = fma(sp, r2, -1.6666666666666666667e-01); const double sn = fma(sp * r2, r, r);
        double cp = 4.7794773323873852974e-14; cp = fma(cp, r2, -1.1470745597729724714e-11); cp = fma(cp, r2, 2.0876756987868098979e-09); cp = fma(cp, r2, -2.7557319223985890653e-07);
        cp = fma(cp, r2, 2.4801587301587301587e-05); cp = fma(cp, r2, -1.3888888888888888889e-03); cp = fma(cp, r2, 4.1666666666666666667e-02); cp = fma(cp, r2, -0.5); const double cs = fma(cp, r2, 1.0);
        const int q = ((int)kq) & 3;
        const double c = (q == 0) ? cs : (q == 1) ? -sn : (q == 2) ? -cs : sn;
        const double s = (q == 0) ? sn : (q == 1) ? cs : (q == 2) ? -sn : -cs;
        rope[idx] = (f32x2){(float)c, (float)s};
    }
}

__device__ __forceinline__ void row_load(const float* row, int lane, f32x4 (&v)[4]) {
#pragma unroll
    for (int j = 0; j < 4; ++j) v[j] = *(const f32x4*)(row + j * 256 + lane * 4);
}
__device__ __forceinline__ float row_rstd(const f32x4 (&v)[4], float eps) {
    float ss = 0.f;
#pragma unroll
    for (int j = 0; j < 4; ++j) ss += v[j][0] * v[j][0] + v[j][1] * v[j][1] + v[j][2] * v[j][2] + v[j][3] * v[j][3];
    ss = wave_sum(ss);
    return rsqrtf(ss * (1.f / 1024.f) + eps);
}
__device__ __forceinline__ void row_store_bf16(bf16_t* row, int lane, const f32x4 (&v)[4]) {
#pragma unroll
    for (int j = 0; j < 4; ++j) { u32x2 w; w.x = cvt_pk_bf16(v[j][0], v[j][1]); w.y = cvt_pk_bf16(v[j][2], v[j][3]); *(u32x2*)(row + j * 256 + lane * 4) = w; }
}

template <bool TO_BF16>
__device__ __forceinline__ void phase_rmsnorm(const Params& p, const Frame& F, const float* src, const float* w, void* dst) {
    f32x4 wv[4]; row_load(w, F.lane, wv);
    for (int row = F.bid * 8 + F.wave; row < T_TOK; row += F.G * 8) {
        f32x4 v[4]; row_load(src + (size_t)row * DM, F.lane, v);
        const float rs = row_rstd(v, 1e-6f);
#pragma unroll
        for (int j = 0; j < 4; ++j) v[j] = v[j] * rs * wv[j];
        if constexpr (TO_BF16) row_store_bf16((bf16_t*)dst + (size_t)row * DM, F.lane, v);
        else {
#pragma unroll
            for (int j = 0; j < 4; ++j) *(f32x4*)((float*)dst + (size_t)row * DM + j * 256 + F.lane * 4) = v[j];
        }
    }
}

__device__ __forceinline__ void phase_scan0(const Params& p, const Frame& F) {
    const bf16_t* proj = WSP(bf16_t, WS_SLAB);
    bf16_t* ybuf = (bf16_t*)F.out;
    const f32x2* rope = WSP(f32x2, WS_ROPE);
    LAS float* qs = (LAS float*)F.lds;
    LAS float* ks = qs + 8192;
    LAS float* vs = ks + 8192;
    LAS float* xr = vs + 4096;
    LAS float* zs = xr + 4096;
    LAS float* ys = zs + 4096;
    LAS float* ds = ys + 4096;
    const float* conv_w = p.in[5]; const float* conv_b = p.in[6];
    const int prow = F.tid >> 3, nq = F.tid & 7;
    for (int unit = F.bid; unit < 512; unit += F.G) {
        const bool is_ssd = unit < 256;
        const int b = is_ssd ? unit >> 4 : (unit - 256) >> 4;
        const int hh = unit & 15;
        const int grp = hh >> 3, hr = hh >> 2, sl = hh & 3;
        const float A_h = is_ssd ? -__expf(p.in[8][hh]) : 0.f, dtb = is_ssd ? p.in[7][hh] : 0.f, D_h = is_ssd ? p.in[9][hh] : 0.f;
        const float gam = 1.f - exp2f(-5.f - (float)hr);
        float s[16];
#pragma unroll
        for (int j = 0; j < 16; ++j) s[j] = 0.f;
        for (int t0 = 0; t0 < SEQ; t0 += 64) {
            __syncthreads();
            const size_t rbase = (size_t)b * SEQ + t0;
            if (is_ssd) {
                for (int idx = F.tid; idx < 64 * 256; idx += NTHREADS) { const int t = idx >> 8, n = idx & 255;
                    const int cc = 1024 + grp * 128 + (n & 127) + ((n >> 7) ? 256 : 0);
                    float a = conv_b[cc];
#pragma unroll
                    for (int j = 0; j < 4; ++j) { const int tt = t0 + t - 3 + j; if (tt >= 0) a += conv_w[j * 1536 + cc] * bf2f(proj[((size_t)b * SEQ + tt) * NPROJ + PC_XBC + cc]); }
                    a = fsilu(a);
                    if (n < 128) ks[t * 128 + n] = a; else qs[t * 128 + (n - 128)] = a; }
                for (int idx = F.tid; idx < 64 * 64; idx += NTHREADS) { const int t = idx >> 6, pp = idx & 63; const int cc = hh * 64 + pp;
                    float a = conv_b[cc];
#pragma unroll
                    for (int j = 0; j < 4; ++j) { const int tt = t0 + t - 3 + j; if (tt >= 0) a += conv_w[j * 1536 + cc] * bf2f(proj[((size_t)b * SEQ + tt) * NPROJ + PC_XBC + cc]); }
                    a = fsilu(a);
                    const float dtv = fsoftplus(bf2f(proj[(rbase + t) * NPROJ + PC_DT + hh]) + dtb);
                    xr[idx] = a; vs[idx] = a * dtv; zs[idx] = bf2f(proj[(rbase + t) * NPROJ + PC_Z + cc]);
                    if (pp == 0) ds[t] = __expf(dtv * A_h); }
            } else {
                for (int idx = F.tid; idx < 64 * 64; idx += NTHREADS) { const int t = idx >> 6, i = idx & 63;
                    const f32x2 cs = rope[(t0 + t) * 64 + i]; const size_t ro = (rbase + t) * NPROJ;
                    const float q1 = bf2f(proj[ro + PC_Q + hr * 128 + i]), q2 = bf2f(proj[ro + PC_Q + hr * 128 + 64 + i]);
                    const float k1 = bf2f(proj[ro + PC_K + hr * 128 + i]), k2 = bf2f(proj[ro + PC_K + hr * 128 + 64 + i]);
                    qs[t * 128 + i] = q1 * cs.x - q2 * cs.y; qs[t * 128 + 64 + i] = q1 * cs.y + q2 * cs.x;
                    ks[t * 128 + i] = (k1 * cs.x - k2 * cs.y) * 0.08838834764831845f; ks[t * 128 + 64 + i] = (k1 * cs.y + k2 * cs.x) * 0.08838834764831845f;
                    vs[idx] = bf2f(proj[ro + PC_V + hr * 256 + sl * 64 + i]);
                    if (i == 0) ds[t] = gam; }
            }
            __syncthreads();
            for (int t = 0; t < 64; ++t) {
                const float d = ds[t], v = vs[t * 64 + prow]; float a = 0.f;
                const LAS f32x4* kq = (const LAS f32x4*)(ks + t * 128 + nq * 16); const LAS f32x4* qq = (const LAS f32x4*)(qs + t * 128 + nq * 16);
#pragma unroll
                for (int j4 = 0; j4 < 4; ++j4) { const f32x4 kv = kq[j4], qv = qq[j4];
#pragma unroll
                    for (int j = 0; j < 4; ++j) { s[j4 * 4 + j] = s[j4 * 4 + j] * d + v * kv[j]; a += s[j4 * 4 + j] * qv[j]; } }
                a += __shfl_xor(a, 1); a += __shfl_xor(a, 2); a += __shfl_xor(a, 4);
                if (nq == 0) ys[t * 64 + prow] = a;
            }
            __syncthreads();
            for (int idx = F.tid; idx < 64 * 64; idx += NTHREADS) { const int t = idx >> 6, pp = idx & 63; float y = ys[idx];
                if (is_ssd) { y = (y + xr[idx] * D_h) * fsilu(zs[idx]); ybuf[(rbase + t) * 2048 + hh * 64 + pp] = f2bf(y); }
                else ybuf[(rbase + t) * 2048 + 1024 + hr * 256 + sl * 64 + pp] = f2bf(y); }
        }
    }
}

__device__ __forceinline__ void phase_gatenorm(const Params& p, const Frame& F) {
    const bf16_t* proj = WSP(bf16_t, WS_SLAB);
    bf16_t* ybuf = (bf16_t*)F.out;
    const float* nw = p.in[10];
    for (int row = F.bid * 8 + F.wave; row < T_TOK; row += F.G * 8) {
        bf16_t* yr = ybuf + (size_t)row * 2048;
#pragma unroll
        for (int j = 0; j < 4; ++j) {
            const u32x4 w = *(const u32x4*)(yr + j * 512 + F.lane * 8);
            float x[8] = {bflo(w.x), bfhi(w.x), bflo(w.y), bfhi(w.y), bflo(w.z), bfhi(w.z), bflo(w.w), bfhi(w.w)};
            float ss = 0.f;
#pragma unroll
            for (int e = 0; e < 8; ++e) ss += x[e] * x[e];
            if (j < 2) { ss = wave_sum(ss); const float rs = rsqrtf(ss * (1.f / 512.f) + 1e-5f);
                const f32x4 w0 = *(const f32x4*)(nw + j * 512 + F.lane * 8), w1 = *(const f32x4*)(nw + j * 512 + F.lane * 8 + 4);
#pragma unroll
                for (int e = 0; e < 4; ++e) { x[e] *= rs * w0[e]; x[4 + e] *= rs * w1[e]; } }
            else {
#pragma unroll
                for (int o = 16; o >= 1; o >>= 1) ss += __shfl_xor(ss, o);
                const float rs = rsqrtf(ss * (1.f / 256.f) + 1e-6f);
                const u32x4 gw = *(const u32x4*)(proj + (size_t)row * NPROJ + PC_G + (j - 2) * 512 + F.lane * 8);
                const float g[8] = {bflo(gw.x), bfhi(gw.x), bflo(gw.y), bfhi(gw.y), bflo(gw.z), bfhi(gw.z), bflo(gw.w), bfhi(gw.w)};
#pragma unroll
                for (int e = 0; e < 8; ++e) x[e] *= rs * fsilu(g[e]); }
            u32x4 o; o.x = cvt_pk_bf16(x[0], x[1]); o.y = cvt_pk_bf16(x[2], x[3]); o.z = cvt_pk_bf16(x[4], x[5]); o.w = cvt_pk_bf16(x[6], x[7]);
            *(u32x4*)(yr + j * 512 + F.lane * 8) = o;
        }
    }
}

__device__ __forceinline__ void phase_moe_route(const Params& p, const Frame& F, int layer, const float* h, bf16_t* tbuf) {
    unsigned char* meta = F.ws + WS_META + (size_t)layer * META_STRIDE;
    int* tok_rank = (int*)(meta + MT_RANK); int* tok_bkt = (int*)(meta + MT_BKT); f32x2* tok_c = (f32x2*)(meta + MT_C);
    int* gcount = (int*)(F.ws + WS_CTL + CTL_CNT_OFF) + layer * 32;
    const float* wg = p.in[30] + (size_t)layer * 4096; const float* bg = p.in[31] + layer * 4;
    const float* we = p.in[32] + (size_t)layer * 16384; const float* be = p.in[33] + layer * 16;
    LAS float* wl = (LAS float*)F.lds;
    LAS int* lcount = (LAS int*)(F.lds + 81920);
    LAS int* lbase = lcount + 32;
    LAS int* l_bkt = lbase + 32;
    LAS int* l_rank = l_bkt + 1024;
    LAS float* l_c = (LAS float*)(l_rank + 1024);
    __syncthreads();
    for (int idx = F.tid; idx < 20 * 1024; idx += NTHREADS) { const int j = idx >> 10, k = idx & 1023; wl[idx] = (j < 4) ? wg[k * 4 + j] : we[k * 16 + (j - 4)]; }
    if (F.tid < 32) lcount[F.tid] = 0;
    __syncthreads();
    const int TPB = (T_TOK + F.G - 1) / F.G, tok0 = F.bid * TPB;
    f32x4 wv[4]; row_load(p.in[2] + (size_t)layer * DM, F.lane, wv);
    for (int li = F.wave; li < TPB; li += 8) {
        const int tok = tok0 + li; if (tok >= T_TOK) break;
        f32x4 v[4]; row_load(h + (size_t)tok * DM, F.lane, v);
        const float rs = row_rstd(v, 1e-6f);
#pragma unroll
        for (int j = 0; j < 4; ++j) v[j] = v[j] * rs * wv[j];
        row_store_bf16(tbuf + (size_t)tok * DM, F.lane, v);
        float lg[20];
#pragma unroll
        for (int o = 0; o < 20; ++o) { float a = 0.f;
#pragma unroll
            for (int j = 0; j < 4; ++j) { const f32x4 w4 = *(const LAS f32x4*)(wl + o * 1024 + j * 256 + F.lane * 4); a += v[j][0] * w4[0] + v[j][1] * w4[1] + v[j][2] * w4[2] + v[j][3] * w4[3]; }
            lg[o] = wave_sum(a); }
        if (F.lane == 0) {
            float g0 = lg[0] + bg[0], g1 = lg[1] + bg[1], g2 = lg[2] + bg[2], g3 = lg[3] + bg[3];
            int gi = 0; float gm = g0; if (g1 > gm) { gm = g1; gi = 1; } if (g2 > gm) { gm = g2; gi = 2; } if (g3 > gm) { gm = g3; gi = 3; }
            const float gate = 1.f / (__expf(g0 - gm) + __expf(g1 - gm) + __expf(g2 - gm) + __expf(g3 - gm));
            float e0, e1, e2, e3;
            e0 = (gi == 0) ? lg[4] : (gi == 1) ? lg[8] : (gi == 2) ? lg[12] : lg[16];
            e1 = (gi == 0) ? lg[5] : (gi == 1) ? lg[9] : (gi == 2) ? lg[13] : lg[17];
            e2 = (gi == 0) ? lg[6] : (gi == 1) ? lg[10] : (gi == 2) ? lg[14] : lg[18];
            e3 = (gi == 0) ? lg[7] : (gi == 1) ? lg[11] : (gi == 2) ? lg[15] : lg[19];
            e0 += be[gi * 4 + 0]; e1 += be[gi * 4 + 1]; e2 += be[gi * 4 + 2]; e3 += be[gi * 4 + 3];
            int i1 = 0; float v1 = e0; if (e1 > v1) { v1 = e1; i1 = 1; } if (e2 > v1) { v1 = e2; i1 = 2; } if (e3 > v1) { v1 = e3; i1 = 3; }
            int i2 = -1; float v2 = -3.0e38f;
            if (i1 != 0 && e0 > v2) { v2 = e0; i2 = 0; } if (i1 != 1 && e1 > v2) { v2 = e1; i2 = 1; } if (i1 != 2 && e2 > v2) { v2 = e2; i2 = 2; } if (i1 != 3 && e3 > v2) { v2 = e3; i2 = 3; }
            const float w1 = gate / (1.f + __expf(v2 - v1)), w2 = gate - w1;
            const int lo = i1 < i2 ? i1 : i2, hi = i1 < i2 ? i2 : i1; const float clo = i1 < i2 ? w1 : w2, chi = i1 < i2 ? w2 : w1;
            const int pr = (lo == 0) ? hi - 1 : (lo == 1) ? hi + 1 : 5;
            const int bk = gi * 6 + pr;
            l_bkt[li] = bk; l_c[li * 2] = clo; l_c[li * 2 + 1] = chi;
            l_rank[li] = __hip_atomic_fetch_add((int*)(lcount + bk), 1, __ATOMIC_RELAXED, __HIP_MEMORY_SCOPE_WORKGROUP);
        }
    }
    __syncthreads();
    if (F.tid < 24) lbase[F.tid] = __hip_atomic_fetch_add(gcount + F.tid, lcount[F.tid], __ATOMIC_RELAXED, __HIP_MEMORY_SCOPE_AGENT);
    __syncthreads();
    for (int li = F.tid; li < TPB; li += NTHREADS) { const int tok = tok0 + li; if (tok < T_TOK) { const int bk = l_bkt[li]; tok_bkt[tok] = bk; tok_rank[tok] = lbase[bk] + l_rank[li]; tok_c[tok] = (f32x2){l_c[li * 2], l_c[li * 2 + 1]}; } }
}
__device__ __forceinline__ void phase_moe_slots(const Params& p, const Frame& F, int layer) {
    unsigned char* meta = F.ws + WS_META + (size_t)layer * META_STRIDE;
    const int* tok_rank = (const int*)(meta + MT_RANK); const int* tok_bkt = (const int*)(meta + MT_BKT); const f32x2* tok_c = (const f32x2*)(meta + MT_C);
    int* slot_tok = (int*)(meta + MT_STOK); f32x2* slot_c = (f32x2*)(meta + MT_SC); int* tile_tab = (int*)(meta + MT_TILE);
    int* gcount = (int*)(F.ws + WS_CTL + CTL_CNT_OFF) + layer * 32;
    LAS int* cnt = (LAS int*)F.lds; LAS int* start = cnt + 32;
    __syncthreads();
    if (F.tid < 24) cnt[F.tid] = __hip_atomic_load(gcount + F.tid, __ATOMIC_RELAXED, __HIP_MEMORY_SCOPE_AGENT);
    __syncthreads();
    if (F.tid == 0) { int a = 0; for (int b = 0; b < 24; ++b) { start[b] = a; a += (cnt[b] + 255) >> 8; } start[24] = a; }
    __syncthreads();
    for (int tok = F.bid * NTHREADS + F.tid; tok < T_TOK; tok += F.G * NTHREADS) { const int bk = tok_bkt[tok]; const int slot = start[bk] * 256 + tok_rank[tok]; slot_tok[slot] = tok; slot_c[slot] = tok_c[tok]; }
    for (int b = F.bid; b < 24; b += F.G) { const int s0 = start[b] * 256 + cnt[b], s1 = start[b + 1] * 256;
        for (int s = s0 + F.tid; s < s1; s += NTHREADS) { slot_tok[s] = -1; slot_c[s] = (f32x2){0.f, 0.f}; } }
    if (F.bid == 0) { if (F.tid == 0) tile_tab[0] = start[24];
        for (int m = F.tid; m < 288; m += NTHREADS) { int bk = 23; for (int b = 0; b < 24; ++b) if (m >= start[b] && m < start[b + 1]) bk = b; tile_tab[64 + m] = bk; } }
}

template <int SET>
__device__ __forceinline__ void phase_mix(const Params& p, const Frame& F, const float* h, bf16_t* o0, bf16_t* o1, bf16_t* o2) {
    const float* mu = p.in[12];
    constexpr int M0 = SET ? 0 : 1, M1 = SET ? 2 : 4, M2 = SET ? 3 : 5;
    f32x4 wv[4], m0[4], m1[4], m2[4];
    row_load(p.in[1] + DM, F.lane, wv); row_load(mu + M0 * DM, F.lane, m0); row_load(mu + M1 * DM, F.lane, m1); row_load(mu + M2 * DM, F.lane, m2);
    for (int run = F.bid * 8 + F.wave; run < T_TOK / 32; run += F.G * 8) {
        const int t0 = run * 32;
        f32x4 up[4];
        if ((t0 & (SEQ - 1)) == 0) {
#pragma unroll
            for (int j = 0; j < 4; ++j) up[j] = (f32x4){0.f, 0.f, 0.f, 0.f};
        } else { row_load(h + (size_t)(t0 - 1) * DM, F.lane, up); const float rs = row_rstd(up, 1e-6f);
#pragma unroll
            for (int j = 0; j < 4; ++j) up[j] = up[j] * rs * wv[j]; }
        for (int tt = 0; tt < 32; ++tt) {
            f32x4 u[4]; row_load(h + (size_t)(t0 + tt) * DM, F.lane, u); const float rs = row_rstd(u, 1e-6f);
            f32x4 a[4], b[4], c[4];
#pragma unroll
            for (int j = 0; j < 4; ++j) { u[j] = u[j] * rs * wv[j]; const f32x4 xx = up[j] - u[j]; a[j] = u[j] + xx * m0[j]; b[j] = u[j] + xx * m1[j]; c[j] = u[j] + xx * m2[j]; up[j] = u[j]; }
            row_store_bf16(o0 + (size_t)(t0 + tt) * DM, F.lane, a); row_store_bf16(o1 + (size_t)(t0 + tt) * DM, F.lane, b); row_store_bf16(o2 + (size_t)(t0 + tt) * DM, F.lane, c);
        }
    }
}

__device__ __forceinline__ void phase_rwkv(const Params& p, const Frame& F, bf16_t* rbuf, const bf16_t* kbuf, const bf16_t* vbuf, const bf16_t* ebuf, const bf16_t* abuf, const bf16_t* gbuf) {
    LAS float* R = (LAS float*)F.lds;
    LAS float* W = R + 4096; LAS float* KP = W + 4096; LAS float* V = KP + 4096; LAS float* AA = V + 4096; LAS float* BB = AA + 4096; LAS float* GG = BB + 4096; LAS float* YS = GG + 4096;
    LAS float* BON = (LAS float*)(F.lds + 131072);
    const float* k_k = p.in[25]; const float* k_a = p.in[26]; const float* r_k = p.in[27]; const float* lnw = p.in[28]; const float* lnb = p.in[29];
    const int i = F.tid >> 3, jq = F.tid & 7;
    for (int unit = F.bid; unit < 256; unit += F.G) {
        const int b = unit >> 4, hd = unit & 15;
        float s[8];
#pragma unroll
        for (int j = 0; j < 8; ++j) s[j] = 0.f;
        const int gcol = hd * 64 + F.lane;
        const float kkw = k_k[gcol], kaw = k_a[gcol], rkw = r_k[gcol], lw = lnw[gcol], lb = lnb[gcol];
        for (int t0 = 0; t0 < SEQ; t0 += 64) {
            __syncthreads();
#pragma unroll
            for (int q = 0; q < 8; ++q) { const int t = F.wave + 8 * q; const size_t off = ((size_t)b * SEQ + t0 + t) * DM + gcol; const int li = t * 64 + F.lane;
                const float r = bf2f(rbuf[off]), k = bf2f(kbuf[off]), v = bf2f(vbuf[off]), e = bf2f(ebuf[off]), a = bf2f(abuf[off]), g = bf2f(gbuf[off]);
                const float kkv = k * kkw; const float ss = wave_sum(kkv * kkv); const float kk = kkv * rsqrtf(fmaxf(ss, 1e-24f));
                const float kp = k * (1.f + (a - 1.f) * kaw);
                const float bon = wave_sum(r * kp * rkw);
                R[li] = r; W[li] = __expf(-e); KP[li] = kp; V[li] = v; AA[li] = -kk; BB[li] = kk * a; GG[li] = g;
                if (F.lane == 0) BON[t] = bon; }
            __syncthreads();
            for (int t = 0; t < 64; ++t) {
                const float v = V[t * 64 + i];
                const LAS f32x4* pa = (const LAS f32x4*)(AA + t * 64 + jq * 8); const LAS f32x4* pw = (const LAS f32x4*)(W + t * 64 + jq * 8);
                const LAS f32x4* pb = (const LAS f32x4*)(BB + t * 64 + jq * 8); const LAS f32x4* pk = (const LAS f32x4*)(KP + t * 64 + jq * 8); const LAS f32x4* pr = (const LAS f32x4*)(R + t * 64 + jq * 8);
                const f32x4 a0 = pa[0], a1 = pa[1];
                float sa = s[0] * a0[0] + s[1] * a0[1] + s[2] * a0[2] + s[3] * a0[3] + s[4] * a1[0] + s[5] * a1[1] + s[6] * a1[2] + s[7] * a1[3];
                sa += __shfl_xor(sa, 1); sa += __shfl_xor(sa, 2); sa += __shfl_xor(sa, 4);
                const f32x4 w0 = pw[0], w1 = pw[1], b0 = pb[0], b1 = pb[1], k0 = pk[0], k1 = pk[1], r0 = pr[0], r1 = pr[1];
                float y = 0.f;
#pragma unroll
                for (int j = 0; j < 4; ++j) { s[j] = s[j] * w0[j] + sa * b0[j] + v * k0[j]; y += s[j] * r0[j]; s[4 + j] = s[4 + j] * w1[j] + sa * b1[j] + v * k1[j]; y += s[4 + j] * r1[j]; }
                y += __shfl_xor(y, 1); y += __shfl_xor(y, 2); y += __shfl_xor(y, 4);
                if (jq == 0) YS[t * 64 + i] = y;
            }
            __syncthreads();
#pragma unroll
            for (int q = 0; q < 8; ++q) { const int t = F.wave + 8 * q; const int li = t * 64 + F.lane; const size_t off = ((size_t)b * SEQ + t0 + t) * DM + gcol;
                const float y = YS[li]; const float mean = wave_sum(y) * (1.f / 64.f); const float dlt = y - mean; const float var = wave_sum(dlt * dlt) * (1.f / 64.f);
                float o = dlt * rsqrtf(var + 64e-5f) * lw + lb; o += BON[t] * V[li]; o *= GG[li];
                rbuf[off] = f2bf(o); }
        }
    }
}

__global__ void __launch_bounds__(NTHREADS, 2) mega_fwd(Params p) {
    extern __shared__ __attribute__((aligned(16))) unsigned char lds_raw[];
    Frame F;
    F.lds = (LAS unsigned char*)lds_raw;
    F.tid = threadIdx.x; F.lane = F.tid & 63; F.wave = __builtin_amdgcn_readfirstlane(F.tid >> 6); F.G = gridDim.x; F.bid = blockIdx.x;
    F.out = p.out; F.ws = p.ws;
    volatile LAS unsigned* misc = (volatile LAS unsigned*)(F.lds + LDS_MISC);
    if (F.tid < 16) misc[F.tid] = 0u;
    __syncthreads();
    const int lo = p.ph_lo, hi = p.ph_hi;
    XcdBarrier bar; bar.bar = (unsigned*)(F.ws + WS_CTL); bar.x = 0; bar.st = misc;
    if (hi - lo > 1) bar = xcd_barrier_post((unsigned*)(F.ws + WS_CTL), misc);
#define IN(k) (lo <= (k) && (k) < hi)
#define SEAM(k) do { if (IN(k) && IN((k) + 1)) xcd_barrier(bar); } while (0)
    bf16_t* wb = WSP(bf16_t, WS_WB);
    bf16_t* S0 = WSP(bf16_t, WS_SLAB); bf16_t* S2 = WSP(bf16_t, WS_SLAB + 2 * SLAB); bf16_t* S3 = WSP(bf16_t, WS_SLAB + 3 * SLAB); bf16_t* S4 = WSP(bf16_t, WS_SLAB + 4 * SLAB); bf16_t* S5 = WSP(bf16_t, WS_SLAB + 5 * SLAB);
    bf16_t* EH = WSP(bf16_t, WS_E);
    bf16_t* O0 = (bf16_t*)F.out; bf16_t* O1 = O0 + (size_t)T_TOK * DM;
    float* hres = WSP(float, WS_SLAB);
    const int vcu = (F.G % 8 == 0) ? F.bid : F.bid;

    if (IN(0)) { phase_prep(p, F); } SEAM(0);
    if (IN(1)) { phase_rmsnorm<true>(p, F, p.in[0], p.in[1], O0); } SEAM(1);
    if (IN(2)) { DenseP<EK_BF16> P{}; P.K = 1024; P.lda = 1024; P.ldb = 1024; P.nM = 256; P.nN = NPROJ / 256; P.nprob = 1; P.G = F.G; P.c = vcu; P.A = O0; P.a_stride = 0; P.B = wb + WB_WIN / 2; P.b_stride = 0;
        P.O = S0; P.o_stride = 0; P.ldc = NPROJ; gemm_phase(F.lds, P); } SEAM(2);
    if (IN(3)) { phase_scan0(p, F); } SEAM(3);
    if (IN(4)) { phase_gatenorm(p, F); } SEAM(4);
    if (IN(5)) { DenseP<EK_F32RES> P{}; P.K = 2048; P.lda = 2048; P.ldb = 2048; P.nM = 256; P.nN = 4; P.nprob = 1; P.G = F.G; P.c = vcu; P.A = O0; P.B = wb + WB_WOUT / 2; P.res = p.in[0]; P.Of = hres; P.ldc = 1024; gemm_phase(F.lds, P); } SEAM(5);
#define MOE_LAYER(L, k0) \
    if (IN(k0)) { phase_moe_route(p, F, L, hres, S2); } SEAM(k0); \
    if (IN(k0 + 1)) { phase_moe_slots(p, F, L); } SEAM(k0 + 1); \
    if (IN(k0 + 2)) { unsigned char* meta = F.ws + WS_META + (size_t)(L) * META_STRIDE; Moe1P P{}; P.K = 1024; P.lda = 1024; P.ldb = 1024; P.G = F.G; P.c = vcu; \
        P.ntiles = __builtin_amdgcn_readfirstlane(ld_vec_i32((const int*)(meta + MT_TILE))); P.A = S2; P.W13 = wb + WB_W13 / 2 + (size_t)(L) * 16 * 1048576; P.H = S3; \
        P.slot_tok = (const int*)(meta + MT_STOK); P.slot_c = (const float*)(meta + MT_SC); P.tile_bkt = (const int*)(meta + MT_TILE) + 64; gemm_phase(F.lds, P); } SEAM(k0 + 2); \
    if (IN(k0 + 3)) { unsigned char* meta = F.ws + WS_META + (size_t)(L) * META_STRIDE; Moe2P P{}; P.K = 1024; P.lda = 1024; P.ldb = 512; P.G = F.G; P.c = vcu; \
        P.ntiles = __builtin_amdgcn_readfirstlane(ld_vec_i32((const int*)(meta + MT_TILE))); P.H = S3; P.W2 = wb + WB_W2 / 2 + (size_t)(L) * 16 * 524288; P.hres = hres; \
        P.slot_tok = (const int*)(meta + MT_STOK); P.tile_bkt = (const int*)(meta + MT_TILE) + 64; gemm_phase(F.lds, P); } SEAM(k0 + 3);
    MOE_LAYER(0, 6)
    if (IN(10)) { phase_mix<0>(p, F, hres, S2, S3, S4); } SEAM(10);
    if (IN(11)) { DenseP<EK_LORA1> P{}; P.K = 1024; P.lda = 1024; P.ldb = 1024; P.nM = 256; P.nN = 1; P.nprob = 3; P.G = F.G; P.c = vcu; P.A = S2; P.a_stride = (size_t)T_TOK * DM; P.B = wb + WB_L1 / 2; P.b_stride = 262144;
        P.O = EH; P.o_stride = (size_t)T_TOK * 256; P.ldc = 256; gemm_phase(F.lds, P); } SEAM(11);
    if (IN(12)) { phase_mix<1>(p, F, hres, S2, S3, S4); } SEAM(12);
    if (IN(13)) { DenseP<EK_BF16> P{}; P.K = 1024; P.lda = 1024; P.ldb = 1024; P.nM = 256; P.nN = 4; P.nprob = 3; P.G = F.G; P.c = vcu; P.ldc = 1024; P.A = S2; P.a_stride = (size_t)T_TOK * DM; P.B = wb + WB_WR / 2; P.b_stride = 1048576;
        P.O = S5; P.Oalt1 = O0; P.Oalt2 = O1; gemm_phase(F.lds, P); } SEAM(13);
    if (IN(14)) { DenseP<EK_LORA2> P{}; P.K = 256; P.lda = 256; P.ldb = 256; P.nM = 256; P.nN = 4; P.nprob = 3; P.G = F.G; P.c = vcu; P.A = EH; P.a_stride = (size_t)T_TOK * 256; P.B = wb + WB_L2 / 2; P.b_stride = 262144;
        P.O = S2; P.o_stride = (size_t)T_TOK * DM; P.ldc = 1024; P.v0 = p.in[17]; P.v1 = p.in[20]; gemm_phase(F.lds, P); } SEAM(14);
    if (IN(15)) { phase_rwkv(p, F, S5, O0, O1, S2, S3, S4); } SEAM(15);
    if (IN(16)) { DenseP<EK_F32RES> P{}; P.K = 1024; P.lda = 1024; P.ldb = 1024; P.nM = 256; P.nN = 4; P.nprob = 1; P.G = F.G; P.c = vcu; P.A = S5; P.B = wb + WB_WO / 2; P.res = hres; P.Of = hres; P.ldc = 1024; gemm_phase(F.lds, P); } SEAM(16);
    MOE_LAYER(1, 17)
    if (IN(21)) { phase_rmsnorm<false>(p, F, hres, p.in[3], F.out); }
}

extern "C" void kernel_launch(void* const* d_in, const int* in_sizes, int n_in, void* d_out, int out_size, void* d_ws, size_t ws_size, hipStream_t stream) {
    static int grid = 0;
    if (grid == 0) {
        if (n_in != 37 || out_size != T_TOK * DM || ws_size < WS_END) { fprintf(stderr, "kernel_launch: unexpected shapes (n_in %d out %d ws %zu)\n", n_in, out_size, ws_size); grid = -1; return; }
        int dev = 0, cus = 0, per_cu = 0;
        if (hipGetDevice(&dev) != hipSuccess || hipDeviceGetAttribute(&cus, hipDeviceAttributeMultiprocessorCount, dev) != hipSuccess) { grid = -1; return; }
        if (hipFuncSetAttribute((const void*)mega_fwd, hipFuncAttributeMaxDynamicSharedMemorySize, LDS_BYTES) != hipSuccess) { fprintf(stderr, "kernel_launch: hipFuncSetAttribute failed\n"); grid = -1; return; }
        if (hipOccupancyMaxActiveBlocksPerMultiprocessor(&per_cu, (const void*)mega_fwd, NTHREADS, LDS_BYTES) != hipSuccess || per_cu < 1) fprintf(stderr, "kernel_launch: occupancy query says %d\n", per_cu);
        (void)hipGetLastError();
        grid = cus;
    }
    if (grid < 0) return;
    (void)in_sizes;
    hipMemsetAsync((char*)d_ws + WS_CTL, 0, CTL_ZERO_BYTES, stream);
    Params p{};
    for (int i = 0; i < 37; ++i) p.in[i] = (const float*)d_in[i];
    p.out = (float*)d_out; p.ws = (unsigned char*)d_ws;
#if MK_PER_PHASE
    for (int k = 0; k < NPHASE; ++k) { p.ph_lo = k; p.ph_hi = k + 1; hipLaunchKernelGGL(mega_fwd, dim3(grid), dim3(NTHREADS), LDS_BYTES, stream, p); }
#else
    p.ph_lo = 0; p.ph_hi = NPHASE; hipLaunchKernelGGL(mega_fwd, dim3(grid), dim3(NTHREADS), LDS_BYTES, stream, p);
#endif
}
```

```cpp
#include <hip/hip_runtime.h>
#include <stdint.h>
#include <stdio.h>

#ifndef MK_PER_PHASE
#define MK_PER_PHASE 0
#endif

#define LAS __attribute__((address_space(3)))
typedef unsigned short bf16_t;
typedef short bf16x8 __attribute__((ext_vector_type(8)));
typedef float f32x4 __attribute__((ext_vector_type(4)));
typedef float f32x2 __attribute__((ext_vector_type(2)));
typedef unsigned u32x4 __attribute__((ext_vector_type(4)));
typedef unsigned u32x2 __attribute__((ext_vector_type(2)));

constexpr int T_TOK = 65536, DM = 1024, SEQ = 4096;
constexpr int NPROJ = 5888;
constexpr int PC_Z = 0, PC_XBC = 1024, PC_Q = 2560, PC_K = 3072, PC_V = 3584, PC_G = 4608, PC_DT = 5632;
constexpr int NTHREADS = 512;
constexpr int LDS_BYTES = 147456;
constexpr int LDS_MISC = LDS_BYTES - 256;
constexpr int NSLOT = T_TOK + 24 * 256;
constexpr int NPHASE = 22;

constexpr size_t MiB = 1024 * 1024;
constexpr size_t WS_CTL = 0;
constexpr size_t CTL_ZERO_BYTES = 16384;
constexpr size_t CTL_CNT_OFF = 14336;
constexpr size_t WS_META = 64 * 1024;
constexpr size_t META_STRIDE = 2 * MiB - 32 * 1024;
constexpr size_t MT_RANK = 0, MT_BKT = 262144, MT_C = 524288, MT_STOK = 1048576, MT_SC = 1048576 + 294912, MT_TILE = 1048576 + 294912 + 589824;
constexpr size_t WS_ROPE = 4 * MiB;
constexpr size_t WS_WB = 6 * MiB;
constexpr size_t WB_WIN = 0, WB_WOUT = WB_WIN + (size_t)NPROJ * 1024 * 2, WB_WR = WB_WOUT + (size_t)1024 * 2048 * 2, WB_WK = WB_WR + 2 * MiB, WB_WV = WB_WK + 2 * MiB, WB_WO = WB_WV + 2 * MiB,
                 WB_L1 = WB_WO + 2 * MiB  , WB_L2 = WB_L1 + 3 * 512 * 1024  , WB_W13 = WB_L2 + 3 * 512 * 1024  ,
                 WB_W2 = WB_W13 + (size_t)32 * 2 * MiB  , WB_END = WB_W2 + (size_t)32 * MiB;
constexpr size_t WS_SLAB = 130 * MiB;
constexpr size_t SLAB = 128 * MiB;
constexpr size_t WS_E = WS_SLAB + 6 * SLAB;
constexpr size_t WS_END = WS_E + 96 * MiB;
static_assert(WS_WB + WB_END <= WS_SLAB, "weights overflow");
static_assert(WS_END <= 1024 * MiB, "workspace overflow");

struct Params {
    const float* in[37];
    float* out;
    unsigned char* ws;
    int ph_lo, ph_hi;
};

__device__ __forceinline__ float bf2f(bf16_t v) { return __uint_as_float(((unsigned)v) << 16); }
__device__ __forceinline__ float bflo(unsigned w) { return __uint_as_float(w << 16); }
__device__ __forceinline__ float bfhi(unsigned w) { return __uint_as_float(w & 0xffff0000u); }
__device__ __forceinline__ unsigned cvt_pk_bf16(float lo, float hi) { unsigned r; asm volatile("v_cvt_pk_bf16_f32 %0, %1, %2" : "=v"(r) : "v"(lo), "v"(hi)); return r; }
__device__ __forceinline__ bf16_t f2bf(float f) { return (bf16_t)(cvt_pk_bf16(f, 0.f) & 0xffffu); }
__device__ __forceinline__ float wave_sum(float v) {
#pragma unroll
    for (int o = 32; o >= 1; o >>= 1) v += __shfl_xor(v, o);
    return v;
}
__device__ __forceinline__ float fsilu(float x) { return x / (1.f + __expf(-x)); }
__device__ __forceinline__ float fsigmoid(float x) { return 1.f / (1.f + __expf(-x)); }
__device__ __forceinline__ float fsoftplus(float x) { return x > 20.f ? x : log1pf(__expf(x)); }
__device__ __forceinline__ float ftanh(float x) { const float xc = fminf(fmaxf(x, -15.f), 15.f); const float e = __expf(2.f * xc); return (e - 1.f) / (e + 1.f); }
__device__ __forceinline__ int ld_vec_i32(const int* p) { int r; asm volatile("global_load_dword %0, %1, off\n\ts_waitcnt vmcnt(0)" : "=&v"(r) : "v"(p) : "memory"); return r; }

#define XB_TMO      128
#define XB_XCNT(j)  (256  + 64 * (j))
#define XB_XSUB(j)  (1280 + 64 * (j))
#define XB_XGEN(j)  (2304 + 64 * (j))
#define XB_TOP      3328
#define XB_TOPGEN   3392
#define XCD_BAR_WORDS 3456
#define XB_SPIN_CAP (1u << 24)
__device__ __forceinline__ unsigned xb_ld(unsigned* p)              { return __hip_atomic_load(p, __ATOMIC_RELAXED, __HIP_MEMORY_SCOPE_AGENT); }
__device__ __forceinline__ unsigned xb_add(unsigned* p, unsigned v) { return __hip_atomic_fetch_add(p, v, __ATOMIC_RELAXED, __HIP_MEMORY_SCOPE_AGENT); }
__device__ __forceinline__ unsigned xb_xcc_id() { return (unsigned)__builtin_amdgcn_s_getreg((3 << 11) | 20) & 0xFu; }
#define XB_SPIN(cond, bar) do { unsigned _sp = 0; while (cond) { __builtin_amdgcn_s_sleep(1); \
    if ((++_sp & 255u) == 0u) { if (xb_ld(&(bar)[XB_TMO])) break; if (_sp > XB_SPIN_CAP) { atomicAdd(&(bar)[XB_TMO], 1u); break; } } } } while (0)
struct XcdBarrier { unsigned* bar; unsigned x; volatile LAS unsigned* st; };
__device__ __forceinline__ XcdBarrier xcd_barrier_post(unsigned* bar, volatile LAS unsigned* st) {
    XcdBarrier b; b.bar = bar; b.x = xb_xcc_id(); b.st = st;
    if (threadIdx.x == 0) (void)xb_add(&bar[XB_XCNT(b.x)], 1u);
    return b;
}
__device__ __forceinline__ void xcd_barrier_complete(unsigned* bar, unsigned x, unsigned& nloc, unsigned& nx) {
    const unsigned G = gridDim.x * gridDim.y * gridDim.z;
    unsigned sum, cnt, mine, sp = 0u;
    for (;;) {
        sum = 0u; cnt = 0u; mine = 0u;
#pragma unroll
        for (unsigned j = 0; j < 16; ++j) { const unsigned c = xb_ld(&bar[XB_XCNT(j)]); sum += c; cnt += (c > 0u) ? 1u : 0u; mine = (j == x) ? c : mine; }
        if (sum == G) break;
        __builtin_amdgcn_s_sleep(1);
        if ((++sp & 255u) == 0u) { if (xb_ld(&bar[XB_TMO])) break; if (sp > XB_SPIN_CAP) { atomicAdd(&bar[XB_TMO], 1u); break; } }
    }
    nloc = mine > 0u ? mine : 1u; nx = cnt > 0u ? cnt : 1u;
}
__device__ __forceinline__ void xcd_barrier(const XcdBarrier& b) {
    asm volatile("s_waitcnt vmcnt(0)" ::: "memory");
    __syncthreads();
    if (threadIdx.x == 0) {
        unsigned* bar = b.bar;
        __builtin_amdgcn_s_waitcnt(0);
        unsigned nloc = b.st[0], nx = b.st[1];
        if (nloc == 0u) { xcd_barrier_complete(bar, b.x, nloc, nx); b.st[0] = nloc; b.st[1] = nx; }
        const unsigned old = xb_add(&bar[XB_XSUB(b.x)], 1u);
        const unsigned gen = old / nloc;
        if (old + 1u == (gen + 1u) * nloc) {
            __builtin_amdgcn_fence(__ATOMIC_RELEASE, "agent");
            asm volatile("s_waitcnt vmcnt(0)" ::: "memory");
            const unsigned og = xb_add(&bar[XB_TOP], 1u);
            const unsigned tg = og / nx;
            if (og + 1u == (tg + 1u) * nx) xb_add(&bar[XB_TOPGEN], 1u);
            else XB_SPIN(xb_ld(&bar[XB_TOPGEN]) == tg, bar);
            __builtin_amdgcn_fence(__ATOMIC_ACQUIRE, "agent");
            xb_add(&bar[XB_XGEN(b.x)], 1u);
            asm volatile("s_waitcnt vmcnt(0)" ::: "memory");
        } else {
            XB_SPIN(xb_ld(&bar[XB_XGEN(b.x)]) == gen, bar);
            __builtin_amdgcn_fence(__ATOMIC_ACQUIRE, "agent");
            asm volatile("s_waitcnt vmcnt(0)" ::: "memory");
        }
    }
    __syncthreads();
}

constexpr int BM = 256, BK = 64, HALF = 128, HTB = HALF * BK * 2, STAGE_BYTES = 8 * HTB;
__device__ __forceinline__ int lds_byte(int r, int c) { const int st = (r >> 4) * 2 + (c >> 5), rr = r & 15, cc = c & 31, ob = rr * 64 + cc * 2; return st * 1024 + (ob ^ (((ob >> 9) & 1) << 5)); }
__device__ __forceinline__ void stage_rc(int b, int& R, int& C) { const int st = b / 1024, sb = b % 1024, swz = sb ^ (((sb >> 9) & 1) << 5); R = (st >> 1) * 16 + swz / 64; C = (st & 1) * 32 + (swz % 64) / 2; }
__device__ __forceinline__ int perm32(int rho) { const int n = rho >> 4, i = rho & 15; return 8 * (i >> 2) + 4 * n + (i & 3); }
struct Unit { int pm, pn, prob; };
__device__ __forceinline__ void tile_order(int L, int nM, int nN, int& pm, int& pn) {
    const int nwg = nM * nN; int wgid = L;
    { const int q = nwg / 8, r = nwg % 8, xcd = wgid % 8, off = wgid / 8; wgid = (xcd < r ? xcd * (q + 1) : r * (q + 1) + (xcd - r) * q) + off; }
    const int nig = 8 * nN, gid = wgid / nig, fm = gid * 8, gsz = (nM - fm) < 8 ? (nM - fm) : 8;
    pm = fm + ((wgid % nig) % gsz); pn = (wgid % nig) / gsz;
}

template <class P>
__device__ __forceinline__ void gemm_phase(LAS unsigned char* lds, const P& S) {
    const int tid = threadIdx.x, wid = __builtin_amdgcn_readfirstlane(tid >> 6), lane = tid & 63, wr = wid >> 2, wc = wid & 3, fr = lane & 15, fq = lane >> 4;
    const int K = S.K, nt = K / BK, lda = S.lda, ldb = S.ldb;
    int RA[2], CA[2]; unsigned voffB[2], vAc[2][2], vAn[2][2];
#pragma unroll
    for (int i = 0; i < 2; ++i) { int R, C; stage_rc(tid * 16 + i * 8192, R, C); RA[i] = R; CA[i] = C; const int Rb = P::PERM ? ((R & ~31) + perm32(R & 31)) : R;
        voffB[i] = (unsigned)(Rb * ldb + C) * 2u;
#pragma unroll
        for (int h = 0; h < 2; ++h) { vAc[h][i] = (unsigned)((h * HALF + R) * lda + C) * 2u; vAn[h][i] = vAc[h][i]; } }
    const size_t kstep = (size_t)(BK * 2);
    const size_t hstepB = (size_t)HALF * ldb * 2;
    const unsigned ldsw = (unsigned)wid * 1024u;
    const int aoff = lds_byte(wr * 64 + fr, fq * 8), boff = lds_byte(wc * 32 + fr, fq * 8);
#define PG8_SA(b, h) (((b) * 2 + (h)) * HTB)
#define PG8_SB(b, h) ((4 + (b) * 2 + (h)) * HTB)
#define PG8_STAGE2(bufoff, gbase, v0, v1) do { \
        __builtin_amdgcn_global_load_lds((const unsigned*)((const char*)(gbase) + (v0)), (LAS unsigned*)(lds + (bufoff) + ldsw), 16, 0, 0); \
        __builtin_amdgcn_global_load_lds((const unsigned*)((const char*)(gbase) + (v1)), (LAS unsigned*)(lds + (bufoff) + ldsw + 8192), 16, 0, 0); } while (0)
#define PG8_LDA(dst, b, h) do { _Pragma("unroll") for (int m = 0; m < 4; ++m) _Pragma("unroll") for (int k = 0; k < 2; ++k) dst[m][k] = *(const LAS bf16x8*)(lds + PG8_SA(b, h) + aoff + m * 2048 + k * 1024); } while (0)
#define PG8_LDB(dst, b, h) do { _Pragma("unroll") for (int n = 0; n < 2; ++n) _Pragma("unroll") for (int k = 0; k < 2; ++k) dst[n][k] = *(const LAS bf16x8*)(lds + PG8_SB(b, h) + boff + n * 2048 + k * 1024); } while (0)
#define PG8_MMA(ai, bj, At, Bt) do { __builtin_amdgcn_s_setprio(1); _Pragma("unroll") for (int m = 0; m < 4; ++m) _Pragma("unroll") for (int n = 0; n < 2; ++n) _Pragma("unroll") for (int k = 0; k < 2; ++k) \
        acc[ai][bj][m][n] = __builtin_amdgcn_mfma_f32_16x16x32_bf16(Bt[n][k], At[m][k], acc[ai][bj][m][n], 0, 0, 0); __builtin_amdgcn_s_setprio(0); } while (0)
#define PG8_WAIT_V(n) asm volatile("s_waitcnt vmcnt(" #n ")" ::: "memory")
#define PG8_WAIT_L(n) asm volatile("s_waitcnt lgkmcnt(" #n ")" ::: "memory")
#define PG8_BAR __builtin_amdgcn_s_barrier()
#define PG8_SCHED __builtin_amdgcn_sched_barrier(0)
    Unit cur, nxt; int ui = 0;
    if (!S.next(0, cur)) return;
    if constexpr (P::GATHER) {
#pragma unroll
        for (int h = 0; h < 2; ++h)
#pragma unroll
            for (int i = 0; i < 2; ++i) vAc[h][i] = S.a_voff(cur, h * HALF + RA[i], CA[i]);
    }
    float zf; asm volatile("v_mov_b32 %0, 0" : "=v"(zf));
    f32x4 acc[2][2][4][2];
#pragma unroll
    for (int a = 0; a < 2; ++a)
#pragma unroll
        for (int b = 0; b < 2; ++b)
#pragma unroll
            for (int m = 0; m < 4; ++m)
#pragma unroll
                for (int n = 0; n < 2; ++n) acc[a][b][m][n] = (f32x4){zf, zf, zf, zf};
    bf16x8 At[4][2], B0[2][2], B1[2][2];
    const char* cA = S.a_ptr(cur);
    {
        const char* b0 = S.b_ptr(cur, 0); const char* b1 = S.b_ptr(cur, 1);
        PG8_STAGE2(PG8_SB(0, 0), b0, voffB[0], voffB[1]); PG8_STAGE2(PG8_SA(0, 0), cA, vAc[0][0], vAc[0][1]); PG8_STAGE2(PG8_SB(0, 1), b0 + hstepB, voffB[0], voffB[1]); PG8_STAGE2(PG8_SA(0, 1), cA, vAc[1][0], vAc[1][1]);
        if (wr == 1) PG8_BAR;
        PG8_WAIT_V(4); PG8_BAR;
        PG8_STAGE2(PG8_SB(1, 0), b1, voffB[0], voffB[1]); PG8_STAGE2(PG8_SA(1, 0), cA + kstep, vAc[0][0], vAc[0][1]); PG8_STAGE2(PG8_SB(1, 1), b1 + hstepB, voffB[0], voffB[1]);
        PG8_WAIT_V(6); PG8_BAR;
    }
    for (;;) {
        const bool has_next = S.next(ui + 1, nxt);
        if (!has_next) nxt = cur;
        if constexpr (P::GATHER) {
            if (has_next) {
#pragma unroll
                for (int h = 0; h < 2; ++h)
#pragma unroll
                    for (int i = 0; i < 2; ++i) vAn[h][i] = S.a_voff(nxt, h * HALF + RA[i], CA[i]);
            }
        }
        const char* nA = S.a_ptr(nxt);
        for (int t = 0; t < nt; t += 2) {
            const bool last = (t == nt - 2);
            const char* a1 = cA + (size_t)(t + 1) * kstep;
            const char* a2 = last ? nA : cA + (size_t)(t + 2) * kstep;
            const char* a3 = a2 + kstep;
            const char* b2 = last ? S.b_ptr(nxt, 0) : S.b_ptr(cur, t + 2);
            const char* b3 = last ? S.b_ptr(nxt, 1) : S.b_ptr(cur, t + 3);
            unsigned s00 = vAc[0][0], s01 = vAc[0][1], s10 = vAc[1][0], s11 = vAc[1][1];
            if constexpr (P::GATHER) { if (last) { s00 = vAn[0][0]; s01 = vAn[0][1]; s10 = vAn[1][0]; s11 = vAn[1][1]; } }
            PG8_LDB(B0, 0, 0); PG8_SCHED; PG8_LDA(At, 0, 0); PG8_STAGE2(PG8_SA(1, 1), a1, vAc[1][0], vAc[1][1]);
            PG8_WAIT_L(8); PG8_BAR; PG8_WAIT_L(0); PG8_MMA(0, 0, At, B0); PG8_BAR; PG8_SCHED;
            PG8_LDB(B1, 0, 1); PG8_STAGE2(PG8_SB(0, 0), b2, voffB[0], voffB[1]);
            PG8_BAR; PG8_WAIT_L(0); PG8_MMA(0, 1, At, B1); PG8_BAR;
            PG8_LDA(At, 0, 1); PG8_STAGE2(PG8_SA(0, 0), a2, s00, s01);
            PG8_BAR; PG8_WAIT_L(0); PG8_MMA(1, 0, At, B0); PG8_BAR; PG8_SCHED;
            PG8_STAGE2(PG8_SB(0, 1), b2 + hstepB, voffB[0], voffB[1]);
            PG8_WAIT_V(6); PG8_BAR; PG8_MMA(1, 1, At, B1); PG8_BAR;
            PG8_LDB(B0, 1, 0); PG8_SCHED; PG8_LDA(At, 1, 0); PG8_STAGE2(PG8_SA(0, 1), a2, s10, s11);
            PG8_WAIT_L(8); PG8_BAR; PG8_WAIT_L(0); PG8_MMA(0, 0, At, B0); PG8_BAR; PG8_SCHED;
            PG8_LDB(B1, 1, 1); PG8_STAGE2(PG8_SB(1, 0), b3, voffB[0], voffB[1]);
            PG8_BAR; PG8_WAIT_L(0); PG8_MMA(0, 1, At, B1); PG8_BAR;
            PG8_LDA(At, 1, 1); PG8_STAGE2(PG8_SA(1, 0), a3, s00, s01);
            PG8_BAR; PG8_WAIT_L(0); PG8_MMA(1, 0, At, B0); PG8_BAR; PG8_SCHED;
            PG8_STAGE2(PG8_SB(1, 1), b3 + hstepB, voffB[0], voffB[1]);
            PG8_WAIT_V(6); PG8_BAR; PG8_MMA(1, 1, At, B1); PG8_BAR;
        }
        S.epi(acc, cur, wr, wc, fr, fq);
        if (!has_next) break;
#pragma unroll
        for (int a = 0; a < 2; ++a)
#pragma unroll
            for (int b = 0; b < 2; ++b)
#pragma unroll
                for (int m = 0; m < 4; ++m)
#pragma unroll
                    for (int n = 0; n < 2; ++n) acc[a][b][m][n] = (f32x4){zf, zf, zf, zf};
        cur = nxt; cA = nA; ++ui;
        if constexpr (P::GATHER) {
#pragma unroll
            for (int h = 0; h < 2; ++h)
#pragma unroll
                for (int i = 0; i < 2; ++i) vAc[h][i] = vAn[h][i];
        }
    }
    PG8_WAIT_V(0);
    if (wr == 0) PG8_BAR;
    PG8_BAR;
#undef PG8_SA
#undef PG8_SB
#undef PG8_STAGE2
#undef PG8_LDA
#undef PG8_LDB
#undef PG8_MMA
#undef PG8_WAIT_V
#undef PG8_WAIT_L
#undef PG8_BAR
#undef PG8_SCHED
}

enum { EK_BF16 = 0, EK_LORA1 = 1, EK_LORA2 = 2, EK_F32RES = 3 };
template <int KIND>
struct DenseP {
    static constexpr bool PERM = (KIND != EK_F32RES), GATHER = false;
    int K, lda, ldb, nM, nN, nprob, G, c;
    const bf16_t* A; size_t a_stride;
    const bf16_t* B; size_t b_stride;
    bf16_t* O; size_t o_stride; int ldc;
    bf16_t* Oalt1; bf16_t* Oalt2;
    const float* res; float* Of;
    const float* v0; const float* v1;
    __device__ __forceinline__ bool next(int i, Unit& u) const {
        const long L = (long)i * G + c; const int per = nM * nN; if (L >= (long)per * nprob) return false;
        u.prob = (int)(L / per); tile_order((int)(L % per), nM, nN, u.pm, u.pn); return true;
    }
    __device__ __forceinline__ const char* a_ptr(const Unit& u) const { return (const char*)(A + (size_t)u.prob * a_stride + (size_t)u.pm * BM * lda); }
    __device__ __forceinline__ const char* b_ptr(const Unit& u, int kt) const { return (const char*)(B + (size_t)u.prob * b_stride + (size_t)u.pn * BM * ldb) + (size_t)kt * (BK * 2); }
    __device__ __forceinline__ unsigned a_voff(const Unit&, int, int) const { return 0u; }
    __device__ __forceinline__ void epi(const f32x4 (&acc)[2][2][4][2], const Unit& u, int wr, int wc, int fr, int fq) const {
        const int row0 = u.pm * BM + wr * 64 + fr;
        if constexpr (KIND == EK_F32RES) {
            const int col0 = u.pn * BM + wc * 32 + 4 * fq;
#pragma unroll
            for (int ai = 0; ai < 2; ++ai)
#pragma unroll
                for (int m = 0; m < 4; ++m) { const size_t ro = (size_t)(row0 + ai * HALF + m * 16) * ldc + col0;
#pragma unroll
                    for (int bj = 0; bj < 2; ++bj)
#pragma unroll
                        for (int n = 0; n < 2; ++n) { const f32x4 r = *(const f32x4*)(res + ro + bj * HALF + n * 16); *(f32x4*)(Of + ro + bj * HALF + n * 16) = acc[ai][bj][m][n] + r; } }
        } else {
            const int col0 = u.pn * BM + wc * 32 + 8 * fq;
            bf16_t* base = Oalt1 ? ((u.prob == 0) ? O : (u.prob == 1) ? Oalt1 : Oalt2) : O + (size_t)u.prob * o_stride;
            f32x4 bv[2][2];
#pragma unroll
            for (int bj = 0; bj < 2; ++bj)
#pragma unroll
                for (int n = 0; n < 2; ++n) {
                    if constexpr (KIND == EK_LORA2) { bv[bj][n] = (u.prob == 0) ? *(const f32x4*)(v0 + col0 + bj * HALF + 4 * n) : (u.prob == 1) ? *(const f32x4*)(v1 + col0 + bj * HALF + 4 * n) : (f32x4){0.f, 0.f, 0.f, 0.f}; }
                    else bv[bj][n] = (f32x4){0.f, 0.f, 0.f, 0.f};
                }
#pragma unroll
            for (int ai = 0; ai < 2; ++ai)
#pragma unroll
                for (int m = 0; m < 4; ++m) { bf16_t* rowp = base + (size_t)(row0 + ai * HALF + m * 16) * ldc + col0;
#pragma unroll
                    for (int bj = 0; bj < 2; ++bj) { f32x4 x0 = acc[ai][bj][m][0] + bv[bj][0], x1 = acc[ai][bj][m][1] + bv[bj][1];
                        if constexpr (KIND == EK_LORA1) {
                            const float kx = (u.prob == 0) ? 2.f : 1.f;
#pragma unroll
                            for (int j = 0; j < 4; ++j) { const float s0 = fsigmoid(kx * x0[j]), s1 = fsigmoid(kx * x1[j]);
                                x0[j] = (u.prob == 0) ? 2.f * s0 - 1.f : (u.prob == 2) ? s0 : x0[j]; x1[j] = (u.prob == 0) ? 2.f * s1 - 1.f : (u.prob == 2) ? s1 : x1[j]; } }
                        if constexpr (KIND == EK_LORA2) {
                            const float sc = (u.prob == 0) ? 0.6065306597126334f : 1.f;
#pragma unroll
                            for (int j = 0; j < 4; ++j) { const float s0 = sc * fsigmoid(x0[j]), s1 = sc * fsigmoid(x1[j]); x0[j] = (u.prob == 2) ? x0[j] : s0; x1[j] = (u.prob == 2) ? x1[j] : s1; } }
                        u32x4 w; w.x = cvt_pk_bf16(x0[0], x0[1]); w.y = cvt_pk_bf16(x0[2], x0[3]); w.z = cvt_pk_bf16(x1[0], x1[1]); w.w = cvt_pk_bf16(x1[2], x1[3]);
                        *(u32x4*)(rowp + bj * HALF) = w; } }
        }
    }
};

__device__ __forceinline__ void pair_lohi(int pr, int& lo, int& hi) { lo = (pr < 3) ? 0 : (pr < 5 ? 1 : 2); hi = (pr < 3) ? pr + 1 : (pr < 5 ? pr - 1 : 3); }

struct Moe1P {
    static constexpr bool PERM = true, GATHER = true;
    int K, lda, ldb, G, c, ntiles;
    const bf16_t* A; const bf16_t* W13;
    bf16_t* H; const int* slot_tok; const float* slot_c; const int* tile_bkt;
    __device__ __forceinline__ bool next(int i, Unit& u) const {
        const long L = (long)i * G + c; if (L >= (long)ntiles * 8) return false;
        u.pm = (int)(L >> 3); u.pn = (int)(L & 7); u.prob = __builtin_amdgcn_readfirstlane(ld_vec_i32(tile_bkt + u.pm)); return true;
    }
    __device__ __forceinline__ const char* a_ptr(const Unit&) const { return (const char*)A; }
    __device__ __forceinline__ unsigned a_voff(const Unit& u, int row, int C) const { int tok = ld_vec_i32(slot_tok + u.pm * BM + row); tok = tok < 0 ? 0 : tok; return (unsigned)(tok * lda + C) * 2u; }
    __device__ __forceinline__ const char* b_ptr(const Unit& u, int kt) const {
        int lo, hi; pair_lohi(u.prob % 6, lo, hi); const int e = (u.prob / 6) * 4 + ((u.pn < 4) ? lo : hi);
        return (const char*)(W13 + ((size_t)e * 1024 + (size_t)(u.pn & 3) * BM) * 1024) + (size_t)kt * (BK * 2);
    }
    __device__ __forceinline__ void epi(const f32x4 (&acc)[2][2][4][2], const Unit& u, int wr, int wc, int fr, int fq) const {
        const int row0 = u.pm * BM + wr * 64 + fr, col0 = ((u.pn < 4) ? 0 : 512) + (u.pn & 3) * 128 + wc * 32 + 8 * fq, ci = (u.pn < 4) ? 0 : 1;
#pragma unroll
        for (int ai = 0; ai < 2; ++ai)
#pragma unroll
            for (int m = 0; m < 4; ++m) { const int row = row0 + ai * HALF + m * 16; const float cw = slot_c[(size_t)row * 2 + ci];
                const f32x4 g0 = acc[ai][0][m][0], g1 = acc[ai][0][m][1], u0 = acc[ai][1][m][0], u1 = acc[ai][1][m][1]; f32x4 x0, x1;
#pragma unroll
                for (int j = 0; j < 4; ++j) { x0[j] = fsilu(g0[j]) * u0[j] * cw; x1[j] = fsilu(g1[j]) * u1[j] * cw; }
                u32x4 w; w.x = cvt_pk_bf16(x0[0], x0[1]); w.y = cvt_pk_bf16(x0[2], x0[3]); w.z = cvt_pk_bf16(x1[0], x1[1]); w.w = cvt_pk_bf16(x1[2], x1[3]);
                *(u32x4*)(H + (size_t)row * 1024 + col0) = w; }
    }
};
struct Moe2P {
    static constexpr bool PERM = false, GATHER = false;
    int K, lda, ldb, G, c, ntiles;
    const bf16_t* H; const bf16_t* W2;
    float* hres; const int* slot_tok; const int* tile_bkt;
    __device__ __forceinline__ bool next(int i, Unit& u) const {
        const long L = (long)i * G + c; if (L >= (long)ntiles * 4) return false;
        u.pm = (int)(L >> 2); u.pn = (int)(L & 3); u.prob = __builtin_amdgcn_readfirstlane(ld_vec_i32(tile_bkt + u.pm)); return true;
    }
    __device__ __forceinline__ const char* a_ptr(const Unit& u) const { return (const char*)(H + (size_t)u.pm * BM * 1024); }
    __device__ __forceinline__ unsigned a_voff(const Unit&, int, int) const { return 0u; }
    __device__ __forceinline__ const char* b_ptr(const Unit& u, int kt) const {
        int lo, hi; pair_lohi(u.prob % 6, lo, hi); const int e = (u.prob / 6) * 4 + ((kt < 8) ? lo : hi);
        return (const char*)(W2 + ((size_t)e * 1024 + (size_t)u.pn * BM) * 512) + (size_t)(kt & 7) * (BK * 2);
    }
    __device__ __forceinline__ void epi(const f32x4 (&acc)[2][2][4][2], const Unit& u, int wr, int wc, int fr, int fq) const {
        const int row0 = u.pm * BM + wr * 64 + fr, col0 = u.pn * BM + wc * 32 + 4 * fq;
#pragma unroll
        for (int ai = 0; ai < 2; ++ai)
#pragma unroll
            for (int m = 0; m < 4; ++m) { const int tok = ld_vec_i32(slot_tok + row0 + ai * HALF + m * 16);
                if (tok >= 0) { float* rp = hres + (size_t)tok * 1024 + col0;
#pragma unroll
                    for (int bj = 0; bj < 2; ++bj)
#pragma unroll
                        for (int n = 0; n < 2; ++n) { const f32x4 r = *(const f32x4*)(rp + bj * HALF + n * 16); *(f32x4*)(rp + bj * HALF + n * 16) = acc[ai][bj][m][n] + r; } } }
    }
};

struct Frame {
    LAS unsigned char* lds;
    int tid, lane, wave, G, bid;
    float* out; unsigned char* ws;
};
#define WSP(T, off) ((T*)(F.ws + (off)))

__device__ __forceinline__ void prep_tile(const Frame& F, const float* src, int src_ld, int k0, int kvalid, int c0, int nvalid, bf16_t* dst, int dst_ld) {
    LAS float* tl = (LAS float*)F.lds;
    __syncthreads();
#pragma unroll
    for (int p = 0; p < 2; ++p) { const int kk = (F.tid >> 4) + 32 * p, n4 = (F.tid & 15) * 4;
        f32x4 v = (f32x4){0.f, 0.f, 0.f, 0.f};
        if (kk < kvalid && n4 < nvalid) v = *(const f32x4*)(src + (size_t)(k0 + kk) * src_ld + c0 + n4);
        tl[kk * 65 + n4 + 0] = v[0]; tl[kk * 65 + n4 + 1] = v[1]; tl[kk * 65 + n4 + 2] = v[2]; tl[kk * 65 + n4 + 3] = v[3]; }
    __syncthreads();
    { const int n = F.tid >> 3, kc = (F.tid & 7) * 8; float x[8];
#pragma unroll
        for (int j = 0; j < 8; ++j) x[j] = tl[(kc + j) * 65 + n];
        u32x4 w; w.x = cvt_pk_bf16(x[0], x[1]); w.y = cvt_pk_bf16(x[2], x[3]); w.z = cvt_pk_bf16(x[4], x[5]); w.w = cvt_pk_bf16(x[6], x[7]);
        *(u32x4*)(dst + (size_t)n * dst_ld + k0 + kc) = w; }
}
__device__ __forceinline__ void phase_prep(const Params& p, const Frame& F) {
    bf16_t* wb = WSP(bf16_t, WS_WB);
    constexpr int N0 = 1472, N1 = N0 + 512, N2 = N1 + 1024, N3 = N2 + 192, N4 = N3 + 192, N5 = N4 + 8192, N6 = N5 + 4096;
    for (int id = F.bid; id < N6; id += F.G) {
        if (id < N0) { const int nt = id / 16, kt = id % 16, n0 = nt * 64; int c0, nv;
            if (n0 < PC_Q) { c0 = n0; nv = 64; } else if (n0 < PC_DT) { c0 = n0 + 16; nv = 64; } else if (n0 == PC_DT) { c0 = 2560; nv = 16; } else { c0 = 0; nv = 0; }
            prep_tile(F, p.in[4], 5648, kt * 64, 64, c0, nv, wb + WB_WIN / 2 + (size_t)n0 * 1024, 1024); }
        else if (id < N1) { const int j = id - N0, nt = j / 32, kt = j % 32; prep_tile(F, p.in[11], 1024, kt * 64, 64, nt * 64, 64, wb + WB_WOUT / 2 + (size_t)nt * 64 * 2048, 2048); }
        else if (id < N2) { const int j = id - N1, w = j / 256, r = j % 256, nt = r / 16, kt = r % 16; prep_tile(F, (w == 0) ? p.in[13] : (w == 1) ? p.in[14] : (w == 2) ? p.in[15] : p.in[16], 1024, kt * 64, 64, nt * 64, 64, wb + WB_WR / 2 + (size_t)w * 1048576 + (size_t)nt * 64 * 1024, 1024); }
        else if (id < N3) { const int j = id - N2, w = j / 64, r = j % 64, nt = r / 16, kt = r % 16; const int ncols = (w == 2) ? 160 : 64; int nv = ncols - nt * 64; nv = nv < 0 ? 0 : (nv > 64 ? 64 : nv);
            const float* src = (w == 0) ? p.in[18] : (w == 1) ? p.in[21] : p.in[23];
            prep_tile(F, src, ncols, kt * 64, 64, nt * 64, nv, wb + WB_L1 / 2 + (size_t)w * 262144 + (size_t)nt * 64 * 1024, 1024); }
        else if (id < N4) { const int j = id - N3, w = j / 64, r = j % 64, nt = r / 4, kt = r % 4; const int krows = (w == 2) ? 160 : 64; int kv = krows - kt * 64; kv = kv < 0 ? 0 : (kv > 64 ? 64 : kv);
            const float* src = (w == 0) ? p.in[19] : (w == 1) ? p.in[22] : p.in[24];
            prep_tile(F, src, 1024, kt * 64, kv, nt * 64, 64, wb + WB_L2 / 2 + (size_t)w * 262144 + (size_t)nt * 64 * 256, 256); }
        else if (id < N5) { const int j = id - N4, le = j / 256, r = j % 256, nt = r / 16, kt = r % 16;
            const int pn = nt >> 2, part = (nt >> 1) & 1, c0 = 128 * pn + 64 * (nt & 1);
            const float* src = (part ? p.in[35] : p.in[34]) + (size_t)le * 524288;
            prep_tile(F, src, 512, kt * 64, 64, c0, 64, wb + WB_W13 / 2 + (size_t)le * 1048576 + (size_t)nt * 64 * 1024, 1024); }
        else { const int j = id - N5, le = j / 128, r = j % 128, nt = r / 8, kt = r % 8;
            prep_tile(F, p.in[36] + (size_t)le * 524288, 1024, kt * 64, 64, nt * 64, 64, wb + WB_W2 / 2 + (size_t)le * 524288 + (size_t)nt * 64 * 512, 512); }
    }
    f32x2* rope = WSP(f32x2, WS_ROPE);
    for (int idx = F.bid * NTHREADS + F.tid; idx < SEQ * 64; idx += F.G * NTHREADS) {
        const int pos = idx >> 6, i = idx & 63;
        const float invf = exp2f(-(float)i * (13.287712379549449f / 64.f));
        const float ang = (float)pos * invf;
        const double x = (double)ang;
        const double kq = rint(x * 0.63661977236758134308);
        double r = fma(-kq, 1.57079632679489655800e+00, x); r = fma(-kq, 6.12323399573676603587e-17, r);
        const double r2 = r * r;
        double sp = -7.6471637318198164759e-13; sp = fma(sp, r2, 1.6059043836821614599e-10); sp = fma(sp, r2, -2.5052108385441718775e-08); sp = fma(sp, r2, 2.7557319223985890653e-06);
        sp = fma(sp, r2, -1.9841269841269841270e-04); sp = fma(sp, r2, 8.3333333333333333333e-03); sp = fma(sp, r2, -1.6666666666666666667e-01); const double sn = fma(sp * r2, r, r);
        double cp = 4.7794773323873852974e-14; cp = fma(cp, r2, -1.1470745597729724714e-11); cp = fma(cp, r2, 2.0876756987868098979e-09); cp = fma(cp, r2, -2.7557319223985890653e-07);
        cp = fma(cp, r2, 2.4801587301587301587e-05); cp = fma(cp, r2, -1.3888888888888888889e-03); cp = fma(cp, r2, 4.1666666666666666667e-02); cp = fma(cp, r2, -0.5); const double cs = fma(cp, r2, 1.0);
        const int q = ((int)kq) & 3;
        const double c = (q == 0) ? cs : (q == 1) ? -sn : (q == 2) ? -cs : sn;
        const double s = (q == 0) ? sn : (q == 1) ? cs : (q == 2) ? -sn : -cs;
        rope[idx] = (f32x2){(float)c, (float)s};
    }
}

__device__ __forceinline__ void row_load(const float* row, int lane, f32x4 (&v)[4]) {
#pragma unroll
    for (int j = 0; j < 4; ++j) v[j] = *(const f32x4*)(row + j * 256 + lane * 4);
}
__device__ __forceinline__ float row_rstd(const f32x4 (&v)[4], float eps) {
    float ss = 0.f;
#pragma unroll
    for (int j = 0; j < 4; ++j) ss += v[j][0] * v[j][0] + v[j][1] * v[j][1] + v[j][2] * v[j][2] + v[j][3] * v[j][3];
    ss = wave_sum(ss);
    return rsqrtf(ss * (1.f / 1024.f) + eps);
}
__device__ __forceinline__ void row_store_bf16(bf16_t* row, int lane, const f32x4 (&v)[4]) {
#pragma unroll
    for (int j = 0; j < 4; ++j) { u32x2 w; w.x = cvt_pk_bf16(v[j][0], v[j][1]); w.y = cvt_pk_bf16(v[j][2], v[j][3]); *(u32x2*)(row + j * 256 + lane * 4) = w; }
}

template <bool TO_BF16>
__device__ __forceinline__ void phase_rmsnorm(const Params& p, const Frame& F, const float* src, const float* w, void* dst) {
    f32x4 wv[4]; row_load(w, F.lane, wv);
    for (int row = F.bid * 8 + F.wave; row < T_TOK; row += F.G * 8) {
        f32x4 v[4]; row_load(src + (size_t)row * DM, F.lane, v);
        const float rs = row_rstd(v, 1e-6f);
#pragma unroll
        for (int j = 0; j < 4; ++j) v[j] = v[j] * rs * wv[j];
        if constexpr (TO_BF16) row_store_bf16((bf16_t*)dst + (size_t)row * DM, F.lane, v);
        else {
#pragma unroll
            for (int j = 0; j < 4; ++j) *(f32x4*)((float*)dst + (size_t)row * DM + j * 256 + F.lane * 4) = v[j];
        }
    }
}

__device__ __forceinline__ void phase_scan0(const Params& p, const Frame& F) {
    const bf16_t* proj = WSP(bf16_t, WS_SLAB);
    bf16_t* ybuf = (bf16_t*)F.out;
    const f32x2* rope = WSP(f32x2, WS_ROPE);
    LAS float* qs = (LAS float*)F.lds;
    LAS float* ks = qs + 8192;
    LAS float* vs = ks + 8192;
    LAS float* xr = vs + 4096;
    LAS float* zs = xr + 4096;
    LAS float* ys = zs + 4096;
    LAS float* ds = ys + 4096;
    const float* conv_w = p.in[5]; const float* conv_b = p.in[6];
    const int prow = F.tid >> 3, nq = F.tid & 7;
    for (int unit = F.bid; unit < 512; unit += F.G) {
        const bool is_ssd = unit < 256;
        const int b = is_ssd ? unit >> 4 : (unit - 256) >> 4;
        const int hh = unit & 15;
        const int grp = hh >> 3, hr = hh >> 2, sl = hh & 3;
        const float A_h = is_ssd ? -__expf(p.in[8][hh]) : 0.f, dtb = is_ssd ? p.in[7][hh] : 0.f, D_h = is_ssd ? p.in[9][hh] : 0.f;
        const float gam = 1.f - exp2f(-5.f - (float)hr);
        float s[16];
#pragma unroll
        for (int j = 0; j < 16; ++j) s[j] = 0.f;
        for (int t0 = 0; t0 < SEQ; t0 += 64) {
            __syncthreads();
            const size_t rbase = (size_t)b * SEQ + t0;
            if (is_ssd) {
                for (int idx = F.tid; idx < 64 * 256; idx += NTHREADS) { const int t = idx >> 8, n = idx & 255;
                    const int cc = 1024 + grp * 128 + (n & 127) + ((n >> 7) ? 256 : 0);
                    float a = conv_b[cc];
#pragma unroll
                    for (int j = 0; j < 4; ++j) { const int tt = t0 + t - 3 + j; if (tt >= 0) a += conv_w[j * 1536 + cc] * bf2f(proj[((size_t)b * SEQ + tt) * NPROJ + PC_XBC + cc]); }
                    a = fsilu(a);
                    if (n < 128) ks[t * 128 + n] = a; else qs[t * 128 + (n - 128)] = a; }
                for (int idx = F.tid; idx < 64 * 64; idx += NTHREADS) { const int t = idx >> 6, pp = idx & 63; const int cc = hh * 64 + pp;
                    float a = conv_b[cc];
#pragma unroll
                    for (int j = 0; j < 4; ++j) { const int tt = t0 + t - 3 + j; if (tt >= 0) a += conv_w[j * 1536 + cc] * bf2f(proj[((size_t)b * SEQ + tt) * NPROJ + PC_XBC + cc]); }
                    a = fsilu(a);
                    const float dtv = fsoftplus(bf2f(proj[(rbase + t) * NPROJ + PC_DT + hh]) + dtb);
                    xr[idx] = a; vs[idx] = a * dtv; zs[idx] = bf2f(proj[(rbase + t) * NPROJ + PC_Z + cc]);
                    if (pp == 0) ds[t] = __expf(dtv * A_h); }
            } else {
                for (int idx = F.tid; idx < 64 * 64; idx += NTHREADS) { const int t = idx >> 6, i = idx & 63;
                    const f32x2 cs = rope[(t0 + t) * 64 + i]; const size_t ro = (rbase + t) * NPROJ;
                    const float q1 = bf2f(proj[ro + PC_Q + hr * 128 + i]), q2 = bf2f(proj[ro + PC_Q + hr * 128 + 64 + i]);
                    const float k1 = bf2f(proj[ro + PC_K + hr * 128 + i]), k2 = bf2f(proj[ro + PC_K + hr * 128 + 64 + i]);
                    qs[t * 128 + i] = q1 * cs.x - q2 * cs.y; qs[t * 128 + 64 + i] = q1 * cs.y + q2 * cs.x;
                    ks[t * 128 + i] = (k1 * cs.x - k2 * cs.y) * 0.08838834764831845f; ks[t * 128 + 64 + i] = (k1 * cs.y + k2 * cs.x) * 0.08838834764831845f;
                    vs[idx] = bf2f(proj[ro + PC_V + hr * 256 + sl * 64 + i]);
                    if (i == 0) ds[t] = gam; }
            }
            __syncthreads();
            for (int t = 0; t < 64; ++t) {
                const float d = ds[t], v = vs[t * 64 + prow]; float a = 0.f;
                const LAS f32x4* kq = (const LAS f32x4*)(ks + t * 128 + nq * 16); const LAS f32x4* qq = (const LAS f32x4*)(qs + t * 128 + nq * 16);
#pragma unroll
                for (int j4 = 0; j4 < 4; ++j4) { const f32x4 kv = kq[j4], qv = qq[j4];
#pragma unroll
                    for (int j = 0; j < 4; ++j) { s[j4 * 4 + j] = s[j4 * 4 + j] * d + v * kv[j]; a += s[j4 * 4 + j] * qv[j]; } }
                a += __shfl_xor(a, 1); a += __shfl_xor(a, 2); a += __shfl_xor(a, 4);
                if (nq == 0) ys[t * 64 + prow] = a;
            }
            __syncthreads();
            for (int idx = F.tid; idx < 64 * 64; idx += NTHREADS) { const int t = idx >> 6, pp = idx & 63; float y = ys[idx];
                if (is_ssd) { y = (y + xr[idx] * D_h) * fsilu(zs[idx]); ybuf[(rbase + t) * 2048 + hh * 64 + pp] = f2bf(y); }
                else ybuf[(rbase + t) * 2048 + 1024 + hr * 256 + sl * 64 + pp] = f2bf(y); }
        }
    }
}

__device__ __forceinline__ void phase_gatenorm(const Params& p, const Frame& F) {
    const bf16_t* proj = WSP(bf16_t, WS_SLAB);
    bf16_t* ybuf = (bf16_t*)F.out;
    const float* nw = p.in[10];
    for (int row = F.bid * 8 + F.wave; row < T_TOK; row += F.G * 8) {
        bf16_t* yr = ybuf + (size_t)row * 2048;
#pragma unroll
        for (int j = 0; j < 4; ++j) {
            const u32x4 w = *(const u32x4*)(yr + j * 512 + F.lane * 8);
            float x[8] = {bflo(w.x), bfhi(w.x), bflo(w.y), bfhi(w.y), bflo(w.z), bfhi(w.z), bflo(w.w), bfhi(w.w)};
            float ss = 0.f;
#pragma unroll
            for (int e = 0; e < 8; ++e) ss += x[e] * x[e];
            if (j < 2) { ss = wave_sum(ss); const float rs = rsqrtf(ss * (1.f / 512.f) + 1e-5f);
                const f32x4 w0 = *(const f32x4*)(nw + j * 512 + F.lane * 8), w1 = *(const f32x4*)(nw + j * 512 + F.lane * 8 + 4);
#pragma unroll
                for (int e = 0; e < 4; ++e) { x[e] *= rs * w0[e]; x[4 + e] *= rs * w1[e]; } }
            else {
#pragma unroll
                for (int o = 16; o >= 1; o >>= 1) ss += __shfl_xor(ss, o);
                const float rs = rsqrtf(ss * (1.f / 256.f) + 1e-6f);
                const u32x4 gw = *(const u32x4*)(proj + (size_t)row * NPROJ + PC_G + (j - 2) * 512 + F.lane * 8);
                const float g[8] = {bflo(gw.x), bfhi(gw.x), bflo(gw.y), bfhi(gw.y), bflo(gw.z), bfhi(gw.z), bflo(gw.w), bfhi(gw.w)};
#pragma unroll
                for (int e = 0; e < 8; ++e) x[e] *= rs * fsilu(g[e]); }
            u32x4 o; o.x = cvt_pk_bf16(x[0], x[1]); o.y = cvt_pk_bf16(x[2], x[3]); o.z = cvt_pk_bf16(x[4], x[5]); o.w = cvt_pk_bf16(x[6], x[7]);
            *(u32x4*)(yr + j * 512 + F.lane * 8) = o;
        }
    }
}

__device__ __forceinline__ void phase_moe_route(const Params& p, const Frame& F, int layer, const float* h, bf16_t* tbuf) {
    unsigned char* meta = F.ws + WS_META + (size_t)layer * META_STRIDE;
    int* tok_rank = (int*)(meta + MT_RANK); int* tok_bkt = (int*)(meta + MT_BKT); f32x2* tok_c = (f32x2*)(meta + MT_C);
    int* gcount = (int*)(F.ws + WS_CTL + CTL_CNT_OFF) + layer * 32;
    const float* wg = p.in[30] + (size_t)layer * 4096; const float* bg = p.in[31] + layer * 4;
    const float* we = p.in[32] + (size_t)layer * 16384; const float* be = p.in[33] + layer * 16;
    LAS float* wl = (LAS float*)F.lds;
    LAS int* lcount = (LAS int*)(F.lds + 81920);
    LAS int* lbase = lcount + 32;
    LAS int* l_bkt = lbase + 32;
    LAS int* l_rank = l_bkt + 1024;
    LAS float* l_c = (LAS float*)(l_rank + 1024);
    __syncthreads();
    for (int idx = F.tid; idx < 20 * 1024; idx += NTHREADS) { const int j = idx >> 10, k = idx & 1023; wl[idx] = (j < 4) ? wg[k * 4 + j] : we[k * 16 + (j - 4)]; }
    if (F.tid < 32) lcount[F.tid] = 0;
    __syncthreads();
    const int TPB = (T_TOK + F.G - 1) / F.G, tok0 = F.bid * TPB;
    f32x4 wv[4]; row_load(p.in[2] + (size_t)layer * DM, F.lane, wv);
    for (int li = F.wave; li < TPB; li += 8) {
        const int tok = tok0 + li; if (tok >= T_TOK) break;
        f32x4 v[4]; row_load(h + (size_t)tok * DM, F.lane, v);
        const float rs = row_rstd(v, 1e-6f);
#pragma unroll
        for (int j = 0; j < 4; ++j) v[j] = v[j] * rs * wv[j];
        row_store_bf16(tbuf + (size_t)tok * DM, F.lane, v);
        float lg[20];
#pragma unroll
        for (int o = 0; o < 20; ++o) { float a = 0.f;
#pragma unroll
            for (int j = 0; j < 4; ++j) { const f32x4 w4 = *(const LAS f32x4*)(wl + o * 1024 + j * 256 + F.lane * 4); a += v[j][0] * w4[0] + v[j][1] * w4[1] + v[j][2] * w4[2] + v[j][3] * w4[3]; }
            lg[o] = wave_sum(a); }
        if (F.lane == 0) {
            float g0 = lg[0] + bg[0], g1 = lg[1] + bg[1], g2 = lg[2] + bg[2], g3 = lg[3] + bg[3];
            int gi = 0; float gm = g0; if (g1 > gm) { gm = g1; gi = 1; } if (g2 > gm) { gm = g2; gi = 2; } if (g3 > gm) { gm = g3; gi = 3; }
            const float gate = 1.f / (__expf(g0 - gm) + __expf(g1 - gm) + __expf(g2 - gm) + __expf(g3 - gm));
            float e0, e1, e2, e3;
            e0 = (gi == 0) ? lg[4] : (gi == 1) ? lg[8] : (gi == 2) ? lg[12] : lg[16];
            e1 = (gi == 0) ? lg[5] : (gi == 1) ? lg[9] : (gi == 2) ? lg[13] : lg[17];
            e2 = (gi == 0) ? lg[6] : (gi == 1) ? lg[10] : (gi == 2) ? lg[14] : lg[18];
            e3 = (gi == 0) ? lg[7] : (gi == 1) ? lg[11] : (gi == 2) ? lg[15] : lg[19];
            e0 += be[gi * 4 + 0]; e1 += be[gi * 4 + 1]; e2 += be[gi * 4 + 2]; e3 += be[gi * 4 + 3];
            int i1 = 0; float v1 = e0; if (e1 > v1) { v1 = e1; i1 = 1; } if (e2 > v1) { v1 = e2; i1 = 2; } if (e3 > v1) { v1 = e3; i1 = 3; }
            int i2 = -1; float v2 = -3.0e38f;
            if (i1 != 0 && e0 > v2) { v2 = e0; i2 = 0; } if (i1 != 1 && e1 > v2) { v2 = e1; i2 = 1; } if (i1 != 2 && e2 > v2) { v2 = e2; i2 = 2; } if (i1 != 3 && e3 > v2) { v2 = e3; i2 = 3; }
            const float w1 = gate / (1.f + __expf(v2 - v1)), w2 = gate - w1;
            const int lo = i1 < i2 ? i1 : i2, hi = i1 < i2 ? i2 : i1; const float clo = i1 < i2 ? w1 : w2, chi = i1 < i2 ? w2 : w1;
            const int pr = (lo == 0) ? hi - 1 : (lo == 1) ? hi + 1 : 5;
            const int bk = gi * 6 + pr;
            l_bkt[li] = bk; l_c[li * 2] = clo; l_c[li * 2 + 1] = chi;
            l_rank[li] = __hip_atomic_fetch_add((int*)(lcount + bk), 1, __ATOMIC_RELAXED, __HIP_MEMORY_SCOPE_WORKGROUP);
        }
    }
    __syncthreads();
    if (F.tid < 24) lbase[F.tid] = __hip_atomic_fetch_add(gcount + F.tid, lcount[F.tid], __ATOMIC_RELAXED, __HIP_MEMORY_SCOPE_AGENT);
    __syncthreads();
    for (int li = F.tid; li < TPB; li += NTHREADS) { const int tok = tok0 + li; if (tok < T_TOK) { const int bk = l_bkt[li]; tok_bkt[tok] = bk; tok_rank[tok] = lbase[bk] + l_rank[li]; tok_c[tok] = (f32x2){l_c[li * 2], l_c[li * 2 + 1]}; } }
}
__device__ __forceinline__ void phase_moe_slots(const Params& p, const Frame& F, int layer) {
    unsigned char* meta = F.ws + WS_META + (size_t)layer * META_STRIDE;
    const int* tok_rank = (const int*)(meta + MT_RANK); const int* tok_bkt = (const int*)(meta + MT_BKT); const f32x2* tok_c = (const f32x2*)(meta + MT_C);
    int* slot_tok = (int*)(meta + MT_STOK); f32x2* slot_c = (f32x2*)(meta + MT_SC); int* tile_tab = (int*)(meta + MT_TILE);
    int* gcount = (int*)(F.ws + WS_CTL + CTL_CNT_OFF) + layer * 32;
    LAS int* cnt = (LAS int*)F.lds; LAS int* start = cnt + 32;
    __syncthreads();
    if (F.tid < 24) cnt[F.tid] = __hip_atomic_load(gcount + F.tid, __ATOMIC_RELAXED, __HIP_MEMORY_SCOPE_AGENT);
    __syncthreads();
    if (F.tid == 0) { int a = 0; for (int b = 0; b < 24; ++b) { start[b] = a; a += (cnt[b] + 255) >> 8; } start[24] = a; }
    __syncthreads();
    for (int tok = F.bid * NTHREADS + F.tid; tok < T_TOK; tok += F.G * NTHREADS) { const int bk = tok_bkt[tok]; const int slot = start[bk] * 256 + tok_rank[tok]; slot_tok[slot] = tok; slot_c[slot] = tok_c[tok]; }
    for (int b = F.bid; b < 24; b += F.G) { const int s0 = start[b] * 256 + cnt[b], s1 = start[b + 1] * 256;
        for (int s = s0 + F.tid; s < s1; s += NTHREADS) { slot_tok[s] = -1; slot_c[s] = (f32x2){0.f, 0.f}; } }
    if (F.bid == 0) { if (F.tid == 0) tile_tab[0] = start[24];
        for (int m = F.tid; m < 288; m += NTHREADS) { int bk = 23; for (int b = 0; b < 24; ++b) if (m >= start[b] && m < start[b + 1]) bk = b; tile_tab[64 + m] = bk; } }
}

template <int SET>
__device__ __forceinline__ void phase_mix(const Params& p, const Frame& F, const float* h, bf16_t* o0, bf16_t* o1, bf16_t* o2) {
    const float* mu = p.in[12];
    constexpr int M0 = SET ? 0 : 1, M1 = SET ? 2 : 4, M2 = SET ? 3 : 5;
    f32x4 wv[4], m0[4], m1[4], m2[4];
    row_load(p.in[1] + DM, F.lane, wv); row_load(mu + M0 * DM, F.lane, m0); row_load(mu + M1 * DM, F.lane, m1); row_load(mu + M2 * DM, F.lane, m2);
    for (int run = F.bid * 8 + F.wave; run < T_TOK / 32; run += F.G * 8) {
        const int t0 = run * 32;
        f32x4 up[4];
        if ((t0 & (SEQ - 1)) == 0) {
#pragma unroll
            for (int j = 0; j < 4; ++j) up[j] = (f32x4){0.f, 0.f, 0.f, 0.f};
        } else { row_load(h + (size_t)(t0 - 1) * DM, F.lane, up); const float rs = row_rstd(up, 1e-6f);
#pragma unroll
            for (int j = 0; j < 4; ++j) up[j] = up[j] * rs * wv[j]; }
        for (int tt = 0; tt < 32; ++tt) {
            f32x4 u[4]; row_load(h + (size_t)(t0 + tt) * DM, F.lane, u); const float rs = row_rstd(u, 1e-6f);
            f32x4 a[4], b[4], c[4];
#pragma unroll
            for (int j = 0; j < 4; ++j) { u[j] = u[j] * rs * wv[j]; const f32x4 xx = up[j] - u[j]; a[j] = u[j] + xx * m0[j]; b[j] = u[j] + xx * m1[j]; c[j] = u[j] + xx * m2[j]; up[j] = u[j]; }
            row_store_bf16(o0 + (size_t)(t0 + tt) * DM, F.lane, a); row_store_bf16(o1 + (size_t)(t0 + tt) * DM, F.lane, b); row_store_bf16(o2 + (size_t)(t0 + tt) * DM, F.lane, c);
        }
    }
}

__device__ __forceinline__ void phase_rwkv(const Params& p, const Frame& F, bf16_t* rbuf, const bf16_t* kbuf, const bf16_t* vbuf, const bf16_t* ebuf, const bf16_t* abuf, const bf16_t* gbuf) {
    LAS float* R = (LAS float*)F.lds;
    LAS float* W = R + 4096; LAS float* KP = W + 4096; LAS float* V = KP + 4096; LAS float* AA = V + 4096; LAS float* BB = AA + 4096; LAS float* GG = BB + 4096; LAS float* YS = GG + 4096;
    LAS float* BON = (LAS float*)(F.lds + 131072);
    const float* k_k = p.in[25]; const float* k_a = p.in[26]; const float* r_k = p.in[27]; const float* lnw = p.in[28]; const float* lnb = p.in[29];
    const int i = F.tid >> 3, jq = F.tid & 7;
    for (int unit = F.bid; unit < 256; unit += F.G) {
        const int b = unit >> 4, hd = unit & 15;
        float s[8];
#pragma unroll
        for (int j = 0; j < 8; ++j) s[j] = 0.f;
        const int gcol = hd * 64 + F.lane;
        const float kkw = k_k[gcol], kaw = k_a[gcol], rkw = r_k[gcol], lw = lnw[gcol], lb = lnb[gcol];
        for (int t0 = 0; t0 < SEQ; t0 += 64) {
            __syncthreads();
#pragma unroll
            for (int q = 0; q < 8; ++q) { const int t = F.wave + 8 * q; const size_t off = ((size_t)b * SEQ + t0 + t) * DM + gcol; const int li = t * 64 + F.lane;
                const float r = bf2f(rbuf[off]), k = bf2f(kbuf[off]), v = bf2f(vbuf[off]), e = bf2f(ebuf[off]), a = bf2f(abuf[off]), g = bf2f(gbuf[off]);
                const float kkv = k * kkw; const float ss = wave_sum(kkv * kkv); const float kk = kkv * rsqrtf(fmaxf(ss, 1e-24f));
                const float kp = k * (1.f + (a - 1.f) * kaw);
                const float bon = wave_sum(r * kp * rkw);
                R[li] = r; W[li] = __expf(-e); KP[li] = kp; V[li] = v; AA[li] = -kk; BB[li] = kk * a; GG[li] = g;
                if (F.lane == 0) BON[t] = bon; }
            __syncthreads();
            for (int t = 0; t < 64; ++t) {
                const float v = V[t * 64 + i];
                const LAS f32x4* pa = (const LAS f32x4*)(AA + t * 64 + jq * 8); const LAS f32x4* pw = (const LAS f32x4*)(W + t * 64 + jq * 8);
                const LAS f32x4* pb = (const LAS f32x4*)(BB + t * 64 + jq * 8); const LAS f32x4* pk = (const LAS f32x4*)(KP + t * 64 + jq * 8); const LAS f32x4* pr = (const LAS f32x4*)(R + t * 64 + jq * 8);
                const f32x4 a0 = pa[0], a1 = pa[1];
                float sa = s[0] * a0[0] + s[1] * a0[1] + s[2] * a0[2] + s[3] * a0[3] + s[4] * a1[0] + s[5] * a1[1] + s[6] * a1[2] + s[7] * a1[3];
                sa += __shfl_xor(sa, 1); sa += __shfl_xor(sa, 2); sa += __shfl_xor(sa, 4);
                const f32x4 w0 = pw[0], w1 = pw[1], b0 = pb[0], b1 = pb[1], k0 = pk[0], k1 = pk[1], r0 = pr[0], r1 = pr[1];
                float y = 0.f;
#pragma unroll
                for (int j = 0; j < 4; ++j) { s[j] = s[j] * w0[j] + sa * b0[j] + v * k0[j]; y += s[j] * r0[j]; s[4 + j] = s[4 + j] * w1[j] + sa * b1[j] + v * k1[j]; y += s[4 + j] * r1[j]; }
                y += __shfl_xor(y, 1); y += __shfl_xor(y, 2); y += __shfl_xor(y, 4);
                if (jq == 0) YS[t * 64 + i] = y;
            }
            __syncthreads();
#pragma unroll
            for (int q = 0; q < 8; ++q) { const int t = F.wave + 8 * q; const int li = t * 64 + F.lane; const size_t off = ((size_t)b * SEQ + t0 + t) * DM + gcol;
                const float y = YS[li]; const float mean = wave_sum(y) * (1.f / 64.f); const float dlt = y - mean; const float var = wave_sum(dlt * dlt) * (1.f / 64.f);
                float o = dlt * rsqrtf(var + 64e-5f) * lw + lb; o += BON[t] * V[li]; o *= GG[li];
                rbuf[off] = f2bf(o); }
        }
    }
}

__global__ void __launch_bounds__(NTHREADS, 2) mega_fwd(Params p) {
    extern __shared__ __attribute__((aligned(16))) unsigned char lds_raw[];
    Frame F;
    F.lds = (LAS unsigned char*)lds_raw;
    F.tid = threadIdx.x; F.lane = F.tid & 63; F.wave = __builtin_amdgcn_readfirstlane(F.tid >> 6); F.G = gridDim.x; F.bid = blockIdx.x;
    F.out = p.out; F.ws = p.ws;
    volatile LAS unsigned* misc = (volatile LAS unsigned*)(F.lds + LDS_MISC);
    if (F.tid < 16) misc[F.tid] = 0u;
    __syncthreads();
    const int lo = p.ph_lo, hi = p.ph_hi;
    XcdBarrier bar; bar.bar = (unsigned*)(F.ws + WS_CTL); bar.x = 0; bar.st = misc;
    if (hi - lo > 1) bar = xcd_barrier_post((unsigned*)(F.ws + WS_CTL), misc);
#define IN(k) (lo <= (k) && (k) < hi)
#define SEAM(k) do { if (IN(k) && IN((k) + 1)) xcd_barrier(bar); } while (0)
    bf16_t* wb = WSP(bf16_t, WS_WB);
    bf16_t* S0 = WSP(bf16_t, WS_SLAB); bf16_t* S2 = WSP(bf16_t, WS_SLAB + 2 * SLAB); bf16_t* S3 = WSP(bf16_t, WS_SLAB + 3 * SLAB); bf16_t* S4 = WSP(bf16_t, WS_SLAB + 4 * SLAB); bf16_t* S5 = WSP(bf16_t, WS_SLAB + 5 * SLAB);
    bf16_t* EH = WSP(bf16_t, WS_E);
    bf16_t* O0 = (bf16_t*)F.out; bf16_t* O1 = O0 + (size_t)T_TOK * DM;
    float* hres = WSP(float, WS_SLAB);
    const int vcu = (F.G % 8 == 0) ? F.bid : F.bid;

    if (IN(0)) { phase_prep(p, F); } SEAM(0);
    if (IN(1)) { phase_rmsnorm<true>(p, F, p.in[0], p.in[1], O0); } SEAM(1);
    if (IN(2)) { DenseP<EK_BF16> P{}; P.K = 1024; P.lda = 1024; P.ldb = 1024; P.nM = 256; P.nN = NPROJ / 256; P.nprob = 1; P.G = F.G; P.c = vcu; P.A = O0; P.a_stride = 0; P.B = wb + WB_WIN / 2; P.b_stride = 0;
        P.O = S0; P.o_stride = 0; P.ldc = NPROJ; gemm_phase(F.lds, P); } SEAM(2);
    if (IN(3)) { phase_scan0(p, F); } SEAM(3);
    if (IN(4)) { phase_gatenorm(p, F); } SEAM(4);
    if (IN(5)) { DenseP<EK_F32RES> P{}; P.K = 2048; P.lda = 2048; P.ldb = 2048; P.nM = 256; P.nN = 4; P.nprob = 1; P.G = F.G; P.c = vcu; P.A = O0; P.B = wb + WB_WOUT / 2; P.res = p.in[0]; P.Of = hres; P.ldc = 1024; gemm_phase(F.lds, P); } SEAM(5);
#define MOE_LAYER(L, k0) \
    if (IN(k0)) { phase_moe_route(p, F, L, hres, S2); } SEAM(k0); \
    if (IN(k0 + 1)) { phase_moe_slots(p, F, L); } SEAM(k0 + 1); \
    if (IN(k0 + 2)) { unsigned char* meta = F.ws + WS_META + (size_t)(L) * META_STRIDE; Moe1P P{}; P.K = 1024; P.lda = 1024; P.ldb = 1024; P.G = F.G; P.c = vcu; \
        P.ntiles = __builtin_amdgcn_readfirstlane(ld_vec_i32((const int*)(meta + MT_TILE))); P.A = S2; P.W13 = wb + WB_W13 / 2 + (size_t)(L) * 16 * 1048576; P.H = S3; \
        P.slot_tok = (const int*)(meta + MT_STOK); P.slot_c = (const float*)(meta + MT_SC); P.tile_bkt = (const int*)(meta + MT_TILE) + 64; gemm_phase(F.lds, P); } SEAM(k0 + 2); \
    if (IN(k0 + 3)) { unsigned char* meta = F.ws + WS_META + (size_t)(L) * META_STRIDE; Moe2P P{}; P.K = 1024; P.lda = 1024; P.ldb = 512; P.G = F.G; P.c = vcu; \
        P.ntiles = __builtin_amdgcn_readfirstlane(ld_vec_i32((const int*)(meta + MT_TILE))); P.H = S3; P.W2 = wb + WB_W2 / 2 + (size_t)(L) * 16 * 524288; P.hres = hres; \
        P.slot_tok = (const int*)(meta + MT_STOK); P.tile_bkt = (const int*)(meta + MT_TILE) + 64; gemm_phase(F.lds, P); } SEAM(k0 + 3);
    MOE_LAYER(0, 6)
    if (IN(10)) { phase_mix<0>(p, F, hres, S2, S3, S4); } SEAM(10);
    if (IN(11)) { DenseP<EK_LORA1> P{}; P.K = 1024; P.lda = 1024; P.ldb = 1024; P.nM = 256; P.nN = 1; P.nprob = 3; P.G = F.G; P.c = vcu; P.A = S2; P.a_stride = (size_t)T_TOK * DM; P.B = wb + WB_L1 / 2; P.b_stride = 262144;
        P.O = EH; P.o_stride = (size_t)T_TOK * 256; P.ldc = 256; gemm_phase(F.lds, P); } SEAM(11);
    if (IN(12)) { phase_mix<1>(p, F, hres, S2, S3, S4); } SEAM(12);
    if (IN(13)) { DenseP<EK_BF16> P{}; P.K = 1024; P.lda = 1024; P.ldb = 1024; P.nM = 256; P.nN = 4; P.nprob = 3; P.G = F.G; P.c = vcu; P.ldc = 1024; P.A = S2; P.a_stride = (size_t)T_TOK * DM; P.B = wb + WB_WR / 2; P.b_stride = 1048576;
        P.O = S5; P.Oalt1 = O0; P.Oalt2 = O1; gemm_phase(F.lds, P); } SEAM(13);
    if (IN(14)) { DenseP<EK_LORA2> P{}; P.K = 256; P.lda = 256; P.ldb = 256; P.nM = 256; P.nN = 4; P.nprob = 3; P.G = F.G; P.c = vcu; P.A = EH; P.a_stride = (size_t)T_TOK * 256; P.B = wb + WB_L2 / 2; P.b_stride = 262144;
        P.O = S2; P.o_stride = (size_t)T_TOK * DM; P.ldc = 1024; P.v0 = p.in[17]; P.v1 = p.in[20]; gemm_phase(F.lds, P); } SEAM(14);
    if (IN(15)) { phase_rwkv(p, F, S5, O0, O1, S2, S3, S4); } SEAM(15);
    if (IN(16)) { DenseP<EK_F32RES> P{}; P.K = 1024; P.lda = 1024; P.ldb = 1024; P.nM = 256; P.nN = 4; P.nprob = 1; P.G = F.G; P.c = vcu; P.A = S5; P.B = wb + WB_WO / 2; P.res = hres; P.Of = hres; P.ldc = 1024; gemm_phase(F.lds, P); } SEAM(16);
    MOE_LAYER(1, 17)
    if (IN(21)) { phase_rmsnorm<false>(p, F, hres, p.in[3], F.out); }
}

extern "C" void kernel_launch(void* const* d_in, const int* in_sizes, int n_in, void* d_out, int out_size, void* d_ws, size_t ws_size, hipStream_t stream) {
    static int grid = 0;
    if (grid == 0) {
        if (n_in != 37 || out_size != T_TOK * DM || ws_size < WS_END) { fprintf(stderr, "kernel_launch: unexpected shapes (n_in %d out %d ws %zu)\n", n_in, out_size, ws_size); grid = -1; return; }
        int dev = 0, cus = 0, per_cu = 0;
        if (hipGetDevice(&dev) != hipSuccess || hipDeviceGetAttribute(&cus, hipDeviceAttributeMultiprocessorCount, dev) != hipSuccess) { grid = -1; return; }
        if (hipFuncSetAttribute((const void*)mega_fwd, hipFuncAttributeMaxDynamicSharedMemorySize, LDS_BYTES) != hipSuccess) { fprintf(stderr, "kernel_launch: hipFuncSetAttribute failed\n"); grid = -1; return; }
        if (hipOccupancyMaxActiveBlocksPerMultiprocessor(&per_cu, (const void*)mega_fwd, NTHREADS, LDS_BYTES) != hipSuccess || per_cu < 1) fprintf(stderr, "kernel_launch: occupancy query says %d\n", per_cu);
        (void)hipGetLastError();
        grid = cus;
    }
    if (grid < 0) return;
    (void)in_sizes;
    hipMemsetAsync((char*)d_ws + WS_CTL, 0, CTL_ZERO_BYTES, stream);
    Params p{};
    for (int i = 0; i < 37; ++i) p.in[i] = (const float*)d_in[i];
    p.out = (float*)d_out; p.ws = (unsigned char*)d_ws;
#if MK_PER_PHASE
    for (int k = 0; k < NPHASE; ++k) { p.ph_lo = k; p.ph_hi = k + 1; hipLaunchKernelGGL(mega_fwd, dim3(grid), dim3(NTHREADS), LDS_BYTES, stream, p); }
#else
    p.ph_lo = 0; p.ph_hi = NPHASE; hipLaunchKernelGGL(mega_fwd, dim3(grid), dim3(NTHREADS), LDS_BYTES, stream, p);
#endif
}
```

```cpp
#include <hip/hip_runtime.h>
#include <stdint.h>
#include <stdio.h>

#ifndef MK_PER_PHASE
#define MK_PER_PHASE 0
#endif

#ifndef PROBE_MASK
#define PROBE_MASK 0u
#endif
#ifndef PROBE_PID
#define PROBE_PID -1
#endif
#ifndef PROBE_SUB
#define PROBE_SUB 0
#endif
#define LAS __attribute__((address_space(3)))
typedef unsigned short bf16_t;
typedef short bf16x8 __attribute__((ext_vector_type(8)));
typedef float f32x4 __attribute__((ext_vector_type(4)));
typedef float f32x2 __attribute__((ext_vector_type(2)));
typedef unsigned u32x4 __attribute__((ext_vector_type(4)));
typedef unsigned u32x2 __attribute__((ext_vector_type(2)));

constexpr int T_TOK = 65536, DM = 1024, SEQ = 4096;
constexpr int NPROJ = 5888;
constexpr int PC_Z = 0, PC_XBC = 1024, PC_Q = 2560, PC_K = 3072, PC_V = 3584, PC_G = 4608, PC_DT = 5632;
constexpr int NTHREADS = 512;
constexpr int LDS_BYTES = 147456;
constexpr int LDS_MISC = LDS_BYTES - 256;
constexpr int NSLOT = T_TOK + 24 * 256;
constexpr int NPHASE = 23;
#if PROBE_SUB
#define SP_DECL unsigned long long sp_t_ = wall_clock64()
#define SP_MARK(id_end) do { if (F.tid == 0) { const unsigned long long n_ = wall_clock64(); if ((id_end) == PROBE_SUB) *(LAS unsigned long long*)(F.lds + LDS_MISC + 64) += n_ - sp_t_; sp_t_ = n_; } } while (0)
#else
#define SP_DECL do {} while (0)
#define SP_MARK(id_end) do {} while (0)
#endif

constexpr size_t MiB = 1024 * 1024;
constexpr size_t WS_CTL = 0;
constexpr size_t CTL_ZERO_BYTES = 16384;
constexpr size_t CTL_CNT_OFF = 14336;
constexpr size_t WS_META = 64 * 1024;
constexpr size_t META_STRIDE = 2 * MiB - 32 * 1024;
constexpr size_t MT_RANK = 0, MT_BKT = 262144, MT_C = 524288, MT_STOK = 1048576, MT_SC = 1048576 + 294912, MT_TILE = 1048576 + 294912 + 589824;
constexpr size_t WS_ROPE = 4 * MiB;
constexpr size_t WS_WB = 6 * MiB;
constexpr size_t WB_WIN = 0, WB_WOUT = WB_WIN + (size_t)NPROJ * 1024 * 2, WB_WR = WB_WOUT + (size_t)1024 * 2048 * 2, WB_WK = WB_WR + 2 * MiB, WB_WV = WB_WK + 2 * MiB, WB_WO = WB_WV + 2 * MiB,
                 WB_L1 = WB_WO + 2 * MiB  , WB_L2 = WB_L1 + 3 * 512 * 1024  , WB_W13 = WB_L2 + 3 * 512 * 1024  ,
                 WB_W2 = WB_W13 + (size_t)32 * 2 * MiB  , WB_END = WB_W2 + (size_t)32 * MiB;
constexpr size_t WS_SLAB = 130 * MiB;
constexpr size_t SLAB = 128 * MiB;
constexpr size_t WS_E = WS_SLAB + 6 * SLAB;
constexpr size_t WS_END = WS_E + 96 * MiB;
constexpr size_t WS_RTW = WS_WB + WB_END;
static_assert(WS_RTW + 2 * 20 * 1024 * 4 <= WS_SLAB, "weights overflow");
static_assert(WS_END <= 1024 * MiB, "workspace overflow");

struct Params {
    const float* in[37];
    float* out;
    unsigned char* ws;
    int ph_lo, ph_hi;
};

__device__ __forceinline__ float bf2f(bf16_t v) { return __uint_as_float(((unsigned)v) << 16); }
__device__ __forceinline__ float bflo(unsigned w) { return __uint_as_float(w << 16); }
__device__ __forceinline__ float bfhi(unsigned w) { return __uint_as_float(w & 0xffff0000u); }
__device__ __forceinline__ unsigned cvt_pk_bf16(float lo, float hi) { unsigned r; asm volatile("v_cvt_pk_bf16_f32 %0, %1, %2" : "=v"(r) : "v"(lo), "v"(hi)); return r; }
__device__ __forceinline__ bf16_t f2bf(float f) { return (bf16_t)(cvt_pk_bf16(f, 0.f) & 0xffffu); }
__device__ __forceinline__ float wave_sum(float v) {
#pragma unroll
    for (int o = 32; o >= 1; o >>= 1) v += __shfl_xor(v, o);
    return v;
}
__device__ __forceinline__ float dpp_sum16(float x) {
    x += __builtin_bit_cast(float, __builtin_amdgcn_update_dpp(0, __builtin_bit_cast(int, x), 0xB1, 0xF, 0xF, true));
    x += __builtin_bit_cast(float, __builtin_amdgcn_update_dpp(0, __builtin_bit_cast(int, x), 0x4E, 0xF, 0xF, true));
    x += __builtin_bit_cast(float, __builtin_amdgcn_update_dpp(0, __builtin_bit_cast(int, x), 0x141, 0xF, 0xF, true));
    x += __builtin_bit_cast(float, __builtin_amdgcn_update_dpp(0, __builtin_bit_cast(int, x), 0x140, 0xF, 0xF, true));
    return x;
}
__device__ __forceinline__ float wave_sum_u(float x) {
    x = dpp_sum16(x);
    x += __builtin_bit_cast(float, __builtin_amdgcn_update_dpp(0, __builtin_bit_cast(int, x), 0x142, 0xA, 0xF, false));
    x += __builtin_bit_cast(float, __builtin_amdgcn_update_dpp(0, __builtin_bit_cast(int, x), 0x143, 0xC, 0xF, false));
    return __builtin_bit_cast(float, __builtin_amdgcn_readlane(__builtin_bit_cast(int, x), 63));
}
__device__ __forceinline__ float fsilu(float x) { return x * __builtin_amdgcn_rcpf(1.f + __expf(-x)); }
__device__ __forceinline__ float fsigmoid(float x) { return __builtin_amdgcn_rcpf(1.f + __expf(-x)); }
__device__ __forceinline__ float fsoftplus(float x) { return x > 20.f ? x : log1pf(__expf(x)); }
__device__ __forceinline__ float ftanh(float x) { const float xc = fminf(fmaxf(x, -15.f), 15.f); const float e = __expf(2.f * xc); return (e - 1.f) * __builtin_amdgcn_rcpf(e + 1.f); }
__device__ __forceinline__ int ld_vec_i32(const int* p) { int r; asm volatile("global_load_dword %0, %1, off\n\ts_waitcnt vmcnt(0)" : "=&v"(r) : "v"(p) : "memory"); return r; }

#define XB_TMO      128
#define XB_XCNT(j)  (256  + 64 * (j))
#define XB_XSUB(j)  (1280 + 64 * (j))
#define XB_XGEN(j)  (2304 + 64 * (j))
#define XB_TOP      3328
#define XB_TOPGEN   3392
#define XCD_BAR_WORDS 3456
#define XB_SPIN_CAP (1u << 24)
__device__ __forceinline__ unsigned xb_ld(unsigned* p)              { return __hip_atomic_load(p, __ATOMIC_RELAXED, __HIP_MEMORY_SCOPE_AGENT); }
__device__ __forceinline__ unsigned xb_add(unsigned* p, unsigned v) { return __hip_atomic_fetch_add(p, v, __ATOMIC_RELAXED, __HIP_MEMORY_SCOPE_AGENT); }
__device__ __forceinline__ unsigned xb_xcc_id() { return (unsigned)__builtin_amdgcn_s_getreg((3 << 11) | 20) & 0xFu; }
#define XB_SPIN(cond, bar) do { unsigned _sp = 0; while (cond) { __builtin_amdgcn_s_sleep(1); \
    if ((++_sp & 255u) == 0u) { if (xb_ld(&(bar)[XB_TMO])) break; if (_sp > XB_SPIN_CAP) { atomicAdd(&(bar)[XB_TMO], 1u); break; } } } } while (0)
struct XcdBarrier { unsigned* bar; unsigned x; volatile LAS unsigned* st; };
__device__ __forceinline__ XcdBarrier xcd_barrier_post(unsigned* bar, volatile LAS unsigned* st) {
    XcdBarrier b; b.bar = bar; b.x = xb_xcc_id(); b.st = st;
    if (threadIdx.x == 0) (void)xb_add(&bar[XB_XCNT(b.x)], 1u);
    return b;
}
__device__ __forceinline__ void xcd_barrier_complete(unsigned* bar, unsigned x, unsigned& nloc, unsigned& nx) {
    const unsigned G = gridDim.x * gridDim.y * gridDim.z;
    unsigned sum, cnt, mine, sp = 0u;
    for (;;) {
        sum = 0u; cnt = 0u; mine = 0u;
#pragma unroll
        for (unsigned j = 0; j < 16; ++j) { const unsigned c = xb_ld(&bar[XB_XCNT(j)]); sum += c; cnt += (c > 0u) ? 1u : 0u; mine = (j == x) ? c : mine; }
        if (sum == G) break;
        __builtin_amdgcn_s_sleep(1);
        if ((++sp & 255u) == 0u) { if (xb_ld(&bar[XB_TMO])) break; if (sp > XB_SPIN_CAP) { atomicAdd(&bar[XB_TMO], 1u); break; } }
    }
    nloc = mine > 0u ? mine : 1u; nx = cnt > 0u ? cnt : 1u;
}
__device__ __forceinline__ void xcd_barrier(const XcdBarrier& b) {
    asm volatile("s_waitcnt vmcnt(0)" ::: "memory");
    __syncthreads();
    if (threadIdx.x == 0) {
        unsigned* bar = b.bar;
        __builtin_amdgcn_s_waitcnt(0);
        unsigned nloc = b.st[0], nx = b.st[1];
        if (nloc == 0u) { xcd_barrier_complete(bar, b.x, nloc, nx); b.st[0] = nloc; b.st[1] = nx; }
        const unsigned old = xb_add(&bar[XB_XSUB(b.x)], 1u);
        const unsigned gen = old / nloc;
        if (old + 1u == (gen + 1u) * nloc) {
            __builtin_amdgcn_fence(__ATOMIC_RELEASE, "agent");
            asm volatile("s_waitcnt vmcnt(0)" ::: "memory");
            const unsigned og = xb_add(&bar[XB_TOP], 1u);
            const unsigned tg = og / nx;
            if (og + 1u == (tg + 1u) * nx) xb_add(&bar[XB_TOPGEN], 1u);
            else XB_SPIN(xb_ld(&bar[XB_TOPGEN]) == tg, bar);
            __builtin_amdgcn_fence(__ATOMIC_ACQUIRE, "agent");
            xb_add(&bar[XB_XGEN(b.x)], 1u);
            asm volatile("s_waitcnt vmcnt(0)" ::: "memory");
        } else {
            XB_SPIN(xb_ld(&bar[XB_XGEN(b.x)]) == gen, bar);
            __builtin_amdgcn_fence(__ATOMIC_ACQUIRE, "agent");
            asm volatile("s_waitcnt vmcnt(0)" ::: "memory");
        }
    }
    __syncthreads();
}

constexpr int BM = 256, BK = 64, HALF = 128, HTB = HALF * BK * 2, STAGE_BYTES = 8 * HTB;
__device__ __forceinline__ int lds_byte(int r, int c) { const int st = (r >> 4) * 2 + (c >> 5), rr = r & 15, cc = c & 31, ob = rr * 64 + cc * 2; return st * 1024 + (ob ^ (((ob >> 9) & 1) << 5)); }
__device__ __forceinline__ void stage_rc(int b, int& R, int& C) { const int st = b / 1024, sb = b % 1024, swz = sb ^ (((sb >> 9) & 1) << 5); R = (st >> 1) * 16 + swz / 64; C = (st & 1) * 32 + (swz % 64) / 2; }
__device__ __forceinline__ int perm32(int rho) { const int n = rho >> 4, i = rho & 15; return 8 * (i >> 2) + 4 * n + (i & 3); }
struct Unit { int pm, pn, prob; };
__device__ __forceinline__ void tile_order(int L, int nM, int nN, int& pm, int& pn) {
    const int nwg = nM * nN; int wgid = L;
    { const int q = nwg / 8, r = nwg % 8, xcd = wgid % 8, off = wgid / 8; wgid = (xcd < r ? xcd * (q + 1) : r * (q + 1) + (xcd - r) * q) + off; }
    const int nig = 8 * nN, gid = wgid / nig, fm = gid * 8, gsz = (nM - fm) < 8 ? (nM - fm) : 8;
    pm = fm + ((wgid % nig) % gsz); pn = (wgid % nig) / gsz;
}

template <class P>
__device__ __forceinline__ void gemm_phase(LAS unsigned char* lds, const P& S) {
    const int tid = threadIdx.x, wid = __builtin_amdgcn_readfirstlane(tid >> 6), lane = tid & 63, wr = wid >> 2, wc = wid & 3, fr = lane & 15, fq = lane >> 4;
    const int K = S.K, nt = K / BK, lda = S.lda, ldb = S.ldb;
    int RA[2], CA[2]; unsigned voffB[2], vAc[2][2], vAn[2][2];
#pragma unroll
    for (int i = 0; i < 2; ++i) { int R, C; stage_rc(tid * 16 + i * 8192, R, C); RA[i] = R; CA[i] = C; const int Rb = P::PERM ? ((R & ~31) + perm32(R & 31)) : R;
        voffB[i] = (unsigned)(Rb * ldb + C) * 2u;
#pragma unroll
        for (int h = 0; h < 2; ++h) { vAc[h][i] = (unsigned)((h * HALF + R) * lda + C) * 2u; vAn[h][i] = vAc[h][i]; } }
    const size_t kstep = (size_t)(BK * 2);
    const size_t hstepB = (size_t)HALF * ldb * 2;
    const unsigned ldsw = (unsigned)wid * 1024u;
    const int aoff = lds_byte(wr * 64 + fr, fq * 8), boff = lds_byte(wc * 32 + fr, fq * 8);
#define PG8_SA(b, h) (((b) * 2 + (h)) * HTB)
#define PG8_SB(b, h) ((4 + (b) * 2 + (h)) * HTB)
#define PG8_STAGE2(bufoff, gbase, v0, v1) do { \
        __builtin_amdgcn_global_load_lds((const unsigned*)((const char*)(gbase) + (v0)), (LAS unsigned*)(lds + (bufoff) + ldsw), 16, 0, 0); \
        __builtin_amdgcn_global_load_lds((const unsigned*)((const char*)(gbase) + (v1)), (LAS unsigned*)(lds + (bufoff) + ldsw + 8192), 16, 0, 0); } while (0)
#define PG8_LDA(dst, b, h) do { _Pragma("unroll") for (int m = 0; m < 4; ++m) _Pragma("unroll") for (int k = 0; k < 2; ++k) dst[m][k] = *(const LAS bf16x8*)(lds + PG8_SA(b, h) + aoff + m * 2048 + k * 1024); } while (0)
#define PG8_LDB(dst, b, h) do { _Pragma("unroll") for (int n = 0; n < 2; ++n) _Pragma("unroll") for (int k = 0; k < 2; ++k) dst[n][k] = *(const LAS bf16x8*)(lds + PG8_SB(b, h) + boff + n * 2048 + k * 1024); } while (0)
#define PG8_MMA(ai, bj, At, Bt) do { __builtin_amdgcn_s_setprio(1); _Pragma("unroll") for (int m = 0; m < 4; ++m) _Pragma("unroll") for (int n = 0; n < 2; ++n) _Pragma("unroll") for (int k = 0; k < 2; ++k) \
        acc[ai][bj][m][n] = __builtin_amdgcn_mfma_f32_16x16x32_bf16(Bt[n][k], At[m][k], acc[ai][bj][m][n], 0, 0, 0); __builtin_amdgcn_s_setprio(0); } while (0)
#define PG8_WAIT_V(n) asm volatile("s_waitcnt vmcnt(" #n ")" ::: "memory")
#define PG8_WAIT_L(n) asm volatile("s_waitcnt lgkmcnt(" #n ")" ::: "memory")
#define PG8_BAR __builtin_amdgcn_s_barrier()
#define PG8_SCHED __builtin_amdgcn_sched_barrier(0)
    Unit cur, nxt; int ui = 0;
    if (!S.next(0, cur)) return;
    struct { int tid; LAS unsigned char* lds; } F; F.tid = tid; F.lds = lds; (void)F;
    SP_DECL;
    if constexpr (P::GATHER) {
#pragma unroll
        for (int h = 0; h < 2; ++h)
#pragma unroll
            for (int i = 0; i < 2; ++i) vAc[h][i] = S.a_voff(cur, h * HALF + RA[i], CA[i]);
    }
    float zf; asm volatile("v_mov_b32 %0, 0" : "=v"(zf));
    f32x4 acc[2][2][4][2];
#pragma unroll
    for (int a = 0; a < 2; ++a)
#pragma unroll
        for (int b = 0; b < 2; ++b)
#pragma unroll
            for (int m = 0; m < 4; ++m)
#pragma unroll
                for (int n = 0; n < 2; ++n) acc[a][b][m][n] = (f32x4){zf, zf, zf, zf};
    bf16x8 At[4][2], B0[2][2], B1[2][2];
    const char* cA = S.a_ptr(cur);
    {
        const char* b0 = S.b_ptr(cur, 0); const char* b1 = S.b_ptr(cur, 1);
        PG8_STAGE2(PG8_SB(0, 0), b0, voffB[0], voffB[1]); PG8_STAGE2(PG8_SA(0, 0), cA, vAc[0][0], vAc[0][1]); PG8_STAGE2(PG8_SB(0, 1), b0 + hstepB, voffB[0], voffB[1]); PG8_STAGE2(PG8_SA(0, 1), cA, vAc[1][0], vAc[1][1]);
        if (wr == 1) PG8_BAR;
        PG8_WAIT_V(4); PG8_BAR;
        PG8_STAGE2(PG8_SB(1, 0), b1, voffB[0], voffB[1]); PG8_STAGE2(PG8_SA(1, 0), cA + kstep, vAc[0][0], vAc[0][1]); PG8_STAGE2(PG8_SB(1, 1), b1 + hstepB, voffB[0], voffB[1]);
        PG8_WAIT_V(6); PG8_BAR;
    }
    for (;;) {
        const bool has_next = S.next(ui + 1, nxt);
        if (!has_next) nxt = cur;
        if constexpr (P::GATHER) {
            if (has_next) {
#pragma unroll
                for (int h = 0; h < 2; ++h)
#pragma unroll
                    for (int i = 0; i < 2; ++i) vAn[h][i] = S.a_voff(nxt, h * HALF + RA[i], CA[i]);
            }
        }
        const char* nA = S.a_ptr(nxt);
        for (int t = 0; t < nt; t += 2) {
            const bool last = (t == nt - 2);
            const char* a1 = cA + (size_t)(t + 1) * kstep;
            const char* a2 = last ? nA : cA + (size_t)(t + 2) * kstep;
            const char* a3 = a2 + kstep;
            const char* b2 = last ? S.b_ptr(nxt, 0) : S.b_ptr(cur, t + 2);
            const char* b3 = last ? S.b_ptr(nxt, 1) : S.b_ptr(cur, t + 3);
            unsigned s00 = vAc[0][0], s01 = vAc[0][1], s10 = vAc[1][0], s11 = vAc[1][1];
            if constexpr (P::GATHER) { if (last) { s00 = vAn[0][0]; s01 = vAn[0][1]; s10 = vAn[1][0]; s11 = vAn[1][1]; } }
            PG8_LDB(B0, 0, 0); PG8_SCHED; PG8_LDA(At, 0, 0); PG8_STAGE2(PG8_SA(1, 1), a1, vAc[1][0], vAc[1][1]);
            PG8_WAIT_L(8); PG8_BAR; PG8_WAIT_L(0); PG8_MMA(0, 0, At, B0); PG8_BAR; PG8_SCHED;
            PG8_LDB(B1, 0, 1); PG8_STAGE2(PG8_SB(0, 0), b2, voffB[0], voffB[1]);
            PG8_BAR; PG8_WAIT_L(0); PG8_MMA(0, 1, At, B1); PG8_BAR;
            PG8_LDA(At, 0, 1); PG8_STAGE2(PG8_SA(0, 0), a2, s00, s01);
            PG8_BAR; PG8_WAIT_L(0); PG8_MMA(1, 0, At, B0); PG8_BAR; PG8_SCHED;
            PG8_STAGE2(PG8_SB(0, 1), b2 + hstepB, voffB[0], voffB[1]);
            PG8_WAIT_V(6); PG8_BAR; PG8_MMA(1, 1, At, B1); PG8_BAR;
            PG8_LDB(B0, 1, 0); PG8_SCHED; PG8_LDA(At, 1, 0); PG8_STAGE2(PG8_SA(0, 1), a2, s10, s11);
            PG8_WAIT_L(8); PG8_BAR; PG8_WAIT_L(0); PG8_MMA(0, 0, At, B0); PG8_BAR; PG8_SCHED;
            PG8_LDB(B1, 1, 1); PG8_STAGE2(PG8_SB(1, 0), b3, voffB[0], voffB[1]);
            PG8_BAR; PG8_WAIT_L(0); PG8_MMA(0, 1, At, B1); PG8_BAR;
            PG8_LDA(At, 1, 1); PG8_STAGE2(PG8_SA(1, 0), a3, s00, s01);
            PG8_BAR; PG8_WAIT_L(0); PG8_MMA(1, 0, At, B0); PG8_BAR; PG8_SCHED;
            PG8_STAGE2(PG8_SB(1, 1), b3 + hstepB, voffB[0], voffB[1]);
            PG8_WAIT_V(6); PG8_BAR; PG8_MMA(1, 1, At, B1); PG8_BAR;
        }
        SP_MARK((PROBE_PID < 0 || S.pid == PROBE_PID) ? 10 : -1);
        S.epi(acc, cur, wr, wc, fr, fq);
        SP_MARK((PROBE_PID < 0 || S.pid == PROBE_PID) ? 9 : -1);
        if (!has_next) break;
#pragma unroll
        for (int a = 0; a < 2; ++a)
#pragma unroll
            for (int b = 0; b < 2; ++b)
#pragma unroll
                for (int m = 0; m < 4; ++m)
#pragma unroll
                    for (int n = 0; n < 2; ++n) acc[a][b][m][n] = (f32x4){zf, zf, zf, zf};
        cur = nxt; cA = nA; ++ui;
        if constexpr (P::GATHER) {
#pragma unroll
            for (int h = 0; h < 2; ++h)
#pragma unroll
                for (int i = 0; i < 2; ++i) vAc[h][i] = vAn[h][i];
        }
    }
    PG8_WAIT_V(0);
    if (wr == 0) PG8_BAR;
    PG8_BAR;
#undef PG8_SA
#undef PG8_SB
#undef PG8_STAGE2
#undef PG8_LDA
#undef PG8_LDB
#undef PG8_MMA
#undef PG8_WAIT_V
#undef PG8_WAIT_L
#undef PG8_BAR
#undef PG8_SCHED
}

enum { EK_BF16 = 0, EK_LORA1 = 1, EK_LORA2 = 2, EK_F32RES = 3, EK_INPROJ = 4 };
template <int KIND>
struct DenseP {
    static constexpr bool PERM = true, GATHER = false;
    int K, lda, ldb, nM, nN, nprob, G, c, pid;
    const bf16_t* A; size_t a_stride;
    const bf16_t* B; size_t b_stride;
    bf16_t* O; size_t o_stride; int ldc;
    bf16_t* Oalt1; bf16_t* Oalt2;
    const float* resf; const bf16_t* resb; bf16_t* Ob;
    const float* v0; const float* v1;
    __device__ __forceinline__ bool next(int i, Unit& u) const {
        const long L = (long)i * G + c; const int per = nM * nN; if (L >= (long)per * nprob) return false;
        u.prob = (int)(L / per); tile_order((int)(L % per), nM, nN, u.pm, u.pn); return true;
    }
    __device__ __forceinline__ const char* a_ptr(const Unit& u) const { return (const char*)(A + (size_t)u.prob * a_stride + (size_t)u.pm * BM * lda); }
    __device__ __forceinline__ const char* b_ptr(const Unit& u, int kt) const { return (const char*)(B + (size_t)u.prob * b_stride + (size_t)u.pn * BM * ldb) + (size_t)kt * (BK * 2); }
    __device__ __forceinline__ unsigned a_voff(const Unit&, int, int) const { return 0u; }
    __device__ __forceinline__ void epi(const f32x4 (&acc)[2][2][4][2], const Unit& u, int wr, int wc, int fr, int fq) const {
        const int row0 = u.pm * BM + wr * 64 + fr;
        if constexpr (KIND == EK_F32RES) {
            const int col0 = u.pn * BM + wc * 32 + 8 * fq;
#pragma unroll
            for (int ai = 0; ai < 2; ++ai)
#pragma unroll
                for (int mp = 0; mp < 2; ++mp) {
                    f32x4 r0[2][2], r1[2][2];
#pragma unroll
                    for (int mm = 0; mm < 2; ++mm) { const size_t ro = (size_t)(row0 + ai * HALF + (mp * 2 + mm) * 16) * ldc + col0;
#pragma unroll
                        for (int bj = 0; bj < 2; ++bj) {
                            if (resf) { r0[mm][bj] = __builtin_nontemporal_load((const f32x4*)(resf + ro + bj * HALF)); r1[mm][bj] = __builtin_nontemporal_load((const f32x4*)(resf + ro + bj * HALF + 4)); }
                            else { const u32x4 rw = *(const u32x4*)(resb + ro + bj * HALF); r0[mm][bj] = (f32x4){bflo(rw.x), bfhi(rw.x), bflo(rw.y), bfhi(rw.y)}; r1[mm][bj] = (f32x4){bflo(rw.z), bfhi(rw.z), bflo(rw.w), bfhi(rw.w)}; } } }
#pragma unroll
                    for (int mm = 0; mm < 2; ++mm) { const size_t ro = (size_t)(row0 + ai * HALF + (mp * 2 + mm) * 16) * ldc + col0;
#pragma unroll
                        for (int bj = 0; bj < 2; ++bj) { const f32x4 x0 = acc[ai][bj][mp * 2 + mm][0] + r0[mm][bj], x1 = acc[ai][bj][mp * 2 + mm][1] + r1[mm][bj];
                            u32x4 w; w.x = cvt_pk_bf16(x0[0], x0[1]); w.y = cvt_pk_bf16(x0[2], x0[3]); w.z = cvt_pk_bf16(x1[0], x1[1]); w.w = cvt_pk_bf16(x1[2], x1[3]);
                            *(u32x4*)(Ob + ro + bj * HALF) = w; } }
                }
        } else {
            const int col0 = u.pn * BM + wc * 32 + 8 * fq;
            bf16_t* base = Oalt1 ? ((u.prob == 0) ? O : (u.prob == 1) ? Oalt1 : Oalt2) : O + (size_t)u.prob * o_stride;
            f32x4 bv[2][2];
#pragma unroll
            for (int bj = 0; bj < 2; ++bj)
#pragma unroll
                for (int n = 0; n < 2; ++n) {
                    if constexpr (KIND == EK_LORA2) { bv[bj][n] = (u.prob == 0) ? *(const f32x4*)(v0 + col0 + bj * HALF + 4 * n) : (u.prob == 1) ? *(const f32x4*)(v1 + col0 + bj * HALF + 4 * n) : (f32x4){0.f, 0.f, 0.f, 0.f}; }
                    else bv[bj][n] = (f32x4){0.f, 0.f, 0.f, 0.f};
                }
#pragma unroll
            for (int ai = 0; ai < 2; ++ai)
#pragma unroll
                for (int m = 0; m < 4; ++m) { bf16_t* rowp = base + (size_t)(row0 + ai * HALF + m * 16) * ldc + col0;
#pragma unroll
                    for (int bj = 0; bj < 2; ++bj) { f32x4 x0 = acc[ai][bj][m][0] + bv[bj][0], x1 = acc[ai][bj][m][1] + bv[bj][1];
                        if constexpr (KIND == EK_LORA1) {
                            const float kx = (u.prob == 0) ? 2.f : 1.f;
#pragma unroll
                            for (int j = 0; j < 4; ++j) { const float s0 = fsigmoid(kx * x0[j]), s1 = fsigmoid(kx * x1[j]);
                                x0[j] = (u.prob == 0) ? 2.f * s0 - 1.f : (u.prob == 2) ? s0 : x0[j]; x1[j] = (u.prob == 0) ? 2.f * s1 - 1.f : (u.prob == 2) ? s1 : x1[j]; } }
                        if constexpr (KIND == EK_LORA2) {
                            const float sc = (u.prob == 0) ? 0.6065306597126334f : 1.f;
#pragma unroll
                            for (int j = 0; j < 4; ++j) { const float s0 = sc * fsigmoid(x0[j]), s1 = sc * fsigmoid(x1[j]); x0[j] = (u.prob == 2) ? x0[j] : s0; x1[j] = (u.prob == 2) ? x1[j] : s1; } }
                        if constexpr (KIND == EK_INPROJ) {
                            if (u.pn >= PC_Q / 256 && u.pn < PC_V / 256) { const int pos = (row0 + ai * HALF + m * 16) & (SEQ - 1); const float sc = (u.pn >= PC_K / 256) ? 0.08838834764831845f : 1.f;
                                const f32x4 cs0 = *(const f32x4*)(v0 + ((size_t)pos * 64 + wc * 16 + 4 * fq) * 2), cs1 = *(const f32x4*)(v0 + ((size_t)pos * 64 + wc * 16 + 4 * fq + 2) * 2);
                                const f32x4 a = x0, b = x1;
                                x0[0] = (a[0] * cs0[0] - a[1] * cs0[1]) * sc; x0[1] = (a[0] * cs0[1] + a[1] * cs0[0]) * sc; x0[2] = (a[2] * cs0[2] - a[3] * cs0[3]) * sc; x0[3] = (a[2] * cs0[3] + a[3] * cs0[2]) * sc;
                                x1[0] = (b[0] * cs1[0] - b[1] * cs1[1]) * sc; x1[1] = (b[0] * cs1[1] + b[1] * cs1[0]) * sc; x1[2] = (b[2] * cs1[2] - b[3] * cs1[3]) * sc; x1[3] = (b[2] * cs1[3] + b[3] * cs1[2]) * sc; } }
                        u32x4 w; w.x = cvt_pk_bf16(x0[0], x0[1]); w.y = cvt_pk_bf16(x0[2], x0[3]); w.z = cvt_pk_bf16(x1[0], x1[1]); w.w = cvt_pk_bf16(x1[2], x1[3]);
                        *(u32x4*)(rowp + bj * HALF) = w; } }
        }
    }
};

__device__ __forceinline__ void pair_lohi(int pr, int& lo, int& hi) { lo = (pr < 3) ? 0 : (pr < 5 ? 1 : 2); hi = (pr < 3) ? pr + 1 : (pr < 5 ? pr - 1 : 3); }

struct Moe1P {
    static constexpr bool PERM = true, GATHER = true;
    int K, lda, ldb, G, c, ntiles, pid;
    const bf16_t* A; const bf16_t* W13;
    bf16_t* H; const int* slot_tok; const float* slot_c; const int* tile_bkt;
    __device__ __forceinline__ bool next(int i, Unit& u) const {
        const int m = (c >> 3) + (G >> 3) * i; if ((G & 7) != 0 || m >= ntiles) { if ((G & 7) == 0) return false; const long L = (long)i * G + c; if (L >= (long)ntiles * 8) return false; u.pm = (int)(L >> 3); u.pn = (int)(L & 7); u.prob = __builtin_amdgcn_readfirstlane(ld_vec_i32(tile_bkt + u.pm)); return true; }
        u.pm = m; u.pn = c & 7; u.prob = __builtin_amdgcn_readfirstlane(ld_vec_i32(tile_bkt + u.pm)); return true;
    }
    __device__ __forceinline__ const char* a_ptr(const Unit&) const { return (const char*)A; }
    __device__ __forceinline__ unsigned a_voff(const Unit& u, int row, int C) const { int tok = slot_tok[u.pm * BM + row]; tok = tok < 0 ? 0 : tok; return (unsigned)(tok * lda + C) * 2u; }
    __device__ __forceinline__ const char* b_ptr(const Unit& u, int kt) const {
        int lo, hi; pair_lohi(u.prob % 6, lo, hi); const int e = (u.prob / 6) * 4 + ((u.pn < 4) ? lo : hi);
        return (const char*)(W13 + ((size_t)e * 1024 + (size_t)(u.pn & 3) * BM) * 1024) + (size_t)kt * (BK * 2);
    }
    __device__ __forceinline__ void epi(const f32x4 (&acc)[2][2][4][2], const Unit& u, int wr, int wc, int fr, int fq) const {
        const int row0 = u.pm * BM + wr * 64 + fr, col0 = ((u.pn < 4) ? 0 : 512) + (u.pn & 3) * 128 + wc * 32 + 8 * fq, ci = (u.pn < 4) ? 0 : 1;
#pragma unroll
        for (int ai = 0; ai < 2; ++ai)
#pragma unroll
            for (int m = 0; m < 4; ++m) { const int row = row0 + ai * HALF + m * 16; const float cw = slot_c[(size_t)row * 2 + ci];
                const f32x4 g0 = acc[ai][0][m][0], g1 = acc[ai][0][m][1], u0 = acc[ai][1][m][0], u1 = acc[ai][1][m][1]; f32x4 x0, x1;
#pragma unroll
                for (int j = 0; j < 4; ++j) { x0[j] = fsilu(g0[j]) * u0[j] * cw; x1[j] = fsilu(g1[j]) * u1[j] * cw; }
                u32x4 w; w.x = cvt_pk_bf16(x0[0], x0[1]); w.y = cvt_pk_bf16(x0[2], x0[3]); w.z = cvt_pk_bf16(x1[0], x1[1]); w.w = cvt_pk_bf16(x1[2], x1[3]);
                *(u32x4*)(H + (size_t)row * 1024 + col0) = w; }
    }
};
struct Moe2P {
    static constexpr bool PERM = true, GATHER = false;
    int K, lda, ldb, G, c, ntiles, pid;
    const bf16_t* H; const bf16_t* W2;
    const bf16_t* hsrc; bf16_t* hdst; const int* slot_tok; const int* tile_bkt;
    __device__ __forceinline__ bool next(int i, Unit& u) const {
        const int m = 2 * ((c >> 3) + (G >> 3) * i) + ((c >> 2) & 1); if ((G & 7) != 0 || m >= ntiles) { if ((G & 7) == 0) return false; const long L = (long)i * G + c; if (L >= (long)ntiles * 4) return false; u.pm = (int)(L >> 2); u.pn = (int)(L & 3); u.prob = __builtin_amdgcn_readfirstlane(ld_vec_i32(tile_bkt + u.pm)); return true; }
        u.pm = m; u.pn = c & 3; u.prob = __builtin_amdgcn_readfirstlane(ld_vec_i32(tile_bkt + u.pm)); return true;
    }
    __device__ __forceinline__ const char* a_ptr(const Unit& u) const { return (const char*)(H + (size_t)u.pm * BM * 1024); }
    __device__ __forceinline__ unsigned a_voff(const Unit&, int, int) const { return 0u; }
    __device__ __forceinline__ const char* b_ptr(const Unit& u, int kt) const {
        int lo, hi; pair_lohi(u.prob % 6, lo, hi); const int e = (u.prob / 6) * 4 + ((kt < 8) ? lo : hi);
        return (const char*)(W2 + ((size_t)e * 1024 + (size_t)u.pn * BM) * 512) + (size_t)(kt & 7) * (BK * 2);
    }
    __device__ __forceinline__ void epi(const f32x4 (&acc)[2][2][4][2], const Unit& u, int wr, int wc, int fr, int fq) const {
        const int row0 = u.pm * BM + wr * 64 + fr, col0 = u.pn * BM + wc * 32 + 8 * fq;
        int tok[2][4];
#pragma unroll
        for (int ai = 0; ai < 2; ++ai)
#pragma unroll
            for (int m = 0; m < 4; ++m) tok[ai][m] = slot_tok[row0 + ai * HALF + m * 16];
#pragma unroll
        for (int ai = 0; ai < 2; ++ai) {
            u32x4 r[4][2];
#pragma unroll
            for (int m = 0; m < 4; ++m) { const int tk = tok[ai][m]; const bf16_t* rp = hsrc + (size_t)(tk < 0 ? 0 : tk) * 1024 + col0;
#pragma unroll
                for (int bj = 0; bj < 2; ++bj) r[m][bj] = *(const u32x4*)(rp + bj * HALF); }
#pragma unroll
            for (int m = 0; m < 4; ++m) { const int tk = tok[ai][m];
                if (tk >= 0) { bf16_t* wp = hdst + (size_t)tk * 1024 + col0;
#pragma unroll
                    for (int bj = 0; bj < 2; ++bj) { const u32x4 rw = r[m][bj]; const f32x4 a0 = acc[ai][bj][m][0], a1 = acc[ai][bj][m][1];
                        u32x4 w; w.x = cvt_pk_bf16(a0[0] + bflo(rw.x), a0[1] + bfhi(rw.x)); w.y = cvt_pk_bf16(a0[2] + bflo(rw.y), a0[3] + bfhi(rw.y));
                        w.z = cvt_pk_bf16(a1[0] + bflo(rw.z), a1[1] + bfhi(rw.z)); w.w = cvt_pk_bf16(a1[2] + bflo(rw.w), a1[3] + bfhi(rw.w));
                        *(u32x4*)(wp + bj * HALF) = w; } } }
        }
    }
};

struct Frame {
    LAS unsigned char* lds;
    int tid, lane, wave, G, bid;
    float* out; unsigned char* ws;
};
#define WSP(T, off) ((T*)(F.ws + (off)))

__device__ __forceinline__ void prep_tile(const Frame& F, const float* src, int src_ld, int k0, int kvalid, int c0, int nvalid, bf16_t* dst, int dst_ld, bool il = false) {
    LAS float* tl = (LAS float*)F.lds;
    __syncthreads();
#pragma unroll
    for (int p = 0; p < 2; ++p) { const int kk = (F.tid >> 4) + 32 * p, n4 = (F.tid & 15) * 4;
        f32x4 v = (f32x4){0.f, 0.f, 0.f, 0.f};
        if (il) {
            v = __builtin_nontemporal_load((const f32x4*)(src + (size_t)(k0 + kk) * src_ld + c0 + ((n4 < 32) ? n4 : 32 + n4))); const int d0 = 2 * (n4 & 31) + (n4 >> 5);
            tl[kk * 65 + d0] = v[0]; tl[kk * 65 + d0 + 2] = v[1]; tl[kk * 65 + d0 + 4] = v[2]; tl[kk * 65 + d0 + 6] = v[3];
        } else {
        if (kk < kvalid && n4 < nvalid) v = __builtin_nontemporal_load((const f32x4*)(src + (size_t)(k0 + kk) * src_ld + c0 + n4));
        tl[kk * 65 + n4 + 0] = v[0]; tl[kk * 65 + n4 + 1] = v[1]; tl[kk * 65 + n4 + 2] = v[2]; tl[kk * 65 + n4 + 3] = v[3]; } }
    __syncthreads();
    { const int n = F.tid >> 3, kc = (F.tid & 7) * 8; float x[8];
#pragma unroll
        for (int j = 0; j < 8; ++j) x[j] = tl[(kc + j) * 65 + n];
        u32x4 w; w.x = cvt_pk_bf16(x[0], x[1]); w.y = cvt_pk_bf16(x[2], x[3]); w.z = cvt_pk_bf16(x[4], x[5]); w.w = cvt_pk_bf16(x[6], x[7]);
        *(u32x4*)(dst + (size_t)n * dst_ld + k0 + kc) = w; }
}
__device__ __forceinline__ void phase_prep(const Params& p, const Frame& F) {
    bf16_t* wb = WSP(bf16_t, WS_WB);
    constexpr int N0 = 1472, N1 = N0 + 512, N2 = N1 + 1024, N3 = N2 + 192, N4 = N3 + 192, N5 = N4 + 8192, N6 = N5 + 4096;
    for (int id = F.bid; id < N6; id += F.G) {
        if (id < N0) { const int nt = id / 16, kt = id % 16, n0 = nt * 64; int c0, nv;
            if (n0 < PC_Q) { c0 = n0; nv = 64; } else if (n0 < PC_DT) { c0 = n0 + 16; nv = 64; } else if (n0 == PC_DT) { c0 = 2560; nv = 16; } else { c0 = 0; nv = 0; }
            const bool il = (n0 >= PC_Q && n0 < PC_V);
            if (il) c0 = 2576 + ((n0 - PC_Q) >> 7) * 128 + (((n0 - PC_Q) >> 6) & 1) * 32;
            prep_tile(F, p.in[4], 5648, kt * 64, 64, c0, nv, wb + WB_WIN / 2 + (size_t)n0 * 1024, 1024, il); }
        else if (id < N1) { const int j = id - N0, nt = j / 32, kt = j % 32; prep_tile(F, p.in[11], 1024, kt * 64, 64, nt * 64, 64, wb + WB_WOUT / 2 + (size_t)nt * 64 * 2048, 2048); }
        else if (id < N2) { const int j = id - N1, w = j / 256, r = j % 256, nt = r / 16, kt = r % 16; prep_tile(F, (w == 0) ? p.in[13] : (w == 1) ? p.in[14] : (w == 2) ? p.in[15] : p.in[16], 1024, kt * 64, 64, nt * 64, 64, wb + WB_WR / 2 + (size_t)w * 1048576 + (size_t)nt * 64 * 1024, 1024); }
        else if (id < N3) { const int j = id - N2, w = j / 64, r = j % 64, nt = r / 16, kt = r % 16; const int ncols = (w == 2) ? 160 : 64; int nv = ncols - nt * 64; nv = nv < 0 ? 0 : (nv > 64 ? 64 : nv);
            const float* src = (w == 0) ? p.in[18] : (w == 1) ? p.in[21] : p.in[23];
            prep_tile(F, src, ncols, kt * 64, 64, nt * 64, nv, wb + WB_L1 / 2 + (size_t)w * 262144 + (size_t)nt * 64 * 1024, 1024); }
        else if (id < N4) { const int j = id - N3, w = j / 64, r = j % 64, nt = r / 4, kt = r % 4; const int krows = (w == 2) ? 160 : 64; int kv = krows - kt * 64; kv = kv < 0 ? 0 : (kv > 64 ? 64 : kv);
            const float* src = (w == 0) ? p.in[19] : (w == 1) ? p.in[22] : p.in[24];
            prep_tile(F, src, 1024, kt * 64, kv, nt * 64, 64, wb + WB_L2 / 2 + (size_t)w * 262144 + (size_t)nt * 64 * 256, 256); }
        else if (id < N5) { const int j = id - N4, le = j / 256, r = j % 256, nt = r / 16, kt = r % 16;
            const int pn = nt >> 2, part = (nt >> 1) & 1, c0 = 128 * pn + 64 * (nt & 1);
            const float* src = (part ? p.in[35] : p.in[34]) + (size_t)le * 524288;
            prep_tile(F, src, 512, kt * 64, 64, c0, 64, wb + WB_W13 / 2 + (size_t)le * 1048576 + (size_t)nt * 64 * 1024, 1024); }
        else { const int j = id - N5, le = j / 128, r = j % 128, nt = r / 8, kt = r % 8;
            prep_tile(F, p.in[36] + (size_t)le * 524288, 1024, kt * 64, 64, nt * 64, 64, wb + WB_W2 / 2 + (size_t)le * 524288 + (size_t)nt * 64 * 512, 512); }
    }
    { float* rtw = WSP(float, WS_RTW);
        for (int idx = F.bid * NTHREADS + F.tid; idx < 2 * 20 * 1024; idx += F.G * NTHREADS) { const int l = idx / 20480, r = idx % 20480, j = r >> 10, k = r & 1023;
            rtw[idx] = (j < 4) ? p.in[30][(size_t)l * 4096 + k * 4 + j] : p.in[32][(size_t)l * 16384 + k * 16 + (j - 4)]; } }
    f32x2* rope = WSP(f32x2, WS_ROPE);
    for (int idx = F.bid * NTHREADS + F.tid; idx < SEQ * 64; idx += F.G * NTHREADS) {
        const int pos = idx >> 6, i = idx & 63;
        const float invf = exp2f(-(float)i * (13.287712379549449f / 64.f));
        const float ang = (float)pos * invf;
        const double x = (double)ang;
        const double kq = rint(x * 0.63661977236758134308);
        double r = fma(-kq, 1.57079632679489655800e+00, x); r = fma(-kq, 6.12323399573676603587e-17, r);
        const double r2 = r * r;
        double sp = -7.6471637318198164759e-13; sp = fma(sp, r2, 1.6059043836821614599e-10); sp = fma(sp, r2, -2.5052108385441718775e-08); sp = fma(sp, r2, 2.7557319223985890653e-06);
        sp = fma(sp, r2, -1.9841269841269841270e-04); sp = fma(sp, r2, 8.3333333333333333333e-03); sp = fma(sp, r2, -1.6666666666666666667e-01); const double sn = fma(sp * r2, r, r);
        double cp = 4.7794773323873852974e-14; cp = fma(cp, r2, -1.1470745597729724714e-11); cp = fma(cp, r2, 2.0876756987868098979e-09); cp = fma(cp, r2, -2.7557319223985890653e-07);
        cp = fma(cp, r2, 2.4801587301587301587e-05); cp = fma(cp, r2, -1.3888888888888888889e-03); cp = fma(cp, r2, 4.1666666666666666667e-02); cp = fma(cp, r2, -0.5); const double cs = fma(cp, r2, 1.0);
        const int q = ((int)kq) & 3;
        const double c = (q == 0) ? cs : (q == 1) ? -sn : (q == 2) ? -cs : sn;
        const double s = (q == 0) ? sn : (q == 1) ? cs : (q == 2) ? -sn : -cs;
        rope[idx] = (f32x2){(float)c, (float)s};
    }
}

__device__ __forceinline__ void row_load(const float* row, int lane, f32x4 (&v)[4]) {
#pragma unroll
    for (int j = 0; j < 4; ++j) v[j] = *(const f32x4*)(row + j * 256 + lane * 4);
}
__device__ __forceinline__ void row_load_nt(const float* row, int lane, f32x4 (&v)[4]) {
#pragma unroll
    for (int j = 0; j < 4; ++j) v[j] = __builtin_nontemporal_load((const f32x4*)(row + j * 256 + lane * 4));
}
__device__ __forceinline__ void row_load_bf_nt(const bf16_t* row, int lane, f32x4 (&v)[4]) {
#pragma unroll
    for (int j = 0; j < 4; ++j) { const u32x2 w = __builtin_nontemporal_load((const u32x2*)(row + j * 256 + lane * 4)); v[j] = (f32x4){bflo(w.x), bfhi(w.x), bflo(w.y), bfhi(w.y)}; }
}
__device__ __forceinline__ void row_load_bf(const bf16_t* row, int lane, f32x4 (&v)[4]) {
#pragma unroll
    for (int j = 0; j < 4; ++j) { const u32x2 w = *(const u32x2*)(row + j * 256 + lane * 4); v[j] = (f32x4){bflo(w.x), bfhi(w.x), bflo(w.y), bfhi(w.y)}; }
}
__device__ __forceinline__ float row_rstd(const f32x4 (&v)[4], float eps) {
    float ss = 0.f;
#pragma unroll
    for (int j = 0; j < 4; ++j) ss += v[j][0] * v[j][0] + v[j][1] * v[j][1] + v[j][2] * v[j][2] + v[j][3] * v[j][3];
    ss = wave_sum_u(ss);
    return rsqrtf(ss * (1.f / 1024.f) + eps);
}
__device__ __forceinline__ void row_store_bf16(bf16_t* row, int lane, const f32x4 (&v)[4]) {
#pragma unroll
    for (int j = 0; j < 4; ++j) { u32x2 w; w.x = cvt_pk_bf16(v[j][0], v[j][1]); w.y = cvt_pk_bf16(v[j][2], v[j][3]); *(u32x2*)(row + j * 256 + lane * 4) = w; }
}

template <bool TO_BF16, bool SRC_BF16 = false>
__device__ __forceinline__ void phase_rmsnorm(const Params& p, const Frame& F, const void* src_, const float* w, void* dst) {
    const float* src = (const float*)src_; const bf16_t* srcb = (const bf16_t*)src_; (void)src; (void)srcb;
    f32x4 wv[4]; row_load(w, F.lane, wv);
    int row = F.bid * 8 + F.wave; const int stride = F.G * 8;
    f32x4 v[4], vn[4];
    if (row < T_TOK) { if constexpr (SRC_BF16) row_load_bf_nt(srcb + (size_t)row * DM, F.lane, v); else row_load_nt(src + (size_t)row * DM, F.lane, v); }
    for (; row < T_TOK; row += stride) {
        if (row + stride < T_TOK) { if constexpr (SRC_BF16) row_load_bf_nt(srcb + (size_t)(row + stride) * DM, F.lane, vn); else row_load_nt(src + (size_t)(row + stride) * DM, F.lane, vn); }
        const float rs = row_rstd(v, 1e-6f);
#pragma unroll
        for (int j = 0; j < 4; ++j) v[j] = v[j] * rs * wv[j];
        if constexpr (TO_BF16) row_store_bf16((bf16_t*)dst + (size_t)row * DM, F.lane, v);
        else {
#pragma unroll
            for (int j = 0; j < 4; ++j) *(f32x4*)((float*)dst + (size_t)row * DM + j * 256 + F.lane * 4) = v[j];
        }
#pragma unroll
        for (int j = 0; j < 4; ++j) v[j] = vn[j];
    }
}

__device__ __forceinline__ void phase_conv(const Params& p, const Frame& F) {
    bf16_t* proj = WSP(bf16_t, WS_SLAB);
    bf16_t* xc = (bf16_t*)F.out;
    const float* conv_w = p.in[5]; const float* conv_b = p.in[6];
    for (int item = F.bid * 8 + F.wave; item < (T_TOK / 32) * 3; item += F.G * 8) {
        const int run = item / 3, cb = item - run * 3, c0 = cb * 512 + F.lane * 8, t0 = run * 32;
        float w[4][8], bb[8], xm3[8], xm2[8], xm1[8];
#pragma unroll
        for (int j = 0; j < 4; ++j) { const f32x4 a0 = *(const f32x4*)(conv_w + j * 1536 + c0), a1 = *(const f32x4*)(conv_w + j * 1536 + c0 + 4);
#pragma unroll
            for (int e = 0; e < 4; ++e) { w[j][e] = a0[e]; w[j][4 + e] = a1[e]; } }
        { const f32x4 a0 = *(const f32x4*)(conv_b + c0), a1 = *(const f32x4*)(conv_b + c0 + 4);
#pragma unroll
            for (int e = 0; e < 4; ++e) { bb[e] = a0[e]; bb[4 + e] = a1[e]; } }
        const bool first = (t0 & (SEQ - 1)) == 0;
        { u32x4 r3 = (u32x4){0u, 0u, 0u, 0u}, r2 = r3, r1 = r3;
            if (!first) { r3 = __builtin_nontemporal_load((const u32x4*)(proj + (size_t)(t0 - 3) * NPROJ + PC_XBC + c0)); r2 = __builtin_nontemporal_load((const u32x4*)(proj + (size_t)(t0 - 2) * NPROJ + PC_XBC + c0)); r1 = __builtin_nontemporal_load((const u32x4*)(proj + (size_t)(t0 - 1) * NPROJ + PC_XBC + c0)); }
            xm3[0] = bflo(r3.x); xm3[1] = bfhi(r3.x); xm3[2] = bflo(r3.y); xm3[3] = bfhi(r3.y); xm3[4] = bflo(r3.z); xm3[5] = bfhi(r3.z); xm3[6] = bflo(r3.w); xm3[7] = bfhi(r3.w);
            xm2[0] = bflo(r2.x); xm2[1] = bfhi(r2.x); xm2[2] = bflo(r2.y); xm2[3] = bfhi(r2.y); xm2[4] = bflo(r2.z); xm2[5] = bfhi(r2.z); xm2[6] = bflo(r2.w); xm2[7] = bfhi(r2.w);
            xm1[0] = bflo(r1.x); xm1[1] = bfhi(r1.x); xm1[2] = bflo(r1.y); xm1[3] = bfhi(r1.y); xm1[4] = bflo(r1.z); xm1[5] = bfhi(r1.z); xm1[6] = bflo(r1.w); xm1[7] = bfhi(r1.w); }
#pragma unroll 4
        for (int tt = 0; tt < 32; ++tt) {
            const u32x4 r = __builtin_nontemporal_load((const u32x4*)(proj + (size_t)(t0 + tt) * NPROJ + PC_XBC + c0));
            const float x[8] = {bflo(r.x), bfhi(r.x), bflo(r.y), bfhi(r.y), bflo(r.z), bfhi(r.z), bflo(r.w), bfhi(r.w)};
            float o[8];
#pragma unroll
            for (int e = 0; e < 8; ++e) { o[e] = fsilu(bb[e] + w[0][e] * xm3[e] + w[1][e] * xm2[e] + w[2][e] * xm1[e] + w[3][e] * x[e]); xm3[e] = xm2[e]; xm2[e] = xm1[e]; xm1[e] = x[e]; }
            u32x4 ow; ow.x = cvt_pk_bf16(o[0], o[1]); ow.y = cvt_pk_bf16(o[2], o[3]); ow.z = cvt_pk_bf16(o[4], o[5]); ow.w = cvt_pk_bf16(o[6], o[7]);
            *(u32x4*)(xc + (size_t)(t0 + tt) * 1536 + c0) = ow;
        }
    }
}

typedef float f32x16 __attribute__((ext_vector_type(16)));
typedef short s16x4 __attribute__((ext_vector_type(4)));
#define MFMA32(a, b, c) __builtin_amdgcn_mfma_f32_32x32x16_bf16((a), (b), (c), 0, 0, 0)
__device__ __forceinline__ unsigned off_b(unsigned row, unsigned ch) { return 256u * row + 16u * (ch ^ (((row & 3u) << 2) | ((row >> 2) & 3u))); }
__device__ __forceinline__ unsigned off_v(unsigned row, unsigned ch) { return 128u * row + 16u * (ch ^ (((row >> 1) & 1u) << 2)); }
__device__ __forceinline__ unsigned off_y(unsigned row, unsigned ch) { return 128u * row + 16u * (ch ^ (row & 7u)); }
__device__ __forceinline__ bf16x8 tr_read2(unsigned a0, unsigned a1) {
    s16x4 lo, hi;
    asm volatile("ds_read_b64_tr_b16 %0, %2\n\tds_read_b64_tr_b16 %1, %3\n\ts_waitcnt lgkmcnt(0)" : "=&v"(lo), "=&v"(hi) : "v"(a0), "v"(a1) : "memory");
    return __builtin_shufflevector(lo, hi, 0, 1, 2, 3, 4, 5, 6, 7);
}
__device__ __forceinline__ void tr_read4(unsigned a0, unsigned a1, unsigned a2, unsigned a3, bf16x8& f0, bf16x8& f1) {
    s16x4 r0, r1, r2, r3;
    asm volatile("ds_read_b64_tr_b16 %0, %4\n\tds_read_b64_tr_b16 %1, %5\n\tds_read_b64_tr_b16 %2, %6\n\tds_read_b64_tr_b16 %3, %7\n\ts_waitcnt lgkmcnt(0)"
                 : "=&v"(r0), "=&v"(r1), "=&v"(r2), "=&v"(r3) : "v"(a0), "v"(a1), "v"(a2), "v"(a3) : "memory");
    f0 = __builtin_shufflevector(r0, r1, 0, 1, 2, 3, 4, 5, 6, 7); f1 = __builtin_shufflevector(r2, r3, 0, 1, 2, 3, 4, 5, 6, 7);
}
__device__ __forceinline__ void tr_read8(unsigned a0, unsigned a1, unsigned a2, unsigned a3, unsigned a4, unsigned a5, unsigned a6, unsigned a7, bf16x8& f0, bf16x8& f1, bf16x8& f2, bf16x8& f3) {
    s16x4 r0, r1, r2, r3, r4, r5, r6, r7;
    asm volatile("ds_read_b64_tr_b16 %0, %8\n\tds_read_b64_tr_b16 %1, %9\n\tds_read_b64_tr_b16 %2, %10\n\tds_read_b64_tr_b16 %3, %11\n\tds_read_b64_tr_b16 %4, %12\n\tds_read_b64_tr_b16 %5, %13\n\tds_read_b64_tr_b16 %6, %14\n\tds_read_b64_tr_b16 %7, %15\n\ts_waitcnt lgkmcnt(0)"
                 : "=&v"(r0), "=&v"(r1), "=&v"(r2), "=&v"(r3), "=&v"(r4), "=&v"(r5), "=&v"(r6), "=&v"(r7) : "v"(a0), "v"(a1), "v"(a2), "v"(a3), "v"(a4), "v"(a5), "v"(a6), "v"(a7) : "memory");
    f0 = __builtin_shufflevector(r0, r1, 0, 1, 2, 3, 4, 5, 6, 7); f1 = __builtin_shufflevector(r2, r3, 0, 1, 2, 3, 4, 5, 6, 7);
    f2 = __builtin_shufflevector(r4, r5, 0, 1, 2, 3, 4, 5, 6, 7); f3 = __builtin_shufflevector(r6, r7, 0, 1, 2, 3, 4, 5, 6, 7);
}
__device__ __forceinline__ f32x16 zero16() { f32x16 z;
#pragma unroll
    for (int i = 0; i < 16; ++i) z[i] = 0.f;
    return z; }
__device__ __forceinline__ void phase_scan0(const Params& p, const Frame& F) {
    bf16_t* proj = WSP(bf16_t, WS_SLAB);
    const bf16_t* xc = (const bf16_t*)F.out;
    constexpr unsigned OQ = 0, OK = 32768, OV = 65536, OVW = 81920, OS = 98304, OY = 114688, OSM = 131072;
    LAS unsigned char* L = F.lds;
    const unsigned lbase = (unsigned)(__UINTPTR_TYPE__)L;
    LAS float* sm = (LAS float*)(L + OSM);
    const int lane = F.lane, w = F.wave, it = w >> 1, pt = w & 1;
    const unsigned h0 = lane >> 5, lr0 = lane & 31;
    const int trow = F.tid >> 2, tpart = F.tid & 3;
    const unsigned blk0 = (lane >> 4) & 1u, tq0 = (lane & 15u) >> 2, tp0 = lane & 3u;
    for (int ui = 0; ui < 2; ++ui) {
        const int uu = F.bid + ui * F.G;
        if (uu >= 512) break;
        const bool is_ssd = uu < 256; const int v = uu & 255, x8 = v & 7, slot = v >> 3;
        int b, hh, grp = 0, hr = 0, sl = 0;
        if (is_ssd) { const int pg = x8 + 8 * (slot >> 3), hg = slot & 7; b = pg >> 1; grp = pg & 1; hh = grp * 8 + hg; }
        else { const int pr = x8 + 8 * (slot >> 2); sl = slot & 3; b = pr >> 2; hr = pr & 3; hh = hr * 4 + sl; }
        const size_t row0 = (size_t)b * SEQ;
        const bf16_t* qptr; const bf16_t* kptr; const bf16_t* vptr; size_t qs, vs; bf16_t* optr;
        if (is_ssd) { qptr = xc + 1280 + grp * 128; kptr = xc + 1024 + grp * 128; vptr = xc + hh * 64; qs = 1536; vs = 1536; optr = proj + hh * 64; }
        else { qptr = proj + PC_Q + hr * 128; kptr = proj + PC_K + hr * 128; vptr = proj + PC_V + hr * 256 + sl * 64; qs = NPROJ; vs = NPROJ; optr = proj + 1024 + hr * 256 + sl * 64; }
        const bf16_t* zptr = proj + hh * 64;
        const float A_h = is_ssd ? -__expf(p.in[8][hh]) : 0.f, dtb = is_ssd ? p.in[7][hh] : 0.f, D_h = is_ssd ? p.in[9][hh] : 0.f;
        const float lng = __logf(1.f - exp2f(-5.f - (float)hr));
        u32x4 rv[2], rz[2]; float rdt0 = 0.f, rdt1 = 0.f;
        f32x16 St0 = zero16(), St1 = zero16();
        __syncthreads();
        for (int i = F.tid; i < 16384 / 16; i += NTHREADS) *(LAS u32x4*)(L + OS + i * 16) = (u32x4){0u, 0u, 0u, 0u};
#define SC_LOAD(c) do { const size_t r_ = row0 + (size_t)(c) * 128 + trow; \
            _Pragma("unroll") for (int e = 0; e < 2; ++e) rv[e] = *(const u32x4*)(vptr + r_ * vs + tpart * 16 + e * 8); \
            if (is_ssd && w == 0) { rdt0 = bf2f(proj[(row0 + (size_t)(c) * 128 + 2 * lane) * NPROJ + PC_DT + hh]); rdt1 = bf2f(proj[(row0 + (size_t)(c) * 128 + 2 * lane + 1) * NPROJ + PC_DT + hh]); } } while (0)
#define SC_DMA(c) do { _Pragma("unroll") for (int e = 0; e < 4; ++e) { const int I_ = w * 4 + e; const unsigned r_ = 4u * I_ + ((unsigned)lane >> 4), cs_ = lane & 15u, ch_ = cs_ ^ (((r_ & 3u) << 2) | ((r_ >> 2) & 3u)); \
            const size_t g_ = (row0 + (size_t)(c) * 128 + r_) * qs + ch_ * 8; \
            __builtin_amdgcn_global_load_lds((const unsigned*)(qptr + g_), (LAS unsigned*)(L + OQ + I_ * 1024), 16, 0, 0); \
            __builtin_amdgcn_global_load_lds((const unsigned*)(kptr + g_), (LAS unsigned*)(L + OK + I_ * 1024), 16, 0, 0); } } while (0)
#define SC_LOADZ(c) do { if (is_ssd) { const size_t r_ = row0 + (size_t)(c) * 128 + trow; rz[0] = __builtin_nontemporal_load((const u32x4*)(zptr + r_ * NPROJ + tpart * 16)); rz[1] = __builtin_nontemporal_load((const u32x4*)(zptr + r_ * NPROJ + tpart * 16 + 8)); } } while (0)
#define SC_SMALL(c) do { if (w == 0) { LAS float* sb = sm + ((c) & 1) * 384; float d0, d1, a0, a1; \
            if (is_ssd) { d0 = fsoftplus(rdt0 + dtb); d1 = fsoftplus(rdt1 + dtb); a0 = d0 * A_h; a1 = d1 * A_h; } else { d0 = 1.f; d1 = 1.f; a0 = lng; a1 = lng; } \
            float sc = a0 + a1; _Pragma("unroll") for (int o = 1; o < 64; o <<= 1) { const float tv = __shfl_up(sc, o); if (lane >= o) sc += tv; } \
            const float c1 = sc, c0 = sc - a1; const float tot = __shfl(sc, 63); \
            sb[2 * lane] = c0; sb[2 * lane + 1] = c1; sb[128 + 2 * lane] = d0; sb[128 + 2 * lane + 1] = d1; sb[256 + 2 * lane] = __expf(tot - c0) * d0; sb[256 + 2 * lane + 1] = __expf(tot - c1) * d1; } } while (0)
#define SC_STORE(c) do { const float wj_ = sm[((c) & 1) * 384 + 256 + trow]; \
            _Pragma("unroll") for (int e = 0; e < 2; ++e) { const u32x4 x_ = rv[e]; *(LAS u32x4*)(L + OV + off_v(trow, tpart * 2 + e)) = x_; u32x4 y_; \
                y_.x = cvt_pk_bf16(bflo(x_.x) * wj_, bfhi(x_.x) * wj_); y_.y = cvt_pk_bf16(bflo(x_.y) * wj_, bfhi(x_.y) * wj_); y_.z = cvt_pk_bf16(bflo(x_.z) * wj_, bfhi(x_.z) * wj_); y_.w = cvt_pk_bf16(bflo(x_.w) * wj_, bfhi(x_.w) * wj_); \
                *(LAS u32x4*)(L + OVW + off_v(trow, tpart * 2 + e)) = y_; } } while (0)
        SC_DMA(0); SC_LOAD(0); SC_LOADZ(0);
        SC_SMALL(0);
        __syncthreads();
        SC_STORE(0);
        asm volatile("s_waitcnt vmcnt(0)" ::: "memory");
        __syncthreads();
        SP_DECL;
        for (int c = 0; c < SEQ / 128; ++c) {
            SP_MARK(8);
            const LAS float* sb = sm + (c & 1) * 384;
            unsigned lr = lr0, h = h0, blk = blk0, tq_ = tq0, tp_ = tp0;
            asm volatile("" : "+v"(lr), "+v"(h), "+v"(blk), "+v"(tq_), "+v"(tp_));
            if (c + 1 < SEQ / 128) { SC_LOAD(c + 1); }
            const int ph = pt;
            const float ai = sb[32 * it + lr];
            f32x16 Yd0 = zero16(), Yd1 = zero16();
            for (int jt = ph; jt <= it; jt += 2) {
                f32x16 acc = zero16();
#pragma unroll
                for (int ks = 0; ks < 8; ++ks) { const bf16x8 ka = *(const LAS bf16x8*)(L + OK + off_b(32 * jt + lr, 2 * ks + h)), qb = *(const LAS bf16x8*)(L + OQ + off_b(32 * it + lr, 2 * ks + h)); acc = MFMA32(ka, qb, acc); }
                const bool diag = (jt == it);
#pragma unroll
                for (int g = 0; g < 4; ++g) { const f32x4 aj = *(const LAS f32x4*)(sb + 32 * jt + 8 * g + 4 * h), dj = *(const LAS f32x4*)(sb + 128 + 32 * jt + 8 * g + 4 * h);
#pragma unroll
                    for (int e = 0; e < 4; ++e) { const float dec = __expf(ai - aj[e]) * dj[e]; const bool ok = !diag || ((int)lr >= (int)(8 * g + 4 * h + e)); acc[4 * g + e] = ok ? acc[4 * g + e] * dec : 0.f; } }
#pragma unroll
                for (int s2 = 0; s2 < 2; ++s2) {
                    u32x4 pw; pw.x = cvt_pk_bf16(acc[8 * s2 + 0], acc[8 * s2 + 1]); pw.y = cvt_pk_bf16(acc[8 * s2 + 2], acc[8 * s2 + 3]); pw.z = cvt_pk_bf16(acc[8 * s2 + 4], acc[8 * s2 + 5]); pw.w = cvt_pk_bf16(acc[8 * s2 + 6], acc[8 * s2 + 7]);
                    const bf16x8 Pb = __builtin_bit_cast(bf16x8, pw);
                    const unsigned rb0 = 32 * jt + 16 * s2 + 4 * h + tq_, cc0 = 2 * blk + (tp_ >> 1), o8 = 8 * (tp_ & 1);
                    bf16x8 va0, va1;
                    tr_read4(lbase + OV + off_v(rb0, cc0) + o8, lbase + OV + off_v(rb0 + 8, cc0) + o8, lbase + OV + off_v(rb0, 4 + cc0) + o8, lbase + OV + off_v(rb0 + 8, 4 + cc0) + o8, va0, va1);
                    Yd0 = MFMA32(va0, Pb, Yd0); Yd1 = MFMA32(va1, Pb, Yd1);
                }
            }
            {
                f32x16 Yo = zero16();
#pragma unroll
                for (int ks = 0; ks < 8; ++ks) { const bf16x8 sa = *(const LAS bf16x8*)(L + OS + off_b(32 * ph + lr, 2 * ks + h)), qb = *(const LAS bf16x8*)(L + OQ + off_b(32 * it + lr, 2 * ks + h)); Yo = MFMA32(sa, qb, Yo); }
                const float ei = __expf(ai);
                if (ph == 0) {
#pragma unroll
                    for (int r = 0; r < 16; ++r) Yd0[r] += Yo[r] * ei; }
                else {
#pragma unroll
                    for (int r = 0; r < 16; ++r) Yd1[r] += Yo[r] * ei; }
            }
#pragma unroll
            for (int g = 0; g < 4; ++g) { u32x2 yw;
                if (ph == 0) { yw.x = cvt_pk_bf16(Yd1[4 * g], Yd1[4 * g + 1]); yw.y = cvt_pk_bf16(Yd1[4 * g + 2], Yd1[4 * g + 3]); } else { yw.x = cvt_pk_bf16(Yd0[4 * g], Yd0[4 * g + 1]); yw.y = cvt_pk_bf16(Yd0[4 * g + 2], Yd0[4 * g + 3]); }
                *(LAS u32x2*)(L + OY + off_y(32 * it + lr, 4 * (1 - ph) + g) + 8 * h) = yw; }
            const float dl = __expf(sb[127]);
            const int st0 = (w == 0) ? 0 : (w == 1) ? 2 : (w == 2) ? 4 : (w == 3) ? 5 : (w == 5) ? 6 : -1, st1 = (w == 0) ? 1 : (w == 1) ? 3 : (w == 5) ? 7 : -1;
            if (st0 >= 0) {
                const int spt = st0 & 1, snt = st0 >> 1;
#pragma unroll
                for (int r = 0; r < 16; ++r) St0[r] *= dl;
#pragma unroll
                for (int k2 = 0; k2 < 4; ++k2) { const unsigned rb = 32 * k2 + 8 * h + tq_, cv = 4 * spt + 2 * blk + (tp_ >> 1), cb = 4 * snt + 2 * blk + (tp_ >> 1), o8 = 8 * (tp_ & 1);
                    bf16x8 fa0, fb0, fa1, fb1;
                    tr_read8(lbase + OVW + off_v(rb, cv) + o8, lbase + OVW + off_v(rb + 4, cv) + o8, lbase + OK + off_b(rb, cb) + o8, lbase + OK + off_b(rb + 4, cb) + o8,
                             lbase + OVW + off_v(rb + 16, cv) + o8, lbase + OVW + off_v(rb + 20, cv) + o8, lbase + OK + off_b(rb + 16, cb) + o8, lbase + OK + off_b(rb + 20, cb) + o8, fa0, fb0, fa1, fb1);
                    St0 = MFMA32(fa0, fb0, St0); St0 = MFMA32(fa1, fb1, St0); }
                if (st1 >= 0) {
                    const int spt1 = st1 & 1, snt1 = st1 >> 1;
#pragma unroll
                    for (int r = 0; r < 16; ++r) St1[r] *= dl;
#pragma unroll
                    for (int k2 = 0; k2 < 4; ++k2) { const unsigned rb = 32 * k2 + 8 * h + tq_, cv = 4 * spt1 + 2 * blk + (tp_ >> 1), cb = 4 * snt1 + 2 * blk + (tp_ >> 1), o8 = 8 * (tp_ & 1);
                        bf16x8 fa0, fb0, fa1, fb1;
                        tr_read8(lbase + OVW + off_v(rb, cv) + o8, lbase + OVW + off_v(rb + 4, cv) + o8, lbase + OK + off_b(rb, cb) + o8, lbase + OK + off_b(rb + 4, cb) + o8,
                                 lbase + OVW + off_v(rb + 16, cv) + o8, lbase + OVW + off_v(rb + 20, cv) + o8, lbase + OK + off_b(rb + 16, cb) + o8, lbase + OK + off_b(rb + 20, cb) + o8, fa0, fb0, fa1, fb1);
                        St1 = MFMA32(fa0, fb0, St1); St1 = MFMA32(fa1, fb1, St1); }
                }
            }
            if (c + 1 < SEQ / 128) SC_SMALL(c + 1);
            __syncthreads();
#pragma unroll
            for (int g = 0; g < 4; ++g) { LAS u32x2* yp = (LAS u32x2*)(L + OY + off_y(32 * it + lr, 4 * ph + g) + 8 * h); const u32x2 pv_ = *yp; u32x2 yw;
                if (ph == 0) { yw.x = cvt_pk_bf16(Yd0[4 * g] + bflo(pv_.x), Yd0[4 * g + 1] + bfhi(pv_.x)); yw.y = cvt_pk_bf16(Yd0[4 * g + 2] + bflo(pv_.y), Yd0[4 * g + 3] + bfhi(pv_.y)); }
                else { yw.x = cvt_pk_bf16(Yd1[4 * g] + bflo(pv_.x), Yd1[4 * g + 1] + bfhi(pv_.x)); yw.y = cvt_pk_bf16(Yd1[4 * g + 2] + bflo(pv_.y), Yd1[4 * g + 3] + bfhi(pv_.y)); }
                *yp = yw; }
            __syncthreads();
            SP_MARK(5);
            if (c + 1 < SEQ / 128) SC_DMA(c + 1);
            if (st0 >= 0) {
                const int spt = st0 & 1, snt = st0 >> 1;
#pragma unroll
                for (int r = 0; r < 16; ++r) { const unsigned pr = 32 * spt + (r & 3) + 8 * (r >> 2) + 4 * h, n = 32 * snt + lr; *(LAS bf16_t*)(L + OS + off_b(pr, n >> 3) + 2 * (n & 7)) = f2bf(St0[r]); }
                if (st1 >= 0) { const int spt1 = st1 & 1, snt1 = st1 >> 1;
#pragma unroll
                    for (int r = 0; r < 16; ++r) { const unsigned pr = 32 * spt1 + (r & 3) + 8 * (r >> 2) + 4 * h, n = 32 * snt1 + lr; *(LAS bf16_t*)(L + OS + off_b(pr, n >> 3) + 2 * (n & 7)) = f2bf(St1[r]); }
                }
            }
            {
                bf16_t* orow = optr + (row0 + (size_t)c * 128 + trow) * NPROJ + tpart * 16;
#pragma unroll
                for (int e = 0; e < 2; ++e) {
                    const u32x4 yv = *(const LAS u32x4*)(L + OY + off_y(trow, tpart * 2 + e));
                    u32x4 ov = yv;
                    if (is_ssd) { const u32x4 xv = *(const LAS u32x4*)(L + OV + off_v(trow, tpart * 2 + e)); const u32x4 zv = rz[e];
                        ov.x = cvt_pk_bf16((bflo(yv.x) + bflo(xv.x) * D_h) * fsilu(bflo(zv.x)), (bfhi(yv.x) + bfhi(xv.x) * D_h) * fsilu(bfhi(zv.x)));
                        ov.y = cvt_pk_bf16((bflo(yv.y) + bflo(xv.y) * D_h) * fsilu(bflo(zv.y)), (bfhi(yv.y) + bfhi(xv.y) * D_h) * fsilu(bfhi(zv.y)));
                        ov.z = cvt_pk_bf16((bflo(yv.z) + bflo(xv.z) * D_h) * fsilu(bflo(zv.z)), (bfhi(yv.z) + bfhi(xv.z) * D_h) * fsilu(bfhi(zv.z)));
                        ov.w = cvt_pk_bf16((bflo(yv.w) + bflo(xv.w) * D_h) * fsilu(bflo(zv.w)), (bfhi(yv.w) + bfhi(xv.w) * D_h) * fsilu(bfhi(zv.w))); }
                    *(u32x4*)(orow + e * 8) = ov;
                }
            }
            if (c + 1 < SEQ / 128) { SC_LOADZ(c + 1); }
            __syncthreads();
            SP_MARK(6);
            if (c + 1 < SEQ / 128) SC_STORE(c + 1);
            asm volatile("s_waitcnt vmcnt(0)" ::: "memory");
            __syncthreads();
            SP_MARK(7);
        }
#undef SC_LOAD
#undef SC_LOADZ
#undef SC_SMALL
#undef SC_STORE
    }
}

__device__ __forceinline__ void phase_gatenorm(const Params& p, const Frame& F) {
    const bf16_t* proj = WSP(bf16_t, WS_SLAB);
    bf16_t* ybuf = WSP(bf16_t, WS_SLAB);
    const float* nw = p.in[10];
    int row = F.bid * 8 + F.wave; const int stride = F.G * 8;
    u32x4 yc[4], gc[2], yn[4], gn[2];
#define GN_LOAD(r_, Y_, G_) do { const bf16_t* b_ = ybuf + (size_t)(r_) * NPROJ; _Pragma("unroll") for (int j = 0; j < 4; ++j) Y_[j] = *(const u32x4*)(b_ + j * 512 + F.lane * 8); \
        _Pragma("unroll") for (int j = 0; j < 2; ++j) G_[j] = __builtin_nontemporal_load((const u32x4*)(b_ + PC_G + j * 512 + F.lane * 8)); } while (0)
    if (row < T_TOK) GN_LOAD(row, yc, gc);
    for (; row < T_TOK; row += stride) {
        if (row + stride < T_TOK) GN_LOAD(row + stride, yn, gn);
        bf16_t* yr = ybuf + (size_t)row * NPROJ;
#pragma unroll
        for (int j = 0; j < 4; ++j) {
            const u32x4 w = yc[j];
            float x[8] = {bflo(w.x), bfhi(w.x), bflo(w.y), bfhi(w.y), bflo(w.z), bfhi(w.z), bflo(w.w), bfhi(w.w)};
            float ss = 0.f;
#pragma unroll
            for (int e = 0; e < 8; ++e) ss += x[e] * x[e];
            if (j < 2) { ss = wave_sum_u(ss); const float rs = rsqrtf(ss * (1.f / 512.f) + 1e-5f);
                const f32x4 w0 = *(const f32x4*)(nw + j * 512 + F.lane * 8), w1 = *(const f32x4*)(nw + j * 512 + F.lane * 8 + 4);
#pragma unroll
                for (int e = 0; e < 4; ++e) { x[e] *= rs * w0[e]; x[4 + e] *= rs * w1[e]; } }
            else {
                ss = dpp_sum16(ss); ss += __shfl_xor(ss, 16);
                const float rs = rsqrtf(ss * (1.f / 256.f) + 1e-6f);
                const u32x4 gw = gc[j - 2];
                const float g[8] = {bflo(gw.x), bfhi(gw.x), bflo(gw.y), bfhi(gw.y), bflo(gw.z), bfhi(gw.z), bflo(gw.w), bfhi(gw.w)};
#pragma unroll
                for (int e = 0; e < 8; ++e) x[e] *= rs * fsilu(g[e]); }
            u32x4 o; o.x = cvt_pk_bf16(x[0], x[1]); o.y = cvt_pk_bf16(x[2], x[3]); o.z = cvt_pk_bf16(x[4], x[5]); o.w = cvt_pk_bf16(x[6], x[7]);
            *(u32x4*)(yr + j * 512 + F.lane * 8) = o;
        }
#pragma unroll
        for (int j = 0; j < 4; ++j) yc[j] = yn[j];
        gc[0] = gn[0]; gc[1] = gn[1];
    }
#undef GN_LOAD
}

__device__ __forceinline__ void phase_moe_route(const Params& p, const Frame& F, int layer, const bf16_t* h, bf16_t* tbuf) {
    unsigned char* meta = F.ws + WS_META + (size_t)layer * META_STRIDE;
    int* tok_rank = (int*)(meta + MT_RANK); int* tok_bkt = (int*)(meta + MT_BKT); f32x2* tok_c = (f32x2*)(meta + MT_C);
    int* gcount = (int*)(F.ws + WS_CTL + CTL_CNT_OFF) + layer * 32;
    const float* bg = p.in[31] + layer * 4; const float* be = p.in[33] + layer * 16;
    LAS float* wl = (LAS float*)F.lds;
    LAS int* lcount = (LAS int*)(F.lds + 81920);
    LAS int* lbase = lcount + 32;
    LAS int* l_bkt = lbase + 32;
    LAS int* l_rank = l_bkt + 1024;
    LAS float* l_c = (LAS float*)(l_rank + 1024);
    LAS float* lgt = (LAS float*)(F.lds + 98816);
    __syncthreads();
    { const float* wrt = WSP(float, WS_RTW) + (size_t)layer * 20480;
        for (int idx = F.tid; idx < 20 * 1024 / 4; idx += NTHREADS) *(LAS f32x4*)(wl + idx * 4) = *(const f32x4*)(wrt + idx * 4); }
    if (F.tid < 32) lcount[F.tid] = 0;
    __syncthreads();
    const int TPB = (T_TOK + F.G - 1) / F.G, tok0 = F.bid * TPB;
    f32x4 wv[4]; row_load(p.in[2] + (size_t)layer * DM, F.lane, wv);
    f32x4 va[4], vb[4], na[4], nb[4];
    int hsel;
    { unsigned t0_ = 0u, t1_ = 1u; asm volatile("s_nop 1\n\tv_permlane32_swap_b32 %0, %1\n\ts_nop 1" : "+v"(t0_), "+v"(t1_)); hsel = (t0_ + t1_ >= 2u) ? 10 : 0; }
#define RT_LOAD(li_, A_, B_) do { const int ta_ = tok0 + (li_), tb_ = ta_ + 8; \
        if ((li_) < TPB && ta_ < T_TOK) row_load_bf_nt(h + (size_t)ta_ * DM, F.lane, A_); if ((li_) + 8 < TPB && tb_ < T_TOK) row_load_bf_nt(h + (size_t)tb_ * DM, F.lane, B_); } while (0)
    RT_LOAD(F.wave, va, vb);
    for (int li = F.wave; li < TPB; li += 16) {
        const int tok = tok0 + li; if (tok >= T_TOK) break;
        const bool hasb = (li + 8 < TPB) && (tok + 8 < T_TOK);
        RT_LOAD(li + 16, na, nb);
        const float rsa = row_rstd(va, 1e-6f), rsb = row_rstd(vb, 1e-6f);
#pragma unroll
        for (int j = 0; j < 4; ++j) { va[j] = va[j] * rsa * wv[j]; vb[j] = vb[j] * rsb * wv[j]; }
        row_store_bf16(tbuf + (size_t)tok * DM, F.lane, va);
        if (hasb) row_store_bf16(tbuf + (size_t)(tok + 8) * DM, F.lane, vb);
        LAS float* lga = lgt + li * 20; LAS float* lgb = lgt + (li + 8) * 20;
#pragma unroll
        for (int o = 0; o < 10; ++o) { f32x2 c0 = (f32x2){0.f, 0.f}, c1 = c0, d0 = c0, d1 = c0;
#pragma unroll
            for (int j = 0; j < 4; ++j) { const f32x4 w4 = *(const LAS f32x4*)(wl + o * 1024 + j * 256 + F.lane * 4), w5 = *(const LAS f32x4*)(wl + (o + 10) * 1024 + j * 256 + F.lane * 4);
                const f32x2 w4l = (f32x2){w4[0], w4[1]}, w4h = (f32x2){w4[2], w4[3]}, w5l = (f32x2){w5[0], w5[1]}, w5h = (f32x2){w5[2], w5[3]};
                const f32x2 al = (f32x2){va[j][0], va[j][1]}, ah = (f32x2){va[j][2], va[j][3]}, bl = (f32x2){vb[j][0], vb[j][1]}, bh = (f32x2){vb[j][2], vb[j][3]};
                c0 += al * w4l; c0 += ah * w4h; c1 += al * w5l; c1 += ah * w5h; d0 += bl * w4l; d0 += bh * w4h; d1 += bl * w5l; d1 += bh * w5h; }
            float a0 = c0[0] + c0[1], a1 = c1[0] + c1[1], b0 = d0[0] + d0[1], b1 = d1[0] + d1[1];
            asm volatile("s_nop 1\n\tv_permlane32_swap_b32 %0, %1\n\tv_permlane32_swap_b32 %2, %3\n\ts_nop 1" : "+v"(a0), "+v"(a1), "+v"(b0), "+v"(b1));
            float sa = dpp_sum16(a0 + a1), sb_ = dpp_sum16(b0 + b1);
            sa += __builtin_bit_cast(float, __builtin_amdgcn_update_dpp(0, __builtin_bit_cast(int, sa), 0x142, 0xA, 0xF, false));
            sb_ += __builtin_bit_cast(float, __builtin_amdgcn_update_dpp(0, __builtin_bit_cast(int, sb_), 0x142, 0xA, 0xF, false));
            if ((F.lane & 31) == 16) { lga[hsel + o] = sa; if (hasb) lgb[hsel + o] = sb_; }
            if (o & 1) __builtin_amdgcn_sched_barrier(0); }
#pragma unroll
        for (int j = 0; j < 4; ++j) { va[j] = na[j]; vb[j] = nb[j]; }
    }
#undef RT_LOAD
    __syncthreads();
    for (int li = F.tid; li < TPB; li += NTHREADS) {
        if (tok0 + li >= T_TOK) break;
        float lg[20];
#pragma unroll
        for (int o = 0; o < 20; ++o) lg[o] = lgt[li * 20 + o];
        float g0 = lg[0] + bg[0], g1 = lg[1] + bg[1], g2 = lg[2] + bg[2], g3 = lg[3] + bg[3];
        int gi = 0; float gm = g0; if (g1 > gm) { gm = g1; gi = 1; } if (g2 > gm) { gm = g2; gi = 2; } if (g3 > gm) { gm = g3; gi = 3; }
        const float gate = 1.f / (__expf(g0 - gm) + __expf(g1 - gm) + __expf(g2 - gm) + __expf(g3 - gm));
        float e0, e1, e2, e3;
        e0 = (gi == 0) ? lg[4] : (gi == 1) ? lg[8] : (gi == 2) ? lg[12] : lg[16];
        e1 = (gi == 0) ? lg[5] : (gi == 1) ? lg[9] : (gi == 2) ? lg[13] : lg[17];
        e2 = (gi == 0) ? lg[6] : (gi == 1) ? lg[10] : (gi == 2) ? lg[14] : lg[18];
        e3 = (gi == 0) ? lg[7] : (gi == 1) ? lg[11] : (gi == 2) ? lg[15] : lg[19];
        e0 += be[gi * 4 + 0]; e1 += be[gi * 4 + 1]; e2 += be[gi * 4 + 2]; e3 += be[gi * 4 + 3];
        int i1 = 0; float v1 = e0; if (e1 > v1) { v1 = e1; i1 = 1; } if (e2 > v1) { v1 = e2; i1 = 2; } if (e3 > v1) { v1 = e3; i1 = 3; }
        int i2 = -1; float v2 = -3.0e38f;
        if (i1 != 0 && e0 > v2) { v2 = e0; i2 = 0; } if (i1 != 1 && e1 > v2) { v2 = e1; i2 = 1; } if (i1 != 2 && e2 > v2) { v2 = e2; i2 = 2; } if (i1 != 3 && e3 > v2) { v2 = e3; i2 = 3; }
        const float w1 = gate / (1.f + __expf(v2 - v1)), w2 = gate - w1;
        const int lo = i1 < i2 ? i1 : i2, hi = i1 < i2 ? i2 : i1; const float clo = i1 < i2 ? w1 : w2, chi = i1 < i2 ? w2 : w1;
        const int pr = (lo == 0) ? hi - 1 : (lo == 1) ? hi + 1 : 5;
        const int bk = gi * 6 + pr;
        l_bkt[li] = bk; l_c[li * 2] = clo; l_c[li * 2 + 1] = chi;
        l_rank[li] = __hip_atomic_fetch_add((int*)(lcount + bk), 1, __ATOMIC_RELAXED, __HIP_MEMORY_SCOPE_WORKGROUP);
    }
    __syncthreads();
    if (F.tid < 24) lbase[F.tid] = __hip_atomic_fetch_add(gcount + F.tid, lcount[F.tid], __ATOMIC_RELAXED, __HIP_MEMORY_SCOPE_AGENT);
    __syncthreads();
    for (int li = F.tid; li < TPB; li += NTHREADS) { const int tok = tok0 + li; if (tok < T_TOK) { const int bk = l_bkt[li]; tok_bkt[tok] = bk; tok_rank[tok] = lbase[bk] + l_rank[li]; tok_c[tok] = (f32x2){l_c[li * 2], l_c[li * 2 + 1]}; } }
}
__device__ __forceinline__ void phase_moe_slots(const Params& p, const Frame& F, int layer) {
    unsigned char* meta = F.ws + WS_META + (size_t)layer * META_STRIDE;
    const int* tok_rank = (const int*)(meta + MT_RANK); const int* tok_bkt = (const int*)(meta + MT_BKT); const f32x2* tok_c = (const f32x2*)(meta + MT_C);
    int* slot_tok = (int*)(meta + MT_STOK); f32x2* slot_c = (f32x2*)(meta + MT_SC); int* tile_tab = (int*)(meta + MT_TILE);
    int* gcount = (int*)(F.ws + WS_CTL + CTL_CNT_OFF) + layer * 32;
    LAS int* cnt = (LAS int*)F.lds; LAS int* start = cnt + 32;
    __syncthreads();
    if (F.tid < 24) cnt[F.tid] = __hip_atomic_load(gcount + F.tid, __ATOMIC_RELAXED, __HIP_MEMORY_SCOPE_AGENT);
    __syncthreads();
    if (F.tid == 0) { int a = 0; for (int b = 0; b < 24; ++b) { start[b] = a; a += (cnt[b] + 255) >> 8; } start[24] = a; }
    __syncthreads();
    for (int tok = F.bid * NTHREADS + F.tid; tok < T_TOK; tok += F.G * NTHREADS) { const int bk = tok_bkt[tok]; const int slot = start[bk] * 256 + tok_rank[tok]; slot_tok[slot] = tok; slot_c[slot] = tok_c[tok]; }
    for (int b = F.bid; b < 24; b += F.G) { const int s0 = start[b] * 256 + cnt[b], s1 = start[b + 1] * 256;
        for (int s = s0 + F.tid; s < s1; s += NTHREADS) { slot_tok[s] = -1; slot_c[s] = (f32x2){0.f, 0.f}; } }
    if (F.bid == 0) { if (F.tid == 0) tile_tab[0] = start[24];
        for (int m = F.tid; m < 288; m += NTHREADS) { int bk = 23; for (int b = 0; b < 24; ++b) if (m >= start[b] && m < start[b + 1]) bk = b; tile_tab[64 + m] = bk; } }
}

template <int SET>
__device__ __forceinline__ void phase_mix(const Params& p, const Frame& F, const bf16_t* h, bf16_t* o0, bf16_t* o1, bf16_t* o2) {
    const float* mu = p.in[12];
    constexpr int M0 = SET ? 0 : 1, M1 = SET ? 2 : 4, M2 = SET ? 3 : 5;
    f32x4 wv[4], m0[4], m1[4], m2[4];
    row_load(p.in[1] + DM, F.lane, wv); row_load(mu + M0 * DM, F.lane, m0); row_load(mu + M1 * DM, F.lane, m1); row_load(mu + M2 * DM, F.lane, m2);
    for (int run = F.bid * 8 + F.wave; run < T_TOK / 32; run += F.G * 8) {
        const int t0 = run * 32;
        f32x4 up[4];
        if ((t0 & (SEQ - 1)) == 0) {
#pragma unroll
            for (int j = 0; j < 4; ++j) up[j] = (f32x4){0.f, 0.f, 0.f, 0.f};
        } else { row_load_bf(h + (size_t)(t0 - 1) * DM, F.lane, up); const float rs = row_rstd(up, 1e-6f);
#pragma unroll
            for (int j = 0; j < 4; ++j) up[j] = up[j] * rs * wv[j]; }
        f32x4 u[4], un[4]; if constexpr (SET == 1) row_load_bf_nt(h + (size_t)t0 * DM, F.lane, u); else row_load_bf(h + (size_t)t0 * DM, F.lane, u);
        for (int tt = 0; tt < 32; ++tt) {
            if (tt + 1 < 32) { if constexpr (SET == 1) row_load_bf_nt(h + (size_t)(t0 + tt + 1) * DM, F.lane, un); else row_load_bf(h + (size_t)(t0 + tt + 1) * DM, F.lane, un); }
            const float rs = row_rstd(u, 1e-6f);
            f32x4 a[4], b[4], c[4];
#pragma unroll
            for (int j = 0; j < 4; ++j) { u[j] = u[j] * rs * wv[j]; const f32x4 xx = up[j] - u[j]; a[j] = u[j] + xx * m0[j]; b[j] = u[j] + xx * m1[j]; c[j] = u[j] + xx * m2[j]; up[j] = u[j]; }
            row_store_bf16(o0 + (size_t)(t0 + tt) * DM, F.lane, a); row_store_bf16(o1 + (size_t)(t0 + tt) * DM, F.lane, b); row_store_bf16(o2 + (size_t)(t0 + tt) * DM, F.lane, c);
#pragma unroll
            for (int j = 0; j < 4; ++j) u[j] = un[j];
        }
    }
}

typedef __bf16 bf16x2v __attribute__((ext_vector_type(2)));
__device__ __forceinline__ unsigned pkc(float lo, float hi) { f32x2 t = {lo, hi}; bf16x2v r = __builtin_convertvector(t, bf16x2v); return __builtin_bit_cast(unsigned, r); }
__device__ __forceinline__ unsigned off_r(unsigned row, unsigned ch) { return row * 128u + 16u * (ch ^ ((row >> 1) & 7u)); }
__device__ __forceinline__ unsigned off_m(unsigned row, unsigned ch) { return row * 64u + 16u * (ch ^ ((0u - (row >> 2)) & 3u)); }
#define MFMA16(a, b, c) __builtin_amdgcn_mfma_f32_16x16x32_bf16((a), (b), (c), 0, 0, 0)
__device__ __forceinline__ void swap32(float& a, float& b) { asm volatile("s_nop 1\n\tv_permlane32_swap_b32 %0, %1\n\ts_nop 1" : "+v"(a), "+v"(b)); }
__device__ __forceinline__ float half_sum(float x, bool hf) {
    x = dpp_sum16(x);
    x += __builtin_bit_cast(float, __builtin_amdgcn_update_dpp(0, __builtin_bit_cast(int, x), 0x142, 0xA, 0xF, false));
    const float lo = __builtin_bit_cast(float, __builtin_amdgcn_readlane(__builtin_bit_cast(int, x), 31)), hi = __builtin_bit_cast(float, __builtin_amdgcn_readlane(__builtin_bit_cast(int, x), 63));
    return hf ? hi : lo;
}
__device__ __forceinline__ void phase_rwkv(const Params& p, const Frame& F, bf16_t* rbuf, const bf16_t* kbuf, const bf16_t* vbuf, const bf16_t* ebuf, const bf16_t* abuf, const bf16_t* gbuf) {
    constexpr unsigned ORA = 0, OLB = 16384, OMS = 32768, OMU = 49152, OMY = 53248, OAB = 57344, OAK = 61440, OVT = 65536, OGC = 73728, OYS = 74752, OVF = 91136, OGG = 107520, OBON = 123904;
    LAS unsigned char* L = F.lds;
    const float* k_k = p.in[25]; const float* k_a = p.in[26]; const float* r_k = p.in[27]; const float* lnw = p.in[28]; const float* lnb = p.in[29];
    const int lane0 = F.lane, w = F.wave, pc = w >> 1, th = w & 1;
    for (int unit = F.bid; unit < 256; unit += F.G) {
        const int b = unit >> 4, hd = unit & 15;
        const int gc2 = hd * 64 + 2 * (lane0 & 31);
        const f32x2 kkw = *(const f32x2*)(k_k + gc2), kaw = *(const f32x2*)(k_a + gc2), rkw = *(const f32x2*)(r_k + gc2), lw = *(const f32x2*)(lnw + gc2), lb = *(const f32x2*)(lnb + gc2);
        int lane = lane0;
        f32x4 St[4];
#pragma unroll
        for (int mt = 0; mt < 4; ++mt) St[mt] = (f32x4){0.f, 0.f, 0.f, 0.f};
        unsigned pr[4], pk[4], pv[4], pe[4], pa[4], pg[4], pe0[4];
#define RW_LOAD(t0_) do { const size_t ub_ = ((size_t)b * SEQ + (t0_) + 16 * pc + 8 * th) * DM + hd * 64, ub0_ = ((size_t)b * SEQ + (t0_) + 16 * pc) * DM + hd * 64;     \
            const bf16_t* r_ = rbuf + ub_; const bf16_t* k_ = kbuf + ub_; const bf16_t* v_ = vbuf + ub_; const bf16_t* e_ = ebuf + ub_; const bf16_t* a_ = abuf + ub_; const bf16_t* g_ = gbuf + ub_; const bf16_t* e0_ = ebuf + ub0_; \
            _Pragma("unroll") for (int it = 0; it < 4; ++it) { const unsigned lo_ = (unsigned)((4 * (lane >> 5) + it) * DM + 2 * (lane & 31)); \
            pr[it] = __builtin_nontemporal_load((const unsigned*)(r_ + lo_)); pk[it] = __builtin_nontemporal_load((const unsigned*)(k_ + lo_)); pv[it] = __builtin_nontemporal_load((const unsigned*)(v_ + lo_)); pe[it] = __builtin_nontemporal_load((const unsigned*)(e_ + lo_)); pa[it] = __builtin_nontemporal_load((const unsigned*)(a_ + lo_)); pg[it] = __builtin_nontemporal_load((const unsigned*)(g_ + lo_)); pe0[it] = *(const unsigned*)(e0_ + lo_); } } while (0)
        RW_LOAD(0);
        SP_DECL;
        for (int t0 = 0; t0 < SEQ; t0 += 64) {
            __syncthreads();
            SP_MARK(4);
            asm volatile("" : "+v"(lane));
            const unsigned l15 = lane & 15, q = (unsigned)lane >> 4, cp = lane & 31;
            const bool hf = lane >= 32;
            const unsigned pj = 32u * (cp >> 4) + 8u * ((cp & 7) >> 1) + 2u * (cp & 1) + ((cp & 8) ? 4u : 0u);
            {
                float pl0[4], pl1[4], ls0 = 0.f, ls1 = 0.f, f0 = 0.f, f1 = 0.f;
#pragma unroll
                for (int it = 0; it < 4; ++it) { ls0 += bflo(pe[it]); ls1 += bfhi(pe[it]); pl0[it] = ls0; pl1[it] = ls1; f0 += bflo(pe0[it]); f1 += bfhi(pe0[it]); }
                float xa0 = 0.f, xb0 = ls0, xa1 = 0.f, xb1 = ls1; swap32(xa0, xb0); swap32(xa1, xb1);
                float ya0 = f0, yb0 = f0, ya1 = f1, yb1 = f1; swap32(ya0, yb0); swap32(ya1, yb1);
                const float base0 = xa0 + (th ? f0 + (hf ? ya0 : yb0) : 0.f), base1 = xa1 + (th ? f1 + (hf ? ya1 : yb1) : 0.f);
                float ms0[8], ms1[8], vt0[4], vt1[4];
                LAS unsigned char* ra = L + ORA + pc * 4096; LAS unsigned char* lbp = L + OLB + pc * 4096;
#pragma unroll
                for (int it = 0; it < 4; ++it) {
                    const int t = 8 * th + 4 * (int)hf + it, tb = 16 * pc + t;
                    const float r0 = bflo(pr[it]), r1 = bfhi(pr[it]), k0 = bflo(pk[it]), k1 = bfhi(pk[it]), a0 = bflo(pa[it]), a1 = bfhi(pa[it]);
                    const float kv0 = k0 * kkw[0], kv1 = k1 * kkw[1]; const float ss = half_sum(kv0 * kv0 + kv1 * kv1, hf); const float rn = rsqrtf(fmaxf(ss, 1e-24f));
                    const float kk0 = kv0 * rn, kk1 = kv1 * rn;
                    const float kp0 = k0 * (1.f + (a0 - 1.f) * kaw[0]), kp1 = k1 * (1.f + (a1 - 1.f) * kaw[1]);
                    const float bon = half_sum(r0 * kp0 * rkw[0] + r1 * kp1 * rkw[1], hf);
                    const float lp0 = -(base0 + (it ? pl0[it ? it - 1 : 0] : 0.f)), lp1 = -(base1 + (it ? pl1[it ? it - 1 : 0] : 0.f)), lc0 = -(base0 + pl0[it]), lc1 = -(base1 + pl1[it]);
                    const float ea0 = __expf(lp0), ea1 = __expf(lp1), eb0 = __expf(lc0), eb1 = __expf(lc1), ei0 = __expf(-lc0), ei1 = __expf(-lc1);
                    const float bt0 = kk0 * a0 * ei0, bt1 = kk1 * a1 * ei1, kt0 = kp0 * ei0, kt1 = kp1 * ei1;
                    *(LAS unsigned*)(ra + off_r(t, pj >> 3) + 2 * (pj & 7)) = pkc(-kk0 * ea0, -kk1 * ea1); *(LAS unsigned*)(ra + off_r(16 + t, pj >> 3) + 2 * (pj & 7)) = pkc(r0 * eb0, r1 * eb1);
                    *(LAS unsigned*)(lbp + off_r(t, pj >> 3) + 2 * (pj & 7)) = pkc(bt0, bt1); *(LAS unsigned*)(lbp + off_r(16 + t, pj >> 3) + 2 * (pj & 7)) = pkc(kt0, kt1);
                    ms0[it] = bt0; ms0[4 + it] = kt0; ms1[it] = bt1; ms1[4 + it] = kt1; vt0[it] = bflo(pv[it]); vt1[it] = bfhi(pv[it]);
                    *(LAS f32x2*)(L + OVF + (tb * 64 + 2 * cp) * 4) = (f32x2){bflo(pv[it]), bfhi(pv[it])}; *(LAS f32x2*)(L + OGG + (tb * 64 + 2 * cp) * 4) = (f32x2){bflo(pg[it]), bfhi(pg[it])};
                    if (cp == 0) *(LAS float*)(L + OBON + tb * 4) = bon;
                    if (it == 3 && th && hf) *(LAS f32x2*)(L + OGC + pc * 256 + 2 * cp * 4) = (f32x2){eb0, eb1};
                }
                { u32x4 m0, m1; m0.x = pkc(ms0[0], ms0[1]); m0.y = pkc(ms0[2], ms0[3]); m0.z = pkc(ms0[4], ms0[5]); m0.w = pkc(ms0[6], ms0[7]); m1.x = pkc(ms1[0], ms1[1]); m1.y = pkc(ms1[2], ms1[3]); m1.z = pkc(ms1[4], ms1[5]); m1.w = pkc(ms1[6], ms1[7]);
                  *(LAS u32x4*)(L + OMS + pc * 4096 + off_m(2 * cp, 2 * th + (unsigned)hf)) = m0; *(LAS u32x4*)(L + OMS + pc * 4096 + off_m(2 * cp + 1, 2 * th + (unsigned)hf)) = m1;
                  u32x2 w0, w1; w0.x = pkc(vt0[0], vt0[1]); w0.y = pkc(vt0[2], vt0[3]); w1.x = pkc(vt1[0], vt1[1]); w1.y = pkc(vt1[2], vt1[3]);
                  *(LAS u32x2*)(L + OVT + pc * 2048 + (2 * cp) * 32 + (8 * th + 4 * (unsigned)hf) * 2) = w0; *(LAS u32x2*)(L + OVT + pc * 2048 + (2 * cp + 1) * 32 + (8 * th + 4 * (unsigned)hf) * 2) = w1; }
            }
            if (t0 + 64 < SEQ) RW_LOAD(t0 + 64);
            __syncthreads();
            SP_MARK(1);
            if (w < 4) {
                {
                    const int c = w;
                    f32x4 g00 = (f32x4){0.f, 0.f, 0.f, 0.f}, g01 = g00, g10 = g00, g11 = g00;
#pragma unroll
                    for (int ks = 0; ks < 2; ++ks) {
                        const bf16x8 a0 = *(const LAS bf16x8*)(L + OLB + c * 4096 + off_r(l15, 4 * ks + q)), a1 = *(const LAS bf16x8*)(L + OLB + c * 4096 + off_r(16 + l15, 4 * ks + q));
                        const bf16x8 b0 = *(const LAS bf16x8*)(L + ORA + c * 4096 + off_r(l15, 4 * ks + q)), b1 = *(const LAS bf16x8*)(L + ORA + c * 4096 + off_r(16 + l15, 4 * ks + q));
                        g00 = MFMA16(a0, b0, g00); g01 = MFMA16(a0, b1, g01); g10 = MFMA16(a1, b0, g10); g11 = MFMA16(a1, b1, g11);
                    }
                    f32x4 ab, ak; float br[4], kr[4];
#pragma unroll
                    for (int g = 0; g < 4; ++g) { const bool lt = (4 * q + g) < l15, le = (4 * q + g) <= l15; ab[g] = lt ? g00[g] : 0.f; ak[g] = lt ? g10[g] : 0.f; br[g] = le ? g01[g] : 0.f; kr[g] = le ? g11[g] : 0.f; }
                    *(LAS f32x4*)(L + OAB + c * 1024 + (l15 * 16 + 4 * q) * 4) = ab; *(LAS f32x4*)(L + OAK + c * 1024 + (l15 * 16 + 4 * q) * 4) = ak;
                    u32x4 yw; yw.x = pkc(br[0], br[1]); yw.y = pkc(br[2], br[3]); yw.z = pkc(kr[0], kr[1]); yw.w = pkc(kr[2], kr[3]);
                    *(LAS u32x4*)(L + OMY + c * 1024 + off_m(l15, q)) = yw;
                    if (lane < 32) {
                        float row[16];
#pragma unroll
                        for (int t = 0; t < 16; ++t) {
                            const LAS f32x4* abr = (const LAS f32x4*)(L + OAB + c * 1024 + t * 64);
                            const f32x4 x0 = abr[0], x1 = abr[1], x2 = abr[2], x3 = abr[3];
                            const float abv[16] = {x0[0], x0[1], x0[2], x0[3], x1[0], x1[1], x1[2], x1[3], x2[0], x2[1], x2[2], x2[3], x3[0], x3[1], x3[2], x3[3]};
                            float acc1 = (lane < 16) ? ((lane == t) ? 1.f : 0.f) : *(const LAS float*)(L + OAK + c * 1024 + (t * 16 + (lane & 15)) * 4);
#pragma unroll
                            for (int s_ = 0; s_ < t; ++s_) acc1 += row[s_] * abv[s_];
                            row[t] = acc1;
                        }
                        const unsigned pp = (lane < 16) ? (8u * (lane >> 2) + (lane & 3)) : (8u * ((lane & 15) >> 2) + 4u + (lane & 3));
#pragma unroll
                        for (int t = 0; t < 16; ++t) *(LAS bf16_t*)(L + OMU + c * 1024 + off_m(t, pp >> 3) + 2 * (pp & 7)) = (bf16_t)(pkc(row[t], 0.f) & 0xffffu);
                    }
                }
            }
            __syncthreads();
            SP_MARK(2);
            if (w < 4) {
#pragma unroll 1
                for (int c = 0; c < 4; ++c) {
                    bf16x8 Sb0, Sb1;
                    { u32x4 t0_; t0_.x = pkc(St[0][0], St[0][1]); t0_.y = pkc(St[0][2], St[0][3]); t0_.z = pkc(St[1][0], St[1][1]); t0_.w = pkc(St[1][2], St[1][3]); Sb0 = __builtin_bit_cast(bf16x8, t0_);
                      u32x4 t1_; t1_.x = pkc(St[2][0], St[2][1]); t1_.y = pkc(St[2][2], St[2][3]); t1_.z = pkc(St[3][0], St[3][1]); t1_.w = pkc(St[3][2], St[3][3]); Sb1 = __builtin_bit_cast(bf16x8, t1_); }
                    f32x4 Za = (f32x4){0.f, 0.f, 0.f, 0.f}, Zr = Za;
                    Za = MFMA16(*(const LAS bf16x8*)(L + ORA + c * 4096 + off_r(l15, q)), Sb0, Za); Za = MFMA16(*(const LAS bf16x8*)(L + ORA + c * 4096 + off_r(l15, 4 + q)), Sb1, Za);
                    Zr = MFMA16(*(const LAS bf16x8*)(L + ORA + c * 4096 + off_r(16 + l15, q)), Sb0, Zr); Zr = MFMA16(*(const LAS bf16x8*)(L + ORA + c * 4096 + off_r(16 + l15, 4 + q)), Sb1, Zr);
                    const u32x2 vt = *(const LAS u32x2*)(L + OVT + c * 2048 + (16 * w + l15) * 32 + 8 * q);
                    u32x4 bu; bu.x = pkc(Za[0], Za[1]); bu.y = pkc(Za[2], Za[3]); bu.z = vt.x; bu.w = vt.y;
                    f32x4 U = (f32x4){0.f, 0.f, 0.f, 0.f};
                    U = MFMA16(*(const LAS bf16x8*)(L + OMU + c * 1024 + off_m(l15, q)), __builtin_bit_cast(bf16x8, bu), U);
                    u32x4 by; by.x = pkc(U[0], U[1]); by.y = pkc(U[2], U[3]); by.z = vt.x; by.w = vt.y;
                    const bf16x8 By = __builtin_bit_cast(bf16x8, by);
                    const f32x4 Yt = MFMA16(*(const LAS bf16x8*)(L + OMY + c * 1024 + off_m(l15, q)), By, Zr);
#pragma unroll
                    for (int mt = 0; mt < 4; ++mt) { St[mt] = MFMA16(*(const LAS bf16x8*)(L + OMS + c * 4096 + off_m(16 * mt + l15, q)), By, St[mt]);
                        const f32x4 gc = *(const LAS f32x4*)(L + OGC + c * 256 + (16 * mt + 4 * q) * 4); St[mt] = St[mt] * gc; }
#pragma unroll
                    for (int g = 0; g < 4; ++g) *(LAS float*)(L + OYS + ((16 * c + 4 * q + g) * 64 + 16 * w + l15) * 4) = Yt[g];
                }
            }
            __syncthreads();
            SP_MARK(3);
            bf16_t* ob_ = rbuf + ((size_t)b * SEQ + t0 + w) * DM + hd * 64;
#pragma unroll
            for (int iq = 0; iq < 4; ++iq) { const int tq = 2 * iq + (int)hf, t = w + 8 * tq; const int li = t * 64 + 2 * (int)cp;
                const f32x2 y = *(const LAS f32x2*)(L + OYS + li * 4); const float mean = half_sum(y[0] + y[1], hf) * (1.f / 64.f); const float d0 = y[0] - mean, d1 = y[1] - mean;
                const float rs = rsqrtf(half_sum(d0 * d0 + d1 * d1, hf) * (1.f / 64.f) + 64e-5f);
                const f32x2 vv = *(const LAS f32x2*)(L + OVF + li * 4), gg = *(const LAS f32x2*)(L + OGG + li * 4); const float bo = *(const LAS float*)(L + OBON + t * 4);
                const float o0 = (d0 * rs * lw[0] + lb[0] + bo * vv[0]) * gg[0], o1 = (d1 * rs * lw[1] + lb[1] + bo * vv[1]) * gg[1];
                *(unsigned*)(ob_ + (unsigned)(8 * tq * DM + 2 * (int)cp)) = pkc(o0, o1); }
        }
#undef RW_LOAD
    }
}

__global__ void __launch_bounds__(NTHREADS, 2) mega_fwd(Params p) {
    extern __shared__ __attribute__((aligned(16))) unsigned char lds_raw[];
    Frame F;
    F.lds = (LAS unsigned char*)lds_raw;
    F.tid = threadIdx.x; F.lane = F.tid & 63; F.wave = __builtin_amdgcn_readfirstlane(F.tid >> 6); F.G = gridDim.x; F.bid = blockIdx.x;
    F.out = p.out; F.ws = p.ws;
    volatile LAS unsigned* misc = (volatile LAS unsigned*)(F.lds + LDS_MISC);
    if (F.tid < 32) misc[F.tid] = 0u;
    __syncthreads();
    const int lo = p.ph_lo, hi = p.ph_hi;
    XcdBarrier bar; bar.bar = (unsigned*)(F.ws + WS_CTL); bar.x = 0; bar.st = misc;
    if (hi - lo > 1) bar = xcd_barrier_post((unsigned*)(F.ws + WS_CTL), misc);
#define IN(k) (lo <= (k) && (k) < hi)
#if PROBE_MASK
    unsigned long long pr_t0 = 0ull, pr_acc = 0ull;
#define PSTART(k) do { if ((PROBE_MASK >> (k)) & 1u) pr_t0 = wall_clock64(); } while (0)
#define PEND(k) do { if ((PROBE_MASK >> (k)) & 1u) pr_acc += wall_clock64() - pr_t0; } while (0)
#else
#define PSTART(k) do {} while (0)
#define PEND(k) do {} while (0)
#endif
#if PROBE_SUB == 11
#define SEAM(k) do { if (IN(k) && IN((k) + 1)) { unsigned long long b0_ = 0ull; if (F.tid == 0) b0_ = wall_clock64(); xcd_barrier(bar); if (F.tid == 0) *(LAS unsigned long long*)(F.lds + LDS_MISC + 64) += wall_clock64() - b0_; } PEND(k); PSTART((k) + 1); } while (0)
#else
#define SEAM(k) do { if (IN(k) && IN((k) + 1)) xcd_barrier(bar); PEND(k); PSTART((k) + 1); } while (0)
#endif
    bf16_t* wb = WSP(bf16_t, WS_WB);
    bf16_t* S0 = WSP(bf16_t, WS_SLAB); bf16_t* S2 = WSP(bf16_t, WS_SLAB + 2 * SLAB); bf16_t* S3 = WSP(bf16_t, WS_SLAB + 3 * SLAB); bf16_t* S4 = WSP(bf16_t, WS_SLAB + 4 * SLAB); bf16_t* S5 = WSP(bf16_t, WS_SLAB + 5 * SLAB);
    bf16_t* EH = WSP(bf16_t, WS_E);
    bf16_t* O0 = (bf16_t*)F.out; bf16_t* O1 = O0 + (size_t)T_TOK * DM;
    bf16_t* hres = (bf16_t*)F.out;
    bf16_t* S1 = WSP(bf16_t, WS_SLAB + 1 * SLAB);
    const int vcu = (F.G % 8 == 0) ? F.bid : F.bid;

    PSTART(0);
    if (IN(0)) { phase_prep(p, F); phase_rmsnorm<true>(p, F, p.in[0], p.in[1], O0); } SEAM(0);
    if (IN(2)) { DenseP<EK_INPROJ> P{}; P.pid = 2; P.v0 = (const float*)(F.ws + WS_ROPE); P.K = 1024; P.lda = 1024; P.ldb = 1024; P.nM = 256; P.nN = NPROJ / 256; P.nprob = 1; P.G = F.G; P.c = vcu; P.A = O0; P.a_stride = 0; P.B = wb + WB_WIN / 2; P.b_stride = 0;
        P.O = S0; P.o_stride = 0; P.ldc = NPROJ; gemm_phase(F.lds, P); } SEAM(2);
    if (IN(3)) { phase_conv(p, F); } SEAM(3);
    if (IN(4)) { phase_scan0(p, F); } SEAM(4);
    if (IN(5)) { phase_gatenorm(p, F); } SEAM(5);
    if (IN(6)) { DenseP<EK_F32RES> P{}; P.pid = 6; P.K = 2048; P.lda = NPROJ; P.ldb = 2048; P.nM = 256; P.nN = 4; P.nprob = 1; P.G = F.G; P.c = vcu; P.A = S0; P.B = wb + WB_WOUT / 2; P.resf = p.in[0]; P.resb = nullptr; P.Ob = hres; P.ldc = 1024; gemm_phase(F.lds, P); } SEAM(6);
#define MOE_LAYER(L, k0) \
    if (IN(k0)) { phase_moe_route(p, F, L, hres, S2); } SEAM(k0); \
    if (IN(k0 + 1)) { phase_moe_slots(p, F, L); } SEAM(k0 + 1); \
    if (IN(k0 + 2)) { unsigned char* meta = F.ws + WS_META + (size_t)(L) * META_STRIDE; Moe1P P{}; P.pid = (k0) + 2; P.K = 1024; P.lda = 1024; P.ldb = 1024; P.G = F.G; P.c = vcu; \
        P.ntiles = __builtin_amdgcn_readfirstlane(ld_vec_i32((const int*)(meta + MT_TILE))); P.A = S2; P.W13 = wb + WB_W13 / 2 + (size_t)(L) * 16 * 1048576; P.H = S3; \
        P.slot_tok = (const int*)(meta + MT_STOK); P.slot_c = (const float*)(meta + MT_SC); P.tile_bkt = (const int*)(meta + MT_TILE) + 64; gemm_phase(F.lds, P); } SEAM(k0 + 2); \
    if (IN(k0 + 3)) { unsigned char* meta = F.ws + WS_META + (size_t)(L) * META_STRIDE; Moe2P P{}; P.pid = (k0) + 3; P.K = 1024; P.lda = 1024; P.ldb = 512; P.G = F.G; P.c = vcu; \
        P.ntiles = __builtin_amdgcn_readfirstlane(ld_vec_i32((const int*)(meta + MT_TILE))); P.H = S3; P.W2 = wb + WB_W2 / 2 + (size_t)(L) * 16 * 524288; P.hsrc = hres; P.hdst = ((L) == 1) ? S0 : hres; \
        P.slot_tok = (const int*)(meta + MT_STOK); P.tile_bkt = (const int*)(meta + MT_TILE) + 64; gemm_phase(F.lds, P); } SEAM(k0 + 3);
    MOE_LAYER(0, 7)
    if (IN(11)) { phase_mix<0>(p, F, hres, S2, S3, S4); } SEAM(11);
    if (IN(12)) { DenseP<EK_LORA1> P{}; P.pid = 12; P.K = 1024; P.lda = 1024; P.ldb = 1024; P.nM = 256; P.nN = 1; P.nprob = 3; P.G = F.G; P.c = vcu; P.A = S2; P.a_stride = (size_t)T_TOK * DM; P.B = wb + WB_L1 / 2; P.b_stride = 262144;
        P.O = EH; P.o_stride = (size_t)T_TOK * 256; P.ldc = 256; gemm_phase(F.lds, P); } SEAM(12);
    if (IN(13)) { phase_mix<1>(p, F, hres, S2, S3, S4); } SEAM(13);
    if (IN(14)) { DenseP<EK_BF16> P{}; P.pid = 14; P.K = 1024; P.lda = 1024; P.ldb = 1024; P.nM = 256; P.nN = 4; P.nprob = 3; P.G = F.G; P.c = vcu; P.ldc = 1024; P.A = S2; P.a_stride = (size_t)T_TOK * DM; P.B = wb + WB_WR / 2; P.b_stride = 1048576;
        P.O = S5; P.Oalt1 = S0; P.Oalt2 = S1; gemm_phase(F.lds, P); } SEAM(14);
    if (IN(15)) { DenseP<EK_LORA2> P{}; P.pid = 15; P.K = 256; P.lda = 256; P.ldb = 256; P.nM = 256; P.nN = 4; P.nprob = 3; P.G = F.G; P.c = vcu; P.A = EH; P.a_stride = (size_t)T_TOK * 256; P.B = wb + WB_L2 / 2; P.b_stride = 262144;
        P.O = S2; P.o_stride = (size_t)T_TOK * DM; P.ldc = 1024; P.v0 = p.in[17]; P.v1 = p.in[20]; gemm_phase(F.lds, P); } SEAM(15);
    if (IN(16)) { phase_rwkv(p, F, S5, S0, S1, S2, S3, S4); } SEAM(16);
    if (IN(17)) { DenseP<EK_F32RES> P{}; P.pid = 17; P.K = 1024; P.lda = 1024; P.ldb = 1024; P.nM = 256; P.nN = 4; P.nprob = 1; P.G = F.G; P.c = vcu; P.A = S5; P.B = wb + WB_WO / 2; P.resf = nullptr; P.resb = hres; P.Ob = hres; P.ldc = 1024; gemm_phase(F.lds, P); } SEAM(17);
    MOE_LAYER(1, 18)
    if (IN(22)) { phase_rmsnorm<false, true>(p, F, S0, p.in[3], F.out); }
#if PROBE_SUB
    if (F.bid == 0 && F.tid == 0) { const unsigned long long d_ = *(LAS unsigned long long*)(F.lds + LDS_MISC + 64); const unsigned long long t = wall_clock64(); while (wall_clock64() - t < d_) __builtin_amdgcn_s_sleep(8); }
#endif
#if PROBE_MASK
    PEND(22);
    if (F.bid == 0 && F.tid == 0) { const unsigned long long t = wall_clock64(); while (wall_clock64() - t < pr_acc) __builtin_amdgcn_s_sleep(8); }
#endif
}

extern "C" void kernel_launch(void* const* d_in, const int* in_sizes, int n_in, void* d_out, int out_size, void* d_ws, size_t ws_size, hipStream_t stream) {
    static int grid = 0;
    if (grid == 0) {
        if (n_in != 37 || out_size != T_TOK * DM || ws_size < WS_END) { fprintf(stderr, "kernel_launch: unexpected shapes (n_in %d out %d ws %zu)\n", n_in, out_size, ws_size); grid = -1; return; }
        int dev = 0, cus = 0, per_cu = 0;
        if (hipGetDevice(&dev) != hipSuccess || hipDeviceGetAttribute(&cus, hipDeviceAttributeMultiprocessorCount, dev) != hipSuccess) { grid = -1; return; }
        if (hipFuncSetAttribute((const void*)mega_fwd, hipFuncAttributeMaxDynamicSharedMemorySize, LDS_BYTES) != hipSuccess) { fprintf(stderr, "kernel_launch: hipFuncSetAttribute failed\n"); grid = -1; return; }
        if (hipOccupancyMaxActiveBlocksPerMultiprocessor(&per_cu, (const void*)mega_fwd, NTHREADS, LDS_BYTES) != hipSuccess || per_cu < 1) fprintf(stderr, "kernel_launch: occupancy query says %d\n", per_cu);
        (void)hipGetLastError();
        grid = cus;
        if (grid < 128 || grid > 512) { fprintf(stderr, "kernel_launch: built for 128..512 CUs (the MoE router keeps <= 512 tokens per workgroup in LDS); got %d\n", grid); grid = -1; return; }
    }
    if (grid < 0) return;
    (void)in_sizes;
    hipMemsetAsync((char*)d_ws + WS_CTL, 0, CTL_ZERO_BYTES, stream);
    Params p{};
    for (int i = 0; i < 37; ++i) p.in[i] = (const float*)d_in[i];
    p.out = (float*)d_out; p.ws = (unsigned char*)d_ws;
#if MK_PER_PHASE
    for (int k = 0; k < NPHASE; ++k) { p.ph_lo = k; p.ph_hi = k + 1; hipLaunchKernelGGL(mega_fwd, dim3(grid), dim3(NTHREADS), LDS_BYTES, stream, p); }
#else
    p.ph_lo = 0; p.ph_hi = NPHASE; hipLaunchKernelGGL(mega_fwd, dim3(grid), dim3(NTHREADS), LDS_BYTES, stream, p);
#endif
}
```

```cpp
#include <hip/hip_runtime.h>
#include <stdint.h>
#include <stdio.h>

#ifndef MK_PER_PHASE
#define MK_PER_PHASE 0
#endif

#ifndef PROBE_MASK
#define PROBE_MASK 0u
#endif
#ifndef PROBE_PID
#define PROBE_PID -1
#endif
#ifndef PROBE_SUB
#define PROBE_SUB 0
#endif
#define LAS __attribute__((address_space(3)))
typedef unsigned short bf16_t;
typedef short bf16x8 __attribute__((ext_vector_type(8)));
typedef float f32x4 __attribute__((ext_vector_type(4)));
typedef float f32x2 __attribute__((ext_vector_type(2)));
typedef unsigned u32x4 __attribute__((ext_vector_type(4)));
typedef unsigned u32x2 __attribute__((ext_vector_type(2)));

constexpr int T_TOK = 65536, DM = 1024, SEQ = 4096;
constexpr int NPROJ = 5888;
constexpr int PC_Z = 0, PC_XBC = 1024, PC_Q = 2560, PC_K = 3072, PC_V = 3584, PC_G = 4608, PC_DT = 5632;
constexpr int NTHREADS = 512;
constexpr int LDS_BYTES = 147456;
constexpr int LDS_MISC = LDS_BYTES - 256;
constexpr int NSLOT = T_TOK + 24 * 256;
constexpr int NPHASE = 23;
constexpr int PT_WIN = 1472, PT_WOUT = PT_WIN + 512, PT_RW = PT_WOUT + 1024, PT_L1 = PT_RW + 192, PT_L2 = PT_L1 + 192, PT_W13 = PT_L2 + 8192, PT_W2 = PT_W13 + 4096;
#if PROBE_SUB
#define SP_DECL unsigned long long sp_t_ = wall_clock64()
#define SP_MARK(id_end) do { if (F.tid == 0) { const unsigned long long n_ = wall_clock64(); if ((id_end) == PROBE_SUB) *(LAS unsigned long long*)(F.lds + LDS_MISC + 64) += n_ - sp_t_; sp_t_ = n_; } } while (0)
#else
#define SP_DECL do {} while (0)
#define SP_MARK(id_end) do {} while (0)
#endif

constexpr size_t MiB = 1024 * 1024;
constexpr size_t WS_CTL = 0;
constexpr size_t CTL_ZERO_BYTES = 16384;
constexpr size_t CTL_CNT_OFF = 14336;
constexpr size_t WS_META = 64 * 1024;
constexpr size_t META_STRIDE = 2 * MiB - 32 * 1024;
constexpr size_t MT_RANK = 0, MT_BKT = 262144, MT_C = 524288, MT_STOK = 1048576, MT_SC = 1048576 + 294912, MT_TILE = 1048576 + 294912 + 589824;
constexpr size_t WS_ROPE = 4 * MiB;
constexpr size_t WS_WB = 6 * MiB;
constexpr size_t WB_WIN = 0, WB_WOUT = WB_WIN + (size_t)NPROJ * 1024 * 2, WB_WR = WB_WOUT + (size_t)1024 * 2048 * 2, WB_WK = WB_WR + 2 * MiB, WB_WV = WB_WK + 2 * MiB, WB_WO = WB_WV + 2 * MiB,
                 WB_L1 = WB_WO + 2 * MiB  , WB_L2 = WB_L1 + 3 * 512 * 1024  , WB_W13 = WB_L2 + 3 * 512 * 1024  ,
                 WB_W2 = WB_W13 + (size_t)32 * 2 * MiB  , WB_END = WB_W2 + (size_t)32 * MiB;
constexpr size_t WS_SLAB = 130 * MiB;
constexpr size_t SLAB = 128 * MiB;
constexpr size_t WS_E = WS_SLAB + 6 * SLAB;
constexpr size_t WS_END = WS_E + 96 * MiB;
constexpr size_t WS_RTW = WS_WB + WB_END;
static_assert(WS_RTW + 2 * 20 * 1024 * 4 <= WS_SLAB, "weights overflow");
static_assert(WS_END <= 1024 * MiB, "workspace overflow");

struct Params {
    const float* in[37];
    float* out;
    unsigned char* ws;
    int ph_lo, ph_hi;
};

__device__ __forceinline__ float bf2f(bf16_t v) { return __uint_as_float(((unsigned)v) << 16); }
__device__ __forceinline__ float bflo(unsigned w) { return __uint_as_float(w << 16); }
__device__ __forceinline__ float bfhi(unsigned w) { return __uint_as_float(w & 0xffff0000u); }
__device__ __forceinline__ unsigned cvt_pk_bf16(float lo, float hi) { unsigned r; asm volatile("v_cvt_pk_bf16_f32 %0, %1, %2" : "=v"(r) : "v"(lo), "v"(hi)); return r; }
__device__ __forceinline__ bf16_t f2bf(float f) { return (bf16_t)(cvt_pk_bf16(f, 0.f) & 0xffffu); }
__device__ __forceinline__ float wave_sum(float v) {
#pragma unroll
    for (int o = 32; o >= 1; o >>= 1) v += __shfl_xor(v, o);
    return v;
}
__device__ __forceinline__ float dpp_sum16(float x) {
    x += __builtin_bit_cast(float, __builtin_amdgcn_update_dpp(0, __builtin_bit_cast(int, x), 0xB1, 0xF, 0xF, true));
    x += __builtin_bit_cast(float, __builtin_amdgcn_update_dpp(0, __builtin_bit_cast(int, x), 0x4E, 0xF, 0xF, true));
    x += __builtin_bit_cast(float, __builtin_amdgcn_update_dpp(0, __builtin_bit_cast(int, x), 0x141, 0xF, 0xF, true));
    x += __builtin_bit_cast(float, __builtin_amdgcn_update_dpp(0, __builtin_bit_cast(int, x), 0x140, 0xF, 0xF, true));
    return x;
}
__device__ __forceinline__ float wave_sum_u(float x) {
    x = dpp_sum16(x);
    x += __builtin_bit_cast(float, __builtin_amdgcn_update_dpp(0, __builtin_bit_cast(int, x), 0x142, 0xA, 0xF, false));
    x += __builtin_bit_cast(float, __builtin_amdgcn_update_dpp(0, __builtin_bit_cast(int, x), 0x143, 0xC, 0xF, false));
    return __builtin_bit_cast(float, __builtin_amdgcn_readlane(__builtin_bit_cast(int, x), 63));
}
__device__ __forceinline__ float fsilu(float x) { return x * __builtin_amdgcn_rcpf(1.f + __expf(-x)); }
__device__ __forceinline__ float fsigmoid(float x) { return __builtin_amdgcn_rcpf(1.f + __expf(-x)); }
__device__ __forceinline__ float fsoftplus(float x) { return x > 20.f ? x : log1pf(__expf(x)); }
__device__ __forceinline__ float ftanh(float x) { const float xc = fminf(fmaxf(x, -15.f), 15.f); const float e = __expf(2.f * xc); return (e - 1.f) * __builtin_amdgcn_rcpf(e + 1.f); }
__device__ __forceinline__ int ld_vec_i32(const int* p) { int r; asm volatile("global_load_dword %0, %1, off\n\ts_waitcnt vmcnt(0)" : "=&v"(r) : "v"(p) : "memory"); return r; }

#define XB_TMO      128
#define XB_XCNT(j)  (256  + 64 * (j))
#define XB_XSUB(j)  (1280 + 64 * (j))
#define XB_XGEN(j)  (2304 + 64 * (j))
#define XB_TOP      3328
#define XB_TOPGEN   3392
#define XCD_BAR_WORDS 3456
#define XB_SPIN_CAP (1u << 24)
__device__ __forceinline__ unsigned xb_ld(unsigned* p)              { return __hip_atomic_load(p, __ATOMIC_RELAXED, __HIP_MEMORY_SCOPE_AGENT); }
__device__ __forceinline__ unsigned xb_add(unsigned* p, unsigned v) { return __hip_atomic_fetch_add(p, v, __ATOMIC_RELAXED, __HIP_MEMORY_SCOPE_AGENT); }
__device__ __forceinline__ unsigned xb_xcc_id() { return (unsigned)__builtin_amdgcn_s_getreg((3 << 11) | 20) & 0xFu; }
#define XB_SPIN(cond, bar) do { unsigned _sp = 0; while (cond) { __builtin_amdgcn_s_sleep(1); \
    if ((++_sp & 255u) == 0u) { if (xb_ld(&(bar)[XB_TMO])) break; if (_sp > XB_SPIN_CAP) { atomicAdd(&(bar)[XB_TMO], 1u); break; } } } } while (0)
struct XcdBarrier { unsigned* bar; unsigned x; volatile LAS unsigned* st; };
__device__ __forceinline__ XcdBarrier xcd_barrier_post(unsigned* bar, volatile LAS unsigned* st) {
    XcdBarrier b; b.bar = bar; b.x = xb_xcc_id(); b.st = st;
    if (threadIdx.x == 0) (void)xb_add(&bar[XB_XCNT(b.x)], 1u);
    return b;
}
__device__ __forceinline__ void xcd_barrier_complete(unsigned* bar, unsigned x, unsigned& nloc, unsigned& nx) {
    const unsigned G = gridDim.x * gridDim.y * gridDim.z;
    unsigned sum, cnt, mine, sp = 0u;
    for (;;) {
        sum = 0u; cnt = 0u; mine = 0u;
#pragma unroll
        for (unsigned j = 0; j < 16; ++j) { const unsigned c = xb_ld(&bar[XB_XCNT(j)]); sum += c; cnt += (c > 0u) ? 1u : 0u; mine = (j == x) ? c : mine; }
        if (sum == G) break;
        __builtin_amdgcn_s_sleep(1);
        if ((++sp & 255u) == 0u) { if (xb_ld(&bar[XB_TMO])) break; if (sp > XB_SPIN_CAP) { atomicAdd(&bar[XB_TMO], 1u); break; } }
    }
    nloc = mine > 0u ? mine : 1u; nx = cnt > 0u ? cnt : 1u;
}
__device__ __forceinline__ void xcd_barrier(const XcdBarrier& b) {
    asm volatile("s_waitcnt vmcnt(0)" ::: "memory");
    __syncthreads();
    if (threadIdx.x == 0) {
        unsigned* bar = b.bar;
        __builtin_amdgcn_s_waitcnt(0);
        unsigned nloc = b.st[0], nx = b.st[1];
        if (nloc == 0u) { xcd_barrier_complete(bar, b.x, nloc, nx); b.st[0] = nloc; b.st[1] = nx; }
        const unsigned old = xb_add(&bar[XB_XSUB(b.x)], 1u);
        const unsigned gen = old / nloc;
        if (old + 1u == (gen + 1u) * nloc) {
            __builtin_amdgcn_fence(__ATOMIC_RELEASE, "agent");
            asm volatile("s_waitcnt vmcnt(0)" ::: "memory");
            const unsigned og = xb_add(&bar[XB_TOP], 1u);
            const unsigned tg = og / nx;
            if (og + 1u == (tg + 1u) * nx) xb_add(&bar[XB_TOPGEN], 1u);
            else XB_SPIN(xb_ld(&bar[XB_TOPGEN]) == tg, bar);
            __builtin_amdgcn_fence(__ATOMIC_ACQUIRE, "agent");
            xb_add(&bar[XB_XGEN(b.x)], 1u);
            asm volatile("s_waitcnt vmcnt(0)" ::: "memory");
        } else {
            XB_SPIN(xb_ld(&bar[XB_XGEN(b.x)]) == gen, bar);
            __builtin_amdgcn_fence(__ATOMIC_ACQUIRE, "agent");
            asm volatile("s_waitcnt vmcnt(0)" ::: "memory");
        }
    }
    __syncthreads();
}

constexpr int BM = 256, BK = 64, HALF = 128, HTB = HALF * BK * 2, STAGE_BYTES = 8 * HTB;
__device__ __forceinline__ int lds_byte(int r, int c) { const int st = (r >> 4) * 2 + (c >> 5), rr = r & 15, cc = c & 31, ob = rr * 64 + cc * 2; return st * 1024 + (ob ^ (((ob >> 9) & 1) << 5)); }
__device__ __forceinline__ void stage_rc(int b, int& R, int& C) { const int st = b / 1024, sb = b % 1024, swz = sb ^ (((sb >> 9) & 1) << 5); R = (st >> 1) * 16 + swz / 64; C = (st & 1) * 32 + (swz % 64) / 2; }
__device__ __forceinline__ int perm32(int rho) { const int n = rho >> 4, i = rho & 15; return 8 * (i >> 2) + 4 * n + (i & 3); }
struct Unit { int pm, pn, prob; };
__device__ __forceinline__ void tile_order(int L, int nM, int nN, int& pm, int& pn) {
    const int nwg = nM * nN; int wgid = L;
    { const int q = nwg / 8, r = nwg % 8, xcd = wgid % 8, off = wgid / 8; wgid = (xcd < r ? xcd * (q + 1) : r * (q + 1) + (xcd - r) * q) + off; }
    const int nig = 8 * nN, gid = wgid / nig, fm = gid * 8, gsz = (nM - fm) < 8 ? (nM - fm) : 8;
    pm = fm + ((wgid % nig) % gsz); pn = (wgid % nig) / gsz;
}

template <class P>
__device__ __forceinline__ void gemm_phase(LAS unsigned char* lds, const P& S) {
    const int tid = threadIdx.x, wid = __builtin_amdgcn_readfirstlane(tid >> 6), lane = tid & 63, wr = wid >> 2, wc = wid & 3, fr = lane & 15, fq = lane >> 4;
    const int K = S.K, nt = K / BK, lda = S.lda, ldb = S.ldb;
    int RA[2], CA[2]; unsigned voffB[2], vAc[2][2], vAn[2][2];
#pragma unroll
    for (int i = 0; i < 2; ++i) { int R, C; stage_rc(tid * 16 + i * 8192, R, C); RA[i] = R; CA[i] = C; const int Rb = P::PERM ? ((R & ~31) + perm32(R & 31)) : R;
        voffB[i] = (unsigned)(Rb * ldb + C) * 2u;
#pragma unroll
        for (int h = 0; h < 2; ++h) { vAc[h][i] = (unsigned)((h * HALF + R) * lda + C) * 2u; vAn[h][i] = vAc[h][i]; } }
    const size_t kstep = (size_t)(BK * 2);
    const size_t hstepB = (size_t)HALF * ldb * 2;
    const unsigned ldsw = (unsigned)wid * 1024u;
    const int aoff = lds_byte(wr * 64 + fr, fq * 8), boff = lds_byte(wc * 32 + fr, fq * 8);
#define PG8_SA(b, h) (((b) * 2 + (h)) * HTB)
#define PG8_SB(b, h) ((4 + (b) * 2 + (h)) * HTB)
#define PG8_STAGE2(bufoff, gbase, v0, v1) do { \
        __builtin_amdgcn_global_load_lds((const unsigned*)((const char*)(gbase) + (v0)), (LAS unsigned*)(lds + (bufoff) + ldsw), 16, 0, 0); \
        __builtin_amdgcn_global_load_lds((const unsigned*)((const char*)(gbase) + (v1)), (LAS unsigned*)(lds + (bufoff) + ldsw + 8192), 16, 0, 0); } while (0)
#define PG8_LDA(dst, b, h) do { _Pragma("unroll") for (int m = 0; m < 4; ++m) _Pragma("unroll") for (int k = 0; k < 2; ++k) dst[m][k] = *(const LAS bf16x8*)(lds + PG8_SA(b, h) + aoff + m * 2048 + k * 1024); } while (0)
#define PG8_LDB(dst, b, h) do { _Pragma("unroll") for (int n = 0; n < 2; ++n) _Pragma("unroll") for (int k = 0; k < 2; ++k) dst[n][k] = *(const LAS bf16x8*)(lds + PG8_SB(b, h) + boff + n * 2048 + k * 1024); } while (0)
#define PG8_MMA(ai, bj, At, Bt) do { __builtin_amdgcn_s_setprio(1); _Pragma("unroll") for (int m = 0; m < 4; ++m) _Pragma("unroll") for (int n = 0; n < 2; ++n) _Pragma("unroll") for (int k = 0; k < 2; ++k) \
        acc[ai][bj][m][n] = __builtin_amdgcn_mfma_f32_16x16x32_bf16(Bt[n][k], At[m][k], acc[ai][bj][m][n], 0, 0, 0); __builtin_amdgcn_s_setprio(0); } while (0)
#define PG8_WAIT_V(n) asm volatile("s_waitcnt vmcnt(" #n ")" ::: "memory")
#define PG8_WAIT_L(n) asm volatile("s_waitcnt lgkmcnt(" #n ")" ::: "memory")
#define PG8_BAR __builtin_amdgcn_s_barrier()
#define PG8_SCHED __builtin_amdgcn_sched_barrier(0)
    Unit cur, nxt; int ui = 0;
    if (!S.next(0, cur)) return;
    struct { int tid; LAS unsigned char* lds; } F; F.tid = tid; F.lds = lds; (void)F;
    SP_DECL;
    if constexpr (P::GATHER) {
#pragma unroll
        for (int h = 0; h < 2; ++h)
#pragma unroll
            for (int i = 0; i < 2; ++i) vAc[h][i] = S.a_voff(cur, h * HALF + RA[i], CA[i]);
    }
    float zf; asm volatile("v_mov_b32 %0, 0" : "=v"(zf));
    f32x4 acc[2][2][4][2];
#pragma unroll
    for (int a = 0; a < 2; ++a)
#pragma unroll
        for (int b = 0; b < 2; ++b)
#pragma unroll
            for (int m = 0; m < 4; ++m)
#pragma unroll
                for (int n = 0; n < 2; ++n) acc[a][b][m][n] = (f32x4){zf, zf, zf, zf};
    bf16x8 At[4][2], B0[2][2], B1[2][2];
    const char* cA = S.a_ptr(cur);
    {
        const char* b0 = S.b_ptr(cur, 0); const char* b1 = S.b_ptr(cur, 1);
        PG8_STAGE2(PG8_SB(0, 0), b0, voffB[0], voffB[1]); PG8_STAGE2(PG8_SA(0, 0), cA, vAc[0][0], vAc[0][1]); PG8_STAGE2(PG8_SB(0, 1), b0 + hstepB, voffB[0], voffB[1]); PG8_STAGE2(PG8_SA(0, 1), cA, vAc[1][0], vAc[1][1]);
        if (wr == 1) PG8_BAR;
        PG8_WAIT_V(4); PG8_BAR;
        PG8_STAGE2(PG8_SB(1, 0), b1, voffB[0], voffB[1]); PG8_STAGE2(PG8_SA(1, 0), cA + kstep, vAc[0][0], vAc[0][1]); PG8_STAGE2(PG8_SB(1, 1), b1 + hstepB, voffB[0], voffB[1]);
        PG8_WAIT_V(6); PG8_BAR;
    }
    for (;;) {
        const bool has_next = S.next(ui + 1, nxt);
        if (!has_next) nxt = cur;
        if constexpr (P::GATHER) {
            if (has_next) {
#pragma unroll
                for (int h = 0; h < 2; ++h)
#pragma unroll
                    for (int i = 0; i < 2; ++i) vAn[h][i] = S.a_voff(nxt, h * HALF + RA[i], CA[i]);
            }
        }
        const char* nA = S.a_ptr(nxt);
        for (int t = 0; t < nt; t += 2) {
            const bool last = (t == nt - 2);
            const char* a1 = cA + (size_t)(t + 1) * kstep;
            const char* a2 = last ? nA : cA + (size_t)(t + 2) * kstep;
            const char* a3 = a2 + kstep;
            const char* b2 = last ? S.b_ptr(nxt, 0) : S.b_ptr(cur, t + 2);
            const char* b3 = last ? S.b_ptr(nxt, 1) : S.b_ptr(cur, t + 3);
            unsigned s00 = vAc[0][0], s01 = vAc[0][1], s10 = vAc[1][0], s11 = vAc[1][1];
            if constexpr (P::GATHER) { if (last) { s00 = vAn[0][0]; s01 = vAn[0][1]; s10 = vAn[1][0]; s11 = vAn[1][1]; } }
            PG8_LDB(B0, 0, 0); PG8_SCHED; PG8_LDA(At, 0, 0); PG8_STAGE2(PG8_SA(1, 1), a1, vAc[1][0], vAc[1][1]);
            PG8_WAIT_L(8); PG8_BAR; PG8_WAIT_L(0); PG8_MMA(0, 0, At, B0); PG8_BAR; PG8_SCHED;
            PG8_LDB(B1, 0, 1); PG8_STAGE2(PG8_SB(0, 0), b2, voffB[0], voffB[1]);
            PG8_BAR; PG8_WAIT_L(0); PG8_MMA(0, 1, At, B1); PG8_BAR;
            PG8_LDA(At, 0, 1); PG8_STAGE2(PG8_SA(0, 0), a2, s00, s01);
            PG8_BAR; PG8_WAIT_L(0); PG8_MMA(1, 0, At, B0); PG8_BAR; PG8_SCHED;
            PG8_STAGE2(PG8_SB(0, 1), b2 + hstepB, voffB[0], voffB[1]);
            PG8_WAIT_V(6); PG8_BAR; PG8_MMA(1, 1, At, B1); PG8_BAR;
            PG8_LDB(B0, 1, 0); PG8_SCHED; PG8_LDA(At, 1, 0); PG8_STAGE2(PG8_SA(0, 1), a2, s10, s11);
            PG8_WAIT_L(8); PG8_BAR; PG8_WAIT_L(0); PG8_MMA(0, 0, At, B0); PG8_BAR; PG8_SCHED;
            PG8_LDB(B1, 1, 1); PG8_STAGE2(PG8_SB(1, 0), b3, voffB[0], voffB[1]);
            PG8_BAR; PG8_WAIT_L(0); PG8_MMA(0, 1, At, B1); PG8_BAR;
            PG8_LDA(At, 1, 1); PG8_STAGE2(PG8_SA(1, 0), a3, s00, s01);
            PG8_BAR; PG8_WAIT_L(0); PG8_MMA(1, 0, At, B0); PG8_BAR; PG8_SCHED;
            PG8_STAGE2(PG8_SB(1, 1), b3 + hstepB, voffB[0], voffB[1]);
            PG8_WAIT_V(6); PG8_BAR; PG8_MMA(1, 1, At, B1); PG8_BAR;
        }
        SP_MARK((PROBE_PID < 0 || S.pid == PROBE_PID) ? 10 : -1);
        S.epi(acc, cur, wr, wc, fr, fq);
        SP_MARK((PROBE_PID < 0 || S.pid == PROBE_PID) ? 9 : -1);
        if (!has_next) break;
#pragma unroll
        for (int a = 0; a < 2; ++a)
#pragma unroll
            for (int b = 0; b < 2; ++b)
#pragma unroll
                for (int m = 0; m < 4; ++m)
#pragma unroll
                    for (int n = 0; n < 2; ++n) acc[a][b][m][n] = (f32x4){zf, zf, zf, zf};
        cur = nxt; cA = nA; ++ui;
        if constexpr (P::GATHER) {
#pragma unroll
            for (int h = 0; h < 2; ++h)
#pragma unroll
                for (int i = 0; i < 2; ++i) vAc[h][i] = vAn[h][i];
        }
    }
    PG8_WAIT_V(0);
    if (wr == 0) PG8_BAR;
    PG8_BAR;
#undef PG8_SA
#undef PG8_SB
#undef PG8_STAGE2
#undef PG8_LDA
#undef PG8_LDB
#undef PG8_MMA
#undef PG8_WAIT_V
#undef PG8_WAIT_L
#undef PG8_BAR
#undef PG8_SCHED
}

enum { EK_BF16 = 0, EK_LORA1 = 1, EK_LORA2 = 2, EK_F32RES = 3, EK_INPROJ = 4 };
template <int KIND>
struct DenseP {
    static constexpr bool PERM = true, GATHER = false;
    int K, lda, ldb, nM, nN, nprob, G, c, pid;
    const bf16_t* A; size_t a_stride;
    const bf16_t* B; size_t b_stride;
    bf16_t* O; size_t o_stride; int ldc;
    bf16_t* Oalt1; bf16_t* Oalt2;
    const float* resf; const bf16_t* resb; bf16_t* Ob;
    const float* v0; const float* v1;
    __device__ __forceinline__ bool next(int i, Unit& u) const {
        const long L = (long)i * G + c; const int per = nM * nN; if (L >= (long)per * nprob) return false;
        u.prob = (int)(L / per); tile_order((int)(L % per), nM, nN, u.pm, u.pn); return true;
    }
    __device__ __forceinline__ const char* a_ptr(const Unit& u) const { return (const char*)(A + (size_t)u.prob * a_stride + (size_t)u.pm * BM * lda); }
    __device__ __forceinline__ const char* b_ptr(const Unit& u, int kt) const { return (const char*)(B + (size_t)u.prob * b_stride + (size_t)u.pn * BM * ldb) + (size_t)kt * (BK * 2); }
    __device__ __forceinline__ unsigned a_voff(const Unit&, int, int) const { return 0u; }
    __device__ __forceinline__ void epi(const f32x4 (&acc)[2][2][4][2], const Unit& u, int wr, int wc, int fr, int fq) const {
        const int row0 = u.pm * BM + wr * 64 + fr;
        if constexpr (KIND == EK_F32RES) {
            const int col0 = u.pn * BM + wc * 32 + 8 * fq;
#pragma unroll
            for (int ai = 0; ai < 2; ++ai)
#pragma unroll
                for (int mp = 0; mp < 2; ++mp) {
                    f32x4 r0[2][2], r1[2][2];
#pragma unroll
                    for (int mm = 0; mm < 2; ++mm) { const size_t ro = (size_t)(row0 + ai * HALF + (mp * 2 + mm) * 16) * ldc + col0;
#pragma unroll
                        for (int bj = 0; bj < 2; ++bj) {
                            if (resf) { r0[mm][bj] = __builtin_nontemporal_load((const f32x4*)(resf + ro + bj * HALF)); r1[mm][bj] = __builtin_nontemporal_load((const f32x4*)(resf + ro + bj * HALF + 4)); }
                            else { const u32x4 rw = *(const u32x4*)(resb + ro + bj * HALF); r0[mm][bj] = (f32x4){bflo(rw.x), bfhi(rw.x), bflo(rw.y), bfhi(rw.y)}; r1[mm][bj] = (f32x4){bflo(rw.z), bfhi(rw.z), bflo(rw.w), bfhi(rw.w)}; } } }
#pragma unroll
                    for (int mm = 0; mm < 2; ++mm) { const size_t ro = (size_t)(row0 + ai * HALF + (mp * 2 + mm) * 16) * ldc + col0;
#pragma unroll
                        for (int bj = 0; bj < 2; ++bj) { const f32x4 x0 = acc[ai][bj][mp * 2 + mm][0] + r0[mm][bj], x1 = acc[ai][bj][mp * 2 + mm][1] + r1[mm][bj];
                            u32x4 w; w.x = cvt_pk_bf16(x0[0], x0[1]); w.y = cvt_pk_bf16(x0[2], x0[3]); w.z = cvt_pk_bf16(x1[0], x1[1]); w.w = cvt_pk_bf16(x1[2], x1[3]);
                            *(u32x4*)(Ob + ro + bj * HALF) = w; } }
                }
        } else {
            const int col0 = u.pn * BM + wc * 32 + 8 * fq;
            bf16_t* base = Oalt1 ? ((u.prob == 0) ? O : (u.prob == 1) ? Oalt1 : Oalt2) : O + (size_t)u.prob * o_stride;
            f32x4 bv[2][2];
#pragma unroll
            for (int bj = 0; bj < 2; ++bj)
#pragma unroll
                for (int n = 0; n < 2; ++n) {
                    if constexpr (KIND == EK_LORA2) { bv[bj][n] = (u.prob == 0) ? *(const f32x4*)(v0 + col0 + bj * HALF + 4 * n) : (u.prob == 1) ? *(const f32x4*)(v1 + col0 + bj * HALF + 4 * n) : (f32x4){0.f, 0.f, 0.f, 0.f}; }
                    else bv[bj][n] = (f32x4){0.f, 0.f, 0.f, 0.f};
                }
#pragma unroll
            for (int ai = 0; ai < 2; ++ai)
#pragma unroll
                for (int m = 0; m < 4; ++m) { bf16_t* rowp = base + (size_t)(row0 + ai * HALF + m * 16) * ldc + col0;
#pragma unroll
                    for (int bj = 0; bj < 2; ++bj) { f32x4 x0 = acc[ai][bj][m][0] + bv[bj][0], x1 = acc[ai][bj][m][1] + bv[bj][1];
                        if constexpr (KIND == EK_LORA1) {
                            const float kx = (u.prob == 0) ? 2.f : 1.f;
#pragma unroll
                            for (int j = 0; j < 4; ++j) { const float s0 = fsigmoid(kx * x0[j]), s1 = fsigmoid(kx * x1[j]);
                                x0[j] = (u.prob == 0) ? 2.f * s0 - 1.f : (u.prob == 2) ? s0 : x0[j]; x1[j] = (u.prob == 0) ? 2.f * s1 - 1.f : (u.prob == 2) ? s1 : x1[j]; } }
                        if constexpr (KIND == EK_LORA2) {
                            const float sc = (u.prob == 0) ? 0.6065306597126334f : 1.f;
#pragma unroll
                            for (int j = 0; j < 4; ++j) { const float s0 = sc * fsigmoid(x0[j]), s1 = sc * fsigmoid(x1[j]); x0[j] = (u.prob == 2) ? x0[j] : s0; x1[j] = (u.prob == 2) ? x1[j] : s1; } }
                        if constexpr (KIND == EK_INPROJ) {
                            if (u.pn >= PC_Q / 256 && u.pn < PC_V / 256) { const int pos = (row0 + ai * HALF + m * 16) & (SEQ - 1); const float sc = (u.pn >= PC_K / 256) ? 0.08838834764831845f : 1.f;
                                const f32x4 cs0 = *(const f32x4*)(v0 + ((size_t)pos * 64 + wc * 16 + 4 * fq) * 2), cs1 = *(const f32x4*)(v0 + ((size_t)pos * 64 + wc * 16 + 4 * fq + 2) * 2);
                                const f32x4 a = x0, b = x1;
                                x0[0] = (a[0] * cs0[0] - a[1] * cs0[1]) * sc; x0[1] = (a[0] * cs0[1] + a[1] * cs0[0]) * sc; x0[2] = (a[2] * cs0[2] - a[3] * cs0[3]) * sc; x0[3] = (a[2] * cs0[3] + a[3] * cs0[2]) * sc;
                                x1[0] = (b[0] * cs1[0] - b[1] * cs1[1]) * sc; x1[1] = (b[0] * cs1[1] + b[1] * cs1[0]) * sc; x1[2] = (b[2] * cs1[2] - b[3] * cs1[3]) * sc; x1[3] = (b[2] * cs1[3] + b[3] * cs1[2]) * sc; } }
                        u32x4 w; w.x = cvt_pk_bf16(x0[0], x0[1]); w.y = cvt_pk_bf16(x0[2], x0[3]); w.z = cvt_pk_bf16(x1[0], x1[1]); w.w = cvt_pk_bf16(x1[2], x1[3]);
                        *(u32x4*)(rowp + bj * HALF) = w; } }
        }
    }
};

__device__ __forceinline__ void pair_lohi(int pr, int& lo, int& hi) { lo = (pr < 3) ? 0 : (pr < 5 ? 1 : 2); hi = (pr < 3) ? pr + 1 : (pr < 5 ? pr - 1 : 3); }

struct Moe1P {
    static constexpr bool PERM = true, GATHER = true;
    int K, lda, ldb, G, c, ntiles, pid;
    const bf16_t* A; const bf16_t* W13;
    bf16_t* H; const int* slot_tok; const float* slot_c; const int* tile_bkt;
    __device__ __forceinline__ bool next(int i, Unit& u) const {
        const int m = (c >> 3) + (G >> 3) * i; if ((G & 7) != 0 || m >= ntiles) { if ((G & 7) == 0) return false; const long L = (long)i * G + c; if (L >= (long)ntiles * 8) return false; u.pm = (int)(L >> 3); u.pn = (int)(L & 7); u.prob = __builtin_amdgcn_readfirstlane(ld_vec_i32(tile_bkt + u.pm)); return true; }
        u.pm = m; u.pn = c & 7; u.prob = __builtin_amdgcn_readfirstlane(ld_vec_i32(tile_bkt + u.pm)); return true;
    }
    __device__ __forceinline__ const char* a_ptr(const Unit&) const { return (const char*)A; }
    __device__ __forceinline__ unsigned a_voff(const Unit& u, int row, int C) const { int tok = slot_tok[u.pm * BM + row]; tok = tok < 0 ? 0 : tok; return (unsigned)(tok * lda + C) * 2u; }
    __device__ __forceinline__ const char* b_ptr(const Unit& u, int kt) const {
        int lo, hi; pair_lohi(u.prob % 6, lo, hi); const int e = (u.prob / 6) * 4 + ((u.pn < 4) ? lo : hi);
        return (const char*)(W13 + ((size_t)e * 1024 + (size_t)(u.pn & 3) * BM) * 1024) + (size_t)kt * (BK * 2);
    }
    __device__ __forceinline__ void epi(const f32x4 (&acc)[2][2][4][2], const Unit& u, int wr, int wc, int fr, int fq) const {
        const int row0 = u.pm * BM + wr * 64 + fr, col0 = ((u.pn < 4) ? 0 : 512) + (u.pn & 3) * 128 + wc * 32 + 8 * fq, ci = (u.pn < 4) ? 0 : 1;
#pragma unroll
        for (int ai = 0; ai < 2; ++ai)
#pragma unroll
            for (int m = 0; m < 4; ++m) { const int row = row0 + ai * HALF + m * 16; const float cw = slot_c[(size_t)row * 2 + ci];
                const f32x4 g0 = acc[ai][0][m][0], g1 = acc[ai][0][m][1], u0 = acc[ai][1][m][0], u1 = acc[ai][1][m][1]; f32x4 x0, x1;
#pragma unroll
                for (int j = 0; j < 4; ++j) { x0[j] = fsilu(g0[j]) * u0[j] * cw; x1[j] = fsilu(g1[j]) * u1[j] * cw; }
                u32x4 w; w.x = cvt_pk_bf16(x0[0], x0[1]); w.y = cvt_pk_bf16(x0[2], x0[3]); w.z = cvt_pk_bf16(x1[0], x1[1]); w.w = cvt_pk_bf16(x1[2], x1[3]);
                *(u32x4*)(H + (size_t)row * 1024 + col0) = w; }
    }
};
struct Moe2P {
    static constexpr bool PERM = true, GATHER = false;
    int K, lda, ldb, G, c, ntiles, pid;
    const bf16_t* H; const bf16_t* W2;
    const bf16_t* hsrc; bf16_t* hdst; const int* slot_tok; const int* tile_bkt;
    __device__ __forceinline__ bool next(int i, Unit& u) const {
        const int m = 2 * ((c >> 3) + (G >> 3) * i) + ((c >> 2) & 1); if ((G & 7) != 0 || m >= ntiles) { if ((G & 7) == 0) return false; const long L = (long)i * G + c; if (L >= (long)ntiles * 4) return false; u.pm = (int)(L >> 2); u.pn = (int)(L & 3); u.prob = __builtin_amdgcn_readfirstlane(ld_vec_i32(tile_bkt + u.pm)); return true; }
        u.pm = m; u.pn = c & 3; u.prob = __builtin_amdgcn_readfirstlane(ld_vec_i32(tile_bkt + u.pm)); return true;
    }
    __device__ __forceinline__ const char* a_ptr(const Unit& u) const { return (const char*)(H + (size_t)u.pm * BM * 1024); }
    __device__ __forceinline__ unsigned a_voff(const Unit&, int, int) const { return 0u; }
    __device__ __forceinline__ const char* b_ptr(const Unit& u, int kt) const {
        int lo, hi; pair_lohi(u.prob % 6, lo, hi); const int e = (u.prob / 6) * 4 + ((kt < 8) ? lo : hi);
        return (const char*)(W2 + ((size_t)e * 1024 + (size_t)u.pn * BM) * 512) + (size_t)(kt & 7) * (BK * 2);
    }
    __device__ __forceinline__ void epi(const f32x4 (&acc)[2][2][4][2], const Unit& u, int wr, int wc, int fr, int fq) const {
        const int row0 = u.pm * BM + wr * 64 + fr, col0 = u.pn * BM + wc * 32 + 8 * fq;
        int tok[2][4];
#pragma unroll
        for (int ai = 0; ai < 2; ++ai)
#pragma unroll
            for (int m = 0; m < 4; ++m) tok[ai][m] = slot_tok[row0 + ai * HALF + m * 16];
#pragma unroll
        for (int ai = 0; ai < 2; ++ai) {
            u32x4 r[4][2];
#pragma unroll
            for (int m = 0; m < 4; ++m) { const int tk = tok[ai][m]; const bf16_t* rp = hsrc + (size_t)(tk < 0 ? 0 : tk) * 1024 + col0;
#pragma unroll
                for (int bj = 0; bj < 2; ++bj) r[m][bj] = *(const u32x4*)(rp + bj * HALF); }
#pragma unroll
            for (int m = 0; m < 4; ++m) { const int tk = tok[ai][m];
                if (tk >= 0) { bf16_t* wp = hdst + (size_t)tk * 1024 + col0;
#pragma unroll
                    for (int bj = 0; bj < 2; ++bj) { const u32x4 rw = r[m][bj]; const f32x4 a0 = acc[ai][bj][m][0], a1 = acc[ai][bj][m][1];
                        u32x4 w; w.x = cvt_pk_bf16(a0[0] + bflo(rw.x), a0[1] + bfhi(rw.x)); w.y = cvt_pk_bf16(a0[2] + bflo(rw.y), a0[3] + bfhi(rw.y));
                        w.z = cvt_pk_bf16(a1[0] + bflo(rw.z), a1[1] + bfhi(rw.z)); w.w = cvt_pk_bf16(a1[2] + bflo(rw.w), a1[3] + bfhi(rw.w));
                        *(u32x4*)(wp + bj * HALF) = w; } } }
        }
    }
};

struct Frame {
    LAS unsigned char* lds;
    int tid, lane, wave, G, bid;
    float* out; unsigned char* ws;
};
#define WSP(T, off) ((T*)(F.ws + (off)))

__device__ __forceinline__ void prep_tile(const Frame& F, const float* src, int src_ld, int k0, int kvalid, int c0, int nvalid, bf16_t* dst, int dst_ld, bool il = false) {
    LAS float* tl = (LAS float*)F.lds;
    __syncthreads();
#pragma unroll
    for (int p = 0; p < 2; ++p) { const int kk = (F.tid >> 4) + 32 * p, n4 = (F.tid & 15) * 4;
        f32x4 v = (f32x4){0.f, 0.f, 0.f, 0.f};
        if (il) {
            v = __builtin_nontemporal_load((const f32x4*)(src + (size_t)(k0 + kk) * src_ld + c0 + ((n4 < 32) ? n4 : 32 + n4))); const int d0 = 2 * (n4 & 31) + (n4 >> 5);
            tl[kk * 65 + d0] = v[0]; tl[kk * 65 + d0 + 2] = v[1]; tl[kk * 65 + d0 + 4] = v[2]; tl[kk * 65 + d0 + 6] = v[3];
        } else {
        if (kk < kvalid && n4 < nvalid) v = __builtin_nontemporal_load((const f32x4*)(src + (size_t)(k0 + kk) * src_ld + c0 + n4));
        tl[kk * 65 + n4 + 0] = v[0]; tl[kk * 65 + n4 + 1] = v[1]; tl[kk * 65 + n4 + 2] = v[2]; tl[kk * 65 + n4 + 3] = v[3]; } }
    __syncthreads();
    { const int n = F.tid >> 3, kc = (F.tid & 7) * 8; float x[8];
#pragma unroll
        for (int j = 0; j < 8; ++j) x[j] = tl[(kc + j) * 65 + n];
        u32x4 w; w.x = cvt_pk_bf16(x[0], x[1]); w.y = cvt_pk_bf16(x[2], x[3]); w.z = cvt_pk_bf16(x[4], x[5]); w.w = cvt_pk_bf16(x[6], x[7]);
        *(u32x4*)(dst + (size_t)n * dst_ld + k0 + kc) = w; }
}
__device__ __forceinline__ void phase_prep(const Params& p, const Frame& F, int id_lo, int id_hi, bool tables) {
    bf16_t* wb = WSP(bf16_t, WS_WB);
    constexpr int N0 = 1472, N1 = N0 + 512, N2 = N1 + 1024, N3 = N2 + 192, N4 = N3 + 192, N5 = N4 + 8192, N6 = N5 + 4096;
    (void)N6;
    for (int id = id_lo + F.bid; id < id_hi; id += F.G) {
        if (id < N0) { const int nt = id / 16, kt = id % 16, n0 = nt * 64; int c0, nv;
            if (n0 < PC_Q) { c0 = n0; nv = 64; } else if (n0 < PC_DT) { c0 = n0 + 16; nv = 64; } else if (n0 == PC_DT) { c0 = 2560; nv = 16; } else { c0 = 0; nv = 0; }
            const bool il = (n0 >= PC_Q && n0 < PC_V);
            if (il) c0 = 2576 + ((n0 - PC_Q) >> 7) * 128 + (((n0 - PC_Q) >> 6) & 1) * 32;
            prep_tile(F, p.in[4], 5648, kt * 64, 64, c0, nv, wb + WB_WIN / 2 + (size_t)n0 * 1024, 1024, il); }
        else if (id < N1) { const int j = id - N0, nt = j / 32, kt = j % 32; prep_tile(F, p.in[11], 1024, kt * 64, 64, nt * 64, 64, wb + WB_WOUT / 2 + (size_t)nt * 64 * 2048, 2048); }
        else if (id < N2) { const int j = id - N1, w = j / 256, r = j % 256, nt = r / 16, kt = r % 16; prep_tile(F, (w == 0) ? p.in[13] : (w == 1) ? p.in[14] : (w == 2) ? p.in[15] : p.in[16], 1024, kt * 64, 64, nt * 64, 64, wb + WB_WR / 2 + (size_t)w * 1048576 + (size_t)nt * 64 * 1024, 1024); }
        else if (id < N3) { const int j = id - N2, w = j / 64, r = j % 64, nt = r / 16, kt = r % 16; const int ncols = (w == 2) ? 160 : 64; int nv = ncols - nt * 64; nv = nv < 0 ? 0 : (nv > 64 ? 64 : nv);
            const float* src = (w == 0) ? p.in[18] : (w == 1) ? p.in[21] : p.in[23];
            prep_tile(F, src, ncols, kt * 64, 64, nt * 64, nv, wb + WB_L1 / 2 + (size_t)w * 262144 + (size_t)nt * 64 * 1024, 1024); }
        else if (id < N4) { const int j = id - N3, w = j / 64, r = j % 64, nt = r / 4, kt = r % 4; const int krows = (w == 2) ? 160 : 64; int kv = krows - kt * 64; kv = kv < 0 ? 0 : (kv > 64 ? 64 : kv);
            const float* src = (w == 0) ? p.in[19] : (w == 1) ? p.in[22] : p.in[24];
            prep_tile(F, src, 1024, kt * 64, kv, nt * 64, 64, wb + WB_L2 / 2 + (size_t)w * 262144 + (size_t)nt * 64 * 256, 256); }
        else if (id < N5) { const int j = id - N4, le = j / 256, r = j % 256, nt = r / 16, kt = r % 16;
            const int pn = nt >> 2, part = (nt >> 1) & 1, c0 = 128 * pn + 64 * (nt & 1);
            const float* src = (part ? p.in[35] : p.in[34]) + (size_t)le * 524288;
            prep_tile(F, src, 512, kt * 64, 64, c0, 64, wb + WB_W13 / 2 + (size_t)le * 1048576 + (size_t)nt * 64 * 1024, 1024); }
        else { const int j = id - N5, le = j / 128, r = j % 128, nt = r / 8, kt = r % 8;
            prep_tile(F, p.in[36] + (size_t)le * 524288, 1024, kt * 64, 64, nt * 64, 64, wb + WB_W2 / 2 + (size_t)le * 524288 + (size_t)nt * 64 * 512, 512); }
    }
    if (!tables) { __syncthreads(); return; }
    { float* rtw = WSP(float, WS_RTW);
        for (int idx = F.bid * NTHREADS + F.tid; idx < 2 * 20 * 1024; idx += F.G * NTHREADS) { const int l = idx / 20480, r = idx % 20480, j = r >> 10, k = r & 1023;
            rtw[idx] = (j < 4) ? p.in[30][(size_t)l * 4096 + k * 4 + j] : p.in[32][(size_t)l * 16384 + k * 16 + (j - 4)]; } }
    f32x2* rope = WSP(f32x2, WS_ROPE);
    for (int idx = F.bid * NTHREADS + F.tid; idx < SEQ * 64; idx += F.G * NTHREADS) {
        const int pos = idx >> 6, i = idx & 63;
        const float invf = exp2f(-(float)i * (13.287712379549449f / 64.f));
        const float ang = (float)pos * invf;
        const double x = (double)ang;
        const double kq = rint(x * 0.63661977236758134308);
        double r = fma(-kq, 1.57079632679489655800e+00, x); r = fma(-kq, 6.12323399573676603587e-17, r);
        const double r2 = r * r;
        double sp = -7.6471637318198164759e-13; sp = fma(sp, r2, 1.6059043836821614599e-10); sp = fma(sp, r2, -2.5052108385441718775e-08); sp = fma(sp, r2, 2.7557319223985890653e-06);
        sp = fma(sp, r2, -1.9841269841269841270e-04); sp = fma(sp, r2, 8.3333333333333333333e-03); sp = fma(sp, r2, -1.6666666666666666667e-01); const double sn = fma(sp * r2, r, r);
        double cp = 4.7794773323873852974e-14; cp = fma(cp, r2, -1.1470745597729724714e-11); cp = fma(cp, r2, 2.0876756987868098979e-09); cp = fma(cp, r2, -2.7557319223985890653e-07);
        cp = fma(cp, r2, 2.4801587301587301587e-05); cp = fma(cp, r2, -1.3888888888888888889e-03); cp = fma(cp, r2, 4.1666666666666666667e-02); cp = fma(cp, r2, -0.5); const double cs = fma(cp, r2, 1.0);
        const int q = ((int)kq) & 3;
        const double c = (q == 0) ? cs : (q == 1) ? -sn : (q == 2) ? -cs : sn;
        const double s = (q == 0) ? sn : (q == 1) ? cs : (q == 2) ? -sn : -cs;
        rope[idx] = (f32x2){(float)c, (float)s};
    }
}

__device__ __forceinline__ void row_load(const float* row, int lane, f32x4 (&v)[4]) {
#pragma unroll
    for (int j = 0; j < 4; ++j) v[j] = *(const f32x4*)(row + j * 256 + lane * 4);
}
__device__ __forceinline__ void row_load_nt(const float* row, int lane, f32x4 (&v)[4]) {
#pragma unroll
    for (int j = 0; j < 4; ++j) v[j] = __builtin_nontemporal_load((const f32x4*)(row + j * 256 + lane * 4));
}
__device__ __forceinline__ void row_load_bf_nt(const bf16_t* row, int lane, f32x4 (&v)[4]) {
#pragma unroll
    for (int j = 0; j < 4; ++j) { const u32x2 w = __builtin_nontemporal_load((const u32x2*)(row + j * 256 + lane * 4)); v[j] = (f32x4){bflo(w.x), bfhi(w.x), bflo(w.y), bfhi(w.y)}; }
}
__device__ __forceinline__ void row_load_bf(const bf16_t* row, int lane, f32x4 (&v)[4]) {
#pragma unroll
    for (int j = 0; j < 4; ++j) { const u32x2 w = *(const u32x2*)(row + j * 256 + lane * 4); v[j] = (f32x4){bflo(w.x), bfhi(w.x), bflo(w.y), bfhi(w.y)}; }
}
__device__ __forceinline__ float row_rstd(const f32x4 (&v)[4], float eps) {
    float ss = 0.f;
#pragma unroll
    for (int j = 0; j < 4; ++j) ss += v[j][0] * v[j][0] + v[j][1] * v[j][1] + v[j][2] * v[j][2] + v[j][3] * v[j][3];
    ss = wave_sum_u(ss);
    return rsqrtf(ss * (1.f / 1024.f) + eps);
}
__device__ __forceinline__ void row_store_bf16(bf16_t* row, int lane, const f32x4 (&v)[4]) {
#pragma unroll
    for (int j = 0; j < 4; ++j) { u32x2 w; w.x = cvt_pk_bf16(v[j][0], v[j][1]); w.y = cvt_pk_bf16(v[j][2], v[j][3]); *(u32x2*)(row + j * 256 + lane * 4) = w; }
}

template <bool TO_BF16, bool SRC_BF16 = false>
__device__ __forceinline__ void phase_rmsnorm(const Params& p, const Frame& F, const void* src_, const float* w, void* dst) {
    const float* src = (const float*)src_; const bf16_t* srcb = (const bf16_t*)src_; (void)src; (void)srcb;
    f32x4 wv[4]; row_load(w, F.lane, wv);
    int row = F.bid * 8 + F.wave; const int stride = F.G * 8;
    f32x4 v[4], vn[4];
    if (row < T_TOK) { if constexpr (SRC_BF16) row_load_bf_nt(srcb + (size_t)row * DM, F.lane, v); else row_load_nt(src + (size_t)row * DM, F.lane, v); }
    for (; row < T_TOK; row += stride) {
        if (row + stride < T_TOK) { if constexpr (SRC_BF16) row_load_bf_nt(srcb + (size_t)(row + stride) * DM, F.lane, vn); else row_load_nt(src + (size_t)(row + stride) * DM, F.lane, vn); }
        const float rs = row_rstd(v, 1e-6f);
#pragma unroll
        for (int j = 0; j < 4; ++j) v[j] = v[j] * rs * wv[j];
        if constexpr (TO_BF16) row_store_bf16((bf16_t*)dst + (size_t)row * DM, F.lane, v);
        else {
#pragma unroll
            for (int j = 0; j < 4; ++j) *(f32x4*)((float*)dst + (size_t)row * DM + j * 256 + F.lane * 4) = v[j];
        }
#pragma unroll
        for (int j = 0; j < 4; ++j) v[j] = vn[j];
    }
}

__device__ __forceinline__ void phase_conv(const Params& p, const Frame& F) {
    bf16_t* proj = WSP(bf16_t, WS_SLAB);
    bf16_t* xc = (bf16_t*)F.out;
    const float* conv_w = p.in[5]; const float* conv_b = p.in[6];
    for (int item = F.bid * 8 + F.wave; item < (T_TOK / 32) * 3; item += F.G * 8) {
        const int run = item / 3, cb = item - run * 3, c0 = cb * 512 + F.lane * 8, t0 = run * 32;
        float w[4][8], bb[8], xm3[8], xm2[8], xm1[8];
#pragma unroll
        for (int j = 0; j < 4; ++j) { const f32x4 a0 = *(const f32x4*)(conv_w + j * 1536 + c0), a1 = *(const f32x4*)(conv_w + j * 1536 + c0 + 4);
#pragma unroll
            for (int e = 0; e < 4; ++e) { w[j][e] = a0[e]; w[j][4 + e] = a1[e]; } }
        { const f32x4 a0 = *(const f32x4*)(conv_b + c0), a1 = *(const f32x4*)(conv_b + c0 + 4);
#pragma unroll
            for (int e = 0; e < 4; ++e) { bb[e] = a0[e]; bb[4 + e] = a1[e]; } }
        const bool first = (t0 & (SEQ - 1)) == 0;
        { u32x4 r3 = (u32x4){0u, 0u, 0u, 0u}, r2 = r3, r1 = r3;
            if (!first) { r3 = __builtin_nontemporal_load((const u32x4*)(proj + (size_t)(t0 - 3) * NPROJ + PC_XBC + c0)); r2 = __builtin_nontemporal_load((const u32x4*)(proj + (size_t)(t0 - 2) * NPROJ + PC_XBC + c0)); r1 = __builtin_nontemporal_load((const u32x4*)(proj + (size_t)(t0 - 1) * NPROJ + PC_XBC + c0)); }
            xm3[0] = bflo(r3.x); xm3[1] = bfhi(r3.x); xm3[2] = bflo(r3.y); xm3[3] = bfhi(r3.y); xm3[4] = bflo(r3.z); xm3[5] = bfhi(r3.z); xm3[6] = bflo(r3.w); xm3[7] = bfhi(r3.w);
            xm2[0] = bflo(r2.x); xm2[1] = bfhi(r2.x); xm2[2] = bflo(r2.y); xm2[3] = bfhi(r2.y); xm2[4] = bflo(r2.z); xm2[5] = bfhi(r2.z); xm2[6] = bflo(r2.w); xm2[7] = bfhi(r2.w);
            xm1[0] = bflo(r1.x); xm1[1] = bfhi(r1.x); xm1[2] = bflo(r1.y); xm1[3] = bfhi(r1.y); xm1[4] = bflo(r1.z); xm1[5] = bfhi(r1.z); xm1[6] = bflo(r1.w); xm1[7] = bfhi(r1.w); }
#pragma unroll 4
        for (int tt = 0; tt < 32; ++tt) {
            const u32x4 r = __builtin_nontemporal_load((const u32x4*)(proj + (size_t)(t0 + tt) * NPROJ + PC_XBC + c0));
            const float x[8] = {bflo(r.x), bfhi(r.x), bflo(r.y), bfhi(r.y), bflo(r.z), bfhi(r.z), bflo(r.w), bfhi(r.w)};
            float o[8];
#pragma unroll
            for (int e = 0; e < 8; ++e) { o[e] = fsilu(bb[e] + w[0][e] * xm3[e] + w[1][e] * xm2[e] + w[2][e] * xm1[e] + w[3][e] * x[e]); xm3[e] = xm2[e]; xm2[e] = xm1[e]; xm1[e] = x[e]; }
            u32x4 ow; ow.x = cvt_pk_bf16(o[0], o[1]); ow.y = cvt_pk_bf16(o[2], o[3]); ow.z = cvt_pk_bf16(o[4], o[5]); ow.w = cvt_pk_bf16(o[6], o[7]);
            *(u32x4*)(xc + (size_t)(t0 + tt) * 1536 + c0) = ow;
        }
    }
}

typedef float f32x16 __attribute__((ext_vector_type(16)));
typedef short s16x4 __attribute__((ext_vector_type(4)));
#define MFMA32(a, b, c) __builtin_amdgcn_mfma_f32_32x32x16_bf16((a), (b), (c), 0, 0, 0)
__device__ __forceinline__ unsigned off_b(unsigned row, unsigned ch) { return 256u * row + 16u * (ch ^ (((row & 3u) << 2) | ((row >> 2) & 3u))); }
__device__ __forceinline__ unsigned off_v(unsigned row, unsigned ch) { return 128u * row + 16u * (ch ^ (((row >> 1) & 1u) << 2)); }
__device__ __forceinline__ unsigned off_y(unsigned row, unsigned ch) { return 128u * row + 16u * (ch ^ (row & 7u)); }
__device__ __forceinline__ bf16x8 tr_read2(unsigned a0, unsigned a1) {
    s16x4 lo, hi;
    asm volatile("ds_read_b64_tr_b16 %0, %2\n\tds_read_b64_tr_b16 %1, %3\n\ts_waitcnt lgkmcnt(0)" : "=&v"(lo), "=&v"(hi) : "v"(a0), "v"(a1) : "memory");
    return __builtin_shufflevector(lo, hi, 0, 1, 2, 3, 4, 5, 6, 7);
}
__device__ __forceinline__ void tr_read4(unsigned a0, unsigned a1, unsigned a2, unsigned a3, bf16x8& f0, bf16x8& f1) {
    s16x4 r0, r1, r2, r3;
    asm volatile("ds_read_b64_tr_b16 %0, %4\n\tds_read_b64_tr_b16 %1, %5\n\tds_read_b64_tr_b16 %2, %6\n\tds_read_b64_tr_b16 %3, %7\n\ts_waitcnt lgkmcnt(0)"
                 : "=&v"(r0), "=&v"(r1), "=&v"(r2), "=&v"(r3) : "v"(a0), "v"(a1), "v"(a2), "v"(a3) : "memory");
    f0 = __builtin_shufflevector(r0, r1, 0, 1, 2, 3, 4, 5, 6, 7); f1 = __builtin_shufflevector(r2, r3, 0, 1, 2, 3, 4, 5, 6, 7);
}
__device__ __forceinline__ void tr_read8(unsigned a0, unsigned a1, unsigned a2, unsigned a3, unsigned a4, unsigned a5, unsigned a6, unsigned a7, bf16x8& f0, bf16x8& f1, bf16x8& f2, bf16x8& f3) {
    s16x4 r0, r1, r2, r3, r4, r5, r6, r7;
    asm volatile("ds_read_b64_tr_b16 %0, %8\n\tds_read_b64_tr_b16 %1, %9\n\tds_read_b64_tr_b16 %2, %10\n\tds_read_b64_tr_b16 %3, %11\n\tds_read_b64_tr_b16 %4, %12\n\tds_read_b64_tr_b16 %5, %13\n\tds_read_b64_tr_b16 %6, %14\n\tds_read_b64_tr_b16 %7, %15\n\ts_waitcnt lgkmcnt(0)"
                 : "=&v"(r0), "=&v"(r1), "=&v"(r2), "=&v"(r3), "=&v"(r4), "=&v"(r5), "=&v"(r6), "=&v"(r7) : "v"(a0), "v"(a1), "v"(a2), "v"(a3), "v"(a4), "v"(a5), "v"(a6), "v"(a7) : "memory");
    f0 = __builtin_shufflevector(r0, r1, 0, 1, 2, 3, 4, 5, 6, 7); f1 = __builtin_shufflevector(r2, r3, 0, 1, 2, 3, 4, 5, 6, 7);
    f2 = __builtin_shufflevector(r4, r5, 0, 1, 2, 3, 4, 5, 6, 7); f3 = __builtin_shufflevector(r6, r7, 0, 1, 2, 3, 4, 5, 6, 7);
}
__device__ __forceinline__ f32x16 zero16() { f32x16 z;
#pragma unroll
    for (int i = 0; i < 16; ++i) z[i] = 0.f;
    return z; }
__device__ __forceinline__ void phase_scan0(const Params& p, const Frame& F) {
    bf16_t* proj = WSP(bf16_t, WS_SLAB);
    const bf16_t* xc = (const bf16_t*)F.out;
    constexpr unsigned OQ = 0, OK = 32768, OV = 65536, OVW = 81920, OS = 98304, OY = 114688, OSM = 131072;
    LAS unsigned char* L = F.lds;
    const unsigned lbase = (unsigned)(__UINTPTR_TYPE__)L;
    LAS float* sm = (LAS float*)(L + OSM);
    const int lane = F.lane, w = F.wave, it = w >> 1, pt = w & 1;
    const unsigned h0 = lane >> 5, lr0 = lane & 31;
    const int trow = F.tid >> 2, tpart = F.tid & 3;
    const unsigned blk0 = (lane >> 4) & 1u, tq0 = (lane & 15u) >> 2, tp0 = lane & 3u;
    for (int ui = 0; ui < 2; ++ui) {
        const int uu = F.bid + ui * F.G;
        if (uu >= 512) break;
        const bool is_ssd = uu < 256; const int v = uu & 255, x8 = v & 7, slot = v >> 3;
        int b, hh, grp = 0, hr = 0, sl = 0;
        if (is_ssd) { const int pg = x8 + 8 * (slot >> 3), hg = slot & 7; b = pg >> 1; grp = pg & 1; hh = grp * 8 + hg; }
        else { const int pr = x8 + 8 * (slot >> 2); sl = slot & 3; b = pr >> 2; hr = pr & 3; hh = hr * 4 + sl; }
        const size_t row0 = (size_t)b * SEQ;
        const bf16_t* qptr; const bf16_t* kptr; const bf16_t* vptr; size_t qs, vs; bf16_t* optr;
        if (is_ssd) { qptr = xc + 1280 + grp * 128; kptr = xc + 1024 + grp * 128; vptr = xc + hh * 64; qs = 1536; vs = 1536; optr = proj + hh * 64; }
        else { qptr = proj + PC_Q + hr * 128; kptr = proj + PC_K + hr * 128; vptr = proj + PC_V + hr * 256 + sl * 64; qs = NPROJ; vs = NPROJ; optr = proj + 1024 + hr * 256 + sl * 64; }
        const bf16_t* zptr = proj + hh * 64;
        const float A_h = is_ssd ? -__expf(p.in[8][hh]) : 0.f, dtb = is_ssd ? p.in[7][hh] : 0.f, D_h = is_ssd ? p.in[9][hh] : 0.f;
        const float lng = __logf(1.f - exp2f(-5.f - (float)hr));
        u32x4 rv[2], rz[2]; float rdt0 = 0.f, rdt1 = 0.f;
        f32x16 St0 = zero16(), St1 = zero16();
        __syncthreads();
        for (int i = F.tid; i < 16384 / 16; i += NTHREADS) *(LAS u32x4*)(L + OS + i * 16) = (u32x4){0u, 0u, 0u, 0u};
#define SC_LOAD(c) do { const size_t r_ = row0 + (size_t)(c) * 128 + trow; \
            _Pragma("unroll") for (int e = 0; e < 2; ++e) rv[e] = *(const u32x4*)(vptr + r_ * vs + tpart * 16 + e * 8); \
            if (is_ssd && w == 0) { rdt0 = bf2f(proj[(row0 + (size_t)(c) * 128 + 2 * lane) * NPROJ + PC_DT + hh]); rdt1 = bf2f(proj[(row0 + (size_t)(c) * 128 + 2 * lane + 1) * NPROJ + PC_DT + hh]); } } while (0)
#define SC_DMA(c) do { _Pragma("unroll") for (int e = 0; e < 4; ++e) { const int I_ = w * 4 + e; const unsigned r_ = 4u * I_ + ((unsigned)lane >> 4), cs_ = lane & 15u, ch_ = cs_ ^ (((r_ & 3u) << 2) | ((r_ >> 2) & 3u)); \
            const size_t g_ = (row0 + (size_t)(c) * 128 + r_) * qs + ch_ * 8; \
            __builtin_amdgcn_global_load_lds((const unsigned*)(qptr + g_), (LAS unsigned*)(L + OQ + I_ * 1024), 16, 0, 0); \
            __builtin_amdgcn_global_load_lds((const unsigned*)(kptr + g_), (LAS unsigned*)(L + OK + I_ * 1024), 16, 0, 0); } } while (0)
#define SC_LOADZ(c) do { if (is_ssd) { const size_t r_ = row0 + (size_t)(c) * 128 + trow; rz[0] = __builtin_nontemporal_load((const u32x4*)(zptr + r_ * NPROJ + tpart * 16)); rz[1] = __builtin_nontemporal_load((const u32x4*)(zptr + r_ * NPROJ + tpart * 16 + 8)); } } while (0)
#define SC_SMALL(c) do { if (w == 0) { LAS float* sb = sm + ((c) & 1) * 384; float d0, d1, a0, a1; \
            if (is_ssd) { d0 = fsoftplus(rdt0 + dtb); d1 = fsoftplus(rdt1 + dtb); a0 = d0 * A_h; a1 = d1 * A_h; } else { d0 = 1.f; d1 = 1.f; a0 = lng; a1 = lng; } \
            float sc = a0 + a1; _Pragma("unroll") for (int o = 1; o < 64; o <<= 1) { const float tv = __shfl_up(sc, o); if (lane >= o) sc += tv; } \
            const float c1 = sc, c0 = sc - a1; const float tot = __shfl(sc, 63); \
            sb[2 * lane] = c0; sb[2 * lane + 1] = c1; sb[128 + 2 * lane] = d0; sb[128 + 2 * lane + 1] = d1; sb[256 + 2 * lane] = __expf(tot - c0) * d0; sb[256 + 2 * lane + 1] = __expf(tot - c1) * d1; } } while (0)
#define SC_STORE(c) do { const float wj_ = sm[((c) & 1) * 384 + 256 + trow]; \
            _Pragma("unroll") for (int e = 0; e < 2; ++e) { const u32x4 x_ = rv[e]; *(LAS u32x4*)(L + OV + off_v(trow, tpart * 2 + e)) = x_; u32x4 y_; \
                y_.x = cvt_pk_bf16(bflo(x_.x) * wj_, bfhi(x_.x) * wj_); y_.y = cvt_pk_bf16(bflo(x_.y) * wj_, bfhi(x_.y) * wj_); y_.z = cvt_pk_bf16(bflo(x_.z) * wj_, bfhi(x_.z) * wj_); y_.w = cvt_pk_bf16(bflo(x_.w) * wj_, bfhi(x_.w) * wj_); \
                *(LAS u32x4*)(L + OVW + off_v(trow, tpart * 2 + e)) = y_; } } while (0)
        SC_DMA(0); SC_LOAD(0); SC_LOADZ(0);
        SC_SMALL(0);
        __syncthreads();
        SC_STORE(0);
        asm volatile("s_waitcnt vmcnt(0)" ::: "memory");
        __syncthreads();
        SP_DECL;
        for (int c = 0; c < SEQ / 128; ++c) {
            SP_MARK(8);
            const LAS float* sb = sm + (c & 1) * 384;
            unsigned lr = lr0, h = h0, blk = blk0, tq_ = tq0, tp_ = tp0;
            asm volatile("" : "+v"(lr), "+v"(h), "+v"(blk), "+v"(tq_), "+v"(tp_));
            if (c + 1 < SEQ / 128) { SC_LOAD(c + 1); }
            const int ph = pt;
            const float ai = sb[32 * it + lr];
            f32x16 Yd0 = zero16(), Yd1 = zero16();
            for (int jt = ph; jt <= it; jt += 2) {
                f32x16 acc = zero16();
#pragma unroll
                for (int ks = 0; ks < 8; ++ks) { const bf16x8 ka = *(const LAS bf16x8*)(L + OK + off_b(32 * jt + lr, 2 * ks + h)), qb = *(const LAS bf16x8*)(L + OQ + off_b(32 * it + lr, 2 * ks + h)); acc = MFMA32(ka, qb, acc); }
                const bool diag = (jt == it);
#pragma unroll
                for (int g = 0; g < 4; ++g) { const f32x4 aj = *(const LAS f32x4*)(sb + 32 * jt + 8 * g + 4 * h), dj = *(const LAS f32x4*)(sb + 128 + 32 * jt + 8 * g + 4 * h);
#pragma unroll
                    for (int e = 0; e < 4; ++e) { const float dec = __expf(ai - aj[e]) * dj[e]; const bool ok = !diag || ((int)lr >= (int)(8 * g + 4 * h + e)); acc[4 * g + e] = ok ? acc[4 * g + e] * dec : 0.f; } }
#pragma unroll
                for (int s2 = 0; s2 < 2; ++s2) {
                    u32x4 pw; pw.x = cvt_pk_bf16(acc[8 * s2 + 0], acc[8 * s2 + 1]); pw.y = cvt_pk_bf16(acc[8 * s2 + 2], acc[8 * s2 + 3]); pw.z = cvt_pk_bf16(acc[8 * s2 + 4], acc[8 * s2 + 5]); pw.w = cvt_pk_bf16(acc[8 * s2 + 6], acc[8 * s2 + 7]);
                    const bf16x8 Pb = __builtin_bit_cast(bf16x8, pw);
                    const unsigned rb0 = 32 * jt + 16 * s2 + 4 * h + tq_, cc0 = 2 * blk + (tp_ >> 1), o8 = 8 * (tp_ & 1);
                    bf16x8 va0, va1;
                    tr_read4(lbase + OV + off_v(rb0, cc0) + o8, lbase + OV + off_v(rb0 + 8, cc0) + o8, lbase + OV + off_v(rb0, 4 + cc0) + o8, lbase + OV + off_v(rb0 + 8, 4 + cc0) + o8, va0, va1);
                    Yd0 = MFMA32(va0, Pb, Yd0); Yd1 = MFMA32(va1, Pb, Yd1);
                }
            }
            {
                f32x16 Yo = zero16();
#pragma unroll
                for (int ks = 0; ks < 8; ++ks) { const bf16x8 sa = *(const LAS bf16x8*)(L + OS + off_b(32 * ph + lr, 2 * ks + h)), qb = *(const LAS bf16x8*)(L + OQ + off_b(32 * it + lr, 2 * ks + h)); Yo = MFMA32(sa, qb, Yo); }
                const float ei = __expf(ai);
                if (ph == 0) {
#pragma unroll
                    for (int r = 0; r < 16; ++r) Yd0[r] += Yo[r] * ei; }
                else {
#pragma unroll
                    for (int r = 0; r < 16; ++r) Yd1[r] += Yo[r] * ei; }
            }
#pragma unroll
            for (int g = 0; g < 4; ++g) { u32x2 yw;
                if (ph == 0) { yw.x = cvt_pk_bf16(Yd1[4 * g], Yd1[4 * g + 1]); yw.y = cvt_pk_bf16(Yd1[4 * g + 2], Yd1[4 * g + 3]); } else { yw.x = cvt_pk_bf16(Yd0[4 * g], Yd0[4 * g + 1]); yw.y = cvt_pk_bf16(Yd0[4 * g + 2], Yd0[4 * g + 3]); }
                *(LAS u32x2*)(L + OY + off_y(32 * it + lr, 4 * (1 - ph) + g) + 8 * h) = yw; }
            const float dl = __expf(sb[127]);
            const int st0 = (w == 0) ? 0 : (w == 1) ? 2 : (w == 2) ? 4 : (w == 3) ? 5 : (w == 5) ? 6 : -1, st1 = (w == 0) ? 1 : (w == 1) ? 3 : (w == 5) ? 7 : -1;
            if (st0 >= 0) {
                const int spt = st0 & 1, snt = st0 >> 1;
#pragma unroll
                for (int r = 0; r < 16; ++r) St0[r] *= dl;
#pragma unroll
                for (int k2 = 0; k2 < 4; ++k2) { const unsigned rb = 32 * k2 + 8 * h + tq_, cv = 4 * spt + 2 * blk + (tp_ >> 1), cb = 4 * snt + 2 * blk + (tp_ >> 1), o8 = 8 * (tp_ & 1);
                    bf16x8 fa0, fb0, fa1, fb1;
                    tr_read8(lbase + OVW + off_v(rb, cv) + o8, lbase + OVW + off_v(rb + 4, cv) + o8, lbase + OK + off_b(rb, cb) + o8, lbase + OK + off_b(rb + 4, cb) + o8,
                             lbase + OVW + off_v(rb + 16, cv) + o8, lbase + OVW + off_v(rb + 20, cv) + o8, lbase + OK + off_b(rb + 16, cb) + o8, lbase + OK + off_b(rb + 20, cb) + o8, fa0, fb0, fa1, fb1);
                    St0 = MFMA32(fa0, fb0, St0); St0 = MFMA32(fa1, fb1, St0); }
                if (st1 >= 0) {
                    const int spt1 = st1 & 1, snt1 = st1 >> 1;
#pragma unroll
                    for (int r = 0; r < 16; ++r) St1[r] *= dl;
#pragma unroll
                    for (int k2 = 0; k2 < 4; ++k2) { const unsigned rb = 32 * k2 + 8 * h + tq_, cv = 4 * spt1 + 2 * blk + (tp_ >> 1), cb = 4 * snt1 + 2 * blk + (tp_ >> 1), o8 = 8 * (tp_ & 1);
                        bf16x8 fa0, fb0, fa1, fb1;
                        tr_read8(lbase + OVW + off_v(rb, cv) + o8, lbase + OVW + off_v(rb + 4, cv) + o8, lbase + OK + off_b(rb, cb) + o8, lbase + OK + off_b(rb + 4, cb) + o8,
                                 lbase + OVW + off_v(rb + 16, cv) + o8, lbase + OVW + off_v(rb + 20, cv) + o8, lbase + OK + off_b(rb + 16, cb) + o8, lbase + OK + off_b(rb + 20, cb) + o8, fa0, fb0, fa1, fb1);
                        St1 = MFMA32(fa0, fb0, St1); St1 = MFMA32(fa1, fb1, St1); }
                }
            }
            if (c + 1 < SEQ / 128) SC_SMALL(c + 1);
            __syncthreads();
#pragma unroll
            for (int g = 0; g < 4; ++g) { LAS u32x2* yp = (LAS u32x2*)(L + OY + off_y(32 * it + lr, 4 * ph + g) + 8 * h); const u32x2 pv_ = *yp; u32x2 yw;
                if (ph == 0) { yw.x = cvt_pk_bf16(Yd0[4 * g] + bflo(pv_.x), Yd0[4 * g + 1] + bfhi(pv_.x)); yw.y = cvt_pk_bf16(Yd0[4 * g + 2] + bflo(pv_.y), Yd0[4 * g + 3] + bfhi(pv_.y)); }
                else { yw.x = cvt_pk_bf16(Yd1[4 * g] + bflo(pv_.x), Yd1[4 * g + 1] + bfhi(pv_.x)); yw.y = cvt_pk_bf16(Yd1[4 * g + 2] + bflo(pv_.y), Yd1[4 * g + 3] + bfhi(pv_.y)); }
                *yp = yw; }
            __syncthreads();
            SP_MARK(5);
            if (c + 1 < SEQ / 128) SC_DMA(c + 1);
            if (st0 >= 0) {
                const int spt = st0 & 1, snt = st0 >> 1;
#pragma unroll
                for (int r = 0; r < 16; ++r) { const unsigned pr = 32 * spt + (r & 3) + 8 * (r >> 2) + 4 * h, n = 32 * snt + lr; *(LAS bf16_t*)(L + OS + off_b(pr, n >> 3) + 2 * (n & 7)) = f2bf(St0[r]); }
                if (st1 >= 0) { const int spt1 = st1 & 1, snt1 = st1 >> 1;
#pragma unroll
                    for (int r = 0; r < 16; ++r) { const unsigned pr = 32 * spt1 + (r & 3) + 8 * (r >> 2) + 4 * h, n = 32 * snt1 + lr; *(LAS bf16_t*)(L + OS + off_b(pr, n >> 3) + 2 * (n & 7)) = f2bf(St1[r]); }
                }
            }
            {
                bf16_t* orow = optr + (row0 + (size_t)c * 128 + trow) * NPROJ + tpart * 16;
#pragma unroll
                for (int e = 0; e < 2; ++e) {
                    const u32x4 yv = *(const LAS u32x4*)(L + OY + off_y(trow, tpart * 2 + e));
                    u32x4 ov = yv;
                    if (is_ssd) { const u32x4 xv = *(const LAS u32x4*)(L + OV + off_v(trow, tpart * 2 + e)); const u32x4 zv = rz[e];
                        ov.x = cvt_pk_bf16((bflo(yv.x) + bflo(xv.x) * D_h) * fsilu(bflo(zv.x)), (bfhi(yv.x) + bfhi(xv.x) * D_h) * fsilu(bfhi(zv.x)));
                        ov.y = cvt_pk_bf16((bflo(yv.y) + bflo(xv.y) * D_h) * fsilu(bflo(zv.y)), (bfhi(yv.y) + bfhi(xv.y) * D_h) * fsilu(bfhi(zv.y)));
                        ov.z = cvt_pk_bf16((bflo(yv.z) + bflo(xv.z) * D_h) * fsilu(bflo(zv.z)), (bfhi(yv.z) + bfhi(xv.z) * D_h) * fsilu(bfhi(zv.z)));
                        ov.w = cvt_pk_bf16((bflo(yv.w) + bflo(xv.w) * D_h) * fsilu(bflo(zv.w)), (bfhi(yv.w) + bfhi(xv.w) * D_h) * fsilu(bfhi(zv.w))); }
                    *(u32x4*)(orow + e * 8) = ov;
                }
            }
            if (c + 1 < SEQ / 128) { SC_LOADZ(c + 1); }
            __syncthreads();
            SP_MARK(6);
            if (c + 1 < SEQ / 128) SC_STORE(c + 1);
            asm volatile("s_waitcnt vmcnt(0)" ::: "memory");
            __syncthreads();
            SP_MARK(7);
        }
#undef SC_LOAD
#undef SC_LOADZ
#undef SC_SMALL
#undef SC_STORE
    }
}

__device__ __forceinline__ void phase_gatenorm(const Params& p, const Frame& F) {
    const bf16_t* proj = WSP(bf16_t, WS_SLAB);
    bf16_t* ybuf = WSP(bf16_t, WS_SLAB);
    const float* nw = p.in[10];
    int row = F.bid * 8 + F.wave; const int stride = F.G * 8;
    u32x4 yc[4], gc[2], yn[4], gn[2];
#define GN_LOAD(r_, Y_, G_) do { const bf16_t* b_ = ybuf + (size_t)(r_) * NPROJ; _Pragma("unroll") for (int j = 0; j < 4; ++j) Y_[j] = *(const u32x4*)(b_ + j * 512 + F.lane * 8); \
        _Pragma("unroll") for (int j = 0; j < 2; ++j) G_[j] = __builtin_nontemporal_load((const u32x4*)(b_ + PC_G + j * 512 + F.lane * 8)); } while (0)
    if (row < T_TOK) GN_LOAD(row, yc, gc);
    for (; row < T_TOK; row += stride) {
        if (row + stride < T_TOK) GN_LOAD(row + stride, yn, gn);
        bf16_t* yr = ybuf + (size_t)row * NPROJ;
#pragma unroll
        for (int j = 0; j < 4; ++j) {
            const u32x4 w = yc[j];
            float x[8] = {bflo(w.x), bfhi(w.x), bflo(w.y), bfhi(w.y), bflo(w.z), bfhi(w.z), bflo(w.w), bfhi(w.w)};
            float ss = 0.f;
#pragma unroll
            for (int e = 0; e < 8; ++e) ss += x[e] * x[e];
            if (j < 2) { ss = wave_sum_u(ss); const float rs = rsqrtf(ss * (1.f / 512.f) + 1e-5f);
                const f32x4 w0 = *(const f32x4*)(nw + j * 512 + F.lane * 8), w1 = *(const f32x4*)(nw + j * 512 + F.lane * 8 + 4);
#pragma unroll
                for (int e = 0; e < 4; ++e) { x[e] *= rs * w0[e]; x[4 + e] *= rs * w1[e]; } }
            else {
                ss = dpp_sum16(ss); ss += __shfl_xor(ss, 16);
                const float rs = rsqrtf(ss * (1.f / 256.f) + 1e-6f);
                const u32x4 gw = gc[j - 2];
                const float g[8] = {bflo(gw.x), bfhi(gw.x), bflo(gw.y), bfhi(gw.y), bflo(gw.z), bfhi(gw.z), bflo(gw.w), bfhi(gw.w)};
#pragma unroll
                for (int e = 0; e < 8; ++e) x[e] *= rs * fsilu(g[e]); }
            u32x4 o; o.x = cvt_pk_bf16(x[0], x[1]); o.y = cvt_pk_bf16(x[2], x[3]); o.z = cvt_pk_bf16(x[4], x[5]); o.w = cvt_pk_bf16(x[6], x[7]);
            *(u32x4*)(yr + j * 512 + F.lane * 8) = o;
        }
#pragma unroll
        for (int j = 0; j < 4; ++j) yc[j] = yn[j];
        gc[0] = gn[0]; gc[1] = gn[1];
    }
#undef GN_LOAD
}

__device__ __forceinline__ void phase_moe_route(const Params& p, const Frame& F, int layer, const bf16_t* h, bf16_t* tbuf) {
    unsigned char* meta = F.ws + WS_META + (size_t)layer * META_STRIDE;
    int* tok_rank = (int*)(meta + MT_RANK); int* tok_bkt = (int*)(meta + MT_BKT); f32x2* tok_c = (f32x2*)(meta + MT_C);
    int* gcount = (int*)(F.ws + WS_CTL + CTL_CNT_OFF) + layer * 32;
    const float* bg = p.in[31] + layer * 4; const float* be = p.in[33] + layer * 16;
    LAS float* wl = (LAS float*)F.lds;
    LAS int* lcount = (LAS int*)(F.lds + 81920);
    LAS int* lbase = lcount + 32;
    LAS int* l_bkt = lbase + 32;
    LAS int* l_rank = l_bkt + 1024;
    LAS float* l_c = (LAS float*)(l_rank + 1024);
    LAS float* lgt = (LAS float*)(F.lds + 98816);
    __syncthreads();
    { const float* wrt = WSP(float, WS_RTW) + (size_t)layer * 20480;
        for (int idx = F.tid; idx < 20 * 1024 / 4; idx += NTHREADS) *(LAS f32x4*)(wl + idx * 4) = *(const f32x4*)(wrt + idx * 4); }
    if (F.tid < 32) lcount[F.tid] = 0;
    __syncthreads();
    const int TPB = (T_TOK + F.G - 1) / F.G, tok0 = F.bid * TPB;
    f32x4 wv[4]; row_load(p.in[2] + (size_t)layer * DM, F.lane, wv);
    f32x4 va[4], vb[4], na[4], nb[4];
    int hsel;
    { unsigned t0_ = 0u, t1_ = 1u; asm volatile("s_nop 1\n\tv_permlane32_swap_b32 %0, %1\n\ts_nop 1" : "+v"(t0_), "+v"(t1_)); hsel = (t0_ + t1_ >= 2u) ? 10 : 0; }
#define RT_LOAD(li_, A_, B_) do { const int ta_ = tok0 + (li_), tb_ = ta_ + 8; \
        if ((li_) < TPB && ta_ < T_TOK) row_load_bf_nt(h + (size_t)ta_ * DM, F.lane, A_); if ((li_) + 8 < TPB && tb_ < T_TOK) row_load_bf_nt(h + (size_t)tb_ * DM, F.lane, B_); } while (0)
    RT_LOAD(F.wave, va, vb);
    for (int li = F.wave; li < TPB; li += 16) {
        const int tok = tok0 + li; if (tok >= T_TOK) break;
        const bool hasb = (li + 8 < TPB) && (tok + 8 < T_TOK);
        RT_LOAD(li + 16, na, nb);
        const float rsa = row_rstd(va, 1e-6f), rsb = row_rstd(vb, 1e-6f);
#pragma unroll
        for (int j = 0; j < 4; ++j) { va[j] = va[j] * rsa * wv[j]; vb[j] = vb[j] * rsb * wv[j]; }
        row_store_bf16(tbuf + (size_t)tok * DM, F.lane, va);
        if (hasb) row_store_bf16(tbuf + (size_t)(tok + 8) * DM, F.lane, vb);
        LAS float* lga = lgt + li * 20; LAS float* lgb = lgt + (li + 8) * 20;
#pragma unroll
        for (int o = 0; o < 10; ++o) { f32x2 c0 = (f32x2){0.f, 0.f}, c1 = c0, d0 = c0, d1 = c0;
#pragma unroll
            for (int j = 0; j < 4; ++j) { const f32x4 w4 = *(const LAS f32x4*)(wl + o * 1024 + j * 256 + F.lane * 4), w5 = *(const LAS f32x4*)(wl + (o + 10) * 1024 + j * 256 + F.lane * 4);
                const f32x2 w4l = (f32x2){w4[0], w4[1]}, w4h = (f32x2){w4[2], w4[3]}, w5l = (f32x2){w5[0], w5[1]}, w5h = (f32x2){w5[2], w5[3]};
                const f32x2 al = (f32x2){va[j][0], va[j][1]}, ah = (f32x2){va[j][2], va[j][3]}, bl = (f32x2){vb[j][0], vb[j][1]}, bh = (f32x2){vb[j][2], vb[j][3]};
                c0 += al * w4l; c0 += ah * w4h; c1 += al * w5l; c1 += ah * w5h; d0 += bl * w4l; d0 += bh * w4h; d1 += bl * w5l; d1 += bh * w5h; }
            float a0 = c0[0] + c0[1], a1 = c1[0] + c1[1], b0 = d0[0] + d0[1], b1 = d1[0] + d1[1];
            asm volatile("s_nop 1\n\tv_permlane32_swap_b32 %0, %1\n\tv_permlane32_swap_b32 %2, %3\n\ts_nop 1" : "+v"(a0), "+v"(a1), "+v"(b0), "+v"(b1));
            float sa = dpp_sum16(a0 + a1), sb_ = dpp_sum16(b0 + b1);
            sa += __builtin_bit_cast(float, __builtin_amdgcn_update_dpp(0, __builtin_bit_cast(int, sa), 0x142, 0xA, 0xF, false));
            sb_ += __builtin_bit_cast(float, __builtin_amdgcn_update_dpp(0, __builtin_bit_cast(int, sb_), 0x142, 0xA, 0xF, false));
            if ((F.lane & 31) == 16) { lga[hsel + o] = sa; if (hasb) lgb[hsel + o] = sb_; }
            if (o & 1) __builtin_amdgcn_sched_barrier(0); }
#pragma unroll
        for (int j = 0; j < 4; ++j) { va[j] = na[j]; vb[j] = nb[j]; }
    }
#undef RT_LOAD
    __syncthreads();
    for (int li = F.tid; li < TPB; li += NTHREADS) {
        if (tok0 + li >= T_TOK) break;
        float lg[20];
#pragma unroll
        for (int o = 0; o < 20; ++o) lg[o] = lgt[li * 20 + o];
        float g0 = lg[0] + bg[0], g1 = lg[1] + bg[1], g2 = lg[2] + bg[2], g3 = lg[3] + bg[3];
        int gi = 0; float gm = g0; if (g1 > gm) { gm = g1; gi = 1; } if (g2 > gm) { gm = g2; gi = 2; } if (g3 > gm) { gm = g3; gi = 3; }
        const float gate = 1.f / (__expf(g0 - gm) + __expf(g1 - gm) + __expf(g2 - gm) + __expf(g3 - gm));
        float e0, e1, e2, e3;
        e0 = (gi == 0) ? lg[4] : (gi == 1) ? lg[8] : (gi == 2) ? lg[12] : lg[16];
        e1 = (gi == 0) ? lg[5] : (gi == 1) ? lg[9] : (gi == 2) ? lg[13] : lg[17];
        e2 = (gi == 0) ? lg[6] : (gi == 1) ? lg[10] : (gi == 2) ? lg[14] : lg[18];
        e3 = (gi == 0) ? lg[7] : (gi == 1) ? lg[11] : (gi == 2) ? lg[15] : lg[19];
        e0 += be[gi * 4 + 0]; e1 += be[gi * 4 + 1]; e2 += be[gi * 4 + 2]; e3 += be[gi * 4 + 3];
        int i1 = 0; float v1 = e0; if (e1 > v1) { v1 = e1; i1 = 1; } if (e2 > v1) { v1 = e2; i1 = 2; } if (e3 > v1) { v1 = e3; i1 = 3; }
        int i2 = -1; float v2 = -3.0e38f;
        if (i1 != 0 && e0 > v2) { v2 = e0; i2 = 0; } if (i1 != 1 && e1 > v2) { v2 = e1; i2 = 1; } if (i1 != 2 && e2 > v2) { v2 = e2; i2 = 2; } if (i1 != 3 && e3 > v2) { v2 = e3; i2 = 3; }
        const float w1 = gate / (1.f + __expf(v2 - v1)), w2 = gate - w1;
        const int lo = i1 < i2 ? i1 : i2, hi = i1 < i2 ? i2 : i1; const float clo = i1 < i2 ? w1 : w2, chi = i1 < i2 ? w2 : w1;
        const int pr = (lo == 0) ? hi - 1 : (lo == 1) ? hi + 1 : 5;
        const int bk = gi * 6 + pr;
        l_bkt[li] = bk; l_c[li * 2] = clo; l_c[li * 2 + 1] = chi;
        l_rank[li] = __hip_atomic_fetch_add((int*)(lcount + bk), 1, __ATOMIC_RELAXED, __HIP_MEMORY_SCOPE_WORKGROUP);
    }
    __syncthreads();
    if (F.tid < 24) lbase[F.tid] = __hip_atomic_fetch_add(gcount + F.tid, lcount[F.tid], __ATOMIC_RELAXED, __HIP_MEMORY_SCOPE_AGENT);
    __syncthreads();
    for (int li = F.tid; li < TPB; li += NTHREADS) { const int tok = tok0 + li; if (tok < T_TOK) { const int bk = l_bkt[li]; tok_bkt[tok] = bk; tok_rank[tok] = lbase[bk] + l_rank[li]; tok_c[tok] = (f32x2){l_c[li * 2], l_c[li * 2 + 1]}; } }
}
__device__ __forceinline__ void phase_moe_slots(const Params& p, const Frame& F, int layer) {
    unsigned char* meta = F.ws + WS_META + (size_t)layer * META_STRIDE;
    const int* tok_rank = (const int*)(meta + MT_RANK); const int* tok_bkt = (const int*)(meta + MT_BKT); const f32x2* tok_c = (const f32x2*)(meta + MT_C);
    int* slot_tok = (int*)(meta + MT_STOK); f32x2* slot_c = (f32x2*)(meta + MT_SC); int* tile_tab = (int*)(meta + MT_TILE);
    int* gcount = (int*)(F.ws + WS_CTL + CTL_CNT_OFF) + layer * 32;
    LAS int* cnt = (LAS int*)F.lds; LAS int* start = cnt + 32;
    __syncthreads();
    if (F.tid < 24) cnt[F.tid] = __hip_atomic_load(gcount + F.tid, __ATOMIC_RELAXED, __HIP_MEMORY_SCOPE_AGENT);
    __syncthreads();
    if (F.tid == 0) { int a = 0; for (int b = 0; b < 24; ++b) { start[b] = a; a += (cnt[b] + 255) >> 8; } start[24] = a; }
    __syncthreads();
    for (int tok = F.bid * NTHREADS + F.tid; tok < T_TOK; tok += F.G * NTHREADS) { const int bk = tok_bkt[tok]; const int slot = start[bk] * 256 + tok_rank[tok]; slot_tok[slot] = tok; slot_c[slot] = tok_c[tok]; }
    for (int b = F.bid; b < 24; b += F.G) { const int s0 = start[b] * 256 + cnt[b], s1 = start[b + 1] * 256;
        for (int s = s0 + F.tid; s < s1; s += NTHREADS) { slot_tok[s] = -1; slot_c[s] = (f32x2){0.f, 0.f}; } }
    if (F.bid == 0) { if (F.tid == 0) tile_tab[0] = start[24];
        for (int m = F.tid; m < 288; m += NTHREADS) { int bk = 23; for (int b = 0; b < 24; ++b) if (m >= start[b] && m < start[b + 1]) bk = b; tile_tab[64 + m] = bk; } }
}

template <int SET>
__device__ __forceinline__ void phase_mix(const Params& p, const Frame& F, const bf16_t* h, bf16_t* o0, bf16_t* o1, bf16_t* o2) {
    const float* mu = p.in[12];
    constexpr int M0 = SET ? 0 : 1, M1 = SET ? 2 : 4, M2 = SET ? 3 : 5;
    f32x4 wv[4], m0[4], m1[4], m2[4];
    row_load(p.in[1] + DM, F.lane, wv); row_load(mu + M0 * DM, F.lane, m0); row_load(mu + M1 * DM, F.lane, m1); row_load(mu + M2 * DM, F.lane, m2);
    for (int run = F.bid * 8 + F.wave; run < T_TOK / 32; run += F.G * 8) {
        const int t0 = run * 32;
        f32x4 up[4];
        if ((t0 & (SEQ - 1)) == 0) {
#pragma unroll
            for (int j = 0; j < 4; ++j) up[j] = (f32x4){0.f, 0.f, 0.f, 0.f};
        } else { row_load_bf(h + (size_t)(t0 - 1) * DM, F.lane, up); const float rs = row_rstd(up, 1e-6f);
#pragma unroll
            for (int j = 0; j < 4; ++j) up[j] = up[j] * rs * wv[j]; }
        f32x4 u[4], un[4]; if constexpr (SET == 1) row_load_bf_nt(h + (size_t)t0 * DM, F.lane, u); else row_load_bf(h + (size_t)t0 * DM, F.lane, u);
        for (int tt = 0; tt < 32; ++tt) {
            if (tt + 1 < 32) { if constexpr (SET == 1) row_load_bf_nt(h + (size_t)(t0 + tt + 1) * DM, F.lane, un); else row_load_bf(h + (size_t)(t0 + tt + 1) * DM, F.lane, un); }
            const float rs = row_rstd(u, 1e-6f);
            f32x4 a[4], b[4], c[4];
#pragma unroll
            for (int j = 0; j < 4; ++j) { u[j] = u[j] * rs * wv[j]; const f32x4 xx = up[j] - u[j]; a[j] = u[j] + xx * m0[j]; b[j] = u[j] + xx * m1[j]; c[j] = u[j] + xx * m2[j]; up[j] = u[j]; }
            row_store_bf16(o0 + (size_t)(t0 + tt) * DM, F.lane, a); row_store_bf16(o1 + (size_t)(t0 + tt) * DM, F.lane, b); row_store_bf16(o2 + (size_t)(t0 + tt) * DM, F.lane, c);
#pragma unroll
            for (int j = 0; j < 4; ++j) u[j] = un[j];
        }
    }
}

typedef __bf16 bf16x2v __attribute__((ext_vector_type(2)));
__device__ __forceinline__ unsigned pkc(float lo, float hi) { f32x2 t = {lo, hi}; bf16x2v r = __builtin_convertvector(t, bf16x2v); return __builtin_bit_cast(unsigned, r); }
__device__ __forceinline__ unsigned off_r(unsigned row, unsigned ch) { return row * 128u + 16u * (ch ^ ((row >> 1) & 7u)); }
__device__ __forceinline__ unsigned off_m(unsigned row, unsigned ch) { return row * 64u + 16u * (ch ^ ((0u - (row >> 2)) & 3u)); }
#define MFMA16(a, b, c) __builtin_amdgcn_mfma_f32_16x16x32_bf16((a), (b), (c), 0, 0, 0)
__device__ __forceinline__ void swap32(float& a, float& b) { asm volatile("s_nop 1\n\tv_permlane32_swap_b32 %0, %1\n\ts_nop 1" : "+v"(a), "+v"(b)); }
__device__ __forceinline__ float half_sum(float x, bool hf) {
    x = dpp_sum16(x);
    x += __builtin_bit_cast(float, __builtin_amdgcn_update_dpp(0, __builtin_bit_cast(int, x), 0x142, 0xA, 0xF, false));
    const float lo = __builtin_bit_cast(float, __builtin_amdgcn_readlane(__builtin_bit_cast(int, x), 31)), hi = __builtin_bit_cast(float, __builtin_amdgcn_readlane(__builtin_bit_cast(int, x), 63));
    return hf ? hi : lo;
}
__device__ __forceinline__ void phase_rwkv(const Params& p, const Frame& F, bf16_t* rbuf, const bf16_t* kbuf, const bf16_t* vbuf, const bf16_t* ebuf, const bf16_t* abuf, const bf16_t* gbuf) {
    constexpr unsigned ORA = 0, OLB = 16384, OMS = 32768, OMU = 49152, OMY = 53248, OAB = 57344, OAK = 61440, OVT = 65536, OGC = 73728, OYS = 74752, OVF = 91136, OGG = 107520, OBON = 123904;
    LAS unsigned char* L = F.lds;
    const float* k_k = p.in[25]; const float* k_a = p.in[26]; const float* r_k = p.in[27]; const float* lnw = p.in[28]; const float* lnb = p.in[29];
    const int lane0 = F.lane, w = F.wave, pc = w >> 1, th = w & 1;
    for (int unit = F.bid; unit < 256; unit += F.G) {
        const int b = unit >> 4, hd = unit & 15;
        const int gc2 = hd * 64 + 2 * (lane0 & 31);
        const f32x2 kkw = *(const f32x2*)(k_k + gc2), kaw = *(const f32x2*)(k_a + gc2), rkw = *(const f32x2*)(r_k + gc2), lw = *(const f32x2*)(lnw + gc2), lb = *(const f32x2*)(lnb + gc2);
        int lane = lane0;
        f32x4 St[4];
#pragma unroll
        for (int mt = 0; mt < 4; ++mt) St[mt] = (f32x4){0.f, 0.f, 0.f, 0.f};
        unsigned pr[4], pk[4], pv[4], pe[4], pa[4], pg[4], pe0[4];
#define RW_LOAD(t0_) do { const size_t ub_ = ((size_t)b * SEQ + (t0_) + 16 * pc + 8 * th) * DM + hd * 64, ub0_ = ((size_t)b * SEQ + (t0_) + 16 * pc) * DM + hd * 64;     \
            const bf16_t* r_ = rbuf + ub_; const bf16_t* k_ = kbuf + ub_; const bf16_t* v_ = vbuf + ub_; const bf16_t* e_ = ebuf + ub_; const bf16_t* a_ = abuf + ub_; const bf16_t* g_ = gbuf + ub_; const bf16_t* e0_ = ebuf + ub0_; \
            _Pragma("unroll") for (int it = 0; it < 4; ++it) { const unsigned lo_ = (unsigned)((4 * (lane >> 5) + it) * DM + 2 * (lane & 31)); \
            pr[it] = __builtin_nontemporal_load((const unsigned*)(r_ + lo_)); pk[it] = __builtin_nontemporal_load((const unsigned*)(k_ + lo_)); pv[it] = __builtin_nontemporal_load((const unsigned*)(v_ + lo_)); pe[it] = __builtin_nontemporal_load((const unsigned*)(e_ + lo_)); pa[it] = __builtin_nontemporal_load((const unsigned*)(a_ + lo_)); pg[it] = __builtin_nontemporal_load((const unsigned*)(g_ + lo_)); pe0[it] = *(const unsigned*)(e0_ + lo_); } } while (0)
        RW_LOAD(0);
        SP_DECL;
        for (int t0 = 0; t0 < SEQ; t0 += 64) {
            __syncthreads();
            SP_MARK(4);
            asm volatile("" : "+v"(lane));
            const unsigned l15 = lane & 15, q = (unsigned)lane >> 4, cp = lane & 31;
            const bool hf = lane >= 32;
            const unsigned pj = 32u * (cp >> 4) + 8u * ((cp & 7) >> 1) + 2u * (cp & 1) + ((cp & 8) ? 4u : 0u);
            {
                float pl0[4], pl1[4], ls0 = 0.f, ls1 = 0.f, f0 = 0.f, f1 = 0.f;
#pragma unroll
                for (int it = 0; it < 4; ++it) { ls0 += bflo(pe[it]); ls1 += bfhi(pe[it]); pl0[it] = ls0; pl1[it] = ls1; f0 += bflo(pe0[it]); f1 += bfhi(pe0[it]); }
                float xa0 = 0.f, xb0 = ls0, xa1 = 0.f, xb1 = ls1; swap32(xa0, xb0); swap32(xa1, xb1);
                float ya0 = f0, yb0 = f0, ya1 = f1, yb1 = f1; swap32(ya0, yb0); swap32(ya1, yb1);
                const float base0 = xa0 + (th ? f0 + (hf ? ya0 : yb0) : 0.f), base1 = xa1 + (th ? f1 + (hf ? ya1 : yb1) : 0.f);
                float ms0[8], ms1[8], vt0[4], vt1[4];
                LAS unsigned char* ra = L + ORA + pc * 4096; LAS unsigned char* lbp = L + OLB + pc * 4096;
#pragma unroll
                for (int it = 0; it < 4; ++it) {
                    const int t = 8 * th + 4 * (int)hf + it, tb = 16 * pc + t;
                    const float r0 = bflo(pr[it]), r1 = bfhi(pr[it]), k0 = bflo(pk[it]), k1 = bfhi(pk[it]), a0 = bflo(pa[it]), a1 = bfhi(pa[it]);
                    const float kv0 = k0 * kkw[0], kv1 = k1 * kkw[1]; const float ss = half_sum(kv0 * kv0 + kv1 * kv1, hf); const float rn = rsqrtf(fmaxf(ss, 1e-24f));
                    const float kk0 = kv0 * rn, kk1 = kv1 * rn;
                    const float kp0 = k0 * (1.f + (a0 - 1.f) * kaw[0]), kp1 = k1 * (1.f + (a1 - 1.f) * kaw[1]);
                    const float bon = half_sum(r0 * kp0 * rkw[0] + r1 * kp1 * rkw[1], hf);
                    const float lp0 = -(base0 + (it ? pl0[it ? it - 1 : 0] : 0.f)), lp1 = -(base1 + (it ? pl1[it ? it - 1 : 0] : 0.f)), lc0 = -(base0 + pl0[it]), lc1 = -(base1 + pl1[it]);
                    const float ea0 = __expf(lp0), ea1 = __expf(lp1), eb0 = __expf(lc0), eb1 = __expf(lc1), ei0 = __expf(-lc0), ei1 = __expf(-lc1);
                    const float bt0 = kk0 * a0 * ei0, bt1 = kk1 * a1 * ei1, kt0 = kp0 * ei0, kt1 = kp1 * ei1;
                    *(LAS unsigned*)(ra + off_r(t, pj >> 3) + 2 * (pj & 7)) = pkc(-kk0 * ea0, -kk1 * ea1); *(LAS unsigned*)(ra + off_r(16 + t, pj >> 3) + 2 * (pj & 7)) = pkc(r0 * eb0, r1 * eb1);
                    *(LAS unsigned*)(lbp + off_r(t, pj >> 3) + 2 * (pj & 7)) = pkc(bt0, bt1); *(LAS unsigned*)(lbp + off_r(16 + t, pj >> 3) + 2 * (pj & 7)) = pkc(kt0, kt1);
                    ms0[it] = bt0; ms0[4 + it] = kt0; ms1[it] = bt1; ms1[4 + it] = kt1; vt0[it] = bflo(pv[it]); vt1[it] = bfhi(pv[it]);
                    *(LAS f32x2*)(L + OVF + (tb * 64 + 2 * cp) * 4) = (f32x2){bflo(pv[it]), bfhi(pv[it])}; *(LAS f32x2*)(L + OGG + (tb * 64 + 2 * cp) * 4) = (f32x2){bflo(pg[it]), bfhi(pg[it])};
                    if (cp == 0) *(LAS float*)(L + OBON + tb * 4) = bon;
                    if (it == 3 && th && hf) *(LAS f32x2*)(L + OGC + pc * 256 + 2 * cp * 4) = (f32x2){eb0, eb1};
                }
                { u32x4 m0, m1; m0.x = pkc(ms0[0], ms0[1]); m0.y = pkc(ms0[2], ms0[3]); m0.z = pkc(ms0[4], ms0[5]); m0.w = pkc(ms0[6], ms0[7]); m1.x = pkc(ms1[0], ms1[1]); m1.y = pkc(ms1[2], ms1[3]); m1.z = pkc(ms1[4], ms1[5]); m1.w = pkc(ms1[6], ms1[7]);
                  *(LAS u32x4*)(L + OMS + pc * 4096 + off_m(2 * cp, 2 * th + (unsigned)hf)) = m0; *(LAS u32x4*)(L + OMS + pc * 4096 + off_m(2 * cp + 1, 2 * th + (unsigned)hf)) = m1;
                  u32x2 w0, w1; w0.x = pkc(vt0[0], vt0[1]); w0.y = pkc(vt0[2], vt0[3]); w1.x = pkc(vt1[0], vt1[1]); w1.y = pkc(vt1[2], vt1[3]);
                  *(LAS u32x2*)(L + OVT + pc * 2048 + (2 * cp) * 32 + (8 * th + 4 * (unsigned)hf) * 2) = w0; *(LAS u32x2*)(L + OVT + pc * 2048 + (2 * cp + 1) * 32 + (8 * th + 4 * (unsigned)hf) * 2) = w1; }
            }
            if (t0 + 64 < SEQ) RW_LOAD(t0 + 64);
            __syncthreads();
            SP_MARK(1);
            if (w < 4) {
                {
                    const int c = w;
                    f32x4 g00 = (f32x4){0.f, 0.f, 0.f, 0.f}, g01 = g00, g10 = g00, g11 = g00;
#pragma unroll
                    for (int ks = 0; ks < 2; ++ks) {
                        const bf16x8 a0 = *(const LAS bf16x8*)(L + OLB + c * 4096 + off_r(l15, 4 * ks + q)), a1 = *(const LAS bf16x8*)(L + OLB + c * 4096 + off_r(16 + l15, 4 * ks + q));
                        const bf16x8 b0 = *(const LAS bf16x8*)(L + ORA + c * 4096 + off_r(l15, 4 * ks + q)), b1 = *(const LAS bf16x8*)(L + ORA + c * 4096 + off_r(16 + l15, 4 * ks + q));
                        g00 = MFMA16(a0, b0, g00); g01 = MFMA16(a0, b1, g01); g10 = MFMA16(a1, b0, g10); g11 = MFMA16(a1, b1, g11);
                    }
                    f32x4 ab, ak; float br[4], kr[4];
#pragma unroll
                    for (int g = 0; g < 4; ++g) { const bool lt = (4 * q + g) < l15, le = (4 * q + g) <= l15; ab[g] = lt ? g00[g] : 0.f; ak[g] = lt ? g10[g] : 0.f; br[g] = le ? g01[g] : 0.f; kr[g] = le ? g11[g] : 0.f; }
                    *(LAS f32x4*)(L + OAB + c * 1024 + (l15 * 16 + 4 * q) * 4) = ab; *(LAS f32x4*)(L + OAK + c * 1024 + (l15 * 16 + 4 * q) * 4) = ak;
                    u32x4 yw; yw.x = pkc(br[0], br[1]); yw.y = pkc(br[2], br[3]); yw.z = pkc(kr[0], kr[1]); yw.w = pkc(kr[2], kr[3]);
                    *(LAS u32x4*)(L + OMY + c * 1024 + off_m(l15, q)) = yw;
                    if (lane < 32) {
                        float row[16];
#pragma unroll
                        for (int t = 0; t < 16; ++t) {
                            const LAS f32x4* abr = (const LAS f32x4*)(L + OAB + c * 1024 + t * 64);
                            const f32x4 x0 = abr[0], x1 = abr[1], x2 = abr[2], x3 = abr[3];
                            const float abv[16] = {x0[0], x0[1], x0[2], x0[3], x1[0], x1[1], x1[2], x1[3], x2[0], x2[1], x2[2], x2[3], x3[0], x3[1], x3[2], x3[3]};
                            float acc1 = (lane < 16) ? ((lane == t) ? 1.f : 0.f) : *(const LAS float*)(L + OAK + c * 1024 + (t * 16 + (lane & 15)) * 4);
#pragma unroll
                            for (int s_ = 0; s_ < t; ++s_) acc1 += row[s_] * abv[s_];
                            row[t] = acc1;
                        }
                        const unsigned pp = (lane < 16) ? (8u * (lane >> 2) + (lane & 3)) : (8u * ((lane & 15) >> 2) + 4u + (lane & 3));
#pragma unroll
                        for (int t = 0; t < 16; ++t) *(LAS bf16_t*)(L + OMU + c * 1024 + off_m(t, pp >> 3) + 2 * (pp & 7)) = (bf16_t)(pkc(row[t], 0.f) & 0xffffu);
                    }
                }
            }
            __syncthreads();
            SP_MARK(2);
            if (w < 4) {
#pragma unroll 1
                for (int c = 0; c < 4; ++c) {
                    bf16x8 Sb0, Sb1;
                    { u32x4 t0_; t0_.x = pkc(St[0][0], St[0][1]); t0_.y = pkc(St[0][2], St[0][3]); t0_.z = pkc(St[1][0], St[1][1]); t0_.w = pkc(St[1][2], St[1][3]); Sb0 = __builtin_bit_cast(bf16x8, t0_);
                      u32x4 t1_; t1_.x = pkc(St[2][0], St[2][1]); t1_.y = pkc(St[2][2], St[2][3]); t1_.z = pkc(St[3][0], St[3][1]); t1_.w = pkc(St[3][2], St[3][3]); Sb1 = __builtin_bit_cast(bf16x8, t1_); }
                    f32x4 Za = (f32x4){0.f, 0.f, 0.f, 0.f}, Zr = Za;
                    Za = MFMA16(*(const LAS bf16x8*)(L + ORA + c * 4096 + off_r(l15, q)), Sb0, Za); Za = MFMA16(*(const LAS bf16x8*)(L + ORA + c * 4096 + off_r(l15, 4 + q)), Sb1, Za);
                    Zr = MFMA16(*(const LAS bf16x8*)(L + ORA + c * 4096 + off_r(16 + l15, q)), Sb0, Zr); Zr = MFMA16(*(const LAS bf16x8*)(L + ORA + c * 4096 + off_r(16 + l15, 4 + q)), Sb1, Zr);
                    const u32x2 vt = *(const LAS u32x2*)(L + OVT + c * 2048 + (16 * w + l15) * 32 + 8 * q);
                    u32x4 bu; bu.x = pkc(Za[0], Za[1]); bu.y = pkc(Za[2], Za[3]); bu.z = vt.x; bu.w = vt.y;
                    f32x4 U = (f32x4){0.f, 0.f, 0.f, 0.f};
                    U = MFMA16(*(const LAS bf16x8*)(L + OMU + c * 1024 + off_m(l15, q)), __builtin_bit_cast(bf16x8, bu), U);
                    u32x4 by; by.x = pkc(U[0], U[1]); by.y = pkc(U[2], U[3]); by.z = vt.x; by.w = vt.y;
                    const bf16x8 By = __builtin_bit_cast(bf16x8, by);
                    const f32x4 Yt = MFMA16(*(const LAS bf16x8*)(L + OMY + c * 1024 + off_m(l15, q)), By, Zr);
#pragma unroll
                    for (int mt = 0; mt < 4; ++mt) { St[mt] = MFMA16(*(const LAS bf16x8*)(L + OMS + c * 4096 + off_m(16 * mt + l15, q)), By, St[mt]);
                        const f32x4 gc = *(const LAS f32x4*)(L + OGC + c * 256 + (16 * mt + 4 * q) * 4); St[mt] = St[mt] * gc; }
#pragma unroll
                    for (int g = 0; g < 4; ++g) *(LAS float*)(L + OYS + ((16 * c + 4 * q + g) * 64 + 16 * w + l15) * 4) = Yt[g];
                }
            }
            __syncthreads();
            SP_MARK(3);
            bf16_t* ob_ = rbuf + ((size_t)b * SEQ + t0 + w) * DM + hd * 64;
#pragma unroll
            for (int iq = 0; iq < 4; ++iq) { const int tq = 2 * iq + (int)hf, t = w + 8 * tq; const int li = t * 64 + 2 * (int)cp;
                const f32x2 y = *(const LAS f32x2*)(L + OYS + li * 4); const float mean = half_sum(y[0] + y[1], hf) * (1.f / 64.f); const float d0 = y[0] - mean, d1 = y[1] - mean;
                const float rs = rsqrtf(half_sum(d0 * d0 + d1 * d1, hf) * (1.f / 64.f) + 64e-5f);
                const f32x2 vv = *(const LAS f32x2*)(L + OVF + li * 4), gg = *(const LAS f32x2*)(L + OGG + li * 4); const float bo = *(const LAS float*)(L + OBON + t * 4);
                const float o0 = (d0 * rs * lw[0] + lb[0] + bo * vv[0]) * gg[0], o1 = (d1 * rs * lw[1] + lb[1] + bo * vv[1]) * gg[1];
                *(unsigned*)(ob_ + (unsigned)(8 * tq * DM + 2 * (int)cp)) = pkc(o0, o1); }
        }
#undef RW_LOAD
    }
}

__global__ void __launch_bounds__(NTHREADS, 2) mega_fwd(Params p) {
    extern __shared__ __attribute__((aligned(16))) unsigned char lds_raw[];
    Frame F;
    F.lds = (LAS unsigned char*)lds_raw;
    F.tid = threadIdx.x; F.lane = F.tid & 63; F.wave = __builtin_amdgcn_readfirstlane(F.tid >> 6); F.G = gridDim.x; F.bid = blockIdx.x;
    F.out = p.out; F.ws = p.ws;
    volatile LAS unsigned* misc = (volatile LAS unsigned*)(F.lds + LDS_MISC);
    if (F.tid < 32) misc[F.tid] = 0u;
    __syncthreads();
    const int lo = p.ph_lo, hi = p.ph_hi;
    XcdBarrier bar; bar.bar = (unsigned*)(F.ws + WS_CTL); bar.x = 0; bar.st = misc;
    if (hi - lo > 1) bar = xcd_barrier_post((unsigned*)(F.ws + WS_CTL), misc);
#define IN(k) (lo <= (k) && (k) < hi)
#if PROBE_MASK
    unsigned long long pr_t0 = 0ull, pr_acc = 0ull;
#define PSTART(k) do { if ((PROBE_MASK >> (k)) & 1u) pr_t0 = wall_clock64(); } while (0)
#define PEND(k) do { if ((PROBE_MASK >> (k)) & 1u) pr_acc += wall_clock64() - pr_t0; } while (0)
#else
#define PSTART(k) do {} while (0)
#define PEND(k) do {} while (0)
#endif
#if PROBE_SUB == 11
#define SEAM(k) do { if (IN(k) && IN((k) + 1)) { unsigned long long b0_ = 0ull; if (F.tid == 0) b0_ = wall_clock64(); xcd_barrier(bar); if (F.tid == 0) *(LAS unsigned long long*)(F.lds + LDS_MISC + 64) += wall_clock64() - b0_; } PEND(k); PSTART((k) + 1); } while (0)
#else
#define SEAM(k) do { if (IN(k) && IN((k) + 1)) xcd_barrier(bar); PEND(k); PSTART((k) + 1); } while (0)
#endif
    bf16_t* wb = WSP(bf16_t, WS_WB);
    bf16_t* S0 = WSP(bf16_t, WS_SLAB); bf16_t* S2 = WSP(bf16_t, WS_SLAB + 2 * SLAB); bf16_t* S3 = WSP(bf16_t, WS_SLAB + 3 * SLAB); bf16_t* S4 = WSP(bf16_t, WS_SLAB + 4 * SLAB); bf16_t* S5 = WSP(bf16_t, WS_SLAB + 5 * SLAB);
    bf16_t* EH = WSP(bf16_t, WS_E);
    bf16_t* O0 = (bf16_t*)F.out; bf16_t* O1 = O0 + (size_t)T_TOK * DM;
    bf16_t* hres = (bf16_t*)F.out;
    bf16_t* S1 = WSP(bf16_t, WS_SLAB + 1 * SLAB);
    const int vcu = (F.G % 8 == 0) ? F.bid : F.bid;

    PSTART(0);
    if (IN(0)) { phase_prep(p, F, 0, PT_WIN, true); phase_rmsnorm<true>(p, F, p.in[0], p.in[1], O0); } SEAM(0);
    if (IN(2)) { DenseP<EK_INPROJ> P{}; P.pid = 2; P.v0 = (const float*)(F.ws + WS_ROPE); P.K = 1024; P.lda = 1024; P.ldb = 1024; P.nM = 256; P.nN = NPROJ / 256; P.nprob = 1; P.G = F.G; P.c = vcu; P.A = O0; P.a_stride = 0; P.B = wb + WB_WIN / 2; P.b_stride = 0;
        P.O = S0; P.o_stride = 0; P.ldc = NPROJ; gemm_phase(F.lds, P); } SEAM(2);
    if (IN(3)) { phase_conv(p, F); } SEAM(3);
    if (IN(4)) { phase_scan0(p, F); } SEAM(4);
    if (IN(5)) { phase_prep(p, F, PT_WIN, PT_WOUT, false); phase_gatenorm(p, F); } SEAM(5);
    if (IN(6)) { DenseP<EK_F32RES> P{}; P.pid = 6; P.K = 2048; P.lda = NPROJ; P.ldb = 2048; P.nM = 256; P.nN = 4; P.nprob = 1; P.G = F.G; P.c = vcu; P.A = S0; P.B = wb + WB_WOUT / 2; P.resf = p.in[0]; P.resb = nullptr; P.Ob = hres; P.ldc = 1024; gemm_phase(F.lds, P); } SEAM(6);
#define MOE_LAYER(L, k0) \
    if (IN(k0)) { phase_prep(p, F, PT_L2 + (L) * 4096, PT_L2 + (L) * 4096 + 4096, false); phase_prep(p, F, PT_W13 + (L) * 2048, PT_W13 + (L) * 2048 + 2048, false); phase_moe_route(p, F, L, hres, S2); } SEAM(k0); \
    if (IN(k0 + 1)) { phase_moe_slots(p, F, L); } SEAM(k0 + 1); \
    if (IN(k0 + 2)) { unsigned char* meta = F.ws + WS_META + (size_t)(L) * META_STRIDE; Moe1P P{}; P.pid = (k0) + 2; P.K = 1024; P.lda = 1024; P.ldb = 1024; P.G = F.G; P.c = vcu; \
        P.ntiles = __builtin_amdgcn_readfirstlane(ld_vec_i32((const int*)(meta + MT_TILE))); P.A = S2; P.W13 = wb + WB_W13 / 2 + (size_t)(L) * 16 * 1048576; P.H = S3; \
        P.slot_tok = (const int*)(meta + MT_STOK); P.slot_c = (const float*)(meta + MT_SC); P.tile_bkt = (const int*)(meta + MT_TILE) + 64; gemm_phase(F.lds, P); } SEAM(k0 + 2); \
    if (IN(k0 + 3)) { unsigned char* meta = F.ws + WS_META + (size_t)(L) * META_STRIDE; Moe2P P{}; P.pid = (k0) + 3; P.K = 1024; P.lda = 1024; P.ldb = 512; P.G = F.G; P.c = vcu; \
        P.ntiles = __builtin_amdgcn_readfirstlane(ld_vec_i32((const int*)(meta + MT_TILE))); P.H = S3; P.W2 = wb + WB_W2 / 2 + (size_t)(L) * 16 * 524288; P.hsrc = hres; P.hdst = ((L) == 1) ? S0 : hres; \
        P.slot_tok = (const int*)(meta + MT_STOK); P.tile_bkt = (const int*)(meta + MT_TILE) + 64; gemm_phase(F.lds, P); } SEAM(k0 + 3);
    MOE_LAYER(0, 7)
    if (IN(11)) { phase_prep(p, F, PT_WOUT, PT_L2, false); phase_mix<0>(p, F, hres, S2, S3, S4); } SEAM(11);
    if (IN(12)) { DenseP<EK_LORA1> P{}; P.pid = 12; P.K = 1024; P.lda = 1024; P.ldb = 1024; P.nM = 256; P.nN = 1; P.nprob = 3; P.G = F.G; P.c = vcu; P.A = S2; P.a_stride = (size_t)T_TOK * DM; P.B = wb + WB_L1 / 2; P.b_stride = 262144;
        P.O = EH; P.o_stride = (size_t)T_TOK * 256; P.ldc = 256; gemm_phase(F.lds, P); } SEAM(12);
    if (IN(13)) { phase_mix<1>(p, F, hres, S2, S3, S4); } SEAM(13);
    if (IN(14)) { DenseP<EK_BF16> P{}; P.pid = 14; P.K = 1024; P.lda = 1024; P.ldb = 1024; P.nM = 256; P.nN = 4; P.nprob = 3; P.G = F.G; P.c = vcu; P.ldc = 1024; P.A = S2; P.a_stride = (size_t)T_TOK * DM; P.B = wb + WB_WR / 2; P.b_stride = 1048576;
        P.O = S5; P.Oalt1 = S0; P.Oalt2 = S1; gemm_phase(F.lds, P); } SEAM(14);
    if (IN(15)) { DenseP<EK_LORA2> P{}; P.pid = 15; P.K = 256; P.lda = 256; P.ldb = 256; P.nM = 256; P.nN = 4; P.nprob = 3; P.G = F.G; P.c = vcu; P.A = EH; P.a_stride = (size_t)T_TOK * 256; P.B = wb + WB_L2 / 2; P.b_stride = 262144;
        P.O = S2; P.o_stride = (size_t)T_TOK * DM; P.ldc = 1024; P.v0 = p.in[17]; P.v1 = p.in[20]; gemm_phase(F.lds, P); } SEAM(15);
    if (IN(16)) { phase_rwkv(p, F, S5, S0, S1, S2, S3, S4); } SEAM(16);
    if (IN(17)) { DenseP<EK_F32RES> P{}; P.pid = 17; P.K = 1024; P.lda = 1024; P.ldb = 1024; P.nM = 256; P.nN = 4; P.nprob = 1; P.G = F.G; P.c = vcu; P.A = S5; P.B = wb + WB_WO / 2; P.resf = nullptr; P.resb = hres; P.Ob = hres; P.ldc = 1024; gemm_phase(F.lds, P); } SEAM(17);
    MOE_LAYER(1, 18)
    if (IN(22)) { phase_rmsnorm<false, true>(p, F, S0, p.in[3], F.out); }
#if PROBE_SUB
    if (F.bid == 0 && F.tid == 0) { const unsigned long long d_ = *(LAS unsigned long long*)(F.lds + LDS_MISC + 64); const unsigned long long t = wall_clock64(); while (wall_clock64() - t < d_) __builtin_amdgcn_s_sleep(8); }
#endif
#if PROBE_MASK
    PEND(22);
    if (F.bid == 0 && F.tid == 0) { const unsigned long long t = wall_clock64(); while (wall_clock64() - t < pr_acc) __builtin_amdgcn_s_sleep(8); }
#endif
}

extern "C" void kernel_launch(void* const* d_in, const int* in_sizes, int n_in, void* d_out, int out_size, void* d_ws, size_t ws_size, hipStream_t stream) {
    static int grid = 0;
    if (grid == 0) {
        if (n_in != 37 || out_size != T_TOK * DM || ws_size < WS_END) { fprintf(stderr, "kernel_launch: unexpected shapes (n_in %d out %d ws %zu)\n", n_in, out_size, ws_size); grid = -1; return; }
        int dev = 0, cus = 0, per_cu = 0;
        if (hipGetDevice(&dev) != hipSuccess || hipDeviceGetAttribute(&cus, hipDeviceAttributeMultiprocessorCount, dev) != hipSuccess) { grid = -1; return; }
        if (hipFuncSetAttribute((const void*)mega_fwd, hipFuncAttributeMaxDynamicSharedMemorySize, LDS_BYTES) != hipSuccess) { fprintf(stderr, "kernel_launch: hipFuncSetAttribute failed\n"); grid = -1; return; }
        if (hipOccupancyMaxActiveBlocksPerMultiprocessor(&per_cu, (const void*)mega_fwd, NTHREADS, LDS_BYTES) != hipSuccess || per_cu < 1) fprintf(stderr, "kernel_launch: occupancy query says %d\n", per_cu);
        (void)hipGetLastError();
        grid = cus;
        if (grid < 128 || grid > 512) { fprintf(stderr, "kernel_launch: built for 128..512 CUs (the MoE router keeps <= 512 tokens per workgroup in LDS); got %d\n", grid); grid = -1; return; }
    }
    if (grid < 0) return;
    (void)in_sizes;
    hipMemsetAsync((char*)d_ws + WS_CTL, 0, CTL_ZERO_BYTES, stream);
    Params p{};
    for (int i = 0; i < 37; ++i) p.in[i] = (const float*)d_in[i];
    p.out = (float*)d_out; p.ws = (unsigned char*)d_ws;
#if MK_PER_PHASE
    for (int k = 0; k < NPHASE; ++k) { p.ph_lo = k; p.ph_hi = k + 1; hipLaunchKernelGGL(mega_fwd, dim3(grid), dim3(NTHREADS), LDS_BYTES, stream, p); }
#else
    p.ph_lo = 0; p.ph_hi = NPHASE; hipLaunchKernelGGL(mega_fwd, dim3(grid), dim3(NTHREADS), LDS_BYTES, stream, p);
#endif
}
```

```cpp
#include <hip/hip_runtime.h>
#include <stdint.h>
#include <stdio.h>

#ifndef MK_PER_PHASE
#define MK_PER_PHASE 0
#endif

#ifndef PROBE_MASK
#define PROBE_MASK 0u
#endif
#ifndef PROBE_PID
#define PROBE_PID -1
#endif
#ifndef PROBE_SUB
#define PROBE_SUB 0
#endif
#define LAS __attribute__((address_space(3)))
typedef unsigned short bf16_t;
typedef short bf16x8 __attribute__((ext_vector_type(8)));
typedef float f32x4 __attribute__((ext_vector_type(4)));
typedef float f32x2 __attribute__((ext_vector_type(2)));
typedef unsigned u32x4 __attribute__((ext_vector_type(4)));
typedef unsigned u32x2 __attribute__((ext_vector_type(2)));

constexpr int T_TOK = 65536, DM = 1024, SEQ = 4096;
constexpr int NPROJ = 5888;
constexpr int PC_Z = 0, PC_XBC = 1024, PC_Q = 2560, PC_K = 3072, PC_V = 3584, PC_G = 4608, PC_DT = 5632;
constexpr int NTHREADS = 512;
constexpr int LDS_BYTES = 147456;
constexpr int LDS_MISC = LDS_BYTES - 256;
constexpr int NSLOT = T_TOK + 24 * 256;
constexpr int NPHASE = 23;
constexpr int PT_WIN = 1472, PT_WOUT = PT_WIN + 512, PT_RW = PT_WOUT + 1024, PT_L1 = PT_RW + 256, PT_L2 = PT_L1 + 192, PT_W13 = PT_L2 + 8192, PT_W2 = PT_W13 + 4096;
#if PROBE_SUB
#define SP_DECL unsigned long long sp_t_ = wall_clock64()
#define SP_MARK(id_end) do { if (F.tid == 0) { const unsigned long long n_ = wall_clock64(); if ((id_end) == PROBE_SUB) *(LAS unsigned long long*)(F.lds + LDS_MISC + 64) += n_ - sp_t_; sp_t_ = n_; } } while (0)
#else
#define SP_DECL do {} while (0)
#define SP_MARK(id_end) do {} while (0)
#endif

constexpr size_t MiB = 1024 * 1024;
constexpr size_t WS_CTL = 0;
constexpr size_t CTL_ZERO_BYTES = 16384;
constexpr size_t CTL_CNT_OFF = 14336;
constexpr size_t WS_META = 64 * 1024;
constexpr size_t META_STRIDE = 2 * MiB - 32 * 1024;
constexpr size_t MT_RANK = 0, MT_BKT = 262144, MT_C = 524288, MT_STOK = 1048576, MT_SC = 1048576 + 294912, MT_TILE = 1048576 + 294912 + 589824;
constexpr size_t WS_ROPE = 4 * MiB;
constexpr size_t WS_WB = 6 * MiB;
constexpr size_t WB_WIN = 0, WB_WOUT = WB_WIN + (size_t)NPROJ * 1024 * 2, WB_WR = WB_WOUT + (size_t)1024 * 2048 * 2, WB_WK = WB_WR + 2 * MiB, WB_WV = WB_WK + 2 * MiB, WB_WO = WB_WV + 2 * MiB,
                 WB_L1 = WB_WO + 2 * MiB  , WB_L2 = WB_L1 + 2 * MiB  , WB_W13 = WB_L2 + 3 * 512 * 1024  ,
                 WB_W2 = WB_W13 + (size_t)32 * 2 * MiB  , WB_END = WB_W2 + (size_t)32 * MiB;
constexpr size_t WS_SLAB = 130 * MiB;
constexpr size_t SLAB = 128 * MiB;
constexpr size_t WS_E = WS_SLAB + 6 * SLAB;
constexpr size_t WS_END = WS_E + 96 * MiB;
constexpr size_t WS_RTW = WS_WB + WB_END;
static_assert(WS_RTW + 2 * 20 * 1024 * 4 <= WS_SLAB, "weights overflow");
static_assert(WS_END <= 1024 * MiB, "workspace overflow");

struct Params {
    const float* in[37];
    float* out;
    unsigned char* ws;
    int ph_lo, ph_hi;
};

__device__ __forceinline__ float bf2f(bf16_t v) { return __uint_as_float(((unsigned)v) << 16); }
__device__ __forceinline__ float bflo(unsigned w) { return __uint_as_float(w << 16); }
__device__ __forceinline__ float bfhi(unsigned w) { return __uint_as_float(w & 0xffff0000u); }
__device__ __forceinline__ unsigned cvt_pk_bf16(float lo, float hi) { unsigned r; asm volatile("v_cvt_pk_bf16_f32 %0, %1, %2" : "=v"(r) : "v"(lo), "v"(hi)); return r; }
__device__ __forceinline__ bf16_t f2bf(float f) { return (bf16_t)(cvt_pk_bf16(f, 0.f) & 0xffffu); }
__device__ __forceinline__ float wave_sum(float v) {
#pragma unroll
    for (int o = 32; o >= 1; o >>= 1) v += __shfl_xor(v, o);
    return v;
}
__device__ __forceinline__ float dpp_sum16(float x) {
    x += __builtin_bit_cast(float, __builtin_amdgcn_update_dpp(0, __builtin_bit_cast(int, x), 0xB1, 0xF, 0xF, true));
    x += __builtin_bit_cast(float, __builtin_amdgcn_update_dpp(0, __builtin_bit_cast(int, x), 0x4E, 0xF, 0xF, true));
    x += __builtin_bit_cast(float, __builtin_amdgcn_update_dpp(0, __builtin_bit_cast(int, x), 0x141, 0xF, 0xF, true));
    x += __builtin_bit_cast(float, __builtin_amdgcn_update_dpp(0, __builtin_bit_cast(int, x), 0x140, 0xF, 0xF, true));
    return x;
}
__device__ __forceinline__ float wave_sum_u(float x) {
    x = dpp_sum16(x);
    x += __builtin_bit_cast(float, __builtin_amdgcn_update_dpp(0, __builtin_bit_cast(int, x), 0x142, 0xA, 0xF, false));
    x += __builtin_bit_cast(float, __builtin_amdgcn_update_dpp(0, __builtin_bit_cast(int, x), 0x143, 0xC, 0xF, false));
    return __builtin_bit_cast(float, __builtin_amdgcn_readlane(__builtin_bit_cast(int, x), 63));
}
__device__ __forceinline__ float fsilu(float x) { return x * __builtin_amdgcn_rcpf(1.f + __expf(-x)); }
__device__ __forceinline__ float fsigmoid(float x) { return __builtin_amdgcn_rcpf(1.f + __expf(-x)); }
__device__ __forceinline__ float fsoftplus(float x) { return x > 20.f ? x : log1pf(__expf(x)); }
__device__ __forceinline__ float ftanh(float x) { const float xc = fminf(fmaxf(x, -15.f), 15.f); const float e = __expf(2.f * xc); return (e - 1.f) * __builtin_amdgcn_rcpf(e + 1.f); }
__device__ __forceinline__ int ld_vec_i32(const int* p) { int r; asm volatile("global_load_dword %0, %1, off\n\ts_waitcnt vmcnt(0)" : "=&v"(r) : "v"(p) : "memory"); return r; }

#define XB_TMO      128
#define XB_XCNT(j)  (256  + 64 * (j))
#define XB_XSUB(j)  (1280 + 64 * (j))
#define XB_XGEN(j)  (2304 + 64 * (j))
#define XB_TOP      3328
#define XB_TOPGEN   3392
#define XCD_BAR_WORDS 3456
#define XB_SPIN_CAP (1u << 24)
__device__ __forceinline__ unsigned xb_ld(unsigned* p)              { return __hip_atomic_load(p, __ATOMIC_RELAXED, __HIP_MEMORY_SCOPE_AGENT); }
__device__ __forceinline__ unsigned xb_add(unsigned* p, unsigned v) { return __hip_atomic_fetch_add(p, v, __ATOMIC_RELAXED, __HIP_MEMORY_SCOPE_AGENT); }
__device__ __forceinline__ unsigned xb_xcc_id() { return (unsigned)__builtin_amdgcn_s_getreg((3 << 11) | 20) & 0xFu; }
#define XB_SPIN(cond, bar) do { unsigned _sp = 0; while (cond) { __builtin_amdgcn_s_sleep(1); \
    if ((++_sp & 255u) == 0u) { if (xb_ld(&(bar)[XB_TMO])) break; if (_sp > XB_SPIN_CAP) { atomicAdd(&(bar)[XB_TMO], 1u); break; } } } } while (0)
struct XcdBarrier { unsigned* bar; unsigned x; volatile LAS unsigned* st; };
__device__ __forceinline__ XcdBarrier xcd_barrier_post(unsigned* bar, volatile LAS unsigned* st) {
    XcdBarrier b; b.bar = bar; b.x = xb_xcc_id(); b.st = st;
    if (threadIdx.x == 0) (void)xb_add(&bar[XB_XCNT(b.x)], 1u);
    return b;
}
__device__ __forceinline__ void xcd_barrier_complete(unsigned* bar, unsigned x, unsigned& nloc, unsigned& nx) {
    const unsigned G = gridDim.x * gridDim.y * gridDim.z;
    unsigned sum, cnt, mine, sp = 0u;
    for (;;) {
        sum = 0u; cnt = 0u; mine = 0u;
#pragma unroll
        for (unsigned j = 0; j < 16; ++j) { const unsigned c = xb_ld(&bar[XB_XCNT(j)]); sum += c; cnt += (c > 0u) ? 1u : 0u; mine = (j == x) ? c : mine; }
        if (sum == G) break;
        __builtin_amdgcn_s_sleep(1);
        if ((++sp & 255u) == 0u) { if (xb_ld(&bar[XB_TMO])) break; if (sp > XB_SPIN_CAP) { atomicAdd(&bar[XB_TMO], 1u); break; } }
    }
    nloc = mine > 0u ? mine : 1u; nx = cnt > 0u ? cnt : 1u;
}
__device__ __forceinline__ void xcd_barrier(const XcdBarrier& b) {
    asm volatile("s_waitcnt vmcnt(0)" ::: "memory");
    __syncthreads();
    if (threadIdx.x == 0) {
        unsigned* bar = b.bar;
        __builtin_amdgcn_s_waitcnt(0);
        unsigned nloc = b.st[0], nx = b.st[1];
        if (nloc == 0u) { xcd_barrier_complete(bar, b.x, nloc, nx); b.st[0] = nloc; b.st[1] = nx; }
        const unsigned old = xb_add(&bar[XB_XSUB(b.x)], 1u);
        const unsigned gen = old / nloc;
        if (old + 1u == (gen + 1u) * nloc) {
            __builtin_amdgcn_fence(__ATOMIC_RELEASE, "agent");
            asm volatile("s_waitcnt vmcnt(0)" ::: "memory");
            const unsigned og = xb_add(&bar[XB_TOP], 1u);
            const unsigned tg = og / nx;
            if (og + 1u == (tg + 1u) * nx) xb_add(&bar[XB_TOPGEN], 1u);
            else XB_SPIN(xb_ld(&bar[XB_TOPGEN]) == tg, bar);
            __builtin_amdgcn_fence(__ATOMIC_ACQUIRE, "agent");
            xb_add(&bar[XB_XGEN(b.x)], 1u);
            asm volatile("s_waitcnt vmcnt(0)" ::: "memory");
        } else {
            XB_SPIN(xb_ld(&bar[XB_XGEN(b.x)]) == gen, bar);
            __builtin_amdgcn_fence(__ATOMIC_ACQUIRE, "agent");
            asm volatile("s_waitcnt vmcnt(0)" ::: "memory");
        }
    }
    __syncthreads();
}

constexpr int BM = 256, BK = 64, HALF = 128, HTB = HALF * BK * 2, STAGE_BYTES = 8 * HTB;
__device__ __forceinline__ int lds_byte(int r, int c) { const int st = (r >> 4) * 2 + (c >> 5), rr = r & 15, cc = c & 31, ob = rr * 64 + cc * 2; return st * 1024 + (ob ^ (((ob >> 9) & 1) << 5)); }
__device__ __forceinline__ void stage_rc(int b, int& R, int& C) { const int st = b / 1024, sb = b % 1024, swz = sb ^ (((sb >> 9) & 1) << 5); R = (st >> 1) * 16 + swz / 64; C = (st & 1) * 32 + (swz % 64) / 2; }
__device__ __forceinline__ int perm32(int rho) { const int n = rho >> 4, i = rho & 15; return 8 * (i >> 2) + 4 * n + (i & 3); }
struct Unit { int pm, pn, prob; };
__device__ __forceinline__ void tile_order(int L, int nM, int nN, int& pm, int& pn) {
    const int nwg = nM * nN; int wgid = L;
    { const int q = nwg / 8, r = nwg % 8, xcd = wgid % 8, off = wgid / 8; wgid = (xcd < r ? xcd * (q + 1) : r * (q + 1) + (xcd - r) * q) + off; }
    const int nig = 8 * nN, gid = wgid / nig, fm = gid * 8, gsz = (nM - fm) < 8 ? (nM - fm) : 8;
    pm = fm + ((wgid % nig) % gsz); pn = (wgid % nig) / gsz;
}

template <class P>
__device__ __forceinline__ void gemm_phase(LAS unsigned char* lds, const P& S) {
    const int tid = threadIdx.x, wid = __builtin_amdgcn_readfirstlane(tid >> 6), lane = tid & 63, wr = wid >> 2, wc = wid & 3, fr = lane & 15, fq = lane >> 4;
    const int K = S.K, nt = K / BK, lda = S.lda, ldb = S.ldb;
    int RA[2], CA[2]; unsigned voffB[2], vAc[2][2], vAn[2][2];
#pragma unroll
    for (int i = 0; i < 2; ++i) { int R, C; stage_rc(tid * 16 + i * 8192, R, C); RA[i] = R; CA[i] = C; const int Rb = P::PERM ? ((R & ~31) + perm32(R & 31)) : R;
        voffB[i] = (unsigned)(Rb * ldb + C) * 2u;
#pragma unroll
        for (int h = 0; h < 2; ++h) { vAc[h][i] = (unsigned)((h * HALF + R) * lda + C) * 2u; vAn[h][i] = vAc[h][i]; } }
    const size_t kstep = (size_t)(BK * 2);
    const size_t hstepB = (size_t)HALF * ldb * 2;
    const unsigned ldsw = (unsigned)wid * 1024u;
    const int aoff = lds_byte(wr * 64 + fr, fq * 8), boff = lds_byte(wc * 32 + fr, fq * 8);
#define PG8_SA(b, h) (((b) * 2 + (h)) * HTB)
#define PG8_SB(b, h) ((4 + (b) * 2 + (h)) * HTB)
#define PG8_STAGE2(bufoff, gbase, v0, v1) do { \
        __builtin_amdgcn_global_load_lds((const unsigned*)((const char*)(gbase) + (v0)), (LAS unsigned*)(lds + (bufoff) + ldsw), 16, 0, 0); \
        __builtin_amdgcn_global_load_lds((const unsigned*)((const char*)(gbase) + (v1)), (LAS unsigned*)(lds + (bufoff) + ldsw + 8192), 16, 0, 0); } while (0)
#define PG8_LDA(dst, b, h) do { _Pragma("unroll") for (int m = 0; m < 4; ++m) _Pragma("unroll") for (int k = 0; k < 2; ++k) dst[m][k] = *(const LAS bf16x8*)(lds + PG8_SA(b, h) + aoff + m * 2048 + k * 1024); } while (0)
#define PG8_LDB(dst, b, h) do { _Pragma("unroll") for (int n = 0; n < 2; ++n) _Pragma("unroll") for (int k = 0; k < 2; ++k) dst[n][k] = *(const LAS bf16x8*)(lds + PG8_SB(b, h) + boff + n * 2048 + k * 1024); } while (0)
#define PG8_MMA(ai, bj, At, Bt) do { __builtin_amdgcn_s_setprio(1); _Pragma("unroll") for (int m = 0; m < 4; ++m) _Pragma("unroll") for (int n = 0; n < 2; ++n) _Pragma("unroll") for (int k = 0; k < 2; ++k) \
        acc[ai][bj][m][n] = __builtin_amdgcn_mfma_f32_16x16x32_bf16(Bt[n][k], At[m][k], acc[ai][bj][m][n], 0, 0, 0); __builtin_amdgcn_s_setprio(0); } while (0)
#define PG8_WAIT_V(n) asm volatile("s_waitcnt vmcnt(" #n ")" ::: "memory")
#define PG8_WAIT_L(n) asm volatile("s_waitcnt lgkmcnt(" #n ")" ::: "memory")
#define PG8_BAR __builtin_amdgcn_s_barrier()
#define PG8_SCHED __builtin_amdgcn_sched_barrier(0)
    Unit cur, nxt; int ui = 0;
    if (!S.next(0, cur)) return;
    struct { int tid; LAS unsigned char* lds; } F; F.tid = tid; F.lds = lds; (void)F;
    SP_DECL;
    if constexpr (P::GATHER) {
#pragma unroll
        for (int h = 0; h < 2; ++h)
#pragma unroll
            for (int i = 0; i < 2; ++i) vAc[h][i] = S.a_voff(cur, h * HALF + RA[i], CA[i]);
    }
    float zf; asm volatile("v_mov_b32 %0, 0" : "=v"(zf));
    f32x4 acc[2][2][4][2];
#pragma unroll
    for (int a = 0; a < 2; ++a)
#pragma unroll
        for (int b = 0; b < 2; ++b)
#pragma unroll
            for (int m = 0; m < 4; ++m)
#pragma unroll
                for (int n = 0; n < 2; ++n) acc[a][b][m][n] = (f32x4){zf, zf, zf, zf};
    bf16x8 At[4][2], B0[2][2], B1[2][2];
    const char* cA = S.a_ptr(cur);
    {
        const char* b0 = S.b_ptr(cur, 0); const char* b1 = S.b_ptr(cur, 1);
        const char* cA0 = cA + S.a_kadj(0);
        PG8_STAGE2(PG8_SB(0, 0), b0, voffB[0], voffB[1]); PG8_STAGE2(PG8_SA(0, 0), cA0, vAc[0][0], vAc[0][1]); PG8_STAGE2(PG8_SB(0, 1), b0 + hstepB, voffB[0], voffB[1]); PG8_STAGE2(PG8_SA(0, 1), cA0, vAc[1][0], vAc[1][1]);
        if (wr == 1) PG8_BAR;
        PG8_WAIT_V(4); PG8_BAR;
        PG8_STAGE2(PG8_SB(1, 0), b1, voffB[0], voffB[1]); PG8_STAGE2(PG8_SA(1, 0), cA + kstep + S.a_kadj(1), vAc[0][0], vAc[0][1]); PG8_STAGE2(PG8_SB(1, 1), b1 + hstepB, voffB[0], voffB[1]);
        PG8_WAIT_V(6); PG8_BAR;
    }
    for (;;) {
        const bool has_next = S.next(ui + 1, nxt);
        if (!has_next) nxt = cur;
        if constexpr (P::GATHER) {
            if (has_next) {
#pragma unroll
                for (int h = 0; h < 2; ++h)
#pragma unroll
                    for (int i = 0; i < 2; ++i) vAn[h][i] = S.a_voff(nxt, h * HALF + RA[i], CA[i]);
            }
        }
        const char* nA = S.a_ptr(nxt);
        for (int t = 0; t < nt; t += 2) {
            const bool last = (t == nt - 2);
            const char* a1 = cA + (size_t)(t + 1) * kstep + S.a_kadj(t + 1);
            const char* a2 = last ? nA + S.a_kadj(0) : cA + (size_t)(t + 2) * kstep + S.a_kadj(t + 2);
            const char* a3 = last ? nA + kstep + S.a_kadj(1) : cA + (size_t)(t + 3) * kstep + S.a_kadj(t + 3);
            const char* b2 = last ? S.b_ptr(nxt, 0) : S.b_ptr(cur, t + 2);
            const char* b3 = last ? S.b_ptr(nxt, 1) : S.b_ptr(cur, t + 3);
            unsigned s00 = vAc[0][0], s01 = vAc[0][1], s10 = vAc[1][0], s11 = vAc[1][1];
            if constexpr (P::GATHER) { if (last) { s00 = vAn[0][0]; s01 = vAn[0][1]; s10 = vAn[1][0]; s11 = vAn[1][1]; } }
            PG8_LDB(B0, 0, 0); PG8_SCHED; PG8_LDA(At, 0, 0); PG8_STAGE2(PG8_SA(1, 1), a1, vAc[1][0], vAc[1][1]);
            PG8_WAIT_L(8); PG8_BAR; PG8_WAIT_L(0); PG8_MMA(0, 0, At, B0); PG8_BAR; PG8_SCHED;
            PG8_LDB(B1, 0, 1); PG8_STAGE2(PG8_SB(0, 0), b2, voffB[0], voffB[1]);
            PG8_BAR; PG8_WAIT_L(0); PG8_MMA(0, 1, At, B1); PG8_BAR;
            PG8_LDA(At, 0, 1); PG8_STAGE2(PG8_SA(0, 0), a2, s00, s01);
            PG8_BAR; PG8_WAIT_L(0); PG8_MMA(1, 0, At, B0); PG8_BAR; PG8_SCHED;
            PG8_STAGE2(PG8_SB(0, 1), b2 + hstepB, voffB[0], voffB[1]);
            PG8_WAIT_V(6); PG8_BAR; PG8_MMA(1, 1, At, B1); PG8_BAR;
            PG8_LDB(B0, 1, 0); PG8_SCHED; PG8_LDA(At, 1, 0); PG8_STAGE2(PG8_SA(0, 1), a2, s10, s11);
            PG8_WAIT_L(8); PG8_BAR; PG8_WAIT_L(0); PG8_MMA(0, 0, At, B0); PG8_BAR; PG8_SCHED;
            PG8_LDB(B1, 1, 1); PG8_STAGE2(PG8_SB(1, 0), b3, voffB[0], voffB[1]);
            PG8_BAR; PG8_WAIT_L(0); PG8_MMA(0, 1, At, B1); PG8_BAR;
            PG8_LDA(At, 1, 1); PG8_STAGE2(PG8_SA(1, 0), a3, s00, s01);
            PG8_BAR; PG8_WAIT_L(0); PG8_MMA(1, 0, At, B0); PG8_BAR; PG8_SCHED;
            PG8_STAGE2(PG8_SB(1, 1), b3 + hstepB, voffB[0], voffB[1]);
            PG8_WAIT_V(6); PG8_BAR; PG8_MMA(1, 1, At, B1); PG8_BAR;
        }
        SP_MARK((PROBE_PID < 0 || S.pid == PROBE_PID) ? 10 : -1);
        S.epi(acc, cur, wr, wc, fr, fq);
        SP_MARK((PROBE_PID < 0 || S.pid == PROBE_PID) ? 9 : -1);
        if (!has_next) break;
#pragma unroll
        for (int a = 0; a < 2; ++a)
#pragma unroll
            for (int b = 0; b < 2; ++b)
#pragma unroll
                for (int m = 0; m < 4; ++m)
#pragma unroll
                    for (int n = 0; n < 2; ++n) acc[a][b][m][n] = (f32x4){zf, zf, zf, zf};
        cur = nxt; cA = nA; ++ui;
        if constexpr (P::GATHER) {
#pragma unroll
            for (int h = 0; h < 2; ++h)
#pragma unroll
                for (int i = 0; i < 2; ++i) vAc[h][i] = vAn[h][i];
        }
    }
    PG8_WAIT_V(0);
    if (wr == 0) PG8_BAR;
    PG8_BAR;
#undef PG8_SA
#undef PG8_SB
#undef PG8_STAGE2
#undef PG8_LDA
#undef PG8_LDB
#undef PG8_MMA
#undef PG8_WAIT_V
#undef PG8_WAIT_L
#undef PG8_BAR
#undef PG8_SCHED
}

enum { EK_BF16 = 0, EK_LORA1 = 1, EK_LORA2 = 2, EK_F32RES = 3, EK_INPROJ = 4 };
template <int KIND>
struct DenseP {
    static constexpr bool PERM = true, GATHER = false;
    int K, lda, ldb, nM, nN, nprob, G, c, pid;
    const bf16_t* A; size_t a_stride;
    const bf16_t* Aalt1; const bf16_t* Aalt2;
    int a_split; long a_jump;
    const bf16_t* B; size_t b_stride;
    bf16_t* O; size_t o_stride; int ldc;
    bf16_t* Oalt1; bf16_t* Oalt2;
    const float* resf; const bf16_t* resb; bf16_t* Ob;
    const float* v0; const float* v1;
    __device__ __forceinline__ bool next(int i, Unit& u) const {
        const long L = (long)i * G + c; const int per = nM * nN; if (L >= (long)per * nprob) return false;
        u.prob = (int)(L / per); tile_order((int)(L % per), nM, nN, u.pm, u.pn); return true;
    }
    __device__ __forceinline__ const char* a_ptr(const Unit& u) const { const bf16_t* a0 = Aalt1 ? ((u.prob == 0) ? A : (u.prob == 1) ? Aalt1 : Aalt2) : A + (size_t)u.prob * a_stride; return (const char*)(a0 + (size_t)u.pm * BM * lda); }
    __device__ __forceinline__ long a_kadj(int kt) const { return (a_split > 0 && kt >= a_split) ? a_jump : 0; }
    __device__ __forceinline__ const char* b_ptr(const Unit& u, int kt) const { return (const char*)(B + (size_t)u.prob * b_stride + (size_t)u.pn * BM * ldb) + (size_t)kt * (BK * 2); }
    __device__ __forceinline__ unsigned a_voff(const Unit&, int, int) const { return 0u; }
    __device__ __forceinline__ void epi(const f32x4 (&acc)[2][2][4][2], const Unit& u, int wr, int wc, int fr, int fq) const {
        const int row0 = u.pm * BM + wr * 64 + fr;
        if constexpr (KIND == EK_F32RES) {
            const int col0 = u.pn * BM + wc * 32 + 8 * fq;
#pragma unroll
            for (int ai = 0; ai < 2; ++ai)
#pragma unroll
                for (int mp = 0; mp < 2; ++mp) {
                    f32x4 r0[2][2], r1[2][2];
#pragma unroll
                    for (int mm = 0; mm < 2; ++mm) { const size_t ro = (size_t)(row0 + ai * HALF + (mp * 2 + mm) * 16) * ldc + col0;
#pragma unroll
                        for (int bj = 0; bj < 2; ++bj) {
                            if (resf) { r0[mm][bj] = __builtin_nontemporal_load((const f32x4*)(resf + ro + bj * HALF)); r1[mm][bj] = __builtin_nontemporal_load((const f32x4*)(resf + ro + bj * HALF + 4)); }
                            else { const u32x4 rw = *(const u32x4*)(resb + ro + bj * HALF); r0[mm][bj] = (f32x4){bflo(rw.x), bfhi(rw.x), bflo(rw.y), bfhi(rw.y)}; r1[mm][bj] = (f32x4){bflo(rw.z), bfhi(rw.z), bflo(rw.w), bfhi(rw.w)}; } } }
#pragma unroll
                    for (int mm = 0; mm < 2; ++mm) { const size_t ro = (size_t)(row0 + ai * HALF + (mp * 2 + mm) * 16) * ldc + col0;
#pragma unroll
                        for (int bj = 0; bj < 2; ++bj) { const f32x4 x0 = acc[ai][bj][mp * 2 + mm][0] + r0[mm][bj], x1 = acc[ai][bj][mp * 2 + mm][1] + r1[mm][bj];
                            u32x4 w; w.x = cvt_pk_bf16(x0[0], x0[1]); w.y = cvt_pk_bf16(x0[2], x0[3]); w.z = cvt_pk_bf16(x1[0], x1[1]); w.w = cvt_pk_bf16(x1[2], x1[3]);
                            *(u32x4*)(Ob + ro + bj * HALF) = w; } }
                }
        } else {
            const int col0 = u.pn * BM + wc * 32 + 8 * fq;
            bf16_t* base = Oalt1 ? ((u.prob == 0) ? O : (u.prob == 1) ? Oalt1 : Oalt2) : O + (size_t)u.prob * o_stride;
            f32x4 bv[2][2];
#pragma unroll
            for (int bj = 0; bj < 2; ++bj)
#pragma unroll
                for (int n = 0; n < 2; ++n) {
                    if constexpr (KIND == EK_LORA2) { bv[bj][n] = (u.prob == 0) ? *(const f32x4*)(v0 + col0 + bj * HALF + 4 * n) : (u.prob == 1) ? *(const f32x4*)(v1 + col0 + bj * HALF + 4 * n) : (f32x4){0.f, 0.f, 0.f, 0.f}; }
                    else bv[bj][n] = (f32x4){0.f, 0.f, 0.f, 0.f};
                }
#pragma unroll
            for (int ai = 0; ai < 2; ++ai)
#pragma unroll
                for (int m = 0; m < 4; ++m) { bf16_t* rowp = base + (size_t)(row0 + ai * HALF + m * 16) * ldc + col0;
#pragma unroll
                    for (int bj = 0; bj < 2; ++bj) { f32x4 x0 = acc[ai][bj][m][0] + bv[bj][0], x1 = acc[ai][bj][m][1] + bv[bj][1];
                        if constexpr (KIND == EK_LORA1) {
                            const int g0 = u.pn * BM + bj * HALF + wc * 32; const float kx = (g0 < 64) ? 2.f : 1.f;
#pragma unroll
                            for (int j = 0; j < 4; ++j) { const float s0 = fsigmoid(kx * x0[j]), s1 = fsigmoid(kx * x1[j]);
                                x0[j] = (g0 < 64) ? 2.f * s0 - 1.f : (g0 >= 128) ? s0 : x0[j]; x1[j] = (g0 < 64) ? 2.f * s1 - 1.f : (g0 >= 128) ? s1 : x1[j]; } }
                        if constexpr (KIND == EK_LORA2) {
                            const float sc = (u.prob == 0) ? 0.6065306597126334f : 1.f;
#pragma unroll
                            for (int j = 0; j < 4; ++j) { const float s0 = sc * fsigmoid(x0[j]), s1 = sc * fsigmoid(x1[j]); x0[j] = (u.prob == 2) ? x0[j] : s0; x1[j] = (u.prob == 2) ? x1[j] : s1; } }
                        if constexpr (KIND == EK_INPROJ) {
                            if (u.pn >= PC_Q / 256 && u.pn < PC_V / 256) { const int pos = (row0 + ai * HALF + m * 16) & (SEQ - 1); const float sc = (u.pn >= PC_K / 256) ? 0.08838834764831845f : 1.f;
                                const f32x4 cs0 = *(const f32x4*)(v0 + ((size_t)pos * 64 + wc * 16 + 4 * fq) * 2), cs1 = *(const f32x4*)(v0 + ((size_t)pos * 64 + wc * 16 + 4 * fq + 2) * 2);
                                const f32x4 a = x0, b = x1;
                                x0[0] = (a[0] * cs0[0] - a[1] * cs0[1]) * sc; x0[1] = (a[0] * cs0[1] + a[1] * cs0[0]) * sc; x0[2] = (a[2] * cs0[2] - a[3] * cs0[3]) * sc; x0[3] = (a[2] * cs0[3] + a[3] * cs0[2]) * sc;
                                x1[0] = (b[0] * cs1[0] - b[1] * cs1[1]) * sc; x1[1] = (b[0] * cs1[1] + b[1] * cs1[0]) * sc; x1[2] = (b[2] * cs1[2] - b[3] * cs1[3]) * sc; x1[3] = (b[2] * cs1[3] + b[3] * cs1[2]) * sc; } }
                        u32x4 w; w.x = cvt_pk_bf16(x0[0], x0[1]); w.y = cvt_pk_bf16(x0[2], x0[3]); w.z = cvt_pk_bf16(x1[0], x1[1]); w.w = cvt_pk_bf16(x1[2], x1[3]);
                        *(u32x4*)(rowp + bj * HALF) = w; } }
        }
    }
};

__device__ __forceinline__ void pair_lohi(int pr, int& lo, int& hi) { lo = (pr < 3) ? 0 : (pr < 5 ? 1 : 2); hi = (pr < 3) ? pr + 1 : (pr < 5 ? pr - 1 : 3); }

struct Moe1P {
    static constexpr bool PERM = true, GATHER = true;
    int K, lda, ldb, G, c, ntiles, pid;
    const bf16_t* A; const bf16_t* W13;
    bf16_t* H; const int* slot_tok; const float* slot_c; const int* tile_bkt;
    __device__ __forceinline__ bool next(int i, Unit& u) const {
        const int m = (c >> 3) + (G >> 3) * i; if ((G & 7) != 0 || m >= ntiles) { if ((G & 7) == 0) return false; const long L = (long)i * G + c; if (L >= (long)ntiles * 8) return false; u.pm = (int)(L >> 3); u.pn = (int)(L & 7); u.prob = __builtin_amdgcn_readfirstlane(ld_vec_i32(tile_bkt + u.pm)); return true; }
        u.pm = m; u.pn = c & 7; u.prob = __builtin_amdgcn_readfirstlane(ld_vec_i32(tile_bkt + u.pm)); return true;
    }
    __device__ __forceinline__ const char* a_ptr(const Unit&) const { return (const char*)A; }
    __device__ __forceinline__ long a_kadj(int) const { return 0; }
    __device__ __forceinline__ unsigned a_voff(const Unit& u, int row, int C) const { int tok = slot_tok[u.pm * BM + row]; tok = tok < 0 ? 0 : tok; return (unsigned)(tok * lda + C) * 2u; }
    __device__ __forceinline__ const char* b_ptr(const Unit& u, int kt) const {
        int lo, hi; pair_lohi(u.prob % 6, lo, hi); const int e = (u.prob / 6) * 4 + ((u.pn < 4) ? lo : hi);
        return (const char*)(W13 + ((size_t)e * 1024 + (size_t)(u.pn & 3) * BM) * 1024) + (size_t)kt * (BK * 2);
    }
    __device__ __forceinline__ void epi(const f32x4 (&acc)[2][2][4][2], const Unit& u, int wr, int wc, int fr, int fq) const {
        const int row0 = u.pm * BM + wr * 64 + fr, col0 = ((u.pn < 4) ? 0 : 512) + (u.pn & 3) * 128 + wc * 32 + 8 * fq, ci = (u.pn < 4) ? 0 : 1;
#pragma unroll
        for (int ai = 0; ai < 2; ++ai)
#pragma unroll
            for (int m = 0; m < 4; ++m) { const int row = row0 + ai * HALF + m * 16; const float cw = slot_c[(size_t)row * 2 + ci];
                const f32x4 g0 = acc[ai][0][m][0], g1 = acc[ai][0][m][1], u0 = acc[ai][1][m][0], u1 = acc[ai][1][m][1]; f32x4 x0, x1;
#pragma unroll
                for (int j = 0; j < 4; ++j) { x0[j] = fsilu(g0[j]) * u0[j] * cw; x1[j] = fsilu(g1[j]) * u1[j] * cw; }
                u32x4 w; w.x = cvt_pk_bf16(x0[0], x0[1]); w.y = cvt_pk_bf16(x0[2], x0[3]); w.z = cvt_pk_bf16(x1[0], x1[1]); w.w = cvt_pk_bf16(x1[2], x1[3]);
                *(u32x4*)(H + (size_t)row * 1024 + col0) = w; }
    }
};
struct Moe2P {
    static constexpr bool PERM = true, GATHER = false;
    int K, lda, ldb, G, c, ntiles, pid;
    const bf16_t* H; const bf16_t* W2;
    const bf16_t* hsrc; bf16_t* hdst; const int* slot_tok; const int* tile_bkt;
    __device__ __forceinline__ bool next(int i, Unit& u) const {
        const int m = 2 * ((c >> 3) + (G >> 3) * i) + ((c >> 2) & 1); if ((G & 7) != 0 || m >= ntiles) { if ((G & 7) == 0) return false; const long L = (long)i * G + c; if (L >= (long)ntiles * 4) return false; u.pm = (int)(L >> 2); u.pn = (int)(L & 3); u.prob = __builtin_amdgcn_readfirstlane(ld_vec_i32(tile_bkt + u.pm)); return true; }
        u.pm = m; u.pn = c & 3; u.prob = __builtin_amdgcn_readfirstlane(ld_vec_i32(tile_bkt + u.pm)); return true;
    }
    __device__ __forceinline__ const char* a_ptr(const Unit& u) const { return (const char*)(H + (size_t)u.pm * BM * 1024); }
    __device__ __forceinline__ long a_kadj(int) const { return 0; }
    __device__ __forceinline__ unsigned a_voff(const Unit&, int, int) const { return 0u; }
    __device__ __forceinline__ const char* b_ptr(const Unit& u, int kt) const {
        int lo, hi; pair_lohi(u.prob % 6, lo, hi); const int e = (u.prob / 6) * 4 + ((kt < 8) ? lo : hi);
        return (const char*)(W2 + ((size_t)e * 1024 + (size_t)u.pn * BM) * 512) + (size_t)(kt & 7) * (BK * 2);
    }
    __device__ __forceinline__ void epi(const f32x4 (&acc)[2][2][4][2], const Unit& u, int wr, int wc, int fr, int fq) const {
        const int row0 = u.pm * BM + wr * 64 + fr, col0 = u.pn * BM + wc * 32 + 8 * fq;
        int tok[2][4];
#pragma unroll
        for (int ai = 0; ai < 2; ++ai)
#pragma unroll
            for (int m = 0; m < 4; ++m) tok[ai][m] = slot_tok[row0 + ai * HALF + m * 16];
#pragma unroll
        for (int ai = 0; ai < 2; ++ai) {
            u32x4 r[4][2];
#pragma unroll
            for (int m = 0; m < 4; ++m) { const int tk = tok[ai][m]; const bf16_t* rp = hsrc + (size_t)(tk < 0 ? 0 : tk) * 1024 + col0;
#pragma unroll
                for (int bj = 0; bj < 2; ++bj) r[m][bj] = *(const u32x4*)(rp + bj * HALF); }
#pragma unroll
            for (int m = 0; m < 4; ++m) { const int tk = tok[ai][m];
                if (tk >= 0) { bf16_t* wp = hdst + (size_t)tk * 1024 + col0;
#pragma unroll
                    for (int bj = 0; bj < 2; ++bj) { const u32x4 rw = r[m][bj]; const f32x4 a0 = acc[ai][bj][m][0], a1 = acc[ai][bj][m][1];
                        u32x4 w; w.x = cvt_pk_bf16(a0[0] + bflo(rw.x), a0[1] + bfhi(rw.x)); w.y = cvt_pk_bf16(a0[2] + bflo(rw.y), a0[3] + bfhi(rw.y));
                        w.z = cvt_pk_bf16(a1[0] + bflo(rw.z), a1[1] + bfhi(rw.z)); w.w = cvt_pk_bf16(a1[2] + bflo(rw.w), a1[3] + bfhi(rw.w));
                        *(u32x4*)(wp + bj * HALF) = w; } } }
        }
    }
};

struct Frame {
    LAS unsigned char* lds;
    int tid, lane, wave, G, bid;
    float* out; unsigned char* ws;
};
#define WSP(T, off) ((T*)(F.ws + (off)))

__device__ __forceinline__ void prep_tile(const Frame& F, const float* src, int src_ld, int k0, int kvalid, int c0, int nvalid, bf16_t* dst, int dst_ld, bool il = false, int ksrc = -1, const float* kscale = nullptr, bool one_minus = false) {
    const int ks0 = ksrc < 0 ? k0 : ksrc;
    LAS float* tl = (LAS float*)F.lds;
    __syncthreads();
#pragma unroll
    for (int p = 0; p < 2; ++p) { const int kk = (F.tid >> 4) + 32 * p, n4 = (F.tid & 15) * 4;
        f32x4 v = (f32x4){0.f, 0.f, 0.f, 0.f};
        if (il) {
            v = __builtin_nontemporal_load((const f32x4*)(src + (size_t)(ks0 + kk) * src_ld + c0 + ((n4 < 32) ? n4 : 32 + n4))); const int d0 = 2 * (n4 & 31) + (n4 >> 5);
            tl[kk * 65 + d0] = v[0]; tl[kk * 65 + d0 + 2] = v[1]; tl[kk * 65 + d0 + 4] = v[2]; tl[kk * 65 + d0 + 6] = v[3];
        } else {
        if (kk < kvalid && n4 < nvalid) v = __builtin_nontemporal_load((const f32x4*)(src + (size_t)(ks0 + kk) * src_ld + c0 + n4));
        if (kscale) { const float f_ = kscale[ks0 + kk]; v = v * (one_minus ? 1.f - f_ : f_); }
        tl[kk * 65 + n4 + 0] = v[0]; tl[kk * 65 + n4 + 1] = v[1]; tl[kk * 65 + n4 + 2] = v[2]; tl[kk * 65 + n4 + 3] = v[3]; } }
    __syncthreads();
    { const int n = F.tid >> 3, kc = (F.tid & 7) * 8; float x[8];
#pragma unroll
        for (int j = 0; j < 8; ++j) x[j] = tl[(kc + j) * 65 + n];
        u32x4 w; w.x = cvt_pk_bf16(x[0], x[1]); w.y = cvt_pk_bf16(x[2], x[3]); w.z = cvt_pk_bf16(x[4], x[5]); w.w = cvt_pk_bf16(x[6], x[7]);
        *(u32x4*)(dst + (size_t)n * dst_ld + k0 + kc) = w; }
}
__device__ __forceinline__ void phase_prep(const Params& p, const Frame& F, int id_lo, int id_hi, bool tables) {
    bf16_t* wb = WSP(bf16_t, WS_WB);
    constexpr int N0 = 1472, N1 = N0 + 512, N2 = N1 + 1024, N3 = N2 + 256, N4 = N3 + 192, N5 = N4 + 8192, N6 = N5 + 4096;
    (void)N6;
    for (int id = id_lo + F.bid; id < id_hi; id += F.G) {
        if (id < N0) { const int nt = id / 16, kt = id % 16, n0 = nt * 64; int c0, nv;
            if (n0 < PC_Q) { c0 = n0; nv = 64; } else if (n0 < PC_DT) { c0 = n0 + 16; nv = 64; } else if (n0 == PC_DT) { c0 = 2560; nv = 16; } else { c0 = 0; nv = 0; }
            const bool il = (n0 >= PC_Q && n0 < PC_V);
            if (il) c0 = 2576 + ((n0 - PC_Q) >> 7) * 128 + (((n0 - PC_Q) >> 6) & 1) * 32;
            prep_tile(F, p.in[4], 5648, kt * 64, 64, c0, nv, wb + WB_WIN / 2 + (size_t)n0 * 1024, 1024, il); }
        else if (id < N1) { const int j = id - N0, nt = j / 32, kt = j % 32; prep_tile(F, p.in[11], 1024, kt * 64, 64, nt * 64, 64, wb + WB_WOUT / 2 + (size_t)nt * 64 * 2048, 2048); }
        else if (id < N2) { const int j = id - N1, w = j / 256, r = j % 256, nt = r / 16, kt = r % 16; prep_tile(F, (w == 0) ? p.in[13] : (w == 1) ? p.in[14] : (w == 2) ? p.in[15] : p.in[16], 1024, kt * 64, 64, nt * 64, 64, wb + WB_WR / 2 + (size_t)w * 1048576 + (size_t)nt * 64 * 1024, 1024); }
        else if (id < N3) { const int j = id - N2, nt = j >> 5, kt = j & 31, half = kt >> 4;
            const float* src = (nt == 0) ? p.in[18] : (nt == 1) ? p.in[21] : p.in[23]; const int ncols = (nt < 2) ? 64 : 160, c0 = (nt < 2) ? 0 : (nt - 2) * 64, midx = (nt == 0) ? 1 : (nt == 1) ? 4 : 5;
            int nv = (nt < 2) ? 64 : ncols - c0; nv = nv < 0 ? 0 : (nv > 64 ? 64 : nv); if (nt > 4) nv = 0;
            prep_tile(F, src, ncols, kt * 64, 64, (nv ? c0 : 0), nv, wb + WB_L1 / 2 + (size_t)nt * 64 * 2048, 2048, false, (kt & 15) * 64, p.in[12] + midx * DM, !half); }
        else if (id < N4) { const int j = id - N3, w = j / 64, r = j % 64, nt = r / 4, kt = r % 4;
            int kv = (w == 0) ? (kt == 0 ? 64 : 0) : (w == 1) ? (kt == 1 ? 64 : 0) : 160 - kt * 64; kv = kv < 0 ? 0 : (kv > 64 ? 64 : kv);
            const float* src = (w == 0) ? p.in[19] : (w == 1) ? p.in[22] : p.in[24];
            prep_tile(F, src, 1024, kt * 64, kv, nt * 64, 64, wb + WB_L2 / 2 + (size_t)w * 262144 + (size_t)nt * 64 * 256, 256, false, (w == 1) ? 0 : kt * 64); }
        else if (id < N5) { const int j = id - N4, le = j / 256, r = j % 256, nt = r / 16, kt = r % 16;
            const int pn = nt >> 2, part = (nt >> 1) & 1, c0 = 128 * pn + 64 * (nt & 1);
            const float* src = (part ? p.in[35] : p.in[34]) + (size_t)le * 524288;
            prep_tile(F, src, 512, kt * 64, 64, c0, 64, wb + WB_W13 / 2 + (size_t)le * 1048576 + (size_t)nt * 64 * 1024, 1024); }
        else { const int j = id - N5, le = j / 128, r = j % 128, nt = r / 8, kt = r % 8;
            prep_tile(F, p.in[36] + (size_t)le * 524288, 1024, kt * 64, 64, nt * 64, 64, wb + WB_W2 / 2 + (size_t)le * 524288 + (size_t)nt * 64 * 512, 512); }
    }
    if (!tables) { __syncthreads(); return; }
    { float* rtw = WSP(float, WS_RTW);
        for (int idx = F.bid * NTHREADS + F.tid; idx < 2 * 20 * 1024; idx += F.G * NTHREADS) { const int l = idx / 20480, r = idx % 20480, j = r >> 10, k = r & 1023;
            rtw[idx] = (j < 4) ? p.in[30][(size_t)l * 4096 + k * 4 + j] : p.in[32][(size_t)l * 16384 + k * 16 + (j - 4)]; } }
    f32x2* rope = WSP(f32x2, WS_ROPE);
    for (int idx = F.bid * NTHREADS + F.tid; idx < SEQ * 64; idx += F.G * NTHREADS) {
        const int pos = idx >> 6, i = idx & 63;
        const float invf = exp2f(-(float)i * (13.287712379549449f / 64.f));
        const float ang = (float)pos * invf;
        const double x = (double)ang;
        const double kq = rint(x * 0.63661977236758134308);
        double r = fma(-kq, 1.57079632679489655800e+00, x); r = fma(-kq, 6.12323399573676603587e-17, r);
        const double r2 = r * r;
        double sp = -7.6471637318198164759e-13; sp = fma(sp, r2, 1.6059043836821614599e-10); sp = fma(sp, r2, -2.5052108385441718775e-08); sp = fma(sp, r2, 2.7557319223985890653e-06);
        sp = fma(sp, r2, -1.9841269841269841270e-04); sp = fma(sp, r2, 8.3333333333333333333e-03); sp = fma(sp, r2, -1.6666666666666666667e-01); const double sn = fma(sp * r2, r, r);
        double cp = 4.7794773323873852974e-14; cp = fma(cp, r2, -1.1470745597729724714e-11); cp = fma(cp, r2, 2.0876756987868098979e-09); cp = fma(cp, r2, -2.7557319223985890653e-07);
        cp = fma(cp, r2, 2.4801587301587301587e-05); cp = fma(cp, r2, -1.3888888888888888889e-03); cp = fma(cp, r2, 4.1666666666666666667e-02); cp = fma(cp, r2, -0.5); const double cs = fma(cp, r2, 1.0);
        const int q = ((int)kq) & 3;
        const double c = (q == 0) ? cs : (q == 1) ? -sn : (q == 2) ? -cs : sn;
        const double s = (q == 0) ? sn : (q == 1) ? cs : (q == 2) ? -sn : -cs;
        rope[idx] = (f32x2){(float)c, (float)s};
    }
}

__device__ __forceinline__ void row_load(const float* row, int lane, f32x4 (&v)[4]) {
#pragma unroll
    for (int j = 0; j < 4; ++j) v[j] = *(const f32x4*)(row + j * 256 + lane * 4);
}
__device__ __forceinline__ void row_load_nt(const float* row, int lane, f32x4 (&v)[4]) {
#pragma unroll
    for (int j = 0; j < 4; ++j) v[j] = __builtin_nontemporal_load((const f32x4*)(row + j * 256 + lane * 4));
}
__device__ __forceinline__ void row_load_bf_nt(const bf16_t* row, int lane, f32x4 (&v)[4]) {
#pragma unroll
    for (int j = 0; j < 4; ++j) { const u32x2 w = __builtin_nontemporal_load((const u32x2*)(row + j * 256 + lane * 4)); v[j] = (f32x4){bflo(w.x), bfhi(w.x), bflo(w.y), bfhi(w.y)}; }
}
__device__ __forceinline__ void row_load_bf(const bf16_t* row, int lane, f32x4 (&v)[4]) {
#pragma unroll
    for (int j = 0; j < 4; ++j) { const u32x2 w = *(const u32x2*)(row + j * 256 + lane * 4); v[j] = (f32x4){bflo(w.x), bfhi(w.x), bflo(w.y), bfhi(w.y)}; }
}
__device__ __forceinline__ float row_rstd(const f32x4 (&v)[4], float eps) {
    float ss = 0.f;
#pragma unroll
    for (int j = 0; j < 4; ++j) ss += v[j][0] * v[j][0] + v[j][1] * v[j][1] + v[j][2] * v[j][2] + v[j][3] * v[j][3];
    ss = wave_sum_u(ss);
    return rsqrtf(ss * (1.f / 1024.f) + eps);
}
__device__ __forceinline__ void row_store_bf16(bf16_t* row, int lane, const f32x4 (&v)[4]) {
#pragma unroll
    for (int j = 0; j < 4; ++j) { u32x2 w; w.x = cvt_pk_bf16(v[j][0], v[j][1]); w.y = cvt_pk_bf16(v[j][2], v[j][3]); *(u32x2*)(row + j * 256 + lane * 4) = w; }
}

template <bool TO_BF16, bool SRC_BF16 = false>
__device__ __forceinline__ void phase_rmsnorm(const Params& p, const Frame& F, const void* src_, const float* w, void* dst) {
    const float* src = (const float*)src_; const bf16_t* srcb = (const bf16_t*)src_; (void)src; (void)srcb;
    f32x4 wv[4]; row_load(w, F.lane, wv);
    int row = F.bid * 8 + F.wave; const int stride = F.G * 8;
    f32x4 v[4], vn[4];
    if (row < T_TOK) { if constexpr (SRC_BF16) row_load_bf_nt(srcb + (size_t)row * DM, F.lane, v); else row_load_nt(src + (size_t)row * DM, F.lane, v); }
    for (; row < T_TOK; row += stride) {
        if (row + stride < T_TOK) { if constexpr (SRC_BF16) row_load_bf_nt(srcb + (size_t)(row + stride) * DM, F.lane, vn); else row_load_nt(src + (size_t)(row + stride) * DM, F.lane, vn); }
        const float rs = row_rstd(v, 1e-6f);
#pragma unroll
        for (int j = 0; j < 4; ++j) v[j] = v[j] * rs * wv[j];
        if constexpr (TO_BF16) row_store_bf16((bf16_t*)dst + (size_t)row * DM, F.lane, v);
        else {
#pragma unroll
            for (int j = 0; j < 4; ++j) *(f32x4*)((float*)dst + (size_t)row * DM + j * 256 + F.lane * 4) = v[j];
        }
#pragma unroll
        for (int j = 0; j < 4; ++j) v[j] = vn[j];
    }
}

__device__ __forceinline__ void phase_conv(const Params& p, const Frame& F) {
    bf16_t* proj = WSP(bf16_t, WS_SLAB);
    bf16_t* xc = (bf16_t*)F.out;
    const float* conv_w = p.in[5]; const float* conv_b = p.in[6];
    for (int item = F.bid * 8 + F.wave; item < (T_TOK / 32) * 3; item += F.G * 8) {
        const int run = item / 3, cb = item - run * 3, c0 = cb * 512 + F.lane * 8, t0 = run * 32;
        float w[4][8], bb[8], xm3[8], xm2[8], xm1[8];
#pragma unroll
        for (int j = 0; j < 4; ++j) { const f32x4 a0 = *(const f32x4*)(conv_w + j * 1536 + c0), a1 = *(const f32x4*)(conv_w + j * 1536 + c0 + 4);
#pragma unroll
            for (int e = 0; e < 4; ++e) { w[j][e] = a0[e]; w[j][4 + e] = a1[e]; } }
        { const f32x4 a0 = *(const f32x4*)(conv_b + c0), a1 = *(const f32x4*)(conv_b + c0 + 4);
#pragma unroll
            for (int e = 0; e < 4; ++e) { bb[e] = a0[e]; bb[4 + e] = a1[e]; } }
        const bool first = (t0 & (SEQ - 1)) == 0;
        { u32x4 r3 = (u32x4){0u, 0u, 0u, 0u}, r2 = r3, r1 = r3;
            if (!first) { r3 = __builtin_nontemporal_load((const u32x4*)(proj + (size_t)(t0 - 3) * NPROJ + PC_XBC + c0)); r2 = __builtin_nontemporal_load((const u32x4*)(proj + (size_t)(t0 - 2) * NPROJ + PC_XBC + c0)); r1 = __builtin_nontemporal_load((const u32x4*)(proj + (size_t)(t0 - 1) * NPROJ + PC_XBC + c0)); }
            xm3[0] = bflo(r3.x); xm3[1] = bfhi(r3.x); xm3[2] = bflo(r3.y); xm3[3] = bfhi(r3.y); xm3[4] = bflo(r3.z); xm3[5] = bfhi(r3.z); xm3[6] = bflo(r3.w); xm3[7] = bfhi(r3.w);
            xm2[0] = bflo(r2.x); xm2[1] = bfhi(r2.x); xm2[2] = bflo(r2.y); xm2[3] = bfhi(r2.y); xm2[4] = bflo(r2.z); xm2[5] = bfhi(r2.z); xm2[6] = bflo(r2.w); xm2[7] = bfhi(r2.w);
            xm1[0] = bflo(r1.x); xm1[1] = bfhi(r1.x); xm1[2] = bflo(r1.y); xm1[3] = bfhi(r1.y); xm1[4] = bflo(r1.z); xm1[5] = bfhi(r1.z); xm1[6] = bflo(r1.w); xm1[7] = bfhi(r1.w); }
#pragma unroll 4
        for (int tt = 0; tt < 32; ++tt) {
            const u32x4 r = __builtin_nontemporal_load((const u32x4*)(proj + (size_t)(t0 + tt) * NPROJ + PC_XBC + c0));
            const float x[8] = {bflo(r.x), bfhi(r.x), bflo(r.y), bfhi(r.y), bflo(r.z), bfhi(r.z), bflo(r.w), bfhi(r.w)};
            float o[8];
#pragma unroll
            for (int e = 0; e < 8; ++e) { o[e] = fsilu(bb[e] + w[0][e] * xm3[e] + w[1][e] * xm2[e] + w[2][e] * xm1[e] + w[3][e] * x[e]); xm3[e] = xm2[e]; xm2[e] = xm1[e]; xm1[e] = x[e]; }
            u32x4 ow; ow.x = cvt_pk_bf16(o[0], o[1]); ow.y = cvt_pk_bf16(o[2], o[3]); ow.z = cvt_pk_bf16(o[4], o[5]); ow.w = cvt_pk_bf16(o[6], o[7]);
            *(u32x4*)(xc + (size_t)(t0 + tt) * 1536 + c0) = ow;
        }
    }
}

typedef float f32x16 __attribute__((ext_vector_type(16)));
typedef short s16x4 __attribute__((ext_vector_type(4)));
#define MFMA32(a, b, c) __builtin_amdgcn_mfma_f32_32x32x16_bf16((a), (b), (c), 0, 0, 0)
__device__ __forceinline__ unsigned off_b(unsigned row, unsigned ch) { return 256u * row + 16u * (ch ^ (((row & 3u) << 2) | ((row >> 2) & 3u))); }
__device__ __forceinline__ unsigned off_v(unsigned row, unsigned ch) { return 128u * row + 16u * (ch ^ (((row >> 1) & 1u) << 2)); }
__device__ __forceinline__ unsigned off_y(unsigned row, unsigned ch) { return 128u * row + 16u * (ch ^ (row & 7u)); }
__device__ __forceinline__ bf16x8 tr_read2(unsigned a0, unsigned a1) {
    s16x4 lo, hi;
    asm volatile("ds_read_b64_tr_b16 %0, %2\n\tds_read_b64_tr_b16 %1, %3\n\ts_waitcnt lgkmcnt(0)" : "=&v"(lo), "=&v"(hi) : "v"(a0), "v"(a1) : "memory");
    return __builtin_shufflevector(lo, hi, 0, 1, 2, 3, 4, 5, 6, 7);
}
__device__ __forceinline__ void tr_read4(unsigned a0, unsigned a1, unsigned a2, unsigned a3, bf16x8& f0, bf16x8& f1) {
    s16x4 r0, r1, r2, r3;
    asm volatile("ds_read_b64_tr_b16 %0, %4\n\tds_read_b64_tr_b16 %1, %5\n\tds_read_b64_tr_b16 %2, %6\n\tds_read_b64_tr_b16 %3, %7\n\ts_waitcnt lgkmcnt(0)"
                 : "=&v"(r0), "=&v"(r1), "=&v"(r2), "=&v"(r3) : "v"(a0), "v"(a1), "v"(a2), "v"(a3) : "memory");
    f0 = __builtin_shufflevector(r0, r1, 0, 1, 2, 3, 4, 5, 6, 7); f1 = __builtin_shufflevector(r2, r3, 0, 1, 2, 3, 4, 5, 6, 7);
}
__device__ __forceinline__ void tr_read8(unsigned a0, unsigned a1, unsigned a2, unsigned a3, unsigned a4, unsigned a5, unsigned a6, unsigned a7, bf16x8& f0, bf16x8& f1, bf16x8& f2, bf16x8& f3) {
    s16x4 r0, r1, r2, r3, r4, r5, r6, r7;
    asm volatile("ds_read_b64_tr_b16 %0, %8\n\tds_read_b64_tr_b16 %1, %9\n\tds_read_b64_tr_b16 %2, %10\n\tds_read_b64_tr_b16 %3, %11\n\tds_read_b64_tr_b16 %4, %12\n\tds_read_b64_tr_b16 %5, %13\n\tds_read_b64_tr_b16 %6, %14\n\tds_read_b64_tr_b16 %7, %15\n\ts_waitcnt lgkmcnt(0)"
                 : "=&v"(r0), "=&v"(r1), "=&v"(r2), "=&v"(r3), "=&v"(r4), "=&v"(r5), "=&v"(r6), "=&v"(r7) : "v"(a0), "v"(a1), "v"(a2), "v"(a3), "v"(a4), "v"(a5), "v"(a6), "v"(a7) : "memory");
    f0 = __builtin_shufflevector(r0, r1, 0, 1, 2, 3, 4, 5, 6, 7); f1 = __builtin_shufflevector(r2, r3, 0, 1, 2, 3, 4, 5, 6, 7);
    f2 = __builtin_shufflevector(r4, r5, 0, 1, 2, 3, 4, 5, 6, 7); f3 = __builtin_shufflevector(r6, r7, 0, 1, 2, 3, 4, 5, 6, 7);
}
__device__ __forceinline__ f32x16 zero16() { f32x16 z;
#pragma unroll
    for (int i = 0; i < 16; ++i) z[i] = 0.f;
    return z; }
__device__ __forceinline__ void phase_scan0(const Params& p, const Frame& F) {
    bf16_t* proj = WSP(bf16_t, WS_SLAB);
    const bf16_t* xc = (const bf16_t*)F.out;
    constexpr unsigned OQ = 0, OK = 32768, OV = 65536, OVW = 81920, OS = 98304, OY = 114688, OSM = 131072;
    LAS unsigned char* L = F.lds;
    const unsigned lbase = (unsigned)(__UINTPTR_TYPE__)L;
    LAS float* sm = (LAS float*)(L + OSM);
    const int lane = F.lane, w = F.wave, it = w >> 1, pt = w & 1;
    const unsigned h0 = lane >> 5, lr0 = lane & 31;
    const int trow = F.tid >> 2, tpart = F.tid & 3;
    const unsigned blk0 = (lane >> 4) & 1u, tq0 = (lane & 15u) >> 2, tp0 = lane & 3u;
    for (int ui = 0; ui < 2; ++ui) {
        const int uu = F.bid + ui * F.G;
        if (uu >= 512) break;
        const bool is_ssd = uu < 256; const int v = uu & 255, x8 = v & 7, slot = v >> 3;
        int b, hh, grp = 0, hr = 0, sl = 0;
        if (is_ssd) { const int pg = x8 + 8 * (slot >> 3), hg = slot & 7; b = pg >> 1; grp = pg & 1; hh = grp * 8 + hg; }
        else { const int pr = x8 + 8 * (slot >> 2); sl = slot & 3; b = pr >> 2; hr = pr & 3; hh = hr * 4 + sl; }
        const size_t row0 = (size_t)b * SEQ;
        const bf16_t* qptr; const bf16_t* kptr; const bf16_t* vptr; size_t qs, vs; bf16_t* optr;
        if (is_ssd) { qptr = xc + 1280 + grp * 128; kptr = xc + 1024 + grp * 128; vptr = xc + hh * 64; qs = 1536; vs = 1536; optr = proj + hh * 64; }
        else { qptr = proj + PC_Q + hr * 128; kptr = proj + PC_K + hr * 128; vptr = proj + PC_V + hr * 256 + sl * 64; qs = NPROJ; vs = NPROJ; optr = proj + 1024 + hr * 256 + sl * 64; }
        const bf16_t* zptr = proj + hh * 64;
        const float A_h = is_ssd ? -__expf(p.in[8][hh]) : 0.f, dtb = is_ssd ? p.in[7][hh] : 0.f, D_h = is_ssd ? p.in[9][hh] : 0.f;
        const float lng = __logf(1.f - exp2f(-5.f - (float)hr));
        u32x4 rv[2], rz[2]; float rdt0 = 0.f, rdt1 = 0.f;
        f32x16 St0 = zero16(), St1 = zero16();
        __syncthreads();
        for (int i = F.tid; i < 16384 / 16; i += NTHREADS) *(LAS u32x4*)(L + OS + i * 16) = (u32x4){0u, 0u, 0u, 0u};
#define SC_LOAD(c) do { const size_t r_ = row0 + (size_t)(c) * 128 + trow; \
            _Pragma("unroll") for (int e = 0; e < 2; ++e) rv[e] = *(const u32x4*)(vptr + r_ * vs + tpart * 16 + e * 8); \
            if (is_ssd && w == 0) { rdt0 = bf2f(proj[(row0 + (size_t)(c) * 128 + 2 * lane) * NPROJ + PC_DT + hh]); rdt1 = bf2f(proj[(row0 + (size_t)(c) * 128 + 2 * lane + 1) * NPROJ + PC_DT + hh]); } } while (0)
#define SC_DMA(c) do { _Pragma("unroll") for (int e = 0; e < 4; ++e) { const int I_ = w * 4 + e; const unsigned r_ = 4u * I_ + ((unsigned)lane >> 4), cs_ = lane & 15u, ch_ = cs_ ^ (((r_ & 3u) << 2) | ((r_ >> 2) & 3u)); \
            const size_t g_ = (row0 + (size_t)(c) * 128 + r_) * qs + ch_ * 8; \
            __builtin_amdgcn_global_load_lds((const unsigned*)(qptr + g_), (LAS unsigned*)(L + OQ + I_ * 1024), 16, 0, 0); \
            __builtin_amdgcn_global_load_lds((const unsigned*)(kptr + g_), (LAS unsigned*)(L + OK + I_ * 1024), 16, 0, 0); } } while (0)
#define SC_LOADZ(c) do { if (is_ssd) { const size_t r_ = row0 + (size_t)(c) * 128 + trow; rz[0] = __builtin_nontemporal_load((const u32x4*)(zptr + r_ * NPROJ + tpart * 16)); rz[1] = __builtin_nontemporal_load((const u32x4*)(zptr + r_ * NPROJ + tpart * 16 + 8)); } } while (0)
#define SC_SMALL(c) do { if (w == 0) { LAS float* sb = sm + ((c) & 1) * 384; float d0, d1, a0, a1; \
            if (is_ssd) { d0 = fsoftplus(rdt0 + dtb); d1 = fsoftplus(rdt1 + dtb); a0 = d0 * A_h; a1 = d1 * A_h; } else { d0 = 1.f; d1 = 1.f; a0 = lng; a1 = lng; } \
            float sc = a0 + a1; _Pragma("unroll") for (int o = 1; o < 64; o <<= 1) { const float tv = __shfl_up(sc, o); if (lane >= o) sc += tv; } \
            const float c1 = sc, c0 = sc - a1; const float tot = __shfl(sc, 63); \
            sb[2 * lane] = c0; sb[2 * lane + 1] = c1; sb[128 + 2 * lane] = d0; sb[128 + 2 * lane + 1] = d1; sb[256 + 2 * lane] = __expf(tot - c0) * d0; sb[256 + 2 * lane + 1] = __expf(tot - c1) * d1; } } while (0)
#define SC_STORE(c) do { const float wj_ = sm[((c) & 1) * 384 + 256 + trow]; \
            _Pragma("unroll") for (int e = 0; e < 2; ++e) { const u32x4 x_ = rv[e]; *(LAS u32x4*)(L + OV + off_v(trow, tpart * 2 + e)) = x_; u32x4 y_; \
                y_.x = cvt_pk_bf16(bflo(x_.x) * wj_, bfhi(x_.x) * wj_); y_.y = cvt_pk_bf16(bflo(x_.y) * wj_, bfhi(x_.y) * wj_); y_.z = cvt_pk_bf16(bflo(x_.z) * wj_, bfhi(x_.z) * wj_); y_.w = cvt_pk_bf16(bflo(x_.w) * wj_, bfhi(x_.w) * wj_); \
                *(LAS u32x4*)(L + OVW + off_v(trow, tpart * 2 + e)) = y_; } } while (0)
        SC_DMA(0); SC_LOAD(0); SC_LOADZ(0);
        SC_SMALL(0);
        __syncthreads();
        SC_STORE(0);
        asm volatile("s_waitcnt vmcnt(0)" ::: "memory");
        __syncthreads();
        SP_DECL;
        for (int c = 0; c < SEQ / 128; ++c) {
            SP_MARK(8);
            const LAS float* sb = sm + (c & 1) * 384;
            unsigned lr = lr0, h = h0, blk = blk0, tq_ = tq0, tp_ = tp0;
            asm volatile("" : "+v"(lr), "+v"(h), "+v"(blk), "+v"(tq_), "+v"(tp_));
            if (c + 1 < SEQ / 128) { SC_LOAD(c + 1); }
            const int ph = pt;
            const float ai = sb[32 * it + lr];
            f32x16 Yd0 = zero16(), Yd1 = zero16();
            for (int jt = ph; jt <= it; jt += 2) {
                f32x16 acc = zero16();
#pragma unroll
                for (int ks = 0; ks < 8; ++ks) { const bf16x8 ka = *(const LAS bf16x8*)(L + OK + off_b(32 * jt + lr, 2 * ks + h)), qb = *(const LAS bf16x8*)(L + OQ + off_b(32 * it + lr, 2 * ks + h)); acc = MFMA32(ka, qb, acc); }
                const bool diag = (jt == it);
#pragma unroll
                for (int g = 0; g < 4; ++g) { const f32x4 aj = *(const LAS f32x4*)(sb + 32 * jt + 8 * g + 4 * h), dj = *(const LAS f32x4*)(sb + 128 + 32 * jt + 8 * g + 4 * h);
#pragma unroll
                    for (int e = 0; e < 4; ++e) { const float dec = __expf(ai - aj[e]) * dj[e]; const bool ok = !diag || ((int)lr >= (int)(8 * g + 4 * h + e)); acc[4 * g + e] = ok ? acc[4 * g + e] * dec : 0.f; } }
#pragma unroll
                for (int s2 = 0; s2 < 2; ++s2) {
                    u32x4 pw; pw.x = cvt_pk_bf16(acc[8 * s2 + 0], acc[8 * s2 + 1]); pw.y = cvt_pk_bf16(acc[8 * s2 + 2], acc[8 * s2 + 3]); pw.z = cvt_pk_bf16(acc[8 * s2 + 4], acc[8 * s2 + 5]); pw.w = cvt_pk_bf16(acc[8 * s2 + 6], acc[8 * s2 + 7]);
                    const bf16x8 Pb = __builtin_bit_cast(bf16x8, pw);
                    const unsigned rb0 = 32 * jt + 16 * s2 + 4 * h + tq_, cc0 = 2 * blk + (tp_ >> 1), o8 = 8 * (tp_ & 1);
                    bf16x8 va0, va1;
                    tr_read4(lbase + OV + off_v(rb0, cc0) + o8, lbase + OV + off_v(rb0 + 8, cc0) + o8, lbase + OV + off_v(rb0, 4 + cc0) + o8, lbase + OV + off_v(rb0 + 8, 4 + cc0) + o8, va0, va1);
                    Yd0 = MFMA32(va0, Pb, Yd0); Yd1 = MFMA32(va1, Pb, Yd1);
                }
            }
            {
                f32x16 Yo = zero16();
#pragma unroll
                for (int ks = 0; ks < 8; ++ks) { const bf16x8 sa = *(const LAS bf16x8*)(L + OS + off_b(32 * ph + lr, 2 * ks + h)), qb = *(const LAS bf16x8*)(L + OQ + off_b(32 * it + lr, 2 * ks + h)); Yo = MFMA32(sa, qb, Yo); }
                const float ei = __expf(ai);
                if (ph == 0) {
#pragma unroll
                    for (int r = 0; r < 16; ++r) Yd0[r] += Yo[r] * ei; }
                else {
#pragma unroll
                    for (int r = 0; r < 16; ++r) Yd1[r] += Yo[r] * ei; }
            }
#pragma unroll
            for (int g = 0; g < 4; ++g) { u32x2 yw;
                if (ph == 0) { yw.x = cvt_pk_bf16(Yd1[4 * g], Yd1[4 * g + 1]); yw.y = cvt_pk_bf16(Yd1[4 * g + 2], Yd1[4 * g + 3]); } else { yw.x = cvt_pk_bf16(Yd0[4 * g], Yd0[4 * g + 1]); yw.y = cvt_pk_bf16(Yd0[4 * g + 2], Yd0[4 * g + 3]); }
                *(LAS u32x2*)(L + OY + off_y(32 * it + lr, 4 * (1 - ph) + g) + 8 * h) = yw; }
            const float dl = __expf(sb[127]);
            const int st0 = (w == 0) ? 0 : (w == 1) ? 2 : (w == 2) ? 4 : (w == 3) ? 5 : (w == 5) ? 6 : -1, st1 = (w == 0) ? 1 : (w == 1) ? 3 : (w == 5) ? 7 : -1;
            if (st0 >= 0) {
                const int spt = st0 & 1, snt = st0 >> 1;
#pragma unroll
                for (int r = 0; r < 16; ++r) St0[r] *= dl;
#pragma unroll
                for (int k2 = 0; k2 < 4; ++k2) { const unsigned rb = 32 * k2 + 8 * h + tq_, cv = 4 * spt + 2 * blk + (tp_ >> 1), cb = 4 * snt + 2 * blk + (tp_ >> 1), o8 = 8 * (tp_ & 1);
                    bf16x8 fa0, fb0, fa1, fb1;
                    tr_read8(lbase + OVW + off_v(rb, cv) + o8, lbase + OVW + off_v(rb + 4, cv) + o8, lbase + OK + off_b(rb, cb) + o8, lbase + OK + off_b(rb + 4, cb) + o8,
                             lbase + OVW + off_v(rb + 16, cv) + o8, lbase + OVW + off_v(rb + 20, cv) + o8, lbase + OK + off_b(rb + 16, cb) + o8, lbase + OK + off_b(rb + 20, cb) + o8, fa0, fb0, fa1, fb1);
                    St0 = MFMA32(fa0, fb0, St0); St0 = MFMA32(fa1, fb1, St0); }
                if (st1 >= 0) {
                    const int spt1 = st1 & 1, snt1 = st1 >> 1;
#pragma unroll
                    for (int r = 0; r < 16; ++r) St1[r] *= dl;
#pragma unroll
                    for (int k2 = 0; k2 < 4; ++k2) { const unsigned rb = 32 * k2 + 8 * h + tq_, cv = 4 * spt1 + 2 * blk + (tp_ >> 1), cb = 4 * snt1 + 2 * blk + (tp_ >> 1), o8 = 8 * (tp_ & 1);
                        bf16x8 fa0, fb0, fa1, fb1;
                        tr_read8(lbase + OVW + off_v(rb, cv) + o8, lbase + OVW + off_v(rb + 4, cv) + o8, lbase + OK + off_b(rb, cb) + o8, lbase + OK + off_b(rb + 4, cb) + o8,
                                 lbase + OVW + off_v(rb + 16, cv) + o8, lbase + OVW + off_v(rb + 20, cv) + o8, lbase + OK + off_b(rb + 16, cb) + o8, lbase + OK + off_b(rb + 20, cb) + o8, fa0, fb0, fa1, fb1);
                        St1 = MFMA32(fa0, fb0, St1); St1 = MFMA32(fa1, fb1, St1); }
                }
            }
            if (c + 1 < SEQ / 128) SC_SMALL(c + 1);
            __syncthreads();
#pragma unroll
            for (int g = 0; g < 4; ++g) { LAS u32x2* yp = (LAS u32x2*)(L + OY + off_y(32 * it + lr, 4 * ph + g) + 8 * h); const u32x2 pv_ = *yp; u32x2 yw;
                if (ph == 0) { yw.x = cvt_pk_bf16(Yd0[4 * g] + bflo(pv_.x), Yd0[4 * g + 1] + bfhi(pv_.x)); yw.y = cvt_pk_bf16(Yd0[4 * g + 2] + bflo(pv_.y), Yd0[4 * g + 3] + bfhi(pv_.y)); }
                else { yw.x = cvt_pk_bf16(Yd1[4 * g] + bflo(pv_.x), Yd1[4 * g + 1] + bfhi(pv_.x)); yw.y = cvt_pk_bf16(Yd1[4 * g + 2] + bflo(pv_.y), Yd1[4 * g + 3] + bfhi(pv_.y)); }
                *yp = yw; }
            __syncthreads();
            SP_MARK(5);
            if (c + 1 < SEQ / 128) SC_DMA(c + 1);
            if (st0 >= 0) {
                const int spt = st0 & 1, snt = st0 >> 1;
#pragma unroll
                for (int r = 0; r < 16; ++r) { const unsigned pr = 32 * spt + (r & 3) + 8 * (r >> 2) + 4 * h, n = 32 * snt + lr; *(LAS bf16_t*)(L + OS + off_b(pr, n >> 3) + 2 * (n & 7)) = f2bf(St0[r]); }
                if (st1 >= 0) { const int spt1 = st1 & 1, snt1 = st1 >> 1;
#pragma unroll
                    for (int r = 0; r < 16; ++r) { const unsigned pr = 32 * spt1 + (r & 3) + 8 * (r >> 2) + 4 * h, n = 32 * snt1 + lr; *(LAS bf16_t*)(L + OS + off_b(pr, n >> 3) + 2 * (n & 7)) = f2bf(St1[r]); }
                }
            }
            {
                bf16_t* orow = optr + (row0 + (size_t)c * 128 + trow) * NPROJ + tpart * 16;
#pragma unroll
                for (int e = 0; e < 2; ++e) {
                    const u32x4 yv = *(const LAS u32x4*)(L + OY + off_y(trow, tpart * 2 + e));
                    u32x4 ov = yv;
                    if (is_ssd) { const u32x4 xv = *(const LAS u32x4*)(L + OV + off_v(trow, tpart * 2 + e)); const u32x4 zv = rz[e];
                        ov.x = cvt_pk_bf16((bflo(yv.x) + bflo(xv.x) * D_h) * fsilu(bflo(zv.x)), (bfhi(yv.x) + bfhi(xv.x) * D_h) * fsilu(bfhi(zv.x)));
                        ov.y = cvt_pk_bf16((bflo(yv.y) + bflo(xv.y) * D_h) * fsilu(bflo(zv.y)), (bfhi(yv.y) + bfhi(xv.y) * D_h) * fsilu(bfhi(zv.y)));
                        ov.z = cvt_pk_bf16((bflo(yv.z) + bflo(xv.z) * D_h) * fsilu(bflo(zv.z)), (bfhi(yv.z) + bfhi(xv.z) * D_h) * fsilu(bfhi(zv.z)));
                        ov.w = cvt_pk_bf16((bflo(yv.w) + bflo(xv.w) * D_h) * fsilu(bflo(zv.w)), (bfhi(yv.w) + bfhi(xv.w) * D_h) * fsilu(bfhi(zv.w))); }
                    *(u32x4*)(orow + e * 8) = ov;
                }
            }
            if (c + 1 < SEQ / 128) { SC_LOADZ(c + 1); }
            __syncthreads();
            SP_MARK(6);
            if (c + 1 < SEQ / 128) SC_STORE(c + 1);
            asm volatile("s_waitcnt vmcnt(0)" ::: "memory");
            __syncthreads();
            SP_MARK(7);
        }
#undef SC_LOAD
#undef SC_LOADZ
#undef SC_SMALL
#undef SC_STORE
    }
}

__device__ __forceinline__ void phase_gatenorm(const Params& p, const Frame& F) {
    const bf16_t* proj = WSP(bf16_t, WS_SLAB);
    bf16_t* ybuf = WSP(bf16_t, WS_SLAB);
    const float* nw = p.in[10];
    int row = F.bid * 8 + F.wave; const int stride = F.G * 8;
    u32x4 yc[4], gc[2], yn[4], gn[2];
#define GN_LOAD(r_, Y_, G_) do { const bf16_t* b_ = ybuf + (size_t)(r_) * NPROJ; _Pragma("unroll") for (int j = 0; j < 4; ++j) Y_[j] = *(const u32x4*)(b_ + j * 512 + F.lane * 8); \
        _Pragma("unroll") for (int j = 0; j < 2; ++j) G_[j] = __builtin_nontemporal_load((const u32x4*)(b_ + PC_G + j * 512 + F.lane * 8)); } while (0)
    if (row < T_TOK) GN_LOAD(row, yc, gc);
    for (; row < T_TOK; row += stride) {
        if (row + stride < T_TOK) GN_LOAD(row + stride, yn, gn);
        bf16_t* yr = ybuf + (size_t)row * NPROJ;
#pragma unroll
        for (int j = 0; j < 4; ++j) {
            const u32x4 w = yc[j];
            float x[8] = {bflo(w.x), bfhi(w.x), bflo(w.y), bfhi(w.y), bflo(w.z), bfhi(w.z), bflo(w.w), bfhi(w.w)};
            float ss = 0.f;
#pragma unroll
            for (int e = 0; e < 8; ++e) ss += x[e] * x[e];
            if (j < 2) { ss = wave_sum_u(ss); const float rs = rsqrtf(ss * (1.f / 512.f) + 1e-5f);
                const f32x4 w0 = *(const f32x4*)(nw + j * 512 + F.lane * 8), w1 = *(const f32x4*)(nw + j * 512 + F.lane * 8 + 4);
#pragma unroll
                for (int e = 0; e < 4; ++e) { x[e] *= rs * w0[e]; x[4 + e] *= rs * w1[e]; } }
            else {
                ss = dpp_sum16(ss); ss += __shfl_xor(ss, 16);
                const float rs = rsqrtf(ss * (1.f / 256.f) + 1e-6f);
                const u32x4 gw = gc[j - 2];
                const float g[8] = {bflo(gw.x), bfhi(gw.x), bflo(gw.y), bfhi(gw.y), bflo(gw.z), bfhi(gw.z), bflo(gw.w), bfhi(gw.w)};
#pragma unroll
                for (int e = 0; e < 8; ++e) x[e] *= rs * fsilu(g[e]); }
            u32x4 o; o.x = cvt_pk_bf16(x[0], x[1]); o.y = cvt_pk_bf16(x[2], x[3]); o.z = cvt_pk_bf16(x[4], x[5]); o.w = cvt_pk_bf16(x[6], x[7]);
            *(u32x4*)(yr + j * 512 + F.lane * 8) = o;
        }
#pragma unroll
        for (int j = 0; j < 4; ++j) yc[j] = yn[j];
        gc[0] = gn[0]; gc[1] = gn[1];
    }
#undef GN_LOAD
}

__device__ __forceinline__ void phase_moe_route(const Params& p, const Frame& F, int layer, const bf16_t* h, bf16_t* tbuf) {
    unsigned char* meta = F.ws + WS_META + (size_t)layer * META_STRIDE;
    int* tok_rank = (int*)(meta + MT_RANK); int* tok_bkt = (int*)(meta + MT_BKT); f32x2* tok_c = (f32x2*)(meta + MT_C);
    int* gcount = (int*)(F.ws + WS_CTL + CTL_CNT_OFF) + layer * 32;
    const float* bg = p.in[31] + layer * 4; const float* be = p.in[33] + layer * 16;
    LAS float* wl = (LAS float*)F.lds;
    LAS int* lcount = (LAS int*)(F.lds + 81920);
    LAS int* lbase = lcount + 32;
    LAS int* l_bkt = lbase + 32;
    LAS int* l_rank = l_bkt + 1024;
    LAS float* l_c = (LAS float*)(l_rank + 1024);
    LAS float* lgt = (LAS float*)(F.lds + 98816);
    __syncthreads();
    { const float* wrt = WSP(float, WS_RTW) + (size_t)layer * 20480;
        for (int idx = F.tid; idx < 20 * 1024 / 4; idx += NTHREADS) *(LAS f32x4*)(wl + idx * 4) = *(const f32x4*)(wrt + idx * 4); }
    if (F.tid < 32) lcount[F.tid] = 0;
    __syncthreads();
    const int TPB = (T_TOK + F.G - 1) / F.G, tok0 = F.bid * TPB;
    f32x4 wv[4]; row_load(p.in[2] + (size_t)layer * DM, F.lane, wv);
    f32x4 va[4], vb[4], na[4], nb[4];
    int hsel;
    { unsigned t0_ = 0u, t1_ = 1u; asm volatile("s_nop 1\n\tv_permlane32_swap_b32 %0, %1\n\ts_nop 1" : "+v"(t0_), "+v"(t1_)); hsel = (t0_ + t1_ >= 2u) ? 10 : 0; }
#define RT_LOAD(li_, A_, B_) do { const int ta_ = tok0 + (li_), tb_ = ta_ + 8; \
        if ((li_) < TPB && ta_ < T_TOK) row_load_bf_nt(h + (size_t)ta_ * DM, F.lane, A_); if ((li_) + 8 < TPB && tb_ < T_TOK) row_load_bf_nt(h + (size_t)tb_ * DM, F.lane, B_); } while (0)
    RT_LOAD(F.wave, va, vb);
    for (int li = F.wave; li < TPB; li += 16) {
        const int tok = tok0 + li; if (tok >= T_TOK) break;
        const bool hasb = (li + 8 < TPB) && (tok + 8 < T_TOK);
        RT_LOAD(li + 16, na, nb);
        const float rsa = row_rstd(va, 1e-6f), rsb = row_rstd(vb, 1e-6f);
#pragma unroll
        for (int j = 0; j < 4; ++j) { va[j] = va[j] * rsa * wv[j]; vb[j] = vb[j] * rsb * wv[j]; }
        row_store_bf16(tbuf + (size_t)tok * DM, F.lane, va);
        if (hasb) row_store_bf16(tbuf + (size_t)(tok + 8) * DM, F.lane, vb);
        LAS float* lga = lgt + li * 20; LAS float* lgb = lgt + (li + 8) * 20;
#pragma unroll
        for (int o = 0; o < 10; ++o) { f32x2 c0 = (f32x2){0.f, 0.f}, c1 = c0, d0 = c0, d1 = c0;
#pragma unroll
            for (int j = 0; j < 4; ++j) { const f32x4 w4 = *(const LAS f32x4*)(wl + o * 1024 + j * 256 + F.lane * 4), w5 = *(const LAS f32x4*)(wl + (o + 10) * 1024 + j * 256 + F.lane * 4);
                const f32x2 w4l = (f32x2){w4[0], w4[1]}, w4h = (f32x2){w4[2], w4[3]}, w5l = (f32x2){w5[0], w5[1]}, w5h = (f32x2){w5[2], w5[3]};
                const f32x2 al = (f32x2){va[j][0], va[j][1]}, ah = (f32x2){va[j][2], va[j][3]}, bl = (f32x2){vb[j][0], vb[j][1]}, bh = (f32x2){vb[j][2], vb[j][3]};
                c0 += al * w4l; c0 += ah * w4h; c1 += al * w5l; c1 += ah * w5h; d0 += bl * w4l; d0 += bh * w4h; d1 += bl * w5l; d1 += bh * w5h; }
            float a0 = c0[0] + c0[1], a1 = c1[0] + c1[1], b0 = d0[0] + d0[1], b1 = d1[0] + d1[1];
            asm volatile("s_nop 1\n\tv_permlane32_swap_b32 %0, %1\n\tv_permlane32_swap_b32 %2, %3\n\ts_nop 1" : "+v"(a0), "+v"(a1), "+v"(b0), "+v"(b1));
            float sa = dpp_sum16(a0 + a1), sb_ = dpp_sum16(b0 + b1);
            sa += __builtin_bit_cast(float, __builtin_amdgcn_update_dpp(0, __builtin_bit_cast(int, sa), 0x142, 0xA, 0xF, false));
            sb_ += __builtin_bit_cast(float, __builtin_amdgcn_update_dpp(0, __builtin_bit_cast(int, sb_), 0x142, 0xA, 0xF, false));
            if ((F.lane & 31) == 16) { lga[hsel + o] = sa; if (hasb) lgb[hsel + o] = sb_; }
            if (o & 1) __builtin_amdgcn_sched_barrier(0); }
#pragma unroll
        for (int j = 0; j < 4; ++j) { va[j] = na[j]; vb[j] = nb[j]; }
    }
#undef RT_LOAD
    __syncthreads();
    for (int li = F.tid; li < TPB; li += NTHREADS) {
        if (tok0 + li >= T_TOK) break;
        float lg[20];
#pragma unroll
        for (int o = 0; o < 20; ++o) lg[o] = lgt[li * 20 + o];
        float g0 = lg[0] + bg[0], g1 = lg[1] + bg[1], g2 = lg[2] + bg[2], g3 = lg[3] + bg[3];
        int gi = 0; float gm = g0; if (g1 > gm) { gm = g1; gi = 1; } if (g2 > gm) { gm = g2; gi = 2; } if (g3 > gm) { gm = g3; gi = 3; }
        const float gate = 1.f / (__expf(g0 - gm) + __expf(g1 - gm) + __expf(g2 - gm) + __expf(g3 - gm));
        float e0, e1, e2, e3;
        e0 = (gi == 0) ? lg[4] : (gi == 1) ? lg[8] : (gi == 2) ? lg[12] : lg[16];
        e1 = (gi == 0) ? lg[5] : (gi == 1) ? lg[9] : (gi == 2) ? lg[13] : lg[17];
        e2 = (gi == 0) ? lg[6] : (gi == 1) ? lg[10] : (gi == 2) ? lg[14] : lg[18];
        e3 = (gi == 0) ? lg[7] : (gi == 1) ? lg[11] : (gi == 2) ? lg[15] : lg[19];
        e0 += be[gi * 4 + 0]; e1 += be[gi * 4 + 1]; e2 += be[gi * 4 + 2]; e3 += be[gi * 4 + 3];
        int i1 = 0; float v1 = e0; if (e1 > v1) { v1 = e1; i1 = 1; } if (e2 > v1) { v1 = e2; i1 = 2; } if (e3 > v1) { v1 = e3; i1 = 3; }
        int i2 = -1; float v2 = -3.0e38f;
        if (i1 != 0 && e0 > v2) { v2 = e0; i2 = 0; } if (i1 != 1 && e1 > v2) { v2 = e1; i2 = 1; } if (i1 != 2 && e2 > v2) { v2 = e2; i2 = 2; } if (i1 != 3 && e3 > v2) { v2 = e3; i2 = 3; }
        const float w1 = gate / (1.f + __expf(v2 - v1)), w2 = gate - w1;
        const int lo = i1 < i2 ? i1 : i2, hi = i1 < i2 ? i2 : i1; const float clo = i1 < i2 ? w1 : w2, chi = i1 < i2 ? w2 : w1;
        const int pr = (lo == 0) ? hi - 1 : (lo == 1) ? hi + 1 : 5;
        const int bk = gi * 6 + pr;
        l_bkt[li] = bk; l_c[li * 2] = clo; l_c[li * 2 + 1] = chi;
        l_rank[li] = __hip_atomic_fetch_add((int*)(lcount + bk), 1, __ATOMIC_RELAXED, __HIP_MEMORY_SCOPE_WORKGROUP);
    }
    __syncthreads();
    if (F.tid < 24) lbase[F.tid] = __hip_atomic_fetch_add(gcount + F.tid, lcount[F.tid], __ATOMIC_RELAXED, __HIP_MEMORY_SCOPE_AGENT);
    __syncthreads();
    for (int li = F.tid; li < TPB; li += NTHREADS) { const int tok = tok0 + li; if (tok < T_TOK) { const int bk = l_bkt[li]; tok_bkt[tok] = bk; tok_rank[tok] = lbase[bk] + l_rank[li]; tok_c[tok] = (f32x2){l_c[li * 2], l_c[li * 2 + 1]}; } }
}
__device__ __forceinline__ void phase_moe_slots(const Params& p, const Frame& F, int layer) {
    unsigned char* meta = F.ws + WS_META + (size_t)layer * META_STRIDE;
    const int* tok_rank = (const int*)(meta + MT_RANK); const int* tok_bkt = (const int*)(meta + MT_BKT); const f32x2* tok_c = (const f32x2*)(meta + MT_C);
    int* slot_tok = (int*)(meta + MT_STOK); f32x2* slot_c = (f32x2*)(meta + MT_SC); int* tile_tab = (int*)(meta + MT_TILE);
    int* gcount = (int*)(F.ws + WS_CTL + CTL_CNT_OFF) + layer * 32;
    LAS int* cnt = (LAS int*)F.lds; LAS int* start = cnt + 32;
    __syncthreads();
    if (F.tid < 24) cnt[F.tid] = __hip_atomic_load(gcount + F.tid, __ATOMIC_RELAXED, __HIP_MEMORY_SCOPE_AGENT);
    __syncthreads();
    if (F.tid == 0) { int a = 0; for (int b = 0; b < 24; ++b) { start[b] = a; a += (cnt[b] + 255) >> 8; } start[24] = a; }
    __syncthreads();
    for (int tok = F.bid * NTHREADS + F.tid; tok < T_TOK; tok += F.G * NTHREADS) { const int bk = tok_bkt[tok]; const int slot = start[bk] * 256 + tok_rank[tok]; slot_tok[slot] = tok; slot_c[slot] = tok_c[tok]; }
    for (int b = F.bid; b < 24; b += F.G) { const int s0 = start[b] * 256 + cnt[b], s1 = start[b + 1] * 256;
        for (int s = s0 + F.tid; s < s1; s += NTHREADS) { slot_tok[s] = -1; slot_c[s] = (f32x2){0.f, 0.f}; } }
    if (F.bid == 0) { if (F.tid == 0) tile_tab[0] = start[24];
        for (int m = F.tid; m < 288; m += NTHREADS) { int bk = 23; for (int b = 0; b < 24; ++b) if (m >= start[b] && m < start[b + 1]) bk = b; tile_tab[64 + m] = bk; } }
}

__device__ __forceinline__ void phase_mix5(const Params& p, const Frame& F, const bf16_t* h, bf16_t* ou, bf16_t* oup, bf16_t* o0, bf16_t* o1, bf16_t* o2) {
    const float* mu = p.in[12];
    f32x4 wv[4], m0[4], m1[4], m2[4];
    row_load(p.in[1] + DM, F.lane, wv); row_load(mu, F.lane, m0); row_load(mu + 2 * DM, F.lane, m1); row_load(mu + 3 * DM, F.lane, m2);
    for (int run = F.bid * 8 + F.wave; run < T_TOK / 32; run += F.G * 8) {
        const int t0 = run * 32;
        f32x4 up[4];
        if ((t0 & (SEQ - 1)) == 0) {
#pragma unroll
            for (int j = 0; j < 4; ++j) up[j] = (f32x4){0.f, 0.f, 0.f, 0.f};
        } else { row_load_bf(h + (size_t)(t0 - 1) * DM, F.lane, up); const float rs = row_rstd(up, 1e-6f);
#pragma unroll
            for (int j = 0; j < 4; ++j) up[j] = up[j] * rs * wv[j]; }
        f32x4 u[4], un[4]; row_load_bf(h + (size_t)t0 * DM, F.lane, u);
        for (int tt = 0; tt < 32; ++tt) {
            if (tt + 1 < 32) row_load_bf(h + (size_t)(t0 + tt + 1) * DM, F.lane, un);
            const float rs = row_rstd(u, 1e-6f);
            f32x4 a[4], b[4], c[4];
#pragma unroll
            for (int j = 0; j < 4; ++j) { u[j] = u[j] * rs * wv[j]; const f32x4 xx = up[j] - u[j]; a[j] = u[j] + xx * m0[j]; b[j] = u[j] + xx * m1[j]; c[j] = u[j] + xx * m2[j]; }
            const size_t ro = (size_t)(t0 + tt) * DM;
            row_store_bf16(ou + ro, F.lane, u); row_store_bf16(oup + ro, F.lane, up);
            row_store_bf16(o0 + ro, F.lane, a); row_store_bf16(o1 + ro, F.lane, b); row_store_bf16(o2 + ro, F.lane, c);
#pragma unroll
            for (int j = 0; j < 4; ++j) { up[j] = u[j]; u[j] = un[j]; }
        }
    }
}

typedef __bf16 bf16x2v __attribute__((ext_vector_type(2)));
__device__ __forceinline__ unsigned pkc(float lo, float hi) { f32x2 t = {lo, hi}; bf16x2v r = __builtin_convertvector(t, bf16x2v); return __builtin_bit_cast(unsigned, r); }
__device__ __forceinline__ unsigned off_r(unsigned row, unsigned ch) { return row * 128u + 16u * (ch ^ ((row >> 1) & 7u)); }
__device__ __forceinline__ unsigned off_m(unsigned row, unsigned ch) { return row * 64u + 16u * (ch ^ ((0u - (row >> 2)) & 3u)); }
#define MFMA16(a, b, c) __builtin_amdgcn_mfma_f32_16x16x32_bf16((a), (b), (c), 0, 0, 0)
__device__ __forceinline__ void swap32(float& a, float& b) { asm volatile("s_nop 1\n\tv_permlane32_swap_b32 %0, %1\n\ts_nop 1" : "+v"(a), "+v"(b)); }
__device__ __forceinline__ float half_sum(float x, bool hf) {
    x = dpp_sum16(x);
    x += __builtin_bit_cast(float, __builtin_amdgcn_update_dpp(0, __builtin_bit_cast(int, x), 0x142, 0xA, 0xF, false));
    const float lo = __builtin_bit_cast(float, __builtin_amdgcn_readlane(__builtin_bit_cast(int, x), 31)), hi = __builtin_bit_cast(float, __builtin_amdgcn_readlane(__builtin_bit_cast(int, x), 63));
    return hf ? hi : lo;
}
__device__ __forceinline__ void phase_rwkv(const Params& p, const Frame& F, bf16_t* rbuf, const bf16_t* kbuf, const bf16_t* vbuf, const bf16_t* ebuf, const bf16_t* abuf, const bf16_t* gbuf) {
    constexpr unsigned ORA = 0, OLB = 16384, OMS = 32768, OMU = 49152, OMY = 53248, OAB = 57344, OAK = 61440, OVT = 65536, OGC = 73728, OYS = 74752, OVF = 91136, OGG = 107520, OBON = 123904;
    LAS unsigned char* L = F.lds;
    const float* k_k = p.in[25]; const float* k_a = p.in[26]; const float* r_k = p.in[27]; const float* lnw = p.in[28]; const float* lnb = p.in[29];
    const int lane0 = F.lane, w = F.wave, pc = w >> 1, th = w & 1;
    for (int unit = F.bid; unit < 256; unit += F.G) {
        const int b = unit >> 4, hd = unit & 15;
        const int gc2 = hd * 64 + 2 * (lane0 & 31);
        const f32x2 kkw = *(const f32x2*)(k_k + gc2), kaw = *(const f32x2*)(k_a + gc2), rkw = *(const f32x2*)(r_k + gc2), lw = *(const f32x2*)(lnw + gc2), lb = *(const f32x2*)(lnb + gc2);
        int lane = lane0;
        f32x4 St[4];
#pragma unroll
        for (int mt = 0; mt < 4; ++mt) St[mt] = (f32x4){0.f, 0.f, 0.f, 0.f};
        unsigned pr[4], pk[4], pv[4], pe[4], pa[4], pg[4], pe0[4];
#define RW_LOAD(t0_) do { const size_t ub_ = ((size_t)b * SEQ + (t0_) + 16 * pc + 8 * th) * DM + hd * 64, ub0_ = ((size_t)b * SEQ + (t0_) + 16 * pc) * DM + hd * 64;     \
            const bf16_t* r_ = rbuf + ub_; const bf16_t* k_ = kbuf + ub_; const bf16_t* v_ = vbuf + ub_; const bf16_t* e_ = ebuf + ub_; const bf16_t* a_ = abuf + ub_; const bf16_t* g_ = gbuf + ub_; const bf16_t* e0_ = ebuf + ub0_; \
            _Pragma("unroll") for (int it = 0; it < 4; ++it) { const unsigned lo_ = (unsigned)((4 * (lane >> 5) + it) * DM + 2 * (lane & 31)); \
            pr[it] = __builtin_nontemporal_load((const unsigned*)(r_ + lo_)); pk[it] = __builtin_nontemporal_load((const unsigned*)(k_ + lo_)); pv[it] = __builtin_nontemporal_load((const unsigned*)(v_ + lo_)); pe[it] = __builtin_nontemporal_load((const unsigned*)(e_ + lo_)); pa[it] = __builtin_nontemporal_load((const unsigned*)(a_ + lo_)); pg[it] = __builtin_nontemporal_load((const unsigned*)(g_ + lo_)); pe0[it] = *(const unsigned*)(e0_ + lo_); } } while (0)
        RW_LOAD(0);
        SP_DECL;
        for (int t0 = 0; t0 < SEQ; t0 += 64) {
            __syncthreads();
            SP_MARK(4);
            asm volatile("" : "+v"(lane));
            const unsigned l15 = lane & 15, q = (unsigned)lane >> 4, cp = lane & 31;
            const bool hf = lane >= 32;
            const unsigned pj = 32u * (cp >> 4) + 8u * ((cp & 7) >> 1) + 2u * (cp & 1) + ((cp & 8) ? 4u : 0u);
            {
                float pl0[4], pl1[4], ls0 = 0.f, ls1 = 0.f, f0 = 0.f, f1 = 0.f;
#pragma unroll
                for (int it = 0; it < 4; ++it) { ls0 += bflo(pe[it]); ls1 += bfhi(pe[it]); pl0[it] = ls0; pl1[it] = ls1; f0 += bflo(pe0[it]); f1 += bfhi(pe0[it]); }
                float xa0 = 0.f, xb0 = ls0, xa1 = 0.f, xb1 = ls1; swap32(xa0, xb0); swap32(xa1, xb1);
                float ya0 = f0, yb0 = f0, ya1 = f1, yb1 = f1; swap32(ya0, yb0); swap32(ya1, yb1);
                const float base0 = xa0 + (th ? f0 + (hf ? ya0 : yb0) : 0.f), base1 = xa1 + (th ? f1 + (hf ? ya1 : yb1) : 0.f);
                float ms0[8], ms1[8], vt0[4], vt1[4];
                LAS unsigned char* ra = L + ORA + pc * 4096; LAS unsigned char* lbp = L + OLB + pc * 4096;
#pragma unroll
                for (int it = 0; it < 4; ++it) {
                    const int t = 8 * th + 4 * (int)hf + it, tb = 16 * pc + t;
                    const float r0 = bflo(pr[it]), r1 = bfhi(pr[it]), k0 = bflo(pk[it]), k1 = bfhi(pk[it]), a0 = bflo(pa[it]), a1 = bfhi(pa[it]);
                    const float kv0 = k0 * kkw[0], kv1 = k1 * kkw[1]; const float ss = half_sum(kv0 * kv0 + kv1 * kv1, hf); const float rn = rsqrtf(fmaxf(ss, 1e-24f));
                    const float kk0 = kv0 * rn, kk1 = kv1 * rn;
                    const float kp0 = k0 * (1.f + (a0 - 1.f) * kaw[0]), kp1 = k1 * (1.f + (a1 - 1.f) * kaw[1]);
                    const float bon = half_sum(r0 * kp0 * rkw[0] + r1 * kp1 * rkw[1], hf);
                    const float lp0 = -(base0 + (it ? pl0[it ? it - 1 : 0] : 0.f)), lp1 = -(base1 + (it ? pl1[it ? it - 1 : 0] : 0.f)), lc0 = -(base0 + pl0[it]), lc1 = -(base1 + pl1[it]);
                    const float ea0 = __expf(lp0), ea1 = __expf(lp1), eb0 = __expf(lc0), eb1 = __expf(lc1), ei0 = __expf(-lc0), ei1 = __expf(-lc1);
                    const float bt0 = kk0 * a0 * ei0, bt1 = kk1 * a1 * ei1, kt0 = kp0 * ei0, kt1 = kp1 * ei1;
                    *(LAS unsigned*)(ra + off_r(t, pj >> 3) + 2 * (pj & 7)) = pkc(-kk0 * ea0, -kk1 * ea1); *(LAS unsigned*)(ra + off_r(16 + t, pj >> 3) + 2 * (pj & 7)) = pkc(r0 * eb0, r1 * eb1);
                    *(LAS unsigned*)(lbp + off_r(t, pj >> 3) + 2 * (pj & 7)) = pkc(bt0, bt1); *(LAS unsigned*)(lbp + off_r(16 + t, pj >> 3) + 2 * (pj & 7)) = pkc(kt0, kt1);
                    ms0[it] = bt0; ms0[4 + it] = kt0; ms1[it] = bt1; ms1[4 + it] = kt1; vt0[it] = bflo(pv[it]); vt1[it] = bfhi(pv[it]);
                    *(LAS f32x2*)(L + OVF + (tb * 64 + 2 * cp) * 4) = (f32x2){bflo(pv[it]), bfhi(pv[it])}; *(LAS f32x2*)(L + OGG + (tb * 64 + 2 * cp) * 4) = (f32x2){bflo(pg[it]), bfhi(pg[it])};
                    if (cp == 0) *(LAS float*)(L + OBON + tb * 4) = bon;
                    if (it == 3 && th && hf) *(LAS f32x2*)(L + OGC + pc * 256 + 2 * cp * 4) = (f32x2){eb0, eb1};
                }
                { u32x4 m0, m1; m0.x = pkc(ms0[0], ms0[1]); m0.y = pkc(ms0[2], ms0[3]); m0.z = pkc(ms0[4], ms0[5]); m0.w = pkc(ms0[6], ms0[7]); m1.x = pkc(ms1[0], ms1[1]); m1.y = pkc(ms1[2], ms1[3]); m1.z = pkc(ms1[4], ms1[5]); m1.w = pkc(ms1[6], ms1[7]);
                  *(LAS u32x4*)(L + OMS + pc * 4096 + off_m(2 * cp, 2 * th + (unsigned)hf)) = m0; *(LAS u32x4*)(L + OMS + pc * 4096 + off_m(2 * cp + 1, 2 * th + (unsigned)hf)) = m1;
                  u32x2 w0, w1; w0.x = pkc(vt0[0], vt0[1]); w0.y = pkc(vt0[2], vt0[3]); w1.x = pkc(vt1[0], vt1[1]); w1.y = pkc(vt1[2], vt1[3]);
                  *(LAS u32x2*)(L + OVT + pc * 2048 + (2 * cp) * 32 + (8 * th + 4 * (unsigned)hf) * 2) = w0; *(LAS u32x2*)(L + OVT + pc * 2048 + (2 * cp + 1) * 32 + (8 * th + 4 * (unsigned)hf) * 2) = w1; }
            }
            if (t0 + 64 < SEQ) RW_LOAD(t0 + 64);
            __syncthreads();
            SP_MARK(1);
            if (w < 4) {
                {
                    const int c = w;
                    f32x4 g00 = (f32x4){0.f, 0.f, 0.f, 0.f}, g01 = g00, g10 = g00, g11 = g00;
#pragma unroll
                    for (int ks = 0; ks < 2; ++ks) {
                        const bf16x8 a0 = *(const LAS bf16x8*)(L + OLB + c * 4096 + off_r(l15, 4 * ks + q)), a1 = *(const LAS bf16x8*)(L + OLB + c * 4096 + off_r(16 + l15, 4 * ks + q));
                        const bf16x8 b0 = *(const LAS bf16x8*)(L + ORA + c * 4096 + off_r(l15, 4 * ks + q)), b1 = *(const LAS bf16x8*)(L + ORA + c * 4096 + off_r(16 + l15, 4 * ks + q));
                        g00 = MFMA16(a0, b0, g00); g01 = MFMA16(a0, b1, g01); g10 = MFMA16(a1, b0, g10); g11 = MFMA16(a1, b1, g11);
                    }
                    f32x4 ab, ak; float br[4], kr[4];
#pragma unroll
                    for (int g = 0; g < 4; ++g) { const bool lt = (4 * q + g) < l15, le = (4 * q + g) <= l15; ab[g] = lt ? g00[g] : 0.f; ak[g] = lt ? g10[g] : 0.f; br[g] = le ? g01[g] : 0.f; kr[g] = le ? g11[g] : 0.f; }
                    *(LAS f32x4*)(L + OAB + c * 1024 + (l15 * 16 + 4 * q) * 4) = ab; *(LAS f32x4*)(L + OAK + c * 1024 + (l15 * 16 + 4 * q) * 4) = ak;
                    u32x4 yw; yw.x = pkc(br[0], br[1]); yw.y = pkc(br[2], br[3]); yw.z = pkc(kr[0], kr[1]); yw.w = pkc(kr[2], kr[3]);
                    *(LAS u32x4*)(L + OMY + c * 1024 + off_m(l15, q)) = yw;
                    if (lane < 32) {
                        float row[16];
#pragma unroll
                        for (int t = 0; t < 16; ++t) {
                            const LAS f32x4* abr = (const LAS f32x4*)(L + OAB + c * 1024 + t * 64);
                            const f32x4 x0 = abr[0], x1 = abr[1], x2 = abr[2], x3 = abr[3];
                            const float abv[16] = {x0[0], x0[1], x0[2], x0[3], x1[0], x1[1], x1[2], x1[3], x2[0], x2[1], x2[2], x2[3], x3[0], x3[1], x3[2], x3[3]};
                            float acc1 = (lane < 16) ? ((lane == t) ? 1.f : 0.f) : *(const LAS float*)(L + OAK + c * 1024 + (t * 16 + (lane & 15)) * 4);
#pragma unroll
                            for (int s_ = 0; s_ < t; ++s_) acc1 += row[s_] * abv[s_];
                            row[t] = acc1;
                        }
                        const unsigned pp = (lane < 16) ? (8u * (lane >> 2) + (lane & 3)) : (8u * ((lane & 15) >> 2) + 4u + (lane & 3));
#pragma unroll
                        for (int t = 0; t < 16; ++t) *(LAS bf16_t*)(L + OMU + c * 1024 + off_m(t, pp >> 3) + 2 * (pp & 7)) = (bf16_t)(pkc(row[t], 0.f) & 0xffffu);
                    }
                }
            }
            __syncthreads();
            SP_MARK(2);
            if (w < 4) {
#pragma unroll 1
                for (int c = 0; c < 4; ++c) {
                    bf16x8 Sb0, Sb1;
                    { u32x4 t0_; t0_.x = pkc(St[0][0], St[0][1]); t0_.y = pkc(St[0][2], St[0][3]); t0_.z = pkc(St[1][0], St[1][1]); t0_.w = pkc(St[1][2], St[1][3]); Sb0 = __builtin_bit_cast(bf16x8, t0_);
                      u32x4 t1_; t1_.x = pkc(St[2][0], St[2][1]); t1_.y = pkc(St[2][2], St[2][3]); t1_.z = pkc(St[3][0], St[3][1]); t1_.w = pkc(St[3][2], St[3][3]); Sb1 = __builtin_bit_cast(bf16x8, t1_); }
                    f32x4 Za = (f32x4){0.f, 0.f, 0.f, 0.f}, Zr = Za;
                    Za = MFMA16(*(const LAS bf16x8*)(L + ORA + c * 4096 + off_r(l15, q)), Sb0, Za); Za = MFMA16(*(const LAS bf16x8*)(L + ORA + c * 4096 + off_r(l15, 4 + q)), Sb1, Za);
                    Zr = MFMA16(*(const LAS bf16x8*)(L + ORA + c * 4096 + off_r(16 + l15, q)), Sb0, Zr); Zr = MFMA16(*(const LAS bf16x8*)(L + ORA + c * 4096 + off_r(16 + l15, 4 + q)), Sb1, Zr);
                    const u32x2 vt = *(const LAS u32x2*)(L + OVT + c * 2048 + (16 * w + l15) * 32 + 8 * q);
                    u32x4 bu; bu.x = pkc(Za[0], Za[1]); bu.y = pkc(Za[2], Za[3]); bu.z = vt.x; bu.w = vt.y;
                    f32x4 U = (f32x4){0.f, 0.f, 0.f, 0.f};
                    U = MFMA16(*(const LAS bf16x8*)(L + OMU + c * 1024 + off_m(l15, q)), __builtin_bit_cast(bf16x8, bu), U);
                    u32x4 by; by.x = pkc(U[0], U[1]); by.y = pkc(U[2], U[3]); by.z = vt.x; by.w = vt.y;
                    const bf16x8 By = __builtin_bit_cast(bf16x8, by);
                    const f32x4 Yt = MFMA16(*(const LAS bf16x8*)(L + OMY + c * 1024 + off_m(l15, q)), By, Zr);
#pragma unroll
                    for (int mt = 0; mt < 4; ++mt) { St[mt] = MFMA16(*(const LAS bf16x8*)(L + OMS + c * 4096 + off_m(16 * mt + l15, q)), By, St[mt]);
                        const f32x4 gc = *(const LAS f32x4*)(L + OGC + c * 256 + (16 * mt + 4 * q) * 4); St[mt] = St[mt] * gc; }
#pragma unroll
                    for (int g = 0; g < 4; ++g) *(LAS float*)(L + OYS + ((16 * c + 4 * q + g) * 64 + 16 * w + l15) * 4) = Yt[g];
                }
            }
            __syncthreads();
            SP_MARK(3);
            bf16_t* ob_ = rbuf + ((size_t)b * SEQ + t0 + w) * DM + hd * 64;
#pragma unroll
            for (int iq = 0; iq < 4; ++iq) { const int tq = 2 * iq + (int)hf, t = w + 8 * tq; const int li = t * 64 + 2 * (int)cp;
                const f32x2 y = *(const LAS f32x2*)(L + OYS + li * 4); const float mean = half_sum(y[0] + y[1], hf) * (1.f / 64.f); const float d0 = y[0] - mean, d1 = y[1] - mean;
                const float rs = rsqrtf(half_sum(d0 * d0 + d1 * d1, hf) * (1.f / 64.f) + 64e-5f);
                const f32x2 vv = *(const LAS f32x2*)(L + OVF + li * 4), gg = *(const LAS f32x2*)(L + OGG + li * 4); const float bo = *(const LAS float*)(L + OBON + t * 4);
                const float o0 = (d0 * rs * lw[0] + lb[0] + bo * vv[0]) * gg[0], o1 = (d1 * rs * lw[1] + lb[1] + bo * vv[1]) * gg[1];
                *(unsigned*)(ob_ + (unsigned)(8 * tq * DM + 2 * (int)cp)) = pkc(o0, o1); }
        }
#undef RW_LOAD
    }
}

__global__ void __launch_bounds__(NTHREADS, 2) mega_fwd(Params p) {
    extern __shared__ __attribute__((aligned(16))) unsigned char lds_raw[];
    Frame F;
    F.lds = (LAS unsigned char*)lds_raw;
    F.tid = threadIdx.x; F.lane = F.tid & 63; F.wave = __builtin_amdgcn_readfirstlane(F.tid >> 6); F.G = gridDim.x; F.bid = blockIdx.x;
    F.out = p.out; F.ws = p.ws;
    volatile LAS unsigned* misc = (volatile LAS unsigned*)(F.lds + LDS_MISC);
    if (F.tid < 32) misc[F.tid] = 0u;
    __syncthreads();
    const int lo = p.ph_lo, hi = p.ph_hi;
    XcdBarrier bar; bar.bar = (unsigned*)(F.ws + WS_CTL); bar.x = 0; bar.st = misc;
    if (hi - lo > 1) bar = xcd_barrier_post((unsigned*)(F.ws + WS_CTL), misc);
#define IN(k) (lo <= (k) && (k) < hi)
#if PROBE_MASK
    unsigned long long pr_t0 = 0ull, pr_acc = 0ull;
#define PSTART(k) do { if ((PROBE_MASK >> (k)) & 1u) pr_t0 = wall_clock64(); } while (0)
#define PEND(k) do { if ((PROBE_MASK >> (k)) & 1u) pr_acc += wall_clock64() - pr_t0; } while (0)
#else
#define PSTART(k) do {} while (0)
#define PEND(k) do {} while (0)
#endif
#if PROBE_SUB == 11
#define SEAM(k) do { if (IN(k) && IN((k) + 1)) { unsigned long long b0_ = 0ull; if (F.tid == 0) b0_ = wall_clock64(); xcd_barrier(bar); if (F.tid == 0) *(LAS unsigned long long*)(F.lds + LDS_MISC + 64) += wall_clock64() - b0_; } PEND(k); PSTART((k) + 1); } while (0)
#else
#define SEAM(k) do { if (IN(k) && IN((k) + 1)) xcd_barrier(bar); PEND(k); PSTART((k) + 1); } while (0)
#endif
    bf16_t* wb = WSP(bf16_t, WS_WB);
    bf16_t* S0 = WSP(bf16_t, WS_SLAB); bf16_t* S2 = WSP(bf16_t, WS_SLAB + 2 * SLAB); bf16_t* S3 = WSP(bf16_t, WS_SLAB + 3 * SLAB); bf16_t* S4 = WSP(bf16_t, WS_SLAB + 4 * SLAB); bf16_t* S5 = WSP(bf16_t, WS_SLAB + 5 * SLAB);
    bf16_t* EH = WSP(bf16_t, WS_E);
    bf16_t* O0 = (bf16_t*)F.out; bf16_t* O1 = O0 + (size_t)T_TOK * DM;
    bf16_t* hres = (bf16_t*)F.out;
    bf16_t* S1 = WSP(bf16_t, WS_SLAB + 1 * SLAB);
    const int vcu = (F.G % 8 == 0) ? F.bid : F.bid;

    PSTART(0);
    if (IN(0)) { phase_prep(p, F, 0, PT_WIN, true); phase_rmsnorm<true>(p, F, p.in[0], p.in[1], O0); } SEAM(0);
    if (IN(2)) { DenseP<EK_INPROJ> P{}; P.pid = 2; P.v0 = (const float*)(F.ws + WS_ROPE); P.K = 1024; P.lda = 1024; P.ldb = 1024; P.nM = 256; P.nN = NPROJ / 256; P.nprob = 1; P.G = F.G; P.c = vcu; P.A = O0; P.a_stride = 0; P.B = wb + WB_WIN / 2; P.b_stride = 0;
        P.O = S0; P.o_stride = 0; P.ldc = NPROJ; gemm_phase(F.lds, P); } SEAM(2);
    if (IN(3)) { phase_conv(p, F); } SEAM(3);
    if (IN(4)) { phase_scan0(p, F); } SEAM(4);
    if (IN(5)) { phase_prep(p, F, PT_WIN, PT_WOUT, false); phase_gatenorm(p, F); } SEAM(5);
    if (IN(6)) { DenseP<EK_F32RES> P{}; P.pid = 6; P.K = 2048; P.lda = NPROJ; P.ldb = 2048; P.nM = 256; P.nN = 4; P.nprob = 1; P.G = F.G; P.c = vcu; P.A = S0; P.B = wb + WB_WOUT / 2; P.resf = p.in[0]; P.resb = nullptr; P.Ob = hres; P.ldc = 1024; gemm_phase(F.lds, P); } SEAM(6);
#define MOE_LAYER(L, k0) \
    if (IN(k0)) { phase_prep(p, F, PT_L2 + (L) * 4096, PT_L2 + (L) * 4096 + 4096, false); phase_prep(p, F, PT_W13 + (L) * 2048, PT_W13 + (L) * 2048 + 2048, false); phase_moe_route(p, F, L, hres, S2); } SEAM(k0); \
    if (IN(k0 + 1)) { phase_moe_slots(p, F, L); } SEAM(k0 + 1); \
    if (IN(k0 + 2)) { unsigned char* meta = F.ws + WS_META + (size_t)(L) * META_STRIDE; Moe1P P{}; P.pid = (k0) + 2; P.K = 1024; P.lda = 1024; P.ldb = 1024; P.G = F.G; P.c = vcu; \
        P.ntiles = __builtin_amdgcn_readfirstlane(ld_vec_i32((const int*)(meta + MT_TILE))); P.A = S2; P.W13 = wb + WB_W13 / 2 + (size_t)(L) * 16 * 1048576; P.H = S3; \
        P.slot_tok = (const int*)(meta + MT_STOK); P.slot_c = (const float*)(meta + MT_SC); P.tile_bkt = (const int*)(meta + MT_TILE) + 64; gemm_phase(F.lds, P); } SEAM(k0 + 2); \
    if (IN(k0 + 3)) { unsigned char* meta = F.ws + WS_META + (size_t)(L) * META_STRIDE; Moe2P P{}; P.pid = (k0) + 3; P.K = 1024; P.lda = 1024; P.ldb = 512; P.G = F.G; P.c = vcu; \
        P.ntiles = __builtin_amdgcn_readfirstlane(ld_vec_i32((const int*)(meta + MT_TILE))); P.H = S3; P.W2 = wb + WB_W2 / 2 + (size_t)(L) * 16 * 524288; P.hsrc = hres; P.hdst = ((L) == 1) ? S0 : hres; \
        P.slot_tok = (const int*)(meta + MT_STOK); P.tile_bkt = (const int*)(meta + MT_TILE) + 64; gemm_phase(F.lds, P); } SEAM(k0 + 3);
    MOE_LAYER(0, 7)
    if (IN(11)) { phase_prep(p, F, PT_WOUT, PT_L2, false); phase_mix5(p, F, hres, S0, S1, S2, S3, S4); } SEAM(11);
    if (IN(12)) { DenseP<EK_LORA1> P{}; P.pid = 12; P.K = 2048; P.lda = 1024; P.ldb = 2048; P.nM = 256; P.nN = 2; P.nprob = 1; P.G = F.G; P.c = vcu; P.A = S0; P.a_split = 16; P.a_jump = (long)((const char*)S1 - (const char*)S0) - 16 * (BK * 2);
        P.B = wb + WB_L1 / 2; P.O = EH; P.ldc = 512; gemm_phase(F.lds, P); } SEAM(12);
    if (IN(14)) { DenseP<EK_BF16> P{}; P.pid = 14; P.K = 1024; P.lda = 1024; P.ldb = 1024; P.nM = 256; P.nN = 4; P.nprob = 3; P.G = F.G; P.c = vcu; P.ldc = 1024; P.A = S2; P.a_stride = (size_t)T_TOK * DM; P.B = wb + WB_WR / 2; P.b_stride = 1048576;
        P.O = S5; P.Oalt1 = S0; P.Oalt2 = S1; gemm_phase(F.lds, P); } SEAM(14);
    if (IN(15)) { DenseP<EK_LORA2> P{}; P.pid = 15; P.K = 256; P.lda = 512; P.ldb = 256; P.nM = 256; P.nN = 4; P.nprob = 3; P.G = F.G; P.c = vcu; P.A = EH; P.Aalt1 = EH; P.Aalt2 = EH + 128; P.B = wb + WB_L2 / 2; P.b_stride = 262144;
        P.O = S2; P.o_stride = (size_t)T_TOK * DM; P.ldc = 1024; P.v0 = p.in[17]; P.v1 = p.in[20]; gemm_phase(F.lds, P); } SEAM(15);
    if (IN(16)) { phase_rwkv(p, F, S5, S0, S1, S2, S3, S4); } SEAM(16);
    if (IN(17)) { DenseP<EK_F32RES> P{}; P.pid = 17; P.K = 1024; P.lda = 1024; P.ldb = 1024; P.nM = 256; P.nN = 4; P.nprob = 1; P.G = F.G; P.c = vcu; P.A = S5; P.B = wb + WB_WO / 2; P.resf = nullptr; P.resb = hres; P.Ob = hres; P.ldc = 1024; gemm_phase(F.lds, P); } SEAM(17);
    MOE_LAYER(1, 18)
    if (IN(22)) { phase_rmsnorm<false, true>(p, F, S0, p.in[3], F.out); }
#if PROBE_SUB
    if (F.bid == 0 && F.tid == 0) { const unsigned long long d_ = *(LAS unsigned long long*)(F.lds + LDS_MISC + 64); const unsigned long long t = wall_clock64(); while (wall_clock64() - t < d_) __builtin_amdgcn_s_sleep(8); }
#endif
#if PROBE_MASK
    PEND(22);
    if (F.bid == 0 && F.tid == 0) { const unsigned long long t = wall_clock64(); while (wall_clock64() - t < pr_acc) __builtin_amdgcn_s_sleep(8); }
#endif
}

extern "C" void kernel_launch(void* const* d_in, const int* in_sizes, int n_in, void* d_out, int out_size, void* d_ws, size_t ws_size, hipStream_t stream) {
    static int grid = 0;
    if (grid == 0) {
        if (n_in != 37 || out_size != T_TOK * DM || ws_size < WS_END) { fprintf(stderr, "kernel_launch: unexpected shapes (n_in %d out %d ws %zu)\n", n_in, out_size, ws_size); grid = -1; return; }
        int dev = 0, cus = 0, per_cu = 0;
        if (hipGetDevice(&dev) != hipSuccess || hipDeviceGetAttribute(&cus, hipDeviceAttributeMultiprocessorCount, dev) != hipSuccess) { grid = -1; return; }
        if (hipFuncSetAttribute((const void*)mega_fwd, hipFuncAttributeMaxDynamicSharedMemorySize, LDS_BYTES) != hipSuccess) { fprintf(stderr, "kernel_launch: hipFuncSetAttribute failed\n"); grid = -1; return; }
        if (hipOccupancyMaxActiveBlocksPerMultiprocessor(&per_cu, (const void*)mega_fwd, NTHREADS, LDS_BYTES) != hipSuccess || per_cu < 1) fprintf(stderr, "kernel_launch: occupancy query says %d\n", per_cu);
        (void)hipGetLastError();
        grid = cus;
        if (grid < 128 || grid > 512) { fprintf(stderr, "kernel_launch: built for 128..512 CUs (the MoE router keeps <= 512 tokens per workgroup in LDS); got %d\n", grid); grid = -1; return; }
    }
    if (grid < 0) return;
    (void)in_sizes;
    hipMemsetAsync((char*)d_ws + WS_CTL, 0, CTL_ZERO_BYTES, stream);
    Params p{};
    for (int i = 0; i < 37; ++i) p.in[i] = (const float*)d_in[i];
    p.out = (float*)d_out; p.ws = (unsigned char*)d_ws;
#if MK_PER_PHASE
    for (int k = 0; k < NPHASE; ++k) { p.ph_lo = k; p.ph_hi = k + 1; hipLaunchKernelGGL(mega_fwd, dim3(grid), dim3(NTHREADS), LDS_BYTES, stream, p); }
#else
    p.ph_lo = 0; p.ph_hi = NPHASE; hipLaunchKernelGGL(mega_fwd, dim3(grid), dim3(NTHREADS), LDS_BYTES, stream, p);
#endif
}
```

```cpp
#include <hip/hip_runtime.h>
#include <stdint.h>
#include <stdio.h>

#ifndef MK_PER_PHASE
#define MK_PER_PHASE 0
#endif

#ifndef PROBE_MASK
#define PROBE_MASK 0u
#endif
#ifndef PROBE_PID
#define PROBE_PID -1
#endif
#ifndef PROBE_SUB
#define PROBE_SUB 0
#endif
#define LAS __attribute__((address_space(3)))
typedef unsigned short bf16_t;
typedef short bf16x8 __attribute__((ext_vector_type(8)));
typedef float f32x4 __attribute__((ext_vector_type(4)));
typedef float f32x2 __attribute__((ext_vector_type(2)));
typedef unsigned u32x4 __attribute__((ext_vector_type(4)));
typedef unsigned u32x2 __attribute__((ext_vector_type(2)));

constexpr int T_TOK = 65536, DM = 1024, SEQ = 4096;
constexpr int NPROJ = 5888;
constexpr int PC_Z = 0, PC_XBC = 1024, PC_Q = 2560, PC_K = 3072, PC_V = 3584, PC_G = 4608, PC_DT = 5632;
constexpr int NTHREADS = 512;
constexpr int LDS_BYTES = 147456;
constexpr int LDS_MISC = LDS_BYTES - 256;
constexpr int NSLOT = T_TOK + 24 * 256;
constexpr int NPHASE = 23;
constexpr int PT_WIN = 1472, PT_WOUT = PT_WIN + 512, PT_RW = PT_WOUT + 1024, PT_L1 = PT_RW + 256, PT_L2 = PT_L1 + 192, PT_W13 = PT_L2 + 8192, PT_W2 = PT_W13 + 4096;
#if PROBE_SUB
#define SP_DECL unsigned long long sp_t_ = wall_clock64()
#define SP_MARK(id_end) do { if (F.tid == 0) { const unsigned long long n_ = wall_clock64(); if ((id_end) == PROBE_SUB) *(LAS unsigned long long*)(F.lds + LDS_MISC + 64) += n_ - sp_t_; sp_t_ = n_; } } while (0)
#else
#define SP_DECL do {} while (0)
#define SP_MARK(id_end) do {} while (0)
#endif

constexpr size_t MiB = 1024 * 1024;
constexpr size_t WS_CTL = 0;
constexpr size_t CTL_ZERO_BYTES = 16384;
constexpr size_t CTL_CNT_OFF = 14336;
constexpr size_t WS_META = 64 * 1024;
constexpr size_t META_STRIDE = 2 * MiB - 32 * 1024;
constexpr size_t MT_RANK = 0, MT_BKT = 262144, MT_C = 524288, MT_STOK = 1048576, MT_SC = 1048576 + 294912, MT_TILE = 1048576 + 294912 + 589824;
constexpr size_t WS_ROPE = 4 * MiB;
constexpr size_t WS_WB = 6 * MiB;
constexpr size_t WB_WIN = 0, WB_WOUT = WB_WIN + (size_t)NPROJ * 1024 * 2, WB_WR = WB_WOUT + (size_t)1024 * 2048 * 2, WB_WK = WB_WR + 2 * MiB, WB_WV = WB_WK + 2 * MiB, WB_WO = WB_WV + 2 * MiB,
                 WB_L1 = WB_WO + 2 * MiB  , WB_L2 = WB_L1 + 2 * MiB  , WB_W13 = WB_L2 + 3 * 512 * 1024  ,
                 WB_W2 = WB_W13 + (size_t)32 * 2 * MiB  , WB_END = WB_W2 + (size_t)32 * MiB;
constexpr size_t WS_SLAB = 130 * MiB;
constexpr size_t SLAB = 128 * MiB;
constexpr size_t WS_E = WS_SLAB + 6 * SLAB;
constexpr size_t WS_END = WS_E + 96 * MiB;
constexpr size_t WS_RTW = WS_WB + WB_END;
static_assert(WS_RTW + 2 * 20 * 1024 * 4 <= WS_SLAB, "weights overflow");
static_assert(WS_END <= 1024 * MiB, "workspace overflow");

struct Params {
    const float* in[37];
    float* out;
    unsigned char* ws;
    int ph_lo, ph_hi;
};

__device__ __forceinline__ float bf2f(bf16_t v) { return __uint_as_float(((unsigned)v) << 16); }
__device__ __forceinline__ float bflo(unsigned w) { return __uint_as_float(w << 16); }
__device__ __forceinline__ float bfhi(unsigned w) { return __uint_as_float(w & 0xffff0000u); }
__device__ __forceinline__ unsigned cvt_pk_bf16(float lo, float hi) { unsigned r; asm volatile("v_cvt_pk_bf16_f32 %0, %1, %2" : "=v"(r) : "v"(lo), "v"(hi)); return r; }
__device__ __forceinline__ bf16_t f2bf(float f) { return (bf16_t)(cvt_pk_bf16(f, 0.f) & 0xffffu); }
__device__ __forceinline__ float wave_sum(float v) {
#pragma unroll
    for (int o = 32; o >= 1; o >>= 1) v += __shfl_xor(v, o);
    return v;
}
__device__ __forceinline__ float dpp_sum16(float x) {
    x += __builtin_bit_cast(float, __builtin_amdgcn_update_dpp(0, __builtin_bit_cast(int, x), 0xB1, 0xF, 0xF, true));
    x += __builtin_bit_cast(float, __builtin_amdgcn_update_dpp(0, __builtin_bit_cast(int, x), 0x4E, 0xF, 0xF, true));
    x += __builtin_bit_cast(float, __builtin_amdgcn_update_dpp(0, __builtin_bit_cast(int, x), 0x141, 0xF, 0xF, true));
    x += __builtin_bit_cast(float, __builtin_amdgcn_update_dpp(0, __builtin_bit_cast(int, x), 0x140, 0xF, 0xF, true));
    return x;
}
__device__ __forceinline__ float wave_sum_u(float x) {
    x = dpp_sum16(x);
    x += __builtin_bit_cast(float, __builtin_amdgcn_update_dpp(0, __builtin_bit_cast(int, x), 0x142, 0xA, 0xF, false));
    x += __builtin_bit_cast(float, __builtin_amdgcn_update_dpp(0, __builtin_bit_cast(int, x), 0x143, 0xC, 0xF, false));
    return __builtin_bit_cast(float, __builtin_amdgcn_readlane(__builtin_bit_cast(int, x), 63));
}
__device__ __forceinline__ float fsilu(float x) { return x * __builtin_amdgcn_rcpf(1.f + __expf(-x)); }
__device__ __forceinline__ float fsigmoid(float x) { return __builtin_amdgcn_rcpf(1.f + __expf(-x)); }
__device__ __forceinline__ float fsoftplus(float x) { return x > 20.f ? x : log1pf(__expf(x)); }
__device__ __forceinline__ float ftanh(float x) { const float xc = fminf(fmaxf(x, -15.f), 15.f); const float e = __expf(2.f * xc); return (e - 1.f) * __builtin_amdgcn_rcpf(e + 1.f); }
__device__ __forceinline__ int ld_vec_i32(const int* p) { int r; asm volatile("global_load_dword %0, %1, off\n\ts_waitcnt vmcnt(0)" : "=&v"(r) : "v"(p) : "memory"); return r; }

#define XB_TMO      128
#define XB_XCNT(j)  (256  + 64 * (j))
#define XB_XSUB(j)  (1280 + 64 * (j))
#define XB_XGEN(j)  (2304 + 64 * (j))
#define XB_TOP      3328
#define XB_TOPGEN   3392
#define XCD_BAR_WORDS 3456
#define XB_SPIN_CAP (1u << 24)
__device__ __forceinline__ unsigned xb_ld(unsigned* p)              { return __hip_atomic_load(p, __ATOMIC_RELAXED, __HIP_MEMORY_SCOPE_AGENT); }
__device__ __forceinline__ unsigned xb_add(unsigned* p, unsigned v) { return __hip_atomic_fetch_add(p, v, __ATOMIC_RELAXED, __HIP_MEMORY_SCOPE_AGENT); }
__device__ __forceinline__ unsigned xb_xcc_id() { return (unsigned)__builtin_amdgcn_s_getreg((3 << 11) | 20) & 0xFu; }
#define XB_SPIN(cond, bar) do { unsigned _sp = 0; while (cond) { __builtin_amdgcn_s_sleep(1); \
    if ((++_sp & 255u) == 0u) { if (xb_ld(&(bar)[XB_TMO])) break; if (_sp > XB_SPIN_CAP) { atomicAdd(&(bar)[XB_TMO], 1u); break; } } } } while (0)
struct XcdBarrier { unsigned* bar; unsigned x; volatile LAS unsigned* st; };
__device__ __forceinline__ XcdBarrier xcd_barrier_post(unsigned* bar, volatile LAS unsigned* st) {
    XcdBarrier b; b.bar = bar; b.x = xb_xcc_id(); b.st = st;
    if (threadIdx.x == 0) (void)xb_add(&bar[XB_XCNT(b.x)], 1u);
    return b;
}
__device__ __forceinline__ void xcd_barrier_complete(unsigned* bar, unsigned x, unsigned& nloc, unsigned& nx) {
    const unsigned G = gridDim.x * gridDim.y * gridDim.z;
    unsigned sum, cnt, mine, sp = 0u;
    for (;;) {
        sum = 0u; cnt = 0u; mine = 0u;
#pragma unroll
        for (unsigned j = 0; j < 16; ++j) { const unsigned c = xb_ld(&bar[XB_XCNT(j)]); sum += c; cnt += (c > 0u) ? 1u : 0u; mine = (j == x) ? c : mine; }
        if (sum == G) break;
        __builtin_amdgcn_s_sleep(1);
        if ((++sp & 255u) == 0u) { if (xb_ld(&bar[XB_TMO])) break; if (sp > XB_SPIN_CAP) { atomicAdd(&bar[XB_TMO], 1u); break; } }
    }
    nloc = mine > 0u ? mine : 1u; nx = cnt > 0u ? cnt : 1u;
}
__device__ __forceinline__ void xcd_barrier(const XcdBarrier& b) {
    asm volatile("s_waitcnt vmcnt(0)" ::: "memory");
    __syncthreads();
    if (threadIdx.x == 0) {
        unsigned* bar = b.bar;
        __builtin_amdgcn_s_waitcnt(0);
        unsigned nloc = b.st[0], nx = b.st[1];
        if (nloc == 0u) { xcd_barrier_complete(bar, b.x, nloc, nx); b.st[0] = nloc; b.st[1] = nx; }
        const unsigned old = xb_add(&bar[XB_XSUB(b.x)], 1u);
        const unsigned gen = old / nloc;
        if (old + 1u == (gen + 1u) * nloc) {
            __builtin_amdgcn_fence(__ATOMIC_RELEASE, "agent");
            asm volatile("s_waitcnt vmcnt(0)" ::: "memory");
            const unsigned og = xb_add(&bar[XB_TOP], 1u);
            const unsigned tg = og / nx;
            if (og + 1u == (tg + 1u) * nx) xb_add(&bar[XB_TOPGEN], 1u);
            else XB_SPIN(xb_ld(&bar[XB_TOPGEN]) == tg, bar);
            __builtin_amdgcn_fence(__ATOMIC_ACQUIRE, "agent");
            xb_add(&bar[XB_XGEN(b.x)], 1u);
            asm volatile("s_waitcnt vmcnt(0)" ::: "memory");
        } else {
            XB_SPIN(xb_ld(&bar[XB_XGEN(b.x)]) == gen, bar);
            __builtin_amdgcn_fence(__ATOMIC_ACQUIRE, "agent");
            asm volatile("s_waitcnt vmcnt(0)" ::: "memory");
        }
    }
    __syncthreads();
}

constexpr int BM = 256, BK = 64, HALF = 128, HTB = HALF * BK * 2, STAGE_BYTES = 8 * HTB;
__device__ __forceinline__ int lds_byte(int r, int c) { const int st = (r >> 4) * 2 + (c >> 5), rr = r & 15, cc = c & 31, ob = rr * 64 + cc * 2; return st * 1024 + (ob ^ (((ob >> 9) & 1) << 5)); }
__device__ __forceinline__ void stage_rc(int b, int& R, int& C) { const int st = b / 1024, sb = b % 1024, swz = sb ^ (((sb >> 9) & 1) << 5); R = (st >> 1) * 16 + swz / 64; C = (st & 1) * 32 + (swz % 64) / 2; }
__device__ __forceinline__ int perm32(int rho) { const int n = rho >> 4, i = rho & 15; return 8 * (i >> 2) + 4 * n + (i & 3); }
struct Unit { int pm, pn, prob; };
__device__ __forceinline__ void tile_order(int L, int nM, int nN, int& pm, int& pn) {
    const int nwg = nM * nN; int wgid = L;
    { const int q = nwg / 8, r = nwg % 8, xcd = wgid % 8, off = wgid / 8; wgid = (xcd < r ? xcd * (q + 1) : r * (q + 1) + (xcd - r) * q) + off; }
    const int nig = 8 * nN, gid = wgid / nig, fm = gid * 8, gsz = (nM - fm) < 8 ? (nM - fm) : 8;
    pm = fm + ((wgid % nig) % gsz); pn = (wgid % nig) / gsz;
}

template <class P>
__device__ __forceinline__ void gemm_phase(LAS unsigned char* lds, const P& S) {
    const int tid = threadIdx.x, wid = __builtin_amdgcn_readfirstlane(tid >> 6), lane = tid & 63, wr = wid >> 2, wc = wid & 3, fr = lane & 15, fq = lane >> 4;
    const int K = S.K, nt = K / BK, lda = S.lda, ldb = S.ldb;
    int RA[2], CA[2]; unsigned voffB[2], vAc[2][2], vAn[2][2];
#pragma unroll
    for (int i = 0; i < 2; ++i) { int R, C; stage_rc(tid * 16 + i * 8192, R, C); RA[i] = R; CA[i] = C; const int Rb = P::PERM ? ((R & ~31) + perm32(R & 31)) : R;
        voffB[i] = (unsigned)(Rb * ldb + C) * 2u;
#pragma unroll
        for (int h = 0; h < 2; ++h) { vAc[h][i] = (unsigned)((h * HALF + R) * lda + C) * 2u; vAn[h][i] = vAc[h][i]; } }
    const size_t kstep = (size_t)(BK * 2);
    const size_t hstepB = (size_t)HALF * ldb * 2;
    const unsigned ldsw = (unsigned)wid * 1024u;
    const int aoff = lds_byte(wr * 64 + fr, fq * 8), boff = lds_byte(wc * 32 + fr, fq * 8);
#define PG8_SA(b, h) (((b) * 2 + (h)) * HTB)
#define PG8_SB(b, h) ((4 + (b) * 2 + (h)) * HTB)
#define PG8_STAGE2(bufoff, gbase, v0, v1) do { \
        __builtin_amdgcn_global_load_lds((const unsigned*)((const char*)(gbase) + (v0)), (LAS unsigned*)(lds + (bufoff) + ldsw), 16, 0, 0); \
        __builtin_amdgcn_global_load_lds((const unsigned*)((const char*)(gbase) + (v1)), (LAS unsigned*)(lds + (bufoff) + ldsw + 8192), 16, 0, 0); } while (0)
#define PG8_LDA(dst, b, h) do { _Pragma("unroll") for (int m = 0; m < 4; ++m) _Pragma("unroll") for (int k = 0; k < 2; ++k) dst[m][k] = *(const LAS bf16x8*)(lds + PG8_SA(b, h) + aoff + m * 2048 + k * 1024); } while (0)
#define PG8_LDB(dst, b, h) do { _Pragma("unroll") for (int n = 0; n < 2; ++n) _Pragma("unroll") for (int k = 0; k < 2; ++k) dst[n][k] = *(const LAS bf16x8*)(lds + PG8_SB(b, h) + boff + n * 2048 + k * 1024); } while (0)
#define PG8_MMA(ai, bj, At, Bt) do { __builtin_amdgcn_s_setprio(1); _Pragma("unroll") for (int m = 0; m < 4; ++m) _Pragma("unroll") for (int n = 0; n < 2; ++n) _Pragma("unroll") for (int k = 0; k < 2; ++k) \
        acc[ai][bj][m][n] = __builtin_amdgcn_mfma_f32_16x16x32_bf16(Bt[n][k], At[m][k], acc[ai][bj][m][n], 0, 0, 0); __builtin_amdgcn_s_setprio(0); } while (0)
#define PG8_WAIT_V(n) asm volatile("s_waitcnt vmcnt(" #n ")" ::: "memory")
#define PG8_WAIT_L(n) asm volatile("s_waitcnt lgkmcnt(" #n ")" ::: "memory")
#define PG8_BAR __builtin_amdgcn_s_barrier()
#define LDS_BAR() asm volatile("s_waitcnt lgkmcnt(0)\n\ts_barrier" ::: "memory")
#define PG8_SCHED __builtin_amdgcn_sched_barrier(0)
    Unit cur, nxt; int ui = 0;
    if (!S.next(0, cur)) return;
    struct { int tid; LAS unsigned char* lds; } F; F.tid = tid; F.lds = lds; (void)F;
    SP_DECL;
    if constexpr (P::GATHER) {
#pragma unroll
        for (int h = 0; h < 2; ++h)
#pragma unroll
            for (int i = 0; i < 2; ++i) vAc[h][i] = S.a_voff(cur, h * HALF + RA[i], CA[i]);
    }
    float zf; asm volatile("v_mov_b32 %0, 0" : "=v"(zf));
    f32x4 acc[2][2][4][2];
#pragma unroll
    for (int a = 0; a < 2; ++a)
#pragma unroll
        for (int b = 0; b < 2; ++b)
#pragma unroll
            for (int m = 0; m < 4; ++m)
#pragma unroll
                for (int n = 0; n < 2; ++n) acc[a][b][m][n] = (f32x4){zf, zf, zf, zf};
    bf16x8 At[4][2], B0[2][2], B1[2][2];
    const char* cA = S.a_ptr(cur);
    {
        const char* b0 = S.b_ptr(cur, 0); const char* b1 = S.b_ptr(cur, 1);
        const char* cA0 = cA + S.a_kadj(0);
        PG8_STAGE2(PG8_SB(0, 0), b0, voffB[0], voffB[1]); PG8_STAGE2(PG8_SA(0, 0), cA0, vAc[0][0], vAc[0][1]); PG8_STAGE2(PG8_SB(0, 1), b0 + hstepB, voffB[0], voffB[1]); PG8_STAGE2(PG8_SA(0, 1), cA0, vAc[1][0], vAc[1][1]);
        if (wr == 1) PG8_BAR;
        PG8_WAIT_V(4); PG8_BAR;
        PG8_STAGE2(PG8_SB(1, 0), b1, voffB[0], voffB[1]); PG8_STAGE2(PG8_SA(1, 0), cA + kstep + S.a_kadj(1), vAc[0][0], vAc[0][1]); PG8_STAGE2(PG8_SB(1, 1), b1 + hstepB, voffB[0], voffB[1]);
        PG8_WAIT_V(6); PG8_BAR;
    }
    for (;;) {
        const bool has_next = S.next(ui + 1, nxt);
        if (!has_next) nxt = cur;
        if constexpr (P::GATHER) {
            if (has_next) {
#pragma unroll
                for (int h = 0; h < 2; ++h)
#pragma unroll
                    for (int i = 0; i < 2; ++i) vAn[h][i] = S.a_voff(nxt, h * HALF + RA[i], CA[i]);
            }
        }
        const char* nA = S.a_ptr(nxt);
        for (int t = 0; t < nt; t += 2) {
            const bool last = (t == nt - 2);
            const char* a1 = cA + (size_t)(t + 1) * kstep + S.a_kadj(t + 1);
            const char* a2 = last ? nA + S.a_kadj(0) : cA + (size_t)(t + 2) * kstep + S.a_kadj(t + 2);
            const char* a3 = last ? nA + kstep + S.a_kadj(1) : cA + (size_t)(t + 3) * kstep + S.a_kadj(t + 3);
            const char* b2 = last ? S.b_ptr(nxt, 0) : S.b_ptr(cur, t + 2);
            const char* b3 = last ? S.b_ptr(nxt, 1) : S.b_ptr(cur, t + 3);
            unsigned s00 = vAc[0][0], s01 = vAc[0][1], s10 = vAc[1][0], s11 = vAc[1][1];
            if constexpr (P::GATHER) { if (last) { s00 = vAn[0][0]; s01 = vAn[0][1]; s10 = vAn[1][0]; s11 = vAn[1][1]; } }
            PG8_LDB(B0, 0, 0); PG8_SCHED; PG8_LDA(At, 0, 0); PG8_STAGE2(PG8_SA(1, 1), a1, vAc[1][0], vAc[1][1]);
            PG8_WAIT_L(8); PG8_BAR; PG8_WAIT_L(0); PG8_MMA(0, 0, At, B0); PG8_BAR; PG8_SCHED;
            PG8_LDB(B1, 0, 1); PG8_STAGE2(PG8_SB(0, 0), b2, voffB[0], voffB[1]);
            PG8_BAR; PG8_WAIT_L(0); PG8_MMA(0, 1, At, B1); PG8_BAR;
            PG8_LDA(At, 0, 1); PG8_STAGE2(PG8_SA(0, 0), a2, s00, s01);
            PG8_BAR; PG8_WAIT_L(0); PG8_MMA(1, 0, At, B0); PG8_BAR; PG8_SCHED;
            PG8_STAGE2(PG8_SB(0, 1), b2 + hstepB, voffB[0], voffB[1]);
            PG8_WAIT_V(6); PG8_BAR; PG8_MMA(1, 1, At, B1); PG8_BAR;
            PG8_LDB(B0, 1, 0); PG8_SCHED; PG8_LDA(At, 1, 0); PG8_STAGE2(PG8_SA(0, 1), a2, s10, s11);
            PG8_WAIT_L(8); PG8_BAR; PG8_WAIT_L(0); PG8_MMA(0, 0, At, B0); PG8_BAR; PG8_SCHED;
            PG8_LDB(B1, 1, 1); PG8_STAGE2(PG8_SB(1, 0), b3, voffB[0], voffB[1]);
            PG8_BAR; PG8_WAIT_L(0); PG8_MMA(0, 1, At, B1); PG8_BAR;
            PG8_LDA(At, 1, 1); PG8_STAGE2(PG8_SA(1, 0), a3, s00, s01);
            PG8_BAR; PG8_WAIT_L(0); PG8_MMA(1, 0, At, B0); PG8_BAR; PG8_SCHED;
            PG8_STAGE2(PG8_SB(1, 1), b3 + hstepB, voffB[0], voffB[1]);
            PG8_WAIT_V(6); PG8_BAR; PG8_MMA(1, 1, At, B1); PG8_BAR;
        }
        SP_MARK((PROBE_PID < 0 || S.pid == PROBE_PID) ? 10 : -1);
        S.epi(acc, cur, wr, wc, fr, fq);
        SP_MARK((PROBE_PID < 0 || S.pid == PROBE_PID) ? 9 : -1);
        if (!has_next) break;
#pragma unroll
        for (int a = 0; a < 2; ++a)
#pragma unroll
            for (int b = 0; b < 2; ++b)
#pragma unroll
                for (int m = 0; m < 4; ++m)
#pragma unroll
                    for (int n = 0; n < 2; ++n) acc[a][b][m][n] = (f32x4){zf, zf, zf, zf};
        cur = nxt; cA = nA; ++ui;
        if constexpr (P::GATHER) {
#pragma unroll
            for (int h = 0; h < 2; ++h)
#pragma unroll
                for (int i = 0; i < 2; ++i) vAc[h][i] = vAn[h][i];
        }
    }
    PG8_WAIT_V(0);
    if (wr == 0) PG8_BAR;
    PG8_BAR;
#undef PG8_SA
#undef PG8_SB
#undef PG8_STAGE2
#undef PG8_LDA
#undef PG8_LDB
#undef PG8_MMA
#undef PG8_WAIT_V
#undef PG8_WAIT_L
#undef PG8_BAR
#undef PG8_SCHED
}

enum { EK_BF16 = 0, EK_LORA1 = 1, EK_LORA2 = 2, EK_F32RES = 3, EK_INPROJ = 4 };
template <int KIND>
struct DenseP {
    static constexpr bool PERM = true, GATHER = false;
    int K, lda, ldb, nM, nN, nprob, G, c, pid;
    const bf16_t* A; size_t a_stride;
    const bf16_t* Aalt1; const bf16_t* Aalt2;
    int a_split; long a_jump;
    const bf16_t* B; size_t b_stride;
    bf16_t* O; size_t o_stride; int ldc;
    bf16_t* Oalt1; bf16_t* Oalt2;
    const float* resf; const bf16_t* resb; bf16_t* Ob;
    const float* v0; const float* v1;
    __device__ __forceinline__ bool next(int i, Unit& u) const {
        const long L = (long)i * G + c; const int per = nM * nN; if (L >= (long)per * nprob) return false;
        u.prob = (int)(L / per); tile_order((int)(L % per), nM, nN, u.pm, u.pn); return true;
    }
    __device__ __forceinline__ const char* a_ptr(const Unit& u) const { const bf16_t* a0 = Aalt1 ? ((u.prob == 0) ? A : (u.prob == 1) ? Aalt1 : Aalt2) : A + (size_t)u.prob * a_stride; return (const char*)(a0 + (size_t)u.pm * BM * lda); }
    __device__ __forceinline__ long a_kadj(int kt) const { return (a_split > 0 && kt >= a_split) ? a_jump : 0; }
    __device__ __forceinline__ const char* b_ptr(const Unit& u, int kt) const { return (const char*)(B + (size_t)u.prob * b_stride + (size_t)u.pn * BM * ldb) + (size_t)kt * (BK * 2); }
    __device__ __forceinline__ unsigned a_voff(const Unit&, int, int) const { return 0u; }
    __device__ __forceinline__ void epi(const f32x4 (&acc)[2][2][4][2], const Unit& u, int wr, int wc, int fr, int fq) const {
        const int row0 = u.pm * BM + wr * 64 + fr;
        if constexpr (KIND == EK_F32RES) {
            const int col0 = u.pn * BM + wc * 32 + 8 * fq;
#pragma unroll
            for (int ai = 0; ai < 2; ++ai)
#pragma unroll
                for (int mp = 0; mp < 2; ++mp) {
                    f32x4 r0[2][2], r1[2][2];
#pragma unroll
                    for (int mm = 0; mm < 2; ++mm) { const size_t ro = (size_t)(row0 + ai * HALF + (mp * 2 + mm) * 16) * ldc + col0;
#pragma unroll
                        for (int bj = 0; bj < 2; ++bj) {
                            if (resf) { r0[mm][bj] = __builtin_nontemporal_load((const f32x4*)(resf + ro + bj * HALF)); r1[mm][bj] = __builtin_nontemporal_load((const f32x4*)(resf + ro + bj * HALF + 4)); }
                            else { const u32x4 rw = *(const u32x4*)(resb + ro + bj * HALF); r0[mm][bj] = (f32x4){bflo(rw.x), bfhi(rw.x), bflo(rw.y), bfhi(rw.y)}; r1[mm][bj] = (f32x4){bflo(rw.z), bfhi(rw.z), bflo(rw.w), bfhi(rw.w)}; } } }
#pragma unroll
                    for (int mm = 0; mm < 2; ++mm) { const size_t ro = (size_t)(row0 + ai * HALF + (mp * 2 + mm) * 16) * ldc + col0;
#pragma unroll
                        for (int bj = 0; bj < 2; ++bj) { const f32x4 x0 = acc[ai][bj][mp * 2 + mm][0] + r0[mm][bj], x1 = acc[ai][bj][mp * 2 + mm][1] + r1[mm][bj];
                            u32x4 w; w.x = cvt_pk_bf16(x0[0], x0[1]); w.y = cvt_pk_bf16(x0[2], x0[3]); w.z = cvt_pk_bf16(x1[0], x1[1]); w.w = cvt_pk_bf16(x1[2], x1[3]);
                            *(u32x4*)(Ob + ro + bj * HALF) = w; } }
                }
        } else {
            const int col0 = u.pn * BM + wc * 32 + 8 * fq;
            bf16_t* base = Oalt1 ? ((u.prob == 0) ? O : (u.prob == 1) ? Oalt1 : Oalt2) : O + (size_t)u.prob * o_stride;
            f32x4 bv[2][2];
#pragma unroll
            for (int bj = 0; bj < 2; ++bj)
#pragma unroll
                for (int n = 0; n < 2; ++n) {
                    if constexpr (KIND == EK_LORA2) { bv[bj][n] = (u.prob == 0) ? *(const f32x4*)(v0 + col0 + bj * HALF + 4 * n) : (u.prob == 1) ? *(const f32x4*)(v1 + col0 + bj * HALF + 4 * n) : (f32x4){0.f, 0.f, 0.f, 0.f}; }
                    else bv[bj][n] = (f32x4){0.f, 0.f, 0.f, 0.f};
                }
#pragma unroll
            for (int ai = 0; ai < 2; ++ai)
#pragma unroll
                for (int m = 0; m < 4; ++m) { bf16_t* rowp = base + (size_t)(row0 + ai * HALF + m * 16) * ldc + col0;
#pragma unroll
                    for (int bj = 0; bj < 2; ++bj) { f32x4 x0 = acc[ai][bj][m][0] + bv[bj][0], x1 = acc[ai][bj][m][1] + bv[bj][1];
                        if constexpr (KIND == EK_LORA1) {
                            const int g0 = u.pn * BM + bj * HALF + wc * 32; const float kx = (g0 < 64) ? 2.f : 1.f;
#pragma unroll
                            for (int j = 0; j < 4; ++j) { const float s0 = fsigmoid(kx * x0[j]), s1 = fsigmoid(kx * x1[j]);
                                x0[j] = (g0 < 64) ? 2.f * s0 - 1.f : (g0 >= 128) ? s0 : x0[j]; x1[j] = (g0 < 64) ? 2.f * s1 - 1.f : (g0 >= 128) ? s1 : x1[j]; } }
                        if constexpr (KIND == EK_LORA2) {
                            const float sc = (u.prob == 0) ? 0.6065306597126334f : 1.f;
#pragma unroll
                            for (int j = 0; j < 4; ++j) { const float s0 = sc * fsigmoid(x0[j]), s1 = sc * fsigmoid(x1[j]); x0[j] = (u.prob == 2) ? x0[j] : s0; x1[j] = (u.prob == 2) ? x1[j] : s1; } }
                        if constexpr (KIND == EK_INPROJ) {
                            if (u.pn >= PC_Q / 256 && u.pn < PC_V / 256) { const int pos = (row0 + ai * HALF + m * 16) & (SEQ - 1); const float sc = (u.pn >= PC_K / 256) ? 0.08838834764831845f : 1.f;
                                const f32x4 cs0 = *(const f32x4*)(v0 + ((size_t)pos * 64 + wc * 16 + 4 * fq) * 2), cs1 = *(const f32x4*)(v0 + ((size_t)pos * 64 + wc * 16 + 4 * fq + 2) * 2);
                                const f32x4 a = x0, b = x1;
                                x0[0] = (a[0] * cs0[0] - a[1] * cs0[1]) * sc; x0[1] = (a[0] * cs0[1] + a[1] * cs0[0]) * sc; x0[2] = (a[2] * cs0[2] - a[3] * cs0[3]) * sc; x0[3] = (a[2] * cs0[3] + a[3] * cs0[2]) * sc;
                                x1[0] = (b[0] * cs1[0] - b[1] * cs1[1]) * sc; x1[1] = (b[0] * cs1[1] + b[1] * cs1[0]) * sc; x1[2] = (b[2] * cs1[2] - b[3] * cs1[3]) * sc; x1[3] = (b[2] * cs1[3] + b[3] * cs1[2]) * sc; } }
                        u32x4 w; w.x = cvt_pk_bf16(x0[0], x0[1]); w.y = cvt_pk_bf16(x0[2], x0[3]); w.z = cvt_pk_bf16(x1[0], x1[1]); w.w = cvt_pk_bf16(x1[2], x1[3]);
                        *(u32x4*)(rowp + bj * HALF) = w; } }
        }
    }
};

__device__ __forceinline__ void pair_lohi(int pr, int& lo, int& hi) { lo = (pr < 3) ? 0 : (pr < 5 ? 1 : 2); hi = (pr < 3) ? pr + 1 : (pr < 5 ? pr - 1 : 3); }

struct Moe1P {
    static constexpr bool PERM = true, GATHER = true;
    int K, lda, ldb, G, c, ntiles, pid;
    const bf16_t* A; const bf16_t* W13;
    bf16_t* H; const int* slot_tok; const float* slot_c; const int* tile_bkt;
    __device__ __forceinline__ bool next(int i, Unit& u) const {
        const int m = (c >> 3) + (G >> 3) * i; if ((G & 7) != 0 || m >= ntiles) { if ((G & 7) == 0) return false; const long L = (long)i * G + c; if (L >= (long)ntiles * 8) return false; u.pm = (int)(L >> 3); u.pn = (int)(L & 7); u.prob = __builtin_amdgcn_readfirstlane(ld_vec_i32(tile_bkt + u.pm)); return true; }
        u.pm = m; u.pn = c & 7; u.prob = __builtin_amdgcn_readfirstlane(ld_vec_i32(tile_bkt + u.pm)); return true;
    }
    __device__ __forceinline__ const char* a_ptr(const Unit&) const { return (const char*)A; }
    __device__ __forceinline__ long a_kadj(int) const { return 0; }
    __device__ __forceinline__ unsigned a_voff(const Unit& u, int row, int C) const { int tok = slot_tok[u.pm * BM + row]; tok = tok < 0 ? 0 : tok; return (unsigned)(tok * lda + C) * 2u; }
    __device__ __forceinline__ const char* b_ptr(const Unit& u, int kt) const {
        int lo, hi; pair_lohi(u.prob % 6, lo, hi); const int e = (u.prob / 6) * 4 + ((u.pn < 4) ? lo : hi);
        return (const char*)(W13 + ((size_t)e * 1024 + (size_t)(u.pn & 3) * BM) * 1024) + (size_t)kt * (BK * 2);
    }
    __device__ __forceinline__ void epi(const f32x4 (&acc)[2][2][4][2], const Unit& u, int wr, int wc, int fr, int fq) const {
        const int row0 = u.pm * BM + wr * 64 + fr, col0 = ((u.pn < 4) ? 0 : 512) + (u.pn & 3) * 128 + wc * 32 + 8 * fq, ci = (u.pn < 4) ? 0 : 1;
#pragma unroll
        for (int ai = 0; ai < 2; ++ai)
#pragma unroll
            for (int m = 0; m < 4; ++m) { const int row = row0 + ai * HALF + m * 16; const float cw = slot_c[(size_t)row * 2 + ci];
                const f32x4 g0 = acc[ai][0][m][0], g1 = acc[ai][0][m][1], u0 = acc[ai][1][m][0], u1 = acc[ai][1][m][1]; f32x4 x0, x1;
#pragma unroll
                for (int j = 0; j < 4; ++j) { x0[j] = fsilu(g0[j]) * u0[j] * cw; x1[j] = fsilu(g1[j]) * u1[j] * cw; }
                u32x4 w; w.x = cvt_pk_bf16(x0[0], x0[1]); w.y = cvt_pk_bf16(x0[2], x0[3]); w.z = cvt_pk_bf16(x1[0], x1[1]); w.w = cvt_pk_bf16(x1[2], x1[3]);
                *(u32x4*)(H + (size_t)row * 1024 + col0) = w; }
    }
};
struct Moe2P {
    static constexpr bool PERM = true, GATHER = false;
    int K, lda, ldb, G, c, ntiles, pid;
    const bf16_t* H; const bf16_t* W2;
    const bf16_t* hsrc; bf16_t* hdst; const int* slot_tok; const int* tile_bkt;
    __device__ __forceinline__ bool next(int i, Unit& u) const {
        const int m = 2 * ((c >> 3) + (G >> 3) * i) + ((c >> 2) & 1); if ((G & 7) != 0 || m >= ntiles) { if ((G & 7) == 0) return false; const long L = (long)i * G + c; if (L >= (long)ntiles * 4) return false; u.pm = (int)(L >> 2); u.pn = (int)(L & 3); u.prob = __builtin_amdgcn_readfirstlane(ld_vec_i32(tile_bkt + u.pm)); return true; }
        u.pm = m; u.pn = c & 3; u.prob = __builtin_amdgcn_readfirstlane(ld_vec_i32(tile_bkt + u.pm)); return true;
    }
    __device__ __forceinline__ const char* a_ptr(const Unit& u) const { return (const char*)(H + (size_t)u.pm * BM * 1024); }
    __device__ __forceinline__ long a_kadj(int) const { return 0; }
    __device__ __forceinline__ unsigned a_voff(const Unit&, int, int) const { return 0u; }
    __device__ __forceinline__ const char* b_ptr(const Unit& u, int kt) const {
        int lo, hi; pair_lohi(u.prob % 6, lo, hi); const int e = (u.prob / 6) * 4 + ((kt < 8) ? lo : hi);
        return (const char*)(W2 + ((size_t)e * 1024 + (size_t)u.pn * BM) * 512) + (size_t)(kt & 7) * (BK * 2);
    }
    __device__ __forceinline__ void epi(const f32x4 (&acc)[2][2][4][2], const Unit& u, int wr, int wc, int fr, int fq) const {
        const int row0 = u.pm * BM + wr * 64 + fr, col0 = u.pn * BM + wc * 32 + 8 * fq;
        int tok[2][4];
#pragma unroll
        for (int ai = 0; ai < 2; ++ai)
#pragma unroll
            for (int m = 0; m < 4; ++m) tok[ai][m] = slot_tok[row0 + ai * HALF + m * 16];
#pragma unroll
        for (int ai = 0; ai < 2; ++ai) {
            u32x4 r[4][2];
#pragma unroll
            for (int m = 0; m < 4; ++m) { const int tk = tok[ai][m]; const bf16_t* rp = hsrc + (size_t)(tk < 0 ? 0 : tk) * 1024 + col0;
#pragma unroll
                for (int bj = 0; bj < 2; ++bj) r[m][bj] = *(const u32x4*)(rp + bj * HALF); }
#pragma unroll
            for (int m = 0; m < 4; ++m) { const int tk = tok[ai][m];
                if (tk >= 0) { bf16_t* wp = hdst + (size_t)tk * 1024 + col0;
#pragma unroll
                    for (int bj = 0; bj < 2; ++bj) { const u32x4 rw = r[m][bj]; const f32x4 a0 = acc[ai][bj][m][0], a1 = acc[ai][bj][m][1];
                        u32x4 w; w.x = cvt_pk_bf16(a0[0] + bflo(rw.x), a0[1] + bfhi(rw.x)); w.y = cvt_pk_bf16(a0[2] + bflo(rw.y), a0[3] + bfhi(rw.y));
                        w.z = cvt_pk_bf16(a1[0] + bflo(rw.z), a1[1] + bfhi(rw.z)); w.w = cvt_pk_bf16(a1[2] + bflo(rw.w), a1[3] + bfhi(rw.w));
                        *(u32x4*)(wp + bj * HALF) = w; } } }
        }
    }
};

struct Frame {
    LAS unsigned char* lds;
    int tid, lane, wave, G, bid;
    float* out; unsigned char* ws;
};
#define WSP(T, off) ((T*)(F.ws + (off)))

__device__ __forceinline__ void prep_tile(const Frame& F, const float* src, int src_ld, int k0, int kvalid, int c0, int nvalid, bf16_t* dst, int dst_ld, bool il = false, int ksrc = -1, const float* kscale = nullptr, bool one_minus = false) {
    const int ks0 = ksrc < 0 ? k0 : ksrc;
    LAS float* tl = (LAS float*)F.lds;
    __syncthreads();
#pragma unroll
    for (int p = 0; p < 2; ++p) { const int kk = (F.tid >> 4) + 32 * p, n4 = (F.tid & 15) * 4;
        f32x4 v = (f32x4){0.f, 0.f, 0.f, 0.f};
        if (il) {
            v = __builtin_nontemporal_load((const f32x4*)(src + (size_t)(ks0 + kk) * src_ld + c0 + ((n4 < 32) ? n4 : 32 + n4))); const int d0 = 2 * (n4 & 31) + (n4 >> 5);
            tl[kk * 65 + d0] = v[0]; tl[kk * 65 + d0 + 2] = v[1]; tl[kk * 65 + d0 + 4] = v[2]; tl[kk * 65 + d0 + 6] = v[3];
        } else {
        if (kk < kvalid && n4 < nvalid) v = __builtin_nontemporal_load((const f32x4*)(src + (size_t)(ks0 + kk) * src_ld + c0 + n4));
        if (kscale) { const float f_ = kscale[ks0 + kk]; v = v * (one_minus ? 1.f - f_ : f_); }
        tl[kk * 65 + n4 + 0] = v[0]; tl[kk * 65 + n4 + 1] = v[1]; tl[kk * 65 + n4 + 2] = v[2]; tl[kk * 65 + n4 + 3] = v[3]; } }
    __syncthreads();
    { const int n = F.tid >> 3, kc = (F.tid & 7) * 8; float x[8];
#pragma unroll
        for (int j = 0; j < 8; ++j) x[j] = tl[(kc + j) * 65 + n];
        u32x4 w; w.x = cvt_pk_bf16(x[0], x[1]); w.y = cvt_pk_bf16(x[2], x[3]); w.z = cvt_pk_bf16(x[4], x[5]); w.w = cvt_pk_bf16(x[6], x[7]);
        *(u32x4*)(dst + (size_t)n * dst_ld + k0 + kc) = w; }
}
__device__ __forceinline__ void phase_prep(const Params& p, const Frame& F, int id_lo, int id_hi, bool tables) {
    bf16_t* wb = WSP(bf16_t, WS_WB);
    constexpr int N0 = 1472, N1 = N0 + 512, N2 = N1 + 1024, N3 = N2 + 256, N4 = N3 + 192, N5 = N4 + 8192, N6 = N5 + 4096;
    (void)N6;
    for (int id = id_lo + F.bid; id < id_hi; id += F.G) {
        if (id < N0) { const int nt = id / 16, kt = id % 16, n0 = nt * 64; int c0, nv;
            if (n0 < PC_Q) { c0 = n0; nv = 64; } else if (n0 < PC_DT) { c0 = n0 + 16; nv = 64; } else if (n0 == PC_DT) { c0 = 2560; nv = 16; } else { c0 = 0; nv = 0; }
            const bool il = (n0 >= PC_Q && n0 < PC_V);
            if (il) c0 = 2576 + ((n0 - PC_Q) >> 7) * 128 + (((n0 - PC_Q) >> 6) & 1) * 32;
            prep_tile(F, p.in[4], 5648, kt * 64, 64, c0, nv, wb + WB_WIN / 2 + (size_t)n0 * 1024, 1024, il); }
        else if (id < N1) { const int j = id - N0, nt = j / 32, kt = j % 32; prep_tile(F, p.in[11], 1024, kt * 64, 64, nt * 64, 64, wb + WB_WOUT / 2 + (size_t)nt * 64 * 2048, 2048); }
        else if (id < N2) { const int j = id - N1, w = j / 256, r = j % 256, nt = r / 16, kt = r % 16; prep_tile(F, (w == 0) ? p.in[13] : (w == 1) ? p.in[14] : (w == 2) ? p.in[15] : p.in[16], 1024, kt * 64, 64, nt * 64, 64, wb + WB_WR / 2 + (size_t)w * 1048576 + (size_t)nt * 64 * 1024, 1024); }
        else if (id < N3) { const int j = id - N2, nt = j >> 5, kt = j & 31, half = kt >> 4;
            const float* src = (nt == 0) ? p.in[18] : (nt == 1) ? p.in[21] : p.in[23]; const int ncols = (nt < 2) ? 64 : 160, c0 = (nt < 2) ? 0 : (nt - 2) * 64, midx = (nt == 0) ? 1 : (nt == 1) ? 4 : 5;
            int nv = (nt < 2) ? 64 : ncols - c0; nv = nv < 0 ? 0 : (nv > 64 ? 64 : nv); if (nt > 4) nv = 0;
            prep_tile(F, src, ncols, kt * 64, 64, (nv ? c0 : 0), nv, wb + WB_L1 / 2 + (size_t)nt * 64 * 2048, 2048, false, (kt & 15) * 64, p.in[12] + midx * DM, !half); }
        else if (id < N4) { const int j = id - N3, w = j / 64, r = j % 64, nt = r / 4, kt = r % 4;
            int kv = (w == 0) ? (kt == 0 ? 64 : 0) : (w == 1) ? (kt == 1 ? 64 : 0) : 160 - kt * 64; kv = kv < 0 ? 0 : (kv > 64 ? 64 : kv);
            const float* src = (w == 0) ? p.in[19] : (w == 1) ? p.in[22] : p.in[24];
            prep_tile(F, src, 1024, kt * 64, kv, nt * 64, 64, wb + WB_L2 / 2 + (size_t)w * 262144 + (size_t)nt * 64 * 256, 256, false, (w == 1) ? 0 : kt * 64); }
        else if (id < N5) { const int j = id - N4, le = j / 256, r = j % 256, nt = r / 16, kt = r % 16;
            const int pn = nt >> 2, part = (nt >> 1) & 1, c0 = 128 * pn + 64 * (nt & 1);
            const float* src = (part ? p.in[35] : p.in[34]) + (size_t)le * 524288;
            prep_tile(F, src, 512, kt * 64, 64, c0, 64, wb + WB_W13 / 2 + (size_t)le * 1048576 + (size_t)nt * 64 * 1024, 1024); }
        else { const int j = id - N5, le = j / 128, r = j % 128, nt = r / 8, kt = r % 8;
            prep_tile(F, p.in[36] + (size_t)le * 524288, 1024, kt * 64, 64, nt * 64, 64, wb + WB_W2 / 2 + (size_t)le * 524288 + (size_t)nt * 64 * 512, 512); }
    }
    if (!tables) { __syncthreads(); return; }
    { float* rtw = WSP(float, WS_RTW);
        for (int idx = F.bid * NTHREADS + F.tid; idx < 2 * 20 * 1024; idx += F.G * NTHREADS) { const int l = idx / 20480, r = idx % 20480, j = r >> 10, k = r & 1023;
            rtw[idx] = (j < 4) ? p.in[30][(size_t)l * 4096 + k * 4 + j] : p.in[32][(size_t)l * 16384 + k * 16 + (j - 4)]; } }
    f32x2* rope = WSP(f32x2, WS_ROPE);
    for (int idx = F.bid * NTHREADS + F.tid; idx < SEQ * 64; idx += F.G * NTHREADS) {
        const int pos = idx >> 6, i = idx & 63;
        const float invf = exp2f(-(float)i * (13.287712379549449f / 64.f));
        const float ang = (float)pos * invf;
        const double x = (double)ang;
        const double kq = rint(x * 0.63661977236758134308);
        double r = fma(-kq, 1.57079632679489655800e+00, x); r = fma(-kq, 6.12323399573676603587e-17, r);
        const double r2 = r * r;
        double sp = -7.6471637318198164759e-13; sp = fma(sp, r2, 1.6059043836821614599e-10); sp = fma(sp, r2, -2.5052108385441718775e-08); sp = fma(sp, r2, 2.7557319223985890653e-06);
        sp = fma(sp, r2, -1.9841269841269841270e-04); sp = fma(sp, r2, 8.3333333333333333333e-03); sp = fma(sp, r2, -1.6666666666666666667e-01); const double sn = fma(sp * r2, r, r);
        double cp = 4.7794773323873852974e-14; cp = fma(cp, r2, -1.1470745597729724714e-11); cp = fma(cp, r2, 2.0876756987868098979e-09); cp = fma(cp, r2, -2.7557319223985890653e-07);
        cp = fma(cp, r2, 2.4801587301587301587e-05); cp = fma(cp, r2, -1.3888888888888888889e-03); cp = fma(cp, r2, 4.1666666666666666667e-02); cp = fma(cp, r2, -0.5); const double cs = fma(cp, r2, 1.0);
        const int q = ((int)kq) & 3;
        const double c = (q == 0) ? cs : (q == 1) ? -sn : (q == 2) ? -cs : sn;
        const double s = (q == 0) ? sn : (q == 1) ? cs : (q == 2) ? -sn : -cs;
        rope[idx] = (f32x2){(float)c, (float)s};
    }
}

__device__ __forceinline__ void row_load(const float* row, int lane, f32x4 (&v)[4]) {
#pragma unroll
    for (int j = 0; j < 4; ++j) v[j] = *(const f32x4*)(row + j * 256 + lane * 4);
}
__device__ __forceinline__ void row_load_nt(const float* row, int lane, f32x4 (&v)[4]) {
#pragma unroll
    for (int j = 0; j < 4; ++j) v[j] = __builtin_nontemporal_load((const f32x4*)(row + j * 256 + lane * 4));
}
__device__ __forceinline__ void row_load_bf_nt(const bf16_t* row, int lane, f32x4 (&v)[4]) {
#pragma unroll
    for (int j = 0; j < 4; ++j) { const u32x2 w = __builtin_nontemporal_load((const u32x2*)(row + j * 256 + lane * 4)); v[j] = (f32x4){bflo(w.x), bfhi(w.x), bflo(w.y), bfhi(w.y)}; }
}
__device__ __forceinline__ void row_load_bf(const bf16_t* row, int lane, f32x4 (&v)[4]) {
#pragma unroll
    for (int j = 0; j < 4; ++j) { const u32x2 w = *(const u32x2*)(row + j * 256 + lane * 4); v[j] = (f32x4){bflo(w.x), bfhi(w.x), bflo(w.y), bfhi(w.y)}; }
}
__device__ __forceinline__ float row_rstd(const f32x4 (&v)[4], float eps) {
    float ss = 0.f;
#pragma unroll
    for (int j = 0; j < 4; ++j) ss += v[j][0] * v[j][0] + v[j][1] * v[j][1] + v[j][2] * v[j][2] + v[j][3] * v[j][3];
    ss = wave_sum_u(ss);
    return rsqrtf(ss * (1.f / 1024.f) + eps);
}
__device__ __forceinline__ void row_store_bf16(bf16_t* row, int lane, const f32x4 (&v)[4]) {
#pragma unroll
    for (int j = 0; j < 4; ++j) { u32x2 w; w.x = cvt_pk_bf16(v[j][0], v[j][1]); w.y = cvt_pk_bf16(v[j][2], v[j][3]); *(u32x2*)(row + j * 256 + lane * 4) = w; }
}

template <bool TO_BF16, bool SRC_BF16 = false>
__device__ __forceinline__ void phase_rmsnorm(const Params& p, const Frame& F, const void* src_, const float* w, void* dst) {
    const float* src = (const float*)src_; const bf16_t* srcb = (const bf16_t*)src_; (void)src; (void)srcb;
    f32x4 wv[4]; row_load(w, F.lane, wv);
    int row = F.bid * 8 + F.wave; const int stride = F.G * 8;
    f32x4 v[4], vn[4];
    if (row < T_TOK) { if constexpr (SRC_BF16) row_load_bf_nt(srcb + (size_t)row * DM, F.lane, v); else row_load_nt(src + (size_t)row * DM, F.lane, v); }
    for (; row < T_TOK; row += stride) {
        if (row + stride < T_TOK) { if constexpr (SRC_BF16) row_load_bf_nt(srcb + (size_t)(row + stride) * DM, F.lane, vn); else row_load_nt(src + (size_t)(row + stride) * DM, F.lane, vn); }
        const float rs = row_rstd(v, 1e-6f);
#pragma unroll
        for (int j = 0; j < 4; ++j) v[j] = v[j] * rs * wv[j];
        if constexpr (TO_BF16) row_store_bf16((bf16_t*)dst + (size_t)row * DM, F.lane, v);
        else {
#pragma unroll
            for (int j = 0; j < 4; ++j) *(f32x4*)((float*)dst + (size_t)row * DM + j * 256 + F.lane * 4) = v[j];
        }
#pragma unroll
        for (int j = 0; j < 4; ++j) v[j] = vn[j];
    }
}

__device__ __forceinline__ void phase_conv(const Params& p, const Frame& F) {
    bf16_t* proj = WSP(bf16_t, WS_SLAB);
    bf16_t* xc = (bf16_t*)F.out;
    const float* conv_w = p.in[5]; const float* conv_b = p.in[6];
    for (int item = F.bid * 8 + F.wave; item < (T_TOK / 32) * 3; item += F.G * 8) {
        const int run = item / 3, cb = item - run * 3, c0 = cb * 512 + F.lane * 8, t0 = run * 32;
        float w[4][8], bb[8], xm3[8], xm2[8], xm1[8];
#pragma unroll
        for (int j = 0; j < 4; ++j) { const f32x4 a0 = *(const f32x4*)(conv_w + j * 1536 + c0), a1 = *(const f32x4*)(conv_w + j * 1536 + c0 + 4);
#pragma unroll
            for (int e = 0; e < 4; ++e) { w[j][e] = a0[e]; w[j][4 + e] = a1[e]; } }
        { const f32x4 a0 = *(const f32x4*)(conv_b + c0), a1 = *(const f32x4*)(conv_b + c0 + 4);
#pragma unroll
            for (int e = 0; e < 4; ++e) { bb[e] = a0[e]; bb[4 + e] = a1[e]; } }
        const bool first = (t0 & (SEQ - 1)) == 0;
        { u32x4 r3 = (u32x4){0u, 0u, 0u, 0u}, r2 = r3, r1 = r3;
            if (!first) { r3 = __builtin_nontemporal_load((const u32x4*)(proj + (size_t)(t0 - 3) * NPROJ + PC_XBC + c0)); r2 = __builtin_nontemporal_load((const u32x4*)(proj + (size_t)(t0 - 2) * NPROJ + PC_XBC + c0)); r1 = __builtin_nontemporal_load((const u32x4*)(proj + (size_t)(t0 - 1) * NPROJ + PC_XBC + c0)); }
            xm3[0] = bflo(r3.x); xm3[1] = bfhi(r3.x); xm3[2] = bflo(r3.y); xm3[3] = bfhi(r3.y); xm3[4] = bflo(r3.z); xm3[5] = bfhi(r3.z); xm3[6] = bflo(r3.w); xm3[7] = bfhi(r3.w);
            xm2[0] = bflo(r2.x); xm2[1] = bfhi(r2.x); xm2[2] = bflo(r2.y); xm2[3] = bfhi(r2.y); xm2[4] = bflo(r2.z); xm2[5] = bfhi(r2.z); xm2[6] = bflo(r2.w); xm2[7] = bfhi(r2.w);
            xm1[0] = bflo(r1.x); xm1[1] = bfhi(r1.x); xm1[2] = bflo(r1.y); xm1[3] = bfhi(r1.y); xm1[4] = bflo(r1.z); xm1[5] = bfhi(r1.z); xm1[6] = bflo(r1.w); xm1[7] = bfhi(r1.w); }
#pragma unroll 4
        for (int tt = 0; tt < 32; ++tt) {
            const u32x4 r = __builtin_nontemporal_load((const u32x4*)(proj + (size_t)(t0 + tt) * NPROJ + PC_XBC + c0));
            const float x[8] = {bflo(r.x), bfhi(r.x), bflo(r.y), bfhi(r.y), bflo(r.z), bfhi(r.z), bflo(r.w), bfhi(r.w)};
            float o[8];
#pragma unroll
            for (int e = 0; e < 8; ++e) { o[e] = fsilu(bb[e] + w[0][e] * xm3[e] + w[1][e] * xm2[e] + w[2][e] * xm1[e] + w[3][e] * x[e]); xm3[e] = xm2[e]; xm2[e] = xm1[e]; xm1[e] = x[e]; }
            u32x4 ow; ow.x = cvt_pk_bf16(o[0], o[1]); ow.y = cvt_pk_bf16(o[2], o[3]); ow.z = cvt_pk_bf16(o[4], o[5]); ow.w = cvt_pk_bf16(o[6], o[7]);
            *(u32x4*)(xc + (size_t)(t0 + tt) * 1536 + c0) = ow;
        }
    }
}

typedef float f32x16 __attribute__((ext_vector_type(16)));
typedef short s16x4 __attribute__((ext_vector_type(4)));
#define MFMA32(a, b, c) __builtin_amdgcn_mfma_f32_32x32x16_bf16((a), (b), (c), 0, 0, 0)
__device__ __forceinline__ unsigned off_b(unsigned row, unsigned ch) { return 256u * row + 16u * (ch ^ (((row & 3u) << 2) | ((row >> 2) & 3u))); }
__device__ __forceinline__ unsigned off_v(unsigned row, unsigned ch) { return 128u * row + 16u * (ch ^ (((row >> 1) & 1u) << 2)); }
__device__ __forceinline__ unsigned off_y(unsigned row, unsigned ch) { return 128u * row + 16u * (ch ^ (row & 7u)); }
__device__ __forceinline__ bf16x8 tr_read2(unsigned a0, unsigned a1) {
    s16x4 lo, hi;
    asm volatile("ds_read_b64_tr_b16 %0, %2\n\tds_read_b64_tr_b16 %1, %3\n\ts_waitcnt lgkmcnt(0)" : "=&v"(lo), "=&v"(hi) : "v"(a0), "v"(a1) : "memory");
    return __builtin_shufflevector(lo, hi, 0, 1, 2, 3, 4, 5, 6, 7);
}
__device__ __forceinline__ void tr_read4(unsigned a0, unsigned a1, unsigned a2, unsigned a3, bf16x8& f0, bf16x8& f1) {
    s16x4 r0, r1, r2, r3;
    asm volatile("ds_read_b64_tr_b16 %0, %4\n\tds_read_b64_tr_b16 %1, %5\n\tds_read_b64_tr_b16 %2, %6\n\tds_read_b64_tr_b16 %3, %7\n\ts_waitcnt lgkmcnt(0)"
                 : "=&v"(r0), "=&v"(r1), "=&v"(r2), "=&v"(r3) : "v"(a0), "v"(a1), "v"(a2), "v"(a3) : "memory");
    f0 = __builtin_shufflevector(r0, r1, 0, 1, 2, 3, 4, 5, 6, 7); f1 = __builtin_shufflevector(r2, r3, 0, 1, 2, 3, 4, 5, 6, 7);
}
__device__ __forceinline__ void tr_read8(unsigned a0, unsigned a1, unsigned a2, unsigned a3, unsigned a4, unsigned a5, unsigned a6, unsigned a7, bf16x8& f0, bf16x8& f1, bf16x8& f2, bf16x8& f3) {
    s16x4 r0, r1, r2, r3, r4, r5, r6, r7;
    asm volatile("ds_read_b64_tr_b16 %0, %8\n\tds_read_b64_tr_b16 %1, %9\n\tds_read_b64_tr_b16 %2, %10\n\tds_read_b64_tr_b16 %3, %11\n\tds_read_b64_tr_b16 %4, %12\n\tds_read_b64_tr_b16 %5, %13\n\tds_read_b64_tr_b16 %6, %14\n\tds_read_b64_tr_b16 %7, %15\n\ts_waitcnt lgkmcnt(0)"
                 : "=&v"(r0), "=&v"(r1), "=&v"(r2), "=&v"(r3), "=&v"(r4), "=&v"(r5), "=&v"(r6), "=&v"(r7) : "v"(a0), "v"(a1), "v"(a2), "v"(a3), "v"(a4), "v"(a5), "v"(a6), "v"(a7) : "memory");
    f0 = __builtin_shufflevector(r0, r1, 0, 1, 2, 3, 4, 5, 6, 7); f1 = __builtin_shufflevector(r2, r3, 0, 1, 2, 3, 4, 5, 6, 7);
    f2 = __builtin_shufflevector(r4, r5, 0, 1, 2, 3, 4, 5, 6, 7); f3 = __builtin_shufflevector(r6, r7, 0, 1, 2, 3, 4, 5, 6, 7);
}
__device__ __forceinline__ f32x16 zero16() { f32x16 z;
#pragma unroll
    for (int i = 0; i < 16; ++i) z[i] = 0.f;
    return z; }
__device__ __forceinline__ void phase_scan0(const Params& p, const Frame& F) {
    bf16_t* proj = WSP(bf16_t, WS_SLAB);
    const bf16_t* xc = (const bf16_t*)F.out;
    constexpr unsigned OQ = 0, OK = 32768, OV = 65536, OVW = 81920, OS = 98304, OY = 114688, OSM = 131072;
    LAS unsigned char* L = F.lds;
    const unsigned lbase = (unsigned)(__UINTPTR_TYPE__)L;
    LAS float* sm = (LAS float*)(L + OSM);
    const int lane = F.lane, w = F.wave, it = w >> 1, pt = w & 1;
    const unsigned h0 = lane >> 5, lr0 = lane & 31;
    const int trow = F.tid >> 2, tpart = F.tid & 3;
    const unsigned blk0 = (lane >> 4) & 1u, tq0 = (lane & 15u) >> 2, tp0 = lane & 3u;
    for (int ui = 0; ui < 2; ++ui) {
        const int uu = F.bid + ui * F.G;
        if (uu >= 512) break;
        const bool is_ssd = uu < 256; const int v = uu & 255, x8 = v & 7, slot = v >> 3;
        int b, hh, grp = 0, hr = 0, sl = 0;
        if (is_ssd) { const int pg = x8 + 8 * (slot >> 3), hg = slot & 7; b = pg >> 1; grp = pg & 1; hh = grp * 8 + hg; }
        else { const int pr = x8 + 8 * (slot >> 2); sl = slot & 3; b = pr >> 2; hr = pr & 3; hh = hr * 4 + sl; }
        const size_t row0 = (size_t)b * SEQ;
        const bf16_t* qptr; const bf16_t* kptr; const bf16_t* vptr; size_t qs, vs; bf16_t* optr;
        if (is_ssd) { qptr = xc + 1280 + grp * 128; kptr = xc + 1024 + grp * 128; vptr = xc + hh * 64; qs = 1536; vs = 1536; optr = proj + hh * 64; }
        else { qptr = proj + PC_Q + hr * 128; kptr = proj + PC_K + hr * 128; vptr = proj + PC_V + hr * 256 + sl * 64; qs = NPROJ; vs = NPROJ; optr = proj + 1024 + hr * 256 + sl * 64; }
        const bf16_t* zptr = proj + hh * 64;
        const float A_h = is_ssd ? -__expf(p.in[8][hh]) : 0.f, dtb = is_ssd ? p.in[7][hh] : 0.f, D_h = is_ssd ? p.in[9][hh] : 0.f;
        const float lng = __logf(1.f - exp2f(-5.f - (float)hr));
        u32x4 rv[2], rz[2]; float rdt0 = 0.f, rdt1 = 0.f;
        f32x16 St0 = zero16(), St1 = zero16();
        __syncthreads();
        for (int i = F.tid; i < 16384 / 16; i += NTHREADS) *(LAS u32x4*)(L + OS + i * 16) = (u32x4){0u, 0u, 0u, 0u};
#define SC_LOAD(c) do { const size_t r_ = row0 + (size_t)(c) * 128 + trow; \
            _Pragma("unroll") for (int e = 0; e < 2; ++e) rv[e] = *(const u32x4*)(vptr + r_ * vs + tpart * 16 + e * 8); \
            if (is_ssd && w == 0) { rdt0 = bf2f(proj[(row0 + (size_t)(c) * 128 + 2 * lane) * NPROJ + PC_DT + hh]); rdt1 = bf2f(proj[(row0 + (size_t)(c) * 128 + 2 * lane + 1) * NPROJ + PC_DT + hh]); } } while (0)
#define SC_DMA(c) do { _Pragma("unroll") for (int e = 0; e < 4; ++e) { const int I_ = w * 4 + e; const unsigned r_ = 4u * I_ + ((unsigned)lane >> 4), cs_ = lane & 15u, ch_ = cs_ ^ (((r_ & 3u) << 2) | ((r_ >> 2) & 3u)); \
            const size_t g_ = (row0 + (size_t)(c) * 128 + r_) * qs + ch_ * 8; \
            __builtin_amdgcn_global_load_lds((const unsigned*)(qptr + g_), (LAS unsigned*)(L + OQ + I_ * 1024), 16, 0, 0); \
            __builtin_amdgcn_global_load_lds((const unsigned*)(kptr + g_), (LAS unsigned*)(L + OK + I_ * 1024), 16, 0, 0); } } while (0)
#define SC_LOADZ(c) do { if (is_ssd) { const size_t r_ = row0 + (size_t)(c) * 128 + trow; rz[0] = __builtin_nontemporal_load((const u32x4*)(zptr + r_ * NPROJ + tpart * 16)); rz[1] = __builtin_nontemporal_load((const u32x4*)(zptr + r_ * NPROJ + tpart * 16 + 8)); } } while (0)
#define SC_SMALL(c) do { if (w == 0) { LAS float* sb = sm + ((c) & 1) * 384; float d0, d1, a0, a1; \
            if (is_ssd) { d0 = fsoftplus(rdt0 + dtb); d1 = fsoftplus(rdt1 + dtb); a0 = d0 * A_h; a1 = d1 * A_h; } else { d0 = 1.f; d1 = 1.f; a0 = lng; a1 = lng; } \
            float sc = a0 + a1; _Pragma("unroll") for (int o = 1; o < 64; o <<= 1) { const float tv = __shfl_up(sc, o); if (lane >= o) sc += tv; } \
            const float c1 = sc, c0 = sc - a1; const float tot = __shfl(sc, 63); \
            sb[2 * lane] = c0; sb[2 * lane + 1] = c1; sb[128 + 2 * lane] = d0; sb[128 + 2 * lane + 1] = d1; sb[256 + 2 * lane] = __expf(tot - c0) * d0; sb[256 + 2 * lane + 1] = __expf(tot - c1) * d1; } } while (0)
#define SC_STORE(c) do { const float wj_ = sm[((c) & 1) * 384 + 256 + trow]; \
            _Pragma("unroll") for (int e = 0; e < 2; ++e) { const u32x4 x_ = rv[e]; *(LAS u32x4*)(L + OV + off_v(trow, tpart * 2 + e)) = x_; u32x4 y_; \
                y_.x = cvt_pk_bf16(bflo(x_.x) * wj_, bfhi(x_.x) * wj_); y_.y = cvt_pk_bf16(bflo(x_.y) * wj_, bfhi(x_.y) * wj_); y_.z = cvt_pk_bf16(bflo(x_.z) * wj_, bfhi(x_.z) * wj_); y_.w = cvt_pk_bf16(bflo(x_.w) * wj_, bfhi(x_.w) * wj_); \
                *(LAS u32x4*)(L + OVW + off_v(trow, tpart * 2 + e)) = y_; } } while (0)
        SC_DMA(0); SC_LOAD(0);
        SC_SMALL(0);
        __syncthreads();
        SC_STORE(0);
        asm volatile("s_waitcnt vmcnt(0)" ::: "memory");
        __syncthreads();
        SP_DECL;
        for (int c = 0; c < SEQ / 128; ++c) {
            SP_MARK(8);
            const LAS float* sb = sm + (c & 1) * 384;
            unsigned lr = lr0, h = h0, blk = blk0, tq_ = tq0, tp_ = tp0;
            asm volatile("" : "+v"(lr), "+v"(h), "+v"(blk), "+v"(tq_), "+v"(tp_));
            if (c + 1 < SEQ / 128) { SC_LOAD(c + 1); }
            SC_LOADZ(c);
            const int ph = pt;
            const float ai = sb[32 * it + lr];
            f32x16 Yd0 = zero16(), Yd1 = zero16();
            for (int jt = ph; jt <= it; jt += 2) {
                f32x16 acc = zero16();
#pragma unroll
                for (int ks = 0; ks < 8; ++ks) { const bf16x8 ka = *(const LAS bf16x8*)(L + OK + off_b(32 * jt + lr, 2 * ks + h)), qb = *(const LAS bf16x8*)(L + OQ + off_b(32 * it + lr, 2 * ks + h)); acc = MFMA32(ka, qb, acc); }
                const bool diag = (jt == it);
#pragma unroll
                for (int g = 0; g < 4; ++g) { const f32x4 aj = *(const LAS f32x4*)(sb + 32 * jt + 8 * g + 4 * h), dj = *(const LAS f32x4*)(sb + 128 + 32 * jt + 8 * g + 4 * h);
#pragma unroll
                    for (int e = 0; e < 4; ++e) { const float dec = __expf(ai - aj[e]) * dj[e]; const bool ok = !diag || ((int)lr >= (int)(8 * g + 4 * h + e)); acc[4 * g + e] = ok ? acc[4 * g + e] * dec : 0.f; } }
#pragma unroll
                for (int s2 = 0; s2 < 2; ++s2) {
                    u32x4 pw; pw.x = cvt_pk_bf16(acc[8 * s2 + 0], acc[8 * s2 + 1]); pw.y = cvt_pk_bf16(acc[8 * s2 + 2], acc[8 * s2 + 3]); pw.z = cvt_pk_bf16(acc[8 * s2 + 4], acc[8 * s2 + 5]); pw.w = cvt_pk_bf16(acc[8 * s2 + 6], acc[8 * s2 + 7]);
                    const bf16x8 Pb = __builtin_bit_cast(bf16x8, pw);
                    const unsigned rb0 = 32 * jt + 16 * s2 + 4 * h + tq_, cc0 = 2 * blk + (tp_ >> 1), o8 = 8 * (tp_ & 1);
                    bf16x8 va0, va1;
                    tr_read4(lbase + OV + off_v(rb0, cc0) + o8, lbase + OV + off_v(rb0 + 8, cc0) + o8, lbase + OV + off_v(rb0, 4 + cc0) + o8, lbase + OV + off_v(rb0 + 8, 4 + cc0) + o8, va0, va1);
                    Yd0 = MFMA32(va0, Pb, Yd0); Yd1 = MFMA32(va1, Pb, Yd1);
                }
            }
            {
                f32x16 Yo = zero16();
#pragma unroll
                for (int ks = 0; ks < 8; ++ks) { const bf16x8 sa = *(const LAS bf16x8*)(L + OS + off_b(32 * ph + lr, 2 * ks + h)), qb = *(const LAS bf16x8*)(L + OQ + off_b(32 * it + lr, 2 * ks + h)); Yo = MFMA32(sa, qb, Yo); }
                const float ei = __expf(ai);
                if (ph == 0) {
#pragma unroll
                    for (int r = 0; r < 16; ++r) Yd0[r] += Yo[r] * ei; }
                else {
#pragma unroll
                    for (int r = 0; r < 16; ++r) Yd1[r] += Yo[r] * ei; }
            }
#pragma unroll
            for (int g = 0; g < 4; ++g) { u32x2 yw;
                if (ph == 0) { yw.x = cvt_pk_bf16(Yd1[4 * g], Yd1[4 * g + 1]); yw.y = cvt_pk_bf16(Yd1[4 * g + 2], Yd1[4 * g + 3]); } else { yw.x = cvt_pk_bf16(Yd0[4 * g], Yd0[4 * g + 1]); yw.y = cvt_pk_bf16(Yd0[4 * g + 2], Yd0[4 * g + 3]); }
                *(LAS u32x2*)(L + OY + off_y(32 * it + lr, 4 * (1 - ph) + g) + 8 * h) = yw; }
            const float dl = __expf(sb[127]);
            const int st0 = (w == 0) ? 0 : (w == 1) ? 2 : (w == 2) ? 4 : (w == 3) ? 5 : (w == 5) ? 6 : -1, st1 = (w == 0) ? 1 : (w == 1) ? 3 : (w == 5) ? 7 : -1;
            if (st0 >= 0) {
                const int spt = st0 & 1, snt = st0 >> 1;
#pragma unroll
                for (int r = 0; r < 16; ++r) St0[r] *= dl;
#pragma unroll
                for (int k2 = 0; k2 < 4; ++k2) { const unsigned rb = 32 * k2 + 8 * h + tq_, cv = 4 * spt + 2 * blk + (tp_ >> 1), cb = 4 * snt + 2 * blk + (tp_ >> 1), o8 = 8 * (tp_ & 1);
                    bf16x8 fa0, fb0, fa1, fb1;
                    tr_read8(lbase + OVW + off_v(rb, cv) + o8, lbase + OVW + off_v(rb + 4, cv) + o8, lbase + OK + off_b(rb, cb) + o8, lbase + OK + off_b(rb + 4, cb) + o8,
                             lbase + OVW + off_v(rb + 16, cv) + o8, lbase + OVW + off_v(rb + 20, cv) + o8, lbase + OK + off_b(rb + 16, cb) + o8, lbase + OK + off_b(rb + 20, cb) + o8, fa0, fb0, fa1, fb1);
                    St0 = MFMA32(fa0, fb0, St0); St0 = MFMA32(fa1, fb1, St0); }
                if (st1 >= 0) {
                    const int spt1 = st1 & 1, snt1 = st1 >> 1;
#pragma unroll
                    for (int r = 0; r < 16; ++r) St1[r] *= dl;
#pragma unroll
                    for (int k2 = 0; k2 < 4; ++k2) { const unsigned rb = 32 * k2 + 8 * h + tq_, cv = 4 * spt1 + 2 * blk + (tp_ >> 1), cb = 4 * snt1 + 2 * blk + (tp_ >> 1), o8 = 8 * (tp_ & 1);
                        bf16x8 fa0, fb0, fa1, fb1;
                        tr_read8(lbase + OVW + off_v(rb, cv) + o8, lbase + OVW + off_v(rb + 4, cv) + o8, lbase + OK + off_b(rb, cb) + o8, lbase + OK + off_b(rb + 4, cb) + o8,
                                 lbase + OVW + off_v(rb + 16, cv) + o8, lbase + OVW + off_v(rb + 20, cv) + o8, lbase + OK + off_b(rb + 16, cb) + o8, lbase + OK + off_b(rb + 20, cb) + o8, fa0, fb0, fa1, fb1);
                        St1 = MFMA32(fa0, fb0, St1); St1 = MFMA32(fa1, fb1, St1); }
                }
            }
            if (c + 1 < SEQ / 128) SC_SMALL(c + 1);
            LDS_BAR();
#pragma unroll
            for (int g = 0; g < 4; ++g) { LAS u32x2* yp = (LAS u32x2*)(L + OY + off_y(32 * it + lr, 4 * ph + g) + 8 * h); const u32x2 pv_ = *yp; u32x2 yw;
                if (ph == 0) { yw.x = cvt_pk_bf16(Yd0[4 * g] + bflo(pv_.x), Yd0[4 * g + 1] + bfhi(pv_.x)); yw.y = cvt_pk_bf16(Yd0[4 * g + 2] + bflo(pv_.y), Yd0[4 * g + 3] + bfhi(pv_.y)); }
                else { yw.x = cvt_pk_bf16(Yd1[4 * g] + bflo(pv_.x), Yd1[4 * g + 1] + bfhi(pv_.x)); yw.y = cvt_pk_bf16(Yd1[4 * g + 2] + bflo(pv_.y), Yd1[4 * g + 3] + bfhi(pv_.y)); }
                *yp = yw; }
            LDS_BAR();
            SP_MARK(5);
            if (c + 1 < SEQ / 128) SC_DMA(c + 1);
            if (st0 >= 0) {
                const int spt = st0 & 1, snt = st0 >> 1;
#pragma unroll
                for (int r = 0; r < 16; ++r) { const unsigned pr = 32 * spt + (r & 3) + 8 * (r >> 2) + 4 * h, n = 32 * snt + lr; *(LAS bf16_t*)(L + OS + off_b(pr, n >> 3) + 2 * (n & 7)) = f2bf(St0[r]); }
                if (st1 >= 0) { const int spt1 = st1 & 1, snt1 = st1 >> 1;
#pragma unroll
                    for (int r = 0; r < 16; ++r) { const unsigned pr = 32 * spt1 + (r & 3) + 8 * (r >> 2) + 4 * h, n = 32 * snt1 + lr; *(LAS bf16_t*)(L + OS + off_b(pr, n >> 3) + 2 * (n & 7)) = f2bf(St1[r]); }
                }
            }
            {
                bf16_t* orow = optr + (row0 + (size_t)c * 128 + trow) * NPROJ + tpart * 16;
#pragma unroll
                for (int e = 0; e < 2; ++e) {
                    const u32x4 yv = *(const LAS u32x4*)(L + OY + off_y(trow, tpart * 2 + e));
                    u32x4 ov = yv;
                    if (is_ssd) { const u32x4 xv = *(const LAS u32x4*)(L + OV + off_v(trow, tpart * 2 + e)); const u32x4 zv = rz[e];
                        ov.x = cvt_pk_bf16((bflo(yv.x) + bflo(xv.x) * D_h) * fsilu(bflo(zv.x)), (bfhi(yv.x) + bfhi(xv.x) * D_h) * fsilu(bfhi(zv.x)));
                        ov.y = cvt_pk_bf16((bflo(yv.y) + bflo(xv.y) * D_h) * fsilu(bflo(zv.y)), (bfhi(yv.y) + bfhi(xv.y) * D_h) * fsilu(bfhi(zv.y)));
                        ov.z = cvt_pk_bf16((bflo(yv.z) + bflo(xv.z) * D_h) * fsilu(bflo(zv.z)), (bfhi(yv.z) + bfhi(xv.z) * D_h) * fsilu(bfhi(zv.z)));
                        ov.w = cvt_pk_bf16((bflo(yv.w) + bflo(xv.w) * D_h) * fsilu(bflo(zv.w)), (bfhi(yv.w) + bfhi(xv.w) * D_h) * fsilu(bfhi(zv.w))); }
                    *(u32x4*)(orow + e * 8) = ov;
                }
            }
            LDS_BAR();
            SP_MARK(6);
            if (c + 1 < SEQ / 128) SC_STORE(c + 1);
            asm volatile("s_waitcnt vmcnt(0)" ::: "memory");
            LDS_BAR();
            SP_MARK(7);
        }
#undef SC_LOAD
#undef SC_LOADZ
#undef SC_SMALL
#undef SC_STORE
    }
}

__device__ __forceinline__ void phase_gatenorm(const Params& p, const Frame& F) {
    const bf16_t* proj = WSP(bf16_t, WS_SLAB);
    bf16_t* ybuf = WSP(bf16_t, WS_SLAB);
    const float* nw = p.in[10];
    int row = F.bid * 8 + F.wave; const int stride = F.G * 8;
    u32x4 yc[4], gc[2], yn[4], gn[2];
#define GN_LOAD(r_, Y_, G_) do { const bf16_t* b_ = ybuf + (size_t)(r_) * NPROJ; _Pragma("unroll") for (int j = 0; j < 4; ++j) Y_[j] = *(const u32x4*)(b_ + j * 512 + F.lane * 8); \
        _Pragma("unroll") for (int j = 0; j < 2; ++j) G_[j] = __builtin_nontemporal_load((const u32x4*)(b_ + PC_G + j * 512 + F.lane * 8)); } while (0)
    if (row < T_TOK) GN_LOAD(row, yc, gc);
    for (; row < T_TOK; row += stride) {
        if (row + stride < T_TOK) GN_LOAD(row + stride, yn, gn);
        bf16_t* yr = ybuf + (size_t)row * NPROJ;
#pragma unroll
        for (int j = 0; j < 4; ++j) {
            const u32x4 w = yc[j];
            float x[8] = {bflo(w.x), bfhi(w.x), bflo(w.y), bfhi(w.y), bflo(w.z), bfhi(w.z), bflo(w.w), bfhi(w.w)};
            float ss = 0.f;
#pragma unroll
            for (int e = 0; e < 8; ++e) ss += x[e] * x[e];
            if (j < 2) { ss = wave_sum_u(ss); const float rs = rsqrtf(ss * (1.f / 512.f) + 1e-5f);
                const f32x4 w0 = *(const f32x4*)(nw + j * 512 + F.lane * 8), w1 = *(const f32x4*)(nw + j * 512 + F.lane * 8 + 4);
#pragma unroll
                for (int e = 0; e < 4; ++e) { x[e] *= rs * w0[e]; x[4 + e] *= rs * w1[e]; } }
            else {
                ss = dpp_sum16(ss); ss += __shfl_xor(ss, 16);
                const float rs = rsqrtf(ss * (1.f / 256.f) + 1e-6f);
                const u32x4 gw = gc[j - 2];
                const float g[8] = {bflo(gw.x), bfhi(gw.x), bflo(gw.y), bfhi(gw.y), bflo(gw.z), bfhi(gw.z), bflo(gw.w), bfhi(gw.w)};
#pragma unroll
                for (int e = 0; e < 8; ++e) x[e] *= rs * fsilu(g[e]); }
            u32x4 o; o.x = cvt_pk_bf16(x[0], x[1]); o.y = cvt_pk_bf16(x[2], x[3]); o.z = cvt_pk_bf16(x[4], x[5]); o.w = cvt_pk_bf16(x[6], x[7]);
            *(u32x4*)(yr + j * 512 + F.lane * 8) = o;
        }
#pragma unroll
        for (int j = 0; j < 4; ++j) yc[j] = yn[j];
        gc[0] = gn[0]; gc[1] = gn[1];
    }
#undef GN_LOAD
}

__device__ __forceinline__ void phase_moe_route(const Params& p, const Frame& F, int layer, const bf16_t* h, bf16_t* tbuf) {
    unsigned char* meta = F.ws + WS_META + (size_t)layer * META_STRIDE;
    int* tok_rank = (int*)(meta + MT_RANK); int* tok_bkt = (int*)(meta + MT_BKT); f32x2* tok_c = (f32x2*)(meta + MT_C);
    int* gcount = (int*)(F.ws + WS_CTL + CTL_CNT_OFF) + layer * 32;
    const float* bg = p.in[31] + layer * 4; const float* be = p.in[33] + layer * 16;
    LAS float* wl = (LAS float*)F.lds;
    LAS int* lcount = (LAS int*)(F.lds + 81920);
    LAS int* lbase = lcount + 32;
    LAS int* l_bkt = lbase + 32;
    LAS int* l_rank = l_bkt + 1024;
    LAS float* l_c = (LAS float*)(l_rank + 1024);
    LAS float* lgt = (LAS float*)(F.lds + 98816);
    __syncthreads();
    { const float* wrt = WSP(float, WS_RTW) + (size_t)layer * 20480;
        for (int idx = F.tid; idx < 20 * 1024 / 4; idx += NTHREADS) *(LAS f32x4*)(wl + idx * 4) = *(const f32x4*)(wrt + idx * 4); }
    if (F.tid < 32) lcount[F.tid] = 0;
    __syncthreads();
    const int TPB = (T_TOK + F.G - 1) / F.G, tok0 = F.bid * TPB;
    f32x4 wv[4]; row_load(p.in[2] + (size_t)layer * DM, F.lane, wv);
    f32x4 va[4], vb[4], na[4], nb[4];
    int hsel;
    { unsigned t0_ = 0u, t1_ = 1u; asm volatile("s_nop 1\n\tv_permlane32_swap_b32 %0, %1\n\ts_nop 1" : "+v"(t0_), "+v"(t1_)); hsel = (t0_ + t1_ >= 2u) ? 10 : 0; }
#define RT_LOAD(li_, A_, B_) do { const int ta_ = tok0 + (li_), tb_ = ta_ + 8; \
        if ((li_) < TPB && ta_ < T_TOK) row_load_bf_nt(h + (size_t)ta_ * DM, F.lane, A_); if ((li_) + 8 < TPB && tb_ < T_TOK) row_load_bf_nt(h + (size_t)tb_ * DM, F.lane, B_); } while (0)
    RT_LOAD(F.wave, va, vb);
    for (int li = F.wave; li < TPB; li += 16) {
        const int tok = tok0 + li; if (tok >= T_TOK) break;
        const bool hasb = (li + 8 < TPB) && (tok + 8 < T_TOK);
        RT_LOAD(li + 16, na, nb);
        const float rsa = row_rstd(va, 1e-6f), rsb = row_rstd(vb, 1e-6f);
#pragma unroll
        for (int j = 0; j < 4; ++j) { va[j] = va[j] * rsa * wv[j]; vb[j] = vb[j] * rsb * wv[j]; }
        row_store_bf16(tbuf + (size_t)tok * DM, F.lane, va);
        if (hasb) row_store_bf16(tbuf + (size_t)(tok + 8) * DM, F.lane, vb);
        LAS float* lga = lgt + li * 20; LAS float* lgb = lgt + (li + 8) * 20;
#pragma unroll
        for (int o = 0; o < 10; ++o) { f32x2 c0 = (f32x2){0.f, 0.f}, c1 = c0, d0 = c0, d1 = c0;
#pragma unroll
            for (int j = 0; j < 4; ++j) { const f32x4 w4 = *(const LAS f32x4*)(wl + o * 1024 + j * 256 + F.lane * 4), w5 = *(const LAS f32x4*)(wl + (o + 10) * 1024 + j * 256 + F.lane * 4);
                const f32x2 w4l = (f32x2){w4[0], w4[1]}, w4h = (f32x2){w4[2], w4[3]}, w5l = (f32x2){w5[0], w5[1]}, w5h = (f32x2){w5[2], w5[3]};
                const f32x2 al = (f32x2){va[j][0], va[j][1]}, ah = (f32x2){va[j][2], va[j][3]}, bl = (f32x2){vb[j][0], vb[j][1]}, bh = (f32x2){vb[j][2], vb[j][3]};
                c0 += al * w4l; c0 += ah * w4h; c1 += al * w5l; c1 += ah * w5h; d0 += bl * w4l; d0 += bh * w4h; d1 += bl * w5l; d1 += bh * w5h; }
            float a0 = c0[0] + c0[1], a1 = c1[0] + c1[1], b0 = d0[0] + d0[1], b1 = d1[0] + d1[1];
            asm volatile("s_nop 1\n\tv_permlane32_swap_b32 %0, %1\n\tv_permlane32_swap_b32 %2, %3\n\ts_nop 1" : "+v"(a0), "+v"(a1), "+v"(b0), "+v"(b1));
            float sa = dpp_sum16(a0 + a1), sb_ = dpp_sum16(b0 + b1);
            sa += __builtin_bit_cast(float, __builtin_amdgcn_update_dpp(0, __builtin_bit_cast(int, sa), 0x142, 0xA, 0xF, false));
            sb_ += __builtin_bit_cast(float, __builtin_amdgcn_update_dpp(0, __builtin_bit_cast(int, sb_), 0x142, 0xA, 0xF, false));
            if ((F.lane & 31) == 16) { lga[hsel + o] = sa; if (hasb) lgb[hsel + o] = sb_; }
            if (o & 1) __builtin_amdgcn_sched_barrier(0); }
#pragma unroll
        for (int j = 0; j < 4; ++j) { va[j] = na[j]; vb[j] = nb[j]; }
    }
#undef RT_LOAD
    __syncthreads();
    for (int li = F.tid; li < TPB; li += NTHREADS) {
        if (tok0 + li >= T_TOK) break;
        float lg[20];
#pragma unroll
        for (int o = 0; o < 20; ++o) lg[o] = lgt[li * 20 + o];
        float g0 = lg[0] + bg[0], g1 = lg[1] + bg[1], g2 = lg[2] + bg[2], g3 = lg[3] + bg[3];
        int gi = 0; float gm = g0; if (g1 > gm) { gm = g1; gi = 1; } if (g2 > gm) { gm = g2; gi = 2; } if (g3 > gm) { gm = g3; gi = 3; }
        const float gate = 1.f / (__expf(g0 - gm) + __expf(g1 - gm) + __expf(g2 - gm) + __expf(g3 - gm));
        float e0, e1, e2, e3;
        e0 = (gi == 0) ? lg[4] : (gi == 1) ? lg[8] : (gi == 2) ? lg[12] : lg[16];
        e1 = (gi == 0) ? lg[5] : (gi == 1) ? lg[9] : (gi == 2) ? lg[13] : lg[17];
        e2 = (gi == 0) ? lg[6] : (gi == 1) ? lg[10] : (gi == 2) ? lg[14] : lg[18];
        e3 = (gi == 0) ? lg[7] : (gi == 1) ? lg[11] : (gi == 2) ? lg[15] : lg[19];
        e0 += be[gi * 4 + 0]; e1 += be[gi * 4 + 1]; e2 += be[gi * 4 + 2]; e3 += be[gi * 4 + 3];
        int i1 = 0; float v1 = e0; if (e1 > v1) { v1 = e1; i1 = 1; } if (e2 > v1) { v1 = e2; i1 = 2; } if (e3 > v1) { v1 = e3; i1 = 3; }
        int i2 = -1; float v2 = -3.0e38f;
        if (i1 != 0 && e0 > v2) { v2 = e0; i2 = 0; } if (i1 != 1 && e1 > v2) { v2 = e1; i2 = 1; } if (i1 != 2 && e2 > v2) { v2 = e2; i2 = 2; } if (i1 != 3 && e3 > v2) { v2 = e3; i2 = 3; }
        const float w1 = gate / (1.f + __expf(v2 - v1)), w2 = gate - w1;
        const int lo = i1 < i2 ? i1 : i2, hi = i1 < i2 ? i2 : i1; const float clo = i1 < i2 ? w1 : w2, chi = i1 < i2 ? w2 : w1;
        const int pr = (lo == 0) ? hi - 1 : (lo == 1) ? hi + 1 : 5;
        const int bk = gi * 6 + pr;
        l_bkt[li] = bk; l_c[li * 2] = clo; l_c[li * 2 + 1] = chi;
        l_rank[li] = __hip_atomic_fetch_add((int*)(lcount + bk), 1, __ATOMIC_RELAXED, __HIP_MEMORY_SCOPE_WORKGROUP);
    }
    __syncthreads();
    if (F.tid < 24) lbase[F.tid] = __hip_atomic_fetch_add(gcount + F.tid, lcount[F.tid], __ATOMIC_RELAXED, __HIP_MEMORY_SCOPE_AGENT);
    __syncthreads();
    for (int li = F.tid; li < TPB; li += NTHREADS) { const int tok = tok0 + li; if (tok < T_TOK) { const int bk = l_bkt[li]; tok_bkt[tok] = bk; tok_rank[tok] = lbase[bk] + l_rank[li]; tok_c[tok] = (f32x2){l_c[li * 2], l_c[li * 2 + 1]}; } }
}
__device__ __forceinline__ void phase_moe_slots(const Params& p, const Frame& F, int layer) {
    unsigned char* meta = F.ws + WS_META + (size_t)layer * META_STRIDE;
    const int* tok_rank = (const int*)(meta + MT_RANK); const int* tok_bkt = (const int*)(meta + MT_BKT); const f32x2* tok_c = (const f32x2*)(meta + MT_C);
    int* slot_tok = (int*)(meta + MT_STOK); f32x2* slot_c = (f32x2*)(meta + MT_SC); int* tile_tab = (int*)(meta + MT_TILE);
    int* gcount = (int*)(F.ws + WS_CTL + CTL_CNT_OFF) + layer * 32;
    LAS int* cnt = (LAS int*)F.lds; LAS int* start = cnt + 32;
    __syncthreads();
    if (F.tid < 24) cnt[F.tid] = __hip_atomic_load(gcount + F.tid, __ATOMIC_RELAXED, __HIP_MEMORY_SCOPE_AGENT);
    __syncthreads();
    if (F.tid == 0) { int a = 0; for (int b = 0; b < 24; ++b) { start[b] = a; a += (cnt[b] + 255) >> 8; } start[24] = a; }
    __syncthreads();
    for (int tok = F.bid * NTHREADS + F.tid; tok < T_TOK; tok += F.G * NTHREADS) { const int bk = tok_bkt[tok]; const int slot = start[bk] * 256 + tok_rank[tok]; slot_tok[slot] = tok; slot_c[slot] = tok_c[tok]; }
    for (int b = F.bid; b < 24; b += F.G) { const int s0 = start[b] * 256 + cnt[b], s1 = start[b + 1] * 256;
        for (int s = s0 + F.tid; s < s1; s += NTHREADS) { slot_tok[s] = -1; slot_c[s] = (f32x2){0.f, 0.f}; } }
    if (F.bid == 0) { if (F.tid == 0) tile_tab[0] = start[24];
        for (int m = F.tid; m < 288; m += NTHREADS) { int bk = 23; for (int b = 0; b < 24; ++b) if (m >= start[b] && m < start[b + 1]) bk = b; tile_tab[64 + m] = bk; } }
}

__device__ __forceinline__ void phase_mix5(const Params& p, const Frame& F, const bf16_t* h, bf16_t* ou, bf16_t* oup, bf16_t* o0, bf16_t* o1, bf16_t* o2) {
    const float* mu = p.in[12];
    f32x4 wv[4], m0[4], m1[4], m2[4];
    row_load(p.in[1] + DM, F.lane, wv); row_load(mu, F.lane, m0); row_load(mu + 2 * DM, F.lane, m1); row_load(mu + 3 * DM, F.lane, m2);
    for (int run = F.bid * 8 + F.wave; run < T_TOK / 32; run += F.G * 8) {
        const int t0 = run * 32;
        f32x4 up[4];
        if ((t0 & (SEQ - 1)) == 0) {
#pragma unroll
            for (int j = 0; j < 4; ++j) up[j] = (f32x4){0.f, 0.f, 0.f, 0.f};
        } else { row_load_bf(h + (size_t)(t0 - 1) * DM, F.lane, up); const float rs = row_rstd(up, 1e-6f);
#pragma unroll
            for (int j = 0; j < 4; ++j) up[j] = up[j] * rs * wv[j]; }
        f32x4 u[4], un[4]; row_load_bf(h + (size_t)t0 * DM, F.lane, u);
        for (int tt = 0; tt < 32; ++tt) {
            if (tt + 1 < 32) row_load_bf(h + (size_t)(t0 + tt + 1) * DM, F.lane, un);
            const float rs = row_rstd(u, 1e-6f);
            f32x4 a[4], b[4], c[4];
#pragma unroll
            for (int j = 0; j < 4; ++j) { u[j] = u[j] * rs * wv[j]; const f32x4 xx = up[j] - u[j]; a[j] = u[j] + xx * m0[j]; b[j] = u[j] + xx * m1[j]; c[j] = u[j] + xx * m2[j]; }
            const size_t ro = (size_t)(t0 + tt) * DM;
            row_store_bf16(ou + ro, F.lane, u); row_store_bf16(oup + ro, F.lane, up);
            row_store_bf16(o0 + ro, F.lane, a); row_store_bf16(o1 + ro, F.lane, b); row_store_bf16(o2 + ro, F.lane, c);
#pragma unroll
            for (int j = 0; j < 4; ++j) { up[j] = u[j]; u[j] = un[j]; }
        }
    }
}

typedef __bf16 bf16x2v __attribute__((ext_vector_type(2)));
__device__ __forceinline__ unsigned pkc(float lo, float hi) { f32x2 t = {lo, hi}; bf16x2v r = __builtin_convertvector(t, bf16x2v); return __builtin_bit_cast(unsigned, r); }
__device__ __forceinline__ unsigned off_r(unsigned row, unsigned ch) { return row * 128u + 16u * (ch ^ ((row >> 1) & 7u)); }
__device__ __forceinline__ unsigned off_m(unsigned row, unsigned ch) { return row * 64u + 16u * (ch ^ ((0u - (row >> 2)) & 3u)); }
#define MFMA16(a, b, c) __builtin_amdgcn_mfma_f32_16x16x32_bf16((a), (b), (c), 0, 0, 0)
__device__ __forceinline__ void swap32(float& a, float& b) { asm volatile("s_nop 1\n\tv_permlane32_swap_b32 %0, %1\n\ts_nop 1" : "+v"(a), "+v"(b)); }
__device__ __forceinline__ float half_sum(float x, bool hf) {
    x = dpp_sum16(x);
    x += __builtin_bit_cast(float, __builtin_amdgcn_update_dpp(0, __builtin_bit_cast(int, x), 0x142, 0xA, 0xF, false));
    const float lo = __builtin_bit_cast(float, __builtin_amdgcn_readlane(__builtin_bit_cast(int, x), 31)), hi = __builtin_bit_cast(float, __builtin_amdgcn_readlane(__builtin_bit_cast(int, x), 63));
    return hf ? hi : lo;
}
__device__ __forceinline__ void phase_rwkv(const Params& p, const Frame& F, bf16_t* rbuf, const bf16_t* kbuf, const bf16_t* vbuf, const bf16_t* ebuf, const bf16_t* abuf, const bf16_t* gbuf) {
    constexpr unsigned ORA = 0, OLB = 16384, OMS = 32768, OMU = 49152, OMY = 53248, OAB = 57344, OAK = 61440, OVT = 65536, OGC = 73728, OYS = 74752, OVF = 91136, OGG = 107520, OBON = 123904;
    LAS unsigned char* L = F.lds;
    const float* k_k = p.in[25]; const float* k_a = p.in[26]; const float* r_k = p.in[27]; const float* lnw = p.in[28]; const float* lnb = p.in[29];
    const int lane0 = F.lane, w = F.wave, pc = w >> 1, th = w & 1;
    for (int unit = F.bid; unit < 256; unit += F.G) {
        const int b = unit >> 4, hd = unit & 15;
        const int gc2 = hd * 64 + 2 * (lane0 & 31);
        const f32x2 kkw = *(const f32x2*)(k_k + gc2), kaw = *(const f32x2*)(k_a + gc2), rkw = *(const f32x2*)(r_k + gc2), lw = *(const f32x2*)(lnw + gc2), lb = *(const f32x2*)(lnb + gc2);
        int lane = lane0;
        f32x4 St[4];
#pragma unroll
        for (int mt = 0; mt < 4; ++mt) St[mt] = (f32x4){0.f, 0.f, 0.f, 0.f};
        unsigned pr[4], pk[4], pv[4], pe[4], pa[4], pg[4], pe0[4];
#define RW_LOAD(t0_) do { const size_t ub_ = ((size_t)b * SEQ + (t0_) + 16 * pc + 8 * th) * DM + hd * 64, ub0_ = ((size_t)b * SEQ + (t0_) + 16 * pc) * DM + hd * 64;     \
            const bf16_t* r_ = rbuf + ub_; const bf16_t* k_ = kbuf + ub_; const bf16_t* v_ = vbuf + ub_; const bf16_t* e_ = ebuf + ub_; const bf16_t* a_ = abuf + ub_; const bf16_t* g_ = gbuf + ub_; const bf16_t* e0_ = ebuf + ub0_; \
            _Pragma("unroll") for (int it = 0; it < 4; ++it) { const unsigned lo_ = (unsigned)((4 * (lane >> 5) + it) * DM + 2 * (lane & 31)); \
            pr[it] = __builtin_nontemporal_load((const unsigned*)(r_ + lo_)); pk[it] = __builtin_nontemporal_load((const unsigned*)(k_ + lo_)); pv[it] = __builtin_nontemporal_load((const unsigned*)(v_ + lo_)); pe[it] = __builtin_nontemporal_load((const unsigned*)(e_ + lo_)); pa[it] = __builtin_nontemporal_load((const unsigned*)(a_ + lo_)); pg[it] = __builtin_nontemporal_load((const unsigned*)(g_ + lo_)); pe0[it] = *(const unsigned*)(e0_ + lo_); } } while (0)
        RW_LOAD(0);
        SP_DECL;
        for (int t0 = 0; t0 < SEQ; t0 += 64) {
            LDS_BAR();
            SP_MARK(4);
            asm volatile("" : "+v"(lane));
            const unsigned l15 = lane & 15, q = (unsigned)lane >> 4, cp = lane & 31;
            const bool hf = lane >= 32;
            const unsigned pj = 32u * (cp >> 4) + 8u * ((cp & 7) >> 1) + 2u * (cp & 1) + ((cp & 8) ? 4u : 0u);
            {
                float pl0[4], pl1[4], ls0 = 0.f, ls1 = 0.f, f0 = 0.f, f1 = 0.f;
#pragma unroll
                for (int it = 0; it < 4; ++it) { ls0 += bflo(pe[it]); ls1 += bfhi(pe[it]); pl0[it] = ls0; pl1[it] = ls1; f0 += bflo(pe0[it]); f1 += bfhi(pe0[it]); }
                float xa0 = 0.f, xb0 = ls0, xa1 = 0.f, xb1 = ls1; swap32(xa0, xb0); swap32(xa1, xb1);
                float ya0 = f0, yb0 = f0, ya1 = f1, yb1 = f1; swap32(ya0, yb0); swap32(ya1, yb1);
                const float base0 = xa0 + (th ? f0 + (hf ? ya0 : yb0) : 0.f), base1 = xa1 + (th ? f1 + (hf ? ya1 : yb1) : 0.f);
                float ms0[8], ms1[8], vt0[4], vt1[4];
                LAS unsigned char* ra = L + ORA + pc * 4096; LAS unsigned char* lbp = L + OLB + pc * 4096;
#pragma unroll
                for (int it = 0; it < 4; ++it) {
                    const int t = 8 * th + 4 * (int)hf + it, tb = 16 * pc + t;
                    const float r0 = bflo(pr[it]), r1 = bfhi(pr[it]), k0 = bflo(pk[it]), k1 = bfhi(pk[it]), a0 = bflo(pa[it]), a1 = bfhi(pa[it]);
                    const float kv0 = k0 * kkw[0], kv1 = k1 * kkw[1]; const float ss = half_sum(kv0 * kv0 + kv1 * kv1, hf); const float rn = rsqrtf(fmaxf(ss, 1e-24f));
                    const float kk0 = kv0 * rn, kk1 = kv1 * rn;
                    const float kp0 = k0 * (1.f + (a0 - 1.f) * kaw[0]), kp1 = k1 * (1.f + (a1 - 1.f) * kaw[1]);
                    const float bon = half_sum(r0 * kp0 * rkw[0] + r1 * kp1 * rkw[1], hf);
                    const float lp0 = -(base0 + (it ? pl0[it ? it - 1 : 0] : 0.f)), lp1 = -(base1 + (it ? pl1[it ? it - 1 : 0] : 0.f)), lc0 = -(base0 + pl0[it]), lc1 = -(base1 + pl1[it]);
                    const float ea0 = __expf(lp0), ea1 = __expf(lp1), eb0 = __expf(lc0), eb1 = __expf(lc1), ei0 = __expf(-lc0), ei1 = __expf(-lc1);
                    const float bt0 = kk0 * a0 * ei0, bt1 = kk1 * a1 * ei1, kt0 = kp0 * ei0, kt1 = kp1 * ei1;
                    *(LAS unsigned*)(ra + off_r(t, pj >> 3) + 2 * (pj & 7)) = pkc(-kk0 * ea0, -kk1 * ea1); *(LAS unsigned*)(ra + off_r(16 + t, pj >> 3) + 2 * (pj & 7)) = pkc(r0 * eb0, r1 * eb1);
                    *(LAS unsigned*)(lbp + off_r(t, pj >> 3) + 2 * (pj & 7)) = pkc(bt0, bt1); *(LAS unsigned*)(lbp + off_r(16 + t, pj >> 3) + 2 * (pj & 7)) = pkc(kt0, kt1);
                    ms0[it] = bt0; ms0[4 + it] = kt0; ms1[it] = bt1; ms1[4 + it] = kt1; vt0[it] = bflo(pv[it]); vt1[it] = bfhi(pv[it]);
                    *(LAS f32x2*)(L + OVF + (tb * 64 + 2 * cp) * 4) = (f32x2){bflo(pv[it]), bfhi(pv[it])}; *(LAS f32x2*)(L + OGG + (tb * 64 + 2 * cp) * 4) = (f32x2){bflo(pg[it]), bfhi(pg[it])};
                    if (cp == 0) *(LAS float*)(L + OBON + tb * 4) = bon;
                    if (it == 3 && th && hf) *(LAS f32x2*)(L + OGC + pc * 256 + 2 * cp * 4) = (f32x2){eb0, eb1};
                }
                { u32x4 m0, m1; m0.x = pkc(ms0[0], ms0[1]); m0.y = pkc(ms0[2], ms0[3]); m0.z = pkc(ms0[4], ms0[5]); m0.w = pkc(ms0[6], ms0[7]); m1.x = pkc(ms1[0], ms1[1]); m1.y = pkc(ms1[2], ms1[3]); m1.z = pkc(ms1[4], ms1[5]); m1.w = pkc(ms1[6], ms1[7]);
                  *(LAS u32x4*)(L + OMS + pc * 4096 + off_m(2 * cp, 2 * th + (unsigned)hf)) = m0; *(LAS u32x4*)(L + OMS + pc * 4096 + off_m(2 * cp + 1, 2 * th + (unsigned)hf)) = m1;
                  u32x2 w0, w1; w0.x = pkc(vt0[0], vt0[1]); w0.y = pkc(vt0[2], vt0[3]); w1.x = pkc(vt1[0], vt1[1]); w1.y = pkc(vt1[2], vt1[3]);
                  *(LAS u32x2*)(L + OVT + pc * 2048 + (2 * cp) * 32 + (8 * th + 4 * (unsigned)hf) * 2) = w0; *(LAS u32x2*)(L + OVT + pc * 2048 + (2 * cp + 1) * 32 + (8 * th + 4 * (unsigned)hf) * 2) = w1; }
            }
            if (t0 + 64 < SEQ) RW_LOAD(t0 + 64);
            LDS_BAR();
            SP_MARK(1);
            if (w < 4) {
                {
                    const int c = w;
                    f32x4 g00 = (f32x4){0.f, 0.f, 0.f, 0.f}, g01 = g00, g10 = g00, g11 = g00;
#pragma unroll
                    for (int ks = 0; ks < 2; ++ks) {
                        const bf16x8 a0 = *(const LAS bf16x8*)(L + OLB + c * 4096 + off_r(l15, 4 * ks + q)), a1 = *(const LAS bf16x8*)(L + OLB + c * 4096 + off_r(16 + l15, 4 * ks + q));
                        const bf16x8 b0 = *(const LAS bf16x8*)(L + ORA + c * 4096 + off_r(l15, 4 * ks + q)), b1 = *(const LAS bf16x8*)(L + ORA + c * 4096 + off_r(16 + l15, 4 * ks + q));
                        g00 = MFMA16(a0, b0, g00); g01 = MFMA16(a0, b1, g01); g10 = MFMA16(a1, b0, g10); g11 = MFMA16(a1, b1, g11);
                    }
                    f32x4 ab, ak; float br[4], kr[4];
#pragma unroll
                    for (int g = 0; g < 4; ++g) { const bool lt = (4 * q + g) < l15, le = (4 * q + g) <= l15; ab[g] = lt ? g00[g] : 0.f; ak[g] = lt ? g10[g] : 0.f; br[g] = le ? g01[g] : 0.f; kr[g] = le ? g11[g] : 0.f; }
                    *(LAS f32x4*)(L + OAB + c * 1024 + (l15 * 16 + 4 * q) * 4) = ab; *(LAS f32x4*)(L + OAK + c * 1024 + (l15 * 16 + 4 * q) * 4) = ak;
                    u32x4 yw; yw.x = pkc(br[0], br[1]); yw.y = pkc(br[2], br[3]); yw.z = pkc(kr[0], kr[1]); yw.w = pkc(kr[2], kr[3]);
                    *(LAS u32x4*)(L + OMY + c * 1024 + off_m(l15, q)) = yw;
                    if (lane < 32) {
                        float row[16];
#pragma unroll
                        for (int t = 0; t < 16; ++t) {
                            const LAS f32x4* abr = (const LAS f32x4*)(L + OAB + c * 1024 + t * 64);
                            const f32x4 x0 = abr[0], x1 = abr[1], x2 = abr[2], x3 = abr[3];
                            const float abv[16] = {x0[0], x0[1], x0[2], x0[3], x1[0], x1[1], x1[2], x1[3], x2[0], x2[1], x2[2], x2[3], x3[0], x3[1], x3[2], x3[3]};
                            float acc1 = (lane < 16) ? ((lane == t) ? 1.f : 0.f) : *(const LAS float*)(L + OAK + c * 1024 + (t * 16 + (lane & 15)) * 4);
#pragma unroll
                            for (int s_ = 0; s_ < t; ++s_) acc1 += row[s_] * abv[s_];
                            row[t] = acc1;
                        }
                        const unsigned pp = (lane < 16) ? (8u * (lane >> 2) + (lane & 3)) : (8u * ((lane & 15) >> 2) + 4u + (lane & 3));
#pragma unroll
                        for (int t = 0; t < 16; ++t) *(LAS bf16_t*)(L + OMU + c * 1024 + off_m(t, pp >> 3) + 2 * (pp & 7)) = (bf16_t)(pkc(row[t], 0.f) & 0xffffu);
                    }
                }
            }
            LDS_BAR();
            SP_MARK(2);
            if (w < 4) {
#pragma unroll 1
                for (int c = 0; c < 4; ++c) {
                    bf16x8 Sb0, Sb1;
                    { u32x4 t0_; t0_.x = pkc(St[0][0], St[0][1]); t0_.y = pkc(St[0][2], St[0][3]); t0_.z = pkc(St[1][0], St[1][1]); t0_.w = pkc(St[1][2], St[1][3]); Sb0 = __builtin_bit_cast(bf16x8, t0_);
                      u32x4 t1_; t1_.x = pkc(St[2][0], St[2][1]); t1_.y = pkc(St[2][2], St[2][3]); t1_.z = pkc(St[3][0], St[3][1]); t1_.w = pkc(St[3][2], St[3][3]); Sb1 = __builtin_bit_cast(bf16x8, t1_); }
                    f32x4 Za = (f32x4){0.f, 0.f, 0.f, 0.f}, Zr = Za;
                    Za = MFMA16(*(const LAS bf16x8*)(L + ORA + c * 4096 + off_r(l15, q)), Sb0, Za); Za = MFMA16(*(const LAS bf16x8*)(L + ORA + c * 4096 + off_r(l15, 4 + q)), Sb1, Za);
                    Zr = MFMA16(*(const LAS bf16x8*)(L + ORA + c * 4096 + off_r(16 + l15, q)), Sb0, Zr); Zr = MFMA16(*(const LAS bf16x8*)(L + ORA + c * 4096 + off_r(16 + l15, 4 + q)), Sb1, Zr);
                    const u32x2 vt = *(const LAS u32x2*)(L + OVT + c * 2048 + (16 * w + l15) * 32 + 8 * q);
                    u32x4 bu; bu.x = pkc(Za[0], Za[1]); bu.y = pkc(Za[2], Za[3]); bu.z = vt.x; bu.w = vt.y;
                    f32x4 U = (f32x4){0.f, 0.f, 0.f, 0.f};
                    U = MFMA16(*(const LAS bf16x8*)(L + OMU + c * 1024 + off_m(l15, q)), __builtin_bit_cast(bf16x8, bu), U);
                    u32x4 by; by.x = pkc(U[0], U[1]); by.y = pkc(U[2], U[3]); by.z = vt.x; by.w = vt.y;
                    const bf16x8 By = __builtin_bit_cast(bf16x8, by);
                    const f32x4 Yt = MFMA16(*(const LAS bf16x8*)(L + OMY + c * 1024 + off_m(l15, q)), By, Zr);
#pragma unroll
                    for (int mt = 0; mt < 4; ++mt) { St[mt] = MFMA16(*(const LAS bf16x8*)(L + OMS + c * 4096 + off_m(16 * mt + l15, q)), By, St[mt]);
                        const f32x4 gc = *(const LAS f32x4*)(L + OGC + c * 256 + (16 * mt + 4 * q) * 4); St[mt] = St[mt] * gc; }
#pragma unroll
                    for (int g = 0; g < 4; ++g) *(LAS float*)(L + OYS + ((16 * c + 4 * q + g) * 64 + 16 * w + l15) * 4) = Yt[g];
                }
            }
            LDS_BAR();
            SP_MARK(3);
            bf16_t* ob_ = rbuf + ((size_t)b * SEQ + t0 + w) * DM + hd * 64;
#pragma unroll
            for (int iq = 0; iq < 4; ++iq) { const int tq = 2 * iq + (int)hf, t = w + 8 * tq; const int li = t * 64 + 2 * (int)cp;
                const f32x2 y = *(const LAS f32x2*)(L + OYS + li * 4); const float mean = half_sum(y[0] + y[1], hf) * (1.f / 64.f); const float d0 = y[0] - mean, d1 = y[1] - mean;
                const float rs = rsqrtf(half_sum(d0 * d0 + d1 * d1, hf) * (1.f / 64.f) + 64e-5f);
                const f32x2 vv = *(const LAS f32x2*)(L + OVF + li * 4), gg = *(const LAS f32x2*)(L + OGG + li * 4); const float bo = *(const LAS float*)(L + OBON + t * 4);
                const float o0 = (d0 * rs * lw[0] + lb[0] + bo * vv[0]) * gg[0], o1 = (d1 * rs * lw[1] + lb[1] + bo * vv[1]) * gg[1];
                *(unsigned*)(ob_ + (unsigned)(8 * tq * DM + 2 * (int)cp)) = pkc(o0, o1); }
        }
#undef RW_LOAD
    }
}

__global__ void __launch_bounds__(NTHREADS, 2) mega_fwd(Params p) {
    extern __shared__ __attribute__((aligned(16))) unsigned char lds_raw[];
    Frame F;
    F.lds = (LAS unsigned char*)lds_raw;
    F.tid = threadIdx.x; F.lane = F.tid & 63; F.wave = __builtin_amdgcn_readfirstlane(F.tid >> 6); F.G = gridDim.x; F.bid = blockIdx.x;
    F.out = p.out; F.ws = p.ws;
    volatile LAS unsigned* misc = (volatile LAS unsigned*)(F.lds + LDS_MISC);
    if (F.tid < 32) misc[F.tid] = 0u;
    __syncthreads();
    const int lo = p.ph_lo, hi = p.ph_hi;
    XcdBarrier bar; bar.bar = (unsigned*)(F.ws + WS_CTL); bar.x = 0; bar.st = misc;
    if (hi - lo > 1) bar = xcd_barrier_post((unsigned*)(F.ws + WS_CTL), misc);
#define IN(k) (lo <= (k) && (k) < hi)
#if PROBE_MASK
    unsigned long long pr_t0 = 0ull, pr_acc = 0ull;
#define PSTART(k) do { if ((PROBE_MASK >> (k)) & 1u) pr_t0 = wall_clock64(); } while (0)
#define PEND(k) do { if ((PROBE_MASK >> (k)) & 1u) pr_acc += wall_clock64() - pr_t0; } while (0)
#else
#define PSTART(k) do {} while (0)
#define PEND(k) do {} while (0)
#endif
#if PROBE_SUB == 11
#define SEAM(k) do { if (IN(k) && IN((k) + 1)) { unsigned long long b0_ = 0ull; if (F.tid == 0) b0_ = wall_clock64(); xcd_barrier(bar); if (F.tid == 0) *(LAS unsigned long long*)(F.lds + LDS_MISC + 64) += wall_clock64() - b0_; } PEND(k); PSTART((k) + 1); } while (0)
#else
#define SEAM(k) do { if (IN(k) && IN((k) + 1)) xcd_barrier(bar); PEND(k); PSTART((k) + 1); } while (0)
#endif
    bf16_t* wb = WSP(bf16_t, WS_WB);
    bf16_t* S0 = WSP(bf16_t, WS_SLAB); bf16_t* S2 = WSP(bf16_t, WS_SLAB + 2 * SLAB); bf16_t* S3 = WSP(bf16_t, WS_SLAB + 3 * SLAB); bf16_t* S4 = WSP(bf16_t, WS_SLAB + 4 * SLAB); bf16_t* S5 = WSP(bf16_t, WS_SLAB + 5 * SLAB);
    bf16_t* EH = WSP(bf16_t, WS_E);
    bf16_t* O0 = (bf16_t*)F.out; bf16_t* O1 = O0 + (size_t)T_TOK * DM;
    bf16_t* hres = (bf16_t*)F.out;
    bf16_t* S1 = WSP(bf16_t, WS_SLAB + 1 * SLAB);
    const int vcu = (F.G % 8 == 0) ? F.bid : F.bid;

    PSTART(0);
    if (IN(0)) { phase_prep(p, F, 0, PT_WIN, true); phase_rmsnorm<true>(p, F, p.in[0], p.in[1], O0); } SEAM(0);
    if (IN(2)) { DenseP<EK_INPROJ> P{}; P.pid = 2; P.v0 = (const float*)(F.ws + WS_ROPE); P.K = 1024; P.lda = 1024; P.ldb = 1024; P.nM = 256; P.nN = NPROJ / 256; P.nprob = 1; P.G = F.G; P.c = vcu; P.A = O0; P.a_stride = 0; P.B = wb + WB_WIN / 2; P.b_stride = 0;
        P.O = S0; P.o_stride = 0; P.ldc = NPROJ; gemm_phase(F.lds, P); } SEAM(2);
    if (IN(3)) { phase_conv(p, F); } SEAM(3);
    if (IN(4)) { phase_scan0(p, F); } SEAM(4);
    if (IN(5)) { phase_prep(p, F, PT_WIN, PT_WOUT, false); phase_gatenorm(p, F); } SEAM(5);
    if (IN(6)) { DenseP<EK_F32RES> P{}; P.pid = 6; P.K = 2048; P.lda = NPROJ; P.ldb = 2048; P.nM = 256; P.nN = 4; P.nprob = 1; P.G = F.G; P.c = vcu; P.A = S0; P.B = wb + WB_WOUT / 2; P.resf = p.in[0]; P.resb = nullptr; P.Ob = hres; P.ldc = 1024; gemm_phase(F.lds, P); } SEAM(6);
#define MOE_LAYER(L, k0) \
    if (IN(k0)) { phase_prep(p, F, PT_L2 + (L) * 4096, PT_L2 + (L) * 4096 + 4096, false); phase_prep(p, F, PT_W13 + (L) * 2048, PT_W13 + (L) * 2048 + 2048, false); phase_moe_route(p, F, L, hres, S2); } SEAM(k0); \
    if (IN(k0 + 1)) { phase_moe_slots(p, F, L); } SEAM(k0 + 1); \
    if (IN(k0 + 2)) { unsigned char* meta = F.ws + WS_META + (size_t)(L) * META_STRIDE; Moe1P P{}; P.pid = (k0) + 2; P.K = 1024; P.lda = 1024; P.ldb = 1024; P.G = F.G; P.c = vcu; \
        P.ntiles = __builtin_amdgcn_readfirstlane(ld_vec_i32((const int*)(meta + MT_TILE))); P.A = S2; P.W13 = wb + WB_W13 / 2 + (size_t)(L) * 16 * 1048576; P.H = S3; \
        P.slot_tok = (const int*)(meta + MT_STOK); P.slot_c = (const float*)(meta + MT_SC); P.tile_bkt = (const int*)(meta + MT_TILE) + 64; gemm_phase(F.lds, P); } SEAM(k0 + 2); \
    if (IN(k0 + 3)) { unsigned char* meta = F.ws + WS_META + (size_t)(L) * META_STRIDE; Moe2P P{}; P.pid = (k0) + 3; P.K = 1024; P.lda = 1024; P.ldb = 512; P.G = F.G; P.c = vcu; \
        P.ntiles = __builtin_amdgcn_readfirstlane(ld_vec_i32((const int*)(meta + MT_TILE))); P.H = S3; P.W2 = wb + WB_W2 / 2 + (size_t)(L) * 16 * 524288; P.hsrc = hres; P.hdst = ((L) == 1) ? S0 : hres; \
        P.slot_tok = (const int*)(meta + MT_STOK); P.tile_bkt = (const int*)(meta + MT_TILE) + 64; gemm_phase(F.lds, P); } SEAM(k0 + 3);
    MOE_LAYER(0, 7)
    if (IN(11)) { phase_prep(p, F, PT_WOUT, PT_L2, false); phase_mix5(p, F, hres, S0, S1, S2, S3, S4); } SEAM(11);
    if (IN(12)) { DenseP<EK_LORA1> P{}; P.pid = 12; P.K = 2048; P.lda = 1024; P.ldb = 2048; P.nM = 256; P.nN = 2; P.nprob = 1; P.G = F.G; P.c = vcu; P.A = S0; P.a_split = 16; P.a_jump = (long)((const char*)S1 - (const char*)S0) - 16 * (BK * 2);
        P.B = wb + WB_L1 / 2; P.O = EH; P.ldc = 512; gemm_phase(F.lds, P); } SEAM(12);
    if (IN(14)) { DenseP<EK_BF16> P{}; P.pid = 14; P.K = 1024; P.lda = 1024; P.ldb = 1024; P.nM = 256; P.nN = 4; P.nprob = 3; P.G = F.G; P.c = vcu; P.ldc = 1024; P.A = S2; P.a_stride = (size_t)T_TOK * DM; P.B = wb + WB_WR / 2; P.b_stride = 1048576;
        P.O = S5; P.Oalt1 = S0; P.Oalt2 = S1; gemm_phase(F.lds, P); } SEAM(14);
    if (IN(15)) { DenseP<EK_LORA2> P{}; P.pid = 15; P.K = 256; P.lda = 512; P.ldb = 256; P.nM = 256; P.nN = 4; P.nprob = 3; P.G = F.G; P.c = vcu; P.A = EH; P.Aalt1 = EH; P.Aalt2 = EH + 128; P.B = wb + WB_L2 / 2; P.b_stride = 262144;
        P.O = S2; P.o_stride = (size_t)T_TOK * DM; P.ldc = 1024; P.v0 = p.in[17]; P.v1 = p.in[20]; gemm_phase(F.lds, P); } SEAM(15);
    if (IN(16)) { phase_rwkv(p, F, S5, S0, S1, S2, S3, S4); } SEAM(16);
    if (IN(17)) { DenseP<EK_F32RES> P{}; P.pid = 17; P.K = 1024; P.lda = 1024; P.ldb = 1024; P.nM = 256; P.nN = 4; P.nprob = 1; P.G = F.G; P.c = vcu; P.A = S5; P.B = wb + WB_WO / 2; P.resf = nullptr; P.resb = hres; P.Ob = hres; P.ldc = 1024; gemm_phase(F.lds, P); } SEAM(17);
    MOE_LAYER(1, 18)
    if (IN(22)) { phase_rmsnorm<false, true>(p, F, S0, p.in[3], F.out); }
#if PROBE_SUB
    if (F.bid == 0 && F.tid == 0) { const unsigned long long d_ = *(LAS unsigned long long*)(F.lds + LDS_MISC + 64); const unsigned long long t = wall_clock64(); while (wall_clock64() - t < d_) __builtin_amdgcn_s_sleep(8); }
#endif
#if PROBE_MASK
    PEND(22);
    if (F.bid == 0 && F.tid == 0) { const unsigned long long t = wall_clock64(); while (wall_clock64() - t < pr_acc) __builtin_amdgcn_s_sleep(8); }
#endif
}

extern "C" void kernel_launch(void* const* d_in, const int* in_sizes, int n_in, void* d_out, int out_size, void* d_ws, size_t ws_size, hipStream_t stream) {
    static int grid = 0;
    if (grid == 0) {
        if (n_in != 37 || out_size != T_TOK * DM || ws_size < WS_END) { fprintf(stderr, "kernel_launch: unexpected shapes (n_in %d out %d ws %zu)\n", n_in, out_size, ws_size); grid = -1; return; }
        int dev = 0, cus = 0, per_cu = 0;
        if (hipGetDevice(&dev) != hipSuccess || hipDeviceGetAttribute(&cus, hipDeviceAttributeMultiprocessorCount, dev) != hipSuccess) { grid = -1; return; }
        if (hipFuncSetAttribute((const void*)mega_fwd, hipFuncAttributeMaxDynamicSharedMemorySize, LDS_BYTES) != hipSuccess) { fprintf(stderr, "kernel_launch: hipFuncSetAttribute failed\n"); grid = -1; return; }
        if (hipOccupancyMaxActiveBlocksPerMultiprocessor(&per_cu, (const void*)mega_fwd, NTHREADS, LDS_BYTES) != hipSuccess || per_cu < 1) fprintf(stderr, "kernel_launch: occupancy query says %d\n", per_cu);
        (void)hipGetLastError();
        grid = cus;
        if (grid < 128 || grid > 512) { fprintf(stderr, "kernel_launch: built for 128..512 CUs (the MoE router keeps <= 512 tokens per workgroup in LDS); got %d\n", grid); grid = -1; return; }
    }
    if (grid < 0) return;
    (void)in_sizes;
    hipMemsetAsync((char*)d_ws + WS_CTL, 0, CTL_ZERO_BYTES, stream);
    Params p{};
    for (int i = 0; i < 37; ++i) p.in[i] = (const float*)d_in[i];
    p.out = (float*)d_out; p.ws = (unsigned char*)d_ws;
#if MK_PER_PHASE
    for (int k = 0; k < NPHASE; ++k) { p.ph_lo = k; p.ph_hi = k + 1; hipLaunchKernelGGL(mega_fwd, dim3(grid), dim3(NTHREADS), LDS_BYTES, stream, p); }
#else
    p.ph_lo = 0; p.ph_hi = NPHASE; hipLaunchKernelGGL(mega_fwd, dim3(grid), dim3(NTHREADS), LDS_BYTES, stream, p);
#endif
}
```

```cpp
#include <hip/hip_runtime.h>
#include <stdint.h>
#include <stdio.h>

#ifndef MK_PER_PHASE
#define MK_PER_PHASE 0
#endif

#ifndef PROBE_MASK
#define PROBE_MASK 0u
#endif
#ifndef PROBE_PID
#define PROBE_PID -1
#endif
#ifndef PROBE_SUB
#define PROBE_SUB 0
#endif
#define LAS __attribute__((address_space(3)))
typedef unsigned short bf16_t;
typedef short bf16x8 __attribute__((ext_vector_type(8)));
typedef float f32x4 __attribute__((ext_vector_type(4)));
typedef float f32x2 __attribute__((ext_vector_type(2)));
typedef unsigned u32x4 __attribute__((ext_vector_type(4)));
typedef unsigned u32x2 __attribute__((ext_vector_type(2)));

constexpr int T_TOK = 65536, DM = 1024, SEQ = 4096;
constexpr int NPROJ = 5888;
constexpr int PC_Z = 0, PC_XBC = 1024, PC_Q = 2560, PC_K = 3072, PC_V = 3584, PC_G = 4608, PC_DT = 5632;
constexpr int NTHREADS = 512;
constexpr int LDS_BYTES = 147456;
constexpr int LDS_MISC = LDS_BYTES - 256;
constexpr int NSLOT = T_TOK + 24 * 256;
constexpr int NPHASE = 23;
constexpr int PT_WIN = 1472, PT_WOUT = PT_WIN + 512, PT_RW = PT_WOUT + 1024, PT_L1 = PT_RW + 256, PT_L2 = PT_L1 + 192, PT_W13 = PT_L2 + 8192, PT_W2 = PT_W13 + 4096;
#if PROBE_SUB
#define SP_DECL unsigned long long sp_t_ = wall_clock64()
#define SP_MARK(id_end) do { if (F.tid == 0) { const unsigned long long n_ = wall_clock64(); if ((id_end) == PROBE_SUB) *(LAS unsigned long long*)(F.lds + LDS_MISC + 64) += n_ - sp_t_; sp_t_ = n_; } } while (0)
#else
#define SP_DECL do {} while (0)
#define SP_MARK(id_end) do {} while (0)
#endif

constexpr size_t MiB = 1024 * 1024;
constexpr size_t WS_CTL = 0;
constexpr size_t CTL_ZERO_BYTES = 16384;
constexpr size_t CTL_CNT_OFF = 14336;
constexpr size_t WS_META = 64 * 1024;
constexpr size_t META_STRIDE = 2 * MiB - 32 * 1024;
constexpr size_t MT_RANK = 0, MT_BKT = 262144, MT_C = 524288, MT_STOK = 1048576, MT_SC = 1048576 + 294912, MT_TILE = 1048576 + 294912 + 589824;
constexpr size_t WS_ROPE = 4 * MiB;
constexpr size_t WS_WB = 6 * MiB;
constexpr size_t WB_WIN = 0, WB_WOUT = WB_WIN + (size_t)NPROJ * 1024 * 2, WB_WR = WB_WOUT + (size_t)1024 * 2048 * 2, WB_WK = WB_WR + 2 * MiB, WB_WV = WB_WK + 2 * MiB, WB_WO = WB_WV + 2 * MiB,
                 WB_L1 = WB_WO + 2 * MiB  , WB_L2 = WB_L1 + 2 * MiB  , WB_W13 = WB_L2 + 3 * 512 * 1024  ,
                 WB_W2 = WB_W13 + (size_t)32 * 2 * MiB  , WB_END = WB_W2 + (size_t)32 * MiB;
constexpr size_t WS_SLAB = 130 * MiB;
constexpr size_t SLAB = 128 * MiB;
constexpr size_t WS_E = WS_SLAB + 6 * SLAB;
constexpr size_t WS_END = WS_E + 96 * MiB;
constexpr size_t WS_RTW = WS_WB + WB_END;
static_assert(WS_RTW + 2 * 20 * 1024 * 4 <= WS_SLAB, "weights overflow");
static_assert(WS_END <= 1024 * MiB, "workspace overflow");

struct Params {
    const float* in[37];
    float* out;
    unsigned char* ws;
    int ph_lo, ph_hi;
};

__device__ __forceinline__ float bf2f(bf16_t v) { return __uint_as_float(((unsigned)v) << 16); }
__device__ __forceinline__ float bflo(unsigned w) { return __uint_as_float(w << 16); }
__device__ __forceinline__ float bfhi(unsigned w) { return __uint_as_float(w & 0xffff0000u); }
__device__ __forceinline__ unsigned cvt_pk_bf16(float lo, float hi) { unsigned r; asm volatile("v_cvt_pk_bf16_f32 %0, %1, %2" : "=v"(r) : "v"(lo), "v"(hi)); return r; }
__device__ __forceinline__ bf16_t f2bf(float f) { return (bf16_t)(cvt_pk_bf16(f, 0.f) & 0xffffu); }
__device__ __forceinline__ float wave_sum(float v) {
#pragma unroll
    for (int o = 32; o >= 1; o >>= 1) v += __shfl_xor(v, o);
    return v;
}
__device__ __forceinline__ float dpp_sum16(float x) {
    x += __builtin_bit_cast(float, __builtin_amdgcn_update_dpp(0, __builtin_bit_cast(int, x), 0xB1, 0xF, 0xF, true));
    x += __builtin_bit_cast(float, __builtin_amdgcn_update_dpp(0, __builtin_bit_cast(int, x), 0x4E, 0xF, 0xF, true));
    x += __builtin_bit_cast(float, __builtin_amdgcn_update_dpp(0, __builtin_bit_cast(int, x), 0x141, 0xF, 0xF, true));
    x += __builtin_bit_cast(float, __builtin_amdgcn_update_dpp(0, __builtin_bit_cast(int, x), 0x140, 0xF, 0xF, true));
    return x;
}
__device__ __forceinline__ float wave_sum_u(float x) {
    x = dpp_sum16(x);
    x += __builtin_bit_cast(float, __builtin_amdgcn_update_dpp(0, __builtin_bit_cast(int, x), 0x142, 0xA, 0xF, false));
    x += __builtin_bit_cast(float, __builtin_amdgcn_update_dpp(0, __builtin_bit_cast(int, x), 0x143, 0xC, 0xF, false));
    return __builtin_bit_cast(float, __builtin_amdgcn_readlane(__builtin_bit_cast(int, x), 63));
}
__device__ __forceinline__ float fsilu(float x) { return x * __builtin_amdgcn_rcpf(1.f + __expf(-x)); }
__device__ __forceinline__ float fsigmoid(float x) { return __builtin_amdgcn_rcpf(1.f + __expf(-x)); }
__device__ __forceinline__ float fsoftplus(float x) { return x > 20.f ? x : log1pf(__expf(x)); }
__device__ __forceinline__ float ftanh(float x) { const float xc = fminf(fmaxf(x, -15.f), 15.f); const float e = __expf(2.f * xc); return (e - 1.f) * __builtin_amdgcn_rcpf(e + 1.f); }
__device__ __forceinline__ int ld_vec_i32(const int* p) { int r; asm volatile("global_load_dword %0, %1, off\n\ts_waitcnt vmcnt(0)" : "=&v"(r) : "v"(p) : "memory"); return r; }

#define XB_TMO      128
#define XB_XCNT(j)  (256  + 64 * (j))
#define XB_XSUB(j)  (1280 + 64 * (j))
#define XB_XGEN(j)  (2304 + 64 * (j))
#define XB_TOP      3328
#define XB_TOPGEN   3392
#define XCD_BAR_WORDS 3456
#define XB_SPIN_CAP (1u << 24)
__device__ __forceinline__ unsigned xb_ld(unsigned* p)              { return __hip_atomic_load(p, __ATOMIC_RELAXED, __HIP_MEMORY_SCOPE_AGENT); }
__device__ __forceinline__ unsigned xb_add(unsigned* p, unsigned v) { return __hip_atomic_fetch_add(p, v, __ATOMIC_RELAXED, __HIP_MEMORY_SCOPE_AGENT); }
__device__ __forceinline__ unsigned xb_xcc_id() { return (unsigned)__builtin_amdgcn_s_getreg((3 << 11) | 20) & 0xFu; }
#define XB_SPIN(cond, bar) do { unsigned _sp = 0; while (cond) { __builtin_amdgcn_s_sleep(1); \
    if ((++_sp & 255u) == 0u) { if (xb_ld(&(bar)[XB_TMO])) break; if (_sp > XB_SPIN_CAP) { atomicAdd(&(bar)[XB_TMO], 1u); break; } } } } while (0)
struct XcdBarrier { unsigned* bar; unsigned x; volatile LAS unsigned* st; };
__device__ __forceinline__ XcdBarrier xcd_barrier_post(unsigned* bar, volatile LAS unsigned* st) {
    XcdBarrier b; b.bar = bar; b.x = xb_xcc_id(); b.st = st;
    if (threadIdx.x == 0) (void)xb_add(&bar[XB_XCNT(b.x)], 1u);
    return b;
}
__device__ __forceinline__ void xcd_barrier_complete(unsigned* bar, unsigned x, unsigned& nloc, unsigned& nx) {
    const unsigned G = gridDim.x * gridDim.y * gridDim.z;
    unsigned sum, cnt, mine, sp = 0u;
    for (;;) {
        sum = 0u; cnt = 0u; mine = 0u;
#pragma unroll
        for (unsigned j = 0; j < 16; ++j) { const unsigned c = xb_ld(&bar[XB_XCNT(j)]); sum += c; cnt += (c > 0u) ? 1u : 0u; mine = (j == x) ? c : mine; }
        if (sum == G) break;
        __builtin_amdgcn_s_sleep(1);
        if ((++sp & 255u) == 0u) { if (xb_ld(&bar[XB_TMO])) break; if (sp > XB_SPIN_CAP) { atomicAdd(&bar[XB_TMO], 1u); break; } }
    }
    nloc = mine > 0u ? mine : 1u; nx = cnt > 0u ? cnt : 1u;
}
__device__ __forceinline__ void xcd_barrier(const XcdBarrier& b) {
    asm volatile("s_waitcnt vmcnt(0)" ::: "memory");
    __syncthreads();
    if (threadIdx.x == 0) {
        unsigned* bar = b.bar;
        __builtin_amdgcn_s_waitcnt(0);
        unsigned nloc = b.st[0], nx = b.st[1];
        if (nloc == 0u) { xcd_barrier_complete(bar, b.x, nloc, nx); b.st[0] = nloc; b.st[1] = nx; }
        const unsigned old = xb_add(&bar[XB_XSUB(b.x)], 1u);
        const unsigned gen = old / nloc;
        if (old + 1u == (gen + 1u) * nloc) {
            __builtin_amdgcn_fence(__ATOMIC_RELEASE, "agent");
            asm volatile("s_waitcnt vmcnt(0)" ::: "memory");
            const unsigned og = xb_add(&bar[XB_TOP], 1u);
            const unsigned tg = og / nx;
            if (og + 1u == (tg + 1u) * nx) xb_add(&bar[XB_TOPGEN], 1u);
            else XB_SPIN(xb_ld(&bar[XB_TOPGEN]) == tg, bar);
            __builtin_amdgcn_fence(__ATOMIC_ACQUIRE, "agent");
            xb_add(&bar[XB_XGEN(b.x)], 1u);
            asm volatile("s_waitcnt vmcnt(0)" ::: "memory");
        } else {
            XB_SPIN(xb_ld(&bar[XB_XGEN(b.x)]) == gen, bar);
            __builtin_amdgcn_fence(__ATOMIC_ACQUIRE, "agent");
            asm volatile("s_waitcnt vmcnt(0)" ::: "memory");
        }
    }
    __syncthreads();
}

constexpr int BM = 256, BK = 64, HALF = 128, HTB = HALF * BK * 2, STAGE_BYTES = 8 * HTB;
__device__ __forceinline__ int lds_byte(int r, int c) { const int st = (r >> 4) * 2 + (c >> 5), rr = r & 15, cc = c & 31, ob = rr * 64 + cc * 2; return st * 1024 + (ob ^ (((ob >> 9) & 1) << 5)); }
__device__ __forceinline__ void stage_rc(int b, int& R, int& C) { const int st = b / 1024, sb = b % 1024, swz = sb ^ (((sb >> 9) & 1) << 5); R = (st >> 1) * 16 + swz / 64; C = (st & 1) * 32 + (swz % 64) / 2; }
__device__ __forceinline__ int perm32(int rho) { const int n = rho >> 4, i = rho & 15; return 8 * (i >> 2) + 4 * n + (i & 3); }
struct Unit { int pm, pn, prob; };
__device__ __forceinline__ void tile_order(int L, int nM, int nN, int& pm, int& pn) {
    const int nwg = nM * nN; int wgid = L;
    { const int q = nwg / 8, r = nwg % 8, xcd = wgid % 8, off = wgid / 8; wgid = (xcd < r ? xcd * (q + 1) : r * (q + 1) + (xcd - r) * q) + off; }
    const int nig = 8 * nN, gid = wgid / nig, fm = gid * 8, gsz = (nM - fm) < 8 ? (nM - fm) : 8;
    pm = fm + ((wgid % nig) % gsz); pn = (wgid % nig) / gsz;
}

template <class P>
__device__ __forceinline__ void gemm_phase(LAS unsigned char* lds, const P& S) {
    const int tid = threadIdx.x, wid = __builtin_amdgcn_readfirstlane(tid >> 6), lane = tid & 63, wr = wid >> 2, wc = wid & 3, fr = lane & 15, fq = lane >> 4;
    const int K = S.K, nt = K / BK, lda = S.lda, ldb = S.ldb;
    int RA[2], CA[2]; unsigned voffB[2], vAc[2][2], vAn[2][2];
#pragma unroll
    for (int i = 0; i < 2; ++i) { int R, C; stage_rc(tid * 16 + i * 8192, R, C); RA[i] = R; CA[i] = C; const int Rb = P::PERM ? ((R & ~31) + perm32(R & 31)) : R;
        voffB[i] = (unsigned)(Rb * ldb + C) * 2u;
#pragma unroll
        for (int h = 0; h < 2; ++h) { vAc[h][i] = (unsigned)((h * HALF + R) * lda + C) * 2u; vAn[h][i] = vAc[h][i]; } }
    const size_t kstep = (size_t)(BK * 2);
    const size_t hstepB = (size_t)HALF * ldb * 2;
    const unsigned ldsw = (unsigned)wid * 1024u;
    const int aoff = lds_byte(wr * 64 + fr, fq * 8), boff = lds_byte(wc * 32 + fr, fq * 8);
#define PG8_SA(b, h) (((b) * 2 + (h)) * HTB)
#define PG8_SB(b, h) ((4 + (b) * 2 + (h)) * HTB)
#define PG8_STAGE2(bufoff, gbase, v0, v1) do { \
        __builtin_amdgcn_global_load_lds((const unsigned*)((const char*)(gbase) + (v0)), (LAS unsigned*)(lds + (bufoff) + ldsw), 16, 0, 0); \
        __builtin_amdgcn_global_load_lds((const unsigned*)((const char*)(gbase) + (v1)), (LAS unsigned*)(lds + (bufoff) + ldsw + 8192), 16, 0, 0); } while (0)
#define PG8_LDA(dst, b, h) do { _Pragma("unroll") for (int m = 0; m < 4; ++m) _Pragma("unroll") for (int k = 0; k < 2; ++k) dst[m][k] = *(const LAS bf16x8*)(lds + PG8_SA(b, h) + aoff + m * 2048 + k * 1024); } while (0)
#define PG8_LDB(dst, b, h) do { _Pragma("unroll") for (int n = 0; n < 2; ++n) _Pragma("unroll") for (int k = 0; k < 2; ++k) dst[n][k] = *(const LAS bf16x8*)(lds + PG8_SB(b, h) + boff + n * 2048 + k * 1024); } while (0)
#define PG8_MMA(ai, bj, At, Bt) do { __builtin_amdgcn_s_setprio(1); _Pragma("unroll") for (int m = 0; m < 4; ++m) _Pragma("unroll") for (int n = 0; n < 2; ++n) _Pragma("unroll") for (int k = 0; k < 2; ++k) \
        acc[ai][bj][m][n] = __builtin_amdgcn_mfma_f32_16x16x32_bf16(Bt[n][k], At[m][k], acc[ai][bj][m][n], 0, 0, 0); __builtin_amdgcn_s_setprio(0); } while (0)
#define PG8_WAIT_V(n) asm volatile("s_waitcnt vmcnt(" #n ")" ::: "memory")
#define PG8_WAIT_L(n) asm volatile("s_waitcnt lgkmcnt(" #n ")" ::: "memory")
#define PG8_BAR __builtin_amdgcn_s_barrier()
#define LDS_BAR() asm volatile("s_waitcnt lgkmcnt(0)\n\ts_barrier" ::: "memory")
#define PG8_SCHED __builtin_amdgcn_sched_barrier(0)
    Unit cur, nxt; int ui = 0;
    if (!S.next(0, cur)) return;
    struct { int tid; LAS unsigned char* lds; } F; F.tid = tid; F.lds = lds; (void)F;
    SP_DECL;
    if constexpr (P::GATHER) {
#pragma unroll
        for (int h = 0; h < 2; ++h)
#pragma unroll
            for (int i = 0; i < 2; ++i) vAc[h][i] = S.a_voff(cur, h * HALF + RA[i], CA[i]);
    }
    float zf; asm volatile("v_mov_b32 %0, 0" : "=v"(zf));
    f32x4 acc[2][2][4][2];
#pragma unroll
    for (int a = 0; a < 2; ++a)
#pragma unroll
        for (int b = 0; b < 2; ++b)
#pragma unroll
            for (int m = 0; m < 4; ++m)
#pragma unroll
                for (int n = 0; n < 2; ++n) acc[a][b][m][n] = (f32x4){zf, zf, zf, zf};
    bf16x8 At[4][2], B0[2][2], B1[2][2];
    const char* cA = S.a_ptr(cur);
    {
        const char* b0 = S.b_ptr(cur, 0); const char* b1 = S.b_ptr(cur, 1);
        const char* cA0 = cA + S.a_kadj(0);
        PG8_STAGE2(PG8_SB(0, 0), b0, voffB[0], voffB[1]); PG8_STAGE2(PG8_SA(0, 0), cA0, vAc[0][0], vAc[0][1]); PG8_STAGE2(PG8_SB(0, 1), b0 + hstepB, voffB[0], voffB[1]); PG8_STAGE2(PG8_SA(0, 1), cA0, vAc[1][0], vAc[1][1]);
        if (wr == 1) PG8_BAR;
        PG8_WAIT_V(4); PG8_BAR;
        PG8_STAGE2(PG8_SB(1, 0), b1, voffB[0], voffB[1]); PG8_STAGE2(PG8_SA(1, 0), cA + kstep + S.a_kadj(1), vAc[0][0], vAc[0][1]); PG8_STAGE2(PG8_SB(1, 1), b1 + hstepB, voffB[0], voffB[1]);
        PG8_WAIT_V(6); PG8_BAR;
    }
    for (;;) {
        const bool has_next = S.next(ui + 1, nxt);
        if (!has_next) nxt = cur;
        if constexpr (P::GATHER) {
            if (has_next) {
#pragma unroll
                for (int h = 0; h < 2; ++h)
#pragma unroll
                    for (int i = 0; i < 2; ++i) vAn[h][i] = S.a_voff(nxt, h * HALF + RA[i], CA[i]);
            }
        }
        const char* nA = S.a_ptr(nxt);
        for (int t = 0; t < nt; t += 2) {
            const bool last = (t == nt - 2);
            const char* a1 = cA + (size_t)(t + 1) * kstep + S.a_kadj(t + 1);
            const char* a2 = last ? nA + S.a_kadj(0) : cA + (size_t)(t + 2) * kstep + S.a_kadj(t + 2);
            const char* a3 = last ? nA + kstep + S.a_kadj(1) : cA + (size_t)(t + 3) * kstep + S.a_kadj(t + 3);
            const char* b2 = last ? S.b_ptr(nxt, 0) : S.b_ptr(cur, t + 2);
            const char* b3 = last ? S.b_ptr(nxt, 1) : S.b_ptr(cur, t + 3);
            unsigned s00 = vAc[0][0], s01 = vAc[0][1], s10 = vAc[1][0], s11 = vAc[1][1];
            if constexpr (P::GATHER) { if (last) { s00 = vAn[0][0]; s01 = vAn[0][1]; s10 = vAn[1][0]; s11 = vAn[1][1]; } }
            PG8_LDB(B0, 0, 0); PG8_SCHED; PG8_LDA(At, 0, 0); PG8_STAGE2(PG8_SA(1, 1), a1, vAc[1][0], vAc[1][1]);
            PG8_WAIT_L(8); PG8_BAR; PG8_WAIT_L(0); PG8_MMA(0, 0, At, B0); PG8_BAR; PG8_SCHED;
            PG8_LDB(B1, 0, 1); PG8_STAGE2(PG8_SB(0, 0), b2, voffB[0], voffB[1]);
            PG8_BAR; PG8_WAIT_L(0); PG8_MMA(0, 1, At, B1); PG8_BAR;
            PG8_LDA(At, 0, 1); PG8_STAGE2(PG8_SA(0, 0), a2, s00, s01);
            PG8_BAR; PG8_WAIT_L(0); PG8_MMA(1, 0, At, B0); PG8_BAR; PG8_SCHED;
            PG8_STAGE2(PG8_SB(0, 1), b2 + hstepB, voffB[0], voffB[1]);
            PG8_WAIT_V(6); PG8_BAR; PG8_MMA(1, 1, At, B1); PG8_BAR;
            PG8_LDB(B0, 1, 0); PG8_SCHED; PG8_LDA(At, 1, 0); PG8_STAGE2(PG8_SA(0, 1), a2, s10, s11);
            PG8_WAIT_L(8); PG8_BAR; PG8_WAIT_L(0); PG8_MMA(0, 0, At, B0); PG8_BAR; PG8_SCHED;
            PG8_LDB(B1, 1, 1); PG8_STAGE2(PG8_SB(1, 0), b3, voffB[0], voffB[1]);
            PG8_BAR; PG8_WAIT_L(0); PG8_MMA(0, 1, At, B1); PG8_BAR;
            PG8_LDA(At, 1, 1); PG8_STAGE2(PG8_SA(1, 0), a3, s00, s01);
            PG8_BAR; PG8_WAIT_L(0); PG8_MMA(1, 0, At, B0); PG8_BAR; PG8_SCHED;
            PG8_STAGE2(PG8_SB(1, 1), b3 + hstepB, voffB[0], voffB[1]);
            PG8_WAIT_V(6); PG8_BAR; PG8_MMA(1, 1, At, B1); PG8_BAR;
        }
        SP_MARK((PROBE_PID < 0 || S.pid == PROBE_PID) ? 10 : -1);
        S.epi(acc, cur, wr, wc, fr, fq);
        SP_MARK((PROBE_PID < 0 || S.pid == PROBE_PID) ? 9 : -1);
        if (!has_next) break;
#pragma unroll
        for (int a = 0; a < 2; ++a)
#pragma unroll
            for (int b = 0; b < 2; ++b)
#pragma unroll
                for (int m = 0; m < 4; ++m)
#pragma unroll
                    for (int n = 0; n < 2; ++n) acc[a][b][m][n] = (f32x4){zf, zf, zf, zf};
        cur = nxt; cA = nA; ++ui;
        if constexpr (P::GATHER) {
#pragma unroll
            for (int h = 0; h < 2; ++h)
#pragma unroll
                for (int i = 0; i < 2; ++i) vAc[h][i] = vAn[h][i];
        }
    }
    PG8_WAIT_V(0);
    if (wr == 0) PG8_BAR;
    PG8_BAR;
#undef PG8_SA
#undef PG8_SB
#undef PG8_STAGE2
#undef PG8_LDA
#undef PG8_LDB
#undef PG8_MMA
#undef PG8_WAIT_V
#undef PG8_WAIT_L
#undef PG8_BAR
#undef PG8_SCHED
}

enum { EK_BF16 = 0, EK_LORA1 = 1, EK_LORA2 = 2, EK_F32RES = 3, EK_INPROJ = 4 };
template <int KIND>
struct DenseP {
    static constexpr bool PERM = true, GATHER = false;
    int K, lda, ldb, nM, nN, nprob, G, c, pid;
    const bf16_t* A; size_t a_stride;
    const bf16_t* Aalt1; const bf16_t* Aalt2;
    int a_skew;
    int a_split; long a_jump;
    const bf16_t* B; size_t b_stride;
    bf16_t* O; size_t o_stride; int ldc;
    bf16_t* Oalt1; bf16_t* Oalt2;
    const float* resf; const bf16_t* resb; bf16_t* Ob;
    const float* v0; const float* v1;
    __device__ __forceinline__ bool next(int i, Unit& u) const {
        const long L = (long)i * G + c; const int per = nM * nN; if (L >= (long)per * nprob) return false;
        u.prob = (int)(L / per); tile_order((int)(L % per), nM, nN, u.pm, u.pn); return true;
    }
    __device__ __forceinline__ const char* a_ptr(const Unit& u) const { const bf16_t* a0 = Aalt1 ? ((u.prob == 0) ? A : (u.prob == 1) ? Aalt1 : Aalt2) : A + (size_t)u.prob * a_stride; return (const char*)(a0 + ((size_t)u.pm * BM + (a_skew ? (u.pm >> 4) + 1 : 0)) * lda); }
    __device__ __forceinline__ long a_kadj(int kt) const { return (a_split > 0 && kt >= a_split) ? a_jump : 0; }
    __device__ __forceinline__ const char* b_ptr(const Unit& u, int kt) const { return (const char*)(B + (size_t)u.prob * b_stride + (size_t)u.pn * BM * ldb) + (size_t)kt * (BK * 2); }
    __device__ __forceinline__ unsigned a_voff(const Unit&, int, int) const { return 0u; }
    __device__ __forceinline__ void epi(const f32x4 (&acc)[2][2][4][2], const Unit& u, int wr, int wc, int fr, int fq) const {
        const int row0 = u.pm * BM + wr * 64 + fr;
        if constexpr (KIND == EK_F32RES) {
            const int col0 = u.pn * BM + wc * 32 + 8 * fq;
#pragma unroll
            for (int ai = 0; ai < 2; ++ai)
#pragma unroll
                for (int mp = 0; mp < 2; ++mp) {
                    f32x4 r0[2][2], r1[2][2];
#pragma unroll
                    for (int mm = 0; mm < 2; ++mm) { const size_t ro = (size_t)(row0 + ai * HALF + (mp * 2 + mm) * 16) * ldc + col0;
#pragma unroll
                        for (int bj = 0; bj < 2; ++bj) {
                            if (resf) { r0[mm][bj] = __builtin_nontemporal_load((const f32x4*)(resf + ro + bj * HALF)); r1[mm][bj] = __builtin_nontemporal_load((const f32x4*)(resf + ro + bj * HALF + 4)); }
                            else { const u32x4 rw = *(const u32x4*)(resb + ro + bj * HALF); r0[mm][bj] = (f32x4){bflo(rw.x), bfhi(rw.x), bflo(rw.y), bfhi(rw.y)}; r1[mm][bj] = (f32x4){bflo(rw.z), bfhi(rw.z), bflo(rw.w), bfhi(rw.w)}; } } }
#pragma unroll
                    for (int mm = 0; mm < 2; ++mm) { const size_t ro = (size_t)(row0 + ai * HALF + (mp * 2 + mm) * 16) * ldc + col0;
#pragma unroll
                        for (int bj = 0; bj < 2; ++bj) { const f32x4 x0 = acc[ai][bj][mp * 2 + mm][0] + r0[mm][bj], x1 = acc[ai][bj][mp * 2 + mm][1] + r1[mm][bj];
                            u32x4 w; w.x = cvt_pk_bf16(x0[0], x0[1]); w.y = cvt_pk_bf16(x0[2], x0[3]); w.z = cvt_pk_bf16(x1[0], x1[1]); w.w = cvt_pk_bf16(x1[2], x1[3]);
                            *(u32x4*)(Ob + ro + bj * HALF) = w; } }
                }
        } else {
            const int col0 = u.pn * BM + wc * 32 + 8 * fq;
            bf16_t* base = Oalt1 ? ((u.prob == 0) ? O : (u.prob == 1) ? Oalt1 : Oalt2) : O + (size_t)u.prob * o_stride;
            f32x4 bv[2][2];
#pragma unroll
            for (int bj = 0; bj < 2; ++bj)
#pragma unroll
                for (int n = 0; n < 2; ++n) {
                    if constexpr (KIND == EK_LORA2) { bv[bj][n] = (u.prob == 0) ? *(const f32x4*)(v0 + col0 + bj * HALF + 4 * n) : (u.prob == 1) ? *(const f32x4*)(v1 + col0 + bj * HALF + 4 * n) : (f32x4){0.f, 0.f, 0.f, 0.f}; }
                    else bv[bj][n] = (f32x4){0.f, 0.f, 0.f, 0.f};
                }
#pragma unroll
            for (int ai = 0; ai < 2; ++ai)
#pragma unroll
                for (int m = 0; m < 4; ++m) { bf16_t* rowp = base + (size_t)(row0 + ai * HALF + m * 16) * ldc + col0;
#pragma unroll
                    for (int bj = 0; bj < 2; ++bj) { f32x4 x0 = acc[ai][bj][m][0] + bv[bj][0], x1 = acc[ai][bj][m][1] + bv[bj][1];
                        if constexpr (KIND == EK_LORA1) {
                            const int g0 = u.pn * BM + bj * HALF + wc * 32; const float kx = (g0 < 64) ? 2.f : 1.f;
#pragma unroll
                            for (int j = 0; j < 4; ++j) { const float s0 = fsigmoid(kx * x0[j]), s1 = fsigmoid(kx * x1[j]);
                                x0[j] = (g0 < 64) ? 2.f * s0 - 1.f : (g0 >= 128) ? s0 : x0[j]; x1[j] = (g0 < 64) ? 2.f * s1 - 1.f : (g0 >= 128) ? s1 : x1[j]; } }
                        if constexpr (KIND == EK_LORA2) {
                            const float sc = (u.prob == 0) ? 0.6065306597126334f : 1.f;
#pragma unroll
                            for (int j = 0; j < 4; ++j) { const float s0 = sc * fsigmoid(x0[j]), s1 = sc * fsigmoid(x1[j]); x0[j] = (u.prob == 2) ? x0[j] : s0; x1[j] = (u.prob == 2) ? x1[j] : s1; } }
                        if constexpr (KIND == EK_INPROJ) {
                            if (u.pn >= PC_Q / 256 && u.pn < PC_V / 256) { const int pos = (row0 + ai * HALF + m * 16) & (SEQ - 1); const float sc = (u.pn >= PC_K / 256) ? 0.08838834764831845f : 1.f;
                                const f32x4 cs0 = *(const f32x4*)(v0 + ((size_t)pos * 64 + wc * 16 + 4 * fq) * 2), cs1 = *(const f32x4*)(v0 + ((size_t)pos * 64 + wc * 16 + 4 * fq + 2) * 2);
                                const f32x4 a = x0, b = x1;
                                x0[0] = (a[0] * cs0[0] - a[1] * cs0[1]) * sc; x0[1] = (a[0] * cs0[1] + a[1] * cs0[0]) * sc; x0[2] = (a[2] * cs0[2] - a[3] * cs0[3]) * sc; x0[3] = (a[2] * cs0[3] + a[3] * cs0[2]) * sc;
                                x1[0] = (b[0] * cs1[0] - b[1] * cs1[1]) * sc; x1[1] = (b[0] * cs1[1] + b[1] * cs1[0]) * sc; x1[2] = (b[2] * cs1[2] - b[3] * cs1[3]) * sc; x1[3] = (b[2] * cs1[3] + b[3] * cs1[2]) * sc; } }
                        u32x4 w; w.x = cvt_pk_bf16(x0[0], x0[1]); w.y = cvt_pk_bf16(x0[2], x0[3]); w.z = cvt_pk_bf16(x1[0], x1[1]); w.w = cvt_pk_bf16(x1[2], x1[3]);
                        *(u32x4*)(rowp + bj * HALF) = w; } }
        }
    }
};

__device__ __forceinline__ void pair_lohi(int pr, int& lo, int& hi) { lo = (pr < 3) ? 0 : (pr < 5 ? 1 : 2); hi = (pr < 3) ? pr + 1 : (pr < 5 ? pr - 1 : 3); }

struct Moe1P {
    static constexpr bool PERM = true, GATHER = true;
    int K, lda, ldb, G, c, ntiles, pid;
    const bf16_t* A; const bf16_t* W13;
    bf16_t* H; const int* slot_tok; const float* slot_c; const int* tile_bkt;
    __device__ __forceinline__ bool next(int i, Unit& u) const {
        const int m = (c >> 3) + (G >> 3) * i; if ((G & 7) != 0 || m >= ntiles) { if ((G & 7) == 0) return false; const long L = (long)i * G + c; if (L >= (long)ntiles * 8) return false; u.pm = (int)(L >> 3); u.pn = (int)(L & 7); u.prob = __builtin_amdgcn_readfirstlane(ld_vec_i32(tile_bkt + u.pm)); return true; }
        u.pm = m; u.pn = c & 7; u.prob = __builtin_amdgcn_readfirstlane(ld_vec_i32(tile_bkt + u.pm)); return true;
    }
    __device__ __forceinline__ const char* a_ptr(const Unit&) const { return (const char*)A; }
    __device__ __forceinline__ long a_kadj(int) const { return 0; }
    __device__ __forceinline__ unsigned a_voff(const Unit& u, int row, int C) const { int tok = slot_tok[u.pm * BM + row]; tok = tok < 0 ? 0 : tok; return (unsigned)(tok * lda + C) * 2u; }
    __device__ __forceinline__ const char* b_ptr(const Unit& u, int kt) const {
        int lo, hi; pair_lohi(u.prob % 6, lo, hi); const int e = (u.prob / 6) * 4 + ((u.pn < 4) ? lo : hi);
        return (const char*)(W13 + ((size_t)e * 1024 + (size_t)(u.pn & 3) * BM) * 1024) + (size_t)kt * (BK * 2);
    }
    __device__ __forceinline__ void epi(const f32x4 (&acc)[2][2][4][2], const Unit& u, int wr, int wc, int fr, int fq) const {
        const int row0 = u.pm * BM + wr * 64 + fr, col0 = ((u.pn < 4) ? 0 : 512) + (u.pn & 3) * 128 + wc * 32 + 8 * fq, ci = (u.pn < 4) ? 0 : 1;
#pragma unroll
        for (int ai = 0; ai < 2; ++ai)
#pragma unroll
            for (int m = 0; m < 4; ++m) { const int row = row0 + ai * HALF + m * 16; const float cw = slot_c[(size_t)row * 2 + ci];
                const f32x4 g0 = acc[ai][0][m][0], g1 = acc[ai][0][m][1], u0 = acc[ai][1][m][0], u1 = acc[ai][1][m][1]; f32x4 x0, x1;
#pragma unroll
                for (int j = 0; j < 4; ++j) { x0[j] = fsilu(g0[j]) * u0[j] * cw; x1[j] = fsilu(g1[j]) * u1[j] * cw; }
                u32x4 w; w.x = cvt_pk_bf16(x0[0], x0[1]); w.y = cvt_pk_bf16(x0[2], x0[3]); w.z = cvt_pk_bf16(x1[0], x1[1]); w.w = cvt_pk_bf16(x1[2], x1[3]);
                *(u32x4*)(H + (size_t)row * 1024 + col0) = w; }
    }
};
struct Moe2P {
    static constexpr bool PERM = true, GATHER = false;
    int K, lda, ldb, G, c, ntiles, pid;
    const bf16_t* H; const bf16_t* W2;
    const bf16_t* hsrc; bf16_t* hdst; const int* slot_tok; const int* tile_bkt;
    __device__ __forceinline__ bool next(int i, Unit& u) const {
        const int m = 2 * ((c >> 3) + (G >> 3) * i) + ((c >> 2) & 1); if ((G & 7) != 0 || m >= ntiles) { if ((G & 7) == 0) return false; const long L = (long)i * G + c; if (L >= (long)ntiles * 4) return false; u.pm = (int)(L >> 2); u.pn = (int)(L & 3); u.prob = __builtin_amdgcn_readfirstlane(ld_vec_i32(tile_bkt + u.pm)); return true; }
        u.pm = m; u.pn = c & 3; u.prob = __builtin_amdgcn_readfirstlane(ld_vec_i32(tile_bkt + u.pm)); return true;
    }
    __device__ __forceinline__ const char* a_ptr(const Unit& u) const { return (const char*)(H + (size_t)u.pm * BM * 1024); }
    __device__ __forceinline__ long a_kadj(int) const { return 0; }
    __device__ __forceinline__ unsigned a_voff(const Unit&, int, int) const { return 0u; }
    __device__ __forceinline__ const char* b_ptr(const Unit& u, int kt) const {
        int lo, hi; pair_lohi(u.prob % 6, lo, hi); const int e = (u.prob / 6) * 4 + ((kt < 8) ? lo : hi);
        return (const char*)(W2 + ((size_t)e * 1024 + (size_t)u.pn * BM) * 512) + (size_t)(kt & 7) * (BK * 2);
    }
    __device__ __forceinline__ void epi(const f32x4 (&acc)[2][2][4][2], const Unit& u, int wr, int wc, int fr, int fq) const {
        const int row0 = u.pm * BM + wr * 64 + fr, col0 = u.pn * BM + wc * 32 + 8 * fq;
        int tok[2][4];
#pragma unroll
        for (int ai = 0; ai < 2; ++ai)
#pragma unroll
            for (int m = 0; m < 4; ++m) tok[ai][m] = slot_tok[row0 + ai * HALF + m * 16];
#pragma unroll
        for (int ai = 0; ai < 2; ++ai) {
            u32x4 r[4][2];
#pragma unroll
            for (int m = 0; m < 4; ++m) { const int tk = tok[ai][m]; const bf16_t* rp = hsrc + (size_t)(tk < 0 ? 0 : tk) * 1024 + col0;
#pragma unroll
                for (int bj = 0; bj < 2; ++bj) r[m][bj] = *(const u32x4*)(rp + bj * HALF); }
#pragma unroll
            for (int m = 0; m < 4; ++m) { const int tk = tok[ai][m];
                if (tk >= 0) { bf16_t* wp = hdst + (size_t)tk * 1024 + col0;
#pragma unroll
                    for (int bj = 0; bj < 2; ++bj) { const u32x4 rw = r[m][bj]; const f32x4 a0 = acc[ai][bj][m][0], a1 = acc[ai][bj][m][1];
                        u32x4 w; w.x = cvt_pk_bf16(a0[0] + bflo(rw.x), a0[1] + bfhi(rw.x)); w.y = cvt_pk_bf16(a0[2] + bflo(rw.y), a0[3] + bfhi(rw.y));
                        w.z = cvt_pk_bf16(a1[0] + bflo(rw.z), a1[1] + bfhi(rw.z)); w.w = cvt_pk_bf16(a1[2] + bflo(rw.w), a1[3] + bfhi(rw.w));
                        *(u32x4*)(wp + bj * HALF) = w; } } }
        }
    }
};

struct Frame {
    LAS unsigned char* lds;
    int tid, lane, wave, G, bid;
    float* out; unsigned char* ws;
};
#define WSP(T, off) ((T*)(F.ws + (off)))

__device__ __forceinline__ void prep_tile(const Frame& F, const float* src, int src_ld, int k0, int kvalid, int c0, int nvalid, bf16_t* dst, int dst_ld, bool il = false, int ksrc = -1, const float* kscale = nullptr, bool one_minus = false) {
    const int ks0 = ksrc < 0 ? k0 : ksrc;
    LAS float* tl = (LAS float*)F.lds;
    __syncthreads();
#pragma unroll
    for (int p = 0; p < 2; ++p) { const int kk = (F.tid >> 4) + 32 * p, n4 = (F.tid & 15) * 4;
        f32x4 v = (f32x4){0.f, 0.f, 0.f, 0.f};
        if (il) {
            v = __builtin_nontemporal_load((const f32x4*)(src + (size_t)(ks0 + kk) * src_ld + c0 + ((n4 < 32) ? n4 : 32 + n4))); const int d0 = 2 * (n4 & 31) + (n4 >> 5);
            tl[kk * 65 + d0] = v[0]; tl[kk * 65 + d0 + 2] = v[1]; tl[kk * 65 + d0 + 4] = v[2]; tl[kk * 65 + d0 + 6] = v[3];
        } else {
        if (kk < kvalid && n4 < nvalid) v = __builtin_nontemporal_load((const f32x4*)(src + (size_t)(ks0 + kk) * src_ld + c0 + n4));
        if (kscale) { const float f_ = kscale[ks0 + kk]; v = v * (one_minus ? 1.f - f_ : f_); }
        tl[kk * 65 + n4 + 0] = v[0]; tl[kk * 65 + n4 + 1] = v[1]; tl[kk * 65 + n4 + 2] = v[2]; tl[kk * 65 + n4 + 3] = v[3]; } }
    __syncthreads();
    { const int n = F.tid >> 3, kc = (F.tid & 7) * 8; float x[8];
#pragma unroll
        for (int j = 0; j < 8; ++j) x[j] = tl[(kc + j) * 65 + n];
        u32x4 w; w.x = cvt_pk_bf16(x[0], x[1]); w.y = cvt_pk_bf16(x[2], x[3]); w.z = cvt_pk_bf16(x[4], x[5]); w.w = cvt_pk_bf16(x[6], x[7]);
        *(u32x4*)(dst + (size_t)n * dst_ld + k0 + kc) = w; }
}
__device__ __forceinline__ void phase_prep(const Params& p, const Frame& F, int id_lo, int id_hi, bool tables) {
    bf16_t* wb = WSP(bf16_t, WS_WB);
    constexpr int N0 = 1472, N1 = N0 + 512, N2 = N1 + 1024, N3 = N2 + 256, N4 = N3 + 192, N5 = N4 + 8192, N6 = N5 + 4096;
    (void)N6;
    for (int id = id_lo + F.bid; id < id_hi; id += F.G) {
        if (id < N0) { const int nt = id / 16, kt = id % 16, n0 = nt * 64; int c0, nv;
            if (n0 < PC_Q) { c0 = n0; nv = 64; } else if (n0 < PC_DT) { c0 = n0 + 16; nv = 64; } else if (n0 == PC_DT) { c0 = 2560; nv = 16; } else { c0 = 0; nv = 0; }
            const bool il = (n0 >= PC_Q && n0 < PC_V);
            if (il) c0 = 2576 + ((n0 - PC_Q) >> 7) * 128 + (((n0 - PC_Q) >> 6) & 1) * 32;
            prep_tile(F, p.in[4], 5648, kt * 64, 64, c0, nv, wb + WB_WIN / 2 + (size_t)n0 * 1024, 1024, il); }
        else if (id < N1) { const int j = id - N0, nt = j / 32, kt = j % 32; prep_tile(F, p.in[11], 1024, kt * 64, 64, nt * 64, 64, wb + WB_WOUT / 2 + (size_t)nt * 64 * 2048, 2048); }
        else if (id < N2) { const int j = id - N1, w = j / 256, r = j % 256, nt = r / 16, kt = r % 16; prep_tile(F, (w == 0) ? p.in[13] : (w == 1) ? p.in[14] : (w == 2) ? p.in[15] : p.in[16], 1024, kt * 64, 64, nt * 64, 64, wb + WB_WR / 2 + (size_t)w * 1048576 + (size_t)nt * 64 * 1024, 1024); }
        else if (id < N3) { const int j = id - N2, nt = j >> 5, kt = j & 31, half = kt >> 4;
            const float* src = (nt == 0) ? p.in[18] : (nt == 1) ? p.in[21] : p.in[23]; const int ncols = (nt < 2) ? 64 : 160, c0 = (nt < 2) ? 0 : (nt - 2) * 64, midx = (nt == 0) ? 1 : (nt == 1) ? 4 : 5;
            int nv = (nt < 2) ? 64 : ncols - c0; nv = nv < 0 ? 0 : (nv > 64 ? 64 : nv); if (nt > 4) nv = 0;
            prep_tile(F, src, ncols, kt * 64, 64, (nv ? c0 : 0), nv, wb + WB_L1 / 2 + (size_t)nt * 64 * 2048, 2048, false, (kt & 15) * 64, p.in[12] + midx * DM, !half); }
        else if (id < N4) { const int j = id - N3, w = j / 64, r = j % 64, nt = r / 4, kt = r % 4;
            int kv = (w == 0) ? (kt == 0 ? 64 : 0) : (w == 1) ? (kt == 1 ? 64 : 0) : 160 - kt * 64; kv = kv < 0 ? 0 : (kv > 64 ? 64 : kv);
            const float* src = (w == 0) ? p.in[19] : (w == 1) ? p.in[22] : p.in[24];
            prep_tile(F, src, 1024, kt * 64, kv, nt * 64, 64, wb + WB_L2 / 2 + (size_t)w * 262144 + (size_t)nt * 64 * 256, 256, false, (w == 1) ? 0 : kt * 64); }
        else if (id < N5) { const int j = id - N4, le = j / 256, r = j % 256, nt = r / 16, kt = r % 16;
            const int pn = nt >> 2, part = (nt >> 1) & 1, c0 = 128 * pn + 64 * (nt & 1);
            const float* src = (part ? p.in[35] : p.in[34]) + (size_t)le * 524288;
            prep_tile(F, src, 512, kt * 64, 64, c0, 64, wb + WB_W13 / 2 + (size_t)le * 1048576 + (size_t)nt * 64 * 1024, 1024); }
        else { const int j = id - N5, le = j / 128, r = j % 128, nt = r / 8, kt = r % 8;
            prep_tile(F, p.in[36] + (size_t)le * 524288, 1024, kt * 64, 64, nt * 64, 64, wb + WB_W2 / 2 + (size_t)le * 524288 + (size_t)nt * 64 * 512, 512); }
    }
    if (!tables) { __syncthreads(); return; }
    { float* rtw = WSP(float, WS_RTW);
        for (int idx = F.bid * NTHREADS + F.tid; idx < 2 * 20 * 1024; idx += F.G * NTHREADS) { const int l = idx / 20480, r = idx % 20480, j = r >> 10, k = r & 1023;
            rtw[idx] = (j < 4) ? p.in[30][(size_t)l * 4096 + k * 4 + j] : p.in[32][(size_t)l * 16384 + k * 16 + (j - 4)]; } }
    f32x2* rope = WSP(f32x2, WS_ROPE);
    for (int idx = F.bid * NTHREADS + F.tid; idx < SEQ * 64; idx += F.G * NTHREADS) {
        const int pos = idx >> 6, i = idx & 63;
        const float invf = exp2f(-(float)i * (13.287712379549449f / 64.f));
        const float ang = (float)pos * invf;
        const double x = (double)ang;
        const double kq = rint(x * 0.63661977236758134308);
        double r = fma(-kq, 1.57079632679489655800e+00, x); r = fma(-kq, 6.12323399573676603587e-17, r);
        const double r2 = r * r;
        double sp = -7.6471637318198164759e-13; sp = fma(sp, r2, 1.6059043836821614599e-10); sp = fma(sp, r2, -2.5052108385441718775e-08); sp = fma(sp, r2, 2.7557319223985890653e-06);
        sp = fma(sp, r2, -1.9841269841269841270e-04); sp = fma(sp, r2, 8.3333333333333333333e-03); sp = fma(sp, r2, -1.6666666666666666667e-01); const double sn = fma(sp * r2, r, r);
        double cp = 4.7794773323873852974e-14; cp = fma(cp, r2, -1.1470745597729724714e-11); cp = fma(cp, r2, 2.0876756987868098979e-09); cp = fma(cp, r2, -2.7557319223985890653e-07);
        cp = fma(cp, r2, 2.4801587301587301587e-05); cp = fma(cp, r2, -1.3888888888888888889e-03); cp = fma(cp, r2, 4.1666666666666666667e-02); cp = fma(cp, r2, -0.5); const double cs = fma(cp, r2, 1.0);
        const int q = ((int)kq) & 3;
        const double c = (q == 0) ? cs : (q == 1) ? -sn : (q == 2) ? -cs : sn;
        const double s = (q == 0) ? sn : (q == 1) ? cs : (q == 2) ? -sn : -cs;
        rope[idx] = (f32x2){(float)c, (float)s};
    }
}

__device__ __forceinline__ void row_load(const float* row, int lane, f32x4 (&v)[4]) {
#pragma unroll
    for (int j = 0; j < 4; ++j) v[j] = *(const f32x4*)(row + j * 256 + lane * 4);
}
__device__ __forceinline__ void row_load_nt(const float* row, int lane, f32x4 (&v)[4]) {
#pragma unroll
    for (int j = 0; j < 4; ++j) v[j] = __builtin_nontemporal_load((const f32x4*)(row + j * 256 + lane * 4));
}
__device__ __forceinline__ void row_load_bf_nt(const bf16_t* row, int lane, f32x4 (&v)[4]) {
#pragma unroll
    for (int j = 0; j < 4; ++j) { const u32x2 w = __builtin_nontemporal_load((const u32x2*)(row + j * 256 + lane * 4)); v[j] = (f32x4){bflo(w.x), bfhi(w.x), bflo(w.y), bfhi(w.y)}; }
}
__device__ __forceinline__ void row_load_bf(const bf16_t* row, int lane, f32x4 (&v)[4]) {
#pragma unroll
    for (int j = 0; j < 4; ++j) { const u32x2 w = *(const u32x2*)(row + j * 256 + lane * 4); v[j] = (f32x4){bflo(w.x), bfhi(w.x), bflo(w.y), bfhi(w.y)}; }
}
__device__ __forceinline__ float row_rstd(const f32x4 (&v)[4], float eps) {
    float ss = 0.f;
#pragma unroll
    for (int j = 0; j < 4; ++j) ss += v[j][0] * v[j][0] + v[j][1] * v[j][1] + v[j][2] * v[j][2] + v[j][3] * v[j][3];
    ss = wave_sum_u(ss);
    return rsqrtf(ss * (1.f / 1024.f) + eps);
}
__device__ __forceinline__ void row_store_bf16(bf16_t* row, int lane, const f32x4 (&v)[4]) {
#pragma unroll
    for (int j = 0; j < 4; ++j) { u32x2 w; w.x = cvt_pk_bf16(v[j][0], v[j][1]); w.y = cvt_pk_bf16(v[j][2], v[j][3]); *(u32x2*)(row + j * 256 + lane * 4) = w; }
}

template <bool TO_BF16, bool SRC_BF16 = false>
__device__ __forceinline__ void phase_rmsnorm(const Params& p, const Frame& F, const void* src_, const float* w, void* dst) {
    const float* src = (const float*)src_; const bf16_t* srcb = (const bf16_t*)src_; (void)src; (void)srcb;
    f32x4 wv[4]; row_load(w, F.lane, wv);
    int row = F.bid * 8 + F.wave; const int stride = F.G * 8;
    f32x4 v[4], vn[4];
    if (row < T_TOK) { if constexpr (SRC_BF16) row_load_bf_nt(srcb + (size_t)row * DM, F.lane, v); else row_load_nt(src + (size_t)row * DM, F.lane, v); }
    for (; row < T_TOK; row += stride) {
        if (row + stride < T_TOK) { if constexpr (SRC_BF16) row_load_bf_nt(srcb + (size_t)(row + stride) * DM, F.lane, vn); else row_load_nt(src + (size_t)(row + stride) * DM, F.lane, vn); }
        const float rs = row_rstd(v, 1e-6f);
#pragma unroll
        for (int j = 0; j < 4; ++j) v[j] = v[j] * rs * wv[j];
        if constexpr (TO_BF16) row_store_bf16((bf16_t*)dst + (size_t)row * DM, F.lane, v);
        else {
#pragma unroll
            for (int j = 0; j < 4; ++j) *(f32x4*)((float*)dst + (size_t)row * DM + j * 256 + F.lane * 4) = v[j];
        }
#pragma unroll
        for (int j = 0; j < 4; ++j) v[j] = vn[j];
    }
}

__device__ __forceinline__ void phase_conv(const Params& p, const Frame& F) {
    bf16_t* proj = WSP(bf16_t, WS_SLAB);
    bf16_t* xc = (bf16_t*)F.out;
    const float* conv_w = p.in[5]; const float* conv_b = p.in[6];
    for (int item = F.bid * 8 + F.wave; item < (T_TOK / 32) * 3; item += F.G * 8) {
        const int run = item / 3, cb = item - run * 3, c0 = cb * 512 + F.lane * 8, t0 = run * 32;
        float w[4][8], bb[8], xm3[8], xm2[8], xm1[8];
#pragma unroll
        for (int j = 0; j < 4; ++j) { const f32x4 a0 = *(const f32x4*)(conv_w + j * 1536 + c0), a1 = *(const f32x4*)(conv_w + j * 1536 + c0 + 4);
#pragma unroll
            for (int e = 0; e < 4; ++e) { w[j][e] = a0[e]; w[j][4 + e] = a1[e]; } }
        { const f32x4 a0 = *(const f32x4*)(conv_b + c0), a1 = *(const f32x4*)(conv_b + c0 + 4);
#pragma unroll
            for (int e = 0; e < 4; ++e) { bb[e] = a0[e]; bb[4 + e] = a1[e]; } }
        const bool first = (t0 & (SEQ - 1)) == 0;
        { u32x4 r3 = (u32x4){0u, 0u, 0u, 0u}, r2 = r3, r1 = r3;
            if (!first) { r3 = __builtin_nontemporal_load((const u32x4*)(proj + (size_t)(t0 - 3) * NPROJ + PC_XBC + c0)); r2 = __builtin_nontemporal_load((const u32x4*)(proj + (size_t)(t0 - 2) * NPROJ + PC_XBC + c0)); r1 = __builtin_nontemporal_load((const u32x4*)(proj + (size_t)(t0 - 1) * NPROJ + PC_XBC + c0)); }
            xm3[0] = bflo(r3.x); xm3[1] = bfhi(r3.x); xm3[2] = bflo(r3.y); xm3[3] = bfhi(r3.y); xm3[4] = bflo(r3.z); xm3[5] = bfhi(r3.z); xm3[6] = bflo(r3.w); xm3[7] = bfhi(r3.w);
            xm2[0] = bflo(r2.x); xm2[1] = bfhi(r2.x); xm2[2] = bflo(r2.y); xm2[3] = bfhi(r2.y); xm2[4] = bflo(r2.z); xm2[5] = bfhi(r2.z); xm2[6] = bflo(r2.w); xm2[7] = bfhi(r2.w);
            xm1[0] = bflo(r1.x); xm1[1] = bfhi(r1.x); xm1[2] = bflo(r1.y); xm1[3] = bfhi(r1.y); xm1[4] = bflo(r1.z); xm1[5] = bfhi(r1.z); xm1[6] = bflo(r1.w); xm1[7] = bfhi(r1.w); }
#pragma unroll 4
        for (int tt = 0; tt < 32; ++tt) {
            const u32x4 r = __builtin_nontemporal_load((const u32x4*)(proj + (size_t)(t0 + tt) * NPROJ + PC_XBC + c0));
            const float x[8] = {bflo(r.x), bfhi(r.x), bflo(r.y), bfhi(r.y), bflo(r.z), bfhi(r.z), bflo(r.w), bfhi(r.w)};
            float o[8];
#pragma unroll
            for (int e = 0; e < 8; ++e) { o[e] = fsilu(bb[e] + w[0][e] * xm3[e] + w[1][e] * xm2[e] + w[2][e] * xm1[e] + w[3][e] * x[e]); xm3[e] = xm2[e]; xm2[e] = xm1[e]; xm1[e] = x[e]; }
            u32x4 ow; ow.x = cvt_pk_bf16(o[0], o[1]); ow.y = cvt_pk_bf16(o[2], o[3]); ow.z = cvt_pk_bf16(o[4], o[5]); ow.w = cvt_pk_bf16(o[6], o[7]);
            *(u32x4*)(xc + (size_t)(t0 + tt) * 1536 + c0) = ow;
        }
    }
}

typedef float f32x16 __attribute__((ext_vector_type(16)));
typedef short s16x4 __attribute__((ext_vector_type(4)));
#define MFMA32(a, b, c) __builtin_amdgcn_mfma_f32_32x32x16_bf16((a), (b), (c), 0, 0, 0)
__device__ __forceinline__ unsigned off_b(unsigned row, unsigned ch) { return 256u * row + 16u * (ch ^ (((row & 3u) << 2) | ((row >> 2) & 3u))); }
__device__ __forceinline__ unsigned off_v(unsigned row, unsigned ch) { return 128u * row + 16u * (ch ^ (((row >> 1) & 1u) << 2)); }
__device__ __forceinline__ unsigned off_y(unsigned row, unsigned ch) { return 128u * row + 16u * (ch ^ (row & 7u)); }
__device__ __forceinline__ bf16x8 tr_read2(unsigned a0, unsigned a1) {
    s16x4 lo, hi;
    asm volatile("ds_read_b64_tr_b16 %0, %2\n\tds_read_b64_tr_b16 %1, %3\n\ts_waitcnt lgkmcnt(0)" : "=&v"(lo), "=&v"(hi) : "v"(a0), "v"(a1) : "memory");
    return __builtin_shufflevector(lo, hi, 0, 1, 2, 3, 4, 5, 6, 7);
}
__device__ __forceinline__ void tr_read4(unsigned a0, unsigned a1, unsigned a2, unsigned a3, bf16x8& f0, bf16x8& f1) {
    s16x4 r0, r1, r2, r3;
    asm volatile("ds_read_b64_tr_b16 %0, %4\n\tds_read_b64_tr_b16 %1, %5\n\tds_read_b64_tr_b16 %2, %6\n\tds_read_b64_tr_b16 %3, %7\n\ts_waitcnt lgkmcnt(0)"
                 : "=&v"(r0), "=&v"(r1), "=&v"(r2), "=&v"(r3) : "v"(a0), "v"(a1), "v"(a2), "v"(a3) : "memory");
    f0 = __builtin_shufflevector(r0, r1, 0, 1, 2, 3, 4, 5, 6, 7); f1 = __builtin_shufflevector(r2, r3, 0, 1, 2, 3, 4, 5, 6, 7);
}
__device__ __forceinline__ void tr_read8(unsigned a0, unsigned a1, unsigned a2, unsigned a3, unsigned a4, unsigned a5, unsigned a6, unsigned a7, bf16x8& f0, bf16x8& f1, bf16x8& f2, bf16x8& f3) {
    s16x4 r0, r1, r2, r3, r4, r5, r6, r7;
    asm volatile("ds_read_b64_tr_b16 %0, %8\n\tds_read_b64_tr_b16 %1, %9\n\tds_read_b64_tr_b16 %2, %10\n\tds_read_b64_tr_b16 %3, %11\n\tds_read_b64_tr_b16 %4, %12\n\tds_read_b64_tr_b16 %5, %13\n\tds_read_b64_tr_b16 %6, %14\n\tds_read_b64_tr_b16 %7, %15\n\ts_waitcnt lgkmcnt(0)"
                 : "=&v"(r0), "=&v"(r1), "=&v"(r2), "=&v"(r3), "=&v"(r4), "=&v"(r5), "=&v"(r6), "=&v"(r7) : "v"(a0), "v"(a1), "v"(a2), "v"(a3), "v"(a4), "v"(a5), "v"(a6), "v"(a7) : "memory");
    f0 = __builtin_shufflevector(r0, r1, 0, 1, 2, 3, 4, 5, 6, 7); f1 = __builtin_shufflevector(r2, r3, 0, 1, 2, 3, 4, 5, 6, 7);
    f2 = __builtin_shufflevector(r4, r5, 0, 1, 2, 3, 4, 5, 6, 7); f3 = __builtin_shufflevector(r6, r7, 0, 1, 2, 3, 4, 5, 6, 7);
}
__device__ __forceinline__ f32x16 zero16() { f32x16 z;
#pragma unroll
    for (int i = 0; i < 16; ++i) z[i] = 0.f;
    return z; }
__device__ __forceinline__ void phase_scan0(const Params& p, const Frame& F) {
    bf16_t* proj = WSP(bf16_t, WS_SLAB);
    const bf16_t* xc = (const bf16_t*)F.out;
    constexpr unsigned OQ = 0, OK = 32768, OV = 65536, OVW = 81920, OS = 98304, OY = 114688, OSM = 131072;
    LAS unsigned char* L = F.lds;
    const unsigned lbase = (unsigned)(__UINTPTR_TYPE__)L;
    LAS float* sm = (LAS float*)(L + OSM);
    const int lane = F.lane, w = F.wave, it = w >> 1, pt = w & 1;
    const unsigned h0 = lane >> 5, lr0 = lane & 31;
    const int trow = F.tid >> 2, tpart = F.tid & 3;
    const unsigned blk0 = (lane >> 4) & 1u, tq0 = (lane & 15u) >> 2, tp0 = lane & 3u;
    for (int ui = 0; ui < 2; ++ui) {
        const int uu = F.bid + ui * F.G;
        if (uu >= 512) break;
        const bool is_ssd = uu < 256; const int v = uu & 255, x8 = v & 7, slot = v >> 3;
        int b, hh, grp = 0, hr = 0, sl = 0;
        if (is_ssd) { const int pg = x8 + 8 * (slot >> 3), hg = slot & 7; b = pg >> 1; grp = pg & 1; hh = grp * 8 + hg; }
        else { const int pr = x8 + 8 * (slot >> 2); sl = slot & 3; b = pr >> 2; hr = pr & 3; hh = hr * 4 + sl; }
        const size_t row0 = (size_t)b * SEQ;
        const bf16_t* qptr; const bf16_t* kptr; const bf16_t* vptr; size_t qs, vs; bf16_t* optr;
        if (is_ssd) { qptr = xc + 1280 + grp * 128; kptr = xc + 1024 + grp * 128; vptr = xc + hh * 64; qs = 1536; vs = 1536; optr = proj + hh * 64; }
        else { qptr = proj + PC_Q + hr * 128; kptr = proj + PC_K + hr * 128; vptr = proj + PC_V + hr * 256 + sl * 64; qs = NPROJ; vs = NPROJ; optr = proj + 1024 + hr * 256 + sl * 64; }
        const bf16_t* zptr = proj + hh * 64;
        const float A_h = is_ssd ? -__expf(p.in[8][hh]) : 0.f, dtb = is_ssd ? p.in[7][hh] : 0.f, D_h = is_ssd ? p.in[9][hh] : 0.f;
        const float lng = __logf(1.f - exp2f(-5.f - (float)hr));
        u32x4 rv[2], rz[2]; float rdt0 = 0.f, rdt1 = 0.f;
        f32x16 St0 = zero16(), St1 = zero16();
        __syncthreads();
        for (int i = F.tid; i < 16384 / 16; i += NTHREADS) *(LAS u32x4*)(L + OS + i * 16) = (u32x4){0u, 0u, 0u, 0u};
#define SC_LOAD(c) do { const size_t r_ = row0 + (size_t)(c) * 128 + trow; \
            _Pragma("unroll") for (int e = 0; e < 2; ++e) rv[e] = *(const u32x4*)(vptr + r_ * vs + tpart * 16 + e * 8); \
            if (is_ssd && w == 0) { rdt0 = bf2f(proj[(row0 + (size_t)(c) * 128 + 2 * lane) * NPROJ + PC_DT + hh]); rdt1 = bf2f(proj[(row0 + (size_t)(c) * 128 + 2 * lane + 1) * NPROJ + PC_DT + hh]); } } while (0)
#define SC_DMA(c) do { _Pragma("unroll") for (int e = 0; e < 4; ++e) { const int I_ = w * 4 + e; const unsigned r_ = 4u * I_ + ((unsigned)lane >> 4), cs_ = lane & 15u, ch_ = cs_ ^ (((r_ & 3u) << 2) | ((r_ >> 2) & 3u)); \
            const size_t g_ = (row0 + (size_t)(c) * 128 + r_) * qs + ch_ * 8; \
            __builtin_amdgcn_global_load_lds((const unsigned*)(qptr + g_), (LAS unsigned*)(L + OQ + I_ * 1024), 16, 0, 0); \
            __builtin_amdgcn_global_load_lds((const unsigned*)(kptr + g_), (LAS unsigned*)(L + OK + I_ * 1024), 16, 0, 0); } } while (0)
#define SC_LOADZ(c) do { if (is_ssd) { const size_t r_ = row0 + (size_t)(c) * 128 + trow; rz[0] = __builtin_nontemporal_load((const u32x4*)(zptr + r_ * NPROJ + tpart * 16)); rz[1] = __builtin_nontemporal_load((const u32x4*)(zptr + r_ * NPROJ + tpart * 16 + 8)); } } while (0)
#define SC_SMALL(c) do { if (w == 0) { LAS float* sb = sm + ((c) & 1) * 384; float d0, d1, a0, a1; \
            if (is_ssd) { d0 = fsoftplus(rdt0 + dtb); d1 = fsoftplus(rdt1 + dtb); a0 = d0 * A_h; a1 = d1 * A_h; } else { d0 = 1.f; d1 = 1.f; a0 = lng; a1 = lng; } \
            float sc = a0 + a1; _Pragma("unroll") for (int o = 1; o < 64; o <<= 1) { const float tv = __shfl_up(sc, o); if (lane >= o) sc += tv; } \
            const float c1 = sc, c0 = sc - a1; const float tot = __shfl(sc, 63); \
            sb[2 * lane] = c0; sb[2 * lane + 1] = c1; sb[128 + 2 * lane] = d0; sb[128 + 2 * lane + 1] = d1; sb[256 + 2 * lane] = __expf(tot - c0) * d0; sb[256 + 2 * lane + 1] = __expf(tot - c1) * d1; } } while (0)
#define SC_STORE(c) do { const float wj_ = sm[((c) & 1) * 384 + 256 + trow]; \
            _Pragma("unroll") for (int e = 0; e < 2; ++e) { const u32x4 x_ = rv[e]; *(LAS u32x4*)(L + OV + off_v(trow, tpart * 2 + e)) = x_; u32x4 y_; \
                y_.x = cvt_pk_bf16(bflo(x_.x) * wj_, bfhi(x_.x) * wj_); y_.y = cvt_pk_bf16(bflo(x_.y) * wj_, bfhi(x_.y) * wj_); y_.z = cvt_pk_bf16(bflo(x_.z) * wj_, bfhi(x_.z) * wj_); y_.w = cvt_pk_bf16(bflo(x_.w) * wj_, bfhi(x_.w) * wj_); \
                *(LAS u32x4*)(L + OVW + off_v(trow, tpart * 2 + e)) = y_; } } while (0)
        SC_DMA(0); SC_LOAD(0);
        SC_SMALL(0);
        __syncthreads();
        SC_STORE(0);
        asm volatile("s_waitcnt vmcnt(0)" ::: "memory");
        __syncthreads();
        SP_DECL;
        for (int c = 0; c < SEQ / 128; ++c) {
            SP_MARK(8);
            const LAS float* sb = sm + (c & 1) * 384;
            unsigned lr = lr0, h = h0, blk = blk0, tq_ = tq0, tp_ = tp0;
            asm volatile("" : "+v"(lr), "+v"(h), "+v"(blk), "+v"(tq_), "+v"(tp_));
            if (c + 1 < SEQ / 128) { SC_LOAD(c + 1); }
            SC_LOADZ(c);
            const int ph = pt;
            const float ai = sb[32 * it + lr];
            f32x16 Yd0 = zero16(), Yd1 = zero16();
            for (int jt = ph; jt <= it; jt += 2) {
                f32x16 acc = zero16();
#pragma unroll
                for (int ks = 0; ks < 8; ++ks) { const bf16x8 ka = *(const LAS bf16x8*)(L + OK + off_b(32 * jt + lr, 2 * ks + h)), qb = *(const LAS bf16x8*)(L + OQ + off_b(32 * it + lr, 2 * ks + h)); acc = MFMA32(ka, qb, acc); }
                const bool diag = (jt == it);
#pragma unroll
                for (int g = 0; g < 4; ++g) { const f32x4 aj = *(const LAS f32x4*)(sb + 32 * jt + 8 * g + 4 * h), dj = *(const LAS f32x4*)(sb + 128 + 32 * jt + 8 * g + 4 * h);
#pragma unroll
                    for (int e = 0; e < 4; ++e) { const float dec = __expf(ai - aj[e]) * dj[e]; const bool ok = !diag || ((int)lr >= (int)(8 * g + 4 * h + e)); acc[4 * g + e] = ok ? acc[4 * g + e] * dec : 0.f; } }
#pragma unroll
                for (int s2 = 0; s2 < 2; ++s2) {
                    u32x4 pw; pw.x = cvt_pk_bf16(acc[8 * s2 + 0], acc[8 * s2 + 1]); pw.y = cvt_pk_bf16(acc[8 * s2 + 2], acc[8 * s2 + 3]); pw.z = cvt_pk_bf16(acc[8 * s2 + 4], acc[8 * s2 + 5]); pw.w = cvt_pk_bf16(acc[8 * s2 + 6], acc[8 * s2 + 7]);
                    const bf16x8 Pb = __builtin_bit_cast(bf16x8, pw);
                    const unsigned rb0 = 32 * jt + 16 * s2 + 4 * h + tq_, cc0 = 2 * blk + (tp_ >> 1), o8 = 8 * (tp_ & 1);
                    bf16x8 va0, va1;
                    tr_read4(lbase + OV + off_v(rb0, cc0) + o8, lbase + OV + off_v(rb0 + 8, cc0) + o8, lbase + OV + off_v(rb0, 4 + cc0) + o8, lbase + OV + off_v(rb0 + 8, 4 + cc0) + o8, va0, va1);
                    Yd0 = MFMA32(va0, Pb, Yd0); Yd1 = MFMA32(va1, Pb, Yd1);
                }
            }
            {
                f32x16 Yo = zero16();
#pragma unroll
                for (int ks = 0; ks < 8; ++ks) { const bf16x8 sa = *(const LAS bf16x8*)(L + OS + off_b(32 * ph + lr, 2 * ks + h)), qb = *(const LAS bf16x8*)(L + OQ + off_b(32 * it + lr, 2 * ks + h)); Yo = MFMA32(sa, qb, Yo); }
                const float ei = __expf(ai);
                if (ph == 0) {
#pragma unroll
                    for (int r = 0; r < 16; ++r) Yd0[r] += Yo[r] * ei; }
                else {
#pragma unroll
                    for (int r = 0; r < 16; ++r) Yd1[r] += Yo[r] * ei; }
            }
#pragma unroll
            for (int g = 0; g < 4; ++g) { u32x2 yw;
                if (ph == 0) { yw.x = cvt_pk_bf16(Yd1[4 * g], Yd1[4 * g + 1]); yw.y = cvt_pk_bf16(Yd1[4 * g + 2], Yd1[4 * g + 3]); } else { yw.x = cvt_pk_bf16(Yd0[4 * g], Yd0[4 * g + 1]); yw.y = cvt_pk_bf16(Yd0[4 * g + 2], Yd0[4 * g + 3]); }
                *(LAS u32x2*)(L + OY + off_y(32 * it + lr, 4 * (1 - ph) + g) + 8 * h) = yw; }
            const float dl = __expf(sb[127]);
            const int st0 = (w == 0) ? 0 : (w == 1) ? 2 : (w == 2) ? 4 : (w == 3) ? 5 : (w == 5) ? 6 : -1, st1 = (w == 0) ? 1 : (w == 1) ? 3 : (w == 5) ? 7 : -1;
            if (st0 >= 0) {
                const int spt = st0 & 1, snt = st0 >> 1;
#pragma unroll
                for (int r = 0; r < 16; ++r) St0[r] *= dl;
#pragma unroll
                for (int k2 = 0; k2 < 4; ++k2) { const unsigned rb = 32 * k2 + 8 * h + tq_, cv = 4 * spt + 2 * blk + (tp_ >> 1), cb = 4 * snt + 2 * blk + (tp_ >> 1), o8 = 8 * (tp_ & 1);
                    bf16x8 fa0, fb0, fa1, fb1;
                    tr_read8(lbase + OVW + off_v(rb, cv) + o8, lbase + OVW + off_v(rb + 4, cv) + o8, lbase + OK + off_b(rb, cb) + o8, lbase + OK + off_b(rb + 4, cb) + o8,
                             lbase + OVW + off_v(rb + 16, cv) + o8, lbase + OVW + off_v(rb + 20, cv) + o8, lbase + OK + off_b(rb + 16, cb) + o8, lbase + OK + off_b(rb + 20, cb) + o8, fa0, fb0, fa1, fb1);
                    St0 = MFMA32(fa0, fb0, St0); St0 = MFMA32(fa1, fb1, St0); }
                if (st1 >= 0) {
                    const int spt1 = st1 & 1, snt1 = st1 >> 1;
#pragma unroll
                    for (int r = 0; r < 16; ++r) St1[r] *= dl;
#pragma unroll
                    for (int k2 = 0; k2 < 4; ++k2) { const unsigned rb = 32 * k2 + 8 * h + tq_, cv = 4 * spt1 + 2 * blk + (tp_ >> 1), cb = 4 * snt1 + 2 * blk + (tp_ >> 1), o8 = 8 * (tp_ & 1);
                        bf16x8 fa0, fb0, fa1, fb1;
                        tr_read8(lbase + OVW + off_v(rb, cv) + o8, lbase + OVW + off_v(rb + 4, cv) + o8, lbase + OK + off_b(rb, cb) + o8, lbase + OK + off_b(rb + 4, cb) + o8,
                                 lbase + OVW + off_v(rb + 16, cv) + o8, lbase + OVW + off_v(rb + 20, cv) + o8, lbase + OK + off_b(rb + 16, cb) + o8, lbase + OK + off_b(rb + 20, cb) + o8, fa0, fb0, fa1, fb1);
                        St1 = MFMA32(fa0, fb0, St1); St1 = MFMA32(fa1, fb1, St1); }
                }
            }
            if (c + 1 < SEQ / 128) SC_SMALL(c + 1);
            LDS_BAR();
#pragma unroll
            for (int g = 0; g < 4; ++g) { LAS u32x2* yp = (LAS u32x2*)(L + OY + off_y(32 * it + lr, 4 * ph + g) + 8 * h); const u32x2 pv_ = *yp; u32x2 yw;
                if (ph == 0) { yw.x = cvt_pk_bf16(Yd0[4 * g] + bflo(pv_.x), Yd0[4 * g + 1] + bfhi(pv_.x)); yw.y = cvt_pk_bf16(Yd0[4 * g + 2] + bflo(pv_.y), Yd0[4 * g + 3] + bfhi(pv_.y)); }
                else { yw.x = cvt_pk_bf16(Yd1[4 * g] + bflo(pv_.x), Yd1[4 * g + 1] + bfhi(pv_.x)); yw.y = cvt_pk_bf16(Yd1[4 * g + 2] + bflo(pv_.y), Yd1[4 * g + 3] + bfhi(pv_.y)); }
                *yp = yw; }
            LDS_BAR();
            SP_MARK(5);
            if (c + 1 < SEQ / 128) SC_DMA(c + 1);
            if (st0 >= 0) {
                const int spt = st0 & 1, snt = st0 >> 1;
#pragma unroll
                for (int r = 0; r < 16; ++r) { const unsigned pr = 32 * spt + (r & 3) + 8 * (r >> 2) + 4 * h, n = 32 * snt + lr; *(LAS bf16_t*)(L + OS + off_b(pr, n >> 3) + 2 * (n & 7)) = f2bf(St0[r]); }
                if (st1 >= 0) { const int spt1 = st1 & 1, snt1 = st1 >> 1;
#pragma unroll
                    for (int r = 0; r < 16; ++r) { const unsigned pr = 32 * spt1 + (r & 3) + 8 * (r >> 2) + 4 * h, n = 32 * snt1 + lr; *(LAS bf16_t*)(L + OS + off_b(pr, n >> 3) + 2 * (n & 7)) = f2bf(St1[r]); }
                }
            }
            {
                bf16_t* orow = optr + (row0 + (size_t)c * 128 + trow) * NPROJ + tpart * 16;
#pragma unroll
                for (int e = 0; e < 2; ++e) {
                    const u32x4 yv = *(const LAS u32x4*)(L + OY + off_y(trow, tpart * 2 + e));
                    u32x4 ov = yv;
                    if (is_ssd) { const u32x4 xv = *(const LAS u32x4*)(L + OV + off_v(trow, tpart * 2 + e)); const u32x4 zv = rz[e];
                        ov.x = cvt_pk_bf16((bflo(yv.x) + bflo(xv.x) * D_h) * fsilu(bflo(zv.x)), (bfhi(yv.x) + bfhi(xv.x) * D_h) * fsilu(bfhi(zv.x)));
                        ov.y = cvt_pk_bf16((bflo(yv.y) + bflo(xv.y) * D_h) * fsilu(bflo(zv.y)), (bfhi(yv.y) + bfhi(xv.y) * D_h) * fsilu(bfhi(zv.y)));
                        ov.z = cvt_pk_bf16((bflo(yv.z) + bflo(xv.z) * D_h) * fsilu(bflo(zv.z)), (bfhi(yv.z) + bfhi(xv.z) * D_h) * fsilu(bfhi(zv.z)));
                        ov.w = cvt_pk_bf16((bflo(yv.w) + bflo(xv.w) * D_h) * fsilu(bflo(zv.w)), (bfhi(yv.w) + bfhi(xv.w) * D_h) * fsilu(bfhi(zv.w))); }
                    *(u32x4*)(orow + e * 8) = ov;
                }
            }
            LDS_BAR();
            SP_MARK(6);
            if (c + 1 < SEQ / 128) SC_STORE(c + 1);
            asm volatile("s_waitcnt vmcnt(0)" ::: "memory");
            LDS_BAR();
            SP_MARK(7);
        }
#undef SC_LOAD
#undef SC_LOADZ
#undef SC_SMALL
#undef SC_STORE
    }
}

__device__ __forceinline__ void phase_gatenorm(const Params& p, const Frame& F) {
    const bf16_t* proj = WSP(bf16_t, WS_SLAB);
    bf16_t* ybuf = WSP(bf16_t, WS_SLAB);
    const float* nw = p.in[10];
    int row = F.bid * 8 + F.wave; const int stride = F.G * 8;
    u32x4 yc[4], gc[2], yn[4], gn[2];
#define GN_LOAD(r_, Y_, G_) do { const bf16_t* b_ = ybuf + (size_t)(r_) * NPROJ; _Pragma("unroll") for (int j = 0; j < 4; ++j) Y_[j] = *(const u32x4*)(b_ + j * 512 + F.lane * 8); \
        _Pragma("unroll") for (int j = 0; j < 2; ++j) G_[j] = __builtin_nontemporal_load((const u32x4*)(b_ + PC_G + j * 512 + F.lane * 8)); } while (0)
    if (row < T_TOK) GN_LOAD(row, yc, gc);
    for (; row < T_TOK; row += stride) {
        if (row + stride < T_TOK) GN_LOAD(row + stride, yn, gn);
        bf16_t* yr = ybuf + (size_t)row * NPROJ;
#pragma unroll
        for (int j = 0; j < 4; ++j) {
            const u32x4 w = yc[j];
            float x[8] = {bflo(w.x), bfhi(w.x), bflo(w.y), bfhi(w.y), bflo(w.z), bfhi(w.z), bflo(w.w), bfhi(w.w)};
            float ss = 0.f;
#pragma unroll
            for (int e = 0; e < 8; ++e) ss += x[e] * x[e];
            if (j < 2) { ss = wave_sum_u(ss); const float rs = rsqrtf(ss * (1.f / 512.f) + 1e-5f);
                const f32x4 w0 = *(const f32x4*)(nw + j * 512 + F.lane * 8), w1 = *(const f32x4*)(nw + j * 512 + F.lane * 8 + 4);
#pragma unroll
                for (int e = 0; e < 4; ++e) { x[e] *= rs * w0[e]; x[4 + e] *= rs * w1[e]; } }
            else {
                ss = dpp_sum16(ss); ss += __shfl_xor(ss, 16);
                const float rs = rsqrtf(ss * (1.f / 256.f) + 1e-6f);
                const u32x4 gw = gc[j - 2];
                const float g[8] = {bflo(gw.x), bfhi(gw.x), bflo(gw.y), bfhi(gw.y), bflo(gw.z), bfhi(gw.z), bflo(gw.w), bfhi(gw.w)};
#pragma unroll
                for (int e = 0; e < 8; ++e) x[e] *= rs * fsilu(g[e]); }
            u32x4 o; o.x = cvt_pk_bf16(x[0], x[1]); o.y = cvt_pk_bf16(x[2], x[3]); o.z = cvt_pk_bf16(x[4], x[5]); o.w = cvt_pk_bf16(x[6], x[7]);
            *(u32x4*)(yr + j * 512 + F.lane * 8) = o;
        }
#pragma unroll
        for (int j = 0; j < 4; ++j) yc[j] = yn[j];
        gc[0] = gn[0]; gc[1] = gn[1];
    }
#undef GN_LOAD
}

__device__ __forceinline__ void phase_moe_route(const Params& p, const Frame& F, int layer, const bf16_t* h, bf16_t* tbuf) {
    unsigned char* meta = F.ws + WS_META + (size_t)layer * META_STRIDE;
    int* tok_rank = (int*)(meta + MT_RANK); int* tok_bkt = (int*)(meta + MT_BKT); f32x2* tok_c = (f32x2*)(meta + MT_C);
    int* gcount = (int*)(F.ws + WS_CTL + CTL_CNT_OFF) + layer * 32;
    const float* bg = p.in[31] + layer * 4; const float* be = p.in[33] + layer * 16;
    LAS float* wl = (LAS float*)F.lds;
    LAS int* lcount = (LAS int*)(F.lds + 81920);
    LAS int* lbase = lcount + 32;
    LAS int* l_bkt = lbase + 32;
    LAS int* l_rank = l_bkt + 1024;
    LAS float* l_c = (LAS float*)(l_rank + 1024);
    LAS float* lgt = (LAS float*)(F.lds + 98816);
    __syncthreads();
    { const float* wrt = WSP(float, WS_RTW) + (size_t)layer * 20480;
        for (int idx = F.tid; idx < 20 * 1024 / 4; idx += NTHREADS) *(LAS f32x4*)(wl + idx * 4) = *(const f32x4*)(wrt + idx * 4); }
    if (F.tid < 32) lcount[F.tid] = 0;
    __syncthreads();
    const int TPB = (T_TOK + F.G - 1) / F.G, tok0 = F.bid * TPB;
    f32x4 wv[4]; row_load(p.in[2] + (size_t)layer * DM, F.lane, wv);
    f32x4 va[4], vb[4], na[4], nb[4];
    int hsel;
    { unsigned t0_ = 0u, t1_ = 1u; asm volatile("s_nop 1\n\tv_permlane32_swap_b32 %0, %1\n\ts_nop 1" : "+v"(t0_), "+v"(t1_)); hsel = (t0_ + t1_ >= 2u) ? 10 : 0; }
#define RT_LOAD(li_, A_, B_) do { const int ta_ = tok0 + (li_), tb_ = ta_ + 8; \
        if ((li_) < TPB && ta_ < T_TOK) row_load_bf_nt(h + (size_t)ta_ * DM, F.lane, A_); if ((li_) + 8 < TPB && tb_ < T_TOK) row_load_bf_nt(h + (size_t)tb_ * DM, F.lane, B_); } while (0)
    RT_LOAD(F.wave, va, vb);
    for (int li = F.wave; li < TPB; li += 16) {
        const int tok = tok0 + li; if (tok >= T_TOK) break;
        const bool hasb = (li + 8 < TPB) && (tok + 8 < T_TOK);
        RT_LOAD(li + 16, na, nb);
        const float rsa = row_rstd(va, 1e-6f), rsb = row_rstd(vb, 1e-6f);
#pragma unroll
        for (int j = 0; j < 4; ++j) { va[j] = va[j] * rsa * wv[j]; vb[j] = vb[j] * rsb * wv[j]; }
        row_store_bf16(tbuf + (size_t)tok * DM, F.lane, va);
        if (hasb) row_store_bf16(tbuf + (size_t)(tok + 8) * DM, F.lane, vb);
        LAS float* lga = lgt + li * 20; LAS float* lgb = lgt + (li + 8) * 20;
#pragma unroll
        for (int o = 0; o < 10; ++o) { f32x2 c0 = (f32x2){0.f, 0.f}, c1 = c0, d0 = c0, d1 = c0;
#pragma unroll
            for (int j = 0; j < 4; ++j) { const f32x4 w4 = *(const LAS f32x4*)(wl + o * 1024 + j * 256 + F.lane * 4), w5 = *(const LAS f32x4*)(wl + (o + 10) * 1024 + j * 256 + F.lane * 4);
                const f32x2 w4l = (f32x2){w4[0], w4[1]}, w4h = (f32x2){w4[2], w4[3]}, w5l = (f32x2){w5[0], w5[1]}, w5h = (f32x2){w5[2], w5[3]};
                const f32x2 al = (f32x2){va[j][0], va[j][1]}, ah = (f32x2){va[j][2], va[j][3]}, bl = (f32x2){vb[j][0], vb[j][1]}, bh = (f32x2){vb[j][2], vb[j][3]};
                c0 += al * w4l; c0 += ah * w4h; c1 += al * w5l; c1 += ah * w5h; d0 += bl * w4l; d0 += bh * w4h; d1 += bl * w5l; d1 += bh * w5h; }
            float a0 = c0[0] + c0[1], a1 = c1[0] + c1[1], b0 = d0[0] + d0[1], b1 = d1[0] + d1[1];
            asm volatile("s_nop 1\n\tv_permlane32_swap_b32 %0, %1\n\tv_permlane32_swap_b32 %2, %3\n\ts_nop 1" : "+v"(a0), "+v"(a1), "+v"(b0), "+v"(b1));
            float sa = dpp_sum16(a0 + a1), sb_ = dpp_sum16(b0 + b1);
            sa += __builtin_bit_cast(float, __builtin_amdgcn_update_dpp(0, __builtin_bit_cast(int, sa), 0x142, 0xA, 0xF, false));
            sb_ += __builtin_bit_cast(float, __builtin_amdgcn_update_dpp(0, __builtin_bit_cast(int, sb_), 0x142, 0xA, 0xF, false));
            if ((F.lane & 31) == 16) { lga[hsel + o] = sa; if (hasb) lgb[hsel + o] = sb_; }
            if (o & 1) __builtin_amdgcn_sched_barrier(0); }
#pragma unroll
        for (int j = 0; j < 4; ++j) { va[j] = na[j]; vb[j] = nb[j]; }
    }
#undef RT_LOAD
    __syncthreads();
    for (int li = F.tid; li < TPB; li += NTHREADS) {
        if (tok0 + li >= T_TOK) break;
        float lg[20];
#pragma unroll
        for (int o = 0; o < 20; ++o) lg[o] = lgt[li * 20 + o];
        float g0 = lg[0] + bg[0], g1 = lg[1] + bg[1], g2 = lg[2] + bg[2], g3 = lg[3] + bg[3];
        int gi = 0; float gm = g0; if (g1 > gm) { gm = g1; gi = 1; } if (g2 > gm) { gm = g2; gi = 2; } if (g3 > gm) { gm = g3; gi = 3; }
        const float gate = 1.f / (__expf(g0 - gm) + __expf(g1 - gm) + __expf(g2 - gm) + __expf(g3 - gm));
        float e0, e1, e2, e3;
        e0 = (gi == 0) ? lg[4] : (gi == 1) ? lg[8] : (gi == 2) ? lg[12] : lg[16];
        e1 = (gi == 0) ? lg[5] : (gi == 1) ? lg[9] : (gi == 2) ? lg[13] : lg[17];
        e2 = (gi == 0) ? lg[6] : (gi == 1) ? lg[10] : (gi == 2) ? lg[14] : lg[18];
        e3 = (gi == 0) ? lg[7] : (gi == 1) ? lg[11] : (gi == 2) ? lg[15] : lg[19];
        e0 += be[gi * 4 + 0]; e1 += be[gi * 4 + 1]; e2 += be[gi * 4 + 2]; e3 += be[gi * 4 + 3];
        int i1 = 0; float v1 = e0; if (e1 > v1) { v1 = e1; i1 = 1; } if (e2 > v1) { v1 = e2; i1 = 2; } if (e3 > v1) { v1 = e3; i1 = 3; }
        int i2 = -1; float v2 = -3.0e38f;
        if (i1 != 0 && e0 > v2) { v2 = e0; i2 = 0; } if (i1 != 1 && e1 > v2) { v2 = e1; i2 = 1; } if (i1 != 2 && e2 > v2) { v2 = e2; i2 = 2; } if (i1 != 3 && e3 > v2) { v2 = e3; i2 = 3; }
        const float w1 = gate / (1.f + __expf(v2 - v1)), w2 = gate - w1;
        const int lo = i1 < i2 ? i1 : i2, hi = i1 < i2 ? i2 : i1; const float clo = i1 < i2 ? w1 : w2, chi = i1 < i2 ? w2 : w1;
        const int pr = (lo == 0) ? hi - 1 : (lo == 1) ? hi + 1 : 5;
        const int bk = gi * 6 + pr;
        l_bkt[li] = bk; l_c[li * 2] = clo; l_c[li * 2 + 1] = chi;
        l_rank[li] = __hip_atomic_fetch_add((int*)(lcount + bk), 1, __ATOMIC_RELAXED, __HIP_MEMORY_SCOPE_WORKGROUP);
    }
    __syncthreads();
    if (F.tid < 24) lbase[F.tid] = __hip_atomic_fetch_add(gcount + F.tid, lcount[F.tid], __ATOMIC_RELAXED, __HIP_MEMORY_SCOPE_AGENT);
    __syncthreads();
    for (int li = F.tid; li < TPB; li += NTHREADS) { const int tok = tok0 + li; if (tok < T_TOK) { const int bk = l_bkt[li]; tok_bkt[tok] = bk; tok_rank[tok] = lbase[bk] + l_rank[li]; tok_c[tok] = (f32x2){l_c[li * 2], l_c[li * 2 + 1]}; } }
}
__device__ __forceinline__ void phase_moe_slots(const Params& p, const Frame& F, int layer) {
    unsigned char* meta = F.ws + WS_META + (size_t)layer * META_STRIDE;
    const int* tok_rank = (const int*)(meta + MT_RANK); const int* tok_bkt = (const int*)(meta + MT_BKT); const f32x2* tok_c = (const f32x2*)(meta + MT_C);
    int* slot_tok = (int*)(meta + MT_STOK); f32x2* slot_c = (f32x2*)(meta + MT_SC); int* tile_tab = (int*)(meta + MT_TILE);
    int* gcount = (int*)(F.ws + WS_CTL + CTL_CNT_OFF) + layer * 32;
    LAS int* cnt = (LAS int*)F.lds; LAS int* start = cnt + 32;
    __syncthreads();
    if (F.tid < 24) cnt[F.tid] = __hip_atomic_load(gcount + F.tid, __ATOMIC_RELAXED, __HIP_MEMORY_SCOPE_AGENT);
    __syncthreads();
    if (F.tid == 0) { int a = 0; for (int b = 0; b < 24; ++b) { start[b] = a; a += (cnt[b] + 255) >> 8; } start[24] = a; }
    __syncthreads();
    for (int tok = F.bid * NTHREADS + F.tid; tok < T_TOK; tok += F.G * NTHREADS) { const int bk = tok_bkt[tok]; const int slot = start[bk] * 256 + tok_rank[tok]; slot_tok[slot] = tok; slot_c[slot] = tok_c[tok]; }
    for (int b = F.bid; b < 24; b += F.G) { const int s0 = start[b] * 256 + cnt[b], s1 = start[b + 1] * 256;
        for (int s = s0 + F.tid; s < s1; s += NTHREADS) { slot_tok[s] = -1; slot_c[s] = (f32x2){0.f, 0.f}; } }
    if (F.bid == 0) { if (F.tid == 0) tile_tab[0] = start[24];
        for (int m = F.tid; m < 288; m += NTHREADS) { int bk = 23; for (int b = 0; b < 24; ++b) if (m >= start[b] && m < start[b + 1]) bk = b; tile_tab[64 + m] = bk; } }
}

__device__ __forceinline__ void phase_mix5(const Params& p, const Frame& F, const bf16_t* h, bf16_t* ou, bf16_t* o0, bf16_t* o1, bf16_t* o2) {
    const float* mu = p.in[12];
    f32x4 wv[4], m0[4], m1[4], m2[4];
    row_load(p.in[1] + DM, F.lane, wv); row_load(mu, F.lane, m0); row_load(mu + 2 * DM, F.lane, m1); row_load(mu + 3 * DM, F.lane, m2);
    for (int run = F.bid * 8 + F.wave; run < T_TOK / 32; run += F.G * 8) {
        const int t0 = run * 32;
        f32x4 up[4];
        if ((t0 & (SEQ - 1)) == 0) {
#pragma unroll
            for (int j = 0; j < 4; ++j) up[j] = (f32x4){0.f, 0.f, 0.f, 0.f};
            row_store_bf16(ou + (size_t)(t0 + (t0 >> 12)) * DM, F.lane, up);
        } else { row_load_bf(h + (size_t)(t0 - 1) * DM, F.lane, up); const float rs = row_rstd(up, 1e-6f);
#pragma unroll
            for (int j = 0; j < 4; ++j) up[j] = up[j] * rs * wv[j]; }
        f32x4 u[4], un[4]; row_load_bf(h + (size_t)t0 * DM, F.lane, u);
        for (int tt = 0; tt < 32; ++tt) {
            if (tt + 1 < 32) row_load_bf(h + (size_t)(t0 + tt + 1) * DM, F.lane, un);
            const float rs = row_rstd(u, 1e-6f);
            f32x4 a[4], b[4], c[4];
#pragma unroll
            for (int j = 0; j < 4; ++j) { u[j] = u[j] * rs * wv[j]; const f32x4 xx = up[j] - u[j]; a[j] = u[j] + xx * m0[j]; b[j] = u[j] + xx * m1[j]; c[j] = u[j] + xx * m2[j]; }
            const size_t ro = (size_t)(t0 + tt) * DM;
            row_store_bf16(ou + ro + (size_t)((t0 >> 12) + 1) * DM, F.lane, u);
            row_store_bf16(o0 + ro, F.lane, a); row_store_bf16(o1 + ro, F.lane, b); row_store_bf16(o2 + ro, F.lane, c);
#pragma unroll
            for (int j = 0; j < 4; ++j) { up[j] = u[j]; u[j] = un[j]; }
        }
    }
}

typedef __bf16 bf16x2v __attribute__((ext_vector_type(2)));
__device__ __forceinline__ unsigned pkc(float lo, float hi) { f32x2 t = {lo, hi}; bf16x2v r = __builtin_convertvector(t, bf16x2v); return __builtin_bit_cast(unsigned, r); }
__device__ __forceinline__ unsigned off_r(unsigned row, unsigned ch) { return row * 128u + 16u * (ch ^ ((row >> 1) & 7u)); }
__device__ __forceinline__ unsigned off_m(unsigned row, unsigned ch) { return row * 64u + 16u * (ch ^ ((0u - (row >> 2)) & 3u)); }
#define MFMA16(a, b, c) __builtin_amdgcn_mfma_f32_16x16x32_bf16((a), (b), (c), 0, 0, 0)
__device__ __forceinline__ void swap32(float& a, float& b) { asm volatile("s_nop 1\n\tv_permlane32_swap_b32 %0, %1\n\ts_nop 1" : "+v"(a), "+v"(b)); }
__device__ __forceinline__ float half_sum(float x, bool hf) {
    x = dpp_sum16(x);
    x += __builtin_bit_cast(float, __builtin_amdgcn_update_dpp(0, __builtin_bit_cast(int, x), 0x142, 0xA, 0xF, false));
    const float lo = __builtin_bit_cast(float, __builtin_amdgcn_readlane(__builtin_bit_cast(int, x), 31)), hi = __builtin_bit_cast(float, __builtin_amdgcn_readlane(__builtin_bit_cast(int, x), 63));
    return hf ? hi : lo;
}
__device__ __forceinline__ void phase_rwkv(const Params& p, const Frame& F, bf16_t* rbuf, const bf16_t* kbuf, const bf16_t* vbuf, const bf16_t* ebuf, const bf16_t* abuf, const bf16_t* gbuf) {
    constexpr unsigned ORA = 0, OLB = 16384, OMS = 32768, OMU = 49152, OMY = 53248, OAB = 57344, OAK = 61440, OVT = 65536, OGC = 73728, OYS = 74752, OVF = 91136, OGG = 107520, OBON = 123904;
    LAS unsigned char* L = F.lds;
    const float* k_k = p.in[25]; const float* k_a = p.in[26]; const float* r_k = p.in[27]; const float* lnw = p.in[28]; const float* lnb = p.in[29];
    const int lane0 = F.lane, w = F.wave, pc = w >> 1, th = w & 1;
    for (int unit = F.bid; unit < 256; unit += F.G) {
        const int b = unit >> 4, hd = unit & 15;
        const int gc2 = hd * 64 + 2 * (lane0 & 31);
        const f32x2 kkw = *(const f32x2*)(k_k + gc2), kaw = *(const f32x2*)(k_a + gc2), rkw = *(const f32x2*)(r_k + gc2), lw = *(const f32x2*)(lnw + gc2), lb = *(const f32x2*)(lnb + gc2);
        int lane = lane0;
        f32x4 St[4];
#pragma unroll
        for (int mt = 0; mt < 4; ++mt) St[mt] = (f32x4){0.f, 0.f, 0.f, 0.f};
        unsigned pr[4], pk[4], pv[4], pe[4], pa[4], pg[4], pe0[4];
#define RW_LOAD(t0_) do { const size_t ub_ = ((size_t)b * SEQ + (t0_) + 16 * pc + 8 * th) * DM + hd * 64, ub0_ = ((size_t)b * SEQ + (t0_) + 16 * pc) * DM + hd * 64;     \
            const bf16_t* r_ = rbuf + ub_; const bf16_t* k_ = kbuf + ub_; const bf16_t* v_ = vbuf + ub_; const bf16_t* e_ = ebuf + ub_; const bf16_t* a_ = abuf + ub_; const bf16_t* g_ = gbuf + ub_; const bf16_t* e0_ = ebuf + ub0_; \
            _Pragma("unroll") for (int it = 0; it < 4; ++it) { const unsigned lo_ = (unsigned)((4 * (lane >> 5) + it) * DM + 2 * (lane & 31)); \
            pr[it] = __builtin_nontemporal_load((const unsigned*)(r_ + lo_)); pk[it] = __builtin_nontemporal_load((const unsigned*)(k_ + lo_)); pv[it] = __builtin_nontemporal_load((const unsigned*)(v_ + lo_)); pe[it] = __builtin_nontemporal_load((const unsigned*)(e_ + lo_)); pa[it] = __builtin_nontemporal_load((const unsigned*)(a_ + lo_)); pg[it] = __builtin_nontemporal_load((const unsigned*)(g_ + lo_)); pe0[it] = *(const unsigned*)(e0_ + lo_); } } while (0)
        RW_LOAD(0);
        SP_DECL;
        for (int t0 = 0; t0 < SEQ; t0 += 64) {
            LDS_BAR();
            SP_MARK(4);
            asm volatile("" : "+v"(lane));
            const unsigned l15 = lane & 15, q = (unsigned)lane >> 4, cp = lane & 31;
            const bool hf = lane >= 32;
            const unsigned pj = 32u * (cp >> 4) + 8u * ((cp & 7) >> 1) + 2u * (cp & 1) + ((cp & 8) ? 4u : 0u);
            {
                float pl0[4], pl1[4], ls0 = 0.f, ls1 = 0.f, f0 = 0.f, f1 = 0.f;
#pragma unroll
                for (int it = 0; it < 4; ++it) { ls0 += bflo(pe[it]); ls1 += bfhi(pe[it]); pl0[it] = ls0; pl1[it] = ls1; f0 += bflo(pe0[it]); f1 += bfhi(pe0[it]); }
                float xa0 = 0.f, xb0 = ls0, xa1 = 0.f, xb1 = ls1; swap32(xa0, xb0); swap32(xa1, xb1);
                float ya0 = f0, yb0 = f0, ya1 = f1, yb1 = f1; swap32(ya0, yb0); swap32(ya1, yb1);
                const float base0 = xa0 + (th ? f0 + (hf ? ya0 : yb0) : 0.f), base1 = xa1 + (th ? f1 + (hf ? ya1 : yb1) : 0.f);
                float ms0[8], ms1[8], vt0[4], vt1[4];
                LAS unsigned char* ra = L + ORA + pc * 4096; LAS unsigned char* lbp = L + OLB + pc * 4096;
#pragma unroll
                for (int it = 0; it < 4; ++it) {
                    const int t = 8 * th + 4 * (int)hf + it, tb = 16 * pc + t;
                    const float r0 = bflo(pr[it]), r1 = bfhi(pr[it]), k0 = bflo(pk[it]), k1 = bfhi(pk[it]), a0 = bflo(pa[it]), a1 = bfhi(pa[it]);
                    const float kv0 = k0 * kkw[0], kv1 = k1 * kkw[1]; const float ss = half_sum(kv0 * kv0 + kv1 * kv1, hf); const float rn = rsqrtf(fmaxf(ss, 1e-24f));
                    const float kk0 = kv0 * rn, kk1 = kv1 * rn;
                    const float kp0 = k0 * (1.f + (a0 - 1.f) * kaw[0]), kp1 = k1 * (1.f + (a1 - 1.f) * kaw[1]);
                    const float bon = half_sum(r0 * kp0 * rkw[0] + r1 * kp1 * rkw[1], hf);
                    const float lp0 = -(base0 + (it ? pl0[it ? it - 1 : 0] : 0.f)), lp1 = -(base1 + (it ? pl1[it ? it - 1 : 0] : 0.f)), lc0 = -(base0 + pl0[it]), lc1 = -(base1 + pl1[it]);
                    const float ea0 = __expf(lp0), ea1 = __expf(lp1), eb0 = __expf(lc0), eb1 = __expf(lc1), ei0 = __expf(-lc0), ei1 = __expf(-lc1);
                    const float bt0 = kk0 * a0 * ei0, bt1 = kk1 * a1 * ei1, kt0 = kp0 * ei0, kt1 = kp1 * ei1;
                    *(LAS unsigned*)(ra + off_r(t, pj >> 3) + 2 * (pj & 7)) = pkc(-kk0 * ea0, -kk1 * ea1); *(LAS unsigned*)(ra + off_r(16 + t, pj >> 3) + 2 * (pj & 7)) = pkc(r0 * eb0, r1 * eb1);
                    *(LAS unsigned*)(lbp + off_r(t, pj >> 3) + 2 * (pj & 7)) = pkc(bt0, bt1); *(LAS unsigned*)(lbp + off_r(16 + t, pj >> 3) + 2 * (pj & 7)) = pkc(kt0, kt1);
                    ms0[it] = bt0; ms0[4 + it] = kt0; ms1[it] = bt1; ms1[4 + it] = kt1; vt0[it] = bflo(pv[it]); vt1[it] = bfhi(pv[it]);
                    *(LAS f32x2*)(L + OVF + (tb * 64 + 2 * cp) * 4) = (f32x2){bflo(pv[it]), bfhi(pv[it])}; *(LAS f32x2*)(L + OGG + (tb * 64 + 2 * cp) * 4) = (f32x2){bflo(pg[it]), bfhi(pg[it])};
                    if (cp == 0) *(LAS float*)(L + OBON + tb * 4) = bon;
                    if (it == 3 && th && hf) *(LAS f32x2*)(L + OGC + pc * 256 + 2 * cp * 4) = (f32x2){eb0, eb1};
                }
                { u32x4 m0, m1; m0.x = pkc(ms0[0], ms0[1]); m0.y = pkc(ms0[2], ms0[3]); m0.z = pkc(ms0[4], ms0[5]); m0.w = pkc(ms0[6], ms0[7]); m1.x = pkc(ms1[0], ms1[1]); m1.y = pkc(ms1[2], ms1[3]); m1.z = pkc(ms1[4], ms1[5]); m1.w = pkc(ms1[6], ms1[7]);
                  *(LAS u32x4*)(L + OMS + pc * 4096 + off_m(2 * cp, 2 * th + (unsigned)hf)) = m0; *(LAS u32x4*)(L + OMS + pc * 4096 + off_m(2 * cp + 1, 2 * th + (unsigned)hf)) = m1;
                  u32x2 w0, w1; w0.x = pkc(vt0[0], vt0[1]); w0.y = pkc(vt0[2], vt0[3]); w1.x = pkc(vt1[0], vt1[1]); w1.y = pkc(vt1[2], vt1[3]);
                  *(LAS u32x2*)(L + OVT + pc * 2048 + (2 * cp) * 32 + (8 * th + 4 * (unsigned)hf) * 2) = w0; *(LAS u32x2*)(L + OVT + pc * 2048 + (2 * cp + 1) * 32 + (8 * th + 4 * (unsigned)hf) * 2) = w1; }
            }
            if (t0 + 64 < SEQ) RW_LOAD(t0 + 64);
            LDS_BAR();
            SP_MARK(1);
            if (w < 4) {
                {
                    const int c = w;
                    f32x4 g00 = (f32x4){0.f, 0.f, 0.f, 0.f}, g01 = g00, g10 = g00, g11 = g00;
#pragma unroll
                    for (int ks = 0; ks < 2; ++ks) {
                        const bf16x8 a0 = *(const LAS bf16x8*)(L + OLB + c * 4096 + off_r(l15, 4 * ks + q)), a1 = *(const LAS bf16x8*)(L + OLB + c * 4096 + off_r(16 + l15, 4 * ks + q));
                        const bf16x8 b0 = *(const LAS bf16x8*)(L + ORA + c * 4096 + off_r(l15, 4 * ks + q)), b1 = *(const LAS bf16x8*)(L + ORA + c * 4096 + off_r(16 + l15, 4 * ks + q));
                        g00 = MFMA16(a0, b0, g00); g01 = MFMA16(a0, b1, g01); g10 = MFMA16(a1, b0, g10); g11 = MFMA16(a1, b1, g11);
                    }
                    f32x4 ab, ak; float br[4], kr[4];
#pragma unroll
                    for (int g = 0; g < 4; ++g) { const bool lt = (4 * q + g) < l15, le = (4 * q + g) <= l15; ab[g] = lt ? g00[g] : 0.f; ak[g] = lt ? g10[g] : 0.f; br[g] = le ? g01[g] : 0.f; kr[g] = le ? g11[g] : 0.f; }
                    *(LAS f32x4*)(L + OAB + c * 1024 + (l15 * 16 + 4 * q) * 4) = ab; *(LAS f32x4*)(L + OAK + c * 1024 + (l15 * 16 + 4 * q) * 4) = ak;
                    u32x4 yw; yw.x = pkc(br[0], br[1]); yw.y = pkc(br[2], br[3]); yw.z = pkc(kr[0], kr[1]); yw.w = pkc(kr[2], kr[3]);
                    *(LAS u32x4*)(L + OMY + c * 1024 + off_m(l15, q)) = yw;
                    if (lane < 32) {
                        float row[16];
#pragma unroll
                        for (int t = 0; t < 16; ++t) {
                            const LAS f32x4* abr = (const LAS f32x4*)(L + OAB + c * 1024 + t * 64);
                            const f32x4 x0 = abr[0], x1 = abr[1], x2 = abr[2], x3 = abr[3];
                            const float abv[16] = {x0[0], x0[1], x0[2], x0[3], x1[0], x1[1], x1[2], x1[3], x2[0], x2[1], x2[2], x2[3], x3[0], x3[1], x3[2], x3[3]};
                            float acc1 = (lane < 16) ? ((lane == t) ? 1.f : 0.f) : *(const LAS float*)(L + OAK + c * 1024 + (t * 16 + (lane & 15)) * 4);
#pragma unroll
                            for (int s_ = 0; s_ < t; ++s_) acc1 += row[s_] * abv[s_];
                            row[t] = acc1;
                        }
                        const unsigned pp = (lane < 16) ? (8u * (lane >> 2) + (lane & 3)) : (8u * ((lane & 15) >> 2) + 4u + (lane & 3));
#pragma unroll
                        for (int t = 0; t < 16; ++t) *(LAS bf16_t*)(L + OMU + c * 1024 + off_m(t, pp >> 3) + 2 * (pp & 7)) = (bf16_t)(pkc(row[t], 0.f) & 0xffffu);
                    }
                }
            }
            LDS_BAR();
            SP_MARK(2);
            if (w < 4) {
#pragma unroll 1
                for (int c = 0; c < 4; ++c) {
                    bf16x8 Sb0, Sb1;
                    { u32x4 t0_; t0_.x = pkc(St[0][0], St[0][1]); t0_.y = pkc(St[0][2], St[0][3]); t0_.z = pkc(St[1][0], St[1][1]); t0_.w = pkc(St[1][2], St[1][3]); Sb0 = __builtin_bit_cast(bf16x8, t0_);
                      u32x4 t1_; t1_.x = pkc(St[2][0], St[2][1]); t1_.y = pkc(St[2][2], St[2][3]); t1_.z = pkc(St[3][0], St[3][1]); t1_.w = pkc(St[3][2], St[3][3]); Sb1 = __builtin_bit_cast(bf16x8, t1_); }
                    f32x4 Za = (f32x4){0.f, 0.f, 0.f, 0.f}, Zr = Za;
                    Za = MFMA16(*(const LAS bf16x8*)(L + ORA + c * 4096 + off_r(l15, q)), Sb0, Za); Za = MFMA16(*(const LAS bf16x8*)(L + ORA + c * 4096 + off_r(l15, 4 + q)), Sb1, Za);
                    Zr = MFMA16(*(const LAS bf16x8*)(L + ORA + c * 4096 + off_r(16 + l15, q)), Sb0, Zr); Zr = MFMA16(*(const LAS bf16x8*)(L + ORA + c * 4096 + off_r(16 + l15, 4 + q)), Sb1, Zr);
                    const u32x2 vt = *(const LAS u32x2*)(L + OVT + c * 2048 + (16 * w + l15) * 32 + 8 * q);
                    u32x4 bu; bu.x = pkc(Za[0], Za[1]); bu.y = pkc(Za[2], Za[3]); bu.z = vt.x; bu.w = vt.y;
                    f32x4 U = (f32x4){0.f, 0.f, 0.f, 0.f};
                    U = MFMA16(*(const LAS bf16x8*)(L + OMU + c * 1024 + off_m(l15, q)), __builtin_bit_cast(bf16x8, bu), U);
                    u32x4 by; by.x = pkc(U[0], U[1]); by.y = pkc(U[2], U[3]); by.z = vt.x; by.w = vt.y;
                    const bf16x8 By = __builtin_bit_cast(bf16x8, by);
                    const f32x4 Yt = MFMA16(*(const LAS bf16x8*)(L + OMY + c * 1024 + off_m(l15, q)), By, Zr);
#pragma unroll
                    for (int mt = 0; mt < 4; ++mt) { St[mt] = MFMA16(*(const LAS bf16x8*)(L + OMS + c * 4096 + off_m(16 * mt + l15, q)), By, St[mt]);
                        const f32x4 gc = *(const LAS f32x4*)(L + OGC + c * 256 + (16 * mt + 4 * q) * 4); St[mt] = St[mt] * gc; }
#pragma unroll
                    for (int g = 0; g < 4; ++g) *(LAS float*)(L + OYS + ((16 * c + 4 * q + g) * 64 + 16 * w + l15) * 4) = Yt[g];
                }
            }
            LDS_BAR();
            SP_MARK(3);
            bf16_t* ob_ = rbuf + ((size_t)b * SEQ + t0 + w) * DM + hd * 64;
#pragma unroll
            for (int iq = 0; iq < 4; ++iq) { const int tq = 2 * iq + (int)hf, t = w + 8 * tq; const int li = t * 64 + 2 * (int)cp;
                const f32x2 y = *(const LAS f32x2*)(L + OYS + li * 4); const float mean = half_sum(y[0] + y[1], hf) * (1.f / 64.f); const float d0 = y[0] - mean, d1 = y[1] - mean;
                const float rs = rsqrtf(half_sum(d0 * d0 + d1 * d1, hf) * (1.f / 64.f) + 64e-5f);
                const f32x2 vv = *(const LAS f32x2*)(L + OVF + li * 4), gg = *(const LAS f32x2*)(L + OGG + li * 4); const float bo = *(const LAS float*)(L + OBON + t * 4);
                const float o0 = (d0 * rs * lw[0] + lb[0] + bo * vv[0]) * gg[0], o1 = (d1 * rs * lw[1] + lb[1] + bo * vv[1]) * gg[1];
                *(unsigned*)(ob_ + (unsigned)(8 * tq * DM + 2 * (int)cp)) = pkc(o0, o1); }
        }
#undef RW_LOAD
    }
}

__global__ void __launch_bounds__(NTHREADS, 2) mega_fwd(Params p) {
    extern __shared__ __attribute__((aligned(16))) unsigned char lds_raw[];
    Frame F;
    F.lds = (LAS unsigned char*)lds_raw;
    F.tid = threadIdx.x; F.lane = F.tid & 63; F.wave = __builtin_amdgcn_readfirstlane(F.tid >> 6); F.G = gridDim.x; F.bid = blockIdx.x;
    F.out = p.out; F.ws = p.ws;
    volatile LAS unsigned* misc = (volatile LAS unsigned*)(F.lds + LDS_MISC);
    if (F.tid < 32) misc[F.tid] = 0u;
    __syncthreads();
    const int lo = p.ph_lo, hi = p.ph_hi;
    XcdBarrier bar; bar.bar = (unsigned*)(F.ws + WS_CTL); bar.x = 0; bar.st = misc;
    if (hi - lo > 1) bar = xcd_barrier_post((unsigned*)(F.ws + WS_CTL), misc);
#define IN(k) (lo <= (k) && (k) < hi)
#if PROBE_MASK
    unsigned long long pr_t0 = 0ull, pr_acc = 0ull;
#define PSTART(k) do { if ((PROBE_MASK >> (k)) & 1u) pr_t0 = wall_clock64(); } while (0)
#define PEND(k) do { if ((PROBE_MASK >> (k)) & 1u) pr_acc += wall_clock64() - pr_t0; } while (0)
#else
#define PSTART(k) do {} while (0)
#define PEND(k) do {} while (0)
#endif
#if PROBE_SUB == 11
#define SEAM(k) do { if (IN(k) && IN((k) + 1)) { unsigned long long b0_ = 0ull; if (F.tid == 0) b0_ = wall_clock64(); xcd_barrier(bar); if (F.tid == 0) *(LAS unsigned long long*)(F.lds + LDS_MISC + 64) += wall_clock64() - b0_; } PEND(k); PSTART((k) + 1); } while (0)
#else
#define SEAM(k) do { if (IN(k) && IN((k) + 1)) xcd_barrier(bar); PEND(k); PSTART((k) + 1); } while (0)
#endif
    bf16_t* wb = WSP(bf16_t, WS_WB);
    bf16_t* S0 = WSP(bf16_t, WS_SLAB); bf16_t* S2 = WSP(bf16_t, WS_SLAB + 2 * SLAB); bf16_t* S3 = WSP(bf16_t, WS_SLAB + 3 * SLAB); bf16_t* S4 = WSP(bf16_t, WS_SLAB + 4 * SLAB); bf16_t* S5 = WSP(bf16_t, WS_SLAB + 5 * SLAB);
    bf16_t* EH = WSP(bf16_t, WS_E);
    bf16_t* O0 = (bf16_t*)F.out; bf16_t* O1 = O0 + (size_t)T_TOK * DM;
    bf16_t* hres = (bf16_t*)F.out;
    bf16_t* S1 = WSP(bf16_t, WS_SLAB + 1 * SLAB);
    const int vcu = (F.G % 8 == 0) ? F.bid : F.bid;

    PSTART(0);
    if (IN(0)) { phase_prep(p, F, 0, PT_WIN, true); phase_rmsnorm<true>(p, F, p.in[0], p.in[1], O0); } SEAM(0);
    if (IN(2)) { DenseP<EK_INPROJ> P{}; P.pid = 2; P.v0 = (const float*)(F.ws + WS_ROPE); P.K = 1024; P.lda = 1024; P.ldb = 1024; P.nM = 256; P.nN = NPROJ / 256; P.nprob = 1; P.G = F.G; P.c = vcu; P.A = O0; P.a_stride = 0; P.B = wb + WB_WIN / 2; P.b_stride = 0;
        P.O = S0; P.o_stride = 0; P.ldc = NPROJ; gemm_phase(F.lds, P); } SEAM(2);
    if (IN(3)) { phase_conv(p, F); } SEAM(3);
    if (IN(4)) { phase_scan0(p, F); } SEAM(4);
    if (IN(5)) { phase_prep(p, F, PT_WIN, PT_WOUT, false); phase_gatenorm(p, F); } SEAM(5);
    if (IN(6)) { DenseP<EK_F32RES> P{}; P.pid = 6; P.K = 2048; P.lda = NPROJ; P.ldb = 2048; P.nM = 256; P.nN = 4; P.nprob = 1; P.G = F.G; P.c = vcu; P.A = S0; P.B = wb + WB_WOUT / 2; P.resf = p.in[0]; P.resb = nullptr; P.Ob = hres; P.ldc = 1024; gemm_phase(F.lds, P); } SEAM(6);
#define MOE_LAYER(L, k0) \
    if (IN(k0)) { phase_prep(p, F, PT_L2 + (L) * 4096, PT_L2 + (L) * 4096 + 4096, false); phase_prep(p, F, PT_W13 + (L) * 2048, PT_W13 + (L) * 2048 + 2048, false); phase_moe_route(p, F, L, hres, S2); } SEAM(k0); \
    if (IN(k0 + 1)) { phase_moe_slots(p, F, L); } SEAM(k0 + 1); \
    if (IN(k0 + 2)) { unsigned char* meta = F.ws + WS_META + (size_t)(L) * META_STRIDE; Moe1P P{}; P.pid = (k0) + 2; P.K = 1024; P.lda = 1024; P.ldb = 1024; P.G = F.G; P.c = vcu; \
        P.ntiles = __builtin_amdgcn_readfirstlane(ld_vec_i32((const int*)(meta + MT_TILE))); P.A = S2; P.W13 = wb + WB_W13 / 2 + (size_t)(L) * 16 * 1048576; P.H = S3; \
        P.slot_tok = (const int*)(meta + MT_STOK); P.slot_c = (const float*)(meta + MT_SC); P.tile_bkt = (const int*)(meta + MT_TILE) + 64; gemm_phase(F.lds, P); } SEAM(k0 + 2); \
    if (IN(k0 + 3)) { unsigned char* meta = F.ws + WS_META + (size_t)(L) * META_STRIDE; Moe2P P{}; P.pid = (k0) + 3; P.K = 1024; P.lda = 1024; P.ldb = 512; P.G = F.G; P.c = vcu; \
        P.ntiles = __builtin_amdgcn_readfirstlane(ld_vec_i32((const int*)(meta + MT_TILE))); P.H = S3; P.W2 = wb + WB_W2 / 2 + (size_t)(L) * 16 * 524288; P.hsrc = hres; P.hdst = ((L) == 1) ? S0 : hres; \
        P.slot_tok = (const int*)(meta + MT_STOK); P.tile_bkt = (const int*)(meta + MT_TILE) + 64; gemm_phase(F.lds, P); } SEAM(k0 + 3);
    MOE_LAYER(0, 7)
    if (IN(11)) { phase_prep(p, F, PT_WOUT, PT_L2, false); phase_mix5(p, F, hres, S0, S2, S3, S4); } SEAM(11);
    if (IN(12)) { DenseP<EK_LORA1> P{}; P.pid = 12; P.K = 2048; P.lda = 1024; P.ldb = 2048; P.nM = 256; P.nN = 2; P.nprob = 1; P.G = F.G; P.c = vcu; P.A = S0; P.a_skew = 1; P.a_split = 16; P.a_jump = -(long)(1024 * 2) - 16 * (BK * 2);
        P.B = wb + WB_L1 / 2; P.O = EH; P.ldc = 512; gemm_phase(F.lds, P); } SEAM(12);
    if (IN(14)) { DenseP<EK_BF16> P{}; P.pid = 14; P.K = 1024; P.lda = 1024; P.ldb = 1024; P.nM = 256; P.nN = 4; P.nprob = 3; P.G = F.G; P.c = vcu; P.ldc = 1024; P.A = S2; P.a_stride = (size_t)T_TOK * DM; P.B = wb + WB_WR / 2; P.b_stride = 1048576;
        P.O = S5; P.Oalt1 = S0; P.Oalt2 = S1; gemm_phase(F.lds, P); } SEAM(14);
    if (IN(15)) { DenseP<EK_LORA2> P{}; P.pid = 15; P.K = 256; P.lda = 512; P.ldb = 256; P.nM = 256; P.nN = 4; P.nprob = 3; P.G = F.G; P.c = vcu; P.A = EH; P.Aalt1 = EH; P.Aalt2 = EH + 128; P.B = wb + WB_L2 / 2; P.b_stride = 262144;
        P.O = S2; P.o_stride = (size_t)T_TOK * DM; P.ldc = 1024; P.v0 = p.in[17]; P.v1 = p.in[20]; gemm_phase(F.lds, P); } SEAM(15);
    if (IN(16)) { phase_rwkv(p, F, S5, S0, S1, S2, S3, S4); } SEAM(16);
    if (IN(17)) { DenseP<EK_F32RES> P{}; P.pid = 17; P.K = 1024; P.lda = 1024; P.ldb = 1024; P.nM = 256; P.nN = 4; P.nprob = 1; P.G = F.G; P.c = vcu; P.A = S5; P.B = wb + WB_WO / 2; P.resf = nullptr; P.resb = hres; P.Ob = hres; P.ldc = 1024; gemm_phase(F.lds, P); } SEAM(17);
    MOE_LAYER(1, 18)
    if (IN(22)) { phase_rmsnorm<false, true>(p, F, S0, p.in[3], F.out); }
#if PROBE_SUB
    if (F.bid == 0 && F.tid == 0) { const unsigned long long d_ = *(LAS unsigned long long*)(F.lds + LDS_MISC + 64); const unsigned long long t = wall_clock64(); while (wall_clock64() - t < d_) __builtin_amdgcn_s_sleep(8); }
#endif
#if PROBE_MASK
    PEND(22);
    if (F.bid == 0 && F.tid == 0) { const unsigned long long t = wall_clock64(); while (wall_clock64() - t < pr_acc) __builtin_amdgcn_s_sleep(8); }
#endif
}

extern "C" void kernel_launch(void* const* d_in, const int* in_sizes, int n_in, void* d_out, int out_size, void* d_ws, size_t ws_size, hipStream_t stream) {
    static int grid = 0;
    if (grid == 0) {
        if (n_in != 37 || out_size != T_TOK * DM || ws_size < WS_END) { fprintf(stderr, "kernel_launch: unexpected shapes (n_in %d out %d ws %zu)\n", n_in, out_size, ws_size); grid = -1; return; }
        int dev = 0, cus = 0, per_cu = 0;
        if (hipGetDevice(&dev) != hipSuccess || hipDeviceGetAttribute(&cus, hipDeviceAttributeMultiprocessorCount, dev) != hipSuccess) { grid = -1; return; }
        if (hipFuncSetAttribute((const void*)mega_fwd, hipFuncAttributeMaxDynamicSharedMemorySize, LDS_BYTES) != hipSuccess) { fprintf(stderr, "kernel_launch: hipFuncSetAttribute failed\n"); grid = -1; return; }
        if (hipOccupancyMaxActiveBlocksPerMultiprocessor(&per_cu, (const void*)mega_fwd, NTHREADS, LDS_BYTES) != hipSuccess || per_cu < 1) fprintf(stderr, "kernel_launch: occupancy query says %d\n", per_cu);
        (void)hipGetLastError();
        grid = cus;
        if (grid < 128 || grid > 512) { fprintf(stderr, "kernel_launch: built for 128..512 CUs (the MoE router keeps <= 512 tokens per workgroup in LDS); got %d\n", grid); grid = -1; return; }
    }
    if (grid < 0) return;
    (void)in_sizes;
    hipMemsetAsync((char*)d_ws + WS_CTL, 0, CTL_ZERO_BYTES, stream);
    Params p{};
    for (int i = 0; i < 37; ++i) p.in[i] = (const float*)d_in[i];
    p.out = (float*)d_out; p.ws = (unsigned char*)d_ws;
#if MK_PER_PHASE
    for (int k = 0; k < NPHASE; ++k) { p.ph_lo = k; p.ph_hi = k + 1; hipLaunchKernelGGL(mega_fwd, dim3(grid), dim3(NTHREADS), LDS_BYTES, stream, p); }
#else
    p.ph_lo = 0; p.ph_hi = NPHASE; hipLaunchKernelGGL(mega_fwd, dim3(grid), dim3(NTHREADS), LDS_BYTES, stream, p);
#endif
}
```

```cpp
#include <hip/hip_runtime.h>
#include <stdint.h>
#include <stdio.h>

#ifndef MK_PER_PHASE
#define MK_PER_PHASE 0
#endif

#ifndef PROBE_MASK
#define PROBE_MASK 0u
#endif
#ifndef PROBE_PID
#define PROBE_PID -1
#endif
#ifndef PROBE_SUB
#define PROBE_SUB 0
#endif
#define LAS __attribute__((address_space(3)))
typedef unsigned short bf16_t;
typedef short bf16x8 __attribute__((ext_vector_type(8)));
typedef float f32x4 __attribute__((ext_vector_type(4)));
typedef float f32x2 __attribute__((ext_vector_type(2)));
typedef unsigned u32x4 __attribute__((ext_vector_type(4)));
typedef unsigned u32x2 __attribute__((ext_vector_type(2)));

constexpr int T_TOK = 65536, DM = 1024, SEQ = 4096;
constexpr int NPROJ = 5888;
constexpr int PC_Z = 0, PC_XBC = 1024, PC_Q = 2560, PC_K = 3072, PC_V = 3584, PC_G = 4608, PC_DT = 5632;
constexpr int NTHREADS = 512;
constexpr int LDS_BYTES = 147456;
constexpr int LDS_MISC = LDS_BYTES - 256;
constexpr int NSLOT = T_TOK + 24 * 256;
constexpr int NPHASE = 23;
constexpr int PT_WIN = 1472, PT_WOUT = PT_WIN + 512, PT_RW = PT_WOUT + 1024, PT_L1 = PT_RW + 256, PT_L2 = PT_L1 + 192, PT_W13 = PT_L2 + 8192, PT_W2 = PT_W13 + 4096;
#if PROBE_SUB
#define SP_DECL unsigned long long sp_t_ = wall_clock64()
#define SP_MARK(id_end) do { if (F.tid == 0) { const unsigned long long n_ = wall_clock64(); if ((id_end) == PROBE_SUB) *(LAS unsigned long long*)(F.lds + LDS_MISC + 64) += n_ - sp_t_; sp_t_ = n_; } } while (0)
#else
#define SP_DECL do {} while (0)
#define SP_MARK(id_end) do {} while (0)
#endif

constexpr size_t MiB = 1024 * 1024;
constexpr size_t WS_CTL = 0;
constexpr size_t CTL_ZERO_BYTES = 16384;
constexpr size_t CTL_CNT_OFF = 14336;
constexpr size_t WS_META = 64 * 1024;
constexpr size_t META_STRIDE = 2 * MiB - 32 * 1024;
constexpr size_t MT_RANK = 0, MT_BKT = 262144, MT_C = 524288, MT_STOK = 1048576, MT_SC = 1048576 + 294912, MT_TILE = 1048576 + 294912 + 589824;
constexpr size_t WS_ROPE = 4 * MiB;
constexpr size_t WS_WB = 6 * MiB;
constexpr size_t WB_WIN = 0, WB_WOUT = WB_WIN + (size_t)NPROJ * 1024 * 2, WB_WR = WB_WOUT + (size_t)1024 * 2048 * 2, WB_WK = WB_WR + 2 * MiB, WB_WV = WB_WK + 2 * MiB, WB_WO = WB_WV + 2 * MiB,
                 WB_L1 = WB_WO + 2 * MiB  , WB_L2 = WB_L1 + 2 * MiB  , WB_W13 = WB_L2 + 3 * 512 * 1024  ,
                 WB_W2 = WB_W13 + (size_t)32 * 2 * MiB  , WB_END = WB_W2 + (size_t)32 * MiB;
constexpr size_t WS_SLAB = 130 * MiB;
constexpr size_t SLAB = 128 * MiB;
constexpr size_t WS_E = WS_SLAB + 6 * SLAB;
constexpr size_t WS_END = WS_E + 96 * MiB;
constexpr size_t WS_RTW = WS_WB + WB_END;
static_assert(WS_RTW + 2 * 20 * 1024 * 4 <= WS_SLAB, "weights overflow");
static_assert(WS_END <= 1024 * MiB, "workspace overflow");

struct Params {
    const float* in[37];
    float* out;
    unsigned char* ws;
    int ph_lo, ph_hi;
};

__device__ __forceinline__ float bf2f(bf16_t v) { return __uint_as_float(((unsigned)v) << 16); }
__device__ __forceinline__ float bflo(unsigned w) { return __uint_as_float(w << 16); }
__device__ __forceinline__ float bfhi(unsigned w) { return __uint_as_float(w & 0xffff0000u); }
__device__ __forceinline__ unsigned cvt_pk_bf16(float lo, float hi) { unsigned r; asm volatile("v_cvt_pk_bf16_f32 %0, %1, %2" : "=v"(r) : "v"(lo), "v"(hi)); return r; }
__device__ __forceinline__ bf16_t f2bf(float f) { return (bf16_t)(cvt_pk_bf16(f, 0.f) & 0xffffu); }
__device__ __forceinline__ float wave_sum(float v) {
#pragma unroll
    for (int o = 32; o >= 1; o >>= 1) v += __shfl_xor(v, o);
    return v;
}
__device__ __forceinline__ float dpp_sum16(float x) {
    x += __builtin_bit_cast(float, __builtin_amdgcn_update_dpp(0, __builtin_bit_cast(int, x), 0xB1, 0xF, 0xF, true));
    x += __builtin_bit_cast(float, __builtin_amdgcn_update_dpp(0, __builtin_bit_cast(int, x), 0x4E, 0xF, 0xF, true));
    x += __builtin_bit_cast(float, __builtin_amdgcn_update_dpp(0, __builtin_bit_cast(int, x), 0x141, 0xF, 0xF, true));
    x += __builtin_bit_cast(float, __builtin_amdgcn_update_dpp(0, __builtin_bit_cast(int, x), 0x140, 0xF, 0xF, true));
    return x;
}
__device__ __forceinline__ float wave_sum_u(float x) {
    x = dpp_sum16(x);
    x += __builtin_bit_cast(float, __builtin_amdgcn_update_dpp(0, __builtin_bit_cast(int, x), 0x142, 0xA, 0xF, false));
    x += __builtin_bit_cast(float, __builtin_amdgcn_update_dpp(0, __builtin_bit_cast(int, x), 0x143, 0xC, 0xF, false));
    return __builtin_bit_cast(float, __builtin_amdgcn_readlane(__builtin_bit_cast(int, x), 63));
}
__device__ __forceinline__ float fsilu(float x) { return x * __builtin_amdgcn_rcpf(1.f + __expf(-x)); }
__device__ __forceinline__ float fsigmoid(float x) { return __builtin_amdgcn_rcpf(1.f + __expf(-x)); }
__device__ __forceinline__ float fsoftplus(float x) { return x > 20.f ? x : log1pf(__expf(x)); }
__device__ __forceinline__ float ftanh(float x) { const float xc = fminf(fmaxf(x, -15.f), 15.f); const float e = __expf(2.f * xc); return (e - 1.f) * __builtin_amdgcn_rcpf(e + 1.f); }
__device__ __forceinline__ int ld_vec_i32(const int* p) { int r; asm volatile("global_load_dword %0, %1, off\n\ts_waitcnt vmcnt(0)" : "=&v"(r) : "v"(p) : "memory"); return r; }

#define XB_TMO      128
#define XB_XCNT(j)  (256  + 64 * (j))
#define XB_XSUB(j)  (1280 + 64 * (j))
#define XB_XGEN(j)  (2304 + 64 * (j))
#define XB_TOP      3328
#define XB_TOPGEN   3392
#define XCD_BAR_WORDS 3456
#define XB_SPIN_CAP (1u << 24)
__device__ __forceinline__ unsigned xb_ld(unsigned* p)              { return __hip_atomic_load(p, __ATOMIC_RELAXED, __HIP_MEMORY_SCOPE_AGENT); }
__device__ __forceinline__ unsigned xb_add(unsigned* p, unsigned v) { return __hip_atomic_fetch_add(p, v, __ATOMIC_RELAXED, __HIP_MEMORY_SCOPE_AGENT); }
__device__ __forceinline__ unsigned xb_xcc_id() { return (unsigned)__builtin_amdgcn_s_getreg((3 << 11) | 20) & 0xFu; }
#define XB_SPIN(cond, bar) do { unsigned _sp = 0; while (cond) { __builtin_amdgcn_s_sleep(1); \
    if ((++_sp & 255u) == 0u) { if (xb_ld(&(bar)[XB_TMO])) break; if (_sp > XB_SPIN_CAP) { atomicAdd(&(bar)[XB_TMO], 1u); break; } } } } while (0)
struct XcdBarrier { unsigned* bar; unsigned x; volatile LAS unsigned* st; };
__device__ __forceinline__ XcdBarrier xcd_barrier_post(unsigned* bar, volatile LAS unsigned* st) {
    XcdBarrier b; b.bar = bar; b.x = xb_xcc_id(); b.st = st;
    if (threadIdx.x == 0) (void)xb_add(&bar[XB_XCNT(b.x)], 1u);
    return b;
}
__device__ __forceinline__ void xcd_barrier_complete(unsigned* bar, unsigned x, unsigned& nloc, unsigned& nx) {
    const unsigned G = gridDim.x * gridDim.y * gridDim.z;
    unsigned sum, cnt, mine, sp = 0u;
    for (;;) {
        sum = 0u; cnt = 0u; mine = 0u;
#pragma unroll
        for (unsigned j = 0; j < 16; ++j) { const unsigned c = xb_ld(&bar[XB_XCNT(j)]); sum += c; cnt += (c > 0u) ? 1u : 0u; mine = (j == x) ? c : mine; }
        if (sum == G) break;
        __builtin_amdgcn_s_sleep(1);
        if ((++sp & 255u) == 0u) { if (xb_ld(&bar[XB_TMO])) break; if (sp > XB_SPIN_CAP) { atomicAdd(&bar[XB_TMO], 1u); break; } }
    }
    nloc = mine > 0u ? mine : 1u; nx = cnt > 0u ? cnt : 1u;
}
__device__ __forceinline__ void xcd_barrier(const XcdBarrier& b) {
    asm volatile("s_waitcnt vmcnt(0)" ::: "memory");
    __syncthreads();
    if (threadIdx.x == 0) {
        unsigned* bar = b.bar;
        __builtin_amdgcn_s_waitcnt(0);
        unsigned nloc = b.st[0], nx = b.st[1];
        if (nloc == 0u) { xcd_barrier_complete(bar, b.x, nloc, nx); b.st[0] = nloc; b.st[1] = nx; }
        const unsigned old = xb_add(&bar[XB_XSUB(b.x)], 1u);
        const unsigned gen = old / nloc;
        if (old + 1u == (gen + 1u) * nloc) {
            __builtin_amdgcn_fence(__ATOMIC_RELEASE, "agent");
            asm volatile("s_waitcnt vmcnt(0)" ::: "memory");
            const unsigned og = xb_add(&bar[XB_TOP], 1u);
            const unsigned tg = og / nx;
            if (og + 1u == (tg + 1u) * nx) xb_add(&bar[XB_TOPGEN], 1u);
            else XB_SPIN(xb_ld(&bar[XB_TOPGEN]) == tg, bar);
            __builtin_amdgcn_fence(__ATOMIC_ACQUIRE, "agent");
            xb_add(&bar[XB_XGEN(b.x)], 1u);
            asm volatile("s_waitcnt vmcnt(0)" ::: "memory");
        } else {
            XB_SPIN(xb_ld(&bar[XB_XGEN(b.x)]) == gen, bar);
            __builtin_amdgcn_fence(__ATOMIC_ACQUIRE, "agent");
            asm volatile("s_waitcnt vmcnt(0)" ::: "memory");
        }
    }
    __syncthreads();
}

typedef int i32x4v __attribute__((ext_vector_type(4)));
typedef int i32x8v __attribute__((ext_vector_type(8)));
__device__ __forceinline__ unsigned pk_fp8x4(float a, float b, float c, float d) {
    a = __builtin_amdgcn_fmed3f(a, -448.f, 448.f); b = __builtin_amdgcn_fmed3f(b, -448.f, 448.f); c = __builtin_amdgcn_fmed3f(c, -448.f, 448.f); d = __builtin_amdgcn_fmed3f(d, -448.f, 448.f);
    int w = __builtin_amdgcn_cvt_pk_fp8_f32(a, b, 0, false); w = __builtin_amdgcn_cvt_pk_fp8_f32(c, d, w, true); return (unsigned)w; }
constexpr float F8_ACT_SCALE = 8.f, F8_W_SCALE = 256.f, F8_DESCALE = 1.f / (8.f * 256.f);
constexpr int BM = 256, BK = 64, HALF = 128, HTB = HALF * BK * 2, STAGE_BYTES = 8 * HTB;
__device__ __forceinline__ int lds_byte(int r, int c) { const int st = (r >> 4) * 2 + (c >> 5), rr = r & 15, cc = c & 31, ob = rr * 64 + cc * 2; return st * 1024 + (ob ^ (((ob >> 9) & 1) << 5)); }
__device__ __forceinline__ void stage_rc(int b, int& R, int& C) { const int st = b / 1024, sb = b % 1024, swz = sb ^ (((sb >> 9) & 1) << 5); R = (st >> 1) * 16 + swz / 64; C = (st & 1) * 32 + (swz % 64) / 2; }
__device__ __forceinline__ int perm32(int rho) { const int n = rho >> 4, i = rho & 15; return 8 * (i >> 2) + 4 * n + (i & 3); }
struct Unit { int pm, pn, prob; };
__device__ __forceinline__ void tile_order(int L, int nM, int nN, int& pm, int& pn) {
    const int nwg = nM * nN; int wgid = L;
    { const int q = nwg / 8, r = nwg % 8, xcd = wgid % 8, off = wgid / 8; wgid = (xcd < r ? xcd * (q + 1) : r * (q + 1) + (xcd - r) * q) + off; }
    const int nig = 8 * nN, gid = wgid / nig, fm = gid * 8, gsz = (nM - fm) < 8 ? (nM - fm) : 8;
    pm = fm + ((wgid % nig) % gsz); pn = (wgid % nig) / gsz;
}

template <class P>
__device__ __forceinline__ void gemm_phase(LAS unsigned char* lds, const P& S) {
    const int tid = threadIdx.x, wid = __builtin_amdgcn_readfirstlane(tid >> 6), lane = tid & 63, wr = wid >> 2, wc = wid & 3, fr = lane & 15, fq = lane >> 4;
    const int K = S.K, nt = K / BK, lda = S.lda, ldb = S.ldb;
    int RA[2], CA[2]; unsigned voffB[2], vAc[2][2], vAn[2][2];
#pragma unroll
    for (int i = 0; i < 2; ++i) { int R, C; stage_rc(tid * 16 + i * 8192, R, C); RA[i] = R; CA[i] = C; const int Rb = P::PERM ? ((R & ~31) + perm32(R & 31)) : R;
        voffB[i] = (unsigned)(Rb * ldb + C) * 2u;
#pragma unroll
        for (int h = 0; h < 2; ++h) { vAc[h][i] = (unsigned)((h * HALF + R) * lda + C) * 2u; vAn[h][i] = vAc[h][i]; } }
    const size_t kstep = (size_t)(BK * 2);
    const size_t hstepB = (size_t)HALF * ldb * 2;
    const unsigned ldsw = (unsigned)wid * 1024u;
    const int aoff = lds_byte(wr * 64 + fr, fq * 8), boff = lds_byte(wc * 32 + fr, fq * 8);
#define PG8_SA(b, h) (((b) * 2 + (h)) * HTB)
#define PG8_SB(b, h) ((4 + (b) * 2 + (h)) * HTB)
#define PG8_STAGE2(bufoff, gbase, v0, v1) do { \
        __builtin_amdgcn_global_load_lds((const unsigned*)((const char*)(gbase) + (v0)), (LAS unsigned*)(lds + (bufoff) + ldsw), 16, 0, 0); \
        __builtin_amdgcn_global_load_lds((const unsigned*)((const char*)(gbase) + (v1)), (LAS unsigned*)(lds + (bufoff) + ldsw + 8192), 16, 0, 0); } while (0)
#define PG8_CAT8(x0_, x1_) __builtin_shufflevector(__builtin_bit_cast(i32x4v, x0_), __builtin_bit_cast(i32x4v, x1_), 0, 1, 2, 3, 4, 5, 6, 7)
#define PG8_LDA(dst, b, h) do { if constexpr (P::FP8) { _Pragma("unroll") for (int m = 0; m < 4; ++m) dst##8[m] = PG8_CAT8(*(const LAS bf16x8*)(lds + PG8_SA(b, h) + aoff + m * 2048), *(const LAS bf16x8*)(lds + PG8_SA(b, h) + aoff + m * 2048 + 1024)); } \
        else { _Pragma("unroll") for (int m = 0; m < 4; ++m) _Pragma("unroll") for (int k = 0; k < 2; ++k) dst[m][k] = *(const LAS bf16x8*)(lds + PG8_SA(b, h) + aoff + m * 2048 + k * 1024); } } while (0)
#define PG8_LDB(dst, b, h) do { if constexpr (P::FP8) { _Pragma("unroll") for (int n = 0; n < 2; ++n) dst##8[n] = PG8_CAT8(*(const LAS bf16x8*)(lds + PG8_SB(b, h) + boff + n * 2048), *(const LAS bf16x8*)(lds + PG8_SB(b, h) + boff + n * 2048 + 1024)); } \
        else { _Pragma("unroll") for (int n = 0; n < 2; ++n) _Pragma("unroll") for (int k = 0; k < 2; ++k) dst[n][k] = *(const LAS bf16x8*)(lds + PG8_SB(b, h) + boff + n * 2048 + k * 1024); } } while (0)
#define PG8_MMA(ai, bj, At, Bt) do { __builtin_amdgcn_s_setprio(1); \
        if constexpr (P::FP8) { _Pragma("unroll") for (int m = 0; m < 4; ++m) _Pragma("unroll") for (int n = 0; n < 2; ++n) \
            asm volatile("v_mfma_f32_16x16x128_f8f6f4 %0, %1, %2, %0" : "+v"(acc[ai][bj][m][n]) : "v"(Bt##8[n]), "v"(At##8[m])); }        \
        else { _Pragma("unroll") for (int m = 0; m < 4; ++m) _Pragma("unroll") for (int n = 0; n < 2; ++n) _Pragma("unroll") for (int k = 0; k < 2; ++k) \
            acc[ai][bj][m][n] = __builtin_amdgcn_mfma_f32_16x16x32_bf16(Bt[n][k], At[m][k], acc[ai][bj][m][n], 0, 0, 0); } \
        __builtin_amdgcn_s_setprio(0); } while (0)
#define PG8_WAIT_V(n) asm volatile("s_waitcnt vmcnt(" #n ")" ::: "memory")
#define PG8_WAIT_L(n) asm volatile("s_waitcnt lgkmcnt(" #n ")" ::: "memory")
#define PG8_BAR __builtin_amdgcn_s_barrier()
#define LDS_BAR() asm volatile("s_waitcnt lgkmcnt(0)\n\ts_barrier" ::: "memory")
#define PG8_SCHED __builtin_amdgcn_sched_barrier(0)
    Unit cur, nxt; int ui = 0;
    if (!S.next(0, cur)) return;
    struct { int tid; LAS unsigned char* lds; } F; F.tid = tid; F.lds = lds; (void)F;
    SP_DECL;
    if constexpr (P::GATHER) {
#pragma unroll
        for (int h = 0; h < 2; ++h)
#pragma unroll
            for (int i = 0; i < 2; ++i) vAc[h][i] = S.a_voff(cur, h * HALF + RA[i], CA[i]);
    }
    float zf; asm volatile("v_mov_b32 %0, 0" : "=v"(zf));
    f32x4 acc[2][2][4][2];
#pragma unroll
    for (int a = 0; a < 2; ++a)
#pragma unroll
        for (int b = 0; b < 2; ++b)
#pragma unroll
            for (int m = 0; m < 4; ++m)
#pragma unroll
                for (int n = 0; n < 2; ++n) acc[a][b][m][n] = (f32x4){zf, zf, zf, zf};
    bf16x8 At[4][2], B0[2][2], B1[2][2]; i32x8v At8[4], B08[2], B18[2]; (void)At; (void)B0; (void)B1; (void)At8; (void)B08; (void)B18;
    const char* cA = S.a_ptr(cur);
    {
        const char* b0 = S.b_ptr(cur, 0); const char* b1 = S.b_ptr(cur, 1);
        const char* cA0 = cA + S.a_kadj(0);
        PG8_STAGE2(PG8_SB(0, 0), b0, voffB[0], voffB[1]); PG8_STAGE2(PG8_SA(0, 0), cA0, vAc[0][0], vAc[0][1]); PG8_STAGE2(PG8_SB(0, 1), b0 + hstepB, voffB[0], voffB[1]); PG8_STAGE2(PG8_SA(0, 1), cA0, vAc[1][0], vAc[1][1]);
        if (wr == 1) PG8_BAR;
        PG8_WAIT_V(4); PG8_BAR;
        PG8_STAGE2(PG8_SB(1, 0), b1, voffB[0], voffB[1]); PG8_STAGE2(PG8_SA(1, 0), cA + kstep + S.a_kadj(1), vAc[0][0], vAc[0][1]); PG8_STAGE2(PG8_SB(1, 1), b1 + hstepB, voffB[0], voffB[1]);
        PG8_WAIT_V(6); PG8_BAR;
    }
    for (;;) {
        const bool has_next = S.next(ui + 1, nxt);
        if (!has_next) nxt = cur;
        if constexpr (P::GATHER) {
            if (has_next) {
#pragma unroll
                for (int h = 0; h < 2; ++h)
#pragma unroll
                    for (int i = 0; i < 2; ++i) vAn[h][i] = S.a_voff(nxt, h * HALF + RA[i], CA[i]);
            }
        }
        const char* nA = S.a_ptr(nxt);
        for (int t = 0; t < nt; t += 2) {
            const bool last = (t == nt - 2);
            const char* a1 = cA + (size_t)(t + 1) * kstep + S.a_kadj(t + 1);
            const char* a2 = last ? nA + S.a_kadj(0) : cA + (size_t)(t + 2) * kstep + S.a_kadj(t + 2);
            const char* a3 = last ? nA + kstep + S.a_kadj(1) : cA + (size_t)(t + 3) * kstep + S.a_kadj(t + 3);
            const char* b2 = last ? S.b_ptr(nxt, 0) : S.b_ptr(cur, t + 2);
            const char* b3 = last ? S.b_ptr(nxt, 1) : S.b_ptr(cur, t + 3);
            unsigned s00 = vAc[0][0], s01 = vAc[0][1], s10 = vAc[1][0], s11 = vAc[1][1];
            if constexpr (P::GATHER) { if (last) { s00 = vAn[0][0]; s01 = vAn[0][1]; s10 = vAn[1][0]; s11 = vAn[1][1]; } }
            PG8_LDB(B0, 0, 0); PG8_SCHED; PG8_LDA(At, 0, 0); PG8_STAGE2(PG8_SA(1, 1), a1, vAc[1][0], vAc[1][1]);
            PG8_WAIT_L(8); PG8_BAR; PG8_WAIT_L(0); PG8_MMA(0, 0, At, B0); PG8_BAR; PG8_SCHED;
            PG8_LDB(B1, 0, 1); PG8_STAGE2(PG8_SB(0, 0), b2, voffB[0], voffB[1]);
            PG8_BAR; PG8_WAIT_L(0); PG8_MMA(0, 1, At, B1); PG8_BAR;
            PG8_LDA(At, 0, 1); PG8_STAGE2(PG8_SA(0, 0), a2, s00, s01);
            PG8_BAR; PG8_WAIT_L(0); PG8_MMA(1, 0, At, B0); PG8_BAR; PG8_SCHED;
            PG8_STAGE2(PG8_SB(0, 1), b2 + hstepB, voffB[0], voffB[1]);
            PG8_WAIT_V(6); PG8_BAR; PG8_MMA(1, 1, At, B1); PG8_BAR;
            PG8_LDB(B0, 1, 0); PG8_SCHED; PG8_LDA(At, 1, 0); PG8_STAGE2(PG8_SA(0, 1), a2, s10, s11);
            PG8_WAIT_L(8); PG8_BAR; PG8_WAIT_L(0); PG8_MMA(0, 0, At, B0); PG8_BAR; PG8_SCHED;
            PG8_LDB(B1, 1, 1); PG8_STAGE2(PG8_SB(1, 0), b3, voffB[0], voffB[1]);
            PG8_BAR; PG8_WAIT_L(0); PG8_MMA(0, 1, At, B1); PG8_BAR;
            PG8_LDA(At, 1, 1); PG8_STAGE2(PG8_SA(1, 0), a3, s00, s01);
            PG8_BAR; PG8_WAIT_L(0); PG8_MMA(1, 0, At, B0); PG8_BAR; PG8_SCHED;
            PG8_STAGE2(PG8_SB(1, 1), b3 + hstepB, voffB[0], voffB[1]);
            PG8_WAIT_V(6); PG8_BAR; PG8_MMA(1, 1, At, B1); PG8_BAR;
        }
        SP_MARK((PROBE_PID < 0 || S.pid == PROBE_PID) ? 10 : -1);
        if constexpr (P::FP8) asm volatile("s_nop 15\n\ts_nop 15\n\ts_nop 15" ::: "memory");
        S.epi(acc, cur, wr, wc, fr, fq);
        SP_MARK((PROBE_PID < 0 || S.pid == PROBE_PID) ? 9 : -1);
        if (!has_next) break;
#pragma unroll
        for (int a = 0; a < 2; ++a)
#pragma unroll
            for (int b = 0; b < 2; ++b)
#pragma unroll
                for (int m = 0; m < 4; ++m)
#pragma unroll
                    for (int n = 0; n < 2; ++n) acc[a][b][m][n] = (f32x4){zf, zf, zf, zf};
        cur = nxt; cA = nA; ++ui;
        if constexpr (P::GATHER) {
#pragma unroll
            for (int h = 0; h < 2; ++h)
#pragma unroll
                for (int i = 0; i < 2; ++i) vAc[h][i] = vAn[h][i];
        }
    }
    PG8_WAIT_V(0);
    if (wr == 0) PG8_BAR;
    PG8_BAR;
#undef PG8_SA
#undef PG8_SB
#undef PG8_STAGE2
#undef PG8_LDA
#undef PG8_LDB
#undef PG8_MMA
#undef PG8_WAIT_V
#undef PG8_WAIT_L
#undef PG8_BAR
#undef PG8_SCHED
}

enum { EK_BF16 = 0, EK_LORA1 = 1, EK_LORA2 = 2, EK_F32RES = 3, EK_INPROJ = 4 };
template <int KIND>
struct DenseP {
    static constexpr bool PERM = true, GATHER = false;
    int K, lda, ldb, nM, nN, nprob, G, c, pid;
    static constexpr bool FP8 = false;
    const bf16_t* A; size_t a_stride;
    const bf16_t* Aalt1; const bf16_t* Aalt2;
    int a_skew;
    int a_split; long a_jump;
    const bf16_t* B; size_t b_stride;
    bf16_t* O; size_t o_stride; int ldc;
    bf16_t* Oalt1; bf16_t* Oalt2;
    const float* resf; const bf16_t* resb; bf16_t* Ob;
    const float* v0; const float* v1;
    __device__ __forceinline__ bool next(int i, Unit& u) const {
        const long L = (long)i * G + c; const int per = nM * nN; if (L >= (long)per * nprob) return false;
        u.prob = (int)(L / per); tile_order((int)(L % per), nM, nN, u.pm, u.pn); return true;
    }
    __device__ __forceinline__ const char* a_ptr(const Unit& u) const { const bf16_t* a0 = Aalt1 ? ((u.prob == 0) ? A : (u.prob == 1) ? Aalt1 : Aalt2) : A + (size_t)u.prob * a_stride; return (const char*)(a0 + ((size_t)u.pm * BM + (a_skew ? (u.pm >> 4) + 1 : 0)) * lda); }
    __device__ __forceinline__ long a_kadj(int kt) const { return (a_split > 0 && kt >= a_split) ? a_jump : 0; }
    __device__ __forceinline__ const char* b_ptr(const Unit& u, int kt) const { return (const char*)(B + (size_t)u.prob * b_stride + (size_t)u.pn * BM * ldb) + (size_t)kt * (BK * 2); }
    __device__ __forceinline__ unsigned a_voff(const Unit&, int, int) const { return 0u; }
    __device__ __forceinline__ void epi(const f32x4 (&acc)[2][2][4][2], const Unit& u, int wr, int wc, int fr, int fq) const {
        const int row0 = u.pm * BM + wr * 64 + fr;
        if constexpr (KIND == EK_F32RES) {
            const int col0 = u.pn * BM + wc * 32 + 8 * fq;
#pragma unroll
            for (int ai = 0; ai < 2; ++ai)
#pragma unroll
                for (int mp = 0; mp < 2; ++mp) {
                    f32x4 r0[2][2], r1[2][2];
#pragma unroll
                    for (int mm = 0; mm < 2; ++mm) { const size_t ro = (size_t)(row0 + ai * HALF + (mp * 2 + mm) * 16) * ldc + col0;
#pragma unroll
                        for (int bj = 0; bj < 2; ++bj) {
                            if (resf) { r0[mm][bj] = __builtin_nontemporal_load((const f32x4*)(resf + ro + bj * HALF)); r1[mm][bj] = __builtin_nontemporal_load((const f32x4*)(resf + ro + bj * HALF + 4)); }
                            else { const u32x4 rw = *(const u32x4*)(resb + ro + bj * HALF); r0[mm][bj] = (f32x4){bflo(rw.x), bfhi(rw.x), bflo(rw.y), bfhi(rw.y)}; r1[mm][bj] = (f32x4){bflo(rw.z), bfhi(rw.z), bflo(rw.w), bfhi(rw.w)}; } } }
#pragma unroll
                    for (int mm = 0; mm < 2; ++mm) { const size_t ro = (size_t)(row0 + ai * HALF + (mp * 2 + mm) * 16) * ldc + col0;
#pragma unroll
                        for (int bj = 0; bj < 2; ++bj) { const f32x4 x0 = acc[ai][bj][mp * 2 + mm][0] + r0[mm][bj], x1 = acc[ai][bj][mp * 2 + mm][1] + r1[mm][bj];
                            u32x4 w; w.x = cvt_pk_bf16(x0[0], x0[1]); w.y = cvt_pk_bf16(x0[2], x0[3]); w.z = cvt_pk_bf16(x1[0], x1[1]); w.w = cvt_pk_bf16(x1[2], x1[3]);
                            *(u32x4*)(Ob + ro + bj * HALF) = w; } }
                }
        } else {
            const int col0 = u.pn * BM + wc * 32 + 8 * fq;
            bf16_t* base = Oalt1 ? ((u.prob == 0) ? O : (u.prob == 1) ? Oalt1 : Oalt2) : O + (size_t)u.prob * o_stride;
            f32x4 bv[2][2];
#pragma unroll
            for (int bj = 0; bj < 2; ++bj)
#pragma unroll
                for (int n = 0; n < 2; ++n) {
                    if constexpr (KIND == EK_LORA2) { bv[bj][n] = (u.prob == 0) ? *(const f32x4*)(v0 + col0 + bj * HALF + 4 * n) : (u.prob == 1) ? *(const f32x4*)(v1 + col0 + bj * HALF + 4 * n) : (f32x4){0.f, 0.f, 0.f, 0.f}; }
                    else bv[bj][n] = (f32x4){0.f, 0.f, 0.f, 0.f};
                }
#pragma unroll
            for (int ai = 0; ai < 2; ++ai)
#pragma unroll
                for (int m = 0; m < 4; ++m) { bf16_t* rowp = base + (size_t)(row0 + ai * HALF + m * 16) * ldc + col0;
#pragma unroll
                    for (int bj = 0; bj < 2; ++bj) { f32x4 x0 = acc[ai][bj][m][0] + bv[bj][0], x1 = acc[ai][bj][m][1] + bv[bj][1];
                        if constexpr (KIND == EK_LORA1) {
                            const int g0 = u.pn * BM + bj * HALF + wc * 32; const float kx = (g0 < 64) ? 2.f : 1.f;
#pragma unroll
                            for (int j = 0; j < 4; ++j) { const float s0 = fsigmoid(kx * x0[j]), s1 = fsigmoid(kx * x1[j]);
                                x0[j] = (g0 < 64) ? 2.f * s0 - 1.f : (g0 >= 128) ? s0 : x0[j]; x1[j] = (g0 < 64) ? 2.f * s1 - 1.f : (g0 >= 128) ? s1 : x1[j]; } }
                        if constexpr (KIND == EK_LORA2) {
                            const float sc = (u.prob == 0) ? 0.6065306597126334f : 1.f;
#pragma unroll
                            for (int j = 0; j < 4; ++j) { const float s0 = sc * fsigmoid(x0[j]), s1 = sc * fsigmoid(x1[j]); x0[j] = (u.prob == 2) ? x0[j] : s0; x1[j] = (u.prob == 2) ? x1[j] : s1; } }
                        if constexpr (KIND == EK_INPROJ) {
                            if (u.pn >= PC_Q / 256 && u.pn < PC_V / 256) { const int pos = (row0 + ai * HALF + m * 16) & (SEQ - 1); const float sc = (u.pn >= PC_K / 256) ? 0.08838834764831845f : 1.f;
                                const f32x4 cs0 = *(const f32x4*)(v0 + ((size_t)pos * 64 + wc * 16 + 4 * fq) * 2), cs1 = *(const f32x4*)(v0 + ((size_t)pos * 64 + wc * 16 + 4 * fq + 2) * 2);
                                const f32x4 a = x0, b = x1;
                                x0[0] = (a[0] * cs0[0] - a[1] * cs0[1]) * sc; x0[1] = (a[0] * cs0[1] + a[1] * cs0[0]) * sc; x0[2] = (a[2] * cs0[2] - a[3] * cs0[3]) * sc; x0[3] = (a[2] * cs0[3] + a[3] * cs0[2]) * sc;
                                x1[0] = (b[0] * cs1[0] - b[1] * cs1[1]) * sc; x1[1] = (b[0] * cs1[1] + b[1] * cs1[0]) * sc; x1[2] = (b[2] * cs1[2] - b[3] * cs1[3]) * sc; x1[3] = (b[2] * cs1[3] + b[3] * cs1[2]) * sc; } }
                        u32x4 w; w.x = cvt_pk_bf16(x0[0], x0[1]); w.y = cvt_pk_bf16(x0[2], x0[3]); w.z = cvt_pk_bf16(x1[0], x1[1]); w.w = cvt_pk_bf16(x1[2], x1[3]);
                        *(u32x4*)(rowp + bj * HALF) = w; } }
        }
    }
};

__device__ __forceinline__ void pair_lohi(int pr, int& lo, int& hi) { lo = (pr < 3) ? 0 : (pr < 5 ? 1 : 2); hi = (pr < 3) ? pr + 1 : (pr < 5 ? pr - 1 : 3); }

template <bool F8>
struct Moe1P {
    static constexpr bool PERM = true, GATHER = true, FP8 = F8;
    int K, lda, ldb, G, c, ntiles, pid;
    const bf16_t* A; const bf16_t* W13;
    bf16_t* H; const int* slot_tok; const float* slot_c; const int* tile_bkt;
    __device__ __forceinline__ bool next(int i, Unit& u) const {
        const int m = (c >> 3) + (G >> 3) * i; if ((G & 7) != 0 || m >= ntiles) { if ((G & 7) == 0) return false; const long L = (long)i * G + c; if (L >= (long)ntiles * 8) return false; u.pm = (int)(L >> 3); u.pn = (int)(L & 7); u.prob = __builtin_amdgcn_readfirstlane(ld_vec_i32(tile_bkt + u.pm)); return true; }
        u.pm = m; u.pn = c & 7; u.prob = __builtin_amdgcn_readfirstlane(ld_vec_i32(tile_bkt + u.pm)); return true;
    }
    __device__ __forceinline__ const char* a_ptr(const Unit&) const { return (const char*)A; }
    __device__ __forceinline__ long a_kadj(int) const { return 0; }
    __device__ __forceinline__ unsigned a_voff(const Unit& u, int row, int C) const { int tok = slot_tok[u.pm * BM + row]; tok = tok < 0 ? 0 : tok; return (unsigned)(tok * lda + C) * 2u; }
    __device__ __forceinline__ const char* b_ptr(const Unit& u, int kt) const {
        int lo, hi; pair_lohi(u.prob % 6, lo, hi); const int e = (u.prob / 6) * 4 + ((u.pn < 4) ? lo : hi);
        if constexpr (F8) return (const char*)W13 + (size_t)e * 2097152 + (size_t)(u.pn & 3) * BM * 1024 + (size_t)kt * (BK * 2);
        return (const char*)(W13 + ((size_t)e * 1024 + (size_t)(u.pn & 3) * BM) * 1024) + (size_t)kt * (BK * 2);
    }
    __device__ __forceinline__ void epi(const f32x4 (&acc)[2][2][4][2], const Unit& u, int wr, int wc, int fr, int fq) const {
        const int row0 = u.pm * BM + wr * 64 + fr, col0 = ((u.pn < 4) ? 0 : 512) + (u.pn & 3) * 128 + wc * 32 + 8 * fq, ci = (u.pn < 4) ? 0 : 1;
#pragma unroll
        for (int ai = 0; ai < 2; ++ai)
#pragma unroll
            for (int m = 0; m < 4; ++m) { const int row = row0 + ai * HALF + m * 16; const float cw = slot_c[(size_t)row * 2 + ci];
                const f32x4 g0 = acc[ai][0][m][0], g1 = acc[ai][0][m][1], u0 = acc[ai][1][m][0], u1 = acc[ai][1][m][1]; f32x4 x0, x1;
#pragma unroll
                for (int j = 0; j < 4; ++j) {
                    if constexpr (F8) { x0[j] = fsilu(g0[j] * F8_DESCALE) * (u0[j] * F8_DESCALE) * (cw * F8_ACT_SCALE); x1[j] = fsilu(g1[j] * F8_DESCALE) * (u1[j] * F8_DESCALE) * (cw * F8_ACT_SCALE); }
                    else { x0[j] = fsilu(g0[j]) * u0[j] * cw; x1[j] = fsilu(g1[j]) * u1[j] * cw; } }
                if constexpr (F8) { u32x2 w8; w8.x = pk_fp8x4(x0[0], x0[1], x0[2], x0[3]); w8.y = pk_fp8x4(x1[0], x1[1], x1[2], x1[3]); *(u32x2*)((unsigned char*)H + (size_t)row * 1024 + col0) = w8; continue; }
                u32x4 w; w.x = cvt_pk_bf16(x0[0], x0[1]); w.y = cvt_pk_bf16(x0[2], x0[3]); w.z = cvt_pk_bf16(x1[0], x1[1]); w.w = cvt_pk_bf16(x1[2], x1[3]);
                *(u32x4*)(H + (size_t)row * 1024 + col0) = w; }
    }
};
template <bool F8>
struct Moe2P {
    static constexpr bool PERM = true, GATHER = false, FP8 = F8;
    int K, lda, ldb, G, c, ntiles, pid;
    const bf16_t* H; const bf16_t* W2;
    const bf16_t* hsrc; bf16_t* hdst; const int* slot_tok; const int* tile_bkt;
    __device__ __forceinline__ bool next(int i, Unit& u) const {
        const int m = 2 * ((c >> 3) + (G >> 3) * i) + ((c >> 2) & 1); if ((G & 7) != 0 || m >= ntiles) { if ((G & 7) == 0) return false; const long L = (long)i * G + c; if (L >= (long)ntiles * 4) return false; u.pm = (int)(L >> 2); u.pn = (int)(L & 3); u.prob = __builtin_amdgcn_readfirstlane(ld_vec_i32(tile_bkt + u.pm)); return true; }
        u.pm = m; u.pn = c & 3; u.prob = __builtin_amdgcn_readfirstlane(ld_vec_i32(tile_bkt + u.pm)); return true;
    }
    __device__ __forceinline__ const char* a_ptr(const Unit& u) const { return (const char*)H + (size_t)u.pm * BM * 1024 * (F8 ? 1 : 2); }
    __device__ __forceinline__ long a_kadj(int) const { return 0; }
    __device__ __forceinline__ unsigned a_voff(const Unit&, int, int) const { return 0u; }
    __device__ __forceinline__ const char* b_ptr(const Unit& u, int kt) const {
        int lo, hi; pair_lohi(u.prob % 6, lo, hi);
        if constexpr (F8) { const int e8 = (u.prob / 6) * 4 + ((kt < 4) ? lo : hi); return (const char*)W2 + (size_t)e8 * 1048576 + (size_t)u.pn * BM * 512 + (size_t)(kt & 3) * (BK * 2); }
        const int e = (u.prob / 6) * 4 + ((kt < 8) ? lo : hi);
        return (const char*)(W2 + ((size_t)e * 1024 + (size_t)u.pn * BM) * 512) + (size_t)(kt & 7) * (BK * 2);
    }
    __device__ __forceinline__ void epi(const f32x4 (&acc)[2][2][4][2], const Unit& u, int wr, int wc, int fr, int fq) const {
        const int row0 = u.pm * BM + wr * 64 + fr, col0 = u.pn * BM + wc * 32 + 8 * fq;
        int tok[2][4];
#pragma unroll
        for (int ai = 0; ai < 2; ++ai)
#pragma unroll
            for (int m = 0; m < 4; ++m) tok[ai][m] = slot_tok[row0 + ai * HALF + m * 16];
#pragma unroll
        for (int ai = 0; ai < 2; ++ai) {
            u32x4 r[4][2];
#pragma unroll
            for (int m = 0; m < 4; ++m) { const int tk = tok[ai][m]; const bf16_t* rp = hsrc + (size_t)(tk < 0 ? 0 : tk) * 1024 + col0;
#pragma unroll
                for (int bj = 0; bj < 2; ++bj) r[m][bj] = *(const u32x4*)(rp + bj * HALF); }
#pragma unroll
            for (int m = 0; m < 4; ++m) { const int tk = tok[ai][m];
                if (tk >= 0) { bf16_t* wp = hdst + (size_t)tk * 1024 + col0;
#pragma unroll
                    for (int bj = 0; bj < 2; ++bj) { const u32x4 rw = r[m][bj]; const f32x4 a0 = acc[ai][bj][m][0], a1 = acc[ai][bj][m][1]; constexpr float ds = F8 ? F8_DESCALE : 1.f;
                        u32x4 w; w.x = cvt_pk_bf16(fmaf(a0[0], ds, bflo(rw.x)), fmaf(a0[1], ds, bfhi(rw.x))); w.y = cvt_pk_bf16(fmaf(a0[2], ds, bflo(rw.y)), fmaf(a0[3], ds, bfhi(rw.y)));
                        w.z = cvt_pk_bf16(fmaf(a1[0], ds, bflo(rw.z)), fmaf(a1[1], ds, bfhi(rw.z))); w.w = cvt_pk_bf16(fmaf(a1[2], ds, bflo(rw.w)), fmaf(a1[3], ds, bfhi(rw.w)));
                        *(u32x4*)(wp + bj * HALF) = w; } } }
        }
    }
};

struct Frame {
    LAS unsigned char* lds;
    int tid, lane, wave, G, bid;
    float* out; unsigned char* ws;
};
#define WSP(T, off) ((T*)(F.ws + (off)))

__device__ __forceinline__ void prep_tile(const Frame& F, const float* src, int src_ld, int k0, int kvalid, int c0, int nvalid, bf16_t* dst, int dst_ld, bool il = false, int ksrc = -1, const float* kscale = nullptr, bool one_minus = false, float f8scale = 0.f) {
    const int ks0 = ksrc < 0 ? k0 : ksrc;
    LAS float* tl = (LAS float*)F.lds;
    __syncthreads();
#pragma unroll
    for (int p = 0; p < 2; ++p) { const int kk = (F.tid >> 4) + 32 * p, n4 = (F.tid & 15) * 4;
        f32x4 v = (f32x4){0.f, 0.f, 0.f, 0.f};
        if (il) {
            v = __builtin_nontemporal_load((const f32x4*)(src + (size_t)(ks0 + kk) * src_ld + c0 + ((n4 < 32) ? n4 : 32 + n4))); const int d0 = 2 * (n4 & 31) + (n4 >> 5);
            tl[kk * 65 + d0] = v[0]; tl[kk * 65 + d0 + 2] = v[1]; tl[kk * 65 + d0 + 4] = v[2]; tl[kk * 65 + d0 + 6] = v[3];
        } else {
        if (kk < kvalid && n4 < nvalid) v = __builtin_nontemporal_load((const f32x4*)(src + (size_t)(ks0 + kk) * src_ld + c0 + n4));
        if (kscale) { const float f_ = kscale[ks0 + kk]; v = v * (one_minus ? 1.f - f_ : f_); }
        tl[kk * 65 + n4 + 0] = v[0]; tl[kk * 65 + n4 + 1] = v[1]; tl[kk * 65 + n4 + 2] = v[2]; tl[kk * 65 + n4 + 3] = v[3]; } }
    __syncthreads();
    { const int n = F.tid >> 3, kc = (F.tid & 7) * 8; float x[8];
#pragma unroll
        for (int j = 0; j < 8; ++j) x[j] = tl[(kc + j) * 65 + n];
        if (f8scale != 0.f) { u32x2 w8; w8.x = pk_fp8x4(x[0] * f8scale, x[1] * f8scale, x[2] * f8scale, x[3] * f8scale); w8.y = pk_fp8x4(x[4] * f8scale, x[5] * f8scale, x[6] * f8scale, x[7] * f8scale);
            *(u32x2*)((unsigned char*)dst + (size_t)n * dst_ld + k0 + kc) = w8; }
        else { u32x4 w; w.x = cvt_pk_bf16(x[0], x[1]); w.y = cvt_pk_bf16(x[2], x[3]); w.z = cvt_pk_bf16(x[4], x[5]); w.w = cvt_pk_bf16(x[6], x[7]);
        *(u32x4*)(dst + (size_t)n * dst_ld + k0 + kc) = w; } }
}
__device__ __forceinline__ void phase_prep(const Params& p, const Frame& F, int id_lo, int id_hi, bool tables) {
    bf16_t* wb = WSP(bf16_t, WS_WB);
    constexpr int N0 = 1472, N1 = N0 + 512, N2 = N1 + 1024, N3 = N2 + 256, N4 = N3 + 192, N5 = N4 + 8192, N6 = N5 + 4096;
    (void)N6;
    for (int id = id_lo + F.bid; id < id_hi; id += F.G) {
        if (id < N0) { const int nt = id / 16, kt = id % 16, n0 = nt * 64; int c0, nv;
            if (n0 < PC_Q) { c0 = n0; nv = 64; } else if (n0 < PC_DT) { c0 = n0 + 16; nv = 64; } else if (n0 == PC_DT) { c0 = 2560; nv = 16; } else { c0 = 0; nv = 0; }
            const bool il = (n0 >= PC_Q && n0 < PC_V);
            if (il) c0 = 2576 + ((n0 - PC_Q) >> 7) * 128 + (((n0 - PC_Q) >> 6) & 1) * 32;
            prep_tile(F, p.in[4], 5648, kt * 64, 64, c0, nv, wb + WB_WIN / 2 + (size_t)n0 * 1024, 1024, il); }
        else if (id < N1) { const int j = id - N0, nt = j / 32, kt = j % 32; prep_tile(F, p.in[11], 1024, kt * 64, 64, nt * 64, 64, wb + WB_WOUT / 2 + (size_t)nt * 64 * 2048, 2048); }
        else if (id < N2) { const int j = id - N1, w = j / 256, r = j % 256, nt = r / 16, kt = r % 16; prep_tile(F, (w == 0) ? p.in[13] : (w == 1) ? p.in[14] : (w == 2) ? p.in[15] : p.in[16], 1024, kt * 64, 64, nt * 64, 64, wb + WB_WR / 2 + (size_t)w * 1048576 + (size_t)nt * 64 * 1024, 1024); }
        else if (id < N3) { const int j = id - N2, nt = j >> 5, kt = j & 31, half = kt >> 4;
            const float* src = (nt == 0) ? p.in[18] : (nt == 1) ? p.in[21] : p.in[23]; const int ncols = (nt < 2) ? 64 : 160, c0 = (nt < 2) ? 0 : (nt - 2) * 64, midx = (nt == 0) ? 1 : (nt == 1) ? 4 : 5;
            int nv = (nt < 2) ? 64 : ncols - c0; nv = nv < 0 ? 0 : (nv > 64 ? 64 : nv); if (nt > 4) nv = 0;
            prep_tile(F, src, ncols, kt * 64, 64, (nv ? c0 : 0), nv, wb + WB_L1 / 2 + (size_t)nt * 64 * 2048, 2048, false, (kt & 15) * 64, p.in[12] + midx * DM, !half); }
        else if (id < N4) { const int j = id - N3, w = j / 64, r = j % 64, nt = r / 4, kt = r % 4;
            int kv = (w == 0) ? (kt == 0 ? 64 : 0) : (w == 1) ? (kt == 1 ? 64 : 0) : 160 - kt * 64; kv = kv < 0 ? 0 : (kv > 64 ? 64 : kv);
            const float* src = (w == 0) ? p.in[19] : (w == 1) ? p.in[22] : p.in[24];
            prep_tile(F, src, 1024, kt * 64, kv, nt * 64, 64, wb + WB_L2 / 2 + (size_t)w * 262144 + (size_t)nt * 64 * 256, 256, false, (w == 1) ? 0 : kt * 64); }
        else if (id < N5) { const int j = id - N4, le = j / 256, r = j % 256, nt = r / 16, kt = r % 16;
            const int pn = nt >> 2, part = (nt >> 1) & 1, c0 = 128 * pn + 64 * (nt & 1);
            const float* src = (part ? p.in[35] : p.in[34]) + (size_t)le * 524288;
            if (le >= 16) prep_tile(F, src, 512, kt * 64, 64, c0, 64, (bf16_t*)((unsigned char*)wb + WB_W13 + (size_t)le * 2097152 + (size_t)nt * 64 * 1024), 1024, false, -1, nullptr, false, F8_W_SCALE);
            else prep_tile(F, src, 512, kt * 64, 64, c0, 64, wb + WB_W13 / 2 + (size_t)le * 1048576 + (size_t)nt * 64 * 1024, 1024); }
        else { const int j = id - N5, le = j / 128, r = j % 128, nt = r / 8, kt = r % 8;
            if (le >= 16) prep_tile(F, p.in[36] + (size_t)le * 524288, 1024, kt * 64, 64, nt * 64, 64, (bf16_t*)((unsigned char*)wb + WB_W2 + (size_t)le * 1048576 + (size_t)nt * 64 * 512), 512, false, -1, nullptr, false, F8_W_SCALE);
            else prep_tile(F, p.in[36] + (size_t)le * 524288, 1024, kt * 64, 64, nt * 64, 64, wb + WB_W2 / 2 + (size_t)le * 524288 + (size_t)nt * 64 * 512, 512); }
    }
    if (!tables) { __syncthreads(); return; }
    { float* rtw = WSP(float, WS_RTW);
        for (int idx = F.bid * NTHREADS + F.tid; idx < 2 * 20 * 1024; idx += F.G * NTHREADS) { const int l = idx / 20480, r = idx % 20480, j = r >> 10, k = r & 1023;
            rtw[idx] = (j < 4) ? p.in[30][(size_t)l * 4096 + k * 4 + j] : p.in[32][(size_t)l * 16384 + k * 16 + (j - 4)]; } }
    f32x2* rope = WSP(f32x2, WS_ROPE);
    for (int idx = F.bid * NTHREADS + F.tid; idx < SEQ * 64; idx += F.G * NTHREADS) {
        const int pos = idx >> 6, i = idx & 63;
        const float invf = exp2f(-(float)i * (13.287712379549449f / 64.f));
        const float ang = (float)pos * invf;
        const double x = (double)ang;
        const double kq = rint(x * 0.63661977236758134308);
        double r = fma(-kq, 1.57079632679489655800e+00, x); r = fma(-kq, 6.12323399573676603587e-17, r);
        const double r2 = r * r;
        double sp = -7.6471637318198164759e-13; sp = fma(sp, r2, 1.6059043836821614599e-10); sp = fma(sp, r2, -2.5052108385441718775e-08); sp = fma(sp, r2, 2.7557319223985890653e-06);
        sp = fma(sp, r2, -1.9841269841269841270e-04); sp = fma(sp, r2, 8.3333333333333333333e-03); sp = fma(sp, r2, -1.6666666666666666667e-01); const double sn = fma(sp * r2, r, r);
        double cp = 4.7794773323873852974e-14; cp = fma(cp, r2, -1.1470745597729724714e-11); cp = fma(cp, r2, 2.0876756987868098979e-09); cp = fma(cp, r2, -2.7557319223985890653e-07);
        cp = fma(cp, r2, 2.4801587301587301587e-05); cp = fma(cp, r2, -1.3888888888888888889e-03); cp = fma(cp, r2, 4.1666666666666666667e-02); cp = fma(cp, r2, -0.5); const double cs = fma(cp, r2, 1.0);
        const int q = ((int)kq) & 3;
        const double c = (q == 0) ? cs : (q == 1) ? -sn : (q == 2) ? -cs : sn;
        const double s = (q == 0) ? sn : (q == 1) ? cs : (q == 2) ? -sn : -cs;
        rope[idx] = (f32x2){(float)c, (float)s};
    }
}

__device__ __forceinline__ void row_load(const float* row, int lane, f32x4 (&v)[4]) {
#pragma unroll
    for (int j = 0; j < 4; ++j) v[j] = *(const f32x4*)(row + j * 256 + lane * 4);
}
__device__ __forceinline__ void row_load_nt(const float* row, int lane, f32x4 (&v)[4]) {
#pragma unroll
    for (int j = 0; j < 4; ++j) v[j] = __builtin_nontemporal_load((const f32x4*)(row + j * 256 + lane * 4));
}
__device__ __forceinline__ void row_load_bf_nt(const bf16_t* row, int lane, f32x4 (&v)[4]) {
#pragma unroll
    for (int j = 0; j < 4; ++j) { const u32x2 w = __builtin_nontemporal_load((const u32x2*)(row + j * 256 + lane * 4)); v[j] = (f32x4){bflo(w.x), bfhi(w.x), bflo(w.y), bfhi(w.y)}; }
}
__device__ __forceinline__ void row_load_bf(const bf16_t* row, int lane, f32x4 (&v)[4]) {
#pragma unroll
    for (int j = 0; j < 4; ++j) { const u32x2 w = *(const u32x2*)(row + j * 256 + lane * 4); v[j] = (f32x4){bflo(w.x), bfhi(w.x), bflo(w.y), bfhi(w.y)}; }
}
__device__ __forceinline__ float row_rstd(const f32x4 (&v)[4], float eps) {
    float ss = 0.f;
#pragma unroll
    for (int j = 0; j < 4; ++j) ss += v[j][0] * v[j][0] + v[j][1] * v[j][1] + v[j][2] * v[j][2] + v[j][3] * v[j][3];
    ss = wave_sum_u(ss);
    return rsqrtf(ss * (1.f / 1024.f) + eps);
}
__device__ __forceinline__ void row_store_bf16(bf16_t* row, int lane, const f32x4 (&v)[4]) {
#pragma unroll
    for (int j = 0; j < 4; ++j) { u32x2 w; w.x = cvt_pk_bf16(v[j][0], v[j][1]); w.y = cvt_pk_bf16(v[j][2], v[j][3]); *(u32x2*)(row + j * 256 + lane * 4) = w; }
}

template <bool TO_BF16, bool SRC_BF16 = false>
__device__ __forceinline__ void phase_rmsnorm(const Params& p, const Frame& F, const void* src_, const float* w, void* dst) {
    const float* src = (const float*)src_; const bf16_t* srcb = (const bf16_t*)src_; (void)src; (void)srcb;
    f32x4 wv[4]; row_load(w, F.lane, wv);
    int row = F.bid * 8 + F.wave; const int stride = F.G * 8;
    f32x4 v[4], vn[4];
    if (row < T_TOK) { if constexpr (SRC_BF16) row_load_bf_nt(srcb + (size_t)row * DM, F.lane, v); else row_load_nt(src + (size_t)row * DM, F.lane, v); }
    for (; row < T_TOK; row += stride) {
        if (row + stride < T_TOK) { if constexpr (SRC_BF16) row_load_bf_nt(srcb + (size_t)(row + stride) * DM, F.lane, vn); else row_load_nt(src + (size_t)(row + stride) * DM, F.lane, vn); }
        const float rs = row_rstd(v, 1e-6f);
#pragma unroll
        for (int j = 0; j < 4; ++j) v[j] = v[j] * rs * wv[j];
        if constexpr (TO_BF16) row_store_bf16((bf16_t*)dst + (size_t)row * DM, F.lane, v);
        else {
#pragma unroll
            for (int j = 0; j < 4; ++j) *(f32x4*)((float*)dst + (size_t)row * DM + j * 256 + F.lane * 4) = v[j];
        }
#pragma unroll
        for (int j = 0; j < 4; ++j) v[j] = vn[j];
    }
}

__device__ __forceinline__ void phase_conv(const Params& p, const Frame& F) {
    bf16_t* proj = WSP(bf16_t, WS_SLAB);
    bf16_t* xc = (bf16_t*)F.out;
    const float* conv_w = p.in[5]; const float* conv_b = p.in[6];
    for (int item = F.bid * 8 + F.wave; item < (T_TOK / 32) * 3; item += F.G * 8) {
        const int run = item / 3, cb = item - run * 3, c0 = cb * 512 + F.lane * 8, t0 = run * 32;
        float w[4][8], bb[8], xm3[8], xm2[8], xm1[8];
#pragma unroll
        for (int j = 0; j < 4; ++j) { const f32x4 a0 = *(const f32x4*)(conv_w + j * 1536 + c0), a1 = *(const f32x4*)(conv_w + j * 1536 + c0 + 4);
#pragma unroll
            for (int e = 0; e < 4; ++e) { w[j][e] = a0[e]; w[j][4 + e] = a1[e]; } }
        { const f32x4 a0 = *(const f32x4*)(conv_b + c0), a1 = *(const f32x4*)(conv_b + c0 + 4);
#pragma unroll
            for (int e = 0; e < 4; ++e) { bb[e] = a0[e]; bb[4 + e] = a1[e]; } }
        const bool first = (t0 & (SEQ - 1)) == 0;
        { u32x4 r3 = (u32x4){0u, 0u, 0u, 0u}, r2 = r3, r1 = r3;
            if (!first) { r3 = __builtin_nontemporal_load((const u32x4*)(proj + (size_t)(t0 - 3) * NPROJ + PC_XBC + c0)); r2 = __builtin_nontemporal_load((const u32x4*)(proj + (size_t)(t0 - 2) * NPROJ + PC_XBC + c0)); r1 = __builtin_nontemporal_load((const u32x4*)(proj + (size_t)(t0 - 1) * NPROJ + PC_XBC + c0)); }
            xm3[0] = bflo(r3.x); xm3[1] = bfhi(r3.x); xm3[2] = bflo(r3.y); xm3[3] = bfhi(r3.y); xm3[4] = bflo(r3.z); xm3[5] = bfhi(r3.z); xm3[6] = bflo(r3.w); xm3[7] = bfhi(r3.w);
            xm2[0] = bflo(r2.x); xm2[1] = bfhi(r2.x); xm2[2] = bflo(r2.y); xm2[3] = bfhi(r2.y); xm2[4] = bflo(r2.z); xm2[5] = bfhi(r2.z); xm2[6] = bflo(r2.w); xm2[7] = bfhi(r2.w);
            xm1[0] = bflo(r1.x); xm1[1] = bfhi(r1.x); xm1[2] = bflo(r1.y); xm1[3] = bfhi(r1.y); xm1[4] = bflo(r1.z); xm1[5] = bfhi(r1.z); xm1[6] = bflo(r1.w); xm1[7] = bfhi(r1.w); }
#pragma unroll 4
        for (int tt = 0; tt < 32; ++tt) {
            const u32x4 r = __builtin_nontemporal_load((const u32x4*)(proj + (size_t)(t0 + tt) * NPROJ + PC_XBC + c0));
            const float x[8] = {bflo(r.x), bfhi(r.x), bflo(r.y), bfhi(r.y), bflo(r.z), bfhi(r.z), bflo(r.w), bfhi(r.w)};
            float o[8];
#pragma unroll
            for (int e = 0; e < 8; ++e) { o[e] = fsilu(bb[e] + w[0][e] * xm3[e] + w[1][e] * xm2[e] + w[2][e] * xm1[e] + w[3][e] * x[e]); xm3[e] = xm2[e]; xm2[e] = xm1[e]; xm1[e] = x[e]; }
            u32x4 ow; ow.x = cvt_pk_bf16(o[0], o[1]); ow.y = cvt_pk_bf16(o[2], o[3]); ow.z = cvt_pk_bf16(o[4], o[5]); ow.w = cvt_pk_bf16(o[6], o[7]);
            *(u32x4*)(xc + (size_t)(t0 + tt) * 1536 + c0) = ow;
        }
    }
}

typedef float f32x16 __attribute__((ext_vector_type(16)));
typedef short s16x4 __attribute__((ext_vector_type(4)));
#define MFMA32(a, b, c) __builtin_amdgcn_mfma_f32_32x32x16_bf16((a), (b), (c), 0, 0, 0)
__device__ __forceinline__ unsigned off_b(unsigned row, unsigned ch) { return 256u * row + 16u * (ch ^ (((row & 3u) << 2) | ((row >> 2) & 3u))); }
__device__ __forceinline__ unsigned off_v(unsigned row, unsigned ch) { return 128u * row + 16u * (ch ^ (((row >> 1) & 1u) << 2)); }
__device__ __forceinline__ unsigned off_y(unsigned row, unsigned ch) { return 128u * row + 16u * (ch ^ (row & 7u)); }
__device__ __forceinline__ bf16x8 tr_read2(unsigned a0, unsigned a1) {
    s16x4 lo, hi;
    asm volatile("ds_read_b64_tr_b16 %0, %2\n\tds_read_b64_tr_b16 %1, %3\n\ts_waitcnt lgkmcnt(0)" : "=&v"(lo), "=&v"(hi) : "v"(a0), "v"(a1) : "memory");
    return __builtin_shufflevector(lo, hi, 0, 1, 2, 3, 4, 5, 6, 7);
}
__device__ __forceinline__ void tr_read4(unsigned a0, unsigned a1, unsigned a2, unsigned a3, bf16x8& f0, bf16x8& f1) {
    s16x4 r0, r1, r2, r3;
    asm volatile("ds_read_b64_tr_b16 %0, %4\n\tds_read_b64_tr_b16 %1, %5\n\tds_read_b64_tr_b16 %2, %6\n\tds_read_b64_tr_b16 %3, %7\n\ts_waitcnt lgkmcnt(0)"
                 : "=&v"(r0), "=&v"(r1), "=&v"(r2), "=&v"(r3) : "v"(a0), "v"(a1), "v"(a2), "v"(a3) : "memory");
    f0 = __builtin_shufflevector(r0, r1, 0, 1, 2, 3, 4, 5, 6, 7); f1 = __builtin_shufflevector(r2, r3, 0, 1, 2, 3, 4, 5, 6, 7);
}
__device__ __forceinline__ void tr_read8(unsigned a0, unsigned a1, unsigned a2, unsigned a3, unsigned a4, unsigned a5, unsigned a6, unsigned a7, bf16x8& f0, bf16x8& f1, bf16x8& f2, bf16x8& f3) {
    s16x4 r0, r1, r2, r3, r4, r5, r6, r7;
    asm volatile("ds_read_b64_tr_b16 %0, %8\n\tds_read_b64_tr_b16 %1, %9\n\tds_read_b64_tr_b16 %2, %10\n\tds_read_b64_tr_b16 %3, %11\n\tds_read_b64_tr_b16 %4, %12\n\tds_read_b64_tr_b16 %5, %13\n\tds_read_b64_tr_b16 %6, %14\n\tds_read_b64_tr_b16 %7, %15\n\ts_waitcnt lgkmcnt(0)"
                 : "=&v"(r0), "=&v"(r1), "=&v"(r2), "=&v"(r3), "=&v"(r4), "=&v"(r5), "=&v"(r6), "=&v"(r7) : "v"(a0), "v"(a1), "v"(a2), "v"(a3), "v"(a4), "v"(a5), "v"(a6), "v"(a7) : "memory");
    f0 = __builtin_shufflevector(r0, r1, 0, 1, 2, 3, 4, 5, 6, 7); f1 = __builtin_shufflevector(r2, r3, 0, 1, 2, 3, 4, 5, 6, 7);
    f2 = __builtin_shufflevector(r4, r5, 0, 1, 2, 3, 4, 5, 6, 7); f3 = __builtin_shufflevector(r6, r7, 0, 1, 2, 3, 4, 5, 6, 7);
}
__device__ __forceinline__ f32x16 zero16() { f32x16 z;
#pragma unroll
    for (int i = 0; i < 16; ++i) z[i] = 0.f;
    return z; }
__device__ __forceinline__ void phase_scan0(const Params& p, const Frame& F) {
    bf16_t* proj = WSP(bf16_t, WS_SLAB);
    const bf16_t* xc = (const bf16_t*)F.out;
    constexpr unsigned OQ = 0, OK = 32768, OV = 65536, OVW = 81920, OS = 98304, OY = 114688, OSM = 131072;
    LAS unsigned char* L = F.lds;
    const unsigned lbase = (unsigned)(__UINTPTR_TYPE__)L;
    LAS float* sm = (LAS float*)(L + OSM);
    const int lane = F.lane, w = F.wave, it = w >> 1, pt = w & 1;
    const unsigned h0 = lane >> 5, lr0 = lane & 31;
    const int trow = F.tid >> 2, tpart = F.tid & 3;
    const unsigned blk0 = (lane >> 4) & 1u, tq0 = (lane & 15u) >> 2, tp0 = lane & 3u;
    for (int ui = 0; ui < 2; ++ui) {
        const int uu = F.bid + ui * F.G;
        if (uu >= 512) break;
        const bool is_ssd = uu < 256; const int v = uu & 255, x8 = v & 7, slot = v >> 3;
        int b, hh, grp = 0, hr = 0, sl = 0;
        if (is_ssd) { const int pg = x8 + 8 * (slot >> 3), hg = slot & 7; b = pg >> 1; grp = pg & 1; hh = grp * 8 + hg; }
        else { const int pr = x8 + 8 * (slot >> 2); sl = slot & 3; b = pr >> 2; hr = pr & 3; hh = hr * 4 + sl; }
        const size_t row0 = (size_t)b * SEQ;
        const bf16_t* qptr; const bf16_t* kptr; const bf16_t* vptr; size_t qs, vs; bf16_t* optr;
        if (is_ssd) { qptr = xc + 1280 + grp * 128; kptr = xc + 1024 + grp * 128; vptr = xc + hh * 64; qs = 1536; vs = 1536; optr = proj + hh * 64; }
        else { qptr = proj + PC_Q + hr * 128; kptr = proj + PC_K + hr * 128; vptr = proj + PC_V + hr * 256 + sl * 64; qs = NPROJ; vs = NPROJ; optr = proj + 1024 + hr * 256 + sl * 64; }
        const bf16_t* zptr = proj + hh * 64;
        const float A_h = is_ssd ? -__expf(p.in[8][hh]) : 0.f, dtb = is_ssd ? p.in[7][hh] : 0.f, D_h = is_ssd ? p.in[9][hh] : 0.f;
        const float lng = __logf(1.f - exp2f(-5.f - (float)hr));
        u32x4 rv[2], rz[2]; float rdt0 = 0.f, rdt1 = 0.f;
        f32x16 St0 = zero16(), St1 = zero16();
        __syncthreads();
        for (int i = F.tid; i < 16384 / 16; i += NTHREADS) *(LAS u32x4*)(L + OS + i * 16) = (u32x4){0u, 0u, 0u, 0u};
#define SC_LOAD(c) do { const size_t r_ = row0 + (size_t)(c) * 128 + trow; \
            _Pragma("unroll") for (int e = 0; e < 2; ++e) rv[e] = *(const u32x4*)(vptr + r_ * vs + tpart * 16 + e * 8); \
            if (is_ssd && w == 0) { rdt0 = bf2f(proj[(row0 + (size_t)(c) * 128 + 2 * lane) * NPROJ + PC_DT + hh]); rdt1 = bf2f(proj[(row0 + (size_t)(c) * 128 + 2 * lane + 1) * NPROJ + PC_DT + hh]); } } while (0)
#define SC_DMA(c) do { _Pragma("unroll") for (int e = 0; e < 4; ++e) { const int I_ = w * 4 + e; const unsigned r_ = 4u * I_ + ((unsigned)lane >> 4), cs_ = lane & 15u, ch_ = cs_ ^ (((r_ & 3u) << 2) | ((r_ >> 2) & 3u)); \
            const size_t g_ = (row0 + (size_t)(c) * 128 + r_) * qs + ch_ * 8; \
            __builtin_amdgcn_global_load_lds((const unsigned*)(qptr + g_), (LAS unsigned*)(L + OQ + I_ * 1024), 16, 0, 0); \
            __builtin_amdgcn_global_load_lds((const unsigned*)(kptr + g_), (LAS unsigned*)(L + OK + I_ * 1024), 16, 0, 0); } } while (0)
#define SC_LOADZ(c) do { if (is_ssd) { const size_t r_ = row0 + (size_t)(c) * 128 + trow; rz[0] = __builtin_nontemporal_load((const u32x4*)(zptr + r_ * NPROJ + tpart * 16)); rz[1] = __builtin_nontemporal_load((const u32x4*)(zptr + r_ * NPROJ + tpart * 16 + 8)); } } while (0)
#define SC_SMALL(c) do { if (w == 0) { LAS float* sb = sm + ((c) & 1) * 384; float d0, d1, a0, a1; \
            if (is_ssd) { d0 = fsoftplus(rdt0 + dtb); d1 = fsoftplus(rdt1 + dtb); a0 = d0 * A_h; a1 = d1 * A_h; } else { d0 = 1.f; d1 = 1.f; a0 = lng; a1 = lng; } \
            float sc = a0 + a1; _Pragma("unroll") for (int o = 1; o < 64; o <<= 1) { const float tv = __shfl_up(sc, o); if (lane >= o) sc += tv; } \
            const float c1 = sc, c0 = sc - a1; const float tot = __shfl(sc, 63); \
            sb[2 * lane] = c0; sb[2 * lane + 1] = c1; sb[128 + 2 * lane] = d0; sb[128 + 2 * lane + 1] = d1; sb[256 + 2 * lane] = __expf(tot - c0) * d0; sb[256 + 2 * lane + 1] = __expf(tot - c1) * d1; } } while (0)
#define SC_STORE(c) do { const float wj_ = sm[((c) & 1) * 384 + 256 + trow]; \
            _Pragma("unroll") for (int e = 0; e < 2; ++e) { const u32x4 x_ = rv[e]; *(LAS u32x4*)(L + OV + off_v(trow, tpart * 2 + e)) = x_; u32x4 y_; \
                y_.x = cvt_pk_bf16(bflo(x_.x) * wj_, bfhi(x_.x) * wj_); y_.y = cvt_pk_bf16(bflo(x_.y) * wj_, bfhi(x_.y) * wj_); y_.z = cvt_pk_bf16(bflo(x_.z) * wj_, bfhi(x_.z) * wj_); y_.w = cvt_pk_bf16(bflo(x_.w) * wj_, bfhi(x_.w) * wj_); \
                *(LAS u32x4*)(L + OVW + off_v(trow, tpart * 2 + e)) = y_; } } while (0)
        SC_DMA(0); SC_LOAD(0);
        SC_SMALL(0);
        __syncthreads();
        SC_STORE(0);
        asm volatile("s_waitcnt vmcnt(0)" ::: "memory");
        __syncthreads();
        SP_DECL;
        for (int c = 0; c < SEQ / 128; ++c) {
            SP_MARK(8);
            const LAS float* sb = sm + (c & 1) * 384;
            unsigned lr = lr0, h = h0, blk = blk0, tq_ = tq0, tp_ = tp0;
            asm volatile("" : "+v"(lr), "+v"(h), "+v"(blk), "+v"(tq_), "+v"(tp_));
            if (c + 1 < SEQ / 128) { SC_LOAD(c + 1); }
            SC_LOADZ(c);
            const int ph = pt;
            const float ai = sb[32 * it + lr];
            f32x16 Yd0 = zero16(), Yd1 = zero16();
            for (int jt = ph; jt <= it; jt += 2) {
                f32x16 acc = zero16();
#pragma unroll
                for (int ks = 0; ks < 8; ++ks) { const bf16x8 ka = *(const LAS bf16x8*)(L + OK + off_b(32 * jt + lr, 2 * ks + h)), qb = *(const LAS bf16x8*)(L + OQ + off_b(32 * it + lr, 2 * ks + h)); acc = MFMA32(ka, qb, acc); }
                const bool diag = (jt == it);
#pragma unroll
                for (int g = 0; g < 4; ++g) { const f32x4 aj = *(const LAS f32x4*)(sb + 32 * jt + 8 * g + 4 * h), dj = *(const LAS f32x4*)(sb + 128 + 32 * jt + 8 * g + 4 * h);
#pragma unroll
                    for (int e = 0; e < 4; ++e) { const float dec = __expf(ai - aj[e]) * dj[e]; const bool ok = !diag || ((int)lr >= (int)(8 * g + 4 * h + e)); acc[4 * g + e] = ok ? acc[4 * g + e] * dec : 0.f; } }
#pragma unroll
                for (int s2 = 0; s2 < 2; ++s2) {
                    u32x4 pw; pw.x = cvt_pk_bf16(acc[8 * s2 + 0], acc[8 * s2 + 1]); pw.y = cvt_pk_bf16(acc[8 * s2 + 2], acc[8 * s2 + 3]); pw.z = cvt_pk_bf16(acc[8 * s2 + 4], acc[8 * s2 + 5]); pw.w = cvt_pk_bf16(acc[8 * s2 + 6], acc[8 * s2 + 7]);
                    const bf16x8 Pb = __builtin_bit_cast(bf16x8, pw);
                    const unsigned rb0 = 32 * jt + 16 * s2 + 4 * h + tq_, cc0 = 2 * blk + (tp_ >> 1), o8 = 8 * (tp_ & 1);
                    bf16x8 va0, va1;
                    tr_read4(lbase + OV + off_v(rb0, cc0) + o8, lbase + OV + off_v(rb0 + 8, cc0) + o8, lbase + OV + off_v(rb0, 4 + cc0) + o8, lbase + OV + off_v(rb0 + 8, 4 + cc0) + o8, va0, va1);
                    Yd0 = MFMA32(va0, Pb, Yd0); Yd1 = MFMA32(va1, Pb, Yd1);
                }
            }
            {
                f32x16 Yo = zero16();
#pragma unroll
                for (int ks = 0; ks < 8; ++ks) { const bf16x8 sa = *(const LAS bf16x8*)(L + OS + off_b(32 * ph + lr, 2 * ks + h)), qb = *(const LAS bf16x8*)(L + OQ + off_b(32 * it + lr, 2 * ks + h)); Yo = MFMA32(sa, qb, Yo); }
                const float ei = __expf(ai);
                if (ph == 0) {
#pragma unroll
                    for (int r = 0; r < 16; ++r) Yd0[r] += Yo[r] * ei; }
                else {
#pragma unroll
                    for (int r = 0; r < 16; ++r) Yd1[r] += Yo[r] * ei; }
            }
#pragma unroll
            for (int g = 0; g < 4; ++g) { u32x2 yw;
                if (ph == 0) { yw.x = cvt_pk_bf16(Yd1[4 * g], Yd1[4 * g + 1]); yw.y = cvt_pk_bf16(Yd1[4 * g + 2], Yd1[4 * g + 3]); } else { yw.x = cvt_pk_bf16(Yd0[4 * g], Yd0[4 * g + 1]); yw.y = cvt_pk_bf16(Yd0[4 * g + 2], Yd0[4 * g + 3]); }
                *(LAS u32x2*)(L + OY + off_y(32 * it + lr, 4 * (1 - ph) + g) + 8 * h) = yw; }
            const float dl = __expf(sb[127]);
            const int st0 = (w == 0) ? 0 : (w == 1) ? 2 : (w == 2) ? 4 : (w == 3) ? 5 : (w == 5) ? 6 : -1, st1 = (w == 0) ? 1 : (w == 1) ? 3 : (w == 5) ? 7 : -1;
            if (st0 >= 0) {
                const int spt = st0 & 1, snt = st0 >> 1;
#pragma unroll
                for (int r = 0; r < 16; ++r) St0[r] *= dl;
#pragma unroll
                for (int k2 = 0; k2 < 4; ++k2) { const unsigned rb = 32 * k2 + 8 * h + tq_, cv = 4 * spt + 2 * blk + (tp_ >> 1), cb = 4 * snt + 2 * blk + (tp_ >> 1), o8 = 8 * (tp_ & 1);
                    bf16x8 fa0, fb0, fa1, fb1;
                    tr_read8(lbase + OVW + off_v(rb, cv) + o8, lbase + OVW + off_v(rb + 4, cv) + o8, lbase + OK + off_b(rb, cb) + o8, lbase + OK + off_b(rb + 4, cb) + o8,
                             lbase + OVW + off_v(rb + 16, cv) + o8, lbase + OVW + off_v(rb + 20, cv) + o8, lbase + OK + off_b(rb + 16, cb) + o8, lbase + OK + off_b(rb + 20, cb) + o8, fa0, fb0, fa1, fb1);
                    St0 = MFMA32(fa0, fb0, St0); St0 = MFMA32(fa1, fb1, St0); }
                if (st1 >= 0) {
                    const int spt1 = st1 & 1, snt1 = st1 >> 1;
#pragma unroll
                    for (int r = 0; r < 16; ++r) St1[r] *= dl;
#pragma unroll
                    for (int k2 = 0; k2 < 4; ++k2) { const unsigned rb = 32 * k2 + 8 * h + tq_, cv = 4 * spt1 + 2 * blk + (tp_ >> 1), cb = 4 * snt1 + 2 * blk + (tp_ >> 1), o8 = 8 * (tp_ & 1);
                        bf16x8 fa0, fb0, fa1, fb1;
                        tr_read8(lbase + OVW + off_v(rb, cv) + o8, lbase + OVW + off_v(rb + 4, cv) + o8, lbase + OK + off_b(rb, cb) + o8, lbase + OK + off_b(rb + 4, cb) + o8,
                                 lbase + OVW + off_v(rb + 16, cv) + o8, lbase + OVW + off_v(rb + 20, cv) + o8, lbase + OK + off_b(rb + 16, cb) + o8, lbase + OK + off_b(rb + 20, cb) + o8, fa0, fb0, fa1, fb1);
                        St1 = MFMA32(fa0, fb0, St1); St1 = MFMA32(fa1, fb1, St1); }
                }
            }
            if (c + 1 < SEQ / 128) SC_SMALL(c + 1);
            LDS_BAR();
#pragma unroll
            for (int g = 0; g < 4; ++g) { LAS u32x2* yp = (LAS u32x2*)(L + OY + off_y(32 * it + lr, 4 * ph + g) + 8 * h); const u32x2 pv_ = *yp; u32x2 yw;
                if (ph == 0) { yw.x = cvt_pk_bf16(Yd0[4 * g] + bflo(pv_.x), Yd0[4 * g + 1] + bfhi(pv_.x)); yw.y = cvt_pk_bf16(Yd0[4 * g + 2] + bflo(pv_.y), Yd0[4 * g + 3] + bfhi(pv_.y)); }
                else { yw.x = cvt_pk_bf16(Yd1[4 * g] + bflo(pv_.x), Yd1[4 * g + 1] + bfhi(pv_.x)); yw.y = cvt_pk_bf16(Yd1[4 * g + 2] + bflo(pv_.y), Yd1[4 * g + 3] + bfhi(pv_.y)); }
                *yp = yw; }
            LDS_BAR();
            SP_MARK(5);
            if (c + 1 < SEQ / 128) SC_DMA(c + 1);
            if (st0 >= 0) {
                const int spt = st0 & 1, snt = st0 >> 1;
#pragma unroll
                for (int r = 0; r < 16; ++r) { const unsigned pr = 32 * spt + (r & 3) + 8 * (r >> 2) + 4 * h, n = 32 * snt + lr; *(LAS bf16_t*)(L + OS + off_b(pr, n >> 3) + 2 * (n & 7)) = f2bf(St0[r]); }
                if (st1 >= 0) { const int spt1 = st1 & 1, snt1 = st1 >> 1;
#pragma unroll
                    for (int r = 0; r < 16; ++r) { const unsigned pr = 32 * spt1 + (r & 3) + 8 * (r >> 2) + 4 * h, n = 32 * snt1 + lr; *(LAS bf16_t*)(L + OS + off_b(pr, n >> 3) + 2 * (n & 7)) = f2bf(St1[r]); }
                }
            }
            {
                bf16_t* orow = optr + (row0 + (size_t)c * 128 + trow) * NPROJ + tpart * 16;
#pragma unroll
                for (int e = 0; e < 2; ++e) {
                    const u32x4 yv = *(const LAS u32x4*)(L + OY + off_y(trow, tpart * 2 + e));
                    u32x4 ov = yv;
                    if (is_ssd) { const u32x4 xv = *(const LAS u32x4*)(L + OV + off_v(trow, tpart * 2 + e)); const u32x4 zv = rz[e];
                        ov.x = cvt_pk_bf16((bflo(yv.x) + bflo(xv.x) * D_h) * fsilu(bflo(zv.x)), (bfhi(yv.x) + bfhi(xv.x) * D_h) * fsilu(bfhi(zv.x)));
                        ov.y = cvt_pk_bf16((bflo(yv.y) + bflo(xv.y) * D_h) * fsilu(bflo(zv.y)), (bfhi(yv.y) + bfhi(xv.y) * D_h) * fsilu(bfhi(zv.y)));
                        ov.z = cvt_pk_bf16((bflo(yv.z) + bflo(xv.z) * D_h) * fsilu(bflo(zv.z)), (bfhi(yv.z) + bfhi(xv.z) * D_h) * fsilu(bfhi(zv.z)));
                        ov.w = cvt_pk_bf16((bflo(yv.w) + bflo(xv.w) * D_h) * fsilu(bflo(zv.w)), (bfhi(yv.w) + bfhi(xv.w) * D_h) * fsilu(bfhi(zv.w))); }
                    *(u32x4*)(orow + e * 8) = ov;
                }
            }
            LDS_BAR();
            SP_MARK(6);
            if (c + 1 < SEQ / 128) SC_STORE(c + 1);
            asm volatile("s_waitcnt vmcnt(0)" ::: "memory");
            LDS_BAR();
            SP_MARK(7);
        }
#undef SC_LOAD
#undef SC_LOADZ
#undef SC_SMALL
#undef SC_STORE
    }
}

__device__ __forceinline__ void phase_gatenorm(const Params& p, const Frame& F) {
    const bf16_t* proj = WSP(bf16_t, WS_SLAB);
    bf16_t* ybuf = WSP(bf16_t, WS_SLAB);
    const float* nw = p.in[10];
    int row = F.bid * 8 + F.wave; const int stride = F.G * 8;
    u32x4 yc[4], gc[2], yn[4], gn[2];
#define GN_LOAD(r_, Y_, G_) do { const bf16_t* b_ = ybuf + (size_t)(r_) * NPROJ; _Pragma("unroll") for (int j = 0; j < 4; ++j) Y_[j] = *(const u32x4*)(b_ + j * 512 + F.lane * 8); \
        _Pragma("unroll") for (int j = 0; j < 2; ++j) G_[j] = __builtin_nontemporal_load((const u32x4*)(b_ + PC_G + j * 512 + F.lane * 8)); } while (0)
    if (row < T_TOK) GN_LOAD(row, yc, gc);
    for (; row < T_TOK; row += stride) {
        if (row + stride < T_TOK) GN_LOAD(row + stride, yn, gn);
        bf16_t* yr = ybuf + (size_t)row * NPROJ;
#pragma unroll
        for (int j = 0; j < 4; ++j) {
            const u32x4 w = yc[j];
            float x[8] = {bflo(w.x), bfhi(w.x), bflo(w.y), bfhi(w.y), bflo(w.z), bfhi(w.z), bflo(w.w), bfhi(w.w)};
            float ss = 0.f;
#pragma unroll
            for (int e = 0; e < 8; ++e) ss += x[e] * x[e];
            if (j < 2) { ss = wave_sum_u(ss); const float rs = rsqrtf(ss * (1.f / 512.f) + 1e-5f);
                const f32x4 w0 = *(const f32x4*)(nw + j * 512 + F.lane * 8), w1 = *(const f32x4*)(nw + j * 512 + F.lane * 8 + 4);
#pragma unroll
                for (int e = 0; e < 4; ++e) { x[e] *= rs * w0[e]; x[4 + e] *= rs * w1[e]; } }
            else {
                ss = dpp_sum16(ss); ss += __shfl_xor(ss, 16);
                const float rs = rsqrtf(ss * (1.f / 256.f) + 1e-6f);
                const u32x4 gw = gc[j - 2];
                const float g[8] = {bflo(gw.x), bfhi(gw.x), bflo(gw.y), bfhi(gw.y), bflo(gw.z), bfhi(gw.z), bflo(gw.w), bfhi(gw.w)};
#pragma unroll
                for (int e = 0; e < 8; ++e) x[e] *= rs * fsilu(g[e]); }
            u32x4 o; o.x = cvt_pk_bf16(x[0], x[1]); o.y = cvt_pk_bf16(x[2], x[3]); o.z = cvt_pk_bf16(x[4], x[5]); o.w = cvt_pk_bf16(x[6], x[7]);
            *(u32x4*)(yr + j * 512 + F.lane * 8) = o;
        }
#pragma unroll
        for (int j = 0; j < 4; ++j) yc[j] = yn[j];
        gc[0] = gn[0]; gc[1] = gn[1];
    }
#undef GN_LOAD
}

__device__ __forceinline__ void phase_moe_route(const Params& p, const Frame& F, int layer, const bf16_t* h, bf16_t* tbuf) {
    unsigned char* meta = F.ws + WS_META + (size_t)layer * META_STRIDE;
    int* tok_rank = (int*)(meta + MT_RANK); int* tok_bkt = (int*)(meta + MT_BKT); f32x2* tok_c = (f32x2*)(meta + MT_C);
    int* gcount = (int*)(F.ws + WS_CTL + CTL_CNT_OFF) + layer * 32;
    const float* bg = p.in[31] + layer * 4; const float* be = p.in[33] + layer * 16;
    LAS float* wl = (LAS float*)F.lds;
    LAS int* lcount = (LAS int*)(F.lds + 81920);
    LAS int* lbase = lcount + 32;
    LAS int* l_bkt = lbase + 32;
    LAS int* l_rank = l_bkt + 1024;
    LAS float* l_c = (LAS float*)(l_rank + 1024);
    LAS float* lgt = (LAS float*)(F.lds + 98816);
    __syncthreads();
    { const float* wrt = WSP(float, WS_RTW) + (size_t)layer * 20480;
        for (int idx = F.tid; idx < 20 * 1024 / 4; idx += NTHREADS) *(LAS f32x4*)(wl + idx * 4) = *(const f32x4*)(wrt + idx * 4); }
    if (F.tid < 32) lcount[F.tid] = 0;
    __syncthreads();
    const int TPB = (T_TOK + F.G - 1) / F.G, tok0 = F.bid * TPB;
    f32x4 wv[4]; row_load(p.in[2] + (size_t)layer * DM, F.lane, wv);
    f32x4 va[4], vb[4], na[4], nb[4];
    int hsel;
    { unsigned t0_ = 0u, t1_ = 1u; asm volatile("s_nop 1\n\tv_permlane32_swap_b32 %0, %1\n\ts_nop 1" : "+v"(t0_), "+v"(t1_)); hsel = (t0_ + t1_ >= 2u) ? 10 : 0; }
#define RT_LOAD(li_, A_, B_) do { const int ta_ = tok0 + (li_), tb_ = ta_ + 8; \
        if ((li_) < TPB && ta_ < T_TOK) row_load_bf_nt(h + (size_t)ta_ * DM, F.lane, A_); if ((li_) + 8 < TPB && tb_ < T_TOK) row_load_bf_nt(h + (size_t)tb_ * DM, F.lane, B_); } while (0)
    RT_LOAD(F.wave, va, vb);
    for (int li = F.wave; li < TPB; li += 16) {
        const int tok = tok0 + li; if (tok >= T_TOK) break;
        const bool hasb = (li + 8 < TPB) && (tok + 8 < T_TOK);
        RT_LOAD(li + 16, na, nb);
        const float rsa = row_rstd(va, 1e-6f), rsb = row_rstd(vb, 1e-6f);
#pragma unroll
        for (int j = 0; j < 4; ++j) { va[j] = va[j] * rsa * wv[j]; vb[j] = vb[j] * rsb * wv[j]; }
        if (layer == 1) {
#pragma unroll
            for (int j = 0; j < 4; ++j) { *(unsigned*)((unsigned char*)tbuf + (size_t)tok * DM + j * 256 + F.lane * 4) = pk_fp8x4(va[j][0] * F8_ACT_SCALE, va[j][1] * F8_ACT_SCALE, va[j][2] * F8_ACT_SCALE, va[j][3] * F8_ACT_SCALE);
                if (hasb) *(unsigned*)((unsigned char*)tbuf + (size_t)(tok + 8) * DM + j * 256 + F.lane * 4) = pk_fp8x4(vb[j][0] * F8_ACT_SCALE, vb[j][1] * F8_ACT_SCALE, vb[j][2] * F8_ACT_SCALE, vb[j][3] * F8_ACT_SCALE); }
        } else {
        row_store_bf16(tbuf + (size_t)tok * DM, F.lane, va);
        if (hasb) row_store_bf16(tbuf + (size_t)(tok + 8) * DM, F.lane, vb); }
        LAS float* lga = lgt + li * 20; LAS float* lgb = lgt + (li + 8) * 20;
#pragma unroll
        for (int o = 0; o < 10; ++o) { f32x2 c0 = (f32x2){0.f, 0.f}, c1 = c0, d0 = c0, d1 = c0;
#pragma unroll
            for (int j = 0; j < 4; ++j) { const f32x4 w4 = *(const LAS f32x4*)(wl + o * 1024 + j * 256 + F.lane * 4), w5 = *(const LAS f32x4*)(wl + (o + 10) * 1024 + j * 256 + F.lane * 4);
                const f32x2 w4l = (f32x2){w4[0], w4[1]}, w4h = (f32x2){w4[2], w4[3]}, w5l = (f32x2){w5[0], w5[1]}, w5h = (f32x2){w5[2], w5[3]};
                const f32x2 al = (f32x2){va[j][0], va[j][1]}, ah = (f32x2){va[j][2], va[j][3]}, bl = (f32x2){vb[j][0], vb[j][1]}, bh = (f32x2){vb[j][2], vb[j][3]};
                c0 += al * w4l; c0 += ah * w4h; c1 += al * w5l; c1 += ah * w5h; d0 += bl * w4l; d0 += bh * w4h; d1 += bl * w5l; d1 += bh * w5h; }
            float a0 = c0[0] + c0[1], a1 = c1[0] + c1[1], b0 = d0[0] + d0[1], b1 = d1[0] + d1[1];
            asm volatile("s_nop 1\n\tv_permlane32_swap_b32 %0, %1\n\tv_permlane32_swap_b32 %2, %3\n\ts_nop 1" : "+v"(a0), "+v"(a1), "+v"(b0), "+v"(b1));
            float sa = dpp_sum16(a0 + a1), sb_ = dpp_sum16(b0 + b1);
            sa += __builtin_bit_cast(float, __builtin_amdgcn_update_dpp(0, __builtin_bit_cast(int, sa), 0x142, 0xA, 0xF, false));
            sb_ += __builtin_bit_cast(float, __builtin_amdgcn_update_dpp(0, __builtin_bit_cast(int, sb_), 0x142, 0xA, 0xF, false));
            if ((F.lane & 31) == 16) { lga[hsel + o] = sa; if (hasb) lgb[hsel + o] = sb_; }
            if (o & 1) __builtin_amdgcn_sched_barrier(0); }
#pragma unroll
        for (int j = 0; j < 4; ++j) { va[j] = na[j]; vb[j] = nb[j]; }
    }
#undef RT_LOAD
    __syncthreads();
    for (int li = F.tid; li < TPB; li += NTHREADS) {
        if (tok0 + li >= T_TOK) break;
        float lg[20];
#pragma unroll
        for (int o = 0; o < 20; ++o) lg[o] = lgt[li * 20 + o];
        float g0 = lg[0] + bg[0], g1 = lg[1] + bg[1], g2 = lg[2] + bg[2], g3 = lg[3] + bg[3];
        int gi = 0; float gm = g0; if (g1 > gm) { gm = g1; gi = 1; } if (g2 > gm) { gm = g2; gi = 2; } if (g3 > gm) { gm = g3; gi = 3; }
        const float gate = 1.f / (__expf(g0 - gm) + __expf(g1 - gm) + __expf(g2 - gm) + __expf(g3 - gm));
        float e0, e1, e2, e3;
        e0 = (gi == 0) ? lg[4] : (gi == 1) ? lg[8] : (gi == 2) ? lg[12] : lg[16];
        e1 = (gi == 0) ? lg[5] : (gi == 1) ? lg[9] : (gi == 2) ? lg[13] : lg[17];
        e2 = (gi == 0) ? lg[6] : (gi == 1) ? lg[10] : (gi == 2) ? lg[14] : lg[18];
        e3 = (gi == 0) ? lg[7] : (gi == 1) ? lg[11] : (gi == 2) ? lg[15] : lg[19];
        e0 += be[gi * 4 + 0]; e1 += be[gi * 4 + 1]; e2 += be[gi * 4 + 2]; e3 += be[gi * 4 + 3];
        int i1 = 0; float v1 = e0; if (e1 > v1) { v1 = e1; i1 = 1; } if (e2 > v1) { v1 = e2; i1 = 2; } if (e3 > v1) { v1 = e3; i1 = 3; }
        int i2 = -1; float v2 = -3.0e38f;
        if (i1 != 0 && e0 > v2) { v2 = e0; i2 = 0; } if (i1 != 1 && e1 > v2) { v2 = e1; i2 = 1; } if (i1 != 2 && e2 > v2) { v2 = e2; i2 = 2; } if (i1 != 3 && e3 > v2) { v2 = e3; i2 = 3; }
        const float w1 = gate / (1.f + __expf(v2 - v1)), w2 = gate - w1;
        const int lo = i1 < i2 ? i1 : i2, hi = i1 < i2 ? i2 : i1; const float clo = i1 < i2 ? w1 : w2, chi = i1 < i2 ? w2 : w1;
        const int pr = (lo == 0) ? hi - 1 : (lo == 1) ? hi + 1 : 5;
        const int bk = gi * 6 + pr;
        l_bkt[li] = bk; l_c[li * 2] = clo; l_c[li * 2 + 1] = chi;
        l_rank[li] = __hip_atomic_fetch_add((int*)(lcount + bk), 1, __ATOMIC_RELAXED, __HIP_MEMORY_SCOPE_WORKGROUP);
    }
    __syncthreads();
    if (F.tid < 24) lbase[F.tid] = __hip_atomic_fetch_add(gcount + F.tid, lcount[F.tid], __ATOMIC_RELAXED, __HIP_MEMORY_SCOPE_AGENT);
    __syncthreads();
    for (int li = F.tid; li < TPB; li += NTHREADS) { const int tok = tok0 + li; if (tok < T_TOK) { const int bk = l_bkt[li]; tok_bkt[tok] = bk; tok_rank[tok] = lbase[bk] + l_rank[li]; tok_c[tok] = (f32x2){l_c[li * 2], l_c[li * 2 + 1]}; } }
}
__device__ __forceinline__ void phase_moe_slots(const Params& p, const Frame& F, int layer) {
    unsigned char* meta = F.ws + WS_META + (size_t)layer * META_STRIDE;
    const int* tok_rank = (const int*)(meta + MT_RANK); const int* tok_bkt = (const int*)(meta + MT_BKT); const f32x2* tok_c = (const f32x2*)(meta + MT_C);
    int* slot_tok = (int*)(meta + MT_STOK); f32x2* slot_c = (f32x2*)(meta + MT_SC); int* tile_tab = (int*)(meta + MT_TILE);
    int* gcount = (int*)(F.ws + WS_CTL + CTL_CNT_OFF) + layer * 32;
    LAS int* cnt = (LAS int*)F.lds; LAS int* start = cnt + 32;
    __syncthreads();
    if (F.tid < 24) cnt[F.tid] = __hip_atomic_load(gcount + F.tid, __ATOMIC_RELAXED, __HIP_MEMORY_SCOPE_AGENT);
    __syncthreads();
    if (F.tid == 0) { int a = 0; for (int b = 0; b < 24; ++b) { start[b] = a; a += (cnt[b] + 255) >> 8; } start[24] = a; }
    __syncthreads();
    for (int tok = F.bid * NTHREADS + F.tid; tok < T_TOK; tok += F.G * NTHREADS) { const int bk = tok_bkt[tok]; const int slot = start[bk] * 256 + tok_rank[tok]; slot_tok[slot] = tok; slot_c[slot] = tok_c[tok]; }
    for (int b = F.bid; b < 24; b += F.G) { const int s0 = start[b] * 256 + cnt[b], s1 = start[b + 1] * 256;
        for (int s = s0 + F.tid; s < s1; s += NTHREADS) { slot_tok[s] = -1; slot_c[s] = (f32x2){0.f, 0.f}; } }
    if (F.bid == 0) { if (F.tid == 0) tile_tab[0] = start[24];
        for (int m = F.tid; m < 288; m += NTHREADS) { int bk = 23; for (int b = 0; b < 24; ++b) if (m >= start[b] && m < start[b + 1]) bk = b; tile_tab[64 + m] = bk; } }
}

__device__ __forceinline__ void phase_mix5(const Params& p, const Frame& F, const bf16_t* h, bf16_t* ou, bf16_t* o0, bf16_t* o1, bf16_t* o2) {
    const float* mu = p.in[12];
    f32x4 wv[4], m0[4], m1[4], m2[4];
    row_load(p.in[1] + DM, F.lane, wv); row_load(mu, F.lane, m0); row_load(mu + 2 * DM, F.lane, m1); row_load(mu + 3 * DM, F.lane, m2);
    for (int run = F.bid * 8 + F.wave; run < T_TOK / 32; run += F.G * 8) {
        const int t0 = run * 32;
        f32x4 up[4];
        if ((t0 & (SEQ - 1)) == 0) {
#pragma unroll
            for (int j = 0; j < 4; ++j) up[j] = (f32x4){0.f, 0.f, 0.f, 0.f};
            row_store_bf16(ou + (size_t)(t0 + (t0 >> 12)) * DM, F.lane, up);
        } else { row_load_bf(h + (size_t)(t0 - 1) * DM, F.lane, up); const float rs = row_rstd(up, 1e-6f);
#pragma unroll
            for (int j = 0; j < 4; ++j) up[j] = up[j] * rs * wv[j]; }
        f32x4 u[4], un[4]; row_load_bf(h + (size_t)t0 * DM, F.lane, u);
        for (int tt = 0; tt < 32; ++tt) {
            if (tt + 1 < 32) row_load_bf(h + (size_t)(t0 + tt + 1) * DM, F.lane, un);
            const float rs = row_rstd(u, 1e-6f);
            f32x4 a[4], b[4], c[4];
#pragma unroll
            for (int j = 0; j < 4; ++j) { u[j] = u[j] * rs * wv[j]; const f32x4 xx = up[j] - u[j]; a[j] = u[j] + xx * m0[j]; b[j] = u[j] + xx * m1[j]; c[j] = u[j] + xx * m2[j]; }
            const size_t ro = (size_t)(t0 + tt) * DM;
            row_store_bf16(ou + ro + (size_t)((t0 >> 12) + 1) * DM, F.lane, u);
            row_store_bf16(o0 + ro, F.lane, a); row_store_bf16(o1 + ro, F.lane, b); row_store_bf16(o2 + ro, F.lane, c);
#pragma unroll
            for (int j = 0; j < 4; ++j) { up[j] = u[j]; u[j] = un[j]; }
        }
    }
}

typedef __bf16 bf16x2v __attribute__((ext_vector_type(2)));
__device__ __forceinline__ unsigned pkc(float lo, float hi) { f32x2 t = {lo, hi}; bf16x2v r = __builtin_convertvector(t, bf16x2v); return __builtin_bit_cast(unsigned, r); }
__device__ __forceinline__ unsigned off_r(unsigned row, unsigned ch) { return row * 128u + 16u * (ch ^ ((row >> 1) & 7u)); }
__device__ __forceinline__ unsigned off_m(unsigned row, unsigned ch) { return row * 64u + 16u * (ch ^ ((0u - (row >> 2)) & 3u)); }
#define MFMA16(a, b, c) __builtin_amdgcn_mfma_f32_16x16x32_bf16((a), (b), (c), 0, 0, 0)
__device__ __forceinline__ void swap32(float& a, float& b) { asm volatile("s_nop 1\n\tv_permlane32_swap_b32 %0, %1\n\ts_nop 1" : "+v"(a), "+v"(b)); }
__device__ __forceinline__ float half_sum(float x, bool hf) {
    x = dpp_sum16(x);
    x += __builtin_bit_cast(float, __builtin_amdgcn_update_dpp(0, __builtin_bit_cast(int, x), 0x142, 0xA, 0xF, false));
    const float lo = __builtin_bit_cast(float, __builtin_amdgcn_readlane(__builtin_bit_cast(int, x), 31)), hi = __builtin_bit_cast(float, __builtin_amdgcn_readlane(__builtin_bit_cast(int, x), 63));
    return hf ? hi : lo;
}
__device__ __forceinline__ void phase_rwkv(const Params& p, const Frame& F, bf16_t* rbuf, const bf16_t* kbuf, const bf16_t* vbuf, const bf16_t* ebuf, const bf16_t* abuf, const bf16_t* gbuf) {
    constexpr unsigned ORA = 0, OLB = 16384, OMS = 32768, OMU = 49152, OMY = 53248, OAB = 57344, OAK = 61440, OVT = 65536, OGC = 73728, OYS = 74752, OVF = 91136, OGG = 107520, OBON = 123904;
    LAS unsigned char* L = F.lds;
    const float* k_k = p.in[25]; const float* k_a = p.in[26]; const float* r_k = p.in[27]; const float* lnw = p.in[28]; const float* lnb = p.in[29];
    const int lane0 = F.lane, w = F.wave, pc = w >> 1, th = w & 1;
    for (int unit = F.bid; unit < 256; unit += F.G) {
        const int b = unit >> 4, hd = unit & 15;
        const int gc2 = hd * 64 + 2 * (lane0 & 31);
        const f32x2 kkw = *(const f32x2*)(k_k + gc2), kaw = *(const f32x2*)(k_a + gc2), rkw = *(const f32x2*)(r_k + gc2), lw = *(const f32x2*)(lnw + gc2), lb = *(const f32x2*)(lnb + gc2);
        int lane = lane0;
        f32x4 St[4];
#pragma unroll
        for (int mt = 0; mt < 4; ++mt) St[mt] = (f32x4){0.f, 0.f, 0.f, 0.f};
        unsigned pr[4], pk[4], pv[4], pe[4], pa[4], pg[4], pe0[4];
#define RW_LOAD(t0_) do { const size_t ub_ = ((size_t)b * SEQ + (t0_) + 16 * pc + 8 * th) * DM + hd * 64, ub0_ = ((size_t)b * SEQ + (t0_) + 16 * pc) * DM + hd * 64;     \
            const bf16_t* r_ = rbuf + ub_; const bf16_t* k_ = kbuf + ub_; const bf16_t* v_ = vbuf + ub_; const bf16_t* e_ = ebuf + ub_; const bf16_t* a_ = abuf + ub_; const bf16_t* g_ = gbuf + ub_; const bf16_t* e0_ = ebuf + ub0_; \
            _Pragma("unroll") for (int it = 0; it < 4; ++it) { const unsigned lo_ = (unsigned)((4 * (lane >> 5) + it) * DM + 2 * (lane & 31)); \
            pr[it] = __builtin_nontemporal_load((const unsigned*)(r_ + lo_)); pk[it] = __builtin_nontemporal_load((const unsigned*)(k_ + lo_)); pv[it] = __builtin_nontemporal_load((const unsigned*)(v_ + lo_)); pe[it] = __builtin_nontemporal_load((const unsigned*)(e_ + lo_)); pa[it] = __builtin_nontemporal_load((const unsigned*)(a_ + lo_)); pg[it] = __builtin_nontemporal_load((const unsigned*)(g_ + lo_)); pe0[it] = *(const unsigned*)(e0_ + lo_); } } while (0)
        RW_LOAD(0);
        SP_DECL;
        for (int t0 = 0; t0 < SEQ; t0 += 64) {
            LDS_BAR();
            SP_MARK(4);
            asm volatile("" : "+v"(lane));
            const unsigned l15 = lane & 15, q = (unsigned)lane >> 4, cp = lane & 31;
            const bool hf = lane >= 32;
            const unsigned pj = 32u * (cp >> 4) + 8u * ((cp & 7) >> 1) + 2u * (cp & 1) + ((cp & 8) ? 4u : 0u);
            {
                float pl0[4], pl1[4], ls0 = 0.f, ls1 = 0.f, f0 = 0.f, f1 = 0.f;
#pragma unroll
                for (int it = 0; it < 4; ++it) { ls0 += bflo(pe[it]); ls1 += bfhi(pe[it]); pl0[it] = ls0; pl1[it] = ls1; f0 += bflo(pe0[it]); f1 += bfhi(pe0[it]); }
                float xa0 = 0.f, xb0 = ls0, xa1 = 0.f, xb1 = ls1; swap32(xa0, xb0); swap32(xa1, xb1);
                float ya0 = f0, yb0 = f0, ya1 = f1, yb1 = f1; swap32(ya0, yb0); swap32(ya1, yb1);
                const float base0 = xa0 + (th ? f0 + (hf ? ya0 : yb0) : 0.f), base1 = xa1 + (th ? f1 + (hf ? ya1 : yb1) : 0.f);
                float ms0[8], ms1[8], vt0[4], vt1[4];
                LAS unsigned char* ra = L + ORA + pc * 4096; LAS unsigned char* lbp = L + OLB + pc * 4096;
#pragma unroll
                for (int it = 0; it < 4; ++it) {
                    const int t = 8 * th + 4 * (int)hf + it, tb = 16 * pc + t;
                    const float r0 = bflo(pr[it]), r1 = bfhi(pr[it]), k0 = bflo(pk[it]), k1 = bfhi(pk[it]), a0 = bflo(pa[it]), a1 = bfhi(pa[it]);
                    const float kv0 = k0 * kkw[0], kv1 = k1 * kkw[1]; const float ss = half_sum(kv0 * kv0 + kv1 * kv1, hf); const float rn = rsqrtf(fmaxf(ss, 1e-24f));
                    const float kk0 = kv0 * rn, kk1 = kv1 * rn;
                    const float kp0 = k0 * (1.f + (a0 - 1.f) * kaw[0]), kp1 = k1 * (1.f + (a1 - 1.f) * kaw[1]);
                    const float bon = half_sum(r0 * kp0 * rkw[0] + r1 * kp1 * rkw[1], hf);
                    const float lp0 = -(base0 + (it ? pl0[it ? it - 1 : 0] : 0.f)), lp1 = -(base1 + (it ? pl1[it ? it - 1 : 0] : 0.f)), lc0 = -(base0 + pl0[it]), lc1 = -(base1 + pl1[it]);
                    const float ea0 = __expf(lp0), ea1 = __expf(lp1), eb0 = __expf(lc0), eb1 = __expf(lc1), ei0 = __expf(-lc0), ei1 = __expf(-lc1);
                    const float bt0 = kk0 * a0 * ei0, bt1 = kk1 * a1 * ei1, kt0 = kp0 * ei0, kt1 = kp1 * ei1;
                    *(LAS unsigned*)(ra + off_r(t, pj >> 3) + 2 * (pj & 7)) = pkc(-kk0 * ea0, -kk1 * ea1); *(LAS unsigned*)(ra + off_r(16 + t, pj >> 3) + 2 * (pj & 7)) = pkc(r0 * eb0, r1 * eb1);
                    *(LAS unsigned*)(lbp + off_r(t, pj >> 3) + 2 * (pj & 7)) = pkc(bt0, bt1); *(LAS unsigned*)(lbp + off_r(16 + t, pj >> 3) + 2 * (pj & 7)) = pkc(kt0, kt1);
                    ms0[it] = bt0; ms0[4 + it] = kt0; ms1[it] = bt1; ms1[4 + it] = kt1; vt0[it] = bflo(pv[it]); vt1[it] = bfhi(pv[it]);
                    *(LAS f32x2*)(L + OVF + (tb * 64 + 2 * cp) * 4) = (f32x2){bflo(pv[it]), bfhi(pv[it])}; *(LAS f32x2*)(L + OGG + (tb * 64 + 2 * cp) * 4) = (f32x2){bflo(pg[it]), bfhi(pg[it])};
                    if (cp == 0) *(LAS float*)(L + OBON + tb * 4) = bon;
                    if (it == 3 && th && hf) *(LAS f32x2*)(L + OGC + pc * 256 + 2 * cp * 4) = (f32x2){eb0, eb1};
                }
                { u32x4 m0, m1; m0.x = pkc(ms0[0], ms0[1]); m0.y = pkc(ms0[2], ms0[3]); m0.z = pkc(ms0[4], ms0[5]); m0.w = pkc(ms0[6], ms0[7]); m1.x = pkc(ms1[0], ms1[1]); m1.y = pkc(ms1[2], ms1[3]); m1.z = pkc(ms1[4], ms1[5]); m1.w = pkc(ms1[6], ms1[7]);
                  *(LAS u32x4*)(L + OMS + pc * 4096 + off_m(2 * cp, 2 * th + (unsigned)hf)) = m0; *(LAS u32x4*)(L + OMS + pc * 4096 + off_m(2 * cp + 1, 2 * th + (unsigned)hf)) = m1;
                  u32x2 w0, w1; w0.x = pkc(vt0[0], vt0[1]); w0.y = pkc(vt0[2], vt0[3]); w1.x = pkc(vt1[0], vt1[1]); w1.y = pkc(vt1[2], vt1[3]);
                  *(LAS u32x2*)(L + OVT + pc * 2048 + (2 * cp) * 32 + (8 * th + 4 * (unsigned)hf) * 2) = w0; *(LAS u32x2*)(L + OVT + pc * 2048 + (2 * cp + 1) * 32 + (8 * th + 4 * (unsigned)hf) * 2) = w1; }
            }
            if (t0 + 64 < SEQ) RW_LOAD(t0 + 64);
            LDS_BAR();
            SP_MARK(1);
            if (w < 4) {
                {
                    const int c = w;
                    f32x4 g00 = (f32x4){0.f, 0.f, 0.f, 0.f}, g01 = g00, g10 = g00, g11 = g00;
#pragma unroll
                    for (int ks = 0; ks < 2; ++ks) {
                        const bf16x8 a0 = *(const LAS bf16x8*)(L + OLB + c * 4096 + off_r(l15, 4 * ks + q)), a1 = *(const LAS bf16x8*)(L + OLB + c * 4096 + off_r(16 + l15, 4 * ks + q));
                        const bf16x8 b0 = *(const LAS bf16x8*)(L + ORA + c * 4096 + off_r(l15, 4 * ks + q)), b1 = *(const LAS bf16x8*)(L + ORA + c * 4096 + off_r(16 + l15, 4 * ks + q));
                        g00 = MFMA16(a0, b0, g00); g01 = MFMA16(a0, b1, g01); g10 = MFMA16(a1, b0, g10); g11 = MFMA16(a1, b1, g11);
                    }
                    f32x4 ab, ak; float br[4], kr[4];
#pragma unroll
                    for (int g = 0; g < 4; ++g) { const bool lt = (4 * q + g) < l15, le = (4 * q + g) <= l15; ab[g] = lt ? g00[g] : 0.f; ak[g] = lt ? g10[g] : 0.f; br[g] = le ? g01[g] : 0.f; kr[g] = le ? g11[g] : 0.f; }
                    *(LAS f32x4*)(L + OAB + c * 1024 + (l15 * 16 + 4 * q) * 4) = ab; *(LAS f32x4*)(L + OAK + c * 1024 + (l15 * 16 + 4 * q) * 4) = ak;
                    u32x4 yw; yw.x = pkc(br[0], br[1]); yw.y = pkc(br[2], br[3]); yw.z = pkc(kr[0], kr[1]); yw.w = pkc(kr[2], kr[3]);
                    *(LAS u32x4*)(L + OMY + c * 1024 + off_m(l15, q)) = yw;
                    if (lane < 32) {
                        float row[16];
#pragma unroll
                        for (int t = 0; t < 16; ++t) {
                            const LAS f32x4* abr = (const LAS f32x4*)(L + OAB + c * 1024 + t * 64);
                            const f32x4 x0 = abr[0], x1 = abr[1], x2 = abr[2], x3 = abr[3];
                            const float abv[16] = {x0[0], x0[1], x0[2], x0[3], x1[0], x1[1], x1[2], x1[3], x2[0], x2[1], x2[2], x2[3], x3[0], x3[1], x3[2], x3[3]};
                            float acc1 = (lane < 16) ? ((lane == t) ? 1.f : 0.f) : *(const LAS float*)(L + OAK + c * 1024 + (t * 16 + (lane & 15)) * 4);
#pragma unroll
                            for (int s_ = 0; s_ < t; ++s_) acc1 += row[s_] * abv[s_];
                            row[t] = acc1;
                        }
                        const unsigned pp = (lane < 16) ? (8u * (lane >> 2) + (lane & 3)) : (8u * ((lane & 15) >> 2) + 4u + (lane & 3));
#pragma unroll
                        for (int t = 0; t < 16; ++t) *(LAS bf16_t*)(L + OMU + c * 1024 + off_m(t, pp >> 3) + 2 * (pp & 7)) = (bf16_t)(pkc(row[t], 0.f) & 0xffffu);
                    }
                }
            }
            LDS_BAR();
            SP_MARK(2);
            if (w < 4) {
#pragma unroll 1
                for (int c = 0; c < 4; ++c) {
                    bf16x8 Sb0, Sb1;
                    { u32x4 t0_; t0_.x = pkc(St[0][0], St[0][1]); t0_.y = pkc(St[0][2], St[0][3]); t0_.z = pkc(St[1][0], St[1][1]); t0_.w = pkc(St[1][2], St[1][3]); Sb0 = __builtin_bit_cast(bf16x8, t0_);
                      u32x4 t1_; t1_.x = pkc(St[2][0], St[2][1]); t1_.y = pkc(St[2][2], St[2][3]); t1_.z = pkc(St[3][0], St[3][1]); t1_.w = pkc(St[3][2], St[3][3]); Sb1 = __builtin_bit_cast(bf16x8, t1_); }
                    f32x4 Za = (f32x4){0.f, 0.f, 0.f, 0.f}, Zr = Za;
                    Za = MFMA16(*(const LAS bf16x8*)(L + ORA + c * 4096 + off_r(l15, q)), Sb0, Za); Za = MFMA16(*(const LAS bf16x8*)(L + ORA + c * 4096 + off_r(l15, 4 + q)), Sb1, Za);
                    Zr = MFMA16(*(const LAS bf16x8*)(L + ORA + c * 4096 + off_r(16 + l15, q)), Sb0, Zr); Zr = MFMA16(*(const LAS bf16x8*)(L + ORA + c * 4096 + off_r(16 + l15, 4 + q)), Sb1, Zr);
                    const u32x2 vt = *(const LAS u32x2*)(L + OVT + c * 2048 + (16 * w + l15) * 32 + 8 * q);
                    u32x4 bu; bu.x = pkc(Za[0], Za[1]); bu.y = pkc(Za[2], Za[3]); bu.z = vt.x; bu.w = vt.y;
                    f32x4 U = (f32x4){0.f, 0.f, 0.f, 0.f};
                    U = MFMA16(*(const LAS bf16x8*)(L + OMU + c * 1024 + off_m(l15, q)), __builtin_bit_cast(bf16x8, bu), U);
                    u32x4 by; by.x = pkc(U[0], U[1]); by.y = pkc(U[2], U[3]); by.z = vt.x; by.w = vt.y;
                    const bf16x8 By = __builtin_bit_cast(bf16x8, by);
                    const f32x4 Yt = MFMA16(*(const LAS bf16x8*)(L + OMY + c * 1024 + off_m(l15, q)), By, Zr);
#pragma unroll
                    for (int mt = 0; mt < 4; ++mt) { St[mt] = MFMA16(*(const LAS bf16x8*)(L + OMS + c * 4096 + off_m(16 * mt + l15, q)), By, St[mt]);
                        const f32x4 gc = *(const LAS f32x4*)(L + OGC + c * 256 + (16 * mt + 4 * q) * 4); St[mt] = St[mt] * gc; }
#pragma unroll
                    for (int g = 0; g < 4; ++g) *(LAS float*)(L + OYS + ((16 * c + 4 * q + g) * 64 + 16 * w + l15) * 4) = Yt[g];
                }
            }
            LDS_BAR();
            SP_MARK(3);
            bf16_t* ob_ = rbuf + ((size_t)b * SEQ + t0 + w) * DM + hd * 64;
#pragma unroll
            for (int iq = 0; iq < 4; ++iq) { const int tq = 2 * iq + (int)hf, t = w + 8 * tq; const int li = t * 64 + 2 * (int)cp;
                const f32x2 y = *(const LAS f32x2*)(L + OYS + li * 4); const float mean = half_sum(y[0] + y[1], hf) * (1.f / 64.f); const float d0 = y[0] - mean, d1 = y[1] - mean;
                const float rs = rsqrtf(half_sum(d0 * d0 + d1 * d1, hf) * (1.f / 64.f) + 64e-5f);
                const f32x2 vv = *(const LAS f32x2*)(L + OVF + li * 4), gg = *(const LAS f32x2*)(L + OGG + li * 4); const float bo = *(const LAS float*)(L + OBON + t * 4);
                const float o0 = (d0 * rs * lw[0] + lb[0] + bo * vv[0]) * gg[0], o1 = (d1 * rs * lw[1] + lb[1] + bo * vv[1]) * gg[1];
                *(unsigned*)(ob_ + (unsigned)(8 * tq * DM + 2 * (int)cp)) = pkc(o0, o1); }
        }
#undef RW_LOAD
    }
}

__global__ void __launch_bounds__(NTHREADS, 2) mega_fwd(Params p) {
    extern __shared__ __attribute__((aligned(16))) unsigned char lds_raw[];
    Frame F;
    F.lds = (LAS unsigned char*)lds_raw;
    F.tid = threadIdx.x; F.lane = F.tid & 63; F.wave = __builtin_amdgcn_readfirstlane(F.tid >> 6); F.G = gridDim.x; F.bid = blockIdx.x;
    F.out = p.out; F.ws = p.ws;
    volatile LAS unsigned* misc = (volatile LAS unsigned*)(F.lds + LDS_MISC);
    if (F.tid < 32) misc[F.tid] = 0u;
    __syncthreads();
    const int lo = p.ph_lo, hi = p.ph_hi;
    XcdBarrier bar; bar.bar = (unsigned*)(F.ws + WS_CTL); bar.x = 0; bar.st = misc;
    if (hi - lo > 1) bar = xcd_barrier_post((unsigned*)(F.ws + WS_CTL), misc);
#define IN(k) (lo <= (k) && (k) < hi)
#if PROBE_MASK
    unsigned long long pr_t0 = 0ull, pr_acc = 0ull;
#define PSTART(k) do { if ((PROBE_MASK >> (k)) & 1u) pr_t0 = wall_clock64(); } while (0)
#define PEND(k) do { if ((PROBE_MASK >> (k)) & 1u) pr_acc += wall_clock64() - pr_t0; } while (0)
#else
#define PSTART(k) do {} while (0)
#define PEND(k) do {} while (0)
#endif
#if PROBE_SUB == 11
#define SEAM(k) do { if (IN(k) && IN((k) + 1)) { unsigned long long b0_ = 0ull; if (F.tid == 0) b0_ = wall_clock64(); xcd_barrier(bar); if (F.tid == 0) *(LAS unsigned long long*)(F.lds + LDS_MISC + 64) += wall_clock64() - b0_; } PEND(k); PSTART((k) + 1); } while (0)
#else
#define SEAM(k) do { if (IN(k) && IN((k) + 1)) xcd_barrier(bar); PEND(k); PSTART((k) + 1); } while (0)
#endif
    bf16_t* wb = WSP(bf16_t, WS_WB);
    bf16_t* S0 = WSP(bf16_t, WS_SLAB); bf16_t* S2 = WSP(bf16_t, WS_SLAB + 2 * SLAB); bf16_t* S3 = WSP(bf16_t, WS_SLAB + 3 * SLAB); bf16_t* S4 = WSP(bf16_t, WS_SLAB + 4 * SLAB); bf16_t* S5 = WSP(bf16_t, WS_SLAB + 5 * SLAB);
    bf16_t* EH = WSP(bf16_t, WS_E);
    bf16_t* O0 = (bf16_t*)F.out; bf16_t* O1 = O0 + (size_t)T_TOK * DM;
    bf16_t* hres = (bf16_t*)F.out;
    bf16_t* S1 = WSP(bf16_t, WS_SLAB + 1 * SLAB);
    const int vcu = (F.G % 8 == 0) ? F.bid : F.bid;

    PSTART(0);
    if (IN(0)) { phase_prep(p, F, 0, PT_WIN, true); phase_rmsnorm<true>(p, F, p.in[0], p.in[1], O0); } SEAM(0);
    if (IN(2)) { DenseP<EK_INPROJ> P{}; P.pid = 2; P.v0 = (const float*)(F.ws + WS_ROPE); P.K = 1024; P.lda = 1024; P.ldb = 1024; P.nM = 256; P.nN = NPROJ / 256; P.nprob = 1; P.G = F.G; P.c = vcu; P.A = O0; P.a_stride = 0; P.B = wb + WB_WIN / 2; P.b_stride = 0;
        P.O = S0; P.o_stride = 0; P.ldc = NPROJ; gemm_phase(F.lds, P); } SEAM(2);
    if (IN(3)) { phase_conv(p, F); } SEAM(3);
    if (IN(4)) { phase_scan0(p, F); } SEAM(4);
    if (IN(5)) { phase_prep(p, F, PT_WIN, PT_WOUT, false); phase_gatenorm(p, F); } SEAM(5);
    if (IN(6)) { DenseP<EK_F32RES> P{}; P.pid = 6; P.K = 2048; P.lda = NPROJ; P.ldb = 2048; P.nM = 256; P.nN = 4; P.nprob = 1; P.G = F.G; P.c = vcu; P.A = S0; P.B = wb + WB_WOUT / 2; P.resf = p.in[0]; P.resb = nullptr; P.Ob = hres; P.ldc = 1024; gemm_phase(F.lds, P); } SEAM(6);
#define MOE_LAYER(L, k0) \
    if (IN(k0)) { phase_prep(p, F, PT_L2 + (L) * 4096, PT_L2 + (L) * 4096 + 4096, false); phase_prep(p, F, PT_W13 + (L) * 2048, PT_W13 + (L) * 2048 + 2048, false); phase_moe_route(p, F, L, hres, S2); } SEAM(k0); \
    if (IN(k0 + 1)) { phase_moe_slots(p, F, L); } SEAM(k0 + 1); \
    if (IN(k0 + 2)) { unsigned char* meta = F.ws + WS_META + (size_t)(L) * META_STRIDE; Moe1P<(L) == 1> P{}; P.pid = (k0) + 2; P.K = ((L) == 1) ? 512 : 1024; P.lda = P.K; P.ldb = P.K; P.G = F.G; P.c = vcu; \
        P.ntiles = __builtin_amdgcn_readfirstlane(ld_vec_i32((const int*)(meta + MT_TILE))); P.A = S2; P.W13 = wb + WB_W13 / 2 + (size_t)(L) * 16 * 1048576; P.H = S3; \
        P.slot_tok = (const int*)(meta + MT_STOK); P.slot_c = (const float*)(meta + MT_SC); P.tile_bkt = (const int*)(meta + MT_TILE) + 64; gemm_phase(F.lds, P); } SEAM(k0 + 2); \
    if (IN(k0 + 3)) { unsigned char* meta = F.ws + WS_META + (size_t)(L) * META_STRIDE; Moe2P<(L) == 1> P{}; P.pid = (k0) + 3; P.K = ((L) == 1) ? 512 : 1024; P.lda = P.K; P.ldb = P.K / 2; P.G = F.G; P.c = vcu; \
        P.ntiles = __builtin_amdgcn_readfirstlane(ld_vec_i32((const int*)(meta + MT_TILE))); P.H = S3; P.W2 = wb + WB_W2 / 2 + (size_t)(L) * 16 * 524288; P.hsrc = hres; P.hdst = ((L) == 1) ? S0 : hres; \
        P.slot_tok = (const int*)(meta + MT_STOK); P.tile_bkt = (const int*)(meta + MT_TILE) + 64; gemm_phase(F.lds, P); } SEAM(k0 + 3);
    MOE_LAYER(0, 7)
    if (IN(11)) { phase_prep(p, F, PT_WOUT, PT_L2, false); phase_mix5(p, F, hres, S0, S2, S3, S4); } SEAM(11);
    if (IN(12)) { DenseP<EK_LORA1> P{}; P.pid = 12; P.K = 2048; P.lda = 1024; P.ldb = 2048; P.nM = 256; P.nN = 2; P.nprob = 1; P.G = F.G; P.c = vcu; P.A = S0; P.a_skew = 1; P.a_split = 16; P.a_jump = -(long)(1024 * 2) - 16 * (BK * 2);
        P.B = wb + WB_L1 / 2; P.O = EH; P.ldc = 512; gemm_phase(F.lds, P); } SEAM(12);
    if (IN(14)) { DenseP<EK_BF16> P{}; P.pid = 14; P.K = 1024; P.lda = 1024; P.ldb = 1024; P.nM = 256; P.nN = 4; P.nprob = 3; P.G = F.G; P.c = vcu; P.ldc = 1024; P.A = S2; P.a_stride = (size_t)T_TOK * DM; P.B = wb + WB_WR / 2; P.b_stride = 1048576;
        P.O = S5; P.Oalt1 = S0; P.Oalt2 = S1; gemm_phase(F.lds, P); } SEAM(14);
    if (IN(15)) { DenseP<EK_LORA2> P{}; P.pid = 15; P.K = 256; P.lda = 512; P.ldb = 256; P.nM = 256; P.nN = 4; P.nprob = 3; P.G = F.G; P.c = vcu; P.A = EH; P.Aalt1 = EH; P.Aalt2 = EH + 128; P.B = wb + WB_L2 / 2; P.b_stride = 262144;
        P.O = S2; P.o_stride = (size_t)T_TOK * DM; P.ldc = 1024; P.v0 = p.in[17]; P.v1 = p.in[20]; gemm_phase(F.lds, P); } SEAM(15);
    if (IN(16)) { phase_rwkv(p, F, S5, S0, S1, S2, S3, S4); } SEAM(16);
    if (IN(17)) { DenseP<EK_F32RES> P{}; P.pid = 17; P.K = 1024; P.lda = 1024; P.ldb = 1024; P.nM = 256; P.nN = 4; P.nprob = 1; P.G = F.G; P.c = vcu; P.A = S5; P.B = wb + WB_WO / 2; P.resf = nullptr; P.resb = hres; P.Ob = hres; P.ldc = 1024; gemm_phase(F.lds, P); } SEAM(17);
    MOE_LAYER(1, 18)
    if (IN(22)) { phase_rmsnorm<false, true>(p, F, S0, p.in[3], F.out); }
#if PROBE_SUB
    if (F.bid == 0 && F.tid == 0) { const unsigned long long d_ = *(LAS unsigned long long*)(F.lds + LDS_MISC + 64); const unsigned long long t = wall_clock64(); while (wall_clock64() - t < d_) __builtin_amdgcn_s_sleep(8); }
#endif
#if PROBE_MASK
    PEND(22);
    if (F.bid == 0 && F.tid == 0) { const unsigned long long t = wall_clock64(); while (wall_clock64() - t < pr_acc) __builtin_amdgcn_s_sleep(8); }
#endif
}

extern "C" void kernel_launch(void* const* d_in, const int* in_sizes, int n_in, void* d_out, int out_size, void* d_ws, size_t ws_size, hipStream_t stream) {
    static int grid = 0;
    if (grid == 0) {
        if (n_in != 37 || out_size != T_TOK * DM || ws_size < WS_END) { fprintf(stderr, "kernel_launch: unexpected shapes (n_in %d out %d ws %zu)\n", n_in, out_size, ws_size); grid = -1; return; }
        int dev = 0, cus = 0, per_cu = 0;
        if (hipGetDevice(&dev) != hipSuccess || hipDeviceGetAttribute(&cus, hipDeviceAttributeMultiprocessorCount, dev) != hipSuccess) { grid = -1; return; }
        if (hipFuncSetAttribute((const void*)mega_fwd, hipFuncAttributeMaxDynamicSharedMemorySize, LDS_BYTES) != hipSuccess) { fprintf(stderr, "kernel_launch: hipFuncSetAttribute failed\n"); grid = -1; return; }
        if (hipOccupancyMaxActiveBlocksPerMultiprocessor(&per_cu, (const void*)mega_fwd, NTHREADS, LDS_BYTES) != hipSuccess || per_cu < 1) fprintf(stderr, "kernel_launch: occupancy query says %d\n", per_cu);
        (void)hipGetLastError();
        grid = cus;
        if (grid < 128 || grid > 512) { fprintf(stderr, "kernel_launch: built for 128..512 CUs (the MoE router keeps <= 512 tokens per workgroup in LDS); got %d\n", grid); grid = -1; return; }
    }
    if (grid < 0) return;
    (void)in_sizes;
    hipMemsetAsync((char*)d_ws + WS_CTL, 0, CTL_ZERO_BYTES, stream);
    Params p{};
    for (int i = 0; i < 37; ++i) p.in[i] = (const float*)d_in[i];
    p.out = (float*)d_out; p.ws = (unsigned char*)d_ws;
#if MK_PER_PHASE
    for (int k = 0; k < NPHASE; ++k) { p.ph_lo = k; p.ph_hi = k + 1; hipLaunchKernelGGL(mega_fwd, dim3(grid), dim3(NTHREADS), LDS_BYTES, stream, p); }
#else
    p.ph_lo = 0; p.ph_hi = NPHASE; hipLaunchKernelGGL(mega_fwd, dim3(grid), dim3(NTHREADS), LDS_BYTES, stream, p);
#endif
}
```

```cpp
#include <hip/hip_runtime.h>
#include <stdint.h>
#include <stdio.h>

#ifndef MK_PER_PHASE
#define MK_PER_PHASE 0
#endif

#ifndef PROBE_MASK
#define PROBE_MASK 0u
#endif
#ifndef PROBE_PID
#define PROBE_PID -1
#endif
#ifndef PROBE_SUB
#define PROBE_SUB 0
#endif
#define LAS __attribute__((address_space(3)))
typedef unsigned short bf16_t;
typedef short bf16x8 __attribute__((ext_vector_type(8)));
typedef float f32x4 __attribute__((ext_vector_type(4)));
typedef float f32x2 __attribute__((ext_vector_type(2)));
typedef unsigned u32x4 __attribute__((ext_vector_type(4)));
typedef unsigned u32x2 __attribute__((ext_vector_type(2)));

constexpr int T_TOK = 65536, DM = 1024, SEQ = 4096;
constexpr int NPROJ = 5888;
constexpr int PC_Z = 0, PC_XBC = 1024, PC_Q = 2560, PC_K = 3072, PC_V = 3584, PC_G = 4608, PC_DT = 5632;
constexpr int NTHREADS = 512;
constexpr int LDS_BYTES = 147456;
constexpr int LDS_MISC = LDS_BYTES - 256;
constexpr int NSLOT = T_TOK + 24 * 256;
constexpr int NPHASE = 23;
constexpr int PT_WIN = 1472, PT_WOUT = PT_WIN + 512, PT_RW = PT_WOUT + 1024, PT_L1 = PT_RW + 256, PT_L2 = PT_L1 + 192, PT_W13 = PT_L2 + 8192, PT_W2 = PT_W13 + 4096;
#if PROBE_SUB
#define SP_DECL unsigned long long sp_t_ = wall_clock64()
#define SP_MARK(id_end) do { if (F.tid == 0) { const unsigned long long n_ = wall_clock64(); if ((id_end) == PROBE_SUB) *(LAS unsigned long long*)(F.lds + LDS_MISC + 64) += n_ - sp_t_; sp_t_ = n_; } } while (0)
#else
#define SP_DECL do {} while (0)
#define SP_MARK(id_end) do {} while (0)
#endif

constexpr size_t MiB = 1024 * 1024;
constexpr size_t WS_CTL = 0;
constexpr size_t CTL_ZERO_BYTES = 16384;
constexpr size_t CTL_CNT_OFF = 14336;
constexpr size_t WS_META = 64 * 1024;
constexpr size_t META_STRIDE = 2 * MiB - 32 * 1024;
constexpr size_t MT_RANK = 0, MT_BKT = 262144, MT_C = 524288, MT_STOK = 1048576, MT_SC = 1048576 + 294912, MT_TILE = 1048576 + 294912 + 589824;
constexpr size_t WS_ROPE = 4 * MiB;
constexpr size_t WS_WB = 6 * MiB;
constexpr size_t WB_WIN = 0, WB_WOUT = WB_WIN + (size_t)NPROJ * 1024 * 2, WB_WR = WB_WOUT + (size_t)1024 * 2048 * 2, WB_WK = WB_WR + 2 * MiB, WB_WV = WB_WK + 2 * MiB, WB_WO = WB_WV + 2 * MiB,
                 WB_L1 = WB_WO + 2 * MiB  , WB_L2 = WB_L1 + 2 * MiB  , WB_W13 = WB_L2 + 3 * 512 * 1024  ,
                 WB_W2 = WB_W13 + (size_t)32 * 2 * MiB  , WB_END = WB_W2 + (size_t)32 * MiB;
constexpr size_t WS_SLAB = 130 * MiB;
constexpr size_t SLAB = 128 * MiB;
constexpr size_t WS_E = WS_SLAB + 6 * SLAB;
constexpr size_t WS_END = WS_E + 96 * MiB;
constexpr size_t WS_RTW = WS_WB + WB_END;
static_assert(WS_RTW + 2 * 20 * 1024 * 4 <= WS_SLAB, "weights overflow");
static_assert(WS_END <= 1024 * MiB, "workspace overflow");

struct Params {
    const float* in[37];
    float* out;
    unsigned char* ws;
    int ph_lo, ph_hi;
};

__device__ __forceinline__ float bf2f(bf16_t v) { return __uint_as_float(((unsigned)v) << 16); }
__device__ __forceinline__ float bflo(unsigned w) { return __uint_as_float(w << 16); }
__device__ __forceinline__ float bfhi(unsigned w) { return __uint_as_float(w & 0xffff0000u); }
__device__ __forceinline__ unsigned cvt_pk_bf16(float lo, float hi) { unsigned r; asm volatile("v_cvt_pk_bf16_f32 %0, %1, %2" : "=v"(r) : "v"(lo), "v"(hi)); return r; }
__device__ __forceinline__ bf16_t f2bf(float f) { return (bf16_t)(cvt_pk_bf16(f, 0.f) & 0xffffu); }
__device__ __forceinline__ float wave_sum(float v) {
#pragma unroll
    for (int o = 32; o >= 1; o >>= 1) v += __shfl_xor(v, o);
    return v;
}
__device__ __forceinline__ float dpp_sum16(float x) {
    x += __builtin_bit_cast(float, __builtin_amdgcn_update_dpp(0, __builtin_bit_cast(int, x), 0xB1, 0xF, 0xF, true));
    x += __builtin_bit_cast(float, __builtin_amdgcn_update_dpp(0, __builtin_bit_cast(int, x), 0x4E, 0xF, 0xF, true));
    x += __builtin_bit_cast(float, __builtin_amdgcn_update_dpp(0, __builtin_bit_cast(int, x), 0x141, 0xF, 0xF, true));
    x += __builtin_bit_cast(float, __builtin_amdgcn_update_dpp(0, __builtin_bit_cast(int, x), 0x140, 0xF, 0xF, true));
    return x;
}
__device__ __forceinline__ float wave_sum_u(float x) {
    x = dpp_sum16(x);
    x += __builtin_bit_cast(float, __builtin_amdgcn_update_dpp(0, __builtin_bit_cast(int, x), 0x142, 0xA, 0xF, false));
    x += __builtin_bit_cast(float, __builtin_amdgcn_update_dpp(0, __builtin_bit_cast(int, x), 0x143, 0xC, 0xF, false));
    return __builtin_bit_cast(float, __builtin_amdgcn_readlane(__builtin_bit_cast(int, x), 63));
}
__device__ __forceinline__ float fsilu(float x) { return x * __builtin_amdgcn_rcpf(1.f + __expf(-x)); }
__device__ __forceinline__ float fsigmoid(float x) { return __builtin_amdgcn_rcpf(1.f + __expf(-x)); }
__device__ __forceinline__ float fsoftplus(float x) { return x > 20.f ? x : log1pf(__expf(x)); }
__device__ __forceinline__ float ftanh(float x) { const float xc = fminf(fmaxf(x, -15.f), 15.f); const float e = __expf(2.f * xc); return (e - 1.f) * __builtin_amdgcn_rcpf(e + 1.f); }
__device__ __forceinline__ int ld_vec_i32(const int* p) { int r; asm volatile("global_load_dword %0, %1, off\n\ts_waitcnt vmcnt(0)" : "=&v"(r) : "v"(p) : "memory"); return r; }

#define XB_TMO      128
#define XB_XCNT(j)  (256  + 64 * (j))
#define XB_XSUB(j)  (1280 + 64 * (j))
#define XB_XGEN(j)  (2304 + 64 * (j))
#define XB_TOP      3328
#define XB_TOPGEN   3392
#define XCD_BAR_WORDS 3456
#define XB_SPIN_CAP (1u << 24)
__device__ __forceinline__ unsigned xb_ld(unsigned* p)              { return __hip_atomic_load(p, __ATOMIC_RELAXED, __HIP_MEMORY_SCOPE_AGENT); }
__device__ __forceinline__ unsigned xb_add(unsigned* p, unsigned v) { return __hip_atomic_fetch_add(p, v, __ATOMIC_RELAXED, __HIP_MEMORY_SCOPE_AGENT); }
__device__ __forceinline__ unsigned xb_xcc_id() { return (unsigned)__builtin_amdgcn_s_getreg((3 << 11) | 20) & 0xFu; }
#define XB_SPIN(cond, bar) do { unsigned _sp = 0; while (cond) { __builtin_amdgcn_s_sleep(1); \
    if ((++_sp & 255u) == 0u) { if (xb_ld(&(bar)[XB_TMO])) break; if (_sp > XB_SPIN_CAP) { atomicAdd(&(bar)[XB_TMO], 1u); break; } } } } while (0)
struct XcdBarrier { unsigned* bar; unsigned x; volatile LAS unsigned* st; };
__device__ __forceinline__ XcdBarrier xcd_barrier_post(unsigned* bar, volatile LAS unsigned* st) {
    XcdBarrier b; b.bar = bar; b.x = xb_xcc_id(); b.st = st;
    if (threadIdx.x == 0) (void)xb_add(&bar[XB_XCNT(b.x)], 1u);
    return b;
}
__device__ __forceinline__ void xcd_barrier_complete(unsigned* bar, unsigned x, unsigned& nloc, unsigned& nx) {
    const unsigned G = gridDim.x * gridDim.y * gridDim.z;
    unsigned sum, cnt, mine, sp = 0u;
    for (;;) {
        sum = 0u; cnt = 0u; mine = 0u;
#pragma unroll
        for (unsigned j = 0; j < 16; ++j) { const unsigned c = xb_ld(&bar[XB_XCNT(j)]); sum += c; cnt += (c > 0u) ? 1u : 0u; mine = (j == x) ? c : mine; }
        if (sum == G) break;
        __builtin_amdgcn_s_sleep(1);
        if ((++sp & 255u) == 0u) { if (xb_ld(&bar[XB_TMO])) break; if (sp > XB_SPIN_CAP) { atomicAdd(&bar[XB_TMO], 1u); break; } }
    }
    nloc = mine > 0u ? mine : 1u; nx = cnt > 0u ? cnt : 1u;
}
__device__ __forceinline__ void xcd_barrier(const XcdBarrier& b) {
    asm volatile("s_waitcnt vmcnt(0)" ::: "memory");
    __syncthreads();
    if (threadIdx.x == 0) {
        unsigned* bar = b.bar;
        __builtin_amdgcn_s_waitcnt(0);
        unsigned nloc = b.st[0], nx = b.st[1];
        if (nloc == 0u) { xcd_barrier_complete(bar, b.x, nloc, nx); b.st[0] = nloc; b.st[1] = nx; }
        const unsigned old = xb_add(&bar[XB_XSUB(b.x)], 1u);
        const unsigned gen = old / nloc;
        if (old + 1u == (gen + 1u) * nloc) {
            __builtin_amdgcn_fence(__ATOMIC_RELEASE, "agent");
            asm volatile("s_waitcnt vmcnt(0)" ::: "memory");
            const unsigned og = xb_add(&bar[XB_TOP], 1u);
            const unsigned tg = og / nx;
            if (og + 1u == (tg + 1u) * nx) xb_add(&bar[XB_TOPGEN], 1u);
            else XB_SPIN(xb_ld(&bar[XB_TOPGEN]) == tg, bar);
            __builtin_amdgcn_fence(__ATOMIC_ACQUIRE, "agent");
            xb_add(&bar[XB_XGEN(b.x)], 1u);
            asm volatile("s_waitcnt vmcnt(0)" ::: "memory");
        } else {
            XB_SPIN(xb_ld(&bar[XB_XGEN(b.x)]) == gen, bar);
            __builtin_amdgcn_fence(__ATOMIC_ACQUIRE, "agent");
            asm volatile("s_waitcnt vmcnt(0)" ::: "memory");
        }
    }
    __syncthreads();
}

typedef int i32x4v __attribute__((ext_vector_type(4)));
typedef int i32x8v __attribute__((ext_vector_type(8)));
__device__ __forceinline__ unsigned pk_fp8x4(float a, float b, float c, float d) {
    a = __builtin_amdgcn_fmed3f(a, -448.f, 448.f); b = __builtin_amdgcn_fmed3f(b, -448.f, 448.f); c = __builtin_amdgcn_fmed3f(c, -448.f, 448.f); d = __builtin_amdgcn_fmed3f(d, -448.f, 448.f);
    int w = __builtin_amdgcn_cvt_pk_fp8_f32(a, b, 0, false); w = __builtin_amdgcn_cvt_pk_fp8_f32(c, d, w, true); return (unsigned)w; }
constexpr float F8_ACT_SCALE = 8.f, F8_W_SCALE = 256.f, F8_DESCALE = 1.f / (8.f * 256.f);
constexpr int BM = 256, BK = 64, HALF = 128, HTB = HALF * BK * 2, STAGE_BYTES = 8 * HTB;
__device__ __forceinline__ int lds_byte(int r, int c) { const int st = (r >> 4) * 2 + (c >> 5), rr = r & 15, cc = c & 31, ob = rr * 64 + cc * 2; return st * 1024 + (ob ^ (((ob >> 9) & 1) << 5)); }
__device__ __forceinline__ void stage_rc(int b, int& R, int& C) { const int st = b / 1024, sb = b % 1024, swz = sb ^ (((sb >> 9) & 1) << 5); R = (st >> 1) * 16 + swz / 64; C = (st & 1) * 32 + (swz % 64) / 2; }
__device__ __forceinline__ int perm32(int rho) { const int n = rho >> 4, i = rho & 15; return 8 * (i >> 2) + 4 * n + (i & 3); }
struct Unit { int pm, pn, prob; };
__device__ __forceinline__ void tile_order(int L, int nM, int nN, int& pm, int& pn) {
    const int nwg = nM * nN; int wgid = L;
    { const int q = nwg / 8, r = nwg % 8, xcd = wgid % 8, off = wgid / 8; wgid = (xcd < r ? xcd * (q + 1) : r * (q + 1) + (xcd - r) * q) + off; }
    const int nig = 8 * nN, gid = wgid / nig, fm = gid * 8, gsz = (nM - fm) < 8 ? (nM - fm) : 8;
    pm = fm + ((wgid % nig) % gsz); pn = (wgid % nig) / gsz;
}

template <class P>
__device__ __forceinline__ void gemm_phase(LAS unsigned char* lds, const P& S) {
    const int tid = threadIdx.x, wid = __builtin_amdgcn_readfirstlane(tid >> 6), lane = tid & 63, wr = wid >> 2, wc = wid & 3, fr = lane & 15, fq = lane >> 4;
    const int K = S.K, nt = K / BK, lda = S.lda, ldb = S.ldb;
    int RA[2], CA[2]; unsigned voffB[2], vAc[2][2], vAn[2][2];
#pragma unroll
    for (int i = 0; i < 2; ++i) { int R, C; stage_rc(tid * 16 + i * 8192, R, C); RA[i] = R; CA[i] = C; const int Rb = P::PERM ? ((R & ~31) + perm32(R & 31)) : R;
        voffB[i] = (unsigned)(Rb * ldb + C) * 2u;
#pragma unroll
        for (int h = 0; h < 2; ++h) { vAc[h][i] = (unsigned)((h * HALF + R) * lda + C) * 2u; vAn[h][i] = vAc[h][i]; } }
    const size_t kstep = (size_t)(BK * 2);
    const size_t hstepB = (size_t)HALF * ldb * 2;
    const unsigned ldsw = (unsigned)wid * 1024u;
    const int aoff = lds_byte(wr * 64 + fr, fq * 8), boff = lds_byte(wc * 32 + fr, fq * 8);
#define PG8_SA(b, h) (((b) * 2 + (h)) * HTB)
#define PG8_SB(b, h) ((4 + (b) * 2 + (h)) * HTB)
#define PG8_STAGE2(bufoff, gbase, v0, v1) do { \
        __builtin_amdgcn_global_load_lds((const unsigned*)((const char*)(gbase) + (v0)), (LAS unsigned*)(lds + (bufoff) + ldsw), 16, 0, 0); \
        __builtin_amdgcn_global_load_lds((const unsigned*)((const char*)(gbase) + (v1)), (LAS unsigned*)(lds + (bufoff) + ldsw + 8192), 16, 0, 0); } while (0)
#define PG8_CAT8(x0_, x1_) __builtin_shufflevector(__builtin_bit_cast(i32x4v, x0_), __builtin_bit_cast(i32x4v, x1_), 0, 1, 2, 3, 4, 5, 6, 7)
#define PG8_LDA(dst, b, h) do { if constexpr (P::FP8) { _Pragma("unroll") for (int m = 0; m < 4; ++m) dst##8[m] = PG8_CAT8(*(const LAS bf16x8*)(lds + PG8_SA(b, h) + aoff + m * 2048), *(const LAS bf16x8*)(lds + PG8_SA(b, h) + aoff + m * 2048 + 1024)); } \
        else { _Pragma("unroll") for (int m = 0; m < 4; ++m) _Pragma("unroll") for (int k = 0; k < 2; ++k) dst[m][k] = *(const LAS bf16x8*)(lds + PG8_SA(b, h) + aoff + m * 2048 + k * 1024); } } while (0)
#define PG8_LDB(dst, b, h) do { if constexpr (P::FP8) { _Pragma("unroll") for (int n = 0; n < 2; ++n) dst##8[n] = PG8_CAT8(*(const LAS bf16x8*)(lds + PG8_SB(b, h) + boff + n * 2048), *(const LAS bf16x8*)(lds + PG8_SB(b, h) + boff + n * 2048 + 1024)); } \
        else { _Pragma("unroll") for (int n = 0; n < 2; ++n) _Pragma("unroll") for (int k = 0; k < 2; ++k) dst[n][k] = *(const LAS bf16x8*)(lds + PG8_SB(b, h) + boff + n * 2048 + k * 1024); } } while (0)
#define PG8_MMA(ai, bj, At, Bt) do { __builtin_amdgcn_s_setprio(1); \
        if constexpr (P::FP8) { _Pragma("unroll") for (int m = 0; m < 4; ++m) _Pragma("unroll") for (int n = 0; n < 2; ++n) \
            asm volatile("v_mfma_f32_16x16x128_f8f6f4 %0, %1, %2, %0" : "+v"(acc[ai][bj][m][n]) : "v"(Bt##8[n]), "v"(At##8[m])); }        \
        else { _Pragma("unroll") for (int m = 0; m < 4; ++m) _Pragma("unroll") for (int n = 0; n < 2; ++n) _Pragma("unroll") for (int k = 0; k < 2; ++k) \
            acc[ai][bj][m][n] = __builtin_amdgcn_mfma_f32_16x16x32_bf16(Bt[n][k], At[m][k], acc[ai][bj][m][n], 0, 0, 0); } \
        __builtin_amdgcn_s_setprio(0); } while (0)
#define PG8_WAIT_V(n) asm volatile("s_waitcnt vmcnt(" #n ")" ::: "memory")
#define PG8_WAIT_L(n) asm volatile("s_waitcnt lgkmcnt(" #n ")" ::: "memory")
#define PG8_BAR __builtin_amdgcn_s_barrier()
#define LDS_BAR() asm volatile("s_waitcnt lgkmcnt(0)\n\ts_barrier" ::: "memory")
#define PG8_SCHED __builtin_amdgcn_sched_barrier(0)
    Unit cur, nxt; int ui = 0;
    if (!S.next(0, cur)) return;
    struct { int tid; LAS unsigned char* lds; } F; F.tid = tid; F.lds = lds; (void)F;
    SP_DECL;
    if constexpr (P::GATHER) {
#pragma unroll
        for (int h = 0; h < 2; ++h)
#pragma unroll
            for (int i = 0; i < 2; ++i) vAc[h][i] = S.a_voff(cur, h * HALF + RA[i], CA[i]);
    }
    float zf; asm volatile("v_mov_b32 %0, 0" : "=v"(zf));
    f32x4 acc[2][2][4][2];
#pragma unroll
    for (int a = 0; a < 2; ++a)
#pragma unroll
        for (int b = 0; b < 2; ++b)
#pragma unroll
            for (int m = 0; m < 4; ++m)
#pragma unroll
                for (int n = 0; n < 2; ++n) acc[a][b][m][n] = (f32x4){zf, zf, zf, zf};
    bf16x8 At[4][2], B0[2][2], B1[2][2]; i32x8v At8[4], B08[2], B18[2]; (void)At; (void)B0; (void)B1; (void)At8; (void)B08; (void)B18;
    const char* cA = S.a_ptr(cur);
    {
        const char* b0 = S.b_ptr(cur, 0); const char* b1 = S.b_ptr(cur, 1);
        const char* cA0 = cA + S.a_kadj(0);
        PG8_STAGE2(PG8_SB(0, 0), b0, voffB[0], voffB[1]); PG8_STAGE2(PG8_SA(0, 0), cA0, vAc[0][0], vAc[0][1]); PG8_STAGE2(PG8_SB(0, 1), b0 + hstepB, voffB[0], voffB[1]); PG8_STAGE2(PG8_SA(0, 1), cA0, vAc[1][0], vAc[1][1]);
        if (wr == 1) PG8_BAR;
        PG8_WAIT_V(4); PG8_BAR;
        PG8_STAGE2(PG8_SB(1, 0), b1, voffB[0], voffB[1]); PG8_STAGE2(PG8_SA(1, 0), cA + kstep + S.a_kadj(1), vAc[0][0], vAc[0][1]); PG8_STAGE2(PG8_SB(1, 1), b1 + hstepB, voffB[0], voffB[1]);
        PG8_WAIT_V(6); PG8_BAR;
    }
    for (;;) {
        const bool has_next = S.next(ui + 1, nxt);
        if (!has_next) nxt = cur;
        if constexpr (P::GATHER) {
            if (has_next) {
#pragma unroll
                for (int h = 0; h < 2; ++h)
#pragma unroll
                    for (int i = 0; i < 2; ++i) vAn[h][i] = S.a_voff(nxt, h * HALF + RA[i], CA[i]);
            }
        }
        const char* nA = S.a_ptr(nxt);
        for (int t = 0; t < nt; t += 2) {
            const bool last = (t == nt - 2);
            const char* a1 = cA + (size_t)(t + 1) * kstep + S.a_kadj(t + 1);
            const char* a2 = last ? nA + S.a_kadj(0) : cA + (size_t)(t + 2) * kstep + S.a_kadj(t + 2);
            const char* a3 = last ? nA + kstep + S.a_kadj(1) : cA + (size_t)(t + 3) * kstep + S.a_kadj(t + 3);
            const char* b2 = last ? S.b_ptr(nxt, 0) : S.b_ptr(cur, t + 2);
            const char* b3 = last ? S.b_ptr(nxt, 1) : S.b_ptr(cur, t + 3);
            unsigned s00 = vAc[0][0], s01 = vAc[0][1], s10 = vAc[1][0], s11 = vAc[1][1];
            if constexpr (P::GATHER) { if (last) { s00 = vAn[0][0]; s01 = vAn[0][1]; s10 = vAn[1][0]; s11 = vAn[1][1]; } }
            PG8_LDB(B0, 0, 0); PG8_SCHED; PG8_LDA(At, 0, 0); PG8_STAGE2(PG8_SA(1, 1), a1, vAc[1][0], vAc[1][1]);
            PG8_WAIT_L(8); PG8_BAR; PG8_WAIT_L(0); PG8_MMA(0, 0, At, B0); PG8_BAR; PG8_SCHED;
            PG8_LDB(B1, 0, 1); PG8_STAGE2(PG8_SB(0, 0), b2, voffB[0], voffB[1]);
            PG8_BAR; PG8_WAIT_L(0); PG8_MMA(0, 1, At, B1); PG8_BAR;
            PG8_LDA(At, 0, 1); PG8_STAGE2(PG8_SA(0, 0), a2, s00, s01);
            PG8_BAR; PG8_WAIT_L(0); PG8_MMA(1, 0, At, B0); PG8_BAR; PG8_SCHED;
            PG8_STAGE2(PG8_SB(0, 1), b2 + hstepB, voffB[0], voffB[1]);
            PG8_WAIT_V(6); PG8_BAR; PG8_MMA(1, 1, At, B1); PG8_BAR;
            PG8_LDB(B0, 1, 0); PG8_SCHED; PG8_LDA(At, 1, 0); PG8_STAGE2(PG8_SA(0, 1), a2, s10, s11);
            PG8_WAIT_L(8); PG8_BAR; PG8_WAIT_L(0); PG8_MMA(0, 0, At, B0); PG8_BAR; PG8_SCHED;
            PG8_LDB(B1, 1, 1); PG8_STAGE2(PG8_SB(1, 0), b3, voffB[0], voffB[1]);
            PG8_BAR; PG8_WAIT_L(0); PG8_MMA(0, 1, At, B1); PG8_BAR;
            PG8_LDA(At, 1, 1); PG8_STAGE2(PG8_SA(1, 0), a3, s00, s01);
            PG8_BAR; PG8_WAIT_L(0); PG8_MMA(1, 0, At, B0); PG8_BAR; PG8_SCHED;
            PG8_STAGE2(PG8_SB(1, 1), b3 + hstepB, voffB[0], voffB[1]);
            PG8_WAIT_V(6); PG8_BAR; PG8_MMA(1, 1, At, B1); PG8_BAR;
        }
        SP_MARK((PROBE_PID < 0 || S.pid == PROBE_PID) ? 10 : -1);
        if constexpr (P::FP8) asm volatile("s_nop 15\n\ts_nop 15\n\ts_nop 15" ::: "memory");
        S.epi(acc, cur, wr, wc, fr, fq);
        SP_MARK((PROBE_PID < 0 || S.pid == PROBE_PID) ? 9 : -1);
        if (!has_next) break;
#pragma unroll
        for (int a = 0; a < 2; ++a)
#pragma unroll
            for (int b = 0; b < 2; ++b)
#pragma unroll
                for (int m = 0; m < 4; ++m)
#pragma unroll
                    for (int n = 0; n < 2; ++n) acc[a][b][m][n] = (f32x4){zf, zf, zf, zf};
        cur = nxt; cA = nA; ++ui;
        if constexpr (P::GATHER) {
#pragma unroll
            for (int h = 0; h < 2; ++h)
#pragma unroll
                for (int i = 0; i < 2; ++i) vAc[h][i] = vAn[h][i];
        }
    }
    PG8_WAIT_V(0);
    if (wr == 0) PG8_BAR;
    PG8_BAR;
#undef PG8_SA
#undef PG8_SB
#undef PG8_STAGE2
#undef PG8_LDA
#undef PG8_LDB
#undef PG8_MMA
#undef PG8_WAIT_V
#undef PG8_WAIT_L
#undef PG8_BAR
#undef PG8_SCHED
}

enum { EK_BF16 = 0, EK_LORA1 = 1, EK_LORA2 = 2, EK_F32RES = 3, EK_INPROJ = 4 };
template <int KIND>
struct DenseP {
    static constexpr bool PERM = true, GATHER = false;
    int K, lda, ldb, nM, nN, nprob, G, c, pid;
    static constexpr bool FP8 = false;
    const bf16_t* A; size_t a_stride;
    const bf16_t* Aalt1; const bf16_t* Aalt2;
    int a_skew;
    int a_split; long a_jump;
    const bf16_t* B; size_t b_stride;
    bf16_t* O; size_t o_stride; int ldc;
    bf16_t* Oalt1; bf16_t* Oalt2;
    const float* resf; const bf16_t* resb; bf16_t* Ob;
    const float* v0; const float* v1;
    __device__ __forceinline__ bool next(int i, Unit& u) const {
        const long L = (long)i * G + c; const int per = nM * nN; if (L >= (long)per * nprob) return false;
        u.prob = (int)(L / per); tile_order((int)(L % per), nM, nN, u.pm, u.pn); return true;
    }
    __device__ __forceinline__ const char* a_ptr(const Unit& u) const { const bf16_t* a0 = Aalt1 ? ((u.prob == 0) ? A : (u.prob == 1) ? Aalt1 : Aalt2) : A + (size_t)u.prob * a_stride; return (const char*)(a0 + ((size_t)u.pm * BM + (a_skew ? (u.pm >> 4) + 1 : 0)) * lda); }
    __device__ __forceinline__ long a_kadj(int kt) const { return (a_split > 0 && kt >= a_split) ? a_jump : 0; }
    __device__ __forceinline__ const char* b_ptr(const Unit& u, int kt) const { return (const char*)(B + (size_t)u.prob * b_stride + (size_t)u.pn * BM * ldb) + (size_t)kt * (BK * 2); }
    __device__ __forceinline__ unsigned a_voff(const Unit&, int, int) const { return 0u; }
    __device__ __forceinline__ void epi(const f32x4 (&acc)[2][2][4][2], const Unit& u, int wr, int wc, int fr, int fq) const {
        const int row0 = u.pm * BM + wr * 64 + fr;
        if constexpr (KIND == EK_F32RES) {
            const int col0 = u.pn * BM + wc * 32 + 8 * fq;
#pragma unroll
            for (int ai = 0; ai < 2; ++ai)
#pragma unroll
                for (int mp = 0; mp < 2; ++mp) {
                    f32x4 r0[2][2], r1[2][2];
#pragma unroll
                    for (int mm = 0; mm < 2; ++mm) { const size_t ro = (size_t)(row0 + ai * HALF + (mp * 2 + mm) * 16) * ldc + col0;
#pragma unroll
                        for (int bj = 0; bj < 2; ++bj) {
                            if (resf) { r0[mm][bj] = __builtin_nontemporal_load((const f32x4*)(resf + ro + bj * HALF)); r1[mm][bj] = __builtin_nontemporal_load((const f32x4*)(resf + ro + bj * HALF + 4)); }
                            else { const u32x4 rw = *(const u32x4*)(resb + ro + bj * HALF); r0[mm][bj] = (f32x4){bflo(rw.x), bfhi(rw.x), bflo(rw.y), bfhi(rw.y)}; r1[mm][bj] = (f32x4){bflo(rw.z), bfhi(rw.z), bflo(rw.w), bfhi(rw.w)}; } } }
#pragma unroll
                    for (int mm = 0; mm < 2; ++mm) { const size_t ro = (size_t)(row0 + ai * HALF + (mp * 2 + mm) * 16) * ldc + col0;
#pragma unroll
                        for (int bj = 0; bj < 2; ++bj) { const f32x4 x0 = acc[ai][bj][mp * 2 + mm][0] + r0[mm][bj], x1 = acc[ai][bj][mp * 2 + mm][1] + r1[mm][bj];
                            u32x4 w; w.x = cvt_pk_bf16(x0[0], x0[1]); w.y = cvt_pk_bf16(x0[2], x0[3]); w.z = cvt_pk_bf16(x1[0], x1[1]); w.w = cvt_pk_bf16(x1[2], x1[3]);
                            *(u32x4*)(Ob + ro + bj * HALF) = w; } }
                }
        } else {
            const int col0 = u.pn * BM + wc * 32 + 8 * fq;
            bf16_t* base = Oalt1 ? ((u.prob == 0) ? O : (u.prob == 1) ? Oalt1 : Oalt2) : O + (size_t)u.prob * o_stride;
            f32x4 bv[2][2];
#pragma unroll
            for (int bj = 0; bj < 2; ++bj)
#pragma unroll
                for (int n = 0; n < 2; ++n) {
                    if constexpr (KIND == EK_LORA2) { bv[bj][n] = (u.prob == 0) ? *(const f32x4*)(v0 + col0 + bj * HALF + 4 * n) : (u.prob == 1) ? *(const f32x4*)(v1 + col0 + bj * HALF + 4 * n) : (f32x4){0.f, 0.f, 0.f, 0.f}; }
                    else bv[bj][n] = (f32x4){0.f, 0.f, 0.f, 0.f};
                }
#pragma unroll
            for (int ai = 0; ai < 2; ++ai)
#pragma unroll
                for (int m = 0; m < 4; ++m) { bf16_t* rowp = base + (size_t)(row0 + ai * HALF + m * 16) * ldc + col0;
#pragma unroll
                    for (int bj = 0; bj < 2; ++bj) { f32x4 x0 = acc[ai][bj][m][0] + bv[bj][0], x1 = acc[ai][bj][m][1] + bv[bj][1];
                        if constexpr (KIND == EK_LORA1) {
                            const int g0 = u.pn * BM + bj * HALF + wc * 32; const float kx = (g0 < 64) ? 2.f : 1.f;
#pragma unroll
                            for (int j = 0; j < 4; ++j) { const float s0 = fsigmoid(kx * x0[j]), s1 = fsigmoid(kx * x1[j]);
                                x0[j] = (g0 < 64) ? 2.f * s0 - 1.f : (g0 >= 128) ? s0 : x0[j]; x1[j] = (g0 < 64) ? 2.f * s1 - 1.f : (g0 >= 128) ? s1 : x1[j]; } }
                        if constexpr (KIND == EK_LORA2) {
                            const float sc = (u.prob == 0) ? 0.6065306597126334f : 1.f;
#pragma unroll
                            for (int j = 0; j < 4; ++j) { const float s0 = sc * fsigmoid(x0[j]), s1 = sc * fsigmoid(x1[j]); x0[j] = (u.prob == 2) ? x0[j] : s0; x1[j] = (u.prob == 2) ? x1[j] : s1; } }
                        if constexpr (KIND == EK_INPROJ) {
                            if (u.pn >= PC_Q / 256 && u.pn < PC_V / 256) { const int pos = (row0 + ai * HALF + m * 16) & (SEQ - 1); const float sc = (u.pn >= PC_K / 256) ? 0.08838834764831845f : 1.f;
                                const f32x4 cs0 = *(const f32x4*)(v0 + ((size_t)pos * 64 + wc * 16 + 4 * fq) * 2), cs1 = *(const f32x4*)(v0 + ((size_t)pos * 64 + wc * 16 + 4 * fq + 2) * 2);
                                const f32x4 a = x0, b = x1;
                                x0[0] = (a[0] * cs0[0] - a[1] * cs0[1]) * sc; x0[1] = (a[0] * cs0[1] + a[1] * cs0[0]) * sc; x0[2] = (a[2] * cs0[2] - a[3] * cs0[3]) * sc; x0[3] = (a[2] * cs0[3] + a[3] * cs0[2]) * sc;
                                x1[0] = (b[0] * cs1[0] - b[1] * cs1[1]) * sc; x1[1] = (b[0] * cs1[1] + b[1] * cs1[0]) * sc; x1[2] = (b[2] * cs1[2] - b[3] * cs1[3]) * sc; x1[3] = (b[2] * cs1[3] + b[3] * cs1[2]) * sc; } }
                        u32x4 w; w.x = cvt_pk_bf16(x0[0], x0[1]); w.y = cvt_pk_bf16(x0[2], x0[3]); w.z = cvt_pk_bf16(x1[0], x1[1]); w.w = cvt_pk_bf16(x1[2], x1[3]);
                        *(u32x4*)(rowp + bj * HALF) = w; } }
        }
    }
};

__device__ __forceinline__ void pair_lohi(int pr, int& lo, int& hi) { lo = (pr < 3) ? 0 : (pr < 5 ? 1 : 2); hi = (pr < 3) ? pr + 1 : (pr < 5 ? pr - 1 : 3); }

template <bool F8>
struct Moe1P {
    static constexpr bool PERM = true, GATHER = true, FP8 = F8;
    int K, lda, ldb, G, c, ntiles, pid;
    const bf16_t* A; const bf16_t* W13;
    bf16_t* H; const int* slot_tok; const float* slot_c; const int* tile_bkt;
    __device__ __forceinline__ bool next(int i, Unit& u) const {
        const int m = (c >> 3) + (G >> 3) * i; if ((G & 7) != 0 || m >= ntiles) { if ((G & 7) == 0) return false; const long L = (long)i * G + c; if (L >= (long)ntiles * 8) return false; u.pm = (int)(L >> 3); u.pn = (int)(L & 7); u.prob = __builtin_amdgcn_readfirstlane(ld_vec_i32(tile_bkt + u.pm)); return true; }
        u.pm = m; u.pn = c & 7; u.prob = __builtin_amdgcn_readfirstlane(ld_vec_i32(tile_bkt + u.pm)); return true;
    }
    __device__ __forceinline__ const char* a_ptr(const Unit&) const { return (const char*)A; }
    __device__ __forceinline__ long a_kadj(int) const { return 0; }
    __device__ __forceinline__ unsigned a_voff(const Unit& u, int row, int C) const { int tok = slot_tok[u.pm * BM + row]; tok = tok < 0 ? 0 : tok; return (unsigned)(tok * lda + C) * 2u; }
    __device__ __forceinline__ const char* b_ptr(const Unit& u, int kt) const {
        int lo, hi; pair_lohi(u.prob % 6, lo, hi); const int e = (u.prob / 6) * 4 + ((u.pn < 4) ? lo : hi);
        if constexpr (F8) return (const char*)W13 + (size_t)e * 2097152 + (size_t)(u.pn & 3) * BM * 1024 + (size_t)kt * (BK * 2);
        return (const char*)(W13 + ((size_t)e * 1024 + (size_t)(u.pn & 3) * BM) * 1024) + (size_t)kt * (BK * 2);
    }
    __device__ __forceinline__ void epi(const f32x4 (&acc)[2][2][4][2], const Unit& u, int wr, int wc, int fr, int fq) const {
        const int row0 = u.pm * BM + wr * 64 + fr, col0 = ((u.pn < 4) ? 0 : 512) + (u.pn & 3) * 128 + wc * 32 + 8 * fq, ci = (u.pn < 4) ? 0 : 1;
#pragma unroll
        for (int ai = 0; ai < 2; ++ai)
#pragma unroll
            for (int m = 0; m < 4; ++m) { const int row = row0 + ai * HALF + m * 16; const float cw = slot_c[(size_t)row * 2 + ci];
                const f32x4 g0 = acc[ai][0][m][0], g1 = acc[ai][0][m][1], u0 = acc[ai][1][m][0], u1 = acc[ai][1][m][1]; f32x4 x0, x1;
#pragma unroll
                for (int j = 0; j < 4; ++j) {
                    if constexpr (F8) { x0[j] = fsilu(g0[j] * F8_DESCALE) * (u0[j] * F8_DESCALE) * (cw * F8_ACT_SCALE); x1[j] = fsilu(g1[j] * F8_DESCALE) * (u1[j] * F8_DESCALE) * (cw * F8_ACT_SCALE); }
                    else { x0[j] = fsilu(g0[j]) * u0[j] * cw; x1[j] = fsilu(g1[j]) * u1[j] * cw; } }
                if constexpr (F8) { u32x2 w8; w8.x = pk_fp8x4(x0[0], x0[1], x0[2], x0[3]); w8.y = pk_fp8x4(x1[0], x1[1], x1[2], x1[3]); *(u32x2*)((unsigned char*)H + (size_t)row * 1024 + col0) = w8; continue; }
                u32x4 w; w.x = cvt_pk_bf16(x0[0], x0[1]); w.y = cvt_pk_bf16(x0[2], x0[3]); w.z = cvt_pk_bf16(x1[0], x1[1]); w.w = cvt_pk_bf16(x1[2], x1[3]);
                *(u32x4*)(H + (size_t)row * 1024 + col0) = w; }
    }
};
template <bool F8>
struct Moe2P {
    static constexpr bool PERM = true, GATHER = false, FP8 = F8;
    int K, lda, ldb, G, c, ntiles, pid;
    const bf16_t* H; const bf16_t* W2;
    const bf16_t* hsrc; bf16_t* hdst; const int* slot_tok; const int* tile_bkt;
    __device__ __forceinline__ bool next(int i, Unit& u) const {
        const int m = 2 * ((c >> 3) + (G >> 3) * i) + ((c >> 2) & 1); if ((G & 7) != 0 || m >= ntiles) { if ((G & 7) == 0) return false; const long L = (long)i * G + c; if (L >= (long)ntiles * 4) return false; u.pm = (int)(L >> 2); u.pn = (int)(L & 3); u.prob = __builtin_amdgcn_readfirstlane(ld_vec_i32(tile_bkt + u.pm)); return true; }
        u.pm = m; u.pn = c & 3; u.prob = __builtin_amdgcn_readfirstlane(ld_vec_i32(tile_bkt + u.pm)); return true;
    }
    __device__ __forceinline__ const char* a_ptr(const Unit& u) const { return (const char*)H + (size_t)u.pm * BM * 1024 * (F8 ? 1 : 2); }
    __device__ __forceinline__ long a_kadj(int) const { return 0; }
    __device__ __forceinline__ unsigned a_voff(const Unit&, int, int) const { return 0u; }
    __device__ __forceinline__ const char* b_ptr(const Unit& u, int kt) const {
        int lo, hi; pair_lohi(u.prob % 6, lo, hi);
        if constexpr (F8) { const int e8 = (u.prob / 6) * 4 + ((kt < 4) ? lo : hi); return (const char*)W2 + (size_t)e8 * 1048576 + (size_t)u.pn * BM * 512 + (size_t)(kt & 3) * (BK * 2); }
        const int e = (u.prob / 6) * 4 + ((kt < 8) ? lo : hi);
        return (const char*)(W2 + ((size_t)e * 1024 + (size_t)u.pn * BM) * 512) + (size_t)(kt & 7) * (BK * 2);
    }
    __device__ __forceinline__ void epi(const f32x4 (&acc)[2][2][4][2], const Unit& u, int wr, int wc, int fr, int fq) const {
        const int row0 = u.pm * BM + wr * 64 + fr, col0 = u.pn * BM + wc * 32 + 8 * fq;
        int tok[2][4];
#pragma unroll
        for (int ai = 0; ai < 2; ++ai)
#pragma unroll
            for (int m = 0; m < 4; ++m) tok[ai][m] = slot_tok[row0 + ai * HALF + m * 16];
#pragma unroll
        for (int ai = 0; ai < 2; ++ai) {
            u32x4 r[4][2];
#pragma unroll
            for (int m = 0; m < 4; ++m) { const int tk = tok[ai][m]; const bf16_t* rp = hsrc + (size_t)(tk < 0 ? 0 : tk) * 1024 + col0;
#pragma unroll
                for (int bj = 0; bj < 2; ++bj) r[m][bj] = *(const u32x4*)(rp + bj * HALF); }
#pragma unroll
            for (int m = 0; m < 4; ++m) { const int tk = tok[ai][m];
                if (tk >= 0) { bf16_t* wp = hdst + (size_t)tk * 1024 + col0;
#pragma unroll
                    for (int bj = 0; bj < 2; ++bj) { const u32x4 rw = r[m][bj]; const f32x4 a0 = acc[ai][bj][m][0], a1 = acc[ai][bj][m][1]; constexpr float ds = F8 ? F8_DESCALE : 1.f;
                        u32x4 w; w.x = cvt_pk_bf16(fmaf(a0[0], ds, bflo(rw.x)), fmaf(a0[1], ds, bfhi(rw.x))); w.y = cvt_pk_bf16(fmaf(a0[2], ds, bflo(rw.y)), fmaf(a0[3], ds, bfhi(rw.y)));
                        w.z = cvt_pk_bf16(fmaf(a1[0], ds, bflo(rw.z)), fmaf(a1[1], ds, bfhi(rw.z))); w.w = cvt_pk_bf16(fmaf(a1[2], ds, bflo(rw.w)), fmaf(a1[3], ds, bfhi(rw.w)));
                        *(u32x4*)(wp + bj * HALF) = w; } } }
        }
    }
};

struct Frame {
    LAS unsigned char* lds;
    int tid, lane, wave, G, bid;
    float* out; unsigned char* ws;
};
#define WSP(T, off) ((T*)(F.ws + (off)))

__device__ __forceinline__ void prep_tile(const Frame& F, const float* src, int src_ld, int k0, int kvalid, int c0, int nvalid, bf16_t* dst, int dst_ld, bool il = false, int ksrc = -1, const float* kscale = nullptr, bool one_minus = false, float f8scale = 0.f) {
    const int ks0 = ksrc < 0 ? k0 : ksrc;
    LAS float* tl = (LAS float*)F.lds;
    __syncthreads();
#pragma unroll
    for (int p = 0; p < 2; ++p) { const int kk = (F.tid >> 4) + 32 * p, n4 = (F.tid & 15) * 4;
        f32x4 v = (f32x4){0.f, 0.f, 0.f, 0.f};
        if (il) {
            v = __builtin_nontemporal_load((const f32x4*)(src + (size_t)(ks0 + kk) * src_ld + c0 + ((n4 < 32) ? n4 : 32 + n4))); const int d0 = 2 * (n4 & 31) + (n4 >> 5);
            tl[kk * 65 + d0] = v[0]; tl[kk * 65 + d0 + 2] = v[1]; tl[kk * 65 + d0 + 4] = v[2]; tl[kk * 65 + d0 + 6] = v[3];
        } else {
        if (kk < kvalid && n4 < nvalid) v = __builtin_nontemporal_load((const f32x4*)(src + (size_t)(ks0 + kk) * src_ld + c0 + n4));
        if (kscale) { const float f_ = kscale[ks0 + kk]; v = v * (one_minus ? 1.f - f_ : f_); }
        tl[kk * 65 + n4 + 0] = v[0]; tl[kk * 65 + n4 + 1] = v[1]; tl[kk * 65 + n4 + 2] = v[2]; tl[kk * 65 + n4 + 3] = v[3]; } }
    __syncthreads();
    { const int n = F.tid >> 3, kc = (F.tid & 7) * 8; float x[8];
#pragma unroll
        for (int j = 0; j < 8; ++j) x[j] = tl[(kc + j) * 65 + n];
        if (f8scale != 0.f) { u32x2 w8; w8.x = pk_fp8x4(x[0] * f8scale, x[1] * f8scale, x[2] * f8scale, x[3] * f8scale); w8.y = pk_fp8x4(x[4] * f8scale, x[5] * f8scale, x[6] * f8scale, x[7] * f8scale);
            *(u32x2*)((unsigned char*)dst + (size_t)n * dst_ld + k0 + kc) = w8; }
        else { u32x4 w; w.x = cvt_pk_bf16(x[0], x[1]); w.y = cvt_pk_bf16(x[2], x[3]); w.z = cvt_pk_bf16(x[4], x[5]); w.w = cvt_pk_bf16(x[6], x[7]);
        *(u32x4*)(dst + (size_t)n * dst_ld + k0 + kc) = w; } }
}
__device__ __forceinline__ void phase_prep(const Params& p, const Frame& F, int id_lo, int id_hi, bool tables) {
    bf16_t* wb = WSP(bf16_t, WS_WB);
    constexpr int N0 = 1472, N1 = N0 + 512, N2 = N1 + 1024, N3 = N2 + 256, N4 = N3 + 192, N5 = N4 + 8192, N6 = N5 + 4096;
    (void)N6;
    for (int id = id_lo + F.bid; id < id_hi; id += F.G) {
        if (id < N0) { const int nt = id / 16, kt = id % 16, n0 = nt * 64; int c0, nv;
            if (n0 < PC_Q) { c0 = n0; nv = 64; } else if (n0 < PC_DT) { c0 = n0 + 16; nv = 64; } else if (n0 == PC_DT) { c0 = 2560; nv = 16; } else { c0 = 0; nv = 0; }
            const bool il = (n0 >= PC_Q && n0 < PC_V);
            if (il) c0 = 2576 + ((n0 - PC_Q) >> 7) * 128 + (((n0 - PC_Q) >> 6) & 1) * 32;
            prep_tile(F, p.in[4], 5648, kt * 64, 64, c0, nv, wb + WB_WIN / 2 + (size_t)n0 * 1024, 1024, il); }
        else if (id < N1) { const int j = id - N0, nt = j / 32, kt = j % 32; prep_tile(F, p.in[11], 1024, kt * 64, 64, nt * 64, 64, wb + WB_WOUT / 2 + (size_t)nt * 64 * 2048, 2048); }
        else if (id < N2) { const int j = id - N1, w = j / 256, r = j % 256, nt = r / 16, kt = r % 16; prep_tile(F, (w == 0) ? p.in[13] : (w == 1) ? p.in[14] : (w == 2) ? p.in[15] : p.in[16], 1024, kt * 64, 64, nt * 64, 64, wb + WB_WR / 2 + (size_t)w * 1048576 + (size_t)nt * 64 * 1024, 1024); }
        else if (id < N3) { const int j = id - N2, nt = j >> 5, kt = j & 31, half = kt >> 4;
            const float* src = (nt == 0) ? p.in[18] : (nt == 1) ? p.in[21] : p.in[23]; const int ncols = (nt < 2) ? 64 : 160, c0 = (nt < 2) ? 0 : (nt - 2) * 64, midx = (nt == 0) ? 1 : (nt == 1) ? 4 : 5;
            int nv = (nt < 2) ? 64 : ncols - c0; nv = nv < 0 ? 0 : (nv > 64 ? 64 : nv); if (nt > 4) nv = 0;
            prep_tile(F, src, ncols, kt * 64, 64, (nv ? c0 : 0), nv, wb + WB_L1 / 2 + (size_t)nt * 64 * 2048, 2048, false, (kt & 15) * 64, p.in[12] + midx * DM, !half); }
        else if (id < N4) { const int j = id - N3, w = j / 64, r = j % 64, nt = r / 4, kt = r % 4;
            int kv = (w == 0) ? (kt == 0 ? 64 : 0) : (w == 1) ? (kt == 1 ? 64 : 0) : 160 - kt * 64; kv = kv < 0 ? 0 : (kv > 64 ? 64 : kv);
            const float* src = (w == 0) ? p.in[19] : (w == 1) ? p.in[22] : p.in[24];
            prep_tile(F, src, 1024, kt * 64, kv, nt * 64, 64, wb + WB_L2 / 2 + (size_t)w * 262144 + (size_t)nt * 64 * 256, 256, false, (w == 1) ? 0 : kt * 64); }
        else if (id < N5) { const int j = id - N4, le = j / 256, r = j % 256, nt = r / 16, kt = r % 16;
            const int pn = nt >> 2, part = (nt >> 1) & 1, c0 = 128 * pn + 64 * (nt & 1);
            const float* src = (part ? p.in[35] : p.in[34]) + (size_t)le * 524288;
            if (le >= 0) prep_tile(F, src, 512, kt * 64, 64, c0, 64, (bf16_t*)((unsigned char*)wb + WB_W13 + (size_t)le * 2097152 + (size_t)nt * 64 * 1024), 1024, false, -1, nullptr, false, F8_W_SCALE);
            else prep_tile(F, src, 512, kt * 64, 64, c0, 64, wb + WB_W13 / 2 + (size_t)le * 1048576 + (size_t)nt * 64 * 1024, 1024); }
        else { const int j = id - N5, le = j / 128, r = j % 128, nt = r / 8, kt = r % 8;
            if (le >= 0) prep_tile(F, p.in[36] + (size_t)le * 524288, 1024, kt * 64, 64, nt * 64, 64, (bf16_t*)((unsigned char*)wb + WB_W2 + (size_t)le * 1048576 + (size_t)nt * 64 * 512), 512, false, -1, nullptr, false, F8_W_SCALE);
            else prep_tile(F, p.in[36] + (size_t)le * 524288, 1024, kt * 64, 64, nt * 64, 64, wb + WB_W2 / 2 + (size_t)le * 524288 + (size_t)nt * 64 * 512, 512); }
    }
    if (!tables) { __syncthreads(); return; }
    { float* rtw = WSP(float, WS_RTW);
        for (int idx = F.bid * NTHREADS + F.tid; idx < 2 * 20 * 1024; idx += F.G * NTHREADS) { const int l = idx / 20480, r = idx % 20480, j = r >> 10, k = r & 1023;
            rtw[idx] = (j < 4) ? p.in[30][(size_t)l * 4096 + k * 4 + j] : p.in[32][(size_t)l * 16384 + k * 16 + (j - 4)]; } }
    f32x2* rope = WSP(f32x2, WS_ROPE);
    for (int idx = F.bid * NTHREADS + F.tid; idx < SEQ * 64; idx += F.G * NTHREADS) {
        const int pos = idx >> 6, i = idx & 63;
        const float invf = exp2f(-(float)i * (13.287712379549449f / 64.f));
        const float ang = (float)pos * invf;
        const double x = (double)ang;
        const double kq = rint(x * 0.63661977236758134308);
        double r = fma(-kq, 1.57079632679489655800e+00, x); r = fma(-kq, 6.12323399573676603587e-17, r);
        const double r2 = r * r;
        double sp = -7.6471637318198164759e-13; sp = fma(sp, r2, 1.6059043836821614599e-10); sp = fma(sp, r2, -2.5052108385441718775e-08); sp = fma(sp, r2, 2.7557319223985890653e-06);
        sp = fma(sp, r2, -1.9841269841269841270e-04); sp = fma(sp, r2, 8.3333333333333333333e-03); sp = fma(sp, r2, -1.6666666666666666667e-01); const double sn = fma(sp * r2, r, r);
        double cp = 4.7794773323873852974e-14; cp = fma(cp, r2, -1.1470745597729724714e-11); cp = fma(cp, r2, 2.0876756987868098979e-09); cp = fma(cp, r2, -2.7557319223985890653e-07);
        cp = fma(cp, r2, 2.4801587301587301587e-05); cp = fma(cp, r2, -1.3888888888888888889e-03); cp = fma(cp, r2, 4.1666666666666666667e-02); cp = fma(cp, r2, -0.5); const double cs = fma(cp, r2, 1.0);
        const int q = ((int)kq) & 3;
        const double c = (q == 0) ? cs : (q == 1) ? -sn : (q == 2) ? -cs : sn;
        const double s = (q == 0) ? sn : (q == 1) ? cs : (q == 2) ? -sn : -cs;
        rope[idx] = (f32x2){(float)c, (float)s};
    }
}

__device__ __forceinline__ void row_load(const float* row, int lane, f32x4 (&v)[4]) {
#pragma unroll
    for (int j = 0; j < 4; ++j) v[j] = *(const f32x4*)(row + j * 256 + lane * 4);
}
__device__ __forceinline__ void row_load_nt(const float* row, int lane, f32x4 (&v)[4]) {
#pragma unroll
    for (int j = 0; j < 4; ++j) v[j] = __builtin_nontemporal_load((const f32x4*)(row + j * 256 + lane * 4));
}
__device__ __forceinline__ void row_load_bf_nt(const bf16_t* row, int lane, f32x4 (&v)[4]) {
#pragma unroll
    for (int j = 0; j < 4; ++j) { const u32x2 w = __builtin_nontemporal_load((const u32x2*)(row + j * 256 + lane * 4)); v[j] = (f32x4){bflo(w.x), bfhi(w.x), bflo(w.y), bfhi(w.y)}; }
}
__device__ __forceinline__ void row_load_bf(const bf16_t* row, int lane, f32x4 (&v)[4]) {
#pragma unroll
    for (int j = 0; j < 4; ++j) { const u32x2 w = *(const u32x2*)(row + j * 256 + lane * 4); v[j] = (f32x4){bflo(w.x), bfhi(w.x), bflo(w.y), bfhi(w.y)}; }
}
__device__ __forceinline__ float row_rstd(const f32x4 (&v)[4], float eps) {
    float ss = 0.f;
#pragma unroll
    for (int j = 0; j < 4; ++j) ss += v[j][0] * v[j][0] + v[j][1] * v[j][1] + v[j][2] * v[j][2] + v[j][3] * v[j][3];
    ss = wave_sum_u(ss);
    return rsqrtf(ss * (1.f / 1024.f) + eps);
}
__device__ __forceinline__ void row_store_bf16(bf16_t* row, int lane, const f32x4 (&v)[4]) {
#pragma unroll
    for (int j = 0; j < 4; ++j) { u32x2 w; w.x = cvt_pk_bf16(v[j][0], v[j][1]); w.y = cvt_pk_bf16(v[j][2], v[j][3]); *(u32x2*)(row + j * 256 + lane * 4) = w; }
}

template <bool TO_BF16, bool SRC_BF16 = false>
__device__ __forceinline__ void phase_rmsnorm(const Params& p, const Frame& F, const void* src_, const float* w, void* dst) {
    const float* src = (const float*)src_; const bf16_t* srcb = (const bf16_t*)src_; (void)src; (void)srcb;
    f32x4 wv[4]; row_load(w, F.lane, wv);
    int row = F.bid * 8 + F.wave; const int stride = F.G * 8;
    f32x4 v[4], vn[4];
    if (row < T_TOK) { if constexpr (SRC_BF16) row_load_bf_nt(srcb + (size_t)row * DM, F.lane, v); else row_load_nt(src + (size_t)row * DM, F.lane, v); }
    for (; row < T_TOK; row += stride) {
        if (row + stride < T_TOK) { if constexpr (SRC_BF16) row_load_bf_nt(srcb + (size_t)(row + stride) * DM, F.lane, vn); else row_load_nt(src + (size_t)(row + stride) * DM, F.lane, vn); }
        const float rs = row_rstd(v, 1e-6f);
#pragma unroll
        for (int j = 0; j < 4; ++j) v[j] = v[j] * rs * wv[j];
        if constexpr (TO_BF16) row_store_bf16((bf16_t*)dst + (size_t)row * DM, F.lane, v);
        else {
#pragma unroll
            for (int j = 0; j < 4; ++j) *(f32x4*)((float*)dst + (size_t)row * DM + j * 256 + F.lane * 4) = v[j];
        }
#pragma unroll
        for (int j = 0; j < 4; ++j) v[j] = vn[j];
    }
}

__device__ __forceinline__ void phase_conv(const Params& p, const Frame& F) {
    bf16_t* proj = WSP(bf16_t, WS_SLAB);
    bf16_t* xc = (bf16_t*)F.out;
    const float* conv_w = p.in[5]; const float* conv_b = p.in[6];
    for (int item = F.bid * 8 + F.wave; item < (T_TOK / 32) * 3; item += F.G * 8) {
        const int run = item / 3, cb = item - run * 3, c0 = cb * 512 + F.lane * 8, t0 = run * 32;
        float w[4][8], bb[8], xm3[8], xm2[8], xm1[8];
#pragma unroll
        for (int j = 0; j < 4; ++j) { const f32x4 a0 = *(const f32x4*)(conv_w + j * 1536 + c0), a1 = *(const f32x4*)(conv_w + j * 1536 + c0 + 4);
#pragma unroll
            for (int e = 0; e < 4; ++e) { w[j][e] = a0[e]; w[j][4 + e] = a1[e]; } }
        { const f32x4 a0 = *(const f32x4*)(conv_b + c0), a1 = *(const f32x4*)(conv_b + c0 + 4);
#pragma unroll
            for (int e = 0; e < 4; ++e) { bb[e] = a0[e]; bb[4 + e] = a1[e]; } }
        const bool first = (t0 & (SEQ - 1)) == 0;
        { u32x4 r3 = (u32x4){0u, 0u, 0u, 0u}, r2 = r3, r1 = r3;
            if (!first) { r3 = __builtin_nontemporal_load((const u32x4*)(proj + (size_t)(t0 - 3) * NPROJ + PC_XBC + c0)); r2 = __builtin_nontemporal_load((const u32x4*)(proj + (size_t)(t0 - 2) * NPROJ + PC_XBC + c0)); r1 = __builtin_nontemporal_load((const u32x4*)(proj + (size_t)(t0 - 1) * NPROJ + PC_XBC + c0)); }
            xm3[0] = bflo(r3.x); xm3[1] = bfhi(r3.x); xm3[2] = bflo(r3.y); xm3[3] = bfhi(r3.y); xm3[4] = bflo(r3.z); xm3[5] = bfhi(r3.z); xm3[6] = bflo(r3.w); xm3[7] = bfhi(r3.w);
            xm2[0] = bflo(r2.x); xm2[1] = bfhi(r2.x); xm2[2] = bflo(r2.y); xm2[3] = bfhi(r2.y); xm2[4] = bflo(r2.z); xm2[5] = bfhi(r2.z); xm2[6] = bflo(r2.w); xm2[7] = bfhi(r2.w);
            xm1[0] = bflo(r1.x); xm1[1] = bfhi(r1.x); xm1[2] = bflo(r1.y); xm1[3] = bfhi(r1.y); xm1[4] = bflo(r1.z); xm1[5] = bfhi(r1.z); xm1[6] = bflo(r1.w); xm1[7] = bfhi(r1.w); }
#pragma unroll 4
        for (int tt = 0; tt < 32; ++tt) {
            const u32x4 r = __builtin_nontemporal_load((const u32x4*)(proj + (size_t)(t0 + tt) * NPROJ + PC_XBC + c0));
            const float x[8] = {bflo(r.x), bfhi(r.x), bflo(r.y), bfhi(r.y), bflo(r.z), bfhi(r.z), bflo(r.w), bfhi(r.w)};
            float o[8];
#pragma unroll
            for (int e = 0; e < 8; ++e) { o[e] = fsilu(bb[e] + w[0][e] * xm3[e] + w[1][e] * xm2[e] + w[2][e] * xm1[e] + w[3][e] * x[e]); xm3[e] = xm2[e]; xm2[e] = xm1[e]; xm1[e] = x[e]; }
            u32x4 ow; ow.x = cvt_pk_bf16(o[0], o[1]); ow.y = cvt_pk_bf16(o[2], o[3]); ow.z = cvt_pk_bf16(o[4], o[5]); ow.w = cvt_pk_bf16(o[6], o[7]);
            *(u32x4*)(xc + (size_t)(t0 + tt) * 1536 + c0) = ow;
        }
    }
}

typedef float f32x16 __attribute__((ext_vector_type(16)));
typedef short s16x4 __attribute__((ext_vector_type(4)));
#define MFMA32(a, b, c) __builtin_amdgcn_mfma_f32_32x32x16_bf16((a), (b), (c), 0, 0, 0)
__device__ __forceinline__ unsigned off_b(unsigned row, unsigned ch) { return 256u * row + 16u * (ch ^ (((row & 3u) << 2) | ((row >> 2) & 3u))); }
__device__ __forceinline__ unsigned off_v(unsigned row, unsigned ch) { return 128u * row + 16u * (ch ^ (((row >> 1) & 1u) << 2)); }
__device__ __forceinline__ unsigned off_y(unsigned row, unsigned ch) { return 128u * row + 16u * (ch ^ (row & 7u)); }
__device__ __forceinline__ bf16x8 tr_read2(unsigned a0, unsigned a1) {
    s16x4 lo, hi;
    asm volatile("ds_read_b64_tr_b16 %0, %2\n\tds_read_b64_tr_b16 %1, %3\n\ts_waitcnt lgkmcnt(0)" : "=&v"(lo), "=&v"(hi) : "v"(a0), "v"(a1) : "memory");
    return __builtin_shufflevector(lo, hi, 0, 1, 2, 3, 4, 5, 6, 7);
}
__device__ __forceinline__ void tr_read4(unsigned a0, unsigned a1, unsigned a2, unsigned a3, bf16x8& f0, bf16x8& f1) {
    s16x4 r0, r1, r2, r3;
    asm volatile("ds_read_b64_tr_b16 %0, %4\n\tds_read_b64_tr_b16 %1, %5\n\tds_read_b64_tr_b16 %2, %6\n\tds_read_b64_tr_b16 %3, %7\n\ts_waitcnt lgkmcnt(0)"
                 : "=&v"(r0), "=&v"(r1), "=&v"(r2), "=&v"(r3) : "v"(a0), "v"(a1), "v"(a2), "v"(a3) : "memory");
    f0 = __builtin_shufflevector(r0, r1, 0, 1, 2, 3, 4, 5, 6, 7); f1 = __builtin_shufflevector(r2, r3, 0, 1, 2, 3, 4, 5, 6, 7);
}
__device__ __forceinline__ void tr_read8(unsigned a0, unsigned a1, unsigned a2, unsigned a3, unsigned a4, unsigned a5, unsigned a6, unsigned a7, bf16x8& f0, bf16x8& f1, bf16x8& f2, bf16x8& f3) {
    s16x4 r0, r1, r2, r3, r4, r5, r6, r7;
    asm volatile("ds_read_b64_tr_b16 %0, %8\n\tds_read_b64_tr_b16 %1, %9\n\tds_read_b64_tr_b16 %2, %10\n\tds_read_b64_tr_b16 %3, %11\n\tds_read_b64_tr_b16 %4, %12\n\tds_read_b64_tr_b16 %5, %13\n\tds_read_b64_tr_b16 %6, %14\n\tds_read_b64_tr_b16 %7, %15\n\ts_waitcnt lgkmcnt(0)"
                 : "=&v"(r0), "=&v"(r1), "=&v"(r2), "=&v"(r3), "=&v"(r4), "=&v"(r5), "=&v"(r6), "=&v"(r7) : "v"(a0), "v"(a1), "v"(a2), "v"(a3), "v"(a4), "v"(a5), "v"(a6), "v"(a7) : "memory");
    f0 = __builtin_shufflevector(r0, r1, 0, 1, 2, 3, 4, 5, 6, 7); f1 = __builtin_shufflevector(r2, r3, 0, 1, 2, 3, 4, 5, 6, 7);
    f2 = __builtin_shufflevector(r4, r5, 0, 1, 2, 3, 4, 5, 6, 7); f3 = __builtin_shufflevector(r6, r7, 0, 1, 2, 3, 4, 5, 6, 7);
}
__device__ __forceinline__ f32x16 zero16() { f32x16 z;
#pragma unroll
    for (int i = 0; i < 16; ++i) z[i] = 0.f;
    return z; }
__device__ __forceinline__ void phase_scan0(const Params& p, const Frame& F) {
    bf16_t* proj = WSP(bf16_t, WS_SLAB);
    const bf16_t* xc = (const bf16_t*)F.out;
    constexpr unsigned OQ = 0, OK = 32768, OV = 65536, OVW = 81920, OS = 98304, OY = 114688, OSM = 131072;
    LAS unsigned char* L = F.lds;
    const unsigned lbase = (unsigned)(__UINTPTR_TYPE__)L;
    LAS float* sm = (LAS float*)(L + OSM);
    const int lane = F.lane, w = F.wave, it = w >> 1, pt = w & 1;
    const unsigned h0 = lane >> 5, lr0 = lane & 31;
    const int trow = F.tid >> 2, tpart = F.tid & 3;
    const unsigned blk0 = (lane >> 4) & 1u, tq0 = (lane & 15u) >> 2, tp0 = lane & 3u;
    for (int ui = 0; ui < 2; ++ui) {
        const int uu = F.bid + ui * F.G;
        if (uu >= 512) break;
        const bool is_ssd = uu < 256; const int v = uu & 255, x8 = v & 7, slot = v >> 3;
        int b, hh, grp = 0, hr = 0, sl = 0;
        if (is_ssd) { const int pg = x8 + 8 * (slot >> 3), hg = slot & 7; b = pg >> 1; grp = pg & 1; hh = grp * 8 + hg; }
        else { const int pr = x8 + 8 * (slot >> 2); sl = slot & 3; b = pr >> 2; hr = pr & 3; hh = hr * 4 + sl; }
        const size_t row0 = (size_t)b * SEQ;
        const bf16_t* qptr; const bf16_t* kptr; const bf16_t* vptr; size_t qs, vs; bf16_t* optr;
        if (is_ssd) { qptr = xc + 1280 + grp * 128; kptr = xc + 1024 + grp * 128; vptr = xc + hh * 64; qs = 1536; vs = 1536; optr = proj + hh * 64; }
        else { qptr = proj + PC_Q + hr * 128; kptr = proj + PC_K + hr * 128; vptr = proj + PC_V + hr * 256 + sl * 64; qs = NPROJ; vs = NPROJ; optr = proj + 1024 + hr * 256 + sl * 64; }
        const bf16_t* zptr = proj + hh * 64;
        const float A_h = is_ssd ? -__expf(p.in[8][hh]) : 0.f, dtb = is_ssd ? p.in[7][hh] : 0.f, D_h = is_ssd ? p.in[9][hh] : 0.f;
        const float lng = __logf(1.f - exp2f(-5.f - (float)hr));
        u32x4 rv[2], rz[2]; float rdt0 = 0.f, rdt1 = 0.f;
        f32x16 St0 = zero16(), St1 = zero16();
        __syncthreads();
        for (int i = F.tid; i < 16384 / 16; i += NTHREADS) *(LAS u32x4*)(L + OS + i * 16) = (u32x4){0u, 0u, 0u, 0u};
#define SC_LOAD(c) do { const size_t r_ = row0 + (size_t)(c) * 128 + trow; \
            _Pragma("unroll") for (int e = 0; e < 2; ++e) rv[e] = *(const u32x4*)(vptr + r_ * vs + tpart * 16 + e * 8); \
            if (is_ssd && w == 0) { rdt0 = bf2f(proj[(row0 + (size_t)(c) * 128 + 2 * lane) * NPROJ + PC_DT + hh]); rdt1 = bf2f(proj[(row0 + (size_t)(c) * 128 + 2 * lane + 1) * NPROJ + PC_DT + hh]); } } while (0)
#define SC_DMA(c) do { _Pragma("unroll") for (int e = 0; e < 4; ++e) { const int I_ = w * 4 + e; const unsigned r_ = 4u * I_ + ((unsigned)lane >> 4), cs_ = lane & 15u, ch_ = cs_ ^ (((r_ & 3u) << 2) | ((r_ >> 2) & 3u)); \
            const size_t g_ = (row0 + (size_t)(c) * 128 + r_) * qs + ch_ * 8; \
            __builtin_amdgcn_global_load_lds((const unsigned*)(qptr + g_), (LAS unsigned*)(L + OQ + I_ * 1024), 16, 0, 0); \
            __builtin_amdgcn_global_load_lds((const unsigned*)(kptr + g_), (LAS unsigned*)(L + OK + I_ * 1024), 16, 0, 0); } } while (0)
#define SC_LOADZ(c) do { if (is_ssd) { const size_t r_ = row0 + (size_t)(c) * 128 + trow; rz[0] = __builtin_nontemporal_load((const u32x4*)(zptr + r_ * NPROJ + tpart * 16)); rz[1] = __builtin_nontemporal_load((const u32x4*)(zptr + r_ * NPROJ + tpart * 16 + 8)); } } while (0)
#define SC_SMALL(c) do { if (w == 0) { LAS float* sb = sm + ((c) & 1) * 384; float d0, d1, a0, a1; \
            if (is_ssd) { d0 = fsoftplus(rdt0 + dtb); d1 = fsoftplus(rdt1 + dtb); a0 = d0 * A_h; a1 = d1 * A_h; } else { d0 = 1.f; d1 = 1.f; a0 = lng; a1 = lng; } \
            float sc = a0 + a1; _Pragma("unroll") for (int o = 1; o < 64; o <<= 1) { const float tv = __shfl_up(sc, o); if (lane >= o) sc += tv; } \
            const float c1 = sc, c0 = sc - a1; const float tot = __shfl(sc, 63); \
            sb[2 * lane] = c0; sb[2 * lane + 1] = c1; sb[128 + 2 * lane] = d0; sb[128 + 2 * lane + 1] = d1; sb[256 + 2 * lane] = __expf(tot - c0) * d0; sb[256 + 2 * lane + 1] = __expf(tot - c1) * d1; } } while (0)
#define SC_STORE(c) do { const float wj_ = sm[((c) & 1) * 384 + 256 + trow]; \
            _Pragma("unroll") for (int e = 0; e < 2; ++e) { const u32x4 x_ = rv[e]; *(LAS u32x4*)(L + OV + off_v(trow, tpart * 2 + e)) = x_; u32x4 y_; \
                y_.x = cvt_pk_bf16(bflo(x_.x) * wj_, bfhi(x_.x) * wj_); y_.y = cvt_pk_bf16(bflo(x_.y) * wj_, bfhi(x_.y) * wj_); y_.z = cvt_pk_bf16(bflo(x_.z) * wj_, bfhi(x_.z) * wj_); y_.w = cvt_pk_bf16(bflo(x_.w) * wj_, bfhi(x_.w) * wj_); \
                *(LAS u32x4*)(L + OVW + off_v(trow, tpart * 2 + e)) = y_; } } while (0)
        SC_DMA(0); SC_LOAD(0);
        SC_SMALL(0);
        __syncthreads();
        SC_STORE(0);
        asm volatile("s_waitcnt vmcnt(0)" ::: "memory");
        __syncthreads();
        SP_DECL;
        for (int c = 0; c < SEQ / 128; ++c) {
            SP_MARK(8);
            const LAS float* sb = sm + (c & 1) * 384;
            unsigned lr = lr0, h = h0, blk = blk0, tq_ = tq0, tp_ = tp0;
            asm volatile("" : "+v"(lr), "+v"(h), "+v"(blk), "+v"(tq_), "+v"(tp_));
            if (c + 1 < SEQ / 128) { SC_LOAD(c + 1); }
            SC_LOADZ(c);
            const int ph = pt;
            const float ai = sb[32 * it + lr];
            f32x16 Yd0 = zero16(), Yd1 = zero16();
            for (int jt = ph; jt <= it; jt += 2) {
                f32x16 acc = zero16();
#pragma unroll
                for (int ks = 0; ks < 8; ++ks) { const bf16x8 ka = *(const LAS bf16x8*)(L + OK + off_b(32 * jt + lr, 2 * ks + h)), qb = *(const LAS bf16x8*)(L + OQ + off_b(32 * it + lr, 2 * ks + h)); acc = MFMA32(ka, qb, acc); }
                const bool diag = (jt == it);
#pragma unroll
                for (int g = 0; g < 4; ++g) { const f32x4 aj = *(const LAS f32x4*)(sb + 32 * jt + 8 * g + 4 * h), dj = *(const LAS f32x4*)(sb + 128 + 32 * jt + 8 * g + 4 * h);
#pragma unroll
                    for (int e = 0; e < 4; ++e) { const float dec = __expf(ai - aj[e]) * dj[e]; const bool ok = !diag || ((int)lr >= (int)(8 * g + 4 * h + e)); acc[4 * g + e] = ok ? acc[4 * g + e] * dec : 0.f; } }
#pragma unroll
                for (int s2 = 0; s2 < 2; ++s2) {
                    u32x4 pw; pw.x = cvt_pk_bf16(acc[8 * s2 + 0], acc[8 * s2 + 1]); pw.y = cvt_pk_bf16(acc[8 * s2 + 2], acc[8 * s2 + 3]); pw.z = cvt_pk_bf16(acc[8 * s2 + 4], acc[8 * s2 + 5]); pw.w = cvt_pk_bf16(acc[8 * s2 + 6], acc[8 * s2 + 7]);
                    const bf16x8 Pb = __builtin_bit_cast(bf16x8, pw);
                    const unsigned rb0 = 32 * jt + 16 * s2 + 4 * h + tq_, cc0 = 2 * blk + (tp_ >> 1), o8 = 8 * (tp_ & 1);
                    bf16x8 va0, va1;
                    tr_read4(lbase + OV + off_v(rb0, cc0) + o8, lbase + OV + off_v(rb0 + 8, cc0) + o8, lbase + OV + off_v(rb0, 4 + cc0) + o8, lbase + OV + off_v(rb0 + 8, 4 + cc0) + o8, va0, va1);
                    Yd0 = MFMA32(va0, Pb, Yd0); Yd1 = MFMA32(va1, Pb, Yd1);
                }
            }
            {
                f32x16 Yo = zero16();
#pragma unroll
                for (int ks = 0; ks < 8; ++ks) { const bf16x8 sa = *(const LAS bf16x8*)(L + OS + off_b(32 * ph + lr, 2 * ks + h)), qb = *(const LAS bf16x8*)(L + OQ + off_b(32 * it + lr, 2 * ks + h)); Yo = MFMA32(sa, qb, Yo); }
                const float ei = __expf(ai);
                if (ph == 0) {
#pragma unroll
                    for (int r = 0; r < 16; ++r) Yd0[r] += Yo[r] * ei; }
                else {
#pragma unroll
                    for (int r = 0; r < 16; ++r) Yd1[r] += Yo[r] * ei; }
            }
#pragma unroll
            for (int g = 0; g < 4; ++g) { u32x2 yw;
                if (ph == 0) { yw.x = cvt_pk_bf16(Yd1[4 * g], Yd1[4 * g + 1]); yw.y = cvt_pk_bf16(Yd1[4 * g + 2], Yd1[4 * g + 3]); } else { yw.x = cvt_pk_bf16(Yd0[4 * g], Yd0[4 * g + 1]); yw.y = cvt_pk_bf16(Yd0[4 * g + 2], Yd0[4 * g + 3]); }
                *(LAS u32x2*)(L + OY + off_y(32 * it + lr, 4 * (1 - ph) + g) + 8 * h) = yw; }
            const float dl = __expf(sb[127]);
            const int st0 = (w == 0) ? 0 : (w == 1) ? 2 : (w == 2) ? 4 : (w == 3) ? 5 : (w == 5) ? 6 : -1, st1 = (w == 0) ? 1 : (w == 1) ? 3 : (w == 5) ? 7 : -1;
            if (st0 >= 0) {
                const int spt = st0 & 1, snt = st0 >> 1;
#pragma unroll
                for (int r = 0; r < 16; ++r) St0[r] *= dl;
#pragma unroll
                for (int k2 = 0; k2 < 4; ++k2) { const unsigned rb = 32 * k2 + 8 * h + tq_, cv = 4 * spt + 2 * blk + (tp_ >> 1), cb = 4 * snt + 2 * blk + (tp_ >> 1), o8 = 8 * (tp_ & 1);
                    bf16x8 fa0, fb0, fa1, fb1;
                    tr_read8(lbase + OVW + off_v(rb, cv) + o8, lbase + OVW + off_v(rb + 4, cv) + o8, lbase + OK + off_b(rb, cb) + o8, lbase + OK + off_b(rb + 4, cb) + o8,
                             lbase + OVW + off_v(rb + 16, cv) + o8, lbase + OVW + off_v(rb + 20, cv) + o8, lbase + OK + off_b(rb + 16, cb) + o8, lbase + OK + off_b(rb + 20, cb) + o8, fa0, fb0, fa1, fb1);
                    St0 = MFMA32(fa0, fb0, St0); St0 = MFMA32(fa1, fb1, St0); }
                if (st1 >= 0) {
                    const int spt1 = st1 & 1, snt1 = st1 >> 1;
#pragma unroll
                    for (int r = 0; r < 16; ++r) St1[r] *= dl;
#pragma unroll
                    for (int k2 = 0; k2 < 4; ++k2) { const unsigned rb = 32 * k2 + 8 * h + tq_, cv = 4 * spt1 + 2 * blk + (tp_ >> 1), cb = 4 * snt1 + 2 * blk + (tp_ >> 1), o8 = 8 * (tp_ & 1);
                        bf16x8 fa0, fb0, fa1, fb1;
                        tr_read8(lbase + OVW + off_v(rb, cv) + o8, lbase + OVW + off_v(rb + 4, cv) + o8, lbase + OK + off_b(rb, cb) + o8, lbase + OK + off_b(rb + 4, cb) + o8,
                                 lbase + OVW + off_v(rb + 16, cv) + o8, lbase + OVW + off_v(rb + 20, cv) + o8, lbase + OK + off_b(rb + 16, cb) + o8, lbase + OK + off_b(rb + 20, cb) + o8, fa0, fb0, fa1, fb1);
                        St1 = MFMA32(fa0, fb0, St1); St1 = MFMA32(fa1, fb1, St1); }
                }
            }
            if (c + 1 < SEQ / 128) SC_SMALL(c + 1);
            LDS_BAR();
#pragma unroll
            for (int g = 0; g < 4; ++g) { LAS u32x2* yp = (LAS u32x2*)(L + OY + off_y(32 * it + lr, 4 * ph + g) + 8 * h); const u32x2 pv_ = *yp; u32x2 yw;
                if (ph == 0) { yw.x = cvt_pk_bf16(Yd0[4 * g] + bflo(pv_.x), Yd0[4 * g + 1] + bfhi(pv_.x)); yw.y = cvt_pk_bf16(Yd0[4 * g + 2] + bflo(pv_.y), Yd0[4 * g + 3] + bfhi(pv_.y)); }
                else { yw.x = cvt_pk_bf16(Yd1[4 * g] + bflo(pv_.x), Yd1[4 * g + 1] + bfhi(pv_.x)); yw.y = cvt_pk_bf16(Yd1[4 * g + 2] + bflo(pv_.y), Yd1[4 * g + 3] + bfhi(pv_.y)); }
                *yp = yw; }
            LDS_BAR();
            SP_MARK(5);
            if (c + 1 < SEQ / 128) SC_DMA(c + 1);
            if (st0 >= 0) {
                const int spt = st0 & 1, snt = st0 >> 1;
#pragma unroll
                for (int r = 0; r < 16; ++r) { const unsigned pr = 32 * spt + (r & 3) + 8 * (r >> 2) + 4 * h, n = 32 * snt + lr; *(LAS bf16_t*)(L + OS + off_b(pr, n >> 3) + 2 * (n & 7)) = f2bf(St0[r]); }
                if (st1 >= 0) { const int spt1 = st1 & 1, snt1 = st1 >> 1;
#pragma unroll
                    for (int r = 0; r < 16; ++r) { const unsigned pr = 32 * spt1 + (r & 3) + 8 * (r >> 2) + 4 * h, n = 32 * snt1 + lr; *(LAS bf16_t*)(L + OS + off_b(pr, n >> 3) + 2 * (n & 7)) = f2bf(St1[r]); }
                }
            }
            {
                bf16_t* orow = optr + (row0 + (size_t)c * 128 + trow) * NPROJ + tpart * 16;
#pragma unroll
                for (int e = 0; e < 2; ++e) {
                    const u32x4 yv = *(const LAS u32x4*)(L + OY + off_y(trow, tpart * 2 + e));
                    u32x4 ov = yv;
                    if (is_ssd) { const u32x4 xv = *(const LAS u32x4*)(L + OV + off_v(trow, tpart * 2 + e)); const u32x4 zv = rz[e];
                        ov.x = cvt_pk_bf16((bflo(yv.x) + bflo(xv.x) * D_h) * fsilu(bflo(zv.x)), (bfhi(yv.x) + bfhi(xv.x) * D_h) * fsilu(bfhi(zv.x)));
                        ov.y = cvt_pk_bf16((bflo(yv.y) + bflo(xv.y) * D_h) * fsilu(bflo(zv.y)), (bfhi(yv.y) + bfhi(xv.y) * D_h) * fsilu(bfhi(zv.y)));
                        ov.z = cvt_pk_bf16((bflo(yv.z) + bflo(xv.z) * D_h) * fsilu(bflo(zv.z)), (bfhi(yv.z) + bfhi(xv.z) * D_h) * fsilu(bfhi(zv.z)));
                        ov.w = cvt_pk_bf16((bflo(yv.w) + bflo(xv.w) * D_h) * fsilu(bflo(zv.w)), (bfhi(yv.w) + bfhi(xv.w) * D_h) * fsilu(bfhi(zv.w))); }
                    *(u32x4*)(orow + e * 8) = ov;
                }
            }
            LDS_BAR();
            SP_MARK(6);
            if (c + 1 < SEQ / 128) SC_STORE(c + 1);
            asm volatile("s_waitcnt vmcnt(0)" ::: "memory");
            LDS_BAR();
            SP_MARK(7);
        }
#undef SC_LOAD
#undef SC_LOADZ
#undef SC_SMALL
#undef SC_STORE
    }
}

__device__ __forceinline__ void phase_gatenorm(const Params& p, const Frame& F) {
    const bf16_t* proj = WSP(bf16_t, WS_SLAB);
    bf16_t* ybuf = WSP(bf16_t, WS_SLAB);
    const float* nw = p.in[10];
    int row = F.bid * 8 + F.wave; const int stride = F.G * 8;
    u32x4 yc[4], gc[2], yn[4], gn[2];
#define GN_LOAD(r_, Y_, G_) do { const bf16_t* b_ = ybuf + (size_t)(r_) * NPROJ; _Pragma("unroll") for (int j = 0; j < 4; ++j) Y_[j] = *(const u32x4*)(b_ + j * 512 + F.lane * 8); \
        _Pragma("unroll") for (int j = 0; j < 2; ++j) G_[j] = __builtin_nontemporal_load((const u32x4*)(b_ + PC_G + j * 512 + F.lane * 8)); } while (0)
    if (row < T_TOK) GN_LOAD(row, yc, gc);
    for (; row < T_TOK; row += stride) {
        if (row + stride < T_TOK) GN_LOAD(row + stride, yn, gn);
        bf16_t* yr = ybuf + (size_t)row * NPROJ;
#pragma unroll
        for (int j = 0; j < 4; ++j) {
            const u32x4 w = yc[j];
            float x[8] = {bflo(w.x), bfhi(w.x), bflo(w.y), bfhi(w.y), bflo(w.z), bfhi(w.z), bflo(w.w), bfhi(w.w)};
            float ss = 0.f;
#pragma unroll
            for (int e = 0; e < 8; ++e) ss += x[e] * x[e];
            if (j < 2) { ss = wave_sum_u(ss); const float rs = rsqrtf(ss * (1.f / 512.f) + 1e-5f);
                const f32x4 w0 = *(const f32x4*)(nw + j * 512 + F.lane * 8), w1 = *(const f32x4*)(nw + j * 512 + F.lane * 8 + 4);
#pragma unroll
                for (int e = 0; e < 4; ++e) { x[e] *= rs * w0[e]; x[4 + e] *= rs * w1[e]; } }
            else {
                ss = dpp_sum16(ss); ss += __shfl_xor(ss, 16);
                const float rs = rsqrtf(ss * (1.f / 256.f) + 1e-6f);
                const u32x4 gw = gc[j - 2];
                const float g[8] = {bflo(gw.x), bfhi(gw.x), bflo(gw.y), bfhi(gw.y), bflo(gw.z), bfhi(gw.z), bflo(gw.w), bfhi(gw.w)};
#pragma unroll
                for (int e = 0; e < 8; ++e) x[e] *= rs * fsilu(g[e]); }
            u32x4 o; o.x = cvt_pk_bf16(x[0], x[1]); o.y = cvt_pk_bf16(x[2], x[3]); o.z = cvt_pk_bf16(x[4], x[5]); o.w = cvt_pk_bf16(x[6], x[7]);
            *(u32x4*)(yr + j * 512 + F.lane * 8) = o;
        }
#pragma unroll
        for (int j = 0; j < 4; ++j) yc[j] = yn[j];
        gc[0] = gn[0]; gc[1] = gn[1];
    }
#undef GN_LOAD
}

__device__ __forceinline__ void phase_moe_route(const Params& p, const Frame& F, int layer, const bf16_t* h, bf16_t* tbuf) {
    unsigned char* meta = F.ws + WS_META + (size_t)layer * META_STRIDE;
    int* tok_rank = (int*)(meta + MT_RANK); int* tok_bkt = (int*)(meta + MT_BKT); f32x2* tok_c = (f32x2*)(meta + MT_C);
    int* gcount = (int*)(F.ws + WS_CTL + CTL_CNT_OFF) + layer * 32;
    const float* bg = p.in[31] + layer * 4; const float* be = p.in[33] + layer * 16;
    LAS float* wl = (LAS float*)F.lds;
    LAS int* lcount = (LAS int*)(F.lds + 81920);
    LAS int* lbase = lcount + 32;
    LAS int* l_bkt = lbase + 32;
    LAS int* l_rank = l_bkt + 1024;
    LAS float* l_c = (LAS float*)(l_rank + 1024);
    LAS float* lgt = (LAS float*)(F.lds + 98816);
    __syncthreads();
    { const float* wrt = WSP(float, WS_RTW) + (size_t)layer * 20480;
        for (int idx = F.tid; idx < 20 * 1024 / 4; idx += NTHREADS) *(LAS f32x4*)(wl + idx * 4) = *(const f32x4*)(wrt + idx * 4); }
    if (F.tid < 32) lcount[F.tid] = 0;
    __syncthreads();
    const int TPB = (T_TOK + F.G - 1) / F.G, tok0 = F.bid * TPB;
    f32x4 wv[4]; row_load(p.in[2] + (size_t)layer * DM, F.lane, wv);
    f32x4 va[4], vb[4], na[4], nb[4];
    int hsel;
    { unsigned t0_ = 0u, t1_ = 1u; asm volatile("s_nop 1\n\tv_permlane32_swap_b32 %0, %1\n\ts_nop 1" : "+v"(t0_), "+v"(t1_)); hsel = (t0_ + t1_ >= 2u) ? 10 : 0; }
#define RT_LOAD(li_, A_, B_) do { const int ta_ = tok0 + (li_), tb_ = ta_ + 8; \
        if ((li_) < TPB && ta_ < T_TOK) row_load_bf_nt(h + (size_t)ta_ * DM, F.lane, A_); if ((li_) + 8 < TPB && tb_ < T_TOK) row_load_bf_nt(h + (size_t)tb_ * DM, F.lane, B_); } while (0)
    RT_LOAD(F.wave, va, vb);
    for (int li = F.wave; li < TPB; li += 16) {
        const int tok = tok0 + li; if (tok >= T_TOK) break;
        const bool hasb = (li + 8 < TPB) && (tok + 8 < T_TOK);
        RT_LOAD(li + 16, na, nb);
        const float rsa = row_rstd(va, 1e-6f), rsb = row_rstd(vb, 1e-6f);
#pragma unroll
        for (int j = 0; j < 4; ++j) { va[j] = va[j] * rsa * wv[j]; vb[j] = vb[j] * rsb * wv[j]; }
        if (true) {
#pragma unroll
            for (int j = 0; j < 4; ++j) { *(unsigned*)((unsigned char*)tbuf + (size_t)tok * DM + j * 256 + F.lane * 4) = pk_fp8x4(va[j][0] * F8_ACT_SCALE, va[j][1] * F8_ACT_SCALE, va[j][2] * F8_ACT_SCALE, va[j][3] * F8_ACT_SCALE);
                if (hasb) *(unsigned*)((unsigned char*)tbuf + (size_t)(tok + 8) * DM + j * 256 + F.lane * 4) = pk_fp8x4(vb[j][0] * F8_ACT_SCALE, vb[j][1] * F8_ACT_SCALE, vb[j][2] * F8_ACT_SCALE, vb[j][3] * F8_ACT_SCALE); }
        } else {
        row_store_bf16(tbuf + (size_t)tok * DM, F.lane, va);
        if (hasb) row_store_bf16(tbuf + (size_t)(tok + 8) * DM, F.lane, vb); }
        LAS float* lga = lgt + li * 20; LAS float* lgb = lgt + (li + 8) * 20;
#pragma unroll
        for (int o = 0; o < 10; ++o) { f32x2 c0 = (f32x2){0.f, 0.f}, c1 = c0, d0 = c0, d1 = c0;
#pragma unroll
            for (int j = 0; j < 4; ++j) { const f32x4 w4 = *(const LAS f32x4*)(wl + o * 1024 + j * 256 + F.lane * 4), w5 = *(const LAS f32x4*)(wl + (o + 10) * 1024 + j * 256 + F.lane * 4);
                const f32x2 w4l = (f32x2){w4[0], w4[1]}, w4h = (f32x2){w4[2], w4[3]}, w5l = (f32x2){w5[0], w5[1]}, w5h = (f32x2){w5[2], w5[3]};
                const f32x2 al = (f32x2){va[j][0], va[j][1]}, ah = (f32x2){va[j][2], va[j][3]}, bl = (f32x2){vb[j][0], vb[j][1]}, bh = (f32x2){vb[j][2], vb[j][3]};
                c0 += al * w4l; c0 += ah * w4h; c1 += al * w5l; c1 += ah * w5h; d0 += bl * w4l; d0 += bh * w4h; d1 += bl * w5l; d1 += bh * w5h; }
            float a0 = c0[0] + c0[1], a1 = c1[0] + c1[1], b0 = d0[0] + d0[1], b1 = d1[0] + d1[1];
            asm volatile("s_nop 1\n\tv_permlane32_swap_b32 %0, %1\n\tv_permlane32_swap_b32 %2, %3\n\ts_nop 1" : "+v"(a0), "+v"(a1), "+v"(b0), "+v"(b1));
            float sa = dpp_sum16(a0 + a1), sb_ = dpp_sum16(b0 + b1);
            sa += __builtin_bit_cast(float, __builtin_amdgcn_update_dpp(0, __builtin_bit_cast(int, sa), 0x142, 0xA, 0xF, false));
            sb_ += __builtin_bit_cast(float, __builtin_amdgcn_update_dpp(0, __builtin_bit_cast(int, sb_), 0x142, 0xA, 0xF, false));
            if ((F.lane & 31) == 16) { lga[hsel + o] = sa; if (hasb) lgb[hsel + o] = sb_; }
            if (o & 1) __builtin_amdgcn_sched_barrier(0); }
#pragma unroll
        for (int j = 0; j < 4; ++j) { va[j] = na[j]; vb[j] = nb[j]; }
    }
#undef RT_LOAD
    __syncthreads();
    for (int li = F.tid; li < TPB; li += NTHREADS) {
        if (tok0 + li >= T_TOK) break;
        float lg[20];
#pragma unroll
        for (int o = 0; o < 20; ++o) lg[o] = lgt[li * 20 + o];
        float g0 = lg[0] + bg[0], g1 = lg[1] + bg[1], g2 = lg[2] + bg[2], g3 = lg[3] + bg[3];
        int gi = 0; float gm = g0; if (g1 > gm) { gm = g1; gi = 1; } if (g2 > gm) { gm = g2; gi = 2; } if (g3 > gm) { gm = g3; gi = 3; }
        const float gate = 1.f / (__expf(g0 - gm) + __expf(g1 - gm) + __expf(g2 - gm) + __expf(g3 - gm));
        float e0, e1, e2, e3;
        e0 = (gi == 0) ? lg[4] : (gi == 1) ? lg[8] : (gi == 2) ? lg[12] : lg[16];
        e1 = (gi == 0) ? lg[5] : (gi == 1) ? lg[9] : (gi == 2) ? lg[13] : lg[17];
        e2 = (gi == 0) ? lg[6] : (gi == 1) ? lg[10] : (gi == 2) ? lg[14] : lg[18];
        e3 = (gi == 0) ? lg[7] : (gi == 1) ? lg[11] : (gi == 2) ? lg[15] : lg[19];
        e0 += be[gi * 4 + 0]; e1 += be[gi * 4 + 1]; e2 += be[gi * 4 + 2]; e3 += be[gi * 4 + 3];
        int i1 = 0; float v1 = e0; if (e1 > v1) { v1 = e1; i1 = 1; } if (e2 > v1) { v1 = e2; i1 = 2; } if (e3 > v1) { v1 = e3; i1 = 3; }
        int i2 = -1; float v2 = -3.0e38f;
        if (i1 != 0 && e0 > v2) { v2 = e0; i2 = 0; } if (i1 != 1 && e1 > v2) { v2 = e1; i2 = 1; } if (i1 != 2 && e2 > v2) { v2 = e2; i2 = 2; } if (i1 != 3 && e3 > v2) { v2 = e3; i2 = 3; }
        const float w1 = gate / (1.f + __expf(v2 - v1)), w2 = gate - w1;
        const int lo = i1 < i2 ? i1 : i2, hi = i1 < i2 ? i2 : i1; const float clo = i1 < i2 ? w1 : w2, chi = i1 < i2 ? w2 : w1;
        const int pr = (lo == 0) ? hi - 1 : (lo == 1) ? hi + 1 : 5;
        const int bk = gi * 6 + pr;
        l_bkt[li] = bk; l_c[li * 2] = clo; l_c[li * 2 + 1] = chi;
        l_rank[li] = __hip_atomic_fetch_add((int*)(lcount + bk), 1, __ATOMIC_RELAXED, __HIP_MEMORY_SCOPE_WORKGROUP);
    }
    __syncthreads();
    if (F.tid < 24) lbase[F.tid] = __hip_atomic_fetch_add(gcount + F.tid, lcount[F.tid], __ATOMIC_RELAXED, __HIP_MEMORY_SCOPE_AGENT);
    __syncthreads();
    for (int li = F.tid; li < TPB; li += NTHREADS) { const int tok = tok0 + li; if (tok < T_TOK) { const int bk = l_bkt[li]; tok_bkt[tok] = bk; tok_rank[tok] = lbase[bk] + l_rank[li]; tok_c[tok] = (f32x2){l_c[li * 2], l_c[li * 2 + 1]}; } }
}
__device__ __forceinline__ void phase_moe_slots(const Params& p, const Frame& F, int layer) {
    unsigned char* meta = F.ws + WS_META + (size_t)layer * META_STRIDE;
    const int* tok_rank = (const int*)(meta + MT_RANK); const int* tok_bkt = (const int*)(meta + MT_BKT); const f32x2* tok_c = (const f32x2*)(meta + MT_C);
    int* slot_tok = (int*)(meta + MT_STOK); f32x2* slot_c = (f32x2*)(meta + MT_SC); int* tile_tab = (int*)(meta + MT_TILE);
    int* gcount = (int*)(F.ws + WS_CTL + CTL_CNT_OFF) + layer * 32;
    LAS int* cnt = (LAS int*)F.lds; LAS int* start = cnt + 32;
    __syncthreads();
    if (F.tid < 24) cnt[F.tid] = __hip_atomic_load(gcount + F.tid, __ATOMIC_RELAXED, __HIP_MEMORY_SCOPE_AGENT);
    __syncthreads();
    if (F.tid == 0) { int a = 0; for (int b = 0; b < 24; ++b) { start[b] = a; a += (cnt[b] + 255) >> 8; } start[24] = a; }
    __syncthreads();
    for (int tok = F.bid * NTHREADS + F.tid; tok < T_TOK; tok += F.G * NTHREADS) { const int bk = tok_bkt[tok]; const int slot = start[bk] * 256 + tok_rank[tok]; slot_tok[slot] = tok; slot_c[slot] = tok_c[tok]; }
    for (int b = F.bid; b < 24; b += F.G) { const int s0 = start[b] * 256 + cnt[b], s1 = start[b + 1] * 256;
        for (int s = s0 + F.tid; s < s1; s += NTHREADS) { slot_tok[s] = -1; slot_c[s] = (f32x2){0.f, 0.f}; } }
    if (F.bid == 0) { if (F.tid == 0) tile_tab[0] = start[24];
        for (int m = F.tid; m < 288; m += NTHREADS) { int bk = 23; for (int b = 0; b < 24; ++b) if (m >= start[b] && m < start[b + 1]) bk = b; tile_tab[64 + m] = bk; } }
}

__device__ __forceinline__ void phase_mix5(const Params& p, const Frame& F, const bf16_t* h, bf16_t* ou, bf16_t* o0, bf16_t* o1, bf16_t* o2) {
    const float* mu = p.in[12];
    f32x4 wv[4], m0[4], m1[4], m2[4];
    row_load(p.in[1] + DM, F.lane, wv); row_load(mu, F.lane, m0); row_load(mu + 2 * DM, F.lane, m1); row_load(mu + 3 * DM, F.lane, m2);
    for (int run = F.bid * 8 + F.wave; run < T_TOK / 32; run += F.G * 8) {
        const int t0 = run * 32;
        f32x4 up[4];
        if ((t0 & (SEQ - 1)) == 0) {
#pragma unroll
            for (int j = 0; j < 4; ++j) up[j] = (f32x4){0.f, 0.f, 0.f, 0.f};
            row_store_bf16(ou + (size_t)(t0 + (t0 >> 12)) * DM, F.lane, up);
        } else { row_load_bf(h + (size_t)(t0 - 1) * DM, F.lane, up); const float rs = row_rstd(up, 1e-6f);
#pragma unroll
            for (int j = 0; j < 4; ++j) up[j] = up[j] * rs * wv[j]; }
        f32x4 u[4], un[4]; row_load_bf(h + (size_t)t0 * DM, F.lane, u);
        for (int tt = 0; tt < 32; ++tt) {
            if (tt + 1 < 32) row_load_bf(h + (size_t)(t0 + tt + 1) * DM, F.lane, un);
            const float rs = row_rstd(u, 1e-6f);
            f32x4 a[4], b[4], c[4];
#pragma unroll
            for (int j = 0; j < 4; ++j) { u[j] = u[j] * rs * wv[j]; const f32x4 xx = up[j] - u[j]; a[j] = u[j] + xx * m0[j]; b[j] = u[j] + xx * m1[j]; c[j] = u[j] + xx * m2[j]; }
            const size_t ro = (size_t)(t0 + tt) * DM;
            row_store_bf16(ou + ro + (size_t)((t0 >> 12) + 1) * DM, F.lane, u);
            row_store_bf16(o0 + ro, F.lane, a); row_store_bf16(o1 + ro, F.lane, b); row_store_bf16(o2 + ro, F.lane, c);
#pragma unroll
            for (int j = 0; j < 4; ++j) { up[j] = u[j]; u[j] = un[j]; }
        }
    }
}

typedef __bf16 bf16x2v __attribute__((ext_vector_type(2)));
__device__ __forceinline__ unsigned pkc(float lo, float hi) { f32x2 t = {lo, hi}; bf16x2v r = __builtin_convertvector(t, bf16x2v); return __builtin_bit_cast(unsigned, r); }
__device__ __forceinline__ unsigned off_r(unsigned row, unsigned ch) { return row * 128u + 16u * (ch ^ ((row >> 1) & 7u)); }
__device__ __forceinline__ unsigned off_m(unsigned row, unsigned ch) { return row * 64u + 16u * (ch ^ ((0u - (row >> 2)) & 3u)); }
#define MFMA16(a, b, c) __builtin_amdgcn_mfma_f32_16x16x32_bf16((a), (b), (c), 0, 0, 0)
__device__ __forceinline__ void swap32(float& a, float& b) { asm volatile("s_nop 1\n\tv_permlane32_swap_b32 %0, %1\n\ts_nop 1" : "+v"(a), "+v"(b)); }
__device__ __forceinline__ float half_sum(float x, bool hf) {
    x = dpp_sum16(x);
    x += __builtin_bit_cast(float, __builtin_amdgcn_update_dpp(0, __builtin_bit_cast(int, x), 0x142, 0xA, 0xF, false));
    const float lo = __builtin_bit_cast(float, __builtin_amdgcn_readlane(__builtin_bit_cast(int, x), 31)), hi = __builtin_bit_cast(float, __builtin_amdgcn_readlane(__builtin_bit_cast(int, x), 63));
    return hf ? hi : lo;
}
__device__ __forceinline__ void phase_rwkv(const Params& p, const Frame& F, bf16_t* rbuf, const bf16_t* kbuf, const bf16_t* vbuf, const bf16_t* ebuf, const bf16_t* abuf, const bf16_t* gbuf) {
    constexpr unsigned ORA = 0, OLB = 16384, OMS = 32768, OMU = 49152, OMY = 53248, OAB = 57344, OAK = 61440, OVT = 65536, OGC = 73728, OYS = 74752, OVF = 91136, OGG = 107520, OBON = 123904;
    LAS unsigned char* L = F.lds;
    const float* k_k = p.in[25]; const float* k_a = p.in[26]; const float* r_k = p.in[27]; const float* lnw = p.in[28]; const float* lnb = p.in[29];
    const int lane0 = F.lane, w = F.wave, pc = w >> 1, th = w & 1;
    for (int unit = F.bid; unit < 256; unit += F.G) {
        const int b = unit >> 4, hd = unit & 15;
        const int gc2 = hd * 64 + 2 * (lane0 & 31);
        const f32x2 kkw = *(const f32x2*)(k_k + gc2), kaw = *(const f32x2*)(k_a + gc2), rkw = *(const f32x2*)(r_k + gc2), lw = *(const f32x2*)(lnw + gc2), lb = *(const f32x2*)(lnb + gc2);
        int lane = lane0;
        f32x4 St[4];
#pragma unroll
        for (int mt = 0; mt < 4; ++mt) St[mt] = (f32x4){0.f, 0.f, 0.f, 0.f};
        unsigned pr[4], pk[4], pv[4], pe[4], pa[4], pg[4], pe0[4];
#define RW_LOAD(t0_) do { const size_t ub_ = ((size_t)b * SEQ + (t0_) + 16 * pc + 8 * th) * DM + hd * 64, ub0_ = ((size_t)b * SEQ + (t0_) + 16 * pc) * DM + hd * 64;     \
            const bf16_t* r_ = rbuf + ub_; const bf16_t* k_ = kbuf + ub_; const bf16_t* v_ = vbuf + ub_; const bf16_t* e_ = ebuf + ub_; const bf16_t* a_ = abuf + ub_; const bf16_t* g_ = gbuf + ub_; const bf16_t* e0_ = ebuf + ub0_; \
            _Pragma("unroll") for (int it = 0; it < 4; ++it) { const unsigned lo_ = (unsigned)((4 * (lane >> 5) + it) * DM + 2 * (lane & 31)); \
            pr[it] = __builtin_nontemporal_load((const unsigned*)(r_ + lo_)); pk[it] = __builtin_nontemporal_load((const unsigned*)(k_ + lo_)); pv[it] = __builtin_nontemporal_load((const unsigned*)(v_ + lo_)); pe[it] = __builtin_nontemporal_load((const unsigned*)(e_ + lo_)); pa[it] = __builtin_nontemporal_load((const unsigned*)(a_ + lo_)); pg[it] = __builtin_nontemporal_load((const unsigned*)(g_ + lo_)); pe0[it] = *(const unsigned*)(e0_ + lo_); } } while (0)
        RW_LOAD(0);
        SP_DECL;
        for (int t0 = 0; t0 < SEQ; t0 += 64) {
            LDS_BAR();
            SP_MARK(4);
            asm volatile("" : "+v"(lane));
            const unsigned l15 = lane & 15, q = (unsigned)lane >> 4, cp = lane & 31;
            const bool hf = lane >= 32;
            const unsigned pj = 32u * (cp >> 4) + 8u * ((cp & 7) >> 1) + 2u * (cp & 1) + ((cp & 8) ? 4u : 0u);
            {
                float pl0[4], pl1[4], ls0 = 0.f, ls1 = 0.f, f0 = 0.f, f1 = 0.f;
#pragma unroll
                for (int it = 0; it < 4; ++it) { ls0 += bflo(pe[it]); ls1 += bfhi(pe[it]); pl0[it] = ls0; pl1[it] = ls1; f0 += bflo(pe0[it]); f1 += bfhi(pe0[it]); }
                float xa0 = 0.f, xb0 = ls0, xa1 = 0.f, xb1 = ls1; swap32(xa0, xb0); swap32(xa1, xb1);
                float ya0 = f0, yb0 = f0, ya1 = f1, yb1 = f1; swap32(ya0, yb0); swap32(ya1, yb1);
                const float base0 = xa0 + (th ? f0 + (hf ? ya0 : yb0) : 0.f), base1 = xa1 + (th ? f1 + (hf ? ya1 : yb1) : 0.f);
                float ms0[8], ms1[8], vt0[4], vt1[4];
                LAS unsigned char* ra = L + ORA + pc * 4096; LAS unsigned char* lbp = L + OLB + pc * 4096;
#pragma unroll
                for (int it = 0; it < 4; ++it) {
                    const int t = 8 * th + 4 * (int)hf + it, tb = 16 * pc + t;
                    const float r0 = bflo(pr[it]), r1 = bfhi(pr[it]), k0 = bflo(pk[it]), k1 = bfhi(pk[it]), a0 = bflo(pa[it]), a1 = bfhi(pa[it]);
                    const float kv0 = k0 * kkw[0], kv1 = k1 * kkw[1]; const float ss = half_sum(kv0 * kv0 + kv1 * kv1, hf); const float rn = rsqrtf(fmaxf(ss, 1e-24f));
                    const float kk0 = kv0 * rn, kk1 = kv1 * rn;
                    const float kp0 = k0 * (1.f + (a0 - 1.f) * kaw[0]), kp1 = k1 * (1.f + (a1 - 1.f) * kaw[1]);
                    const float bon = half_sum(r0 * kp0 * rkw[0] + r1 * kp1 * rkw[1], hf);
                    const float lp0 = -(base0 + (it ? pl0[it ? it - 1 : 0] : 0.f)), lp1 = -(base1 + (it ? pl1[it ? it - 1 : 0] : 0.f)), lc0 = -(base0 + pl0[it]), lc1 = -(base1 + pl1[it]);
                    const float ea0 = __expf(lp0), ea1 = __expf(lp1), eb0 = __expf(lc0), eb1 = __expf(lc1), ei0 = __expf(-lc0), ei1 = __expf(-lc1);
                    const float bt0 = kk0 * a0 * ei0, bt1 = kk1 * a1 * ei1, kt0 = kp0 * ei0, kt1 = kp1 * ei1;
                    *(LAS unsigned*)(ra + off_r(t, pj >> 3) + 2 * (pj & 7)) = pkc(-kk0 * ea0, -kk1 * ea1); *(LAS unsigned*)(ra + off_r(16 + t, pj >> 3) + 2 * (pj & 7)) = pkc(r0 * eb0, r1 * eb1);
                    *(LAS unsigned*)(lbp + off_r(t, pj >> 3) + 2 * (pj & 7)) = pkc(bt0, bt1); *(LAS unsigned*)(lbp + off_r(16 + t, pj >> 3) + 2 * (pj & 7)) = pkc(kt0, kt1);
                    ms0[it] = bt0; ms0[4 + it] = kt0; ms1[it] = bt1; ms1[4 + it] = kt1; vt0[it] = bflo(pv[it]); vt1[it] = bfhi(pv[it]);
                    *(LAS f32x2*)(L + OVF + (tb * 64 + 2 * cp) * 4) = (f32x2){bflo(pv[it]), bfhi(pv[it])}; *(LAS f32x2*)(L + OGG + (tb * 64 + 2 * cp) * 4) = (f32x2){bflo(pg[it]), bfhi(pg[it])};
                    if (cp == 0) *(LAS float*)(L + OBON + tb * 4) = bon;
                    if (it == 3 && th && hf) *(LAS f32x2*)(L + OGC + pc * 256 + 2 * cp * 4) = (f32x2){eb0, eb1};
                }
                { u32x4 m0, m1; m0.x = pkc(ms0[0], ms0[1]); m0.y = pkc(ms0[2], ms0[3]); m0.z = pkc(ms0[4], ms0[5]); m0.w = pkc(ms0[6], ms0[7]); m1.x = pkc(ms1[0], ms1[1]); m1.y = pkc(ms1[2], ms1[3]); m1.z = pkc(ms1[4], ms1[5]); m1.w = pkc(ms1[6], ms1[7]);
                  *(LAS u32x4*)(L + OMS + pc * 4096 + off_m(2 * cp, 2 * th + (unsigned)hf)) = m0; *(LAS u32x4*)(L + OMS + pc * 4096 + off_m(2 * cp + 1, 2 * th + (unsigned)hf)) = m1;
                  u32x2 w0, w1; w0.x = pkc(vt0[0], vt0[1]); w0.y = pkc(vt0[2], vt0[3]); w1.x = pkc(vt1[0], vt1[1]); w1.y = pkc(vt1[2], vt1[3]);
                  *(LAS u32x2*)(L + OVT + pc * 2048 + (2 * cp) * 32 + (8 * th + 4 * (unsigned)hf) * 2) = w0; *(LAS u32x2*)(L + OVT + pc * 2048 + (2 * cp + 1) * 32 + (8 * th + 4 * (unsigned)hf) * 2) = w1; }
            }
            if (t0 + 64 < SEQ) RW_LOAD(t0 + 64);
            LDS_BAR();
            SP_MARK(1);
            if (w < 4) {
                {
                    const int c = w;
                    f32x4 g00 = (f32x4){0.f, 0.f, 0.f, 0.f}, g01 = g00, g10 = g00, g11 = g00;
#pragma unroll
                    for (int ks = 0; ks < 2; ++ks) {
                        const bf16x8 a0 = *(const LAS bf16x8*)(L + OLB + c * 4096 + off_r(l15, 4 * ks + q)), a1 = *(const LAS bf16x8*)(L + OLB + c * 4096 + off_r(16 + l15, 4 * ks + q));
                        const bf16x8 b0 = *(const LAS bf16x8*)(L + ORA + c * 4096 + off_r(l15, 4 * ks + q)), b1 = *(const LAS bf16x8*)(L + ORA + c * 4096 + off_r(16 + l15, 4 * ks + q));
                        g00 = MFMA16(a0, b0, g00); g01 = MFMA16(a0, b1, g01); g10 = MFMA16(a1, b0, g10); g11 = MFMA16(a1, b1, g11);
                    }
                    f32x4 ab, ak; float br[4], kr[4];
#pragma unroll
                    for (int g = 0; g < 4; ++g) { const bool lt = (4 * q + g) < l15, le = (4 * q + g) <= l15; ab[g] = lt ? g00[g] : 0.f; ak[g] = lt ? g10[g] : 0.f; br[g] = le ? g01[g] : 0.f; kr[g] = le ? g11[g] : 0.f; }
                    *(LAS f32x4*)(L + OAB + c * 1024 + (l15 * 16 + 4 * q) * 4) = ab; *(LAS f32x4*)(L + OAK + c * 1024 + (l15 * 16 + 4 * q) * 4) = ak;
                    u32x4 yw; yw.x = pkc(br[0], br[1]); yw.y = pkc(br[2], br[3]); yw.z = pkc(kr[0], kr[1]); yw.w = pkc(kr[2], kr[3]);
                    *(LAS u32x4*)(L + OMY + c * 1024 + off_m(l15, q)) = yw;
                    if (lane < 32) {
                        float row[16];
#pragma unroll
                        for (int t = 0; t < 16; ++t) {
                            const LAS f32x4* abr = (const LAS f32x4*)(L + OAB + c * 1024 + t * 64);
                            const f32x4 x0 = abr[0], x1 = abr[1], x2 = abr[2], x3 = abr[3];
                            const float abv[16] = {x0[0], x0[1], x0[2], x0[3], x1[0], x1[1], x1[2], x1[3], x2[0], x2[1], x2[2], x2[3], x3[0], x3[1], x3[2], x3[3]};
                            float acc1 = (lane < 16) ? ((lane == t) ? 1.f : 0.f) : *(const LAS float*)(L + OAK + c * 1024 + (t * 16 + (lane & 15)) * 4);
#pragma unroll
                            for (int s_ = 0; s_ < t; ++s_) acc1 += row[s_] * abv[s_];
                            row[t] = acc1;
                        }
                        const unsigned pp = (lane < 16) ? (8u * (lane >> 2) + (lane & 3)) : (8u * ((lane & 15) >> 2) + 4u + (lane & 3));
#pragma unroll
                        for (int t = 0; t < 16; ++t) *(LAS bf16_t*)(L + OMU + c * 1024 + off_m(t, pp >> 3) + 2 * (pp & 7)) = (bf16_t)(pkc(row[t], 0.f) & 0xffffu);
                    }
                }
            }
            LDS_BAR();
            SP_MARK(2);
            if (w < 4) {
#pragma unroll 1
                for (int c = 0; c < 4; ++c) {
                    bf16x8 Sb0, Sb1;
                    { u32x4 t0_; t0_.x = pkc(St[0][0], St[0][1]); t0_.y = pkc(St[0][2], St[0][3]); t0_.z = pkc(St[1][0], St[1][1]); t0_.w = pkc(St[1][2], St[1][3]); Sb0 = __builtin_bit_cast(bf16x8, t0_);
                      u32x4 t1_; t1_.x = pkc(St[2][0], St[2][1]); t1_.y = pkc(St[2][2], St[2][3]); t1_.z = pkc(St[3][0], St[3][1]); t1_.w = pkc(St[3][2], St[3][3]); Sb1 = __builtin_bit_cast(bf16x8, t1_); }
                    f32x4 Za = (f32x4){0.f, 0.f, 0.f, 0.f}, Zr = Za;
                    Za = MFMA16(*(const LAS bf16x8*)(L + ORA + c * 4096 + off_r(l15, q)), Sb0, Za); Za = MFMA16(*(const LAS bf16x8*)(L + ORA + c * 4096 + off_r(l15, 4 + q)), Sb1, Za);
                    Zr = MFMA16(*(const LAS bf16x8*)(L + ORA + c * 4096 + off_r(16 + l15, q)), Sb0, Zr); Zr = MFMA16(*(const LAS bf16x8*)(L + ORA + c * 4096 + off_r(16 + l15, 4 + q)), Sb1, Zr);
                    const u32x2 vt = *(const LAS u32x2*)(L + OVT + c * 2048 + (16 * w + l15) * 32 + 8 * q);
                    u32x4 bu; bu.x = pkc(Za[0], Za[1]); bu.y = pkc(Za[2], Za[3]); bu.z = vt.x; bu.w = vt.y;
                    f32x4 U = (f32x4){0.f, 0.f, 0.f, 0.f};
                    U = MFMA16(*(const LAS bf16x8*)(L + OMU + c * 1024 + off_m(l15, q)), __builtin_bit_cast(bf16x8, bu), U);
                    u32x4 by; by.x = pkc(U[0], U[1]); by.y = pkc(U[2], U[3]); by.z = vt.x; by.w = vt.y;
                    const bf16x8 By = __builtin_bit_cast(bf16x8, by);
                    const f32x4 Yt = MFMA16(*(const LAS bf16x8*)(L + OMY + c * 1024 + off_m(l15, q)), By, Zr);
#pragma unroll
                    for (int mt = 0; mt < 4; ++mt) { St[mt] = MFMA16(*(const LAS bf16x8*)(L + OMS + c * 4096 + off_m(16 * mt + l15, q)), By, St[mt]);
                        const f32x4 gc = *(const LAS f32x4*)(L + OGC + c * 256 + (16 * mt + 4 * q) * 4); St[mt] = St[mt] * gc; }
#pragma unroll
                    for (int g = 0; g < 4; ++g) *(LAS float*)(L + OYS + ((16 * c + 4 * q + g) * 64 + 16 * w + l15) * 4) = Yt[g];
                }
            }
            LDS_BAR();
            SP_MARK(3);
            bf16_t* ob_ = rbuf + ((size_t)b * SEQ + t0 + w) * DM + hd * 64;
#pragma unroll
            for (int iq = 0; iq < 4; ++iq) { const int tq = 2 * iq + (int)hf, t = w + 8 * tq; const int li = t * 64 + 2 * (int)cp;
                const f32x2 y = *(const LAS f32x2*)(L + OYS + li * 4); const float mean = half_sum(y[0] + y[1], hf) * (1.f / 64.f); const float d0 = y[0] - mean, d1 = y[1] - mean;
                const float rs = rsqrtf(half_sum(d0 * d0 + d1 * d1, hf) * (1.f / 64.f) + 64e-5f);
                const f32x2 vv = *(const LAS f32x2*)(L + OVF + li * 4), gg = *(const LAS f32x2*)(L + OGG + li * 4); const float bo = *(const LAS float*)(L + OBON + t * 4);
                const float o0 = (d0 * rs * lw[0] + lb[0] + bo * vv[0]) * gg[0], o1 = (d1 * rs * lw[1] + lb[1] + bo * vv[1]) * gg[1];
                *(unsigned*)(ob_ + (unsigned)(8 * tq * DM + 2 * (int)cp)) = pkc(o0, o1); }
        }
#undef RW_LOAD
    }
}

__global__ void __launch_bounds__(NTHREADS, 2) mega_fwd(Params p) {
    extern __shared__ __attribute__((aligned(16))) unsigned char lds_raw[];
    Frame F;
    F.lds = (LAS unsigned char*)lds_raw;
    F.tid = threadIdx.x; F.lane = F.tid & 63; F.wave = __builtin_amdgcn_readfirstlane(F.tid >> 6); F.G = gridDim.x; F.bid = blockIdx.x;
    F.out = p.out; F.ws = p.ws;
    volatile LAS unsigned* misc = (volatile LAS unsigned*)(F.lds + LDS_MISC);
    if (F.tid < 32) misc[F.tid] = 0u;
    __syncthreads();
    const int lo = p.ph_lo, hi = p.ph_hi;
    XcdBarrier bar; bar.bar = (unsigned*)(F.ws + WS_CTL); bar.x = 0; bar.st = misc;
    if (hi - lo > 1) bar = xcd_barrier_post((unsigned*)(F.ws + WS_CTL), misc);
#define IN(k) (lo <= (k) && (k) < hi)
#if PROBE_MASK
    unsigned long long pr_t0 = 0ull, pr_acc = 0ull;
#define PSTART(k) do { if ((PROBE_MASK >> (k)) & 1u) pr_t0 = wall_clock64(); } while (0)
#define PEND(k) do { if ((PROBE_MASK >> (k)) & 1u) pr_acc += wall_clock64() - pr_t0; } while (0)
#else
#define PSTART(k) do {} while (0)
#define PEND(k) do {} while (0)
#endif
#if PROBE_SUB == 11
#define SEAM(k) do { if (IN(k) && IN((k) + 1)) { unsigned long long b0_ = 0ull; if (F.tid == 0) b0_ = wall_clock64(); xcd_barrier(bar); if (F.tid == 0) *(LAS unsigned long long*)(F.lds + LDS_MISC + 64) += wall_clock64() - b0_; } PEND(k); PSTART((k) + 1); } while (0)
#else
#define SEAM(k) do { if (IN(k) && IN((k) + 1)) xcd_barrier(bar); PEND(k); PSTART((k) + 1); } while (0)
#endif
    bf16_t* wb = WSP(bf16_t, WS_WB);
    bf16_t* S0 = WSP(bf16_t, WS_SLAB); bf16_t* S2 = WSP(bf16_t, WS_SLAB + 2 * SLAB); bf16_t* S3 = WSP(bf16_t, WS_SLAB + 3 * SLAB); bf16_t* S4 = WSP(bf16_t, WS_SLAB + 4 * SLAB); bf16_t* S5 = WSP(bf16_t, WS_SLAB + 5 * SLAB);
    bf16_t* EH = WSP(bf16_t, WS_E);
    bf16_t* O0 = (bf16_t*)F.out; bf16_t* O1 = O0 + (size_t)T_TOK * DM;
    bf16_t* hres = (bf16_t*)F.out;
    bf16_t* S1 = WSP(bf16_t, WS_SLAB + 1 * SLAB);
    const int vcu = (F.G % 8 == 0) ? F.bid : F.bid;

    PSTART(0);
    if (IN(0)) { phase_prep(p, F, 0, PT_WIN, true); phase_rmsnorm<true>(p, F, p.in[0], p.in[1], O0); } SEAM(0);
    if (IN(2)) { DenseP<EK_INPROJ> P{}; P.pid = 2; P.v0 = (const float*)(F.ws + WS_ROPE); P.K = 1024; P.lda = 1024; P.ldb = 1024; P.nM = 256; P.nN = NPROJ / 256; P.nprob = 1; P.G = F.G; P.c = vcu; P.A = O0; P.a_stride = 0; P.B = wb + WB_WIN / 2; P.b_stride = 0;
        P.O = S0; P.o_stride = 0; P.ldc = NPROJ; gemm_phase(F.lds, P); } SEAM(2);
    if (IN(3)) { phase_conv(p, F); } SEAM(3);
    if (IN(4)) { phase_scan0(p, F); } SEAM(4);
    if (IN(5)) { phase_prep(p, F, PT_WIN, PT_WOUT, false); phase_gatenorm(p, F); } SEAM(5);
    if (IN(6)) { DenseP<EK_F32RES> P{}; P.pid = 6; P.K = 2048; P.lda = NPROJ; P.ldb = 2048; P.nM = 256; P.nN = 4; P.nprob = 1; P.G = F.G; P.c = vcu; P.A = S0; P.B = wb + WB_WOUT / 2; P.resf = p.in[0]; P.resb = nullptr; P.Ob = hres; P.ldc = 1024; gemm_phase(F.lds, P); } SEAM(6);
#define MOE_LAYER(L, k0) \
    if (IN(k0)) { phase_prep(p, F, PT_L2 + (L) * 4096, PT_L2 + (L) * 4096 + 4096, false); phase_prep(p, F, PT_W13 + (L) * 2048, PT_W13 + (L) * 2048 + 2048, false); phase_moe_route(p, F, L, hres, S2); } SEAM(k0); \
    if (IN(k0 + 1)) { phase_moe_slots(p, F, L); } SEAM(k0 + 1); \
    if (IN(k0 + 2)) { unsigned char* meta = F.ws + WS_META + (size_t)(L) * META_STRIDE; Moe1P<true> P{}; P.pid = (k0) + 2; P.K = 512; P.lda = P.K; P.ldb = P.K; P.G = F.G; P.c = vcu; \
        P.ntiles = __builtin_amdgcn_readfirstlane(ld_vec_i32((const int*)(meta + MT_TILE))); P.A = S2; P.W13 = wb + WB_W13 / 2 + (size_t)(L) * 16 * 1048576; P.H = S3; \
        P.slot_tok = (const int*)(meta + MT_STOK); P.slot_c = (const float*)(meta + MT_SC); P.tile_bkt = (const int*)(meta + MT_TILE) + 64; gemm_phase(F.lds, P); } SEAM(k0 + 2); \
    if (IN(k0 + 3)) { unsigned char* meta = F.ws + WS_META + (size_t)(L) * META_STRIDE; Moe2P<true> P{}; P.pid = (k0) + 3; P.K = 512; P.lda = P.K; P.ldb = P.K / 2; P.G = F.G; P.c = vcu; \
        P.ntiles = __builtin_amdgcn_readfirstlane(ld_vec_i32((const int*)(meta + MT_TILE))); P.H = S3; P.W2 = wb + WB_W2 / 2 + (size_t)(L) * 16 * 524288; P.hsrc = hres; P.hdst = ((L) == 1) ? S0 : hres; \
        P.slot_tok = (const int*)(meta + MT_STOK); P.tile_bkt = (const int*)(meta + MT_TILE) + 64; gemm_phase(F.lds, P); } SEAM(k0 + 3);
    MOE_LAYER(0, 7)
    if (IN(11)) { phase_prep(p, F, PT_WOUT, PT_L2, false); phase_mix5(p, F, hres, S0, S2, S3, S4); } SEAM(11);
    if (IN(12)) { DenseP<EK_LORA1> P{}; P.pid = 12; P.K = 2048; P.lda = 1024; P.ldb = 2048; P.nM = 256; P.nN = 2; P.nprob = 1; P.G = F.G; P.c = vcu; P.A = S0; P.a_skew = 1; P.a_split = 16; P.a_jump = -(long)(1024 * 2) - 16 * (BK * 2);
        P.B = wb + WB_L1 / 2; P.O = EH; P.ldc = 512; gemm_phase(F.lds, P); } SEAM(12);
    if (IN(14)) { DenseP<EK_BF16> P{}; P.pid = 14; P.K = 1024; P.lda = 1024; P.ldb = 1024; P.nM = 256; P.nN = 4; P.nprob = 3; P.G = F.G; P.c = vcu; P.ldc = 1024; P.A = S2; P.a_stride = (size_t)T_TOK * DM; P.B = wb + WB_WR / 2; P.b_stride = 1048576;
        P.O = S5; P.Oalt1 = S0; P.Oalt2 = S1; gemm_phase(F.lds, P); } SEAM(14);
    if (IN(15)) { DenseP<EK_LORA2> P{}; P.pid = 15; P.K = 256; P.lda = 512; P.ldb = 256; P.nM = 256; P.nN = 4; P.nprob = 3; P.G = F.G; P.c = vcu; P.A = EH; P.Aalt1 = EH; P.Aalt2 = EH + 128; P.B = wb + WB_L2 / 2; P.b_stride = 262144;
        P.O = S2; P.o_stride = (size_t)T_TOK * DM; P.ldc = 1024; P.v0 = p.in[17]; P.v1 = p.in[20]; gemm_phase(F.lds, P); } SEAM(15);
    if (IN(16)) { phase_rwkv(p, F, S5, S0, S1, S2, S3, S4); } SEAM(16);
    if (IN(17)) { DenseP<EK_F32RES> P{}; P.pid = 17; P.K = 1024; P.lda = 1024; P.ldb = 1024; P.nM = 256; P.nN = 4; P.nprob = 1; P.G = F.G; P.c = vcu; P.A = S5; P.B = wb + WB_WO / 2; P.resf = nullptr; P.resb = hres; P.Ob = hres; P.ldc = 1024; gemm_phase(F.lds, P); } SEAM(17);
    MOE_LAYER(1, 18)
    if (IN(22)) { phase_rmsnorm<false, true>(p, F, S0, p.in[3], F.out); }
#if PROBE_SUB
    if (F.bid == 0 && F.tid == 0) { const unsigned long long d_ = *(LAS unsigned long long*)(F.lds + LDS_MISC + 64); const unsigned long long t = wall_clock64(); while (wall_clock64() - t < d_) __builtin_amdgcn_s_sleep(8); }
#endif
#if PROBE_MASK
    PEND(22);
    if (F.bid == 0 && F.tid == 0) { const unsigned long long t = wall_clock64(); while (wall_clock64() - t < pr_acc) __builtin_amdgcn_s_sleep(8); }
#endif
}

extern "C" void kernel_launch(void* const* d_in, const int* in_sizes, int n_in, void* d_out, int out_size, void* d_ws, size_t ws_size, hipStream_t stream) {
    static int grid = 0;
    if (grid == 0) {
        if (n_in != 37 || out_size != T_TOK * DM || ws_size < WS_END) { fprintf(stderr, "kernel_launch: unexpected shapes (n_in %d out %d ws %zu)\n", n_in, out_size, ws_size); grid = -1; return; }
        int dev = 0, cus = 0, per_cu = 0;
        if (hipGetDevice(&dev) != hipSuccess || hipDeviceGetAttribute(&cus, hipDeviceAttributeMultiprocessorCount, dev) != hipSuccess) { grid = -1; return; }
        if (hipFuncSetAttribute((const void*)mega_fwd, hipFuncAttributeMaxDynamicSharedMemorySize, LDS_BYTES) != hipSuccess) { fprintf(stderr, "kernel_launch: hipFuncSetAttribute failed\n"); grid = -1; return; }
        if (hipOccupancyMaxActiveBlocksPerMultiprocessor(&per_cu, (const void*)mega_fwd, NTHREADS, LDS_BYTES) != hipSuccess || per_cu < 1) fprintf(stderr, "kernel_launch: occupancy query says %d\n", per_cu);
        (void)hipGetLastError();
        grid = cus;
        if (grid < 128 || grid > 512) { fprintf(stderr, "kernel_launch: built for 128..512 CUs (the MoE router keeps <= 512 tokens per workgroup in LDS); got %d\n", grid); grid = -1; return; }
    }
    if (grid < 0) return;
    (void)in_sizes;
    hipMemsetAsync((char*)d_ws + WS_CTL, 0, CTL_ZERO_BYTES, stream);
    Params p{};
    for (int i = 0; i < 37; ++i) p.in[i] = (const float*)d_in[i];
    p.out = (float*)d_out; p.ws = (unsigned char*)d_ws;
#if MK_PER_PHASE
    for (int k = 0; k < NPHASE; ++k) { p.ph_lo = k; p.ph_hi = k + 1; hipLaunchKernelGGL(mega_fwd, dim3(grid), dim3(NTHREADS), LDS_BYTES, stream, p); }
#else
    p.ph_lo = 0; p.ph_hi = NPHASE; hipLaunchKernelGGL(mega_fwd, dim3(grid), dim3(NTHREADS), LDS_BYTES, stream, p);
#endif
}
```

```cpp
#include <hip/hip_runtime.h>
#include <stdint.h>
#include <stdio.h>

#ifndef MK_PER_PHASE
#define MK_PER_PHASE 0
#endif

#ifndef PROBE_MASK
#define PROBE_MASK 0u
#endif
#ifndef PROBE_PID
#define PROBE_PID -1
#endif
#ifndef PROBE_SUB
#define PROBE_SUB 0
#endif
#define LAS __attribute__((address_space(3)))
typedef unsigned short bf16_t;
typedef short bf16x8 __attribute__((ext_vector_type(8)));
typedef float f32x4 __attribute__((ext_vector_type(4)));
typedef float f32x2 __attribute__((ext_vector_type(2)));
typedef unsigned u32x4 __attribute__((ext_vector_type(4)));
typedef unsigned u32x2 __attribute__((ext_vector_type(2)));

constexpr int T_TOK = 65536, DM = 1024, SEQ = 4096;
constexpr int NPROJ = 5888;
constexpr int PC_Z = 0, PC_XBC = 1024, PC_Q = 2560, PC_K = 3072, PC_V = 3584, PC_G = 4608, PC_DT = 5632;
constexpr int NTHREADS = 512;
constexpr int LDS_BYTES = 147456;
constexpr int LDS_MISC = LDS_BYTES - 256;
constexpr int NSLOT = T_TOK + 24 * 256;
constexpr int NPHASE = 23;
constexpr int PT_WIN = 1472, PT_WOUT = PT_WIN + 512, PT_RW = PT_WOUT + 1024, PT_L1 = PT_RW + 256, PT_L2 = PT_L1 + 192, PT_W13 = PT_L2 + 8192, PT_W2 = PT_W13 + 4096;
#if PROBE_SUB
#define SP_DECL unsigned long long sp_t_ = wall_clock64()
#define SP_MARK(id_end) do { if (F.tid == 0) { const unsigned long long n_ = wall_clock64(); if ((id_end) == PROBE_SUB) *(LAS unsigned long long*)(F.lds + LDS_MISC + 64) += n_ - sp_t_; sp_t_ = n_; } } while (0)
#else
#define SP_DECL do {} while (0)
#define SP_MARK(id_end) do {} while (0)
#endif

constexpr size_t MiB = 1024 * 1024;
constexpr size_t WS_CTL = 0;
constexpr size_t CTL_ZERO_BYTES = 16384;
constexpr size_t CTL_CNT_OFF = 14336;
constexpr size_t WS_META = 64 * 1024;
constexpr size_t META_STRIDE = 2 * MiB - 32 * 1024;
constexpr size_t MT_RANK = 0, MT_BKT = 262144, MT_C = 524288, MT_STOK = 1048576, MT_SC = 1048576 + 294912, MT_TILE = 1048576 + 294912 + 589824;
constexpr size_t WS_ROPE = 4 * MiB;
constexpr size_t WS_WB = 6 * MiB;
constexpr size_t WB_WIN = 0, WB_WOUT = WB_WIN + (size_t)NPROJ * 1024 * 2, WB_WR = WB_WOUT + (size_t)1024 * 2048 * 2, WB_WK = WB_WR + 2 * MiB, WB_WV = WB_WK + 2 * MiB, WB_WO = WB_WV + 2 * MiB,
                 WB_L1 = WB_WO + 2 * MiB  , WB_L2 = WB_L1 + 2 * MiB  , WB_W13 = WB_L2 + 3 * 512 * 1024  ,
                 WB_W2 = WB_W13 + (size_t)32 * 2 * MiB  , WB_END = WB_W2 + (size_t)32 * MiB;
constexpr size_t WS_SLAB = 130 * MiB;
constexpr size_t SLAB = 128 * MiB;
constexpr size_t WS_E = WS_SLAB + 6 * SLAB;
constexpr size_t WS_END = WS_E + 96 * MiB;
constexpr size_t WS_RTW = WS_WB + WB_END;
static_assert(WS_RTW + 2 * 20 * 1024 * 4 <= WS_SLAB, "weights overflow");
static_assert(WS_END <= 1024 * MiB, "workspace overflow");

struct Params {
    const float* in[37];
    float* out;
    unsigned char* ws;
    int ph_lo, ph_hi;
};

__device__ __forceinline__ float bf2f(bf16_t v) { return __uint_as_float(((unsigned)v) << 16); }
__device__ __forceinline__ float bflo(unsigned w) { return __uint_as_float(w << 16); }
__device__ __forceinline__ float bfhi(unsigned w) { return __uint_as_float(w & 0xffff0000u); }
__device__ __forceinline__ unsigned cvt_pk_bf16(float lo, float hi) { unsigned r; asm volatile("v_cvt_pk_bf16_f32 %0, %1, %2" : "=v"(r) : "v"(lo), "v"(hi)); return r; }
__device__ __forceinline__ bf16_t f2bf(float f) { return (bf16_t)(cvt_pk_bf16(f, 0.f) & 0xffffu); }
__device__ __forceinline__ float wave_sum(float v) {
#pragma unroll
    for (int o = 32; o >= 1; o >>= 1) v += __shfl_xor(v, o);
    return v;
}
__device__ __forceinline__ float dpp_sum16(float x) {
    x += __builtin_bit_cast(float, __builtin_amdgcn_update_dpp(0, __builtin_bit_cast(int, x), 0xB1, 0xF, 0xF, true));
    x += __builtin_bit_cast(float, __builtin_amdgcn_update_dpp(0, __builtin_bit_cast(int, x), 0x4E, 0xF, 0xF, true));
    x += __builtin_bit_cast(float, __builtin_amdgcn_update_dpp(0, __builtin_bit_cast(int, x), 0x141, 0xF, 0xF, true));
    x += __builtin_bit_cast(float, __builtin_amdgcn_update_dpp(0, __builtin_bit_cast(int, x), 0x140, 0xF, 0xF, true));
    return x;
}
__device__ __forceinline__ float wave_sum_u(float x) {
    x = dpp_sum16(x);
    x += __builtin_bit_cast(float, __builtin_amdgcn_update_dpp(0, __builtin_bit_cast(int, x), 0x142, 0xA, 0xF, false));
    x += __builtin_bit_cast(float, __builtin_amdgcn_update_dpp(0, __builtin_bit_cast(int, x), 0x143, 0xC, 0xF, false));
    return __builtin_bit_cast(float, __builtin_amdgcn_readlane(__builtin_bit_cast(int, x), 63));
}
__device__ __forceinline__ float fsilu(float x) { return x * __builtin_amdgcn_rcpf(1.f + __expf(-x)); }
__device__ __forceinline__ float fsigmoid(float x) { return __builtin_amdgcn_rcpf(1.f + __expf(-x)); }
__device__ __forceinline__ float fsoftplus(float x) { return x > 20.f ? x : log1pf(__expf(x)); }
__device__ __forceinline__ float ftanh(float x) { const float xc = fminf(fmaxf(x, -15.f), 15.f); const float e = __expf(2.f * xc); return (e - 1.f) * __builtin_amdgcn_rcpf(e + 1.f); }
__device__ __forceinline__ int ld_vec_i32(const int* p) { int r; asm volatile("global_load_dword %0, %1, off\n\ts_waitcnt vmcnt(0)" : "=&v"(r) : "v"(p) : "memory"); return r; }

#define XB_TMO      128
#define XB_XCNT(j)  (256  + 64 * (j))
#define XB_XSUB(j)  (1280 + 64 * (j))
#define XB_XGEN(j)  (2304 + 64 * (j))
#define XB_TOP      3328
#define XB_TOPGEN   3392
#define XCD_BAR_WORDS 3456
#define XB_SPIN_CAP (1u << 24)
__device__ __forceinline__ unsigned xb_ld(unsigned* p)              { return __hip_atomic_load(p, __ATOMIC_RELAXED, __HIP_MEMORY_SCOPE_AGENT); }
__device__ __forceinline__ unsigned xb_add(unsigned* p, unsigned v) { return __hip_atomic_fetch_add(p, v, __ATOMIC_RELAXED, __HIP_MEMORY_SCOPE_AGENT); }
__device__ __forceinline__ unsigned xb_xcc_id() { return (unsigned)__builtin_amdgcn_s_getreg((3 << 11) | 20) & 0xFu; }
#define XB_SPIN(cond, bar) do { unsigned _sp = 0; while (cond) { __builtin_amdgcn_s_sleep(1); \
    if ((++_sp & 255u) == 0u) { if (xb_ld(&(bar)[XB_TMO])) break; if (_sp > XB_SPIN_CAP) { atomicAdd(&(bar)[XB_TMO], 1u); break; } } } } while (0)
struct XcdBarrier { unsigned* bar; unsigned x; volatile LAS unsigned* st; };
__device__ __forceinline__ XcdBarrier xcd_barrier_post(unsigned* bar, volatile LAS unsigned* st) {
    XcdBarrier b; b.bar = bar; b.x = xb_xcc_id(); b.st = st;
    if (threadIdx.x == 0) (void)xb_add(&bar[XB_XCNT(b.x)], 1u);
    return b;
}
__device__ __forceinline__ void xcd_barrier_complete(unsigned* bar, unsigned x, unsigned& nloc, unsigned& nx) {
    const unsigned G = gridDim.x * gridDim.y * gridDim.z;
    unsigned sum, cnt, mine, sp = 0u;
    for (;;) {
        sum = 0u; cnt = 0u; mine = 0u;
#pragma unroll
        for (unsigned j = 0; j < 16; ++j) { const unsigned c = xb_ld(&bar[XB_XCNT(j)]); sum += c; cnt += (c > 0u) ? 1u : 0u; mine = (j == x) ? c : mine; }
        if (sum == G) break;
        __builtin_amdgcn_s_sleep(1);
        if ((++sp & 255u) == 0u) { if (xb_ld(&bar[XB_TMO])) break; if (sp > XB_SPIN_CAP) { atomicAdd(&bar[XB_TMO], 1u); break; } }
    }
    nloc = mine > 0u ? mine : 1u; nx = cnt > 0u ? cnt : 1u;
}
__device__ __forceinline__ void xcd_barrier(const XcdBarrier& b) {
    asm volatile("s_waitcnt vmcnt(0)" ::: "memory");
    __syncthreads();
    if (threadIdx.x == 0) {
        unsigned* bar = b.bar;
        __builtin_amdgcn_s_waitcnt(0);
        unsigned nloc = b.st[0], nx = b.st[1];
        if (nloc == 0u) { xcd_barrier_complete(bar, b.x, nloc, nx); b.st[0] = nloc; b.st[1] = nx; }
        const unsigned old = xb_add(&bar[XB_XSUB(b.x)], 1u);
        const unsigned gen = old / nloc;
        if (old + 1u == (gen + 1u) * nloc) {
            __builtin_amdgcn_fence(__ATOMIC_RELEASE, "agent");
            asm volatile("s_waitcnt vmcnt(0)" ::: "memory");
            const unsigned og = xb_add(&bar[XB_TOP], 1u);
            const unsigned tg = og / nx;
            if (og + 1u == (tg + 1u) * nx) xb_add(&bar[XB_TOPGEN], 1u);
            else XB_SPIN(xb_ld(&bar[XB_TOPGEN]) == tg, bar);
            __builtin_amdgcn_fence(__ATOMIC_ACQUIRE, "agent");
            xb_add(&bar[XB_XGEN(b.x)], 1u);
            asm volatile("s_waitcnt vmcnt(0)" ::: "memory");
        } else {
            XB_SPIN(xb_ld(&bar[XB_XGEN(b.x)]) == gen, bar);
            __builtin_amdgcn_fence(__ATOMIC_ACQUIRE, "agent");
            asm volatile("s_waitcnt vmcnt(0)" ::: "memory");
        }
    }
    __syncthreads();
}

typedef int i32x4v __attribute__((ext_vector_type(4)));
typedef int i32x8v __attribute__((ext_vector_type(8)));
__device__ __forceinline__ unsigned pk_fp8x4(float a, float b, float c, float d) {
    a = __builtin_amdgcn_fmed3f(a, -448.f, 448.f); b = __builtin_amdgcn_fmed3f(b, -448.f, 448.f); c = __builtin_amdgcn_fmed3f(c, -448.f, 448.f); d = __builtin_amdgcn_fmed3f(d, -448.f, 448.f);
    int w = __builtin_amdgcn_cvt_pk_fp8_f32(a, b, 0, false); w = __builtin_amdgcn_cvt_pk_fp8_f32(c, d, w, true); return (unsigned)w; }
#define F8_INPROJ 0
#define F8_OUTPROJ 0
#define F8_RV 1
#define F8_WO 0
constexpr float F8_ACT_SCALE = 8.f, F8_W_SCALE = 256.f, F8_DESCALE = 1.f / (8.f * 256.f);
constexpr int BM = 256, BK = 64, HALF = 128, HTB = HALF * BK * 2, STAGE_BYTES = 8 * HTB;
__device__ __forceinline__ int lds_byte(int r, int c) { const int st = (r >> 4) * 2 + (c >> 5), rr = r & 15, cc = c & 31, ob = rr * 64 + cc * 2; return st * 1024 + (ob ^ (((ob >> 9) & 1) << 5)); }
__device__ __forceinline__ void stage_rc(int b, int& R, int& C) { const int st = b / 1024, sb = b % 1024, swz = sb ^ (((sb >> 9) & 1) << 5); R = (st >> 1) * 16 + swz / 64; C = (st & 1) * 32 + (swz % 64) / 2; }
__device__ __forceinline__ int perm32(int rho) { const int n = rho >> 4, i = rho & 15; return 8 * (i >> 2) + 4 * n + (i & 3); }
struct Unit { int pm, pn, prob; };
__device__ __forceinline__ void tile_order(int L, int nM, int nN, int& pm, int& pn) {
    const int nwg = nM * nN; int wgid = L;
    { const int q = nwg / 8, r = nwg % 8, xcd = wgid % 8, off = wgid / 8; wgid = (xcd < r ? xcd * (q + 1) : r * (q + 1) + (xcd - r) * q) + off; }
    const int nig = 8 * nN, gid = wgid / nig, fm = gid * 8, gsz = (nM - fm) < 8 ? (nM - fm) : 8;
    pm = fm + ((wgid % nig) % gsz); pn = (wgid % nig) / gsz;
}

template <class P>
__device__ __forceinline__ void gemm_phase(LAS unsigned char* lds, const P& S) {
    const int tid = threadIdx.x, wid = __builtin_amdgcn_readfirstlane(tid >> 6), lane = tid & 63, wr = wid >> 2, wc = wid & 3, fr = lane & 15, fq = lane >> 4;
    const int K = S.K, nt = K / BK, lda = S.lda, ldb = S.ldb;
    int RA[2], CA[2]; unsigned voffB[2], vAc[2][2], vAn[2][2];
#pragma unroll
    for (int i = 0; i < 2; ++i) { int R, C; stage_rc(tid * 16 + i * 8192, R, C); RA[i] = R; CA[i] = C; const int Rb = P::PERM ? ((R & ~31) + perm32(R & 31)) : R;
        voffB[i] = (unsigned)(Rb * ldb + C) * 2u;
#pragma unroll
        for (int h = 0; h < 2; ++h) { vAc[h][i] = (unsigned)((h * HALF + R) * lda + C) * 2u; vAn[h][i] = vAc[h][i]; } }
    const size_t kstep = (size_t)(BK * 2);
    const size_t hstepB = (size_t)HALF * ldb * 2;
    const unsigned ldsw = (unsigned)wid * 1024u;
    const int aoff = lds_byte(wr * 64 + fr, fq * 8), boff = lds_byte(wc * 32 + fr, fq * 8);
#define PG8_SA(b, h) (((b) * 2 + (h)) * HTB)
#define PG8_SB(b, h) ((4 + (b) * 2 + (h)) * HTB)
#define PG8_STAGE2(bufoff, gbase, v0, v1) do { \
        __builtin_amdgcn_global_load_lds((const unsigned*)((const char*)(gbase) + (v0)), (LAS unsigned*)(lds + (bufoff) + ldsw), 16, 0, 0); \
        __builtin_amdgcn_global_load_lds((const unsigned*)((const char*)(gbase) + (v1)), (LAS unsigned*)(lds + (bufoff) + ldsw + 8192), 16, 0, 0); } while (0)
#define PG8_CAT8(x0_, x1_) __builtin_shufflevector(__builtin_bit_cast(i32x4v, x0_), __builtin_bit_cast(i32x4v, x1_), 0, 1, 2, 3, 4, 5, 6, 7)
#define PG8_LDA(dst, b, h) do { if constexpr (P::FP8) { _Pragma("unroll") for (int m = 0; m < 4; ++m) dst##8[m] = PG8_CAT8(*(const LAS bf16x8*)(lds + PG8_SA(b, h) + aoff + m * 2048), *(const LAS bf16x8*)(lds + PG8_SA(b, h) + aoff + m * 2048 + 1024)); } \
        else { _Pragma("unroll") for (int m = 0; m < 4; ++m) _Pragma("unroll") for (int k = 0; k < 2; ++k) dst[m][k] = *(const LAS bf16x8*)(lds + PG8_SA(b, h) + aoff + m * 2048 + k * 1024); } } while (0)
#define PG8_LDB(dst, b, h) do { if constexpr (P::FP8) { _Pragma("unroll") for (int n = 0; n < 2; ++n) dst##8[n] = PG8_CAT8(*(const LAS bf16x8*)(lds + PG8_SB(b, h) + boff + n * 2048), *(const LAS bf16x8*)(lds + PG8_SB(b, h) + boff + n * 2048 + 1024)); } \
        else { _Pragma("unroll") for (int n = 0; n < 2; ++n) _Pragma("unroll") for (int k = 0; k < 2; ++k) dst[n][k] = *(const LAS bf16x8*)(lds + PG8_SB(b, h) + boff + n * 2048 + k * 1024); } } while (0)
#define PG8_MMA(ai, bj, At, Bt) do { __builtin_amdgcn_s_setprio(1); \
        if constexpr (P::FP8) { _Pragma("unroll") for (int m = 0; m < 4; ++m) _Pragma("unroll") for (int n = 0; n < 2; ++n) \
            asm volatile("v_mfma_f32_16x16x128_f8f6f4 %0, %1, %2, %0" : "+v"(acc[ai][bj][m][n]) : "v"(Bt##8[n]), "v"(At##8[m])); }        \
        else { _Pragma("unroll") for (int m = 0; m < 4; ++m) _Pragma("unroll") for (int n = 0; n < 2; ++n) _Pragma("unroll") for (int k = 0; k < 2; ++k) \
            acc[ai][bj][m][n] = __builtin_amdgcn_mfma_f32_16x16x32_bf16(Bt[n][k], At[m][k], acc[ai][bj][m][n], 0, 0, 0); } \
        __builtin_amdgcn_s_setprio(0); } while (0)
#define PG8_WAIT_V(n) asm volatile("s_waitcnt vmcnt(" #n ")" ::: "memory")
#define PG8_WAIT_L(n) asm volatile("s_waitcnt lgkmcnt(" #n ")" ::: "memory")
#define PG8_BAR __builtin_amdgcn_s_barrier()
#define LDS_BAR() asm volatile("s_waitcnt lgkmcnt(0)\n\ts_barrier" ::: "memory")
#define PG8_SCHED __builtin_amdgcn_sched_barrier(0)
    Unit cur, nxt; int ui = 0;
    if (!S.next(0, cur)) return;
    struct { int tid; LAS unsigned char* lds; } F; F.tid = tid; F.lds = lds; (void)F;
    SP_DECL;
    if constexpr (P::GATHER) {
#pragma unroll
        for (int h = 0; h < 2; ++h)
#pragma unroll
            for (int i = 0; i < 2; ++i) vAc[h][i] = S.a_voff(cur, h * HALF + RA[i], CA[i]);
    }
    float zf; asm volatile("v_mov_b32 %0, 0" : "=v"(zf));
    f32x4 acc[2][2][4][2];
#pragma unroll
    for (int a = 0; a < 2; ++a)
#pragma unroll
        for (int b = 0; b < 2; ++b)
#pragma unroll
            for (int m = 0; m < 4; ++m)
#pragma unroll
                for (int n = 0; n < 2; ++n) acc[a][b][m][n] = (f32x4){zf, zf, zf, zf};
    bf16x8 At[4][2], B0[2][2], B1[2][2]; i32x8v At8[4], B08[2], B18[2]; (void)At; (void)B0; (void)B1; (void)At8; (void)B08; (void)B18;
    const char* cA = S.a_ptr(cur);
    {
        const char* b0 = S.b_ptr(cur, 0); const char* b1 = S.b_ptr(cur, 1);
        const char* cA0 = cA + S.a_kadj(0);
        PG8_STAGE2(PG8_SB(0, 0), b0, voffB[0], voffB[1]); PG8_STAGE2(PG8_SA(0, 0), cA0, vAc[0][0], vAc[0][1]); PG8_STAGE2(PG8_SB(0, 1), b0 + hstepB, voffB[0], voffB[1]); PG8_STAGE2(PG8_SA(0, 1), cA0, vAc[1][0], vAc[1][1]);
        if (wr == 1) PG8_BAR;
        PG8_WAIT_V(4); PG8_BAR;
        PG8_STAGE2(PG8_SB(1, 0), b1, voffB[0], voffB[1]); PG8_STAGE2(PG8_SA(1, 0), cA + kstep + S.a_kadj(1), vAc[0][0], vAc[0][1]); PG8_STAGE2(PG8_SB(1, 1), b1 + hstepB, voffB[0], voffB[1]);
        PG8_WAIT_V(6); PG8_BAR;
    }
    for (;;) {
        const bool has_next = S.next(ui + 1, nxt);
        if (!has_next) nxt = cur;
        if constexpr (P::GATHER) {
            if (has_next) {
#pragma unroll
                for (int h = 0; h < 2; ++h)
#pragma unroll
                    for (int i = 0; i < 2; ++i) vAn[h][i] = S.a_voff(nxt, h * HALF + RA[i], CA[i]);
            }
        }
        const char* nA = S.a_ptr(nxt);
        for (int t = 0; t < nt; t += 2) {
            const bool last = (t == nt - 2);
            const char* a1 = cA + (size_t)(t + 1) * kstep + S.a_kadj(t + 1);
            const char* a2 = last ? nA + S.a_kadj(0) : cA + (size_t)(t + 2) * kstep + S.a_kadj(t + 2);
            const char* a3 = last ? nA + kstep + S.a_kadj(1) : cA + (size_t)(t + 3) * kstep + S.a_kadj(t + 3);
            const char* b2 = last ? S.b_ptr(nxt, 0) : S.b_ptr(cur, t + 2);
            const char* b3 = last ? S.b_ptr(nxt, 1) : S.b_ptr(cur, t + 3);
            unsigned s00 = vAc[0][0], s01 = vAc[0][1], s10 = vAc[1][0], s11 = vAc[1][1];
            if constexpr (P::GATHER) { if (last) { s00 = vAn[0][0]; s01 = vAn[0][1]; s10 = vAn[1][0]; s11 = vAn[1][1]; } }
            PG8_LDB(B0, 0, 0); PG8_SCHED; PG8_LDA(At, 0, 0); PG8_STAGE2(PG8_SA(1, 1), a1, vAc[1][0], vAc[1][1]);
            PG8_WAIT_L(8); PG8_BAR; PG8_WAIT_L(0); PG8_MMA(0, 0, At, B0); PG8_BAR; PG8_SCHED;
            PG8_LDB(B1, 0, 1); PG8_STAGE2(PG8_SB(0, 0), b2, voffB[0], voffB[1]);
            PG8_BAR; PG8_WAIT_L(0); PG8_MMA(0, 1, At, B1); PG8_BAR;
            PG8_LDA(At, 0, 1); PG8_STAGE2(PG8_SA(0, 0), a2, s00, s01);
            PG8_BAR; PG8_WAIT_L(0); PG8_MMA(1, 0, At, B0); PG8_BAR; PG8_SCHED;
            PG8_STAGE2(PG8_SB(0, 1), b2 + hstepB, voffB[0], voffB[1]);
            PG8_WAIT_V(6); PG8_BAR; PG8_MMA(1, 1, At, B1); PG8_BAR;
            PG8_LDB(B0, 1, 0); PG8_SCHED; PG8_LDA(At, 1, 0); PG8_STAGE2(PG8_SA(0, 1), a2, s10, s11);
            PG8_WAIT_L(8); PG8_BAR; PG8_WAIT_L(0); PG8_MMA(0, 0, At, B0); PG8_BAR; PG8_SCHED;
            PG8_LDB(B1, 1, 1); PG8_STAGE2(PG8_SB(1, 0), b3, voffB[0], voffB[1]);
            PG8_BAR; PG8_WAIT_L(0); PG8_MMA(0, 1, At, B1); PG8_BAR;
            PG8_LDA(At, 1, 1); PG8_STAGE2(PG8_SA(1, 0), a3, s00, s01);
            PG8_BAR; PG8_WAIT_L(0); PG8_MMA(1, 0, At, B0); PG8_BAR; PG8_SCHED;
            PG8_STAGE2(PG8_SB(1, 1), b3 + hstepB, voffB[0], voffB[1]);
            PG8_WAIT_V(6); PG8_BAR; PG8_MMA(1, 1, At, B1); PG8_BAR;
        }
        SP_MARK((PROBE_PID < 0 || S.pid == PROBE_PID) ? 10 : -1);
        if constexpr (P::FP8) asm volatile("s_nop 15\n\ts_nop 15\n\ts_nop 15" ::: "memory");
        S.epi(acc, cur, wr, wc, fr, fq);
        SP_MARK((PROBE_PID < 0 || S.pid == PROBE_PID) ? 9 : -1);
        if (!has_next) break;
#pragma unroll
        for (int a = 0; a < 2; ++a)
#pragma unroll
            for (int b = 0; b < 2; ++b)
#pragma unroll
                for (int m = 0; m < 4; ++m)
#pragma unroll
                    for (int n = 0; n < 2; ++n) acc[a][b][m][n] = (f32x4){zf, zf, zf, zf};
        cur = nxt; cA = nA; ++ui;
        if constexpr (P::GATHER) {
#pragma unroll
            for (int h = 0; h < 2; ++h)
#pragma unroll
                for (int i = 0; i < 2; ++i) vAc[h][i] = vAn[h][i];
        }
    }
    PG8_WAIT_V(0);
    if (wr == 0) PG8_BAR;
    PG8_BAR;
#undef PG8_SA
#undef PG8_SB
#undef PG8_STAGE2
#undef PG8_LDA
#undef PG8_LDB
#undef PG8_MMA
#undef PG8_WAIT_V
#undef PG8_WAIT_L
#undef PG8_BAR
#undef PG8_SCHED
}

enum { EK_BF16 = 0, EK_LORA1 = 1, EK_LORA2 = 2, EK_F32RES = 3, EK_INPROJ = 4 };
template <int KIND, bool F8 = false>
struct DenseP {
    static constexpr bool PERM = true, GATHER = false;
    int K, lda, ldb, nM, nN, nprob, G, c, pid;
    static constexpr bool FP8 = F8; static constexpr float DS = F8 ? F8_DESCALE : 1.f;
    const bf16_t* A; size_t a_stride;
    const bf16_t* Aalt1; const bf16_t* Aalt2;
    int a_skew;
    int a_split; long a_jump;
    const bf16_t* B; size_t b_stride;
    bf16_t* O; size_t o_stride; int ldc;
    bf16_t* Oalt1; bf16_t* Oalt2;
    const float* resf; const bf16_t* resb; bf16_t* Ob;
    const float* v0; const float* v1;
    __device__ __forceinline__ bool next(int i, Unit& u) const {
        const long L = (long)i * G + c; const int per = nM * nN; if (L >= (long)per * nprob) return false;
        u.prob = (int)(L / per); tile_order((int)(L % per), nM, nN, u.pm, u.pn); return true;
    }
    __device__ __forceinline__ const char* a_ptr(const Unit& u) const { const bf16_t* a0 = Aalt1 ? ((u.prob == 0) ? A : (u.prob == 1) ? Aalt1 : Aalt2) : A + (size_t)u.prob * a_stride; return (const char*)(a0 + ((size_t)u.pm * BM + (a_skew ? (u.pm >> 4) + 1 : 0)) * lda); }
    __device__ __forceinline__ long a_kadj(int kt) const { return (a_split > 0 && kt >= a_split) ? a_jump : 0; }
    __device__ __forceinline__ const char* b_ptr(const Unit& u, int kt) const { return (const char*)(B + (size_t)u.prob * b_stride + (size_t)u.pn * BM * ldb) + (size_t)kt * (BK * 2); }
    __device__ __forceinline__ unsigned a_voff(const Unit&, int, int) const { return 0u; }
    __device__ __forceinline__ void epi(const f32x4 (&acc)[2][2][4][2], const Unit& u, int wr, int wc, int fr, int fq) const {
        const int row0 = u.pm * BM + wr * 64 + fr;
        if constexpr (KIND == EK_F32RES) {
            const int col0 = u.pn * BM + wc * 32 + 8 * fq;
#pragma unroll
            for (int ai = 0; ai < 2; ++ai)
#pragma unroll
                for (int mp = 0; mp < 2; ++mp) {
                    f32x4 r0[2][2], r1[2][2];
#pragma unroll
                    for (int mm = 0; mm < 2; ++mm) { const size_t ro = (size_t)(row0 + ai * HALF + (mp * 2 + mm) * 16) * ldc + col0;
#pragma unroll
                        for (int bj = 0; bj < 2; ++bj) {
                            if (resf) { r0[mm][bj] = __builtin_nontemporal_load((const f32x4*)(resf + ro + bj * HALF)); r1[mm][bj] = __builtin_nontemporal_load((const f32x4*)(resf + ro + bj * HALF + 4)); }
                            else { const u32x4 rw = *(const u32x4*)(resb + ro + bj * HALF); r0[mm][bj] = (f32x4){bflo(rw.x), bfhi(rw.x), bflo(rw.y), bfhi(rw.y)}; r1[mm][bj] = (f32x4){bflo(rw.z), bfhi(rw.z), bflo(rw.w), bfhi(rw.w)}; } } }
#pragma unroll
                    for (int mm = 0; mm < 2; ++mm) { const size_t ro = (size_t)(row0 + ai * HALF + (mp * 2 + mm) * 16) * ldc + col0;
#pragma unroll
                        for (int bj = 0; bj < 2; ++bj) { const f32x4 x0 = acc[ai][bj][mp * 2 + mm][0] * DS + r0[mm][bj], x1 = acc[ai][bj][mp * 2 + mm][1] * DS + r1[mm][bj];
                            u32x4 w; w.x = cvt_pk_bf16(x0[0], x0[1]); w.y = cvt_pk_bf16(x0[2], x0[3]); w.z = cvt_pk_bf16(x1[0], x1[1]); w.w = cvt_pk_bf16(x1[2], x1[3]);
                            *(u32x4*)(Ob + ro + bj * HALF) = w; } }
                }
        } else {
            const int col0 = u.pn * BM + wc * 32 + 8 * fq;
            bf16_t* base = Oalt1 ? ((u.prob == 0) ? O : (u.prob == 1) ? Oalt1 : Oalt2) : O + (size_t)u.prob * o_stride;
            f32x4 bv[2][2];
#pragma unroll
            for (int bj = 0; bj < 2; ++bj)
#pragma unroll
                for (int n = 0; n < 2; ++n) {
                    if constexpr (KIND == EK_LORA2) { bv[bj][n] = (u.prob == 0) ? *(const f32x4*)(v0 + col0 + bj * HALF + 4 * n) : (u.prob == 1) ? *(const f32x4*)(v1 + col0 + bj * HALF + 4 * n) : (f32x4){0.f, 0.f, 0.f, 0.f}; }
                    else bv[bj][n] = (f32x4){0.f, 0.f, 0.f, 0.f};
                }
#pragma unroll
            for (int ai = 0; ai < 2; ++ai)
#pragma unroll
                for (int m = 0; m < 4; ++m) { bf16_t* rowp = base + (size_t)(row0 + ai * HALF + m * 16) * ldc + col0;
#pragma unroll
                    for (int bj = 0; bj < 2; ++bj) { f32x4 x0 = acc[ai][bj][m][0] * DS + bv[bj][0], x1 = acc[ai][bj][m][1] * DS + bv[bj][1];
                        if constexpr (KIND == EK_LORA1) {
                            const int g0 = u.pn * BM + bj * HALF + wc * 32; const float kx = (g0 < 64) ? 2.f : 1.f;
#pragma unroll
                            for (int j = 0; j < 4; ++j) { const float s0 = fsigmoid(kx * x0[j]), s1 = fsigmoid(kx * x1[j]);
                                x0[j] = (g0 < 64) ? 2.f * s0 - 1.f : (g0 >= 128) ? s0 : x0[j]; x1[j] = (g0 < 64) ? 2.f * s1 - 1.f : (g0 >= 128) ? s1 : x1[j]; } }
                        if constexpr (KIND == EK_LORA2) {
                            const float sc = (u.prob == 0) ? 0.6065306597126334f : 1.f;
#pragma unroll
                            for (int j = 0; j < 4; ++j) { const float s0 = sc * fsigmoid(x0[j]), s1 = sc * fsigmoid(x1[j]); x0[j] = (u.prob == 2) ? x0[j] : s0; x1[j] = (u.prob == 2) ? x1[j] : s1; } }
                        if constexpr (KIND == EK_INPROJ) {
                            if (u.pn >= PC_Q / 256 && u.pn < PC_V / 256) { const int pos = (row0 + ai * HALF + m * 16) & (SEQ - 1); const float sc = (u.pn >= PC_K / 256) ? 0.08838834764831845f : 1.f;
                                const f32x4 cs0 = *(const f32x4*)(v0 + ((size_t)pos * 64 + wc * 16 + 4 * fq) * 2), cs1 = *(const f32x4*)(v0 + ((size_t)pos * 64 + wc * 16 + 4 * fq + 2) * 2);
                                const f32x4 a = x0, b = x1;
                                x0[0] = (a[0] * cs0[0] - a[1] * cs0[1]) * sc; x0[1] = (a[0] * cs0[1] + a[1] * cs0[0]) * sc; x0[2] = (a[2] * cs0[2] - a[3] * cs0[3]) * sc; x0[3] = (a[2] * cs0[3] + a[3] * cs0[2]) * sc;
                                x1[0] = (b[0] * cs1[0] - b[1] * cs1[1]) * sc; x1[1] = (b[0] * cs1[1] + b[1] * cs1[0]) * sc; x1[2] = (b[2] * cs1[2] - b[3] * cs1[3]) * sc; x1[3] = (b[2] * cs1[3] + b[3] * cs1[2]) * sc; } }
                        u32x4 w; w.x = cvt_pk_bf16(x0[0], x0[1]); w.y = cvt_pk_bf16(x0[2], x0[3]); w.z = cvt_pk_bf16(x1[0], x1[1]); w.w = cvt_pk_bf16(x1[2], x1[3]);
                        *(u32x4*)(rowp + bj * HALF) = w; } }
        }
    }
};

__device__ __forceinline__ void pair_lohi(int pr, int& lo, int& hi) { lo = (pr < 3) ? 0 : (pr < 5 ? 1 : 2); hi = (pr < 3) ? pr + 1 : (pr < 5 ? pr - 1 : 3); }

template <bool F8>
struct Moe1P {
    static constexpr bool PERM = true, GATHER = true, FP8 = F8;
    int K, lda, ldb, G, c, ntiles, pid;
    const bf16_t* A; const bf16_t* W13;
    bf16_t* H; const int* slot_tok; const float* slot_c; const int* tile_bkt;
    __device__ __forceinline__ bool next(int i, Unit& u) const {
        const int m = (c >> 3) + (G >> 3) * i; if ((G & 7) != 0 || m >= ntiles) { if ((G & 7) == 0) return false; const long L = (long)i * G + c; if (L >= (long)ntiles * 8) return false; u.pm = (int)(L >> 3); u.pn = (int)(L & 7); u.prob = __builtin_amdgcn_readfirstlane(ld_vec_i32(tile_bkt + u.pm)); return true; }
        u.pm = m; u.pn = c & 7; u.prob = __builtin_amdgcn_readfirstlane(ld_vec_i32(tile_bkt + u.pm)); return true;
    }
    __device__ __forceinline__ const char* a_ptr(const Unit&) const { return (const char*)A; }
    __device__ __forceinline__ long a_kadj(int) const { return 0; }
    __device__ __forceinline__ unsigned a_voff(const Unit& u, int row, int C) const { int tok = slot_tok[u.pm * BM + row]; tok = tok < 0 ? 0 : tok; return (unsigned)(tok * lda + C) * 2u; }
    __device__ __forceinline__ const char* b_ptr(const Unit& u, int kt) const {
        int lo, hi; pair_lohi(u.prob % 6, lo, hi); const int e = (u.prob / 6) * 4 + ((u.pn < 4) ? lo : hi);
        if constexpr (F8) return (const char*)W13 + (size_t)e * 2097152 + (size_t)(u.pn & 3) * BM * 1024 + (size_t)kt * (BK * 2);
        return (const char*)(W13 + ((size_t)e * 1024 + (size_t)(u.pn & 3) * BM) * 1024) + (size_t)kt * (BK * 2);
    }
    __device__ __forceinline__ void epi(const f32x4 (&acc)[2][2][4][2], const Unit& u, int wr, int wc, int fr, int fq) const {
        const int row0 = u.pm * BM + wr * 64 + fr, col0 = ((u.pn < 4) ? 0 : 512) + (u.pn & 3) * 128 + wc * 32 + 8 * fq, ci = (u.pn < 4) ? 0 : 1;
#pragma unroll
        for (int ai = 0; ai < 2; ++ai)
#pragma unroll
            for (int m = 0; m < 4; ++m) { const int row = row0 + ai * HALF + m * 16; const float cw = slot_c[(size_t)row * 2 + ci];
                const f32x4 g0 = acc[ai][0][m][0], g1 = acc[ai][0][m][1], u0 = acc[ai][1][m][0], u1 = acc[ai][1][m][1]; f32x4 x0, x1;
#pragma unroll
                for (int j = 0; j < 4; ++j) {
                    if constexpr (F8) { x0[j] = fsilu(g0[j] * F8_DESCALE) * (u0[j] * F8_DESCALE) * (cw * F8_ACT_SCALE); x1[j] = fsilu(g1[j] * F8_DESCALE) * (u1[j] * F8_DESCALE) * (cw * F8_ACT_SCALE); }
                    else { x0[j] = fsilu(g0[j]) * u0[j] * cw; x1[j] = fsilu(g1[j]) * u1[j] * cw; } }
                if constexpr (F8) { u32x2 w8; w8.x = pk_fp8x4(x0[0], x0[1], x0[2], x0[3]); w8.y = pk_fp8x4(x1[0], x1[1], x1[2], x1[3]); *(u32x2*)((unsigned char*)H + (size_t)row * 1024 + col0) = w8; continue; }
                u32x4 w; w.x = cvt_pk_bf16(x0[0], x0[1]); w.y = cvt_pk_bf16(x0[2], x0[3]); w.z = cvt_pk_bf16(x1[0], x1[1]); w.w = cvt_pk_bf16(x1[2], x1[3]);
                *(u32x4*)(H + (size_t)row * 1024 + col0) = w; }
    }
};
template <bool F8>
struct Moe2P {
    static constexpr bool PERM = true, GATHER = false, FP8 = F8;
    int K, lda, ldb, G, c, ntiles, pid;
    const bf16_t* H; const bf16_t* W2;
    const bf16_t* hsrc; bf16_t* hdst; const int* slot_tok; const int* tile_bkt;
    __device__ __forceinline__ bool next(int i, Unit& u) const {
        const int m = 2 * ((c >> 3) + (G >> 3) * i) + ((c >> 2) & 1); if ((G & 7) != 0 || m >= ntiles) { if ((G & 7) == 0) return false; const long L = (long)i * G + c; if (L >= (long)ntiles * 4) return false; u.pm = (int)(L >> 2); u.pn = (int)(L & 3); u.prob = __builtin_amdgcn_readfirstlane(ld_vec_i32(tile_bkt + u.pm)); return true; }
        u.pm = m; u.pn = c & 3; u.prob = __builtin_amdgcn_readfirstlane(ld_vec_i32(tile_bkt + u.pm)); return true;
    }
    __device__ __forceinline__ const char* a_ptr(const Unit& u) const { return (const char*)H + (size_t)u.pm * BM * 1024 * (F8 ? 1 : 2); }
    __device__ __forceinline__ long a_kadj(int) const { return 0; }
    __device__ __forceinline__ unsigned a_voff(const Unit&, int, int) const { return 0u; }
    __device__ __forceinline__ const char* b_ptr(const Unit& u, int kt) const {
        int lo, hi; pair_lohi(u.prob % 6, lo, hi);
        if constexpr (F8) { const int e8 = (u.prob / 6) * 4 + ((kt < 4) ? lo : hi); return (const char*)W2 + (size_t)e8 * 1048576 + (size_t)u.pn * BM * 512 + (size_t)(kt & 3) * (BK * 2); }
        const int e = (u.prob / 6) * 4 + ((kt < 8) ? lo : hi);
        return (const char*)(W2 + ((size_t)e * 1024 + (size_t)u.pn * BM) * 512) + (size_t)(kt & 7) * (BK * 2);
    }
    __device__ __forceinline__ void epi(const f32x4 (&acc)[2][2][4][2], const Unit& u, int wr, int wc, int fr, int fq) const {
        const int row0 = u.pm * BM + wr * 64 + fr, col0 = u.pn * BM + wc * 32 + 8 * fq;
        int tok[2][4];
#pragma unroll
        for (int ai = 0; ai < 2; ++ai)
#pragma unroll
            for (int m = 0; m < 4; ++m) tok[ai][m] = slot_tok[row0 + ai * HALF + m * 16];
#pragma unroll
        for (int ai = 0; ai < 2; ++ai) {
            u32x4 r[4][2];
#pragma unroll
            for (int m = 0; m < 4; ++m) { const int tk = tok[ai][m]; const bf16_t* rp = hsrc + (size_t)(tk < 0 ? 0 : tk) * 1024 + col0;
#pragma unroll
                for (int bj = 0; bj < 2; ++bj) r[m][bj] = *(const u32x4*)(rp + bj * HALF); }
#pragma unroll
            for (int m = 0; m < 4; ++m) { const int tk = tok[ai][m];
                if (tk >= 0) { bf16_t* wp = hdst + (size_t)tk * 1024 + col0;
#pragma unroll
                    for (int bj = 0; bj < 2; ++bj) { const u32x4 rw = r[m][bj]; const f32x4 a0 = acc[ai][bj][m][0], a1 = acc[ai][bj][m][1]; constexpr float ds = F8 ? F8_DESCALE : 1.f;
                        u32x4 w; w.x = cvt_pk_bf16(fmaf(a0[0], ds, bflo(rw.x)), fmaf(a0[1], ds, bfhi(rw.x))); w.y = cvt_pk_bf16(fmaf(a0[2], ds, bflo(rw.y)), fmaf(a0[3], ds, bfhi(rw.y)));
                        w.z = cvt_pk_bf16(fmaf(a1[0], ds, bflo(rw.z)), fmaf(a1[1], ds, bfhi(rw.z))); w.w = cvt_pk_bf16(fmaf(a1[2], ds, bflo(rw.w)), fmaf(a1[3], ds, bfhi(rw.w)));
                        *(u32x4*)(wp + bj * HALF) = w; } } }
        }
    }
};

struct Frame {
    LAS unsigned char* lds;
    int tid, lane, wave, G, bid;
    float* out; unsigned char* ws;
};
#define WSP(T, off) ((T*)(F.ws + (off)))

__device__ __forceinline__ void prep_tile(const Frame& F, const float* src, int src_ld, int k0, int kvalid, int c0, int nvalid, bf16_t* dst, int dst_ld, bool il = false, int ksrc = -1, const float* kscale = nullptr, bool one_minus = false, float f8scale = 0.f) {
    const int ks0 = ksrc < 0 ? k0 : ksrc;
    LAS float* tl = (LAS float*)F.lds;
    __syncthreads();
#pragma unroll
    for (int p = 0; p < 2; ++p) { const int kk = (F.tid >> 4) + 32 * p, n4 = (F.tid & 15) * 4;
        f32x4 v = (f32x4){0.f, 0.f, 0.f, 0.f};
        if (il) {
            v = __builtin_nontemporal_load((const f32x4*)(src + (size_t)(ks0 + kk) * src_ld + c0 + ((n4 < 32) ? n4 : 32 + n4))); const int d0 = 2 * (n4 & 31) + (n4 >> 5);
            tl[kk * 65 + d0] = v[0]; tl[kk * 65 + d0 + 2] = v[1]; tl[kk * 65 + d0 + 4] = v[2]; tl[kk * 65 + d0 + 6] = v[3];
        } else {
        if (kk < kvalid && n4 < nvalid) v = __builtin_nontemporal_load((const f32x4*)(src + (size_t)(ks0 + kk) * src_ld + c0 + n4));
        if (kscale) { const float f_ = kscale[ks0 + kk]; v = v * (one_minus ? 1.f - f_ : f_); }
        tl[kk * 65 + n4 + 0] = v[0]; tl[kk * 65 + n4 + 1] = v[1]; tl[kk * 65 + n4 + 2] = v[2]; tl[kk * 65 + n4 + 3] = v[3]; } }
    __syncthreads();
    { const int n = F.tid >> 3, kc = (F.tid & 7) * 8; float x[8];
#pragma unroll
        for (int j = 0; j < 8; ++j) x[j] = tl[(kc + j) * 65 + n];
        if (f8scale != 0.f) { u32x2 w8; w8.x = pk_fp8x4(x[0] * f8scale, x[1] * f8scale, x[2] * f8scale, x[3] * f8scale); w8.y = pk_fp8x4(x[4] * f8scale, x[5] * f8scale, x[6] * f8scale, x[7] * f8scale);
            *(u32x2*)((unsigned char*)dst + (size_t)n * dst_ld + k0 + kc) = w8; }
        else { u32x4 w; w.x = cvt_pk_bf16(x[0], x[1]); w.y = cvt_pk_bf16(x[2], x[3]); w.z = cvt_pk_bf16(x[4], x[5]); w.w = cvt_pk_bf16(x[6], x[7]);
        *(u32x4*)(dst + (size_t)n * dst_ld + k0 + kc) = w; } }
}
__device__ __forceinline__ void phase_prep(const Params& p, const Frame& F, int id_lo, int id_hi, bool tables) {
    bf16_t* wb = WSP(bf16_t, WS_WB);
    constexpr int N0 = 1472, N1 = N0 + 512, N2 = N1 + 1024, N3 = N2 + 256, N4 = N3 + 192, N5 = N4 + 8192, N6 = N5 + 4096;
    (void)N6;
    for (int id = id_lo + F.bid; id < id_hi; id += F.G) {
        if (id < N0) { const int nt = id / 16, kt = id % 16, n0 = nt * 64; int c0, nv;
            if (n0 < PC_Q) { c0 = n0; nv = 64; } else if (n0 < PC_DT) { c0 = n0 + 16; nv = 64; } else if (n0 == PC_DT) { c0 = 2560; nv = 16; } else { c0 = 0; nv = 0; }
            const bool il = (n0 >= PC_Q && n0 < PC_V);
            if (il) c0 = 2576 + ((n0 - PC_Q) >> 7) * 128 + (((n0 - PC_Q) >> 6) & 1) * 32;
            if (F8_INPROJ) prep_tile(F, p.in[4], 5648, kt * 64, 64, c0, nv, (bf16_t*)((unsigned char*)wb + WB_WIN + (size_t)n0 * 1024), 1024, il, -1, nullptr, false, F8_W_SCALE);
            else prep_tile(F, p.in[4], 5648, kt * 64, 64, c0, nv, wb + WB_WIN / 2 + (size_t)n0 * 1024, 1024, il); }
        else if (id < N1) { const int j = id - N0, nt = j / 32, kt = j % 32;
            if (F8_OUTPROJ) prep_tile(F, p.in[11], 1024, kt * 64, 64, nt * 64, 64, (bf16_t*)((unsigned char*)wb + WB_WOUT + (size_t)nt * 64 * 2048), 2048, false, -1, nullptr, false, F8_W_SCALE);
            else prep_tile(F, p.in[11], 1024, kt * 64, 64, nt * 64, 64, wb + WB_WOUT / 2 + (size_t)nt * 64 * 2048, 2048); }
        else if (id < N2) { const int j = id - N1, w = j / 256, r = j % 256, nt = r / 16, kt = r % 16; const float* src = (w == 0) ? p.in[13] : (w == 1) ? p.in[14] : (w == 2) ? p.in[15] : p.in[16];
            if ((w == 3) ? F8_WO : (w != 1 && F8_RV)) prep_tile(F, src, 1024, kt * 64, 64, nt * 64, 64, (bf16_t*)((unsigned char*)wb + WB_WR + (size_t)w * 2097152 + (size_t)nt * 64 * 1024), 1024, false, -1, nullptr, false, F8_W_SCALE);
            else prep_tile(F, src, 1024, kt * 64, 64, nt * 64, 64, wb + WB_WR / 2 + (size_t)w * 1048576 + (size_t)nt * 64 * 1024, 1024); }
        else if (id < N3) { const int j = id - N2, nt = j >> 5, kt = j & 31, half = kt >> 4;
            const float* src = (nt == 0) ? p.in[18] : (nt == 1) ? p.in[21] : p.in[23]; const int ncols = (nt < 2) ? 64 : 160, c0 = (nt < 2) ? 0 : (nt - 2) * 64, midx = (nt == 0) ? 1 : (nt == 1) ? 4 : 5;
            int nv = (nt < 2) ? 64 : ncols - c0; nv = nv < 0 ? 0 : (nv > 64 ? 64 : nv); if (nt > 4) nv = 0;
            prep_tile(F, src, ncols, kt * 64, 64, (nv ? c0 : 0), nv, wb + WB_L1 / 2 + (size_t)nt * 64 * 2048, 2048, false, (kt & 15) * 64, p.in[12] + midx * DM, !half); }
        else if (id < N4) { const int j = id - N3, w = j / 64, r = j % 64, nt = r / 4, kt = r % 4;
            int kv = (w == 0) ? (kt == 0 ? 64 : 0) : (w == 1) ? (kt == 1 ? 64 : 0) : 160 - kt * 64; kv = kv < 0 ? 0 : (kv > 64 ? 64 : kv);
            const float* src = (w == 0) ? p.in[19] : (w == 1) ? p.in[22] : p.in[24];
            prep_tile(F, src, 1024, kt * 64, kv, nt * 64, 64, wb + WB_L2 / 2 + (size_t)w * 262144 + (size_t)nt * 64 * 256, 256, false, (w == 1) ? 0 : kt * 64); }
        else if (id < N5) { const int j = id - N4, le = j / 256, r = j % 256, nt = r / 16, kt = r % 16;
            const int pn = nt >> 2, part = (nt >> 1) & 1, c0 = 128 * pn + 64 * (nt & 1);
            const float* src = (part ? p.in[35] : p.in[34]) + (size_t)le * 524288;
            if (le >= 0) prep_tile(F, src, 512, kt * 64, 64, c0, 64, (bf16_t*)((unsigned char*)wb + WB_W13 + (size_t)le * 2097152 + (size_t)nt * 64 * 1024), 1024, false, -1, nullptr, false, F8_W_SCALE);
            else prep_tile(F, src, 512, kt * 64, 64, c0, 64, wb + WB_W13 / 2 + (size_t)le * 1048576 + (size_t)nt * 64 * 1024, 1024); }
        else { const int j = id - N5, le = j / 128, r = j % 128, nt = r / 8, kt = r % 8;
            if (le >= 0) prep_tile(F, p.in[36] + (size_t)le * 524288, 1024, kt * 64, 64, nt * 64, 64, (bf16_t*)((unsigned char*)wb + WB_W2 + (size_t)le * 1048576 + (size_t)nt * 64 * 512), 512, false, -1, nullptr, false, F8_W_SCALE);
            else prep_tile(F, p.in[36] + (size_t)le * 524288, 1024, kt * 64, 64, nt * 64, 64, wb + WB_W2 / 2 + (size_t)le * 524288 + (size_t)nt * 64 * 512, 512); }
    }
    if (!tables) { __syncthreads(); return; }
    { float* rtw = WSP(float, WS_RTW);
        for (int idx = F.bid * NTHREADS + F.tid; idx < 2 * 20 * 1024; idx += F.G * NTHREADS) { const int l = idx / 20480, r = idx % 20480, j = r >> 10, k = r & 1023;
            rtw[idx] = (j < 4) ? p.in[30][(size_t)l * 4096 + k * 4 + j] : p.in[32][(size_t)l * 16384 + k * 16 + (j - 4)]; } }
    f32x2* rope = WSP(f32x2, WS_ROPE);
    for (int idx = F.bid * NTHREADS + F.tid; idx < SEQ * 64; idx += F.G * NTHREADS) {
        const int pos = idx >> 6, i = idx & 63;
        const float invf = exp2f(-(float)i * (13.287712379549449f / 64.f));
        const float ang = (float)pos * invf;
        const double x = (double)ang;
        const double kq = rint(x * 0.63661977236758134308);
        double r = fma(-kq, 1.57079632679489655800e+00, x); r = fma(-kq, 6.12323399573676603587e-17, r);
        const double r2 = r * r;
        double sp = -7.6471637318198164759e-13; sp = fma(sp, r2, 1.6059043836821614599e-10); sp = fma(sp, r2, -2.5052108385441718775e-08); sp = fma(sp, r2, 2.7557319223985890653e-06);
        sp = fma(sp, r2, -1.9841269841269841270e-04); sp = fma(sp, r2, 8.3333333333333333333e-03); sp = fma(sp, r2, -1.6666666666666666667e-01); const double sn = fma(sp * r2, r, r);
        double cp = 4.7794773323873852974e-14; cp = fma(cp, r2, -1.1470745597729724714e-11); cp = fma(cp, r2, 2.0876756987868098979e-09); cp = fma(cp, r2, -2.7557319223985890653e-07);
        cp = fma(cp, r2, 2.4801587301587301587e-05); cp = fma(cp, r2, -1.3888888888888888889e-03); cp = fma(cp, r2, 4.1666666666666666667e-02); cp = fma(cp, r2, -0.5); const double cs = fma(cp, r2, 1.0);
        const int q = ((int)kq) & 3;
        const double c = (q == 0) ? cs : (q == 1) ? -sn : (q == 2) ? -cs : sn;
        const double s = (q == 0) ? sn : (q == 1) ? cs : (q == 2) ? -sn : -cs;
        rope[idx] = (f32x2){(float)c, (float)s};
    }
}

__device__ __forceinline__ void row_load(const float* row, int lane, f32x4 (&v)[4]) {
#pragma unroll
    for (int j = 0; j < 4; ++j) v[j] = *(const f32x4*)(row + j * 256 + lane * 4);
}
__device__ __forceinline__ void row_load_nt(const float* row, int lane, f32x4 (&v)[4]) {
#pragma unroll
    for (int j = 0; j < 4; ++j) v[j] = __builtin_nontemporal_load((const f32x4*)(row + j * 256 + lane * 4));
}
__device__ __forceinline__ void row_load_bf_nt(const bf16_t* row, int lane, f32x4 (&v)[4]) {
#pragma unroll
    for (int j = 0; j < 4; ++j) { const u32x2 w = __builtin_nontemporal_load((const u32x2*)(row + j * 256 + lane * 4)); v[j] = (f32x4){bflo(w.x), bfhi(w.x), bflo(w.y), bfhi(w.y)}; }
}
__device__ __forceinline__ void row_load_bf(const bf16_t* row, int lane, f32x4 (&v)[4]) {
#pragma unroll
    for (int j = 0; j < 4; ++j) { const u32x2 w = *(const u32x2*)(row + j * 256 + lane * 4); v[j] = (f32x4){bflo(w.x), bfhi(w.x), bflo(w.y), bfhi(w.y)}; }
}
__device__ __forceinline__ float row_rstd(const f32x4 (&v)[4], float eps) {
    float ss = 0.f;
#pragma unroll
    for (int j = 0; j < 4; ++j) ss += v[j][0] * v[j][0] + v[j][1] * v[j][1] + v[j][2] * v[j][2] + v[j][3] * v[j][3];
    ss = wave_sum_u(ss);
    return rsqrtf(ss * (1.f / 1024.f) + eps);
}
__device__ __forceinline__ void row_store_bf16(bf16_t* row, int lane, const f32x4 (&v)[4]) {
#pragma unroll
    for (int j = 0; j < 4; ++j) { u32x2 w; w.x = cvt_pk_bf16(v[j][0], v[j][1]); w.y = cvt_pk_bf16(v[j][2], v[j][3]); *(u32x2*)(row + j * 256 + lane * 4) = w; }
}

__device__ __forceinline__ void row_store_fp8(unsigned char* row, int lane, const f32x4 (&v)[4]) {
#pragma unroll
    for (int j = 0; j < 4; ++j) *(unsigned*)(row + j * 256 + lane * 4) = pk_fp8x4(v[j][0] * F8_ACT_SCALE, v[j][1] * F8_ACT_SCALE, v[j][2] * F8_ACT_SCALE, v[j][3] * F8_ACT_SCALE);
}
template <int TO_BF16, bool SRC_BF16 = false>
__device__ __forceinline__ void phase_rmsnorm(const Params& p, const Frame& F, const void* src_, const float* w, void* dst) {
    const float* src = (const float*)src_; const bf16_t* srcb = (const bf16_t*)src_; (void)src; (void)srcb;
    f32x4 wv[4]; row_load(w, F.lane, wv);
    int row = F.bid * 8 + F.wave; const int stride = F.G * 8;
    f32x4 v[4], vn[4];
    if (row < T_TOK) { if constexpr (SRC_BF16) row_load_bf_nt(srcb + (size_t)row * DM, F.lane, v); else row_load_nt(src + (size_t)row * DM, F.lane, v); }
    for (; row < T_TOK; row += stride) {
        if (row + stride < T_TOK) { if constexpr (SRC_BF16) row_load_bf_nt(srcb + (size_t)(row + stride) * DM, F.lane, vn); else row_load_nt(src + (size_t)(row + stride) * DM, F.lane, vn); }
        const float rs = row_rstd(v, 1e-6f);
#pragma unroll
        for (int j = 0; j < 4; ++j) v[j] = v[j] * rs * wv[j];
        if constexpr (TO_BF16 == 2) row_store_fp8((unsigned char*)dst + (size_t)row * DM, F.lane, v);
        else if constexpr (TO_BF16 == 1) row_store_bf16((bf16_t*)dst + (size_t)row * DM, F.lane, v);
        else {
#pragma unroll
            for (int j = 0; j < 4; ++j) *(f32x4*)((float*)dst + (size_t)row * DM + j * 256 + F.lane * 4) = v[j];
        }
#pragma unroll
        for (int j = 0; j < 4; ++j) v[j] = vn[j];
    }
}

__device__ __forceinline__ void phase_conv(const Params& p, const Frame& F) {
    bf16_t* proj = WSP(bf16_t, WS_SLAB);
    bf16_t* xc = (bf16_t*)F.out;
    const float* conv_w = p.in[5]; const float* conv_b = p.in[6];
    for (int item = F.bid * 8 + F.wave; item < (T_TOK / 32) * 3; item += F.G * 8) {
        const int run = item / 3, cb = item - run * 3, c0 = cb * 512 + F.lane * 8, t0 = run * 32;
        float w[4][8], bb[8], xm3[8], xm2[8], xm1[8];
#pragma unroll
        for (int j = 0; j < 4; ++j) { const f32x4 a0 = *(const f32x4*)(conv_w + j * 1536 + c0), a1 = *(const f32x4*)(conv_w + j * 1536 + c0 + 4);
#pragma unroll
            for (int e = 0; e < 4; ++e) { w[j][e] = a0[e]; w[j][4 + e] = a1[e]; } }
        { const f32x4 a0 = *(const f32x4*)(conv_b + c0), a1 = *(const f32x4*)(conv_b + c0 + 4);
#pragma unroll
            for (int e = 0; e < 4; ++e) { bb[e] = a0[e]; bb[4 + e] = a1[e]; } }
        const bool first = (t0 & (SEQ - 1)) == 0;
        { u32x4 r3 = (u32x4){0u, 0u, 0u, 0u}, r2 = r3, r1 = r3;
            if (!first) { r3 = __builtin_nontemporal_load((const u32x4*)(proj + (size_t)(t0 - 3) * NPROJ + PC_XBC + c0)); r2 = __builtin_nontemporal_load((const u32x4*)(proj + (size_t)(t0 - 2) * NPROJ + PC_XBC + c0)); r1 = __builtin_nontemporal_load((const u32x4*)(proj + (size_t)(t0 - 1) * NPROJ + PC_XBC + c0)); }
            xm3[0] = bflo(r3.x); xm3[1] = bfhi(r3.x); xm3[2] = bflo(r3.y); xm3[3] = bfhi(r3.y); xm3[4] = bflo(r3.z); xm3[5] = bfhi(r3.z); xm3[6] = bflo(r3.w); xm3[7] = bfhi(r3.w);
            xm2[0] = bflo(r2.x); xm2[1] = bfhi(r2.x); xm2[2] = bflo(r2.y); xm2[3] = bfhi(r2.y); xm2[4] = bflo(r2.z); xm2[5] = bfhi(r2.z); xm2[6] = bflo(r2.w); xm2[7] = bfhi(r2.w);
            xm1[0] = bflo(r1.x); xm1[1] = bfhi(r1.x); xm1[2] = bflo(r1.y); xm1[3] = bfhi(r1.y); xm1[4] = bflo(r1.z); xm1[5] = bfhi(r1.z); xm1[6] = bflo(r1.w); xm1[7] = bfhi(r1.w); }
#pragma unroll 4
        for (int tt = 0; tt < 32; ++tt) {
            const u32x4 r = __builtin_nontemporal_load((const u32x4*)(proj + (size_t)(t0 + tt) * NPROJ + PC_XBC + c0));
            const float x[8] = {bflo(r.x), bfhi(r.x), bflo(r.y), bfhi(r.y), bflo(r.z), bfhi(r.z), bflo(r.w), bfhi(r.w)};
            float o[8];
#pragma unroll
            for (int e = 0; e < 8; ++e) { o[e] = fsilu(bb[e] + w[0][e] * xm3[e] + w[1][e] * xm2[e] + w[2][e] * xm1[e] + w[3][e] * x[e]); xm3[e] = xm2[e]; xm2[e] = xm1[e]; xm1[e] = x[e]; }
            u32x4 ow; ow.x = cvt_pk_bf16(o[0], o[1]); ow.y = cvt_pk_bf16(o[2], o[3]); ow.z = cvt_pk_bf16(o[4], o[5]); ow.w = cvt_pk_bf16(o[6], o[7]);
            *(u32x4*)(xc + (size_t)(t0 + tt) * 1536 + c0) = ow;
        }
    }
}

typedef float f32x16 __attribute__((ext_vector_type(16)));
typedef short s16x4 __attribute__((ext_vector_type(4)));
#define MFMA32(a, b, c) __builtin_amdgcn_mfma_f32_32x32x16_bf16((a), (b), (c), 0, 0, 0)
__device__ __forceinline__ unsigned off_b(unsigned row, unsigned ch) { return 256u * row + 16u * (ch ^ (((row & 3u) << 2) | ((row >> 2) & 3u))); }
__device__ __forceinline__ unsigned off_v(unsigned row, unsigned ch) { return 128u * row + 16u * (ch ^ (((row >> 1) & 1u) << 2)); }
__device__ __forceinline__ unsigned off_y(unsigned row, unsigned ch) { return 128u * row + 16u * (ch ^ (row & 7u)); }
__device__ __forceinline__ bf16x8 tr_read2(unsigned a0, unsigned a1) {
    s16x4 lo, hi;
    asm volatile("ds_read_b64_tr_b16 %0, %2\n\tds_read_b64_tr_b16 %1, %3\n\ts_waitcnt lgkmcnt(0)" : "=&v"(lo), "=&v"(hi) : "v"(a0), "v"(a1) : "memory");
    return __builtin_shufflevector(lo, hi, 0, 1, 2, 3, 4, 5, 6, 7);
}
__device__ __forceinline__ void tr_read4(unsigned a0, unsigned a1, unsigned a2, unsigned a3, bf16x8& f0, bf16x8& f1) {
    s16x4 r0, r1, r2, r3;
    asm volatile("ds_read_b64_tr_b16 %0, %4\n\tds_read_b64_tr_b16 %1, %5\n\tds_read_b64_tr_b16 %2, %6\n\tds_read_b64_tr_b16 %3, %7\n\ts_waitcnt lgkmcnt(0)"
                 : "=&v"(r0), "=&v"(r1), "=&v"(r2), "=&v"(r3) : "v"(a0), "v"(a1), "v"(a2), "v"(a3) : "memory");
    f0 = __builtin_shufflevector(r0, r1, 0, 1, 2, 3, 4, 5, 6, 7); f1 = __builtin_shufflevector(r2, r3, 0, 1, 2, 3, 4, 5, 6, 7);
}
__device__ __forceinline__ void tr_read8(unsigned a0, unsigned a1, unsigned a2, unsigned a3, unsigned a4, unsigned a5, unsigned a6, unsigned a7, bf16x8& f0, bf16x8& f1, bf16x8& f2, bf16x8& f3) {
    s16x4 r0, r1, r2, r3, r4, r5, r6, r7;
    asm volatile("ds_read_b64_tr_b16 %0, %8\n\tds_read_b64_tr_b16 %1, %9\n\tds_read_b64_tr_b16 %2, %10\n\tds_read_b64_tr_b16 %3, %11\n\tds_read_b64_tr_b16 %4, %12\n\tds_read_b64_tr_b16 %5, %13\n\tds_read_b64_tr_b16 %6, %14\n\tds_read_b64_tr_b16 %7, %15\n\ts_waitcnt lgkmcnt(0)"
                 : "=&v"(r0), "=&v"(r1), "=&v"(r2), "=&v"(r3), "=&v"(r4), "=&v"(r5), "=&v"(r6), "=&v"(r7) : "v"(a0), "v"(a1), "v"(a2), "v"(a3), "v"(a4), "v"(a5), "v"(a6), "v"(a7) : "memory");
    f0 = __builtin_shufflevector(r0, r1, 0, 1, 2, 3, 4, 5, 6, 7); f1 = __builtin_shufflevector(r2, r3, 0, 1, 2, 3, 4, 5, 6, 7);
    f2 = __builtin_shufflevector(r4, r5, 0, 1, 2, 3, 4, 5, 6, 7); f3 = __builtin_shufflevector(r6, r7, 0, 1, 2, 3, 4, 5, 6, 7);
}
__device__ __forceinline__ f32x16 zero16() { f32x16 z;
#pragma unroll
    for (int i = 0; i < 16; ++i) z[i] = 0.f;
    return z; }
__device__ __forceinline__ void phase_scan0(const Params& p, const Frame& F) {
    bf16_t* proj = WSP(bf16_t, WS_SLAB);
    const bf16_t* xc = (const bf16_t*)F.out;
    constexpr unsigned OQ = 0, OK = 32768, OV = 65536, OVW = 81920, OS = 98304, OY = 114688, OSM = 131072;
    LAS unsigned char* L = F.lds;
    const unsigned lbase = (unsigned)(__UINTPTR_TYPE__)L;
    LAS float* sm = (LAS float*)(L + OSM);
    const int lane = F.lane, w = F.wave, it = w >> 1, pt = w & 1;
    const unsigned h0 = lane >> 5, lr0 = lane & 31;
    const int trow = F.tid >> 2, tpart = F.tid & 3;
    const unsigned blk0 = (lane >> 4) & 1u, tq0 = (lane & 15u) >> 2, tp0 = lane & 3u;
    for (int ui = 0; ui < 2; ++ui) {
        const int uu = F.bid + ui * F.G;
        if (uu >= 512) break;
        const bool is_ssd = uu < 256; const int v = uu & 255, x8 = v & 7, slot = v >> 3;
        int b, hh, grp = 0, hr = 0, sl = 0;
        if (is_ssd) { const int pg = x8 + 8 * (slot >> 3), hg = slot & 7; b = pg >> 1; grp = pg & 1; hh = grp * 8 + hg; }
        else { const int pr = x8 + 8 * (slot >> 2); sl = slot & 3; b = pr >> 2; hr = pr & 3; hh = hr * 4 + sl; }
        const size_t row0 = (size_t)b * SEQ;
        const bf16_t* qptr; const bf16_t* kptr; const bf16_t* vptr; size_t qs, vs; bf16_t* optr;
        if (is_ssd) { qptr = xc + 1280 + grp * 128; kptr = xc + 1024 + grp * 128; vptr = xc + hh * 64; qs = 1536; vs = 1536; optr = proj + hh * 64; }
        else { qptr = proj + PC_Q + hr * 128; kptr = proj + PC_K + hr * 128; vptr = proj + PC_V + hr * 256 + sl * 64; qs = NPROJ; vs = NPROJ; optr = proj + 1024 + hr * 256 + sl * 64; }
        const bf16_t* zptr = proj + hh * 64;
        const float A_h = is_ssd ? -__expf(p.in[8][hh]) : 0.f, dtb = is_ssd ? p.in[7][hh] : 0.f, D_h = is_ssd ? p.in[9][hh] : 0.f;
        const float lng = __logf(1.f - exp2f(-5.f - (float)hr));
        u32x4 rv[2], rz[2]; float rdt0 = 0.f, rdt1 = 0.f;
        f32x16 St0 = zero16(), St1 = zero16();
        __syncthreads();
        for (int i = F.tid; i < 16384 / 16; i += NTHREADS) *(LAS u32x4*)(L + OS + i * 16) = (u32x4){0u, 0u, 0u, 0u};
#define SC_LOAD(c) do { const size_t r_ = row0 + (size_t)(c) * 128 + trow; \
            _Pragma("unroll") for (int e = 0; e < 2; ++e) rv[e] = *(const u32x4*)(vptr + r_ * vs + tpart * 16 + e * 8); \
            if (is_ssd && w == 0) { rdt0 = bf2f(proj[(row0 + (size_t)(c) * 128 + 2 * lane) * NPROJ + PC_DT + hh]); rdt1 = bf2f(proj[(row0 + (size_t)(c) * 128 + 2 * lane + 1) * NPROJ + PC_DT + hh]); } } while (0)
#define SC_DMA(c) do { _Pragma("unroll") for (int e = 0; e < 4; ++e) { const int I_ = w * 4 + e; const unsigned r_ = 4u * I_ + ((unsigned)lane >> 4), cs_ = lane & 15u, ch_ = cs_ ^ (((r_ & 3u) << 2) | ((r_ >> 2) & 3u)); \
            const size_t g_ = (row0 + (size_t)(c) * 128 + r_) * qs + ch_ * 8; \
            __builtin_amdgcn_global_load_lds((const unsigned*)(qptr + g_), (LAS unsigned*)(L + OQ + I_ * 1024), 16, 0, 0); \
            __builtin_amdgcn_global_load_lds((const unsigned*)(kptr + g_), (LAS unsigned*)(L + OK + I_ * 1024), 16, 0, 0); } } while (0)
#define SC_LOADZ(c) do { if (is_ssd) { const size_t r_ = row0 + (size_t)(c) * 128 + trow; rz[0] = __builtin_nontemporal_load((const u32x4*)(zptr + r_ * NPROJ + tpart * 16)); rz[1] = __builtin_nontemporal_load((const u32x4*)(zptr + r_ * NPROJ + tpart * 16 + 8)); } } while (0)
#define SC_SMALL(c) do { if (w == 0) { LAS float* sb = sm + ((c) & 1) * 384; float d0, d1, a0, a1; \
            if (is_ssd) { d0 = fsoftplus(rdt0 + dtb); d1 = fsoftplus(rdt1 + dtb); a0 = d0 * A_h; a1 = d1 * A_h; } else { d0 = 1.f; d1 = 1.f; a0 = lng; a1 = lng; } \
            float sc = a0 + a1; _Pragma("unroll") for (int o = 1; o < 64; o <<= 1) { const float tv = __shfl_up(sc, o); if (lane >= o) sc += tv; } \
            const float c1 = sc, c0 = sc - a1; const float tot = __shfl(sc, 63); \
            sb[2 * lane] = c0; sb[2 * lane + 1] = c1; sb[128 + 2 * lane] = d0; sb[128 + 2 * lane + 1] = d1; sb[256 + 2 * lane] = __expf(tot - c0) * d0; sb[256 + 2 * lane + 1] = __expf(tot - c1) * d1; } } while (0)
#define SC_STORE(c) do { const float wj_ = sm[((c) & 1) * 384 + 256 + trow]; \
            _Pragma("unroll") for (int e = 0; e < 2; ++e) { const u32x4 x_ = rv[e]; *(LAS u32x4*)(L + OV + off_v(trow, tpart * 2 + e)) = x_; u32x4 y_; \
                y_.x = cvt_pk_bf16(bflo(x_.x) * wj_, bfhi(x_.x) * wj_); y_.y = cvt_pk_bf16(bflo(x_.y) * wj_, bfhi(x_.y) * wj_); y_.z = cvt_pk_bf16(bflo(x_.z) * wj_, bfhi(x_.z) * wj_); y_.w = cvt_pk_bf16(bflo(x_.w) * wj_, bfhi(x_.w) * wj_); \
                *(LAS u32x4*)(L + OVW + off_v(trow, tpart * 2 + e)) = y_; } } while (0)
        SC_DMA(0); SC_LOAD(0);
        SC_SMALL(0);
        __syncthreads();
        SC_STORE(0);
        asm volatile("s_waitcnt vmcnt(0)" ::: "memory");
        __syncthreads();
        SP_DECL;
        for (int c = 0; c < SEQ / 128; ++c) {
            SP_MARK(8);
            const LAS float* sb = sm + (c & 1) * 384;
            unsigned lr = lr0, h = h0, blk = blk0, tq_ = tq0, tp_ = tp0;
            asm volatile("" : "+v"(lr), "+v"(h), "+v"(blk), "+v"(tq_), "+v"(tp_));
            if (c + 1 < SEQ / 128) { SC_LOAD(c + 1); }
            SC_LOADZ(c);
            const int ph = pt;
            const float ai = sb[32 * it + lr];
            f32x16 Yd0 = zero16(), Yd1 = zero16();
            for (int jt = ph; jt <= it; jt += 2) {
                f32x16 acc = zero16();
#pragma unroll
                for (int ks = 0; ks < 8; ++ks) { const bf16x8 ka = *(const LAS bf16x8*)(L + OK + off_b(32 * jt + lr, 2 * ks + h)), qb = *(const LAS bf16x8*)(L + OQ + off_b(32 * it + lr, 2 * ks + h)); acc = MFMA32(ka, qb, acc); }
                const bool diag = (jt == it);
#pragma unroll
                for (int g = 0; g < 4; ++g) { const f32x4 aj = *(const LAS f32x4*)(sb + 32 * jt + 8 * g + 4 * h), dj = *(const LAS f32x4*)(sb + 128 + 32 * jt + 8 * g + 4 * h);
#pragma unroll
                    for (int e = 0; e < 4; ++e) { const float dec = __expf(ai - aj[e]) * dj[e]; const bool ok = !diag || ((int)lr >= (int)(8 * g + 4 * h + e)); acc[4 * g + e] = ok ? acc[4 * g + e] * dec : 0.f; } }
#pragma unroll
                for (int s2 = 0; s2 < 2; ++s2) {
                    u32x4 pw; pw.x = cvt_pk_bf16(acc[8 * s2 + 0], acc[8 * s2 + 1]); pw.y = cvt_pk_bf16(acc[8 * s2 + 2], acc[8 * s2 + 3]); pw.z = cvt_pk_bf16(acc[8 * s2 + 4], acc[8 * s2 + 5]); pw.w = cvt_pk_bf16(acc[8 * s2 + 6], acc[8 * s2 + 7]);
                    const bf16x8 Pb = __builtin_bit_cast(bf16x8, pw);
                    const unsigned rb0 = 32 * jt + 16 * s2 + 4 * h + tq_, cc0 = 2 * blk + (tp_ >> 1), o8 = 8 * (tp_ & 1);
                    bf16x8 va0, va1;
                    tr_read4(lbase + OV + off_v(rb0, cc0) + o8, lbase + OV + off_v(rb0 + 8, cc0) + o8, lbase + OV + off_v(rb0, 4 + cc0) + o8, lbase + OV + off_v(rb0 + 8, 4 + cc0) + o8, va0, va1);
                    Yd0 = MFMA32(va0, Pb, Yd0); Yd1 = MFMA32(va1, Pb, Yd1);
                }
            }
            {
                f32x16 Yo = zero16();
#pragma unroll
                for (int ks = 0; ks < 8; ++ks) { const bf16x8 sa = *(const LAS bf16x8*)(L + OS + off_b(32 * ph + lr, 2 * ks + h)), qb = *(const LAS bf16x8*)(L + OQ + off_b(32 * it + lr, 2 * ks + h)); Yo = MFMA32(sa, qb, Yo); }
                const float ei = __expf(ai);
                if (ph == 0) {
#pragma unroll
                    for (int r = 0; r < 16; ++r) Yd0[r] += Yo[r] * ei; }
                else {
#pragma unroll
                    for (int r = 0; r < 16; ++r) Yd1[r] += Yo[r] * ei; }
            }
#pragma unroll
            for (int g = 0; g < 4; ++g) { u32x2 yw;
                if (ph == 0) { yw.x = cvt_pk_bf16(Yd1[4 * g], Yd1[4 * g + 1]); yw.y = cvt_pk_bf16(Yd1[4 * g + 2], Yd1[4 * g + 3]); } else { yw.x = cvt_pk_bf16(Yd0[4 * g], Yd0[4 * g + 1]); yw.y = cvt_pk_bf16(Yd0[4 * g + 2], Yd0[4 * g + 3]); }
                *(LAS u32x2*)(L + OY + off_y(32 * it + lr, 4 * (1 - ph) + g) + 8 * h) = yw; }
            const float dl = __expf(sb[127]);
            const int st0 = (w == 0) ? 0 : (w == 1) ? 2 : (w == 2) ? 4 : (w == 3) ? 5 : (w == 5) ? 6 : -1, st1 = (w == 0) ? 1 : (w == 1) ? 3 : (w == 5) ? 7 : -1;
            if (st0 >= 0) {
                const int spt = st0 & 1, snt = st0 >> 1;
#pragma unroll
                for (int r = 0; r < 16; ++r) St0[r] *= dl;
#pragma unroll
                for (int k2 = 0; k2 < 4; ++k2) { const unsigned rb = 32 * k2 + 8 * h + tq_, cv = 4 * spt + 2 * blk + (tp_ >> 1), cb = 4 * snt + 2 * blk + (tp_ >> 1), o8 = 8 * (tp_ & 1);
                    bf16x8 fa0, fb0, fa1, fb1;
                    tr_read8(lbase + OVW + off_v(rb, cv) + o8, lbase + OVW + off_v(rb + 4, cv) + o8, lbase + OK + off_b(rb, cb) + o8, lbase + OK + off_b(rb + 4, cb) + o8,
                             lbase + OVW + off_v(rb + 16, cv) + o8, lbase + OVW + off_v(rb + 20, cv) + o8, lbase + OK + off_b(rb + 16, cb) + o8, lbase + OK + off_b(rb + 20, cb) + o8, fa0, fb0, fa1, fb1);
                    St0 = MFMA32(fa0, fb0, St0); St0 = MFMA32(fa1, fb1, St0); }
                if (st1 >= 0) {
                    const int spt1 = st1 & 1, snt1 = st1 >> 1;
#pragma unroll
                    for (int r = 0; r < 16; ++r) St1[r] *= dl;
#pragma unroll
                    for (int k2 = 0; k2 < 4; ++k2) { const unsigned rb = 32 * k2 + 8 * h + tq_, cv = 4 * spt1 + 2 * blk + (tp_ >> 1), cb = 4 * snt1 + 2 * blk + (tp_ >> 1), o8 = 8 * (tp_ & 1);
                        bf16x8 fa0, fb0, fa1, fb1;
                        tr_read8(lbase + OVW + off_v(rb, cv) + o8, lbase + OVW + off_v(rb + 4, cv) + o8, lbase + OK + off_b(rb, cb) + o8, lbase + OK + off_b(rb + 4, cb) + o8,
                                 lbase + OVW + off_v(rb + 16, cv) + o8, lbase + OVW + off_v(rb + 20, cv) + o8, lbase + OK + off_b(rb + 16, cb) + o8, lbase + OK + off_b(rb + 20, cb) + o8, fa0, fb0, fa1, fb1);
                        St1 = MFMA32(fa0, fb0, St1); St1 = MFMA32(fa1, fb1, St1); }
                }
            }
            if (c + 1 < SEQ / 128) SC_SMALL(c + 1);
            LDS_BAR();
#pragma unroll
            for (int g = 0; g < 4; ++g) { LAS u32x2* yp = (LAS u32x2*)(L + OY + off_y(32 * it + lr, 4 * ph + g) + 8 * h); const u32x2 pv_ = *yp; u32x2 yw;
                if (ph == 0) { yw.x = cvt_pk_bf16(Yd0[4 * g] + bflo(pv_.x), Yd0[4 * g + 1] + bfhi(pv_.x)); yw.y = cvt_pk_bf16(Yd0[4 * g + 2] + bflo(pv_.y), Yd0[4 * g + 3] + bfhi(pv_.y)); }
                else { yw.x = cvt_pk_bf16(Yd1[4 * g] + bflo(pv_.x), Yd1[4 * g + 1] + bfhi(pv_.x)); yw.y = cvt_pk_bf16(Yd1[4 * g + 2] + bflo(pv_.y), Yd1[4 * g + 3] + bfhi(pv_.y)); }
                *yp = yw; }
            LDS_BAR();
            SP_MARK(5);
            if (c + 1 < SEQ / 128) SC_DMA(c + 1);
            if (st0 >= 0) {
                const int spt = st0 & 1, snt = st0 >> 1;
#pragma unroll
                for (int r = 0; r < 16; ++r) { const unsigned pr = 32 * spt + (r & 3) + 8 * (r >> 2) + 4 * h, n = 32 * snt + lr; *(LAS bf16_t*)(L + OS + off_b(pr, n >> 3) + 2 * (n & 7)) = f2bf(St0[r]); }
                if (st1 >= 0) { const int spt1 = st1 & 1, snt1 = st1 >> 1;
#pragma unroll
                    for (int r = 0; r < 16; ++r) { const unsigned pr = 32 * spt1 + (r & 3) + 8 * (r >> 2) + 4 * h, n = 32 * snt1 + lr; *(LAS bf16_t*)(L + OS + off_b(pr, n >> 3) + 2 * (n & 7)) = f2bf(St1[r]); }
                }
            }
            {
                bf16_t* orow = optr + (row0 + (size_t)c * 128 + trow) * NPROJ + tpart * 16;
#pragma unroll
                for (int e = 0; e < 2; ++e) {
                    const u32x4 yv = *(const LAS u32x4*)(L + OY + off_y(trow, tpart * 2 + e));
                    u32x4 ov = yv;
                    if (is_ssd) { const u32x4 xv = *(const LAS u32x4*)(L + OV + off_v(trow, tpart * 2 + e)); const u32x4 zv = rz[e];
                        ov.x = cvt_pk_bf16((bflo(yv.x) + bflo(xv.x) * D_h) * fsilu(bflo(zv.x)), (bfhi(yv.x) + bfhi(xv.x) * D_h) * fsilu(bfhi(zv.x)));
                        ov.y = cvt_pk_bf16((bflo(yv.y) + bflo(xv.y) * D_h) * fsilu(bflo(zv.y)), (bfhi(yv.y) + bfhi(xv.y) * D_h) * fsilu(bfhi(zv.y)));
                        ov.z = cvt_pk_bf16((bflo(yv.z) + bflo(xv.z) * D_h) * fsilu(bflo(zv.z)), (bfhi(yv.z) + bfhi(xv.z) * D_h) * fsilu(bfhi(zv.z)));
                        ov.w = cvt_pk_bf16((bflo(yv.w) + bflo(xv.w) * D_h) * fsilu(bflo(zv.w)), (bfhi(yv.w) + bfhi(xv.w) * D_h) * fsilu(bfhi(zv.w))); }
                    *(u32x4*)(orow + e * 8) = ov;
                }
            }
            LDS_BAR();
            SP_MARK(6);
            if (c + 1 < SEQ / 128) SC_STORE(c + 1);
            asm volatile("s_waitcnt vmcnt(0)" ::: "memory");
            LDS_BAR();
            SP_MARK(7);
        }
#undef SC_LOAD
#undef SC_LOADZ
#undef SC_SMALL
#undef SC_STORE
    }
}

__device__ __forceinline__ void phase_gatenorm(const Params& p, const Frame& F) {
    const bf16_t* proj = WSP(bf16_t, WS_SLAB);
    bf16_t* ybuf = WSP(bf16_t, WS_SLAB);
    const float* nw = p.in[10];
    int row = F.bid * 8 + F.wave; const int stride = F.G * 8;
    u32x4 yc[4], gc[2], yn[4], gn[2];
#define GN_LOAD(r_, Y_, G_) do { const bf16_t* b_ = ybuf + (size_t)(r_) * NPROJ; _Pragma("unroll") for (int j = 0; j < 4; ++j) Y_[j] = *(const u32x4*)(b_ + j * 512 + F.lane * 8); \
        _Pragma("unroll") for (int j = 0; j < 2; ++j) G_[j] = __builtin_nontemporal_load((const u32x4*)(b_ + PC_G + j * 512 + F.lane * 8)); } while (0)
    if (row < T_TOK) GN_LOAD(row, yc, gc);
    for (; row < T_TOK; row += stride) {
        if (row + stride < T_TOK) GN_LOAD(row + stride, yn, gn);
        bf16_t* yr = ybuf + (size_t)row * NPROJ;
#pragma unroll
        for (int j = 0; j < 4; ++j) {
            const u32x4 w = yc[j];
            float x[8] = {bflo(w.x), bfhi(w.x), bflo(w.y), bfhi(w.y), bflo(w.z), bfhi(w.z), bflo(w.w), bfhi(w.w)};
            float ss = 0.f;
#pragma unroll
            for (int e = 0; e < 8; ++e) ss += x[e] * x[e];
            if (j < 2) { ss = wave_sum_u(ss); const float rs = rsqrtf(ss * (1.f / 512.f) + 1e-5f);
                const f32x4 w0 = *(const f32x4*)(nw + j * 512 + F.lane * 8), w1 = *(const f32x4*)(nw + j * 512 + F.lane * 8 + 4);
#pragma unroll
                for (int e = 0; e < 4; ++e) { x[e] *= rs * w0[e]; x[4 + e] *= rs * w1[e]; } }
            else {
                ss = dpp_sum16(ss); ss += __shfl_xor(ss, 16);
                const float rs = rsqrtf(ss * (1.f / 256.f) + 1e-6f);
                const u32x4 gw = gc[j - 2];
                const float g[8] = {bflo(gw.x), bfhi(gw.x), bflo(gw.y), bfhi(gw.y), bflo(gw.z), bfhi(gw.z), bflo(gw.w), bfhi(gw.w)};
#pragma unroll
                for (int e = 0; e < 8; ++e) x[e] *= rs * fsilu(g[e]); }
            if (F8_OUTPROJ) { u32x2 o8; o8.x = pk_fp8x4(x[0] * F8_ACT_SCALE, x[1] * F8_ACT_SCALE, x[2] * F8_ACT_SCALE, x[3] * F8_ACT_SCALE); o8.y = pk_fp8x4(x[4] * F8_ACT_SCALE, x[5] * F8_ACT_SCALE, x[6] * F8_ACT_SCALE, x[7] * F8_ACT_SCALE);
                *(u32x2*)((unsigned char*)yr + j * 512 + F.lane * 8) = o8; }
            else { u32x4 o; o.x = cvt_pk_bf16(x[0], x[1]); o.y = cvt_pk_bf16(x[2], x[3]); o.z = cvt_pk_bf16(x[4], x[5]); o.w = cvt_pk_bf16(x[6], x[7]);
            *(u32x4*)(yr + j * 512 + F.lane * 8) = o; }
        }
#pragma unroll
        for (int j = 0; j < 4; ++j) yc[j] = yn[j];
        gc[0] = gn[0]; gc[1] = gn[1];
    }
#undef GN_LOAD
}

__device__ __forceinline__ void phase_moe_route(const Params& p, const Frame& F, int layer, const bf16_t* h, bf16_t* tbuf) {
    unsigned char* meta = F.ws + WS_META + (size_t)layer * META_STRIDE;
    int* tok_rank = (int*)(meta + MT_RANK); int* tok_bkt = (int*)(meta + MT_BKT); f32x2* tok_c = (f32x2*)(meta + MT_C);
    int* gcount = (int*)(F.ws + WS_CTL + CTL_CNT_OFF) + layer * 32;
    const float* bg = p.in[31] + layer * 4; const float* be = p.in[33] + layer * 16;
    LAS float* wl = (LAS float*)F.lds;
    LAS int* lcount = (LAS int*)(F.lds + 81920);
    LAS int* lbase = lcount + 32;
    LAS int* l_bkt = lbase + 32;
    LAS int* l_rank = l_bkt + 1024;
    LAS float* l_c = (LAS float*)(l_rank + 1024);
    LAS float* lgt = (LAS float*)(F.lds + 98816);
    __syncthreads();
    { const float* wrt = WSP(float, WS_RTW) + (size_t)layer * 20480;
        for (int idx = F.tid; idx < 20 * 1024 / 4; idx += NTHREADS) *(LAS f32x4*)(wl + idx * 4) = *(const f32x4*)(wrt + idx * 4); }
    if (F.tid < 32) lcount[F.tid] = 0;
    __syncthreads();
    const int TPB = (T_TOK + F.G - 1) / F.G, tok0 = F.bid * TPB;
    f32x4 wv[4]; row_load(p.in[2] + (size_t)layer * DM, F.lane, wv);
    f32x4 va[4], vb[4], na[4], nb[4];
    int hsel;
    { unsigned t0_ = 0u, t1_ = 1u; asm volatile("s_nop 1\n\tv_permlane32_swap_b32 %0, %1\n\ts_nop 1" : "+v"(t0_), "+v"(t1_)); hsel = (t0_ + t1_ >= 2u) ? 10 : 0; }
#define RT_LOAD(li_, A_, B_) do { const int ta_ = tok0 + (li_), tb_ = ta_ + 8; \
        if ((li_) < TPB && ta_ < T_TOK) row_load_bf_nt(h + (size_t)ta_ * DM, F.lane, A_); if ((li_) + 8 < TPB && tb_ < T_TOK) row_load_bf_nt(h + (size_t)tb_ * DM, F.lane, B_); } while (0)
    RT_LOAD(F.wave, va, vb);
    for (int li = F.wave; li < TPB; li += 16) {
        const int tok = tok0 + li; if (tok >= T_TOK) break;
        const bool hasb = (li + 8 < TPB) && (tok + 8 < T_TOK);
        RT_LOAD(li + 16, na, nb);
        const float rsa = row_rstd(va, 1e-6f), rsb = row_rstd(vb, 1e-6f);
#pragma unroll
        for (int j = 0; j < 4; ++j) { va[j] = va[j] * rsa * wv[j]; vb[j] = vb[j] * rsb * wv[j]; }
        if (true) {
#pragma unroll
            for (int j = 0; j < 4; ++j) { *(unsigned*)((unsigned char*)tbuf + (size_t)tok * DM + j * 256 + F.lane * 4) = pk_fp8x4(va[j][0] * F8_ACT_SCALE, va[j][1] * F8_ACT_SCALE, va[j][2] * F8_ACT_SCALE, va[j][3] * F8_ACT_SCALE);
                if (hasb) *(unsigned*)((unsigned char*)tbuf + (size_t)(tok + 8) * DM + j * 256 + F.lane * 4) = pk_fp8x4(vb[j][0] * F8_ACT_SCALE, vb[j][1] * F8_ACT_SCALE, vb[j][2] * F8_ACT_SCALE, vb[j][3] * F8_ACT_SCALE); }
        } else {
        row_store_bf16(tbuf + (size_t)tok * DM, F.lane, va);
        if (hasb) row_store_bf16(tbuf + (size_t)(tok + 8) * DM, F.lane, vb); }
        LAS float* lga = lgt + li * 20; LAS float* lgb = lgt + (li + 8) * 20;
#pragma unroll
        for (int o = 0; o < 10; ++o) { f32x2 c0 = (f32x2){0.f, 0.f}, c1 = c0, d0 = c0, d1 = c0;
#pragma unroll
            for (int j = 0; j < 4; ++j) { const f32x4 w4 = *(const LAS f32x4*)(wl + o * 1024 + j * 256 + F.lane * 4), w5 = *(const LAS f32x4*)(wl + (o + 10) * 1024 + j * 256 + F.lane * 4);
                const f32x2 w4l = (f32x2){w4[0], w4[1]}, w4h = (f32x2){w4[2], w4[3]}, w5l = (f32x2){w5[0], w5[1]}, w5h = (f32x2){w5[2], w5[3]};
                const f32x2 al = (f32x2){va[j][0], va[j][1]}, ah = (f32x2){va[j][2], va[j][3]}, bl = (f32x2){vb[j][0], vb[j][1]}, bh = (f32x2){vb[j][2], vb[j][3]};
                c0 += al * w4l; c0 += ah * w4h; c1 += al * w5l; c1 += ah * w5h; d0 += bl * w4l; d0 += bh * w4h; d1 += bl * w5l; d1 += bh * w5h; }
            float a0 = c0[0] + c0[1], a1 = c1[0] + c1[1], b0 = d0[0] + d0[1], b1 = d1[0] + d1[1];
            asm volatile("s_nop 1\n\tv_permlane32_swap_b32 %0, %1\n\tv_permlane32_swap_b32 %2, %3\n\ts_nop 1" : "+v"(a0), "+v"(a1), "+v"(b0), "+v"(b1));
            float sa = dpp_sum16(a0 + a1), sb_ = dpp_sum16(b0 + b1);
            sa += __builtin_bit_cast(float, __builtin_amdgcn_update_dpp(0, __builtin_bit_cast(int, sa), 0x142, 0xA, 0xF, false));
            sb_ += __builtin_bit_cast(float, __builtin_amdgcn_update_dpp(0, __builtin_bit_cast(int, sb_), 0x142, 0xA, 0xF, false));
            if ((F.lane & 31) == 16) { lga[hsel + o] = sa; if (hasb) lgb[hsel + o] = sb_; }
            if (o & 1) __builtin_amdgcn_sched_barrier(0); }
#pragma unroll
        for (int j = 0; j < 4; ++j) { va[j] = na[j]; vb[j] = nb[j]; }
    }
#undef RT_LOAD
    __syncthreads();
    for (int li = F.tid; li < TPB; li += NTHREADS) {
        if (tok0 + li >= T_TOK) break;
        float lg[20];
#pragma unroll
        for (int o = 0; o < 20; ++o) lg[o] = lgt[li * 20 + o];
        float g0 = lg[0] + bg[0], g1 = lg[1] + bg[1], g2 = lg[2] + bg[2], g3 = lg[3] + bg[3];
        int gi = 0; float gm = g0; if (g1 > gm) { gm = g1; gi = 1; } if (g2 > gm) { gm = g2; gi = 2; } if (g3 > gm) { gm = g3; gi = 3; }
        const float gate = 1.f / (__expf(g0 - gm) + __expf(g1 - gm) + __expf(g2 - gm) + __expf(g3 - gm));
        float e0, e1, e2, e3;
        e0 = (gi == 0) ? lg[4] : (gi == 1) ? lg[8] : (gi == 2) ? lg[12] : lg[16];
        e1 = (gi == 0) ? lg[5] : (gi == 1) ? lg[9] : (gi == 2) ? lg[13] : lg[17];
        e2 = (gi == 0) ? lg[6] : (gi == 1) ? lg[10] : (gi == 2) ? lg[14] : lg[18];
        e3 = (gi == 0) ? lg[7] : (gi == 1) ? lg[11] : (gi == 2) ? lg[15] : lg[19];
        e0 += be[gi * 4 + 0]; e1 += be[gi * 4 + 1]; e2 += be[gi * 4 + 2]; e3 += be[gi * 4 + 3];
        int i1 = 0; float v1 = e0; if (e1 > v1) { v1 = e1; i1 = 1; } if (e2 > v1) { v1 = e2; i1 = 2; } if (e3 > v1) { v1 = e3; i1 = 3; }
        int i2 = -1; float v2 = -3.0e38f;
        if (i1 != 0 && e0 > v2) { v2 = e0; i2 = 0; } if (i1 != 1 && e1 > v2) { v2 = e1; i2 = 1; } if (i1 != 2 && e2 > v2) { v2 = e2; i2 = 2; } if (i1 != 3 && e3 > v2) { v2 = e3; i2 = 3; }
        const float w1 = gate / (1.f + __expf(v2 - v1)), w2 = gate - w1;
        const int lo = i1 < i2 ? i1 : i2, hi = i1 < i2 ? i2 : i1; const float clo = i1 < i2 ? w1 : w2, chi = i1 < i2 ? w2 : w1;
        const int pr = (lo == 0) ? hi - 1 : (lo == 1) ? hi + 1 : 5;
        const int bk = gi * 6 + pr;
        l_bkt[li] = bk; l_c[li * 2] = clo; l_c[li * 2 + 1] = chi;
        l_rank[li] = __hip_atomic_fetch_add((int*)(lcount + bk), 1, __ATOMIC_RELAXED, __HIP_MEMORY_SCOPE_WORKGROUP);
    }
    __syncthreads();
    if (F.tid < 24) lbase[F.tid] = __hip_atomic_fetch_add(gcount + F.tid, lcount[F.tid], __ATOMIC_RELAXED, __HIP_MEMORY_SCOPE_AGENT);
    __syncthreads();
    for (int li = F.tid; li < TPB; li += NTHREADS) { const int tok = tok0 + li; if (tok < T_TOK) { const int bk = l_bkt[li]; tok_bkt[tok] = bk; tok_rank[tok] = lbase[bk] + l_rank[li]; tok_c[tok] = (f32x2){l_c[li * 2], l_c[li * 2 + 1]}; } }
}
__device__ __forceinline__ void phase_moe_slots(const Params& p, const Frame& F, int layer) {
    unsigned char* meta = F.ws + WS_META + (size_t)layer * META_STRIDE;
    const int* tok_rank = (const int*)(meta + MT_RANK); const int* tok_bkt = (const int*)(meta + MT_BKT); const f32x2* tok_c = (const f32x2*)(meta + MT_C);
    int* slot_tok = (int*)(meta + MT_STOK); f32x2* slot_c = (f32x2*)(meta + MT_SC); int* tile_tab = (int*)(meta + MT_TILE);
    int* gcount = (int*)(F.ws + WS_CTL + CTL_CNT_OFF) + layer * 32;
    LAS int* cnt = (LAS int*)F.lds; LAS int* start = cnt + 32;
    __syncthreads();
    if (F.tid < 24) cnt[F.tid] = __hip_atomic_load(gcount + F.tid, __ATOMIC_RELAXED, __HIP_MEMORY_SCOPE_AGENT);
    __syncthreads();
    if (F.tid == 0) { int a = 0; for (int b = 0; b < 24; ++b) { start[b] = a; a += (cnt[b] + 255) >> 8; } start[24] = a; }
    __syncthreads();
    for (int tok = F.bid * NTHREADS + F.tid; tok < T_TOK; tok += F.G * NTHREADS) { const int bk = tok_bkt[tok]; const int slot = start[bk] * 256 + tok_rank[tok]; slot_tok[slot] = tok; slot_c[slot] = tok_c[tok]; }
    for (int b = F.bid; b < 24; b += F.G) { const int s0 = start[b] * 256 + cnt[b], s1 = start[b + 1] * 256;
        for (int s = s0 + F.tid; s < s1; s += NTHREADS) { slot_tok[s] = -1; slot_c[s] = (f32x2){0.f, 0.f}; } }
    if (F.bid == 0) { if (F.tid == 0) tile_tab[0] = start[24];
        for (int m = F.tid; m < 288; m += NTHREADS) { int bk = 23; for (int b = 0; b < 24; ++b) if (m >= start[b] && m < start[b + 1]) bk = b; tile_tab[64 + m] = bk; } }
}

__device__ __forceinline__ void phase_mix5(const Params& p, const Frame& F, const bf16_t* h, bf16_t* ou, bf16_t* o0, bf16_t* o1, bf16_t* o2) {
    const float* mu = p.in[12];
    f32x4 wv[4], m0[4], m1[4], m2[4];
    row_load(p.in[1] + DM, F.lane, wv); row_load(mu, F.lane, m0); row_load(mu + 2 * DM, F.lane, m1); row_load(mu + 3 * DM, F.lane, m2);
    for (int run = F.bid * 8 + F.wave; run < T_TOK / 32; run += F.G * 8) {
        const int t0 = run * 32;
        f32x4 up[4];
        if ((t0 & (SEQ - 1)) == 0) {
#pragma unroll
            for (int j = 0; j < 4; ++j) up[j] = (f32x4){0.f, 0.f, 0.f, 0.f};
            row_store_bf16(ou + (size_t)(t0 + (t0 >> 12)) * DM, F.lane, up);
        } else { row_load_bf(h + (size_t)(t0 - 1) * DM, F.lane, up); const float rs = row_rstd(up, 1e-6f);
#pragma unroll
            for (int j = 0; j < 4; ++j) up[j] = up[j] * rs * wv[j]; }
        f32x4 u[4], un[4]; row_load_bf(h + (size_t)t0 * DM, F.lane, u);
        for (int tt = 0; tt < 32; ++tt) {
            if (tt + 1 < 32) row_load_bf(h + (size_t)(t0 + tt + 1) * DM, F.lane, un);
            const float rs = row_rstd(u, 1e-6f);
            f32x4 a[4], b[4], c[4];
#pragma unroll
            for (int j = 0; j < 4; ++j) { u[j] = u[j] * rs * wv[j]; const f32x4 xx = up[j] - u[j]; a[j] = u[j] + xx * m0[j]; b[j] = u[j] + xx * m1[j]; c[j] = u[j] + xx * m2[j]; }
            const size_t ro = (size_t)(t0 + tt) * DM;
            row_store_bf16(ou + ro + (size_t)((t0 >> 12) + 1) * DM, F.lane, u);
            if (F8_RV) { row_store_fp8((unsigned char*)o0 + ro, F.lane, a); row_store_fp8((unsigned char*)o2 + ro, F.lane, c); }
            else { row_store_bf16(o0 + ro, F.lane, a); row_store_bf16(o2 + ro, F.lane, c); }
            row_store_bf16(o1 + ro, F.lane, b);
#pragma unroll
            for (int j = 0; j < 4; ++j) { up[j] = u[j]; u[j] = un[j]; }
        }
    }
}

typedef __bf16 bf16x2v __attribute__((ext_vector_type(2)));
__device__ __forceinline__ unsigned pkc(float lo, float hi) { f32x2 t = {lo, hi}; bf16x2v r = __builtin_convertvector(t, bf16x2v); return __builtin_bit_cast(unsigned, r); }
__device__ __forceinline__ unsigned off_r(unsigned row, unsigned ch) { return row * 128u + 16u * (ch ^ ((row >> 1) & 7u)); }
__device__ __forceinline__ unsigned off_m(unsigned row, unsigned ch) { return row * 64u + 16u * (ch ^ ((0u - (row >> 2)) & 3u)); }
#define MFMA16(a, b, c) __builtin_amdgcn_mfma_f32_16x16x32_bf16((a), (b), (c), 0, 0, 0)
__device__ __forceinline__ void swap32(float& a, float& b) { asm volatile("s_nop 1\n\tv_permlane32_swap_b32 %0, %1\n\ts_nop 1" : "+v"(a), "+v"(b)); }
__device__ __forceinline__ float half_sum(float x, bool hf) {
    x = dpp_sum16(x);
    x += __builtin_bit_cast(float, __builtin_amdgcn_update_dpp(0, __builtin_bit_cast(int, x), 0x142, 0xA, 0xF, false));
    const float lo = __builtin_bit_cast(float, __builtin_amdgcn_readlane(__builtin_bit_cast(int, x), 31)), hi = __builtin_bit_cast(float, __builtin_amdgcn_readlane(__builtin_bit_cast(int, x), 63));
    return hf ? hi : lo;
}
__device__ __forceinline__ void phase_rwkv(const Params& p, const Frame& F, bf16_t* rbuf, const bf16_t* kbuf, const bf16_t* vbuf, const bf16_t* ebuf, const bf16_t* abuf, const bf16_t* gbuf, unsigned char* y8) {
    (void)y8;
    constexpr unsigned ORA = 0, OLB = 16384, OMS = 32768, OMU = 49152, OMY = 53248, OAB = 57344, OAK = 61440, OVT = 65536, OGC = 73728, OYS = 74752, OVF = 91136, OGG = 107520, OBON = 123904;
    LAS unsigned char* L = F.lds;
    const float* k_k = p.in[25]; const float* k_a = p.in[26]; const float* r_k = p.in[27]; const float* lnw = p.in[28]; const float* lnb = p.in[29];
    const int lane0 = F.lane, w = F.wave, pc = w >> 1, th = w & 1;
    for (int unit = F.bid; unit < 256; unit += F.G) {
        const int b = unit >> 4, hd = unit & 15;
        const int gc2 = hd * 64 + 2 * (lane0 & 31);
        const f32x2 kkw = *(const f32x2*)(k_k + gc2), kaw = *(const f32x2*)(k_a + gc2), rkw = *(const f32x2*)(r_k + gc2), lw = *(const f32x2*)(lnw + gc2), lb = *(const f32x2*)(lnb + gc2);
        int lane = lane0;
        f32x4 St[4];
#pragma unroll
        for (int mt = 0; mt < 4; ++mt) St[mt] = (f32x4){0.f, 0.f, 0.f, 0.f};
        unsigned pr[4], pk[4], pv[4], pe[4], pa[4], pg[4], pe0[4];
#define RW_LOAD(t0_) do { const size_t ub_ = ((size_t)b * SEQ + (t0_) + 16 * pc + 8 * th) * DM + hd * 64, ub0_ = ((size_t)b * SEQ + (t0_) + 16 * pc) * DM + hd * 64;     \
            const bf16_t* r_ = rbuf + ub_; const bf16_t* k_ = kbuf + ub_; const bf16_t* v_ = vbuf + ub_; const bf16_t* e_ = ebuf + ub_; const bf16_t* a_ = abuf + ub_; const bf16_t* g_ = gbuf + ub_; const bf16_t* e0_ = ebuf + ub0_; \
            _Pragma("unroll") for (int it = 0; it < 4; ++it) { const unsigned lo_ = (unsigned)((4 * (lane >> 5) + it) * DM + 2 * (lane & 31)); \
            pr[it] = __builtin_nontemporal_load((const unsigned*)(r_ + lo_)); pk[it] = __builtin_nontemporal_load((const unsigned*)(k_ + lo_)); pv[it] = __builtin_nontemporal_load((const unsigned*)(v_ + lo_)); pe[it] = __builtin_nontemporal_load((const unsigned*)(e_ + lo_)); pa[it] = __builtin_nontemporal_load((const unsigned*)(a_ + lo_)); pg[it] = __builtin_nontemporal_load((const unsigned*)(g_ + lo_)); pe0[it] = *(const unsigned*)(e0_ + lo_); } } while (0)
        RW_LOAD(0);
        SP_DECL;
        for (int t0 = 0; t0 < SEQ; t0 += 64) {
            LDS_BAR();
            SP_MARK(4);
            asm volatile("" : "+v"(lane));
            const unsigned l15 = lane & 15, q = (unsigned)lane >> 4, cp = lane & 31;
            const bool hf = lane >= 32;
            const unsigned pj = 32u * (cp >> 4) + 8u * ((cp & 7) >> 1) + 2u * (cp & 1) + ((cp & 8) ? 4u : 0u);
            {
                float pl0[4], pl1[4], ls0 = 0.f, ls1 = 0.f, f0 = 0.f, f1 = 0.f;
#pragma unroll
                for (int it = 0; it < 4; ++it) { ls0 += bflo(pe[it]); ls1 += bfhi(pe[it]); pl0[it] = ls0; pl1[it] = ls1; f0 += bflo(pe0[it]); f1 += bfhi(pe0[it]); }
                float xa0 = 0.f, xb0 = ls0, xa1 = 0.f, xb1 = ls1; swap32(xa0, xb0); swap32(xa1, xb1);
                float ya0 = f0, yb0 = f0, ya1 = f1, yb1 = f1; swap32(ya0, yb0); swap32(ya1, yb1);
                const float base0 = xa0 + (th ? f0 + (hf ? ya0 : yb0) : 0.f), base1 = xa1 + (th ? f1 + (hf ? ya1 : yb1) : 0.f);
                float ms0[8], ms1[8], vt0[4], vt1[4];
                LAS unsigned char* ra = L + ORA + pc * 4096; LAS unsigned char* lbp = L + OLB + pc * 4096;
#pragma unroll
                for (int it = 0; it < 4; ++it) {
                    const int t = 8 * th + 4 * (int)hf + it, tb = 16 * pc + t;
                    const float r0 = bflo(pr[it]), r1 = bfhi(pr[it]), k0 = bflo(pk[it]), k1 = bfhi(pk[it]), a0 = bflo(pa[it]), a1 = bfhi(pa[it]);
                    const float kv0 = k0 * kkw[0], kv1 = k1 * kkw[1]; const float ss = half_sum(kv0 * kv0 + kv1 * kv1, hf); const float rn = rsqrtf(fmaxf(ss, 1e-24f));
                    const float kk0 = kv0 * rn, kk1 = kv1 * rn;
                    const float kp0 = k0 * (1.f + (a0 - 1.f) * kaw[0]), kp1 = k1 * (1.f + (a1 - 1.f) * kaw[1]);
                    const float bon = half_sum(r0 * kp0 * rkw[0] + r1 * kp1 * rkw[1], hf);
                    const float lp0 = -(base0 + (it ? pl0[it ? it - 1 : 0] : 0.f)), lp1 = -(base1 + (it ? pl1[it ? it - 1 : 0] : 0.f)), lc0 = -(base0 + pl0[it]), lc1 = -(base1 + pl1[it]);
                    const float ea0 = __expf(lp0), ea1 = __expf(lp1), eb0 = __expf(lc0), eb1 = __expf(lc1), ei0 = __expf(-lc0), ei1 = __expf(-lc1);
                    const float bt0 = kk0 * a0 * ei0, bt1 = kk1 * a1 * ei1, kt0 = kp0 * ei0, kt1 = kp1 * ei1;
                    *(LAS unsigned*)(ra + off_r(t, pj >> 3) + 2 * (pj & 7)) = pkc(-kk0 * ea0, -kk1 * ea1); *(LAS unsigned*)(ra + off_r(16 + t, pj >> 3) + 2 * (pj & 7)) = pkc(r0 * eb0, r1 * eb1);
                    *(LAS unsigned*)(lbp + off_r(t, pj >> 3) + 2 * (pj & 7)) = pkc(bt0, bt1); *(LAS unsigned*)(lbp + off_r(16 + t, pj >> 3) + 2 * (pj & 7)) = pkc(kt0, kt1);
                    ms0[it] = bt0; ms0[4 + it] = kt0; ms1[it] = bt1; ms1[4 + it] = kt1; vt0[it] = bflo(pv[it]); vt1[it] = bfhi(pv[it]);
                    *(LAS f32x2*)(L + OVF + (tb * 64 + 2 * cp) * 4) = (f32x2){bflo(pv[it]), bfhi(pv[it])}; *(LAS f32x2*)(L + OGG + (tb * 64 + 2 * cp) * 4) = (f32x2){bflo(pg[it]), bfhi(pg[it])};
                    if (cp == 0) *(LAS float*)(L + OBON + tb * 4) = bon;
                    if (it == 3 && th && hf) *(LAS f32x2*)(L + OGC + pc * 256 + 2 * cp * 4) = (f32x2){eb0, eb1};
                }
                { u32x4 m0, m1; m0.x = pkc(ms0[0], ms0[1]); m0.y = pkc(ms0[2], ms0[3]); m0.z = pkc(ms0[4], ms0[5]); m0.w = pkc(ms0[6], ms0[7]); m1.x = pkc(ms1[0], ms1[1]); m1.y = pkc(ms1[2], ms1[3]); m1.z = pkc(ms1[4], ms1[5]); m1.w = pkc(ms1[6], ms1[7]);
                  *(LAS u32x4*)(L + OMS + pc * 4096 + off_m(2 * cp, 2 * th + (unsigned)hf)) = m0; *(LAS u32x4*)(L + OMS + pc * 4096 + off_m(2 * cp + 1, 2 * th + (unsigned)hf)) = m1;
                  u32x2 w0, w1; w0.x = pkc(vt0[0], vt0[1]); w0.y = pkc(vt0[2], vt0[3]); w1.x = pkc(vt1[0], vt1[1]); w1.y = pkc(vt1[2], vt1[3]);
                  *(LAS u32x2*)(L + OVT + pc * 2048 + (2 * cp) * 32 + (8 * th + 4 * (unsigned)hf) * 2) = w0; *(LAS u32x2*)(L + OVT + pc * 2048 + (2 * cp + 1) * 32 + (8 * th + 4 * (unsigned)hf) * 2) = w1; }
            }
            if (t0 + 64 < SEQ) RW_LOAD(t0 + 64);
            LDS_BAR();
            SP_MARK(1);
            if (w < 4) {
                {
                    const int c = w;
                    f32x4 g00 = (f32x4){0.f, 0.f, 0.f, 0.f}, g01 = g00, g10 = g00, g11 = g00;
#pragma unroll
                    for (int ks = 0; ks < 2; ++ks) {
                        const bf16x8 a0 = *(const LAS bf16x8*)(L + OLB + c * 4096 + off_r(l15, 4 * ks + q)), a1 = *(const LAS bf16x8*)(L + OLB + c * 4096 + off_r(16 + l15, 4 * ks + q));
                        const bf16x8 b0 = *(const LAS bf16x8*)(L + ORA + c * 4096 + off_r(l15, 4 * ks + q)), b1 = *(const LAS bf16x8*)(L + ORA + c * 4096 + off_r(16 + l15, 4 * ks + q));
                        g00 = MFMA16(a0, b0, g00); g01 = MFMA16(a0, b1, g01); g10 = MFMA16(a1, b0, g10); g11 = MFMA16(a1, b1, g11);
                    }
                    f32x4 ab, ak; float br[4], kr[4];
#pragma unroll
                    for (int g = 0; g < 4; ++g) { const bool lt = (4 * q + g) < l15, le = (4 * q + g) <= l15; ab[g] = lt ? g00[g] : 0.f; ak[g] = lt ? g10[g] : 0.f; br[g] = le ? g01[g] : 0.f; kr[g] = le ? g11[g] : 0.f; }
                    *(LAS f32x4*)(L + OAB + c * 1024 + (l15 * 16 + 4 * q) * 4) = ab; *(LAS f32x4*)(L + OAK + c * 1024 + (l15 * 16 + 4 * q) * 4) = ak;
                    u32x4 yw; yw.x = pkc(br[0], br[1]); yw.y = pkc(br[2], br[3]); yw.z = pkc(kr[0], kr[1]); yw.w = pkc(kr[2], kr[3]);
                    *(LAS u32x4*)(L + OMY + c * 1024 + off_m(l15, q)) = yw;
                    if (lane < 32) {
                        float row[16];
#pragma unroll
                        for (int t = 0; t < 16; ++t) {
                            const LAS f32x4* abr = (const LAS f32x4*)(L + OAB + c * 1024 + t * 64);
                            const f32x4 x0 = abr[0], x1 = abr[1], x2 = abr[2], x3 = abr[3];
                            const float abv[16] = {x0[0], x0[1], x0[2], x0[3], x1[0], x1[1], x1[2], x1[3], x2[0], x2[1], x2[2], x2[3], x3[0], x3[1], x3[2], x3[3]};
                            float acc1 = (lane < 16) ? ((lane == t) ? 1.f : 0.f) : *(const LAS float*)(L + OAK + c * 1024 + (t * 16 + (lane & 15)) * 4);
#pragma unroll
                            for (int s_ = 0; s_ < t; ++s_) acc1 += row[s_] * abv[s_];
                            row[t] = acc1;
                        }
                        const unsigned pp = (lane < 16) ? (8u * (lane >> 2) + (lane & 3)) : (8u * ((lane & 15) >> 2) + 4u + (lane & 3));
#pragma unroll
                        for (int t = 0; t < 16; ++t) *(LAS bf16_t*)(L + OMU + c * 1024 + off_m(t, pp >> 3) + 2 * (pp & 7)) = (bf16_t)(pkc(row[t], 0.f) & 0xffffu);
                    }
                }
            }
            LDS_BAR();
            SP_MARK(2);
            if (w < 4) {
#pragma unroll 1
                for (int c = 0; c < 4; ++c) {
                    bf16x8 Sb0, Sb1;
                    { u32x4 t0_; t0_.x = pkc(St[0][0], St[0][1]); t0_.y = pkc(St[0][2], St[0][3]); t0_.z = pkc(St[1][0], St[1][1]); t0_.w = pkc(St[1][2], St[1][3]); Sb0 = __builtin_bit_cast(bf16x8, t0_);
                      u32x4 t1_; t1_.x = pkc(St[2][0], St[2][1]); t1_.y = pkc(St[2][2], St[2][3]); t1_.z = pkc(St[3][0], St[3][1]); t1_.w = pkc(St[3][2], St[3][3]); Sb1 = __builtin_bit_cast(bf16x8, t1_); }
                    f32x4 Za = (f32x4){0.f, 0.f, 0.f, 0.f}, Zr = Za;
                    Za = MFMA16(*(const LAS bf16x8*)(L + ORA + c * 4096 + off_r(l15, q)), Sb0, Za); Za = MFMA16(*(const LAS bf16x8*)(L + ORA + c * 4096 + off_r(l15, 4 + q)), Sb1, Za);
                    Zr = MFMA16(*(const LAS bf16x8*)(L + ORA + c * 4096 + off_r(16 + l15, q)), Sb0, Zr); Zr = MFMA16(*(const LAS bf16x8*)(L + ORA + c * 4096 + off_r(16 + l15, 4 + q)), Sb1, Zr);
                    const u32x2 vt = *(const LAS u32x2*)(L + OVT + c * 2048 + (16 * w + l15) * 32 + 8 * q);
                    u32x4 bu; bu.x = pkc(Za[0], Za[1]); bu.y = pkc(Za[2], Za[3]); bu.z = vt.x; bu.w = vt.y;
                    f32x4 U = (f32x4){0.f, 0.f, 0.f, 0.f};
                    U = MFMA16(*(const LAS bf16x8*)(L + OMU + c * 1024 + off_m(l15, q)), __builtin_bit_cast(bf16x8, bu), U);
                    u32x4 by; by.x = pkc(U[0], U[1]); by.y = pkc(U[2], U[3]); by.z = vt.x; by.w = vt.y;
                    const bf16x8 By = __builtin_bit_cast(bf16x8, by);
                    const f32x4 Yt = MFMA16(*(const LAS bf16x8*)(L + OMY + c * 1024 + off_m(l15, q)), By, Zr);
#pragma unroll
                    for (int mt = 0; mt < 4; ++mt) { St[mt] = MFMA16(*(const LAS bf16x8*)(L + OMS + c * 4096 + off_m(16 * mt + l15, q)), By, St[mt]);
                        const f32x4 gc = *(const LAS f32x4*)(L + OGC + c * 256 + (16 * mt + 4 * q) * 4); St[mt] = St[mt] * gc; }
#pragma unroll
                    for (int g = 0; g < 4; ++g) *(LAS float*)(L + OYS + ((16 * c + 4 * q + g) * 64 + 16 * w + l15) * 4) = Yt[g];
                }
            }
            LDS_BAR();
            SP_MARK(3);
            bf16_t* ob_ = rbuf + ((size_t)b * SEQ + t0 + w) * DM + hd * 64;
#pragma unroll
            for (int iq = 0; iq < 4; ++iq) { const int tq = 2 * iq + (int)hf, t = w + 8 * tq; const int li = t * 64 + 2 * (int)cp;
                const f32x2 y = *(const LAS f32x2*)(L + OYS + li * 4); const float mean = half_sum(y[0] + y[1], hf) * (1.f / 64.f); const float d0 = y[0] - mean, d1 = y[1] - mean;
                const float rs = rsqrtf(half_sum(d0 * d0 + d1 * d1, hf) * (1.f / 64.f) + 64e-5f);
                const f32x2 vv = *(const LAS f32x2*)(L + OVF + li * 4), gg = *(const LAS f32x2*)(L + OGG + li * 4); const float bo = *(const LAS float*)(L + OBON + t * 4);
                const float o0 = (d0 * rs * lw[0] + lb[0] + bo * vv[0]) * gg[0], o1 = (d1 * rs * lw[1] + lb[1] + bo * vv[1]) * gg[1];
                if (F8_WO) *(unsigned short*)(y8 + ((size_t)b * SEQ + t0 + w) * DM + hd * 64 + (unsigned)(8 * tq * DM + 2 * (int)cp)) = (unsigned short)pk_fp8x4(o0 * F8_ACT_SCALE, o1 * F8_ACT_SCALE, 0.f, 0.f);
                else *(unsigned*)(ob_ + (unsigned)(8 * tq * DM + 2 * (int)cp)) = pkc(o0, o1); }
        }
#undef RW_LOAD
    }
}

__global__ void __launch_bounds__(NTHREADS, 2) mega_fwd(Params p) {
    extern __shared__ __attribute__((aligned(16))) unsigned char lds_raw[];
    Frame F;
    F.lds = (LAS unsigned char*)lds_raw;
    F.tid = threadIdx.x; F.lane = F.tid & 63; F.wave = __builtin_amdgcn_readfirstlane(F.tid >> 6); F.G = gridDim.x; F.bid = blockIdx.x;
    F.out = p.out; F.ws = p.ws;
    volatile LAS unsigned* misc = (volatile LAS unsigned*)(F.lds + LDS_MISC);
    if (F.tid < 32) misc[F.tid] = 0u;
    __syncthreads();
    const int lo = p.ph_lo, hi = p.ph_hi;
    XcdBarrier bar; bar.bar = (unsigned*)(F.ws + WS_CTL); bar.x = 0; bar.st = misc;
    if (hi - lo > 1) bar = xcd_barrier_post((unsigned*)(F.ws + WS_CTL), misc);
#define IN(k) (lo <= (k) && (k) < hi)
#if PROBE_MASK
    unsigned long long pr_t0 = 0ull, pr_acc = 0ull;
#define PSTART(k) do { if ((PROBE_MASK >> (k)) & 1u) pr_t0 = wall_clock64(); } while (0)
#define PEND(k) do { if ((PROBE_MASK >> (k)) & 1u) pr_acc += wall_clock64() - pr_t0; } while (0)
#else
#define PSTART(k) do {} while (0)
#define PEND(k) do {} while (0)
#endif
#if PROBE_SUB == 11
#define SEAM(k) do { if (IN(k) && IN((k) + 1)) { unsigned long long b0_ = 0ull; if (F.tid == 0) b0_ = wall_clock64(); xcd_barrier(bar); if (F.tid == 0) *(LAS unsigned long long*)(F.lds + LDS_MISC + 64) += wall_clock64() - b0_; } PEND(k); PSTART((k) + 1); } while (0)
#else
#define SEAM(k) do { if (IN(k) && IN((k) + 1)) xcd_barrier(bar); PEND(k); PSTART((k) + 1); } while (0)
#endif
    bf16_t* wb = WSP(bf16_t, WS_WB);
    bf16_t* S0 = WSP(bf16_t, WS_SLAB); bf16_t* S2 = WSP(bf16_t, WS_SLAB + 2 * SLAB); bf16_t* S3 = WSP(bf16_t, WS_SLAB + 3 * SLAB); bf16_t* S4 = WSP(bf16_t, WS_SLAB + 4 * SLAB); bf16_t* S5 = WSP(bf16_t, WS_SLAB + 5 * SLAB);
    bf16_t* EH = WSP(bf16_t, WS_E);
    bf16_t* O0 = (bf16_t*)F.out; bf16_t* O1 = O0 + (size_t)T_TOK * DM;
    bf16_t* hres = (bf16_t*)F.out;
    bf16_t* S1 = WSP(bf16_t, WS_SLAB + 1 * SLAB);
    const int vcu = (F.G % 8 == 0) ? F.bid : F.bid;

    PSTART(0);
    if (IN(0)) { phase_prep(p, F, 0, PT_WIN, true); phase_rmsnorm<F8_INPROJ ? 2 : 1>(p, F, p.in[0], p.in[1], O0); } SEAM(0);
    if (IN(2)) { DenseP<EK_INPROJ, F8_INPROJ> P{}; P.pid = 2; P.v0 = (const float*)(F.ws + WS_ROPE); P.K = F8_INPROJ ? 512 : 1024; P.lda = P.K; P.ldb = P.K; P.nM = 256; P.nN = NPROJ / 256; P.nprob = 1; P.G = F.G; P.c = vcu; P.A = O0; P.a_stride = 0; P.B = wb + WB_WIN / 2; P.b_stride = 0;
        P.O = S0; P.o_stride = 0; P.ldc = NPROJ; gemm_phase(F.lds, P); } SEAM(2);
    if (IN(3)) { phase_conv(p, F); } SEAM(3);
    if (IN(4)) { phase_scan0(p, F); } SEAM(4);
    if (IN(5)) { phase_prep(p, F, PT_WIN, PT_WOUT, false); phase_gatenorm(p, F); } SEAM(5);
    if (IN(6)) { DenseP<EK_F32RES, F8_OUTPROJ> P{}; P.pid = 6; P.K = F8_OUTPROJ ? 1024 : 2048; P.lda = NPROJ; P.ldb = P.K; P.nM = 256; P.nN = 4; P.nprob = 1; P.G = F.G; P.c = vcu; P.A = S0; P.B = wb + WB_WOUT / 2; P.resf = p.in[0]; P.resb = nullptr; P.Ob = hres; P.ldc = 1024; gemm_phase(F.lds, P); } SEAM(6);
#define MOE_LAYER(L, k0) \
    if (IN(k0)) { phase_prep(p, F, PT_L2 + (L) * 4096, PT_L2 + (L) * 4096 + 4096, false); phase_prep(p, F, PT_W13 + (L) * 2048, PT_W13 + (L) * 2048 + 2048, false); phase_moe_route(p, F, L, hres, S2); } SEAM(k0); \
    if (IN(k0 + 1)) { phase_moe_slots(p, F, L); } SEAM(k0 + 1); \
    if (IN(k0 + 2)) { unsigned char* meta = F.ws + WS_META + (size_t)(L) * META_STRIDE; Moe1P<true> P{}; P.pid = (k0) + 2; P.K = 512; P.lda = P.K; P.ldb = P.K; P.G = F.G; P.c = vcu; \
        P.ntiles = __builtin_amdgcn_readfirstlane(ld_vec_i32((const int*)(meta + MT_TILE))); P.A = S2; P.W13 = wb + WB_W13 / 2 + (size_t)(L) * 16 * 1048576; P.H = S3; \
        P.slot_tok = (const int*)(meta + MT_STOK); P.slot_c = (const float*)(meta + MT_SC); P.tile_bkt = (const int*)(meta + MT_TILE) + 64; gemm_phase(F.lds, P); } SEAM(k0 + 2); \
    if (IN(k0 + 3)) { unsigned char* meta = F.ws + WS_META + (size_t)(L) * META_STRIDE; Moe2P<true> P{}; P.pid = (k0) + 3; P.K = 512; P.lda = P.K; P.ldb = P.K / 2; P.G = F.G; P.c = vcu; \
        P.ntiles = __builtin_amdgcn_readfirstlane(ld_vec_i32((const int*)(meta + MT_TILE))); P.H = S3; P.W2 = wb + WB_W2 / 2 + (size_t)(L) * 16 * 524288; P.hsrc = hres; P.hdst = ((L) == 1) ? S0 : hres; \
        P.slot_tok = (const int*)(meta + MT_STOK); P.tile_bkt = (const int*)(meta + MT_TILE) + 64; gemm_phase(F.lds, P); } SEAM(k0 + 3);
    MOE_LAYER(0, 7)
    if (IN(11)) { phase_prep(p, F, PT_WOUT, PT_L2, false); phase_mix5(p, F, hres, S0, S2, S3, S4); } SEAM(11);
    if (IN(12)) { DenseP<EK_LORA1> P{}; P.pid = 12; P.K = 2048; P.lda = 1024; P.ldb = 2048; P.nM = 256; P.nN = 2; P.nprob = 1; P.G = F.G; P.c = vcu; P.A = S0; P.a_skew = 1; P.a_split = 16; P.a_jump = -(long)(1024 * 2) - 16 * (BK * 2);
        P.B = wb + WB_L1 / 2; P.O = EH; P.ldc = 512; gemm_phase(F.lds, P); } SEAM(12);
    if (IN(14)) {
        { DenseP<EK_BF16> P{}; P.pid = 14; P.K = 1024; P.lda = 1024; P.ldb = 1024; P.nM = 256; P.nN = 4; P.nprob = 1; P.G = F.G; P.c = vcu; P.ldc = 1024; P.A = S3; P.B = wb + WB_WR / 2 + 1048576; P.O = S0; gemm_phase(F.lds, P); }
        { DenseP<EK_BF16, F8_RV> P{}; P.pid = 14; P.K = F8_RV ? 512 : 1024; P.lda = P.K; P.ldb = P.K; P.nM = 256; P.nN = 4; P.nprob = 2; P.G = F.G; P.c = vcu; P.ldc = 1024; P.A = S2; P.Aalt1 = S4; P.Aalt2 = S4; P.B = wb + WB_WR / 2; P.b_stride = 2097152;
          P.O = S5; P.Oalt1 = S1; P.Oalt2 = S1; gemm_phase(F.lds, P); } } SEAM(14);
    if (IN(15)) { DenseP<EK_LORA2> P{}; P.pid = 15; P.K = 256; P.lda = 512; P.ldb = 256; P.nM = 256; P.nN = 4; P.nprob = 3; P.G = F.G; P.c = vcu; P.A = EH; P.Aalt1 = EH; P.Aalt2 = EH + 128; P.B = wb + WB_L2 / 2; P.b_stride = 262144;
        P.O = S2; P.o_stride = (size_t)T_TOK * DM; P.ldc = 1024; P.v0 = p.in[17]; P.v1 = p.in[20]; gemm_phase(F.lds, P); } SEAM(15);
    if (IN(16)) { phase_rwkv(p, F, S5, S0, S1, S2, S3, S4, (unsigned char*)EH); } SEAM(16);
    if (IN(17)) { DenseP<EK_F32RES, F8_WO> P{}; P.pid = 17; P.K = F8_WO ? 512 : 1024; P.lda = P.K; P.ldb = P.K; P.nM = 256; P.nN = 4; P.nprob = 1; P.G = F.G; P.c = vcu; P.A = F8_WO ? EH : S5; P.B = wb + WB_WO / 2; P.resf = nullptr; P.resb = hres; P.Ob = hres; P.ldc = 1024; gemm_phase(F.lds, P); } SEAM(17);
    MOE_LAYER(1, 18)
    if (IN(22)) { phase_rmsnorm<0, true>(p, F, S0, p.in[3], F.out); }
#if PROBE_SUB
    if (F.bid == 0 && F.tid == 0) { const unsigned long long d_ = *(LAS unsigned long long*)(F.lds + LDS_MISC + 64); const unsigned long long t = wall_clock64(); while (wall_clock64() - t < d_) __builtin_amdgcn_s_sleep(8); }
#endif
#if PROBE_MASK
    PEND(22);
    if (F.bid == 0 && F.tid == 0) { const unsigned long long t = wall_clock64(); while (wall_clock64() - t < pr_acc) __builtin_amdgcn_s_sleep(8); }
#endif
}

extern "C" void kernel_launch(void* const* d_in, const int* in_sizes, int n_in, void* d_out, int out_size, void* d_ws, size_t ws_size, hipStream_t stream) {
    static int grid = 0;
    if (grid == 0) {
        if (n_in != 37 || out_size != T_TOK * DM || ws_size < WS_END) { fprintf(stderr, "kernel_launch: unexpected shapes (n_in %d out %d ws %zu)\n", n_in, out_size, ws_size); grid = -1; return; }
        int dev = 0, cus = 0, per_cu = 0;
        if (hipGetDevice(&dev) != hipSuccess || hipDeviceGetAttribute(&cus, hipDeviceAttributeMultiprocessorCount, dev) != hipSuccess) { grid = -1; return; }
        if (hipFuncSetAttribute((const void*)mega_fwd, hipFuncAttributeMaxDynamicSharedMemorySize, LDS_BYTES) != hipSuccess) { fprintf(stderr, "kernel_launch: hipFuncSetAttribute failed\n"); grid = -1; return; }
        if (hipOccupancyMaxActiveBlocksPerMultiprocessor(&per_cu, (const void*)mega_fwd, NTHREADS, LDS_BYTES) != hipSuccess || per_cu < 1) fprintf(stderr, "kernel_launch: occupancy query says %d\n", per_cu);
        (void)hipGetLastError();
        grid = cus;
        if (grid < 128 || grid > 512) { fprintf(stderr, "kernel_launch: built for 128..512 CUs (the MoE router keeps <= 512 tokens per workgroup in LDS); got %d\n", grid); grid = -1; return; }
    }
    if (grid < 0) return;
    (void)in_sizes;
    hipMemsetAsync((char*)d_ws + WS_CTL, 0, CTL_ZERO_BYTES, stream);
    Params p{};
    for (int i = 0; i < 37; ++i) p.in[i] = (const float*)d_in[i];
    p.out = (float*)d_out; p.ws = (unsigned char*)d_ws;
#if MK_PER_PHASE
    for (int k = 0; k < NPHASE; ++k) { p.ph_lo = k; p.ph_hi = k + 1; hipLaunchKernelGGL(mega_fwd, dim3(grid), dim3(NTHREADS), LDS_BYTES, stream, p); }
#else
    p.ph_lo = 0; p.ph_hi = NPHASE; hipLaunchKernelGGL(mega_fwd, dim3(grid), dim3(NTHREADS), LDS_BYTES, stream, p);
#endif
}
```

```cpp
#include <hip/hip_runtime.h>
#include <stdint.h>
#include <stdio.h>

#ifndef MK_PER_PHASE
#define MK_PER_PHASE 0
#endif

#ifndef PROBE_MASK
#define PROBE_MASK 0u
#endif
#ifndef PROBE_PID
#define PROBE_PID -1
#endif
#ifndef PROBE_SUB
#define PROBE_SUB 0
#endif
#define LAS __attribute__((address_space(3)))
typedef unsigned short bf16_t;
typedef short bf16x8 __attribute__((ext_vector_type(8)));
typedef float f32x4 __attribute__((ext_vector_type(4)));
typedef float f32x2 __attribute__((ext_vector_type(2)));
typedef unsigned u32x4 __attribute__((ext_vector_type(4)));
typedef unsigned u32x2 __attribute__((ext_vector_type(2)));

constexpr int T_TOK = 65536, DM = 1024, SEQ = 4096;
constexpr int NPROJ = 5888;
constexpr int PC_Z = 0, PC_XBC = 1024, PC_Q = 2560, PC_K = 3072, PC_V = 3584, PC_G = 4608, PC_DT = 5632;
constexpr int NTHREADS = 512;
constexpr int LDS_BYTES = 147456;
constexpr int LDS_MISC = LDS_BYTES - 256;
constexpr int NSLOT = T_TOK + 24 * 256;
constexpr int NPHASE = 23;
constexpr int PT_WIN = 1472, PT_WOUT = PT_WIN + 512, PT_RW = PT_WOUT + 1024, PT_L1 = PT_RW + 256, PT_L2 = PT_L1 + 192, PT_W13 = PT_L2 + 8192, PT_W2 = PT_W13 + 4096;
#if PROBE_SUB
#define SP_DECL unsigned long long sp_t_ = wall_clock64()
#define SP_MARK(id_end) do { if (F.tid == 0) { const unsigned long long n_ = wall_clock64(); if ((id_end) == PROBE_SUB) *(LAS unsigned long long*)(F.lds + LDS_MISC + 64) += n_ - sp_t_; sp_t_ = n_; } } while (0)
#else
#define SP_DECL do {} while (0)
#define SP_MARK(id_end) do {} while (0)
#endif

constexpr size_t MiB = 1024 * 1024;
constexpr size_t WS_CTL = 0;
constexpr size_t CTL_ZERO_BYTES = 16384;
constexpr size_t CTL_CNT_OFF = 14336;
constexpr size_t WS_META = 64 * 1024;
constexpr size_t META_STRIDE = 2 * MiB - 32 * 1024;
constexpr size_t MT_RANK = 0, MT_BKT = 262144, MT_C = 524288, MT_STOK = 1048576, MT_SC = 1048576 + 294912, MT_TILE = 1048576 + 294912 + 589824;
constexpr size_t WS_ROPE = 4 * MiB;
constexpr size_t WS_WB = 6 * MiB;
constexpr size_t WB_WIN = 0, WB_WOUT = WB_WIN + (size_t)NPROJ * 1024 * 2, WB_WR = WB_WOUT + (size_t)1024 * 2048 * 2, WB_WK = WB_WR + 2 * MiB, WB_WV = WB_WK + 2 * MiB, WB_WO = WB_WV + 2 * MiB,
                 WB_L1 = WB_WO + 2 * MiB  , WB_L2 = WB_L1 + 2 * MiB  , WB_W13 = WB_L2 + 3 * 512 * 1024  ,
                 WB_W2 = WB_W13 + (size_t)32 * 2 * MiB  , WB_END = WB_W2 + (size_t)32 * MiB;
constexpr size_t WS_SLAB = 130 * MiB;
constexpr size_t SLAB = 128 * MiB;
constexpr size_t WS_E = WS_SLAB + 6 * SLAB;
constexpr size_t WS_END = WS_E + 96 * MiB;
constexpr size_t WS_STATS = WS_E + 64 * MiB;
constexpr size_t WS_RTW = WS_WB + WB_END;
static_assert(WS_RTW + 2 * 20 * 1024 * 4 <= WS_SLAB, "weights overflow");
static_assert(WS_END <= 1024 * MiB, "workspace overflow");

struct Params {
    const float* in[37];
    float* out;
    unsigned char* ws;
    int ph_lo, ph_hi;
};

__device__ __forceinline__ float bf2f(bf16_t v) { return __uint_as_float(((unsigned)v) << 16); }
__device__ __forceinline__ float bflo(unsigned w) { return __uint_as_float(w << 16); }
__device__ __forceinline__ float bfhi(unsigned w) { return __uint_as_float(w & 0xffff0000u); }
__device__ __forceinline__ unsigned cvt_pk_bf16(float lo, float hi) { unsigned r; asm volatile("v_cvt_pk_bf16_f32 %0, %1, %2" : "=v"(r) : "v"(lo), "v"(hi)); return r; }
__device__ __forceinline__ bf16_t f2bf(float f) { return (bf16_t)(cvt_pk_bf16(f, 0.f) & 0xffffu); }
__device__ __forceinline__ float wave_sum(float v) {
#pragma unroll
    for (int o = 32; o >= 1; o >>= 1) v += __shfl_xor(v, o);
    return v;
}
__device__ __forceinline__ float dpp_sum16(float x) {
    x += __builtin_bit_cast(float, __builtin_amdgcn_update_dpp(0, __builtin_bit_cast(int, x), 0xB1, 0xF, 0xF, true));
    x += __builtin_bit_cast(float, __builtin_amdgcn_update_dpp(0, __builtin_bit_cast(int, x), 0x4E, 0xF, 0xF, true));
    x += __builtin_bit_cast(float, __builtin_amdgcn_update_dpp(0, __builtin_bit_cast(int, x), 0x141, 0xF, 0xF, true));
    x += __builtin_bit_cast(float, __builtin_amdgcn_update_dpp(0, __builtin_bit_cast(int, x), 0x140, 0xF, 0xF, true));
    return x;
}
__device__ __forceinline__ float wave_sum_u(float x) {
    x = dpp_sum16(x);
    x += __builtin_bit_cast(float, __builtin_amdgcn_update_dpp(0, __builtin_bit_cast(int, x), 0x142, 0xA, 0xF, false));
    x += __builtin_bit_cast(float, __builtin_amdgcn_update_dpp(0, __builtin_bit_cast(int, x), 0x143, 0xC, 0xF, false));
    return __builtin_bit_cast(float, __builtin_amdgcn_readlane(__builtin_bit_cast(int, x), 63));
}
__device__ __forceinline__ float fsilu(float x) { return x * __builtin_amdgcn_rcpf(1.f + __expf(-x)); }
__device__ __forceinline__ float fsigmoid(float x) { return __builtin_amdgcn_rcpf(1.f + __expf(-x)); }
__device__ __forceinline__ float fsoftplus(float x) { return x > 20.f ? x : log1pf(__expf(x)); }
__device__ __forceinline__ float ftanh(float x) { const float xc = fminf(fmaxf(x, -15.f), 15.f); const float e = __expf(2.f * xc); return (e - 1.f) * __builtin_amdgcn_rcpf(e + 1.f); }
__device__ __forceinline__ int ld_vec_i32(const int* p) { int r; asm volatile("global_load_dword %0, %1, off\n\ts_waitcnt vmcnt(0)" : "=&v"(r) : "v"(p) : "memory"); return r; }

#define XB_TMO      128
#define XB_XCNT(j)  (256  + 64 * (j))
#define XB_XSUB(j)  (1280 + 64 * (j))
#define XB_XGEN(j)  (2304 + 64 * (j))
#define XB_TOP      3328
#define XB_TOPGEN   3392
#define XCD_BAR_WORDS 3456
#define XB_SPIN_CAP (1u << 24)
__device__ __forceinline__ unsigned xb_ld(unsigned* p)              { return __hip_atomic_load(p, __ATOMIC_RELAXED, __HIP_MEMORY_SCOPE_AGENT); }
__device__ __forceinline__ unsigned xb_add(unsigned* p, unsigned v) { return __hip_atomic_fetch_add(p, v, __ATOMIC_RELAXED, __HIP_MEMORY_SCOPE_AGENT); }
__device__ __forceinline__ unsigned xb_xcc_id() { return (unsigned)__builtin_amdgcn_s_getreg((3 << 11) | 20) & 0xFu; }
#define XB_SPIN(cond, bar) do { unsigned _sp = 0; while (cond) { __builtin_amdgcn_s_sleep(1); \
    if ((++_sp & 255u) == 0u) { if (xb_ld(&(bar)[XB_TMO])) break; if (_sp > XB_SPIN_CAP) { atomicAdd(&(bar)[XB_TMO], 1u); break; } } } } while (0)
struct XcdBarrier { unsigned* bar; unsigned x; volatile LAS unsigned* st; };
__device__ __forceinline__ XcdBarrier xcd_barrier_post(unsigned* bar, volatile LAS unsigned* st) {
    XcdBarrier b; b.bar = bar; b.x = xb_xcc_id(); b.st = st;
    if (threadIdx.x == 0) (void)xb_add(&bar[XB_XCNT(b.x)], 1u);
    return b;
}
__device__ __forceinline__ void xcd_barrier_complete(unsigned* bar, unsigned x, unsigned& nloc, unsigned& nx) {
    const unsigned G = gridDim.x * gridDim.y * gridDim.z;
    unsigned sum, cnt, mine, sp = 0u;
    for (;;) {
        sum = 0u; cnt = 0u; mine = 0u;
#pragma unroll
        for (unsigned j = 0; j < 16; ++j) { const unsigned c = xb_ld(&bar[XB_XCNT(j)]); sum += c; cnt += (c > 0u) ? 1u : 0u; mine = (j == x) ? c : mine; }
        if (sum == G) break;
        __builtin_amdgcn_s_sleep(1);
        if ((++sp & 255u) == 0u) { if (xb_ld(&bar[XB_TMO])) break; if (sp > XB_SPIN_CAP) { atomicAdd(&bar[XB_TMO], 1u); break; } }
    }
    nloc = mine > 0u ? mine : 1u; nx = cnt > 0u ? cnt : 1u;
}
__device__ __forceinline__ void xcd_barrier(const XcdBarrier& b) {
    asm volatile("s_waitcnt vmcnt(0)" ::: "memory");
    __syncthreads();
    if (threadIdx.x == 0) {
        unsigned* bar = b.bar;
        __builtin_amdgcn_s_waitcnt(0);
        unsigned nloc = b.st[0], nx = b.st[1];
        if (nloc == 0u) { xcd_barrier_complete(bar, b.x, nloc, nx); b.st[0] = nloc; b.st[1] = nx; }
        const unsigned old = xb_add(&bar[XB_XSUB(b.x)], 1u);
        const unsigned gen = old / nloc;
        if (old + 1u == (gen + 1u) * nloc) {
            __builtin_amdgcn_fence(__ATOMIC_RELEASE, "agent");
            asm volatile("s_waitcnt vmcnt(0)" ::: "memory");
            const unsigned og = xb_add(&bar[XB_TOP], 1u);
            const unsigned tg = og / nx;
            if (og + 1u == (tg + 1u) * nx) xb_add(&bar[XB_TOPGEN], 1u);
            else XB_SPIN(xb_ld(&bar[XB_TOPGEN]) == tg, bar);
            __builtin_amdgcn_fence(__ATOMIC_ACQUIRE, "agent");
            xb_add(&bar[XB_XGEN(b.x)], 1u);
            asm volatile("s_waitcnt vmcnt(0)" ::: "memory");
        } else {
            XB_SPIN(xb_ld(&bar[XB_XGEN(b.x)]) == gen, bar);
            __builtin_amdgcn_fence(__ATOMIC_ACQUIRE, "agent");
            asm volatile("s_waitcnt vmcnt(0)" ::: "memory");
        }
    }
    __syncthreads();
}

typedef int i32x4v __attribute__((ext_vector_type(4)));
typedef int i32x8v __attribute__((ext_vector_type(8)));
__device__ __forceinline__ unsigned pk_fp8x4(float a, float b, float c, float d) {
    a = __builtin_amdgcn_fmed3f(a, -448.f, 448.f); b = __builtin_amdgcn_fmed3f(b, -448.f, 448.f); c = __builtin_amdgcn_fmed3f(c, -448.f, 448.f); d = __builtin_amdgcn_fmed3f(d, -448.f, 448.f);
    int w = __builtin_amdgcn_cvt_pk_fp8_f32(a, b, 0, false); w = __builtin_amdgcn_cvt_pk_fp8_f32(c, d, w, true); return (unsigned)w; }
#define F8_INPROJ 0
#define F8_OUTPROJ 0
#define F8_RV 1
#define F8_K 1
#define F8_WO 0
#define F8_L1 1
constexpr float F8_ACT_SCALE = 8.f, F8_W_SCALE = 256.f, F8_DESCALE = 1.f / (8.f * 256.f);
constexpr int BM = 256, BK = 64, HALF = 128, HTB = HALF * BK * 2, STAGE_BYTES = 8 * HTB;
__device__ __forceinline__ int lds_byte(int r, int c) { const int st = (r >> 4) * 2 + (c >> 5), rr = r & 15, cc = c & 31, ob = rr * 64 + cc * 2; return st * 1024 + (ob ^ (((ob >> 9) & 1) << 5)); }
__device__ __forceinline__ void stage_rc(int b, int& R, int& C) { const int st = b / 1024, sb = b % 1024, swz = sb ^ (((sb >> 9) & 1) << 5); R = (st >> 1) * 16 + swz / 64; C = (st & 1) * 32 + (swz % 64) / 2; }
__device__ __forceinline__ int perm32(int rho) { const int n = rho >> 4, i = rho & 15; return 8 * (i >> 2) + 4 * n + (i & 3); }
struct Unit { int pm, pn, prob; };
__device__ __forceinline__ void tile_order(int L, int nM, int nN, int& pm, int& pn) {
    const int nwg = nM * nN; int wgid = L;
    { const int q = nwg / 8, r = nwg % 8, xcd = wgid % 8, off = wgid / 8; wgid = (xcd < r ? xcd * (q + 1) : r * (q + 1) + (xcd - r) * q) + off; }
    const int nig = 8 * nN, gid = wgid / nig, fm = gid * 8, gsz = (nM - fm) < 8 ? (nM - fm) : 8;
    pm = fm + ((wgid % nig) % gsz); pn = (wgid % nig) / gsz;
}

template <class P>
__device__ __forceinline__ void gemm_phase(LAS unsigned char* lds, const P& S) {
    const int tid = threadIdx.x, wid = __builtin_amdgcn_readfirstlane(tid >> 6), lane = tid & 63, wr = wid >> 2, wc = wid & 3, fr = lane & 15, fq = lane >> 4;
    const int K = S.K, nt = K / BK, lda = S.lda, ldb = S.ldb;
    int RA[2], CA[2]; unsigned voffB[2], vAc[2][2], vAn[2][2];
#pragma unroll
    for (int i = 0; i < 2; ++i) { int R, C; stage_rc(tid * 16 + i * 8192, R, C); RA[i] = R; CA[i] = C; const int Rb = P::PERM ? ((R & ~31) + perm32(R & 31)) : R;
        voffB[i] = (unsigned)(Rb * ldb + C) * 2u;
#pragma unroll
        for (int h = 0; h < 2; ++h) { vAc[h][i] = (unsigned)((h * HALF + R) * lda + C) * 2u; vAn[h][i] = vAc[h][i]; } }
    const size_t kstep = (size_t)(BK * 2);
    const size_t hstepB = (size_t)HALF * ldb * 2;
    const unsigned ldsw = (unsigned)wid * 1024u;
    const int aoff = lds_byte(wr * 64 + fr, fq * 8), boff = lds_byte(wc * 32 + fr, fq * 8);
#define PG8_SA(b, h) (((b) * 2 + (h)) * HTB)
#define PG8_SB(b, h) ((4 + (b) * 2 + (h)) * HTB)
#define PG8_STAGE2(bufoff, gbase, v0, v1) do { \
        __builtin_amdgcn_global_load_lds((const unsigned*)((const char*)(gbase) + (v0)), (LAS unsigned*)(lds + (bufoff) + ldsw), 16, 0, 0); \
        __builtin_amdgcn_global_load_lds((const unsigned*)((const char*)(gbase) + (v1)), (LAS unsigned*)(lds + (bufoff) + ldsw + 8192), 16, 0, 0); } while (0)
#define PG8_CAT8(x0_, x1_) __builtin_shufflevector(__builtin_bit_cast(i32x4v, x0_), __builtin_bit_cast(i32x4v, x1_), 0, 1, 2, 3, 4, 5, 6, 7)
#define PG8_LDA(dst, b, h) do { if constexpr (P::FP8) { _Pragma("unroll") for (int m = 0; m < 4; ++m) dst##8[m] = PG8_CAT8(*(const LAS bf16x8*)(lds + PG8_SA(b, h) + aoff + m * 2048), *(const LAS bf16x8*)(lds + PG8_SA(b, h) + aoff + m * 2048 + 1024)); } \
        else { _Pragma("unroll") for (int m = 0; m < 4; ++m) _Pragma("unroll") for (int k = 0; k < 2; ++k) dst[m][k] = *(const LAS bf16x8*)(lds + PG8_SA(b, h) + aoff + m * 2048 + k * 1024); } } while (0)
#define PG8_LDB(dst, b, h) do { if constexpr (P::FP8) { _Pragma("unroll") for (int n = 0; n < 2; ++n) dst##8[n] = PG8_CAT8(*(const LAS bf16x8*)(lds + PG8_SB(b, h) + boff + n * 2048), *(const LAS bf16x8*)(lds + PG8_SB(b, h) + boff + n * 2048 + 1024)); } \
        else { _Pragma("unroll") for (int n = 0; n < 2; ++n) _Pragma("unroll") for (int k = 0; k < 2; ++k) dst[n][k] = *(const LAS bf16x8*)(lds + PG8_SB(b, h) + boff + n * 2048 + k * 1024); } } while (0)
#define PG8_MMA(ai, bj, At, Bt) do { __builtin_amdgcn_s_setprio(1); \
        if constexpr (P::FP8) { _Pragma("unroll") for (int m = 0; m < 4; ++m) _Pragma("unroll") for (int n = 0; n < 2; ++n) \
            asm volatile("v_mfma_f32_16x16x128_f8f6f4 %0, %1, %2, %0" : "+v"(acc[ai][bj][m][n]) : "v"(Bt##8[n]), "v"(At##8[m])); }        \
        else { _Pragma("unroll") for (int m = 0; m < 4; ++m) _Pragma("unroll") for (int n = 0; n < 2; ++n) _Pragma("unroll") for (int k = 0; k < 2; ++k) \
            acc[ai][bj][m][n] = __builtin_amdgcn_mfma_f32_16x16x32_bf16(Bt[n][k], At[m][k], acc[ai][bj][m][n], 0, 0, 0); } \
        __builtin_amdgcn_s_setprio(0); } while (0)
#define PG8_WAIT_V(n) asm volatile("s_waitcnt vmcnt(" #n ")" ::: "memory")
#define PG8_WAIT_L(n) asm volatile("s_waitcnt lgkmcnt(" #n ")" ::: "memory")
#define PG8_BAR __builtin_amdgcn_s_barrier()
#define LDS_BAR() asm volatile("s_waitcnt lgkmcnt(0)\n\ts_barrier" ::: "memory")
#define PG8_SCHED __builtin_amdgcn_sched_barrier(0)
    Unit cur, nxt; int ui = 0;
    if (!S.next(0, cur)) return;
    struct { int tid; LAS unsigned char* lds; } F; F.tid = tid; F.lds = lds; (void)F;
    SP_DECL;
    if constexpr (P::GATHER) {
#pragma unroll
        for (int h = 0; h < 2; ++h)
#pragma unroll
            for (int i = 0; i < 2; ++i) vAc[h][i] = S.a_voff(cur, h * HALF + RA[i], CA[i]);
    }
    float zf; asm volatile("v_mov_b32 %0, 0" : "=v"(zf));
    f32x4 acc[2][2][4][2];
#pragma unroll
    for (int a = 0; a < 2; ++a)
#pragma unroll
        for (int b = 0; b < 2; ++b)
#pragma unroll
            for (int m = 0; m < 4; ++m)
#pragma unroll
                for (int n = 0; n < 2; ++n) acc[a][b][m][n] = (f32x4){zf, zf, zf, zf};
    bf16x8 At[4][2], B0[2][2], B1[2][2]; i32x8v At8[4], B08[2], B18[2]; (void)At; (void)B0; (void)B1; (void)At8; (void)B08; (void)B18;
    const char* cA = S.a_ptr(cur);
    {
        const char* b0 = S.b_ptr(cur, 0); const char* b1 = S.b_ptr(cur, 1);
        const char* cA0 = cA + S.a_kadj(0);
        PG8_STAGE2(PG8_SB(0, 0), b0, voffB[0], voffB[1]); PG8_STAGE2(PG8_SA(0, 0), cA0, vAc[0][0], vAc[0][1]); PG8_STAGE2(PG8_SB(0, 1), b0 + hstepB, voffB[0], voffB[1]); PG8_STAGE2(PG8_SA(0, 1), cA0, vAc[1][0], vAc[1][1]);
        if (wr == 1) PG8_BAR;
        PG8_WAIT_V(4); PG8_BAR;
        PG8_STAGE2(PG8_SB(1, 0), b1, voffB[0], voffB[1]); PG8_STAGE2(PG8_SA(1, 0), cA + kstep + S.a_kadj(1), vAc[0][0], vAc[0][1]); PG8_STAGE2(PG8_SB(1, 1), b1 + hstepB, voffB[0], voffB[1]);
        PG8_WAIT_V(6); PG8_BAR;
    }
    for (;;) {
        const bool has_next = S.next(ui + 1, nxt);
        S.unit_begin(cur, lds, tid, ui);
        if (!has_next) nxt = cur;
        if constexpr (P::GATHER) {
            if (has_next) {
#pragma unroll
                for (int h = 0; h < 2; ++h)
#pragma unroll
                    for (int i = 0; i < 2; ++i) vAn[h][i] = S.a_voff(nxt, h * HALF + RA[i], CA[i]);
            }
        }
        const char* nA = S.a_ptr(nxt);
        for (int t = 0; t < nt; t += 2) {
            S.seg_scale(t, acc, wr, fr, lds, ui);
            const bool last = (t == nt - 2);
            const char* a1 = cA + (size_t)(t + 1) * kstep + S.a_kadj(t + 1);
            const char* a2 = last ? nA + S.a_kadj(0) : cA + (size_t)(t + 2) * kstep + S.a_kadj(t + 2);
            const char* a3 = last ? nA + kstep + S.a_kadj(1) : cA + (size_t)(t + 3) * kstep + S.a_kadj(t + 3);
            const char* b2 = last ? S.b_ptr(nxt, 0) : S.b_ptr(cur, t + 2);
            const char* b3 = last ? S.b_ptr(nxt, 1) : S.b_ptr(cur, t + 3);
            unsigned s00 = vAc[0][0], s01 = vAc[0][1], s10 = vAc[1][0], s11 = vAc[1][1];
            if constexpr (P::GATHER) { if (last) { s00 = vAn[0][0]; s01 = vAn[0][1]; s10 = vAn[1][0]; s11 = vAn[1][1]; } }
            PG8_LDB(B0, 0, 0); PG8_SCHED; PG8_LDA(At, 0, 0); PG8_STAGE2(PG8_SA(1, 1), a1, vAc[1][0], vAc[1][1]);
            PG8_WAIT_L(8); PG8_BAR; PG8_WAIT_L(0); PG8_MMA(0, 0, At, B0); PG8_BAR; PG8_SCHED;
            PG8_LDB(B1, 0, 1); PG8_STAGE2(PG8_SB(0, 0), b2, voffB[0], voffB[1]);
            PG8_BAR; PG8_WAIT_L(0); PG8_MMA(0, 1, At, B1); PG8_BAR;
            PG8_LDA(At, 0, 1); PG8_STAGE2(PG8_SA(0, 0), a2, s00, s01);
            PG8_BAR; PG8_WAIT_L(0); PG8_MMA(1, 0, At, B0); PG8_BAR; PG8_SCHED;
            PG8_STAGE2(PG8_SB(0, 1), b2 + hstepB, voffB[0], voffB[1]);
            PG8_WAIT_V(6); PG8_BAR; PG8_MMA(1, 1, At, B1); PG8_BAR;
            PG8_LDB(B0, 1, 0); PG8_SCHED; PG8_LDA(At, 1, 0); PG8_STAGE2(PG8_SA(0, 1), a2, s10, s11);
            PG8_WAIT_L(8); PG8_BAR; PG8_WAIT_L(0); PG8_MMA(0, 0, At, B0); PG8_BAR; PG8_SCHED;
            PG8_LDB(B1, 1, 1); PG8_STAGE2(PG8_SB(1, 0), b3, voffB[0], voffB[1]);
            PG8_BAR; PG8_WAIT_L(0); PG8_MMA(0, 1, At, B1); PG8_BAR;
            PG8_LDA(At, 1, 1); PG8_STAGE2(PG8_SA(1, 0), a3, s00, s01);
            PG8_BAR; PG8_WAIT_L(0); PG8_MMA(1, 0, At, B0); PG8_BAR; PG8_SCHED;
            PG8_STAGE2(PG8_SB(1, 1), b3 + hstepB, voffB[0], voffB[1]);
            PG8_WAIT_V(6); PG8_BAR; PG8_MMA(1, 1, At, B1); PG8_BAR;
        }
        SP_MARK((PROBE_PID < 0 || S.pid == PROBE_PID) ? 10 : -1);
        if constexpr (P::FP8) asm volatile("s_nop 15\n\ts_nop 15\n\ts_nop 15" ::: "memory");
        S.epi(acc, cur, wr, wc, fr, fq, lds, ui);
        SP_MARK((PROBE_PID < 0 || S.pid == PROBE_PID) ? 9 : -1);
        if (!has_next) break;
#pragma unroll
        for (int a = 0; a < 2; ++a)
#pragma unroll
            for (int b = 0; b < 2; ++b)
#pragma unroll
                for (int m = 0; m < 4; ++m)
#pragma unroll
                    for (int n = 0; n < 2; ++n) acc[a][b][m][n] = (f32x4){zf, zf, zf, zf};
        cur = nxt; cA = nA; ++ui;
        if constexpr (P::GATHER) {
#pragma unroll
            for (int h = 0; h < 2; ++h)
#pragma unroll
                for (int i = 0; i < 2; ++i) vAc[h][i] = vAn[h][i];
        }
    }
    PG8_WAIT_V(0);
    if (wr == 0) PG8_BAR;
    PG8_BAR;
#undef PG8_SA
#undef PG8_SB
#undef PG8_STAGE2
#undef PG8_LDA
#undef PG8_LDB
#undef PG8_MMA
#undef PG8_WAIT_V
#undef PG8_WAIT_L
#undef PG8_BAR
#undef PG8_SCHED
}

enum { EK_BF16 = 0, EK_LORA1 = 1, EK_LORA2 = 2, EK_F32RES = 3, EK_INPROJ = 4 };
template <int KIND, bool F8 = false>
struct DenseP {
    static constexpr bool PERM = true, GATHER = false;
    int K, lda, ldb, nM, nN, nprob, G, c, pid;
    static constexpr bool FP8 = F8; static constexpr float DS = F8 ? F8_DESCALE : 1.f;
    const bf16_t* A; size_t a_stride;
    const bf16_t* Aalt1; const bf16_t* Aalt2;
    int a_skew;
    int a_split; long a_jump;
    const bf16_t* B; size_t b_stride;
    bf16_t* O; size_t o_stride; int ldc;
    bf16_t* Oalt1; bf16_t* Oalt2;
    const float* resf; const bf16_t* resb; bf16_t* Ob;
    const float* v0; const float* v1;
    const float* seg_stats;
    __device__ __forceinline__ void unit_begin(const Unit& u, LAS unsigned char* lds, int tid, int ui) const {
        if constexpr (KIND == EK_F32RES) { if (seg_stats && tid < 256) { const f32x4* sp = (const f32x4*)(seg_stats + ((size_t)u.pm * BM + tid) * 32);
            const f32x4 a0 = sp[0], a1 = sp[1], a2 = sp[2], a3 = sp[3], b0 = sp[4], b1 = sp[5], b2 = sp[6], b3 = sp[7];
            const float g0 = ((a0[0] + a0[1]) + (a0[2] + a0[3])) + ((a1[0] + a1[1]) + (a1[2] + a1[3])), g1 = ((a2[0] + a2[1]) + (a2[2] + a2[3])) + ((a3[0] + a3[1]) + (a3[2] + a3[3]));
            const float h0 = (b0[0] + b0[1]) + (b0[2] + b0[3]), h1 = (b1[0] + b1[1]) + (b1[2] + b1[3]), h2 = (b2[0] + b2[1]) + (b2[2] + b2[3]), h3 = (b3[0] + b3[1]) + (b3[2] + b3[3]);
            const float r0 = rsqrtf(g0 * (1.f / 512.f) + 1e-5f), r1 = rsqrtf(g1 * (1.f / 512.f) + 1e-5f), r2 = rsqrtf(h0 * (1.f / 256.f) + 1e-6f), r3 = rsqrtf(h1 * (1.f / 256.f) + 1e-6f), r4 = rsqrtf(h2 * (1.f / 256.f) + 1e-6f), r5 = rsqrtf(h3 * (1.f / 256.f) + 1e-6f);
            LAS float* tb = (LAS float*)(lds + STAGE_BYTES) + (ui & 1) * 1536 + tid * 6;
            tb[0] = r0 / r1; tb[1] = r1 / r2; tb[2] = r2 / r3; tb[3] = r3 / r4; tb[4] = r4 / r5; tb[5] = r5; } }
    }
    __device__ __forceinline__ void seg_scale(int t, f32x4 (&acc)[2][2][4][2], int wr, int fr, LAS unsigned char* lds, int ui) const {
        if constexpr (KIND == EK_F32RES) { if (seg_stats) { const int bidx = (t == 8) ? 0 : (t == 16) ? 1 : (t == 20) ? 2 : (t == 24) ? 3 : (t == 28) ? 4 : -1;
            if (bidx >= 0) { const LAS float* tb = (const LAS float*)(lds + STAGE_BYTES) + (ui & 1) * 1536 + bidx;
#pragma unroll
                for (int ai = 0; ai < 2; ++ai)
#pragma unroll
                    for (int m = 0; m < 4; ++m) { const float rt = tb[(ai * HALF + wr * 64 + m * 16 + fr) * 6];
#pragma unroll
                        for (int bj = 0; bj < 2; ++bj)
#pragma unroll
                            for (int n = 0; n < 2; ++n) acc[ai][bj][m][n] = acc[ai][bj][m][n] * rt; }
                __builtin_amdgcn_sched_barrier(0); } } }
    }
    __device__ __forceinline__ bool next(int i, Unit& u) const {
        const long L = (long)i * G + c; const int per = nM * nN; if (L >= (long)per * nprob) return false;
        u.prob = (int)(L / per); tile_order((int)(L % per), nM, nN, u.pm, u.pn); return true;
    }
    __device__ __forceinline__ const char* a_ptr(const Unit& u) const { const bf16_t* a0 = Aalt1 ? ((u.prob == 0) ? A : (u.prob == 1) ? Aalt1 : Aalt2) : A + (size_t)u.prob * a_stride; return (const char*)(a0 + ((size_t)u.pm * BM + (a_skew ? (u.pm >> 4) + 1 : 0)) * lda); }
    __device__ __forceinline__ long a_kadj(int kt) const { return (a_split > 0 && kt >= a_split) ? a_jump : 0; }
    __device__ __forceinline__ const char* b_ptr(const Unit& u, int kt) const { return (const char*)(B + (size_t)u.prob * b_stride + (size_t)u.pn * BM * ldb) + (size_t)kt * (BK * 2); }
    __device__ __forceinline__ unsigned a_voff(const Unit&, int, int) const { return 0u; }
    __device__ __forceinline__ void epi(const f32x4 (&acc)[2][2][4][2], const Unit& u, int wr, int wc, int fr, int fq, LAS unsigned char* elds, int eui) const {
        (void)elds; (void)eui;
        const int row0 = u.pm * BM + wr * 64 + fr;
        if constexpr (KIND == EK_F32RES) {
            const int col0 = u.pn * BM + wc * 32 + 8 * fq;
#pragma unroll
            for (int ai = 0; ai < 2; ++ai)
#pragma unroll
                for (int mp = 0; mp < 2; ++mp) {
                    f32x4 r0[2][2], r1[2][2]; float fin[2];
#pragma unroll
                    for (int mm = 0; mm < 2; ++mm) fin[mm] = seg_stats ? ((const LAS float*)(elds + STAGE_BYTES))[(eui & 1) * 1536 + (ai * HALF + wr * 64 + (mp * 2 + mm) * 16 + fr) * 6 + 5] : 1.f;
#pragma unroll
                    for (int mm = 0; mm < 2; ++mm) { const size_t ro = (size_t)(row0 + ai * HALF + (mp * 2 + mm) * 16) * ldc + col0;
#pragma unroll
                        for (int bj = 0; bj < 2; ++bj) {
                            if (resf) { r0[mm][bj] = __builtin_nontemporal_load((const f32x4*)(resf + ro + bj * HALF)); r1[mm][bj] = __builtin_nontemporal_load((const f32x4*)(resf + ro + bj * HALF + 4)); }
                            else { const u32x4 rw = *(const u32x4*)(resb + ro + bj * HALF); r0[mm][bj] = (f32x4){bflo(rw.x), bfhi(rw.x), bflo(rw.y), bfhi(rw.y)}; r1[mm][bj] = (f32x4){bflo(rw.z), bfhi(rw.z), bflo(rw.w), bfhi(rw.w)}; } } }
#pragma unroll
                    for (int mm = 0; mm < 2; ++mm) { const size_t ro = (size_t)(row0 + ai * HALF + (mp * 2 + mm) * 16) * ldc + col0;
#pragma unroll
                        for (int bj = 0; bj < 2; ++bj) { const f32x4 x0 = acc[ai][bj][mp * 2 + mm][0] * (DS * fin[mm]) + r0[mm][bj], x1 = acc[ai][bj][mp * 2 + mm][1] * (DS * fin[mm]) + r1[mm][bj];
                            u32x4 w; w.x = cvt_pk_bf16(x0[0], x0[1]); w.y = cvt_pk_bf16(x0[2], x0[3]); w.z = cvt_pk_bf16(x1[0], x1[1]); w.w = cvt_pk_bf16(x1[2], x1[3]);
                            *(u32x4*)(Ob + ro + bj * HALF) = w; } }
                }
        } else {
            const int col0 = u.pn * BM + wc * 32 + 8 * fq;
            bf16_t* base = Oalt1 ? ((u.prob == 0) ? O : (u.prob == 1) ? Oalt1 : Oalt2) : O + (size_t)u.prob * o_stride;
            f32x4 bv[2][2];
#pragma unroll
            for (int bj = 0; bj < 2; ++bj)
#pragma unroll
                for (int n = 0; n < 2; ++n) {
                    if constexpr (KIND == EK_LORA2) { bv[bj][n] = (u.prob == 0) ? *(const f32x4*)(v0 + col0 + bj * HALF + 4 * n) : (u.prob == 1) ? *(const f32x4*)(v1 + col0 + bj * HALF + 4 * n) : (f32x4){0.f, 0.f, 0.f, 0.f}; }
                    else bv[bj][n] = (f32x4){0.f, 0.f, 0.f, 0.f};
                }
#pragma unroll
            for (int ai = 0; ai < 2; ++ai)
#pragma unroll
                for (int m = 0; m < 4; ++m) { bf16_t* rowp = base + (size_t)(row0 + ai * HALF + m * 16) * ldc + col0;
#pragma unroll
                    for (int bj = 0; bj < 2; ++bj) { f32x4 x0 = acc[ai][bj][m][0] * DS + bv[bj][0], x1 = acc[ai][bj][m][1] * DS + bv[bj][1];
                        if constexpr (KIND == EK_LORA1) {
                            const int g0 = u.pn * BM + bj * HALF + wc * 32; const float kx = (g0 < 64) ? 2.f : 1.f;
#pragma unroll
                            for (int j = 0; j < 4; ++j) { const float s0 = fsigmoid(kx * x0[j]), s1 = fsigmoid(kx * x1[j]);
                                x0[j] = (g0 < 64) ? 2.f * s0 - 1.f : (g0 >= 128) ? s0 : x0[j]; x1[j] = (g0 < 64) ? 2.f * s1 - 1.f : (g0 >= 128) ? s1 : x1[j]; } }
                        if constexpr (KIND == EK_LORA2) {
                            const float sc = (u.prob == 0) ? 0.6065306597126334f : 1.f;
#pragma unroll
                            for (int j = 0; j < 4; ++j) { const float s0 = sc * fsigmoid(x0[j]), s1 = sc * fsigmoid(x1[j]); x0[j] = (u.prob == 2) ? x0[j] : s0; x1[j] = (u.prob == 2) ? x1[j] : s1; } }
                        if constexpr (KIND == EK_INPROJ) {
                            if (u.pn >= PC_Q / 256 && u.pn < PC_V / 256) { const int pos = (row0 + ai * HALF + m * 16) & (SEQ - 1); const float sc = (u.pn >= PC_K / 256) ? 0.08838834764831845f : 1.f;
                                const f32x4 cs0 = *(const f32x4*)(v0 + ((size_t)pos * 64 + wc * 16 + 4 * fq) * 2), cs1 = *(const f32x4*)(v0 + ((size_t)pos * 64 + wc * 16 + 4 * fq + 2) * 2);
                                const f32x4 a = x0, b = x1;
                                x0[0] = (a[0] * cs0[0] - a[1] * cs0[1]) * sc; x0[1] = (a[0] * cs0[1] + a[1] * cs0[0]) * sc; x0[2] = (a[2] * cs0[2] - a[3] * cs0[3]) * sc; x0[3] = (a[2] * cs0[3] + a[3] * cs0[2]) * sc;
                                x1[0] = (b[0] * cs1[0] - b[1] * cs1[1]) * sc; x1[1] = (b[0] * cs1[1] + b[1] * cs1[0]) * sc; x1[2] = (b[2] * cs1[2] - b[3] * cs1[3]) * sc; x1[3] = (b[2] * cs1[3] + b[3] * cs1[2]) * sc; } }
                        u32x4 w; w.x = cvt_pk_bf16(x0[0], x0[1]); w.y = cvt_pk_bf16(x0[2], x0[3]); w.z = cvt_pk_bf16(x1[0], x1[1]); w.w = cvt_pk_bf16(x1[2], x1[3]);
                        *(u32x4*)(rowp + bj * HALF) = w; } }
        }
    }
};

__device__ __forceinline__ void pair_lohi(int pr, int& lo, int& hi) { lo = (pr < 3) ? 0 : (pr < 5 ? 1 : 2); hi = (pr < 3) ? pr + 1 : (pr < 5 ? pr - 1 : 3); }

template <bool F8>
struct Moe1P {
    static constexpr bool PERM = true, GATHER = true, FP8 = F8;
    int K, lda, ldb, G, c, ntiles, pid;
    const bf16_t* A; const bf16_t* W13;
    bf16_t* H; const int* slot_tok; const float* slot_c; const int* tile_bkt;
    __device__ __forceinline__ bool next(int i, Unit& u) const {
        const int m = (c >> 3) + (G >> 3) * i; if ((G & 7) != 0 || m >= ntiles) { if ((G & 7) == 0) return false; const long L = (long)i * G + c; if (L >= (long)ntiles * 8) return false; u.pm = (int)(L >> 3); u.pn = (int)(L & 7); u.prob = __builtin_amdgcn_readfirstlane(ld_vec_i32(tile_bkt + u.pm)); return true; }
        u.pm = m; u.pn = c & 7; u.prob = __builtin_amdgcn_readfirstlane(ld_vec_i32(tile_bkt + u.pm)); return true;
    }
    __device__ __forceinline__ const char* a_ptr(const Unit&) const { return (const char*)A; }
    __device__ __forceinline__ long a_kadj(int) const { return 0; }
    __device__ __forceinline__ void unit_begin(const Unit&, LAS unsigned char*, int, int) const {}
    __device__ __forceinline__ void seg_scale(int, f32x4 (&)[2][2][4][2], int, int, LAS unsigned char*, int) const {}
    __device__ __forceinline__ unsigned a_voff(const Unit& u, int row, int C) const { int tok = slot_tok[u.pm * BM + row]; tok = tok < 0 ? 0 : tok; return (unsigned)(tok * lda + C) * 2u; }
    __device__ __forceinline__ const char* b_ptr(const Unit& u, int kt) const {
        int lo, hi; pair_lohi(u.prob % 6, lo, hi); const int e = (u.prob / 6) * 4 + ((u.pn < 4) ? lo : hi);
        if constexpr (F8) return (const char*)W13 + (size_t)e * 2097152 + (size_t)(u.pn & 3) * BM * 1024 + (size_t)kt * (BK * 2);
        return (const char*)(W13 + ((size_t)e * 1024 + (size_t)(u.pn & 3) * BM) * 1024) + (size_t)kt * (BK * 2);
    }
    __device__ __forceinline__ void epi(const f32x4 (&acc)[2][2][4][2], const Unit& u, int wr, int wc, int fr, int fq, LAS unsigned char* elds, int eui) const {
        (void)elds; (void)eui;
        const int row0 = u.pm * BM + wr * 64 + fr, col0 = ((u.pn < 4) ? 0 : 512) + (u.pn & 3) * 128 + wc * 32 + 8 * fq, ci = (u.pn < 4) ? 0 : 1;
#pragma unroll
        for (int ai = 0; ai < 2; ++ai)
#pragma unroll
            for (int m = 0; m < 4; ++m) { const int row = row0 + ai * HALF + m * 16; const float cw = slot_c[(size_t)row * 2 + ci];
                const f32x4 g0 = acc[ai][0][m][0], g1 = acc[ai][0][m][1], u0 = acc[ai][1][m][0], u1 = acc[ai][1][m][1]; f32x4 x0, x1;
#pragma unroll
                for (int j = 0; j < 4; ++j) {
                    if constexpr (F8) { x0[j] = fsilu(g0[j] * F8_DESCALE) * (u0[j] * F8_DESCALE) * (cw * F8_ACT_SCALE); x1[j] = fsilu(g1[j] * F8_DESCALE) * (u1[j] * F8_DESCALE) * (cw * F8_ACT_SCALE); }
                    else { x0[j] = fsilu(g0[j]) * u0[j] * cw; x1[j] = fsilu(g1[j]) * u1[j] * cw; } }
                if constexpr (F8) { u32x2 w8; w8.x = pk_fp8x4(x0[0], x0[1], x0[2], x0[3]); w8.y = pk_fp8x4(x1[0], x1[1], x1[2], x1[3]); *(u32x2*)((unsigned char*)H + (size_t)row * 1024 + col0) = w8; continue; }
                u32x4 w; w.x = cvt_pk_bf16(x0[0], x0[1]); w.y = cvt_pk_bf16(x0[2], x0[3]); w.z = cvt_pk_bf16(x1[0], x1[1]); w.w = cvt_pk_bf16(x1[2], x1[3]);
                *(u32x4*)(H + (size_t)row * 1024 + col0) = w; }
    }
};
template <bool F8>
struct Moe2P {
    static constexpr bool PERM = true, GATHER = false, FP8 = F8;
    int K, lda, ldb, G, c, ntiles, pid;
    const bf16_t* H; const bf16_t* W2;
    const bf16_t* hsrc; bf16_t* hdst; const int* slot_tok; const int* tile_bkt;
    __device__ __forceinline__ bool next(int i, Unit& u) const {
        const int m = 2 * ((c >> 3) + (G >> 3) * i) + ((c >> 2) & 1); if ((G & 7) != 0 || m >= ntiles) { if ((G & 7) == 0) return false; const long L = (long)i * G + c; if (L >= (long)ntiles * 4) return false; u.pm = (int)(L >> 2); u.pn = (int)(L & 3); u.prob = __builtin_amdgcn_readfirstlane(ld_vec_i32(tile_bkt + u.pm)); return true; }
        u.pm = m; u.pn = c & 3; u.prob = __builtin_amdgcn_readfirstlane(ld_vec_i32(tile_bkt + u.pm)); return true;
    }
    __device__ __forceinline__ const char* a_ptr(const Unit& u) const { return (const char*)H + (size_t)u.pm * BM * 1024 * (F8 ? 1 : 2); }
    __device__ __forceinline__ long a_kadj(int) const { return 0; }
    __device__ __forceinline__ void unit_begin(const Unit&, LAS unsigned char*, int, int) const {}
    __device__ __forceinline__ void seg_scale(int, f32x4 (&)[2][2][4][2], int, int, LAS unsigned char*, int) const {}
    __device__ __forceinline__ unsigned a_voff(const Unit&, int, int) const { return 0u; }
    __device__ __forceinline__ const char* b_ptr(const Unit& u, int kt) const {
        int lo, hi; pair_lohi(u.prob % 6, lo, hi);
        if constexpr (F8) { const int e8 = (u.prob / 6) * 4 + ((kt < 4) ? lo : hi); return (const char*)W2 + (size_t)e8 * 1048576 + (size_t)u.pn * BM * 512 + (size_t)(kt & 3) * (BK * 2); }
        const int e = (u.prob / 6) * 4 + ((kt < 8) ? lo : hi);
        return (const char*)(W2 + ((size_t)e * 1024 + (size_t)u.pn * BM) * 512) + (size_t)(kt & 7) * (BK * 2);
    }
    __device__ __forceinline__ void epi(const f32x4 (&acc)[2][2][4][2], const Unit& u, int wr, int wc, int fr, int fq, LAS unsigned char* elds, int eui) const {
        (void)elds; (void)eui;
        const int row0 = u.pm * BM + wr * 64 + fr, col0 = u.pn * BM + wc * 32 + 8 * fq;
        int tok[2][4];
#pragma unroll
        for (int ai = 0; ai < 2; ++ai)
#pragma unroll
            for (int m = 0; m < 4; ++m) tok[ai][m] = slot_tok[row0 + ai * HALF + m * 16];
#pragma unroll
        for (int ai = 0; ai < 2; ++ai) {
            u32x4 r[4][2];
#pragma unroll
            for (int m = 0; m < 4; ++m) { const int tk = tok[ai][m]; const bf16_t* rp = hsrc + (size_t)(tk < 0 ? 0 : tk) * 1024 + col0;
#pragma unroll
                for (int bj = 0; bj < 2; ++bj) r[m][bj] = *(const u32x4*)(rp + bj * HALF); }
#pragma unroll
            for (int m = 0; m < 4; ++m) { const int tk = tok[ai][m];
                if (tk >= 0) { bf16_t* wp = hdst + (size_t)tk * 1024 + col0;
#pragma unroll
                    for (int bj = 0; bj < 2; ++bj) { const u32x4 rw = r[m][bj]; const f32x4 a0 = acc[ai][bj][m][0], a1 = acc[ai][bj][m][1]; constexpr float ds = F8 ? F8_DESCALE : 1.f;
                        u32x4 w; w.x = cvt_pk_bf16(fmaf(a0[0], ds, bflo(rw.x)), fmaf(a0[1], ds, bfhi(rw.x))); w.y = cvt_pk_bf16(fmaf(a0[2], ds, bflo(rw.y)), fmaf(a0[3], ds, bfhi(rw.y)));
                        w.z = cvt_pk_bf16(fmaf(a1[0], ds, bflo(rw.z)), fmaf(a1[1], ds, bfhi(rw.z))); w.w = cvt_pk_bf16(fmaf(a1[2], ds, bflo(rw.w)), fmaf(a1[3], ds, bfhi(rw.w)));
                        *(u32x4*)(wp + bj * HALF) = w; } } }
        }
    }
};

struct Frame {
    LAS unsigned char* lds;
    int tid, lane, wave, G, bid;
    float* out; unsigned char* ws;
};
#define WSP(T, off) ((T*)(F.ws + (off)))

__device__ __forceinline__ void prep_tile(const Frame& F, const float* src, int src_ld, int k0, int kvalid, int c0, int nvalid, bf16_t* dst, int dst_ld, bool il = false, int ksrc = -1, const float* kscale = nullptr, bool one_minus = false, float f8scale = 0.f) {
    const int ks0 = ksrc < 0 ? k0 : ksrc;
    LAS float* tl = (LAS float*)F.lds;
    __syncthreads();
#pragma unroll
    for (int p = 0; p < 2; ++p) { const int kk = (F.tid >> 4) + 32 * p, n4 = (F.tid & 15) * 4;
        f32x4 v = (f32x4){0.f, 0.f, 0.f, 0.f};
        if (il) {
            v = __builtin_nontemporal_load((const f32x4*)(src + (size_t)(ks0 + kk) * src_ld + c0 + ((n4 < 32) ? n4 : 32 + n4))); const int d0 = 2 * (n4 & 31) + (n4 >> 5);
            tl[kk * 65 + d0] = v[0]; tl[kk * 65 + d0 + 2] = v[1]; tl[kk * 65 + d0 + 4] = v[2]; tl[kk * 65 + d0 + 6] = v[3];
        } else {
        if (kk < kvalid && n4 < nvalid) v = __builtin_nontemporal_load((const f32x4*)(src + (size_t)(ks0 + kk) * src_ld + c0 + n4));
        if (kscale) { const float f_ = kscale[ks0 + kk]; v = v * (one_minus ? 1.f - f_ : f_); }
        tl[kk * 65 + n4 + 0] = v[0]; tl[kk * 65 + n4 + 1] = v[1]; tl[kk * 65 + n4 + 2] = v[2]; tl[kk * 65 + n4 + 3] = v[3]; } }
    __syncthreads();
    { const int n = F.tid >> 3, kc = (F.tid & 7) * 8; float x[8];
#pragma unroll
        for (int j = 0; j < 8; ++j) x[j] = tl[(kc + j) * 65 + n];
        if (f8scale != 0.f) { u32x2 w8; w8.x = pk_fp8x4(x[0] * f8scale, x[1] * f8scale, x[2] * f8scale, x[3] * f8scale); w8.y = pk_fp8x4(x[4] * f8scale, x[5] * f8scale, x[6] * f8scale, x[7] * f8scale);
            *(u32x2*)((unsigned char*)dst + (size_t)n * dst_ld + k0 + kc) = w8; }
        else { u32x4 w; w.x = cvt_pk_bf16(x[0], x[1]); w.y = cvt_pk_bf16(x[2], x[3]); w.z = cvt_pk_bf16(x[4], x[5]); w.w = cvt_pk_bf16(x[6], x[7]);
        *(u32x4*)(dst + (size_t)n * dst_ld + k0 + kc) = w; } }
}
__device__ __forceinline__ void phase_prep(const Params& p, const Frame& F, int id_lo, int id_hi, bool tables) {
    bf16_t* wb = WSP(bf16_t, WS_WB);
    constexpr int N0 = 1472, N1 = N0 + 512, N2 = N1 + 1024, N3 = N2 + 256, N4 = N3 + 192, N5 = N4 + 8192, N6 = N5 + 4096;
    (void)N6;
    for (int id = id_lo + F.bid; id < id_hi; id += F.G) {
        if (id < N0) { const int nt = id / 16, kt = id % 16, n0 = nt * 64; int c0, nv;
            if (n0 < PC_Q) { c0 = n0; nv = 64; } else if (n0 < PC_DT) { c0 = n0 + 16; nv = 64; } else if (n0 == PC_DT) { c0 = 2560; nv = 16; } else { c0 = 0; nv = 0; }
            const bool il = (n0 >= PC_Q && n0 < PC_V);
            if (il) c0 = 2576 + ((n0 - PC_Q) >> 7) * 128 + (((n0 - PC_Q) >> 6) & 1) * 32;
            if (F8_INPROJ) prep_tile(F, p.in[4], 5648, kt * 64, 64, c0, nv, (bf16_t*)((unsigned char*)wb + WB_WIN + (size_t)n0 * 1024), 1024, il, -1, nullptr, false, F8_W_SCALE);
            else prep_tile(F, p.in[4], 5648, kt * 64, 64, c0, nv, wb + WB_WIN / 2 + (size_t)n0 * 1024, 1024, il); }
        else if (id < N1) { const int j = id - N0, nt = j / 32, kt = j % 32;
            if (F8_OUTPROJ) prep_tile(F, p.in[11], 1024, kt * 64, 64, nt * 64, 64, (bf16_t*)((unsigned char*)wb + WB_WOUT + (size_t)nt * 64 * 2048), 2048, false, -1, nullptr, false, F8_W_SCALE);
            else prep_tile(F, p.in[11], 1024, kt * 64, 64, nt * 64, 64, wb + WB_WOUT / 2 + (size_t)nt * 64 * 2048, 2048, false, -1, (kt < 16) ? p.in[10] : nullptr, false); }
        else if (id < N2) { const int j = id - N1, w = j / 256, r = j % 256, nt = r / 16, kt = r % 16; const float* src = (w == 0) ? p.in[13] : (w == 1) ? p.in[14] : (w == 2) ? p.in[15] : p.in[16];
            if ((w == 3) ? F8_WO : (w == 1) ? F8_K : F8_RV) prep_tile(F, src, 1024, kt * 64, 64, nt * 64, 64, (bf16_t*)((unsigned char*)wb + WB_WR + (size_t)w * 2097152 + (size_t)nt * 64 * 1024), 1024, false, -1, nullptr, false, F8_W_SCALE);
            else prep_tile(F, src, 1024, kt * 64, 64, nt * 64, 64, wb + WB_WR / 2 + (size_t)w * 1048576 + (size_t)nt * 64 * 1024, 1024); }
        else if (id < N3) { const int j = id - N2, nt = j >> 5, kt = j & 31, half = kt >> 4;
            const float* src = (nt == 0) ? p.in[18] : (nt == 1) ? p.in[21] : p.in[23]; const int ncols = (nt < 2) ? 64 : 160, c0 = (nt < 2) ? 0 : (nt - 2) * 64, midx = (nt == 0) ? 1 : (nt == 1) ? 4 : 5;
            int nv = (nt < 2) ? 64 : ncols - c0; nv = nv < 0 ? 0 : (nv > 64 ? 64 : nv); if (nt > 4) nv = 0;
            if (F8_L1) prep_tile(F, src, ncols, kt * 64, 64, (nv ? c0 : 0), nv, (bf16_t*)((unsigned char*)wb + WB_L1 + (size_t)nt * 64 * 2048), 2048, false, (kt & 15) * 64, p.in[12] + midx * DM, !half, F8_W_SCALE);
            else prep_tile(F, src, ncols, kt * 64, 64, (nv ? c0 : 0), nv, wb + WB_L1 / 2 + (size_t)nt * 64 * 2048, 2048, false, (kt & 15) * 64, p.in[12] + midx * DM, !half); }
        else if (id < N4) { const int j = id - N3, w = j / 64, r = j % 64, nt = r / 4, kt = r % 4;
            int kv = (w == 0) ? (kt == 0 ? 64 : 0) : (w == 1) ? (kt == 1 ? 64 : 0) : 160 - kt * 64; kv = kv < 0 ? 0 : (kv > 64 ? 64 : kv);
            const float* src = (w == 0) ? p.in[19] : (w == 1) ? p.in[22] : p.in[24];
            prep_tile(F, src, 1024, kt * 64, kv, nt * 64, 64, wb + WB_L2 / 2 + (size_t)w * 262144 + (size_t)nt * 64 * 256, 256, false, (w == 1) ? 0 : kt * 64); }
        else if (id < N5) { const int j = id - N4, le = j / 256, r = j % 256, nt = r / 16, kt = r % 16;
            const int pn = nt >> 2, part = (nt >> 1) & 1, c0 = 128 * pn + 64 * (nt & 1);
            const float* src = (part ? p.in[35] : p.in[34]) + (size_t)le * 524288;
            if (le >= 0) prep_tile(F, src, 512, kt * 64, 64, c0, 64, (bf16_t*)((unsigned char*)wb + WB_W13 + (size_t)le * 2097152 + (size_t)nt * 64 * 1024), 1024, false, -1, nullptr, false, F8_W_SCALE);
            else prep_tile(F, src, 512, kt * 64, 64, c0, 64, wb + WB_W13 / 2 + (size_t)le * 1048576 + (size_t)nt * 64 * 1024, 1024); }
        else { const int j = id - N5, le = j / 128, r = j % 128, nt = r / 8, kt = r % 8;
            if (le >= 0) prep_tile(F, p.in[36] + (size_t)le * 524288, 1024, kt * 64, 64, nt * 64, 64, (bf16_t*)((unsigned char*)wb + WB_W2 + (size_t)le * 1048576 + (size_t)nt * 64 * 512), 512, false, -1, nullptr, false, F8_W_SCALE);
            else prep_tile(F, p.in[36] + (size_t)le * 524288, 1024, kt * 64, 64, nt * 64, 64, wb + WB_W2 / 2 + (size_t)le * 524288 + (size_t)nt * 64 * 512, 512); }
    }
    if (!tables) { __syncthreads(); return; }
    { float* rtw = WSP(float, WS_RTW);
        for (int idx = F.bid * NTHREADS + F.tid; idx < 2 * 20 * 1024; idx += F.G * NTHREADS) { const int l = idx / 20480, r = idx % 20480, j = r >> 10, k = r & 1023;
            rtw[idx] = (j < 4) ? p.in[30][(size_t)l * 4096 + k * 4 + j] : p.in[32][(size_t)l * 16384 + k * 16 + (j - 4)]; } }
    f32x2* rope = WSP(f32x2, WS_ROPE);
    for (int idx = F.bid * NTHREADS + F.tid; idx < SEQ * 64; idx += F.G * NTHREADS) {
        const int pos = idx >> 6, i = idx & 63;
        const float invf = exp2f(-(float)i * (13.287712379549449f / 64.f));
        const float ang = (float)pos * invf;
        const double x = (double)ang;
        const double kq = rint(x * 0.63661977236758134308);
        double r = fma(-kq, 1.57079632679489655800e+00, x); r = fma(-kq, 6.12323399573676603587e-17, r);
        const double r2 = r * r;
        double sp = -7.6471637318198164759e-13; sp = fma(sp, r2, 1.6059043836821614599e-10); sp = fma(sp, r2, -2.5052108385441718775e-08); sp = fma(sp, r2, 2.7557319223985890653e-06);
        sp = fma(sp, r2, -1.9841269841269841270e-04); sp = fma(sp, r2, 8.3333333333333333333e-03); sp = fma(sp, r2, -1.6666666666666666667e-01); const double sn = fma(sp * r2, r, r);
        double cp = 4.7794773323873852974e-14; cp = fma(cp, r2, -1.1470745597729724714e-11); cp = fma(cp, r2, 2.0876756987868098979e-09); cp = fma(cp, r2, -2.7557319223985890653e-07);
        cp = fma(cp, r2, 2.4801587301587301587e-05); cp = fma(cp, r2, -1.3888888888888888889e-03); cp = fma(cp, r2, 4.1666666666666666667e-02); cp = fma(cp, r2, -0.5); const double cs = fma(cp, r2, 1.0);
        const int q = ((int)kq) & 3;
        const double c = (q == 0) ? cs : (q == 1) ? -sn : (q == 2) ? -cs : sn;
        const double s = (q == 0) ? sn : (q == 1) ? cs : (q == 2) ? -sn : -cs;
        rope[idx] = (f32x2){(float)c, (float)s};
    }
}

__device__ __forceinline__ void row_load(const float* row, int lane, f32x4 (&v)[4]) {
#pragma unroll
    for (int j = 0; j < 4; ++j) v[j] = *(const f32x4*)(row + j * 256 + lane * 4);
}
__device__ __forceinline__ void row_load_nt(const float* row, int lane, f32x4 (&v)[4]) {
#pragma unroll
    for (int j = 0; j < 4; ++j) v[j] = __builtin_nontemporal_load((const f32x4*)(row + j * 256 + lane * 4));
}
__device__ __forceinline__ void row_load_bf_nt(const bf16_t* row, int lane, f32x4 (&v)[4]) {
#pragma unroll
    for (int j = 0; j < 4; ++j) { const u32x2 w = __builtin_nontemporal_load((const u32x2*)(row + j * 256 + lane * 4)); v[j] = (f32x4){bflo(w.x), bfhi(w.x), bflo(w.y), bfhi(w.y)}; }
}
__device__ __forceinline__ void row_load_bf(const bf16_t* row, int lane, f32x4 (&v)[4]) {
#pragma unroll
    for (int j = 0; j < 4; ++j) { const u32x2 w = *(const u32x2*)(row + j * 256 + lane * 4); v[j] = (f32x4){bflo(w.x), bfhi(w.x), bflo(w.y), bfhi(w.y)}; }
}
__device__ __forceinline__ float row_rstd(const f32x4 (&v)[4], float eps) {
    float ss = 0.f;
#pragma unroll
    for (int j = 0; j < 4; ++j) ss += v[j][0] * v[j][0] + v[j][1] * v[j][1] + v[j][2] * v[j][2] + v[j][3] * v[j][3];
    ss = wave_sum_u(ss);
    return rsqrtf(ss * (1.f / 1024.f) + eps);
}
__device__ __forceinline__ void row_store_bf16(bf16_t* row, int lane, const f32x4 (&v)[4]) {
#pragma unroll
    for (int j = 0; j < 4; ++j) { u32x2 w; w.x = cvt_pk_bf16(v[j][0], v[j][1]); w.y = cvt_pk_bf16(v[j][2], v[j][3]); *(u32x2*)(row + j * 256 + lane * 4) = w; }
}

__device__ __forceinline__ void row_store_fp8(unsigned char* row, int lane, const f32x4 (&v)[4]) {
#pragma unroll
    for (int j = 0; j < 4; ++j) *(unsigned*)(row + j * 256 + lane * 4) = pk_fp8x4(v[j][0] * F8_ACT_SCALE, v[j][1] * F8_ACT_SCALE, v[j][2] * F8_ACT_SCALE, v[j][3] * F8_ACT_SCALE);
}
template <int TO_BF16, bool SRC_BF16 = false>
__device__ __forceinline__ void phase_rmsnorm(const Params& p, const Frame& F, const void* src_, const float* w, void* dst) {
    const float* src = (const float*)src_; const bf16_t* srcb = (const bf16_t*)src_; (void)src; (void)srcb;
    f32x4 wv[4]; row_load(w, F.lane, wv);
    int row = F.bid * 8 + F.wave; const int stride = F.G * 8;
    f32x4 v[4], vn[4];
    if (row < T_TOK) { if constexpr (SRC_BF16) row_load_bf_nt(srcb + (size_t)row * DM, F.lane, v); else row_load_nt(src + (size_t)row * DM, F.lane, v); }
    for (; row < T_TOK; row += stride) {
        if (row + stride < T_TOK) { if constexpr (SRC_BF16) row_load_bf_nt(srcb + (size_t)(row + stride) * DM, F.lane, vn); else row_load_nt(src + (size_t)(row + stride) * DM, F.lane, vn); }
        const float rs = row_rstd(v, 1e-6f);
#pragma unroll
        for (int j = 0; j < 4; ++j) v[j] = v[j] * rs * wv[j];
        if constexpr (TO_BF16 == 2) row_store_fp8((unsigned char*)dst + (size_t)row * DM, F.lane, v);
        else if constexpr (TO_BF16 == 1) row_store_bf16((bf16_t*)dst + (size_t)row * DM, F.lane, v);
        else {
#pragma unroll
            for (int j = 0; j < 4; ++j) *(f32x4*)((float*)dst + (size_t)row * DM + j * 256 + F.lane * 4) = v[j];
        }
#pragma unroll
        for (int j = 0; j < 4; ++j) v[j] = vn[j];
    }
}

__device__ __forceinline__ void phase_conv(const Params& p, const Frame& F) {
    bf16_t* proj = WSP(bf16_t, WS_SLAB);
    bf16_t* xc = (bf16_t*)F.out;
    const float* conv_w = p.in[5]; const float* conv_b = p.in[6];
    for (int item = F.bid * 8 + F.wave; item < (T_TOK / 32) * 3; item += F.G * 8) {
        const int run = item / 3, cb = item - run * 3, c0 = cb * 512 + F.lane * 8, t0 = run * 32;
        float w[4][8], bb[8], xm3[8], xm2[8], xm1[8];
#pragma unroll
        for (int j = 0; j < 4; ++j) { const f32x4 a0 = *(const f32x4*)(conv_w + j * 1536 + c0), a1 = *(const f32x4*)(conv_w + j * 1536 + c0 + 4);
#pragma unroll
            for (int e = 0; e < 4; ++e) { w[j][e] = a0[e]; w[j][4 + e] = a1[e]; } }
        { const f32x4 a0 = *(const f32x4*)(conv_b + c0), a1 = *(const f32x4*)(conv_b + c0 + 4);
#pragma unroll
            for (int e = 0; e < 4; ++e) { bb[e] = a0[e]; bb[4 + e] = a1[e]; } }
        const bool first = (t0 & (SEQ - 1)) == 0;
        { u32x4 r3 = (u32x4){0u, 0u, 0u, 0u}, r2 = r3, r1 = r3;
            if (!first) { r3 = __builtin_nontemporal_load((const u32x4*)(proj + (size_t)(t0 - 3) * NPROJ + PC_XBC + c0)); r2 = __builtin_nontemporal_load((const u32x4*)(proj + (size_t)(t0 - 2) * NPROJ + PC_XBC + c0)); r1 = __builtin_nontemporal_load((const u32x4*)(proj + (size_t)(t0 - 1) * NPROJ + PC_XBC + c0)); }
            xm3[0] = bflo(r3.x); xm3[1] = bfhi(r3.x); xm3[2] = bflo(r3.y); xm3[3] = bfhi(r3.y); xm3[4] = bflo(r3.z); xm3[5] = bfhi(r3.z); xm3[6] = bflo(r3.w); xm3[7] = bfhi(r3.w);
            xm2[0] = bflo(r2.x); xm2[1] = bfhi(r2.x); xm2[2] = bflo(r2.y); xm2[3] = bfhi(r2.y); xm2[4] = bflo(r2.z); xm2[5] = bfhi(r2.z); xm2[6] = bflo(r2.w); xm2[7] = bfhi(r2.w);
            xm1[0] = bflo(r1.x); xm1[1] = bfhi(r1.x); xm1[2] = bflo(r1.y); xm1[3] = bfhi(r1.y); xm1[4] = bflo(r1.z); xm1[5] = bfhi(r1.z); xm1[6] = bflo(r1.w); xm1[7] = bfhi(r1.w); }
#pragma unroll 4
        for (int tt = 0; tt < 32; ++tt) {
            const u32x4 r = __builtin_nontemporal_load((const u32x4*)(proj + (size_t)(t0 + tt) * NPROJ + PC_XBC + c0));
            const float x[8] = {bflo(r.x), bfhi(r.x), bflo(r.y), bfhi(r.y), bflo(r.z), bfhi(r.z), bflo(r.w), bfhi(r.w)};
            float o[8];
#pragma unroll
            for (int e = 0; e < 8; ++e) { o[e] = fsilu(bb[e] + w[0][e] * xm3[e] + w[1][e] * xm2[e] + w[2][e] * xm1[e] + w[3][e] * x[e]); xm3[e] = xm2[e]; xm2[e] = xm1[e]; xm1[e] = x[e]; }
            u32x4 ow; ow.x = cvt_pk_bf16(o[0], o[1]); ow.y = cvt_pk_bf16(o[2], o[3]); ow.z = cvt_pk_bf16(o[4], o[5]); ow.w = cvt_pk_bf16(o[6], o[7]);
            *(u32x4*)(xc + (size_t)(t0 + tt) * 1536 + c0) = ow;
        }
    }
}

typedef float f32x16 __attribute__((ext_vector_type(16)));
typedef short s16x4 __attribute__((ext_vector_type(4)));
#define MFMA32(a, b, c) __builtin_amdgcn_mfma_f32_32x32x16_bf16((a), (b), (c), 0, 0, 0)
__device__ __forceinline__ unsigned off_b(unsigned row, unsigned ch) { return 256u * row + 16u * (ch ^ (((row & 3u) << 2) | ((row >> 2) & 3u))); }
__device__ __forceinline__ unsigned off_v(unsigned row, unsigned ch) { return 128u * row + 16u * (ch ^ (((row >> 1) & 1u) << 2)); }
__device__ __forceinline__ unsigned off_y(unsigned row, unsigned ch) { return 128u * row + 16u * (ch ^ (row & 7u)); }
__device__ __forceinline__ bf16x8 tr_read2(unsigned a0, unsigned a1) {
    s16x4 lo, hi;
    asm volatile("ds_read_b64_tr_b16 %0, %2\n\tds_read_b64_tr_b16 %1, %3\n\ts_waitcnt lgkmcnt(0)" : "=&v"(lo), "=&v"(hi) : "v"(a0), "v"(a1) : "memory");
    return __builtin_shufflevector(lo, hi, 0, 1, 2, 3, 4, 5, 6, 7);
}
__device__ __forceinline__ void tr_read4(unsigned a0, unsigned a1, unsigned a2, unsigned a3, bf16x8& f0, bf16x8& f1) {
    s16x4 r0, r1, r2, r3;
    asm volatile("ds_read_b64_tr_b16 %0, %4\n\tds_read_b64_tr_b16 %1, %5\n\tds_read_b64_tr_b16 %2, %6\n\tds_read_b64_tr_b16 %3, %7\n\ts_waitcnt lgkmcnt(0)"
                 : "=&v"(r0), "=&v"(r1), "=&v"(r2), "=&v"(r3) : "v"(a0), "v"(a1), "v"(a2), "v"(a3) : "memory");
    f0 = __builtin_shufflevector(r0, r1, 0, 1, 2, 3, 4, 5, 6, 7); f1 = __builtin_shufflevector(r2, r3, 0, 1, 2, 3, 4, 5, 6, 7);
}
__device__ __forceinline__ void tr_read8(unsigned a0, unsigned a1, unsigned a2, unsigned a3, unsigned a4, unsigned a5, unsigned a6, unsigned a7, bf16x8& f0, bf16x8& f1, bf16x8& f2, bf16x8& f3) {
    s16x4 r0, r1, r2, r3, r4, r5, r6, r7;
    asm volatile("ds_read_b64_tr_b16 %0, %8\n\tds_read_b64_tr_b16 %1, %9\n\tds_read_b64_tr_b16 %2, %10\n\tds_read_b64_tr_b16 %3, %11\n\tds_read_b64_tr_b16 %4, %12\n\tds_read_b64_tr_b16 %5, %13\n\tds_read_b64_tr_b16 %6, %14\n\tds_read_b64_tr_b16 %7, %15\n\ts_waitcnt lgkmcnt(0)"
                 : "=&v"(r0), "=&v"(r1), "=&v"(r2), "=&v"(r3), "=&v"(r4), "=&v"(r5), "=&v"(r6), "=&v"(r7) : "v"(a0), "v"(a1), "v"(a2), "v"(a3), "v"(a4), "v"(a5), "v"(a6), "v"(a7) : "memory");
    f0 = __builtin_shufflevector(r0, r1, 0, 1, 2, 3, 4, 5, 6, 7); f1 = __builtin_shufflevector(r2, r3, 0, 1, 2, 3, 4, 5, 6, 7);
    f2 = __builtin_shufflevector(r4, r5, 0, 1, 2, 3, 4, 5, 6, 7); f3 = __builtin_shufflevector(r6, r7, 0, 1, 2, 3, 4, 5, 6, 7);
}
__device__ __forceinline__ f32x16 zero16() { f32x16 z;
#pragma unroll
    for (int i = 0; i < 16; ++i) z[i] = 0.f;
    return z; }
__device__ __forceinline__ void phase_scan0(const Params& p, const Frame& F) {
    bf16_t* proj = WSP(bf16_t, WS_SLAB);
    const bf16_t* xc = (const bf16_t*)F.out;
    constexpr unsigned OQ = 0, OK = 32768, OV = 65536, OVW = 81920, OS = 98304, OY = 114688, OSM = 131072;
    LAS unsigned char* L = F.lds;
    const unsigned lbase = (unsigned)(__UINTPTR_TYPE__)L;
    LAS float* sm = (LAS float*)(L + OSM);
    const int lane = F.lane, w = F.wave, it = w >> 1, pt = w & 1;
    const unsigned h0 = lane >> 5, lr0 = lane & 31;
    const int trow = F.tid >> 2, tpart = F.tid & 3;
    const unsigned blk0 = (lane >> 4) & 1u, tq0 = (lane & 15u) >> 2, tp0 = lane & 3u;
    for (int ui = 0; ui < 2; ++ui) {
        const int uu = F.bid + ui * F.G;
        if (uu >= 512) break;
        const bool is_ssd = uu < 256; const int v = uu & 255, x8 = v & 7, slot = v >> 3;
        int b, hh, grp = 0, hr = 0, sl = 0;
        if (is_ssd) { const int pg = x8 + 8 * (slot >> 3), hg = slot & 7; b = pg >> 1; grp = pg & 1; hh = grp * 8 + hg; }
        else { const int pr = x8 + 8 * (slot >> 2); sl = slot & 3; b = pr >> 2; hr = pr & 3; hh = hr * 4 + sl; }
        const size_t row0 = (size_t)b * SEQ;
        const bf16_t* qptr; const bf16_t* kptr; const bf16_t* vptr; size_t qs, vs; bf16_t* optr;
        if (is_ssd) { qptr = xc + 1280 + grp * 128; kptr = xc + 1024 + grp * 128; vptr = xc + hh * 64; qs = 1536; vs = 1536; optr = proj + hh * 64; }
        else { qptr = proj + PC_Q + hr * 128; kptr = proj + PC_K + hr * 128; vptr = proj + PC_V + hr * 256 + sl * 64; qs = NPROJ; vs = NPROJ; optr = proj + 1024 + hr * 256 + sl * 64; }
        const bf16_t* zptr = is_ssd ? proj + hh * 64 : proj + PC_G + hr * 256 + sl * 64;
        float* stats = WSP(float, WS_STATS); const int nslot = is_ssd ? hh : 16 + hr * 4 + sl;
        const float A_h = is_ssd ? -__expf(p.in[8][hh]) : 0.f, dtb = is_ssd ? p.in[7][hh] : 0.f, D_h = is_ssd ? p.in[9][hh] : 0.f;
        const float lng = __logf(1.f - exp2f(-5.f - (float)hr));
        u32x4 rv[2], rz[2]; float rdt0 = 0.f, rdt1 = 0.f;
        f32x16 St0 = zero16(), St1 = zero16();
        __syncthreads();
        for (int i = F.tid; i < 16384 / 16; i += NTHREADS) *(LAS u32x4*)(L + OS + i * 16) = (u32x4){0u, 0u, 0u, 0u};
#define SC_LOAD(c) do { const size_t r_ = row0 + (size_t)(c) * 128 + trow; \
            _Pragma("unroll") for (int e = 0; e < 2; ++e) rv[e] = *(const u32x4*)(vptr + r_ * vs + tpart * 16 + e * 8); \
            if (is_ssd && w == 0) { rdt0 = bf2f(proj[(row0 + (size_t)(c) * 128 + 2 * lane) * NPROJ + PC_DT + hh]); rdt1 = bf2f(proj[(row0 + (size_t)(c) * 128 + 2 * lane + 1) * NPROJ + PC_DT + hh]); } } while (0)
#define SC_DMA(c) do { _Pragma("unroll") for (int e = 0; e < 4; ++e) { const int I_ = w * 4 + e; const unsigned r_ = 4u * I_ + ((unsigned)lane >> 4), cs_ = lane & 15u, ch_ = cs_ ^ (((r_ & 3u) << 2) | ((r_ >> 2) & 3u)); \
            const size_t g_ = (row0 + (size_t)(c) * 128 + r_) * qs + ch_ * 8; \
            __builtin_amdgcn_global_load_lds((const unsigned*)(qptr + g_), (LAS unsigned*)(L + OQ + I_ * 1024), 16, 0, 0); \
            __builtin_amdgcn_global_load_lds((const unsigned*)(kptr + g_), (LAS unsigned*)(L + OK + I_ * 1024), 16, 0, 0); } } while (0)
#define SC_LOADZ(c) do { { const size_t r_ = row0 + (size_t)(c) * 128 + trow; rz[0] = __builtin_nontemporal_load((const u32x4*)(zptr + r_ * NPROJ + tpart * 16)); rz[1] = __builtin_nontemporal_load((const u32x4*)(zptr + r_ * NPROJ + tpart * 16 + 8)); } } while (0)
#define SC_SMALL(c) do { if (w == 0) { LAS float* sb = sm + ((c) & 1) * 384; float d0, d1, a0, a1; \
            if (is_ssd) { d0 = fsoftplus(rdt0 + dtb); d1 = fsoftplus(rdt1 + dtb); a0 = d0 * A_h; a1 = d1 * A_h; } else { d0 = 1.f; d1 = 1.f; a0 = lng; a1 = lng; } \
            float sc = a0 + a1; _Pragma("unroll") for (int o = 1; o < 64; o <<= 1) { const float tv = __shfl_up(sc, o); if (lane >= o) sc += tv; } \
            const float c1 = sc, c0 = sc - a1; const float tot = __shfl(sc, 63); \
            sb[2 * lane] = c0; sb[2 * lane + 1] = c1; sb[128 + 2 * lane] = d0; sb[128 + 2 * lane + 1] = d1; sb[256 + 2 * lane] = __expf(tot - c0) * d0; sb[256 + 2 * lane + 1] = __expf(tot - c1) * d1; } } while (0)
#define SC_STORE(c) do { const float wj_ = sm[((c) & 1) * 384 + 256 + trow]; \
            _Pragma("unroll") for (int e = 0; e < 2; ++e) { const u32x4 x_ = rv[e]; *(LAS u32x4*)(L + OV + off_v(trow, tpart * 2 + e)) = x_; u32x4 y_; \
                y_.x = cvt_pk_bf16(bflo(x_.x) * wj_, bfhi(x_.x) * wj_); y_.y = cvt_pk_bf16(bflo(x_.y) * wj_, bfhi(x_.y) * wj_); y_.z = cvt_pk_bf16(bflo(x_.z) * wj_, bfhi(x_.z) * wj_); y_.w = cvt_pk_bf16(bflo(x_.w) * wj_, bfhi(x_.w) * wj_); \
                *(LAS u32x4*)(L + OVW + off_v(trow, tpart * 2 + e)) = y_; } } while (0)
        SC_DMA(0); SC_LOAD(0);
        SC_SMALL(0);
        __syncthreads();
        SC_STORE(0);
        asm volatile("s_waitcnt vmcnt(0)" ::: "memory");
        __syncthreads();
        SP_DECL;
        for (int c = 0; c < SEQ / 128; ++c) {
            SP_MARK(8);
            const LAS float* sb = sm + (c & 1) * 384;
            unsigned lr = lr0, h = h0, blk = blk0, tq_ = tq0, tp_ = tp0;
            asm volatile("" : "+v"(lr), "+v"(h), "+v"(blk), "+v"(tq_), "+v"(tp_));
            if (c + 1 < SEQ / 128) { SC_LOAD(c + 1); }
            SC_LOADZ(c);
            const int ph = pt;
            const float ai = sb[32 * it + lr];
            bf16x8 qf[8];
#pragma unroll
            for (int ks = 0; ks < 8; ++ks) qf[ks] = *(const LAS bf16x8*)(L + OQ + off_b(32 * it + lr, 2 * ks + h));
            f32x16 Yd0 = zero16(), Yd1 = zero16();
            for (int jt = ph; jt <= it; jt += 2) {
                f32x16 acc = zero16();
#pragma unroll
                for (int ks = 0; ks < 8; ++ks) { const bf16x8 ka = *(const LAS bf16x8*)(L + OK + off_b(32 * jt + lr, 2 * ks + h)); acc = MFMA32(ka, qf[ks], acc); }
                const bool diag = (jt == it);
#pragma unroll
                for (int g = 0; g < 4; ++g) { const f32x4 aj = *(const LAS f32x4*)(sb + 32 * jt + 8 * g + 4 * h), dj = *(const LAS f32x4*)(sb + 128 + 32 * jt + 8 * g + 4 * h);
#pragma unroll
                    for (int e = 0; e < 4; ++e) { const float dec = __expf(ai - aj[e]) * dj[e]; const bool ok = !diag || ((int)lr >= (int)(8 * g + 4 * h + e)); acc[4 * g + e] = ok ? acc[4 * g + e] * dec : 0.f; } }
#pragma unroll
                for (int s2 = 0; s2 < 2; ++s2) {
                    u32x4 pw; pw.x = cvt_pk_bf16(acc[8 * s2 + 0], acc[8 * s2 + 1]); pw.y = cvt_pk_bf16(acc[8 * s2 + 2], acc[8 * s2 + 3]); pw.z = cvt_pk_bf16(acc[8 * s2 + 4], acc[8 * s2 + 5]); pw.w = cvt_pk_bf16(acc[8 * s2 + 6], acc[8 * s2 + 7]);
                    const bf16x8 Pb = __builtin_bit_cast(bf16x8, pw);
                    const unsigned rb0 = 32 * jt + 16 * s2 + 4 * h + tq_, cc0 = 2 * blk + (tp_ >> 1), o8 = 8 * (tp_ & 1);
                    bf16x8 va0, va1;
                    tr_read4(lbase + OV + off_v(rb0, cc0) + o8, lbase + OV + off_v(rb0 + 8, cc0) + o8, lbase + OV + off_v(rb0, 4 + cc0) + o8, lbase + OV + off_v(rb0 + 8, 4 + cc0) + o8, va0, va1);
                    Yd0 = MFMA32(va0, Pb, Yd0); Yd1 = MFMA32(va1, Pb, Yd1);
                }
            }
            {
                f32x16 Yo = zero16();
#pragma unroll
                for (int ks = 0; ks < 8; ++ks) { const bf16x8 sa = *(const LAS bf16x8*)(L + OS + off_b(32 * ph + lr, 2 * ks + h)); Yo = MFMA32(sa, qf[ks], Yo); }
                const float ei = __expf(ai);
                if (ph == 0) {
#pragma unroll
                    for (int r = 0; r < 16; ++r) Yd0[r] += Yo[r] * ei; }
                else {
#pragma unroll
                    for (int r = 0; r < 16; ++r) Yd1[r] += Yo[r] * ei; }
            }
#pragma unroll
            for (int g = 0; g < 4; ++g) { u32x2 yw;
                if (ph == 0) { yw.x = cvt_pk_bf16(Yd1[4 * g], Yd1[4 * g + 1]); yw.y = cvt_pk_bf16(Yd1[4 * g + 2], Yd1[4 * g + 3]); } else { yw.x = cvt_pk_bf16(Yd0[4 * g], Yd0[4 * g + 1]); yw.y = cvt_pk_bf16(Yd0[4 * g + 2], Yd0[4 * g + 3]); }
                *(LAS u32x2*)(L + OY + off_y(32 * it + lr, 4 * (1 - ph) + g) + 8 * h) = yw; }
            const float dl = __expf(sb[127]);
            const int st0 = (w == 0) ? 0 : (w == 1) ? 2 : (w == 2) ? 4 : (w == 3) ? 5 : (w == 5) ? 6 : -1, st1 = (w == 0) ? 1 : (w == 1) ? 3 : (w == 5) ? 7 : -1;
            if (st0 >= 0) {
                const int spt = st0 & 1, snt = st0 >> 1;
#pragma unroll
                for (int r = 0; r < 16; ++r) St0[r] *= dl;
#pragma unroll
                for (int k2 = 0; k2 < 4; ++k2) { const unsigned rb = 32 * k2 + 8 * h + tq_, cv = 4 * spt + 2 * blk + (tp_ >> 1), cb = 4 * snt + 2 * blk + (tp_ >> 1), o8 = 8 * (tp_ & 1);
                    bf16x8 fa0, fb0, fa1, fb1;
                    tr_read8(lbase + OVW + off_v(rb, cv) + o8, lbase + OVW + off_v(rb + 4, cv) + o8, lbase + OK + off_b(rb, cb) + o8, lbase + OK + off_b(rb + 4, cb) + o8,
                             lbase + OVW + off_v(rb + 16, cv) + o8, lbase + OVW + off_v(rb + 20, cv) + o8, lbase + OK + off_b(rb + 16, cb) + o8, lbase + OK + off_b(rb + 20, cb) + o8, fa0, fb0, fa1, fb1);
                    St0 = MFMA32(fa0, fb0, St0); St0 = MFMA32(fa1, fb1, St0); }
                if (st1 >= 0) {
                    const int spt1 = st1 & 1, snt1 = st1 >> 1;
#pragma unroll
                    for (int r = 0; r < 16; ++r) St1[r] *= dl;
#pragma unroll
                    for (int k2 = 0; k2 < 4; ++k2) { const unsigned rb = 32 * k2 + 8 * h + tq_, cv = 4 * spt1 + 2 * blk + (tp_ >> 1), cb = 4 * snt1 + 2 * blk + (tp_ >> 1), o8 = 8 * (tp_ & 1);
                        bf16x8 fa0, fb0, fa1, fb1;
                        tr_read8(lbase + OVW + off_v(rb, cv) + o8, lbase + OVW + off_v(rb + 4, cv) + o8, lbase + OK + off_b(rb, cb) + o8, lbase + OK + off_b(rb + 4, cb) + o8,
                                 lbase + OVW + off_v(rb + 16, cv) + o8, lbase + OVW + off_v(rb + 20, cv) + o8, lbase + OK + off_b(rb + 16, cb) + o8, lbase + OK + off_b(rb + 20, cb) + o8, fa0, fb0, fa1, fb1);
                        St1 = MFMA32(fa0, fb0, St1); St1 = MFMA32(fa1, fb1, St1); }
                }
            }
            if (c + 1 < SEQ / 128) SC_SMALL(c + 1);
            LDS_BAR();
#pragma unroll
            for (int g = 0; g < 4; ++g) { LAS u32x2* yp = (LAS u32x2*)(L + OY + off_y(32 * it + lr, 4 * ph + g) + 8 * h); const u32x2 pv_ = *yp; u32x2 yw;
                if (ph == 0) { yw.x = cvt_pk_bf16(Yd0[4 * g] + bflo(pv_.x), Yd0[4 * g + 1] + bfhi(pv_.x)); yw.y = cvt_pk_bf16(Yd0[4 * g + 2] + bflo(pv_.y), Yd0[4 * g + 3] + bfhi(pv_.y)); }
                else { yw.x = cvt_pk_bf16(Yd1[4 * g] + bflo(pv_.x), Yd1[4 * g + 1] + bfhi(pv_.x)); yw.y = cvt_pk_bf16(Yd1[4 * g + 2] + bflo(pv_.y), Yd1[4 * g + 3] + bfhi(pv_.y)); }
                *yp = yw; }
            LDS_BAR();
            SP_MARK(5);
            if (c + 1 < SEQ / 128) SC_DMA(c + 1);
            if (st0 >= 0) {
                const int spt = st0 & 1, snt = st0 >> 1;
#pragma unroll
                for (int r = 0; r < 16; ++r) { const unsigned pr = 32 * spt + (r & 3) + 8 * (r >> 2) + 4 * h, n = 32 * snt + lr; *(LAS bf16_t*)(L + OS + off_b(pr, n >> 3) + 2 * (n & 7)) = f2bf(St0[r]); }
                if (st1 >= 0) { const int spt1 = st1 & 1, snt1 = st1 >> 1;
#pragma unroll
                    for (int r = 0; r < 16; ++r) { const unsigned pr = 32 * spt1 + (r & 3) + 8 * (r >> 2) + 4 * h, n = 32 * snt1 + lr; *(LAS bf16_t*)(L + OS + off_b(pr, n >> 3) + 2 * (n & 7)) = f2bf(St1[r]); }
                }
            }
            {
                bf16_t* orow = optr + (row0 + (size_t)c * 128 + trow) * NPROJ + tpart * 16;
                float ssq = 0.f;
#pragma unroll
                for (int e = 0; e < 2; ++e) {
                    const u32x4 yv = *(const LAS u32x4*)(L + OY + off_y(trow, tpart * 2 + e)); const u32x4 zv = rz[e];
                    const unsigned yw[4] = {yv.x, yv.y, yv.z, yv.w}, zw[4] = {zv.x, zv.y, zv.z, zv.w}; unsigned ow[4];
                    if (is_ssd) { const u32x4 xv = *(const LAS u32x4*)(L + OV + off_v(trow, tpart * 2 + e)); const unsigned xw[4] = {xv.x, xv.y, xv.z, xv.w};
#pragma unroll
                        for (int k = 0; k < 4; ++k) { const float v0 = (bflo(yw[k]) + bflo(xw[k]) * D_h) * fsilu(bflo(zw[k])), v1 = (bfhi(yw[k]) + bfhi(xw[k]) * D_h) * fsilu(bfhi(zw[k])); ssq += v0 * v0 + v1 * v1; ow[k] = cvt_pk_bf16(v0, v1); } }
                    else {
#pragma unroll
                        for (int k = 0; k < 4; ++k) { const float y0 = bflo(yw[k]), y1 = bfhi(yw[k]); ssq += y0 * y0 + y1 * y1; ow[k] = cvt_pk_bf16(y0 * fsilu(bflo(zw[k])), y1 * fsilu(bfhi(zw[k]))); } }
                    *(u32x4*)(orow + e * 8) = (u32x4){ow[0], ow[1], ow[2], ow[3]};
                }
                ssq += __shfl_xor(ssq, 1); ssq += __shfl_xor(ssq, 2);
                if (tpart == 0) stats[(row0 + (size_t)c * 128 + trow) * 32 + nslot] = ssq;
            }
            LDS_BAR();
            SP_MARK(6);
            if (c + 1 < SEQ / 128) SC_STORE(c + 1);
            asm volatile("s_waitcnt vmcnt(0)" ::: "memory");
            LDS_BAR();
            SP_MARK(7);
        }
#undef SC_LOAD
#undef SC_LOADZ
#undef SC_SMALL
#undef SC_STORE
    }
}

__device__ __forceinline__ void phase_gatenorm(const Params& p, const Frame& F) {
    const bf16_t* proj = WSP(bf16_t, WS_SLAB);
    bf16_t* ybuf = WSP(bf16_t, WS_SLAB);
    const float* nw = p.in[10];
    int row = F.bid * 8 + F.wave; const int stride = F.G * 8;
    u32x4 yc[4], gc[2], yn[4], gn[2];
#define GN_LOAD(r_, Y_, G_) do { const bf16_t* b_ = ybuf + (size_t)(r_) * NPROJ; _Pragma("unroll") for (int j = 0; j < 4; ++j) Y_[j] = *(const u32x4*)(b_ + j * 512 + F.lane * 8); \
        _Pragma("unroll") for (int j = 0; j < 2; ++j) G_[j] = __builtin_nontemporal_load((const u32x4*)(b_ + PC_G + j * 512 + F.lane * 8)); } while (0)
    if (row < T_TOK) GN_LOAD(row, yc, gc);
    for (; row < T_TOK; row += stride) {
        if (row + stride < T_TOK) GN_LOAD(row + stride, yn, gn);
        bf16_t* yr = ybuf + (size_t)row * NPROJ;
#pragma unroll
        for (int j = 0; j < 4; ++j) {
            const u32x4 w = yc[j];
            float x[8] = {bflo(w.x), bfhi(w.x), bflo(w.y), bfhi(w.y), bflo(w.z), bfhi(w.z), bflo(w.w), bfhi(w.w)};
            float ss = 0.f;
#pragma unroll
            for (int e = 0; e < 8; ++e) ss += x[e] * x[e];
            if (j < 2) { ss = wave_sum_u(ss); const float rs = rsqrtf(ss * (1.f / 512.f) + 1e-5f);
                const f32x4 w0 = *(const f32x4*)(nw + j * 512 + F.lane * 8), w1 = *(const f32x4*)(nw + j * 512 + F.lane * 8 + 4);
#pragma unroll
                for (int e = 0; e < 4; ++e) { x[e] *= rs * w0[e]; x[4 + e] *= rs * w1[e]; } }
            else {
                ss = dpp_sum16(ss); ss += __shfl_xor(ss, 16);
                const float rs = rsqrtf(ss * (1.f / 256.f) + 1e-6f);
                const u32x4 gw = gc[j - 2];
                const float g[8] = {bflo(gw.x), bfhi(gw.x), bflo(gw.y), bfhi(gw.y), bflo(gw.z), bfhi(gw.z), bflo(gw.w), bfhi(gw.w)};
#pragma unroll
                for (int e = 0; e < 8; ++e) x[e] *= rs * fsilu(g[e]); }
            if (F8_OUTPROJ) { u32x2 o8; o8.x = pk_fp8x4(x[0] * F8_ACT_SCALE, x[1] * F8_ACT_SCALE, x[2] * F8_ACT_SCALE, x[3] * F8_ACT_SCALE); o8.y = pk_fp8x4(x[4] * F8_ACT_SCALE, x[5] * F8_ACT_SCALE, x[6] * F8_ACT_SCALE, x[7] * F8_ACT_SCALE);
                *(u32x2*)((unsigned char*)yr + j * 512 + F.lane * 8) = o8; }
            else { u32x4 o; o.x = cvt_pk_bf16(x[0], x[1]); o.y = cvt_pk_bf16(x[2], x[3]); o.z = cvt_pk_bf16(x[4], x[5]); o.w = cvt_pk_bf16(x[6], x[7]);
            *(u32x4*)(yr + j * 512 + F.lane * 8) = o; }
        }
#pragma unroll
        for (int j = 0; j < 4; ++j) yc[j] = yn[j];
        gc[0] = gn[0]; gc[1] = gn[1];
    }
#undef GN_LOAD
}

__device__ __forceinline__ void phase_moe_route(const Params& p, const Frame& F, int layer, const bf16_t* h, bf16_t* tbuf) {
    unsigned char* meta = F.ws + WS_META + (size_t)layer * META_STRIDE;
    int* tok_rank = (int*)(meta + MT_RANK); int* tok_bkt = (int*)(meta + MT_BKT); f32x2* tok_c = (f32x2*)(meta + MT_C);
    int* gcount = (int*)(F.ws + WS_CTL + CTL_CNT_OFF) + layer * 32;
    const float* bg = p.in[31] + layer * 4; const float* be = p.in[33] + layer * 16;
    constexpr unsigned RT_STRIDE = 2064, RT_AH = 0, RT_AL = 16 * RT_STRIDE, RT_DP = 32 * RT_STRIDE;
    LAS int* lcount = (LAS int*)(F.lds + 83968);
    LAS int* lbase = lcount + 32;
    LAS int* l_bkt = lbase + 32;
    LAS int* l_rank = l_bkt + 1024;
    LAS float* l_c = (LAS float*)(l_rank + 1024);
    LAS float* lgt = (LAS float*)(F.lds + 100864);
    __syncthreads();
    if (F.tid < 32) lcount[F.tid] = 0;
    const int TPB = (T_TOK + F.G - 1) / F.G, tok0 = F.bid * TPB;
    f32x4 wv[4]; row_load(p.in[2] + (size_t)layer * DM, F.lane, wv);
    const unsigned l15 = F.lane & 15, q4 = (unsigned)F.lane >> 4;
    bf16x8 Bh[4][2], Bl[4][2];
    { const float* wrt = WSP(float, WS_RTW) + (size_t)layer * 20480;
#pragma unroll
        for (int s_ = 0; s_ < 4; ++s_)
#pragma unroll
            for (int ct = 0; ct < 2; ++ct) { const int col = 16 * ct + (int)l15, colc = col < 20 ? col : 19; const float* sp = wrt + colc * 1024 + 128 * F.wave + 32 * s_ + 8 * (int)q4;
                f32x4 x0 = *(const f32x4*)sp, x1 = *(const f32x4*)(sp + 4); if (col >= 20) { x0 = (f32x4){0.f, 0.f, 0.f, 0.f}; x1 = x0; }
                u32x4 hw, lw_; hw.x = cvt_pk_bf16(x0[0], x0[1]); hw.y = cvt_pk_bf16(x0[2], x0[3]); hw.z = cvt_pk_bf16(x1[0], x1[1]); hw.w = cvt_pk_bf16(x1[2], x1[3]);
                lw_.x = cvt_pk_bf16(x0[0] - bflo(hw.x), x0[1] - bfhi(hw.x)); lw_.y = cvt_pk_bf16(x0[2] - bflo(hw.y), x0[3] - bfhi(hw.y)); lw_.z = cvt_pk_bf16(x1[0] - bflo(hw.z), x1[1] - bfhi(hw.z)); lw_.w = cvt_pk_bf16(x1[2] - bflo(hw.w), x1[3] - bfhi(hw.w));
                Bh[s_][ct] = __builtin_bit_cast(bf16x8, hw); Bl[s_][ct] = __builtin_bit_cast(bf16x8, lw_); } }
    f32x4 va[4], vb[4], na[4], nb[4];
#define RT_MFMA(a, b, c) __builtin_amdgcn_mfma_f32_16x16x32_bf16((a), (b), (c), 0, 0, 0)
#define RT_LOAD(li_, A_, B_) do { const int ta_ = tok0 + (li_), tb_ = ta_ + 8; \
        if ((li_) < TPB && ta_ < T_TOK) row_load_bf_nt(h + (size_t)ta_ * DM, F.lane, A_); if ((li_) + 8 < TPB && tb_ < T_TOK) row_load_bf_nt(h + (size_t)tb_ * DM, F.lane, B_); } while (0)
#define RT_SPLIT_ST(V_, row_) do { _Pragma("unroll") for (int j = 0; j < 4; ++j) { u32x2 hw_, lw2_; hw_.x = cvt_pk_bf16(V_[j][0], V_[j][1]); hw_.y = cvt_pk_bf16(V_[j][2], V_[j][3]); \
            lw2_.x = cvt_pk_bf16(V_[j][0] - bflo(hw_.x), V_[j][1] - bfhi(hw_.x)); lw2_.y = cvt_pk_bf16(V_[j][2] - bflo(hw_.y), V_[j][3] - bfhi(hw_.y)); \
            *(LAS u32x2*)(F.lds + RT_AH + (row_) * RT_STRIDE + (j * 256 + F.lane * 4) * 2) = hw_; *(LAS u32x2*)(F.lds + RT_AL + (row_) * RT_STRIDE + (j * 256 + F.lane * 4) * 2) = lw2_; } } while (0)
    RT_LOAD(F.wave, va, vb);
    __syncthreads();
    for (int li = F.wave; li < ((TPB + 15) & ~15); li += 16) {
        const int tok = tok0 + li;
        const bool hasa = (li < TPB) && (tok < T_TOK), hasb = (li + 8 < TPB) && (tok + 8 < T_TOK);
        RT_LOAD(li + 16, na, nb);
        if (!hasa) {
#pragma unroll
            for (int j = 0; j < 4; ++j) va[j] = (f32x4){0.f, 0.f, 0.f, 0.f}; }
        if (!hasb) {
#pragma unroll
            for (int j = 0; j < 4; ++j) vb[j] = (f32x4){0.f, 0.f, 0.f, 0.f}; }
        const float rsa = row_rstd(va, 1e-6f), rsb = row_rstd(vb, 1e-6f);
#pragma unroll
        for (int j = 0; j < 4; ++j) { va[j] = va[j] * rsa * wv[j]; vb[j] = vb[j] * rsb * wv[j]; }
#pragma unroll
        for (int j = 0; j < 4; ++j) { if (hasa) *(unsigned*)((unsigned char*)tbuf + (size_t)tok * DM + j * 256 + F.lane * 4) = pk_fp8x4(va[j][0] * F8_ACT_SCALE, va[j][1] * F8_ACT_SCALE, va[j][2] * F8_ACT_SCALE, va[j][3] * F8_ACT_SCALE);
            if (hasb) *(unsigned*)((unsigned char*)tbuf + (size_t)(tok + 8) * DM + j * 256 + F.lane * 4) = pk_fp8x4(vb[j][0] * F8_ACT_SCALE, vb[j][1] * F8_ACT_SCALE, vb[j][2] * F8_ACT_SCALE, vb[j][3] * F8_ACT_SCALE); }
        RT_SPLIT_ST(va, F.wave); RT_SPLIT_ST(vb, F.wave + 8);
        LDS_BAR();
        { f32x4 D0 = (f32x4){0.f, 0.f, 0.f, 0.f}, D1 = D0;
#pragma unroll
            for (int s_ = 0; s_ < 4; ++s_) { const unsigned ao = l15 * RT_STRIDE + (128u * F.wave + 32u * s_ + 8u * q4) * 2u;
                const bf16x8 ah = *(const LAS bf16x8*)(F.lds + RT_AH + ao), al = *(const LAS bf16x8*)(F.lds + RT_AL + ao);
                D0 = RT_MFMA(ah, Bh[s_][0], D0); D0 = RT_MFMA(ah, Bl[s_][0], D0); D0 = RT_MFMA(al, Bh[s_][0], D0);
                D1 = RT_MFMA(ah, Bh[s_][1], D1); D1 = RT_MFMA(ah, Bl[s_][1], D1); D1 = RT_MFMA(al, Bh[s_][1], D1); }
#pragma unroll
            for (int r = 0; r < 4; ++r) { LAS float* dp = (LAS float*)(F.lds + RT_DP + F.wave * 2048 + ((4 * q4 + r) * 32 + l15) * 4); dp[0] = D0[r]; dp[16] = D1[r]; } }
        LDS_BAR();
        if (F.tid < 320) { const int tk = F.tid / 20, col = F.tid - tk * 20; float sacc = 0.f;
#pragma unroll
            for (int w8 = 0; w8 < 8; ++w8) sacc += *(const LAS float*)(F.lds + RT_DP + w8 * 2048 + (tk * 32 + col) * 4);
            const int lr_ = (li - F.wave) + tk; if (lr_ < TPB) lgt[lr_ * 20 + col] = sacc; }
#pragma unroll
        for (int j = 0; j < 4; ++j) { va[j] = na[j]; vb[j] = nb[j]; }
    }
#undef RT_SPLIT_ST
#undef RT_MFMA
#undef RT_LOAD
    __syncthreads();
    for (int li = F.tid; li < TPB; li += NTHREADS) {
        if (tok0 + li >= T_TOK) break;
        float lg[20];
#pragma unroll
        for (int o = 0; o < 20; ++o) lg[o] = lgt[li * 20 + o];
        float g0 = lg[0] + bg[0], g1 = lg[1] + bg[1], g2 = lg[2] + bg[2], g3 = lg[3] + bg[3];
        int gi = 0; float gm = g0; if (g1 > gm) { gm = g1; gi = 1; } if (g2 > gm) { gm = g2; gi = 2; } if (g3 > gm) { gm = g3; gi = 3; }
        const float gate = 1.f / (__expf(g0 - gm) + __expf(g1 - gm) + __expf(g2 - gm) + __expf(g3 - gm));
        float e0, e1, e2, e3;
        e0 = (gi == 0) ? lg[4] : (gi == 1) ? lg[8] : (gi == 2) ? lg[12] : lg[16];
        e1 = (gi == 0) ? lg[5] : (gi == 1) ? lg[9] : (gi == 2) ? lg[13] : lg[17];
        e2 = (gi == 0) ? lg[6] : (gi == 1) ? lg[10] : (gi == 2) ? lg[14] : lg[18];
        e3 = (gi == 0) ? lg[7] : (gi == 1) ? lg[11] : (gi == 2) ? lg[15] : lg[19];
        e0 += be[gi * 4 + 0]; e1 += be[gi * 4 + 1]; e2 += be[gi * 4 + 2]; e3 += be[gi * 4 + 3];
        int i1 = 0; float v1 = e0; if (e1 > v1) { v1 = e1; i1 = 1; } if (e2 > v1) { v1 = e2; i1 = 2; } if (e3 > v1) { v1 = e3; i1 = 3; }
        int i2 = -1; float v2 = -3.0e38f;
        if (i1 != 0 && e0 > v2) { v2 = e0; i2 = 0; } if (i1 != 1 && e1 > v2) { v2 = e1; i2 = 1; } if (i1 != 2 && e2 > v2) { v2 = e2; i2 = 2; } if (i1 != 3 && e3 > v2) { v2 = e3; i2 = 3; }
        const float w1 = gate / (1.f + __expf(v2 - v1)), w2 = gate - w1;
        const int lo = i1 < i2 ? i1 : i2, hi = i1 < i2 ? i2 : i1; const float clo = i1 < i2 ? w1 : w2, chi = i1 < i2 ? w2 : w1;
        const int pr = (lo == 0) ? hi - 1 : (lo == 1) ? hi + 1 : 5;
        const int bk = gi * 6 + pr;
        l_bkt[li] = bk; l_c[li * 2] = clo; l_c[li * 2 + 1] = chi;
        l_rank[li] = __hip_atomic_fetch_add((int*)(lcount + bk), 1, __ATOMIC_RELAXED, __HIP_MEMORY_SCOPE_WORKGROUP);
    }
    __syncthreads();
    if (F.tid < 24) lbase[F.tid] = __hip_atomic_fetch_add(gcount + F.tid, lcount[F.tid], __ATOMIC_RELAXED, __HIP_MEMORY_SCOPE_AGENT);
    __syncthreads();
    for (int li = F.tid; li < TPB; li += NTHREADS) { const int tok = tok0 + li; if (tok < T_TOK) { const int bk = l_bkt[li]; tok_bkt[tok] = bk; tok_rank[tok] = lbase[bk] + l_rank[li]; tok_c[tok] = (f32x2){l_c[li * 2], l_c[li * 2 + 1]}; } }
}
__device__ __forceinline__ void phase_moe_slots(const Params& p, const Frame& F, int layer) {
    unsigned char* meta = F.ws + WS_META + (size_t)layer * META_STRIDE;
    const int* tok_rank = (const int*)(meta + MT_RANK); const int* tok_bkt = (const int*)(meta + MT_BKT); const f32x2* tok_c = (const f32x2*)(meta + MT_C);
    int* slot_tok = (int*)(meta + MT_STOK); f32x2* slot_c = (f32x2*)(meta + MT_SC); int* tile_tab = (int*)(meta + MT_TILE);
    int* gcount = (int*)(F.ws + WS_CTL + CTL_CNT_OFF) + layer * 32;
    LAS int* cnt = (LAS int*)F.lds; LAS int* start = cnt + 32;
    __syncthreads();
    if (F.tid < 24) cnt[F.tid] = __hip_atomic_load(gcount + F.tid, __ATOMIC_RELAXED, __HIP_MEMORY_SCOPE_AGENT);
    __syncthreads();
    if (F.tid == 0) { int a = 0; for (int b = 0; b < 24; ++b) { start[b] = a; a += (cnt[b] + 255) >> 8; } start[24] = a; }
    __syncthreads();
    for (int tok = F.bid * NTHREADS + F.tid; tok < T_TOK; tok += F.G * NTHREADS) { const int bk = tok_bkt[tok]; const int slot = start[bk] * 256 + tok_rank[tok]; slot_tok[slot] = tok; slot_c[slot] = tok_c[tok]; }
    for (int b = F.bid; b < 24; b += F.G) { const int s0 = start[b] * 256 + cnt[b], s1 = start[b + 1] * 256;
        for (int s = s0 + F.tid; s < s1; s += NTHREADS) { slot_tok[s] = -1; slot_c[s] = (f32x2){0.f, 0.f}; } }
    if (F.bid == 0) { if (F.tid == 0) tile_tab[0] = start[24];
        for (int m = F.tid; m < 288; m += NTHREADS) { int bk = 23; for (int b = 0; b < 24; ++b) if (m >= start[b] && m < start[b + 1]) bk = b; tile_tab[64 + m] = bk; } }
}

__device__ __forceinline__ void phase_mix5(const Params& p, const Frame& F, const bf16_t* h, bf16_t* ou, bf16_t* o0, bf16_t* o1, bf16_t* o2) {
    const float* mu = p.in[12];
    f32x4 wv[4], m0[4], m1[4], m2[4];
    row_load(p.in[1] + DM, F.lane, wv); row_load(mu, F.lane, m0); row_load(mu + 2 * DM, F.lane, m1); row_load(mu + 3 * DM, F.lane, m2);
    for (int run = F.bid * 8 + F.wave; run < T_TOK / 32; run += F.G * 8) {
        const int t0 = run * 32;
        f32x4 up[4];
        if ((t0 & (SEQ - 1)) == 0) {
#pragma unroll
            for (int j = 0; j < 4; ++j) up[j] = (f32x4){0.f, 0.f, 0.f, 0.f};
            if (F8_L1) row_store_fp8((unsigned char*)ou + (size_t)(t0 + (t0 >> 12)) * DM, F.lane, up); else
            row_store_bf16(ou + (size_t)(t0 + (t0 >> 12)) * DM, F.lane, up);
        } else { row_load_bf(h + (size_t)(t0 - 1) * DM, F.lane, up); const float rs = row_rstd(up, 1e-6f);
#pragma unroll
            for (int j = 0; j < 4; ++j) up[j] = up[j] * rs * wv[j]; }
        f32x4 u[4], un[4]; row_load_bf(h + (size_t)t0 * DM, F.lane, u);
        for (int tt = 0; tt < 32; ++tt) {
            if (tt + 1 < 32) row_load_bf(h + (size_t)(t0 + tt + 1) * DM, F.lane, un);
            const float rs = row_rstd(u, 1e-6f);
            f32x4 a[4], b[4], c[4];
#pragma unroll
            for (int j = 0; j < 4; ++j) { u[j] = u[j] * rs * wv[j]; const f32x4 xx = up[j] - u[j]; a[j] = u[j] + xx * m0[j]; b[j] = u[j] + xx * m1[j]; c[j] = u[j] + xx * m2[j]; }
            const size_t ro = (size_t)(t0 + tt) * DM;
            if (F8_L1) row_store_fp8((unsigned char*)ou + ro + (size_t)((t0 >> 12) + 1) * DM, F.lane, u); else
            row_store_bf16(ou + ro + (size_t)((t0 >> 12) + 1) * DM, F.lane, u);
            if (F8_RV) { row_store_fp8((unsigned char*)o0 + ro, F.lane, a); row_store_fp8((unsigned char*)o2 + ro, F.lane, c); }
            else { row_store_bf16(o0 + ro, F.lane, a); row_store_bf16(o2 + ro, F.lane, c); }
            if (F8_K) row_store_fp8((unsigned char*)o1 + ro, F.lane, b); else row_store_bf16(o1 + ro, F.lane, b);
#pragma unroll
            for (int j = 0; j < 4; ++j) { up[j] = u[j]; u[j] = un[j]; }
        }
    }
}

typedef __bf16 bf16x2v __attribute__((ext_vector_type(2)));
__device__ __forceinline__ unsigned pkc(float lo, float hi) { f32x2 t = {lo, hi}; bf16x2v r = __builtin_convertvector(t, bf16x2v); return __builtin_bit_cast(unsigned, r); }
__device__ __forceinline__ unsigned off_r(unsigned row, unsigned ch) { return row * 128u + 16u * (ch ^ ((row >> 1) & 7u)); }
__device__ __forceinline__ unsigned off_m(unsigned row, unsigned ch) { return row * 64u + 16u * (ch ^ ((0u - (row >> 2)) & 3u)); }
#define MFMA16(a, b, c) __builtin_amdgcn_mfma_f32_16x16x32_bf16((a), (b), (c), 0, 0, 0)
__device__ __forceinline__ void swap32(float& a, float& b) { asm volatile("s_nop 1\n\tv_permlane32_swap_b32 %0, %1\n\ts_nop 1" : "+v"(a), "+v"(b)); }
__device__ __forceinline__ float half_sum(float x, bool hf) {
    x = dpp_sum16(x);
    x += __builtin_bit_cast(float, __builtin_amdgcn_update_dpp(0, __builtin_bit_cast(int, x), 0x142, 0xA, 0xF, false));
    const float lo = __builtin_bit_cast(float, __builtin_amdgcn_readlane(__builtin_bit_cast(int, x), 31)), hi = __builtin_bit_cast(float, __builtin_amdgcn_readlane(__builtin_bit_cast(int, x), 63));
    return hf ? hi : lo;
}
__device__ __forceinline__ void phase_rwkv(const Params& p, const Frame& F, bf16_t* rbuf, const bf16_t* kbuf, const bf16_t* vbuf, const bf16_t* ebuf, const bf16_t* abuf, const bf16_t* gbuf, unsigned char* y8) {
    (void)y8;
    constexpr unsigned ORA = 0, OLB = 16384, OMS = 32768, OMU = 49152, OMY = 53248, OAB = 57344, OAK = 61440, OVT = 65536, OGC = 73728, OYS = 74752, OVF = 91136, OGG = 107520, OBON = 123904, OYS1 = 124416;
    static_assert(!F8_WO, "the overlapped output stage writes bf16 in place");
    LAS unsigned char* L = F.lds;
    const float* k_k = p.in[25]; const float* k_a = p.in[26]; const float* r_k = p.in[27]; const float* lnw = p.in[28]; const float* lnb = p.in[29];
    const int lane0 = F.lane, w = F.wave, pc = w >> 1, th = w & 1;
    for (int unit = F.bid; unit < 256; unit += F.G) {
        const int b = unit >> 4, hd = unit & 15;
        const int gc2 = hd * 64 + 2 * (lane0 & 31);
        const f32x2 kkw = *(const f32x2*)(k_k + gc2), kaw = *(const f32x2*)(k_a + gc2), rkw = *(const f32x2*)(r_k + gc2), lw = *(const f32x2*)(lnw + gc2), lb = *(const f32x2*)(lnb + gc2);
        int lane = lane0;
        f32x4 St[4];
#pragma unroll
        for (int mt = 0; mt < 4; ++mt) St[mt] = (f32x4){0.f, 0.f, 0.f, 0.f};
        unsigned pr[4], pk[4], pv[4], pe[4], pa[4], pg[4], pe0[4];
#define RW_LOAD(t0_) do { const size_t ub_ = ((size_t)b * SEQ + (t0_) + 16 * pc + 8 * th) * DM + hd * 64, ub0_ = ((size_t)b * SEQ + (t0_) + 16 * pc) * DM + hd * 64;     \
            const bf16_t* r_ = rbuf + ub_; const bf16_t* k_ = kbuf + ub_; const bf16_t* v_ = vbuf + ub_; const bf16_t* e_ = ebuf + ub_; const bf16_t* a_ = abuf + ub_; const bf16_t* g_ = gbuf + ub_; const bf16_t* e0_ = ebuf + ub0_; \
            _Pragma("unroll") for (int it = 0; it < 4; ++it) { const unsigned lo_ = (unsigned)((4 * (lane >> 5) + it) * DM + 2 * (lane & 31)); \
            pr[it] = __builtin_nontemporal_load((const unsigned*)(r_ + lo_)); pk[it] = __builtin_nontemporal_load((const unsigned*)(k_ + lo_)); pv[it] = __builtin_nontemporal_load((const unsigned*)(v_ + lo_)); pe[it] = __builtin_nontemporal_load((const unsigned*)(e_ + lo_)); pa[it] = __builtin_nontemporal_load((const unsigned*)(a_ + lo_)); pg[it] = __builtin_nontemporal_load((const unsigned*)(g_ + lo_)); pe0[it] = *(const unsigned*)(e0_ + lo_); } } while (0)
        RW_LOAD(0);
#define RW_OUT(tok_, t0b_, par_) do { const int t_ = (tok_); const int li_ = t_ * 32 + (int)cp; \
            const f32x2 y = *(const LAS f32x2*)(L + ((par_) ? OYS1 : OYS) + (t_ * 64 + 2 * (int)cp) * 4); const float mean = half_sum(y[0] + y[1], hf) * (1.f / 64.f); const float d0 = y[0] - mean, d1 = y[1] - mean; \
            const float rs = rsqrtf(half_sum(d0 * d0 + d1 * d1, hf) * (1.f / 64.f) + 64e-5f); \
            const unsigned vv_ = *(const LAS unsigned*)(L + OVF + (par_) * 8192 + li_ * 4), gg_ = *(const LAS unsigned*)(L + OGG + (par_) * 8192 + li_ * 4); const float bo = *(const LAS float*)(L + OBON + (par_) * 256 + t_ * 4); \
            const float o0 = (d0 * rs * lw[0] + lb[0] + bo * bflo(vv_)) * bflo(gg_), o1 = (d1 * rs * lw[1] + lb[1] + bo * bfhi(vv_)) * bfhi(gg_); \
            *(unsigned*)(rbuf + ((size_t)b * SEQ + (t0b_)) * DM + hd * 64 + (unsigned)(t_ * DM + 2 * (int)cp)) = pkc(o0, o1); } while (0)
        SP_DECL;
        for (int t0 = 0; t0 < SEQ; t0 += 64) {
            LDS_BAR();
            SP_MARK(4);
            asm volatile("" : "+v"(lane));
            const unsigned l15 = lane & 15, q = (unsigned)lane >> 4, cp = lane & 31;
            const bool hf = lane >= 32;
            const unsigned par = (unsigned)(t0 >> 6) & 1u;
            const unsigned pj = 32u * (cp >> 4) + 8u * ((cp & 7) >> 1) + 2u * (cp & 1) + ((cp & 8) ? 4u : 0u);
            {
                float pl0[4], pl1[4], ls0 = 0.f, ls1 = 0.f, f0 = 0.f, f1 = 0.f;
#pragma unroll
                for (int it = 0; it < 4; ++it) { ls0 += bflo(pe[it]); ls1 += bfhi(pe[it]); pl0[it] = ls0; pl1[it] = ls1; f0 += bflo(pe0[it]); f1 += bfhi(pe0[it]); }
                float xa0 = 0.f, xb0 = ls0, xa1 = 0.f, xb1 = ls1; swap32(xa0, xb0); swap32(xa1, xb1);
                float ya0 = f0, yb0 = f0, ya1 = f1, yb1 = f1; swap32(ya0, yb0); swap32(ya1, yb1);
                const float base0 = xa0 + (th ? f0 + (hf ? ya0 : yb0) : 0.f), base1 = xa1 + (th ? f1 + (hf ? ya1 : yb1) : 0.f);
                float ms0[8], ms1[8], vt0[4], vt1[4];
                LAS unsigned char* ra = L + ORA + pc * 4096; LAS unsigned char* lbp = L + OLB + pc * 4096;
#pragma unroll
                for (int it = 0; it < 4; ++it) {
                    const int t = 8 * th + 4 * (int)hf + it, tb = 16 * pc + t;
                    const float r0 = bflo(pr[it]), r1 = bfhi(pr[it]), k0 = bflo(pk[it]), k1 = bfhi(pk[it]), a0 = bflo(pa[it]), a1 = bfhi(pa[it]);
                    const float kv0 = k0 * kkw[0], kv1 = k1 * kkw[1]; const float ss = half_sum(kv0 * kv0 + kv1 * kv1, hf); const float rn = rsqrtf(fmaxf(ss, 1e-24f));
                    const float kk0 = kv0 * rn, kk1 = kv1 * rn;
                    const float kp0 = k0 * (1.f + (a0 - 1.f) * kaw[0]), kp1 = k1 * (1.f + (a1 - 1.f) * kaw[1]);
                    const float bon = half_sum(r0 * kp0 * rkw[0] + r1 * kp1 * rkw[1], hf);
                    const float lp0 = -(base0 + (it ? pl0[it ? it - 1 : 0] : 0.f)), lp1 = -(base1 + (it ? pl1[it ? it - 1 : 0] : 0.f)), lc0 = -(base0 + pl0[it]), lc1 = -(base1 + pl1[it]);
                    const float ea0 = __expf(lp0), ea1 = __expf(lp1), eb0 = __expf(lc0), eb1 = __expf(lc1), ei0 = __expf(-lc0), ei1 = __expf(-lc1);
                    const float bt0 = kk0 * a0 * ei0, bt1 = kk1 * a1 * ei1, kt0 = kp0 * ei0, kt1 = kp1 * ei1;
                    *(LAS unsigned*)(ra + off_r(t, pj >> 3) + 2 * (pj & 7)) = pkc(-kk0 * ea0, -kk1 * ea1); *(LAS unsigned*)(ra + off_r(16 + t, pj >> 3) + 2 * (pj & 7)) = pkc(r0 * eb0, r1 * eb1);
                    *(LAS unsigned*)(lbp + off_r(t, pj >> 3) + 2 * (pj & 7)) = pkc(bt0, bt1); *(LAS unsigned*)(lbp + off_r(16 + t, pj >> 3) + 2 * (pj & 7)) = pkc(kt0, kt1);
                    ms0[it] = bt0; ms0[4 + it] = kt0; ms1[it] = bt1; ms1[4 + it] = kt1; vt0[it] = bflo(pv[it]); vt1[it] = bfhi(pv[it]);
                    *(LAS unsigned*)(L + OVF + par * 8192 + (tb * 32 + cp) * 4) = pv[it]; *(LAS unsigned*)(L + OGG + par * 8192 + (tb * 32 + cp) * 4) = pg[it];
                    if (cp == 0) *(LAS float*)(L + OBON + par * 256 + tb * 4) = bon;
                    if (it == 3 && th && hf) *(LAS f32x2*)(L + OGC + pc * 256 + 2 * cp * 4) = (f32x2){eb0, eb1};
                }
                { u32x4 m0, m1; m0.x = pkc(ms0[0], ms0[1]); m0.y = pkc(ms0[2], ms0[3]); m0.z = pkc(ms0[4], ms0[5]); m0.w = pkc(ms0[6], ms0[7]); m1.x = pkc(ms1[0], ms1[1]); m1.y = pkc(ms1[2], ms1[3]); m1.z = pkc(ms1[4], ms1[5]); m1.w = pkc(ms1[6], ms1[7]);
                  *(LAS u32x4*)(L + OMS + pc * 4096 + off_m(2 * cp, 2 * th + (unsigned)hf)) = m0; *(LAS u32x4*)(L + OMS + pc * 4096 + off_m(2 * cp + 1, 2 * th + (unsigned)hf)) = m1;
                  u32x2 w0, w1; w0.x = pkc(vt0[0], vt0[1]); w0.y = pkc(vt0[2], vt0[3]); w1.x = pkc(vt1[0], vt1[1]); w1.y = pkc(vt1[2], vt1[3]);
                  *(LAS u32x2*)(L + OVT + pc * 2048 + (2 * cp) * 32 + (8 * th + 4 * (unsigned)hf) * 2) = w0; *(LAS u32x2*)(L + OVT + pc * 2048 + (2 * cp + 1) * 32 + (8 * th + 4 * (unsigned)hf) * 2) = w1; }
            }
            if (t0 + 64 < SEQ) RW_LOAD(t0 + 64);
            LDS_BAR();
            SP_MARK(1);
            if (w < 4) {
                {
                    const int c = w;
                    f32x4 g00 = (f32x4){0.f, 0.f, 0.f, 0.f}, g01 = g00, g10 = g00, g11 = g00;
#pragma unroll
                    for (int ks = 0; ks < 2; ++ks) {
                        const bf16x8 a0 = *(const LAS bf16x8*)(L + OLB + c * 4096 + off_r(l15, 4 * ks + q)), a1 = *(const LAS bf16x8*)(L + OLB + c * 4096 + off_r(16 + l15, 4 * ks + q));
                        const bf16x8 b0 = *(const LAS bf16x8*)(L + ORA + c * 4096 + off_r(l15, 4 * ks + q)), b1 = *(const LAS bf16x8*)(L + ORA + c * 4096 + off_r(16 + l15, 4 * ks + q));
                        g00 = MFMA16(a0, b0, g00); g01 = MFMA16(a0, b1, g01); g10 = MFMA16(a1, b0, g10); g11 = MFMA16(a1, b1, g11);
                    }
                    f32x4 ab, ak; float br[4], kr[4];
#pragma unroll
                    for (int g = 0; g < 4; ++g) { const bool lt = (4 * q + g) < l15, le = (4 * q + g) <= l15; ab[g] = lt ? g00[g] : 0.f; ak[g] = lt ? g10[g] : 0.f; br[g] = le ? g01[g] : 0.f; kr[g] = le ? g11[g] : 0.f; }
                    *(LAS f32x4*)(L + OAB + c * 1024 + (l15 * 16 + 4 * q) * 4) = ab; *(LAS f32x4*)(L + OAK + c * 1024 + (l15 * 16 + 4 * q) * 4) = ak;
                    u32x4 yw; yw.x = pkc(br[0], br[1]); yw.y = pkc(br[2], br[3]); yw.z = pkc(kr[0], kr[1]); yw.w = pkc(kr[2], kr[3]);
                    *(LAS u32x4*)(L + OMY + c * 1024 + off_m(l15, q)) = yw;
                    if (lane < 32) {
                        float row[16];
#pragma unroll
                        for (int t = 0; t < 16; ++t) {
                            const LAS f32x4* abr = (const LAS f32x4*)(L + OAB + c * 1024 + t * 64);
                            const f32x4 x0 = abr[0], x1 = abr[1], x2 = abr[2], x3 = abr[3];
                            const float abv[16] = {x0[0], x0[1], x0[2], x0[3], x1[0], x1[1], x1[2], x1[3], x2[0], x2[1], x2[2], x2[3], x3[0], x3[1], x3[2], x3[3]};
                            float acc1 = (lane < 16) ? ((lane == t) ? 1.f : 0.f) : *(const LAS float*)(L + OAK + c * 1024 + (t * 16 + (lane & 15)) * 4);
#pragma unroll
                            for (int s_ = 0; s_ < t; ++s_) acc1 += row[s_] * abv[s_];
                            row[t] = acc1;
                        }
                        const unsigned pp = (lane < 16) ? (8u * (lane >> 2) + (lane & 3)) : (8u * ((lane & 15) >> 2) + 4u + (lane & 3));
#pragma unroll
                        for (int t = 0; t < 16; ++t) *(LAS bf16_t*)(L + OMU + c * 1024 + off_m(t, pp >> 3) + 2 * (pp & 7)) = (bf16_t)(pkc(row[t], 0.f) & 0xffffu);
                    }
                }
            }
            else if (t0 > 0) {
#pragma unroll
                for (int iq = 0; iq < 4; ++iq) RW_OUT((w - 4) + 4 * (2 * iq + (int)hf), t0 - 64, par ^ 1u);
            }
            LDS_BAR();
            SP_MARK(2);
            if (w < 4) {
#pragma unroll 1
                for (int c = 0; c < 4; ++c) {
                    bf16x8 Sb0, Sb1;
                    { u32x4 t0_; t0_.x = pkc(St[0][0], St[0][1]); t0_.y = pkc(St[0][2], St[0][3]); t0_.z = pkc(St[1][0], St[1][1]); t0_.w = pkc(St[1][2], St[1][3]); Sb0 = __builtin_bit_cast(bf16x8, t0_);
                      u32x4 t1_; t1_.x = pkc(St[2][0], St[2][1]); t1_.y = pkc(St[2][2], St[2][3]); t1_.z = pkc(St[3][0], St[3][1]); t1_.w = pkc(St[3][2], St[3][3]); Sb1 = __builtin_bit_cast(bf16x8, t1_); }
                    f32x4 Za = (f32x4){0.f, 0.f, 0.f, 0.f}, Zr = Za;
                    Za = MFMA16(*(const LAS bf16x8*)(L + ORA + c * 4096 + off_r(l15, q)), Sb0, Za); Za = MFMA16(*(const LAS bf16x8*)(L + ORA + c * 4096 + off_r(l15, 4 + q)), Sb1, Za);
                    Zr = MFMA16(*(const LAS bf16x8*)(L + ORA + c * 4096 + off_r(16 + l15, q)), Sb0, Zr); Zr = MFMA16(*(const LAS bf16x8*)(L + ORA + c * 4096 + off_r(16 + l15, 4 + q)), Sb1, Zr);
                    const u32x2 vt = *(const LAS u32x2*)(L + OVT + c * 2048 + (16 * w + l15) * 32 + 8 * q);
                    u32x4 bu; bu.x = pkc(Za[0], Za[1]); bu.y = pkc(Za[2], Za[3]); bu.z = vt.x; bu.w = vt.y;
                    f32x4 U = (f32x4){0.f, 0.f, 0.f, 0.f};
                    U = MFMA16(*(const LAS bf16x8*)(L + OMU + c * 1024 + off_m(l15, q)), __builtin_bit_cast(bf16x8, bu), U);
                    u32x4 by; by.x = pkc(U[0], U[1]); by.y = pkc(U[2], U[3]); by.z = vt.x; by.w = vt.y;
                    const bf16x8 By = __builtin_bit_cast(bf16x8, by);
                    const f32x4 Yt = MFMA16(*(const LAS bf16x8*)(L + OMY + c * 1024 + off_m(l15, q)), By, Zr);
#pragma unroll
                    for (int mt = 0; mt < 4; ++mt) { St[mt] = MFMA16(*(const LAS bf16x8*)(L + OMS + c * 4096 + off_m(16 * mt + l15, q)), By, St[mt]);
                        const f32x4 gc = *(const LAS f32x4*)(L + OGC + c * 256 + (16 * mt + 4 * q) * 4); St[mt] = St[mt] * gc; }
#pragma unroll
                    for (int g = 0; g < 4; ++g) *(LAS float*)(L + (par ? OYS1 : OYS) + ((16 * c + 4 * q + g) * 64 + 16 * w + l15) * 4) = Yt[g];
                }
            }
            else if (t0 > 0) {
#pragma unroll
                for (int iq = 0; iq < 4; ++iq) RW_OUT((w - 4) + 4 * (8 + 2 * iq + (int)hf), t0 - 64, par ^ 1u);
            }
            SP_MARK(3);
        }
        {
            LDS_BAR();
            const unsigned cp = lane0 & 31; const bool hf = lane0 >= 32; const unsigned parl = (unsigned)((SEQ - 64) >> 6) & 1u;
#pragma unroll
            for (int iq = 0; iq < 4; ++iq) { const int tq = 2 * iq + (int)hf; RW_OUT(w + 8 * tq, SEQ - 64, parl); }
        }
#undef RW_LOAD
#undef RW_OUT
    }
}

__global__ void __launch_bounds__(NTHREADS, 2) mega_fwd(Params p) {
    extern __shared__ __attribute__((aligned(16))) unsigned char lds_raw[];
    Frame F;
    F.lds = (LAS unsigned char*)lds_raw;
    F.tid = threadIdx.x; F.lane = F.tid & 63; F.wave = __builtin_amdgcn_readfirstlane(F.tid >> 6); F.G = gridDim.x; F.bid = blockIdx.x;
    F.out = p.out; F.ws = p.ws;
    volatile LAS unsigned* misc = (volatile LAS unsigned*)(F.lds + LDS_MISC);
    if (F.tid < 32) misc[F.tid] = 0u;
    __syncthreads();
    const int lo = p.ph_lo, hi = p.ph_hi;
    XcdBarrier bar; bar.bar = (unsigned*)(F.ws + WS_CTL); bar.x = 0; bar.st = misc;
    if (hi - lo > 1) bar = xcd_barrier_post((unsigned*)(F.ws + WS_CTL), misc);
#define IN(k) (lo <= (k) && (k) < hi)
#if PROBE_MASK
    unsigned long long pr_t0 = 0ull, pr_acc = 0ull;
#define PSTART(k) do { if ((PROBE_MASK >> (k)) & 1u) pr_t0 = wall_clock64(); } while (0)
#define PEND(k) do { if ((PROBE_MASK >> (k)) & 1u) pr_acc += wall_clock64() - pr_t0; } while (0)
#else
#define PSTART(k) do {} while (0)
#define PEND(k) do {} while (0)
#endif
#if PROBE_SUB == 11
#define SEAM(k) do { if (IN(k) && IN((k) + 1)) { unsigned long long b0_ = 0ull; if (F.tid == 0) b0_ = wall_clock64(); xcd_barrier(bar); if (F.tid == 0) *(LAS unsigned long long*)(F.lds + LDS_MISC + 64) += wall_clock64() - b0_; } PEND(k); PSTART((k) + 1); } while (0)
#else
#define SEAM(k) do { if (IN(k) && IN((k) + 1)) xcd_barrier(bar); PEND(k); PSTART((k) + 1); } while (0)
#endif
    bf16_t* wb = WSP(bf16_t, WS_WB);
    bf16_t* S0 = WSP(bf16_t, WS_SLAB); bf16_t* S2 = WSP(bf16_t, WS_SLAB + 2 * SLAB); bf16_t* S3 = WSP(bf16_t, WS_SLAB + 3 * SLAB); bf16_t* S4 = WSP(bf16_t, WS_SLAB + 4 * SLAB); bf16_t* S5 = WSP(bf16_t, WS_SLAB + 5 * SLAB);
    bf16_t* EH = WSP(bf16_t, WS_E);
    bf16_t* O0 = (bf16_t*)F.out; bf16_t* O1 = O0 + (size_t)T_TOK * DM;
    bf16_t* hres = (bf16_t*)F.out;
    bf16_t* S1 = WSP(bf16_t, WS_SLAB + 1 * SLAB);
    const int vcu = (F.G % 8 == 0) ? F.bid : F.bid;

    PSTART(0);
    if (IN(0)) { phase_prep(p, F, 0, PT_WIN, true); phase_rmsnorm<F8_INPROJ ? 2 : 1>(p, F, p.in[0], p.in[1], O0); } SEAM(0);
    if (IN(2)) { DenseP<EK_INPROJ, F8_INPROJ> P{}; P.pid = 2; P.v0 = (const float*)(F.ws + WS_ROPE); P.K = F8_INPROJ ? 512 : 1024; P.lda = P.K; P.ldb = P.K; P.nM = 256; P.nN = NPROJ / 256; P.nprob = 1; P.G = F.G; P.c = vcu; P.A = O0; P.a_stride = 0; P.B = wb + WB_WIN / 2; P.b_stride = 0;
        P.O = S0; P.o_stride = 0; P.ldc = NPROJ; gemm_phase(F.lds, P); } SEAM(2);
    if (IN(3)) { phase_conv(p, F); } SEAM(3);
    if (IN(4)) { phase_scan0(p, F); phase_prep(p, F, PT_WIN, PT_WOUT, false); } SEAM(4);
    if (IN(6)) { DenseP<EK_F32RES, F8_OUTPROJ> P{}; P.pid = 6; P.K = F8_OUTPROJ ? 1024 : 2048; P.lda = NPROJ; P.ldb = P.K; P.nM = 256; P.nN = 4; P.nprob = 1; P.G = F.G; P.c = vcu; P.A = S0; P.B = wb + WB_WOUT / 2; P.resf = p.in[0]; P.resb = nullptr; P.Ob = hres; P.ldc = 1024; P.seg_stats = WSP(float, WS_STATS); gemm_phase(F.lds, P); } SEAM(6);
#define MOE_LAYER(L, k0) \
    if (IN(k0)) { phase_prep(p, F, PT_L2 + (L) * 4096, PT_L2 + (L) * 4096 + 4096, false); phase_prep(p, F, PT_W13 + (L) * 2048, PT_W13 + (L) * 2048 + 2048, false); phase_moe_route(p, F, L, hres, S2); } SEAM(k0); \
    if (IN(k0 + 1)) { phase_moe_slots(p, F, L); } SEAM(k0 + 1); \
    if (IN(k0 + 2)) { unsigned char* meta = F.ws + WS_META + (size_t)(L) * META_STRIDE; Moe1P<true> P{}; P.pid = (k0) + 2; P.K = 512; P.lda = P.K; P.ldb = P.K; P.G = F.G; P.c = vcu; \
        P.ntiles = __builtin_amdgcn_readfirstlane(ld_vec_i32((const int*)(meta + MT_TILE))); P.A = S2; P.W13 = wb + WB_W13 / 2 + (size_t)(L) * 16 * 1048576; P.H = S3; \
        P.slot_tok = (const int*)(meta + MT_STOK); P.slot_c = (const float*)(meta + MT_SC); P.tile_bkt = (const int*)(meta + MT_TILE) + 64; gemm_phase(F.lds, P); } SEAM(k0 + 2); \
    if (IN(k0 + 3)) { unsigned char* meta = F.ws + WS_META + (size_t)(L) * META_STRIDE; Moe2P<true> P{}; P.pid = (k0) + 3; P.K = 512; P.lda = P.K; P.ldb = P.K / 2; P.G = F.G; P.c = vcu; \
        P.ntiles = __builtin_amdgcn_readfirstlane(ld_vec_i32((const int*)(meta + MT_TILE))); P.H = S3; P.W2 = wb + WB_W2 / 2 + (size_t)(L) * 16 * 524288; P.hsrc = hres; P.hdst = ((L) == 1) ? S0 : hres; \
        P.slot_tok = (const int*)(meta + MT_STOK); P.tile_bkt = (const int*)(meta + MT_TILE) + 64; gemm_phase(F.lds, P); } SEAM(k0 + 3);
    MOE_LAYER(0, 7)
    if (IN(11)) { phase_prep(p, F, PT_WOUT, PT_L2, false); phase_mix5(p, F, hres, S0, S2, S3, S4); } SEAM(11);
    if (IN(12)) {
        { DenseP<EK_LORA1, F8_L1> P{}; P.pid = 12; P.K = F8_L1 ? 1024 : 2048; P.lda = P.K / 2; P.ldb = P.K; P.nM = 256; P.nN = 2; P.nprob = 1; P.G = F.G; P.c = vcu; P.A = S0; P.a_skew = 1; P.a_split = P.K / 128; P.a_jump = -(long)(P.K) - (P.K / 128) * (BK * 2);
          P.B = wb + WB_L1 / 2; P.O = EH; P.ldc = 512; gemm_phase(F.lds, P); }
        static_assert(F8_K == F8_RV, "one three-problem GEMM: the three projections share the operand type");
        { DenseP<EK_BF16, F8_RV> P{}; P.pid = 14; P.K = F8_RV ? 512 : 1024; P.lda = P.K; P.ldb = P.K; P.nM = 256; P.nN = 4; P.nprob = 3; P.G = F.G; P.c = vcu; P.ldc = 1024; P.A = S2; P.a_stride = (size_t)T_TOK * DM; P.B = wb + WB_WR / 2; P.b_stride = 1048576;
          P.O = S5; P.Oalt1 = O1; P.Oalt2 = S1; gemm_phase(F.lds, P); } } SEAM(12);
    if (IN(15)) { DenseP<EK_LORA2> P{}; P.pid = 15; P.K = 256; P.lda = 512; P.ldb = 256; P.nM = 256; P.nN = 4; P.nprob = 3; P.G = F.G; P.c = vcu; P.A = EH; P.Aalt1 = EH; P.Aalt2 = EH + 128; P.B = wb + WB_L2 / 2; P.b_stride = 262144;
        P.O = S2; P.o_stride = (size_t)T_TOK * DM; P.ldc = 1024; P.v0 = p.in[17]; P.v1 = p.in[20]; gemm_phase(F.lds, P); } SEAM(15);
    if (IN(16)) { phase_rwkv(p, F, S5, O1, S1, S2, S3, S4, (unsigned char*)EH); } SEAM(16);
    if (IN(17)) { DenseP<EK_F32RES, F8_WO> P{}; P.pid = 17; P.K = F8_WO ? 512 : 1024; P.lda = P.K; P.ldb = P.K; P.nM = 256; P.nN = 4; P.nprob = 1; P.G = F.G; P.c = vcu; P.A = F8_WO ? EH : S5; P.B = wb + WB_WO / 2; P.resf = nullptr; P.resb = hres; P.Ob = hres; P.ldc = 1024; gemm_phase(F.lds, P); } SEAM(17);
    MOE_LAYER(1, 18)
    if (IN(22)) { phase_rmsnorm<0, true>(p, F, S0, p.in[3], F.out); }
#if PROBE_SUB
    if (F.bid == 0 && F.tid == 0) { const unsigned long long d_ = *(LAS unsigned long long*)(F.lds + LDS_MISC + 64); const unsigned long long t = wall_clock64(); while (wall_clock64() - t < d_) __builtin_amdgcn_s_sleep(8); }
#endif
#if PROBE_MASK
    PEND(22);
    if (F.bid == 0 && F.tid == 0) { const unsigned long long t = wall_clock64(); while (wall_clock64() - t < pr_acc) __builtin_amdgcn_s_sleep(8); }
#endif
}

extern "C" void kernel_launch(void* const* d_in, const int* in_sizes, int n_in, void* d_out, int out_size, void* d_ws, size_t ws_size, hipStream_t stream) {
    static int grid = 0;
    if (grid == 0) {
        if (n_in != 37 || out_size != T_TOK * DM || ws_size < WS_END) { fprintf(stderr, "kernel_launch: unexpected shapes (n_in %d out %d ws %zu)\n", n_in, out_size, ws_size); grid = -1; return; }
        int dev = 0, cus = 0, per_cu = 0;
        if (hipGetDevice(&dev) != hipSuccess || hipDeviceGetAttribute(&cus, hipDeviceAttributeMultiprocessorCount, dev) != hipSuccess) { grid = -1; return; }
        if (hipFuncSetAttribute((const void*)mega_fwd, hipFuncAttributeMaxDynamicSharedMemorySize, LDS_BYTES) != hipSuccess) { fprintf(stderr, "kernel_launch: hipFuncSetAttribute failed\n"); grid = -1; return; }
        if (hipOccupancyMaxActiveBlocksPerMultiprocessor(&per_cu, (const void*)mega_fwd, NTHREADS, LDS_BYTES) != hipSuccess || per_cu < 1) fprintf(stderr, "kernel_launch: occupancy query says %d\n", per_cu);
        (void)hipGetLastError();
        grid = cus;
        if (grid < 128 || grid > 512) { fprintf(stderr, "kernel_launch: built for 128..512 CUs (the MoE router keeps <= 512 tokens per workgroup in LDS); got %d\n", grid); grid = -1; return; }
    }
    if (grid < 0) return;
    (void)in_sizes;
    hipMemsetAsync((char*)d_ws + WS_CTL, 0, CTL_ZERO_BYTES, stream);
    Params p{};
    for (int i = 0; i < 37; ++i) p.in[i] = (const float*)d_in[i];
    p.out = (float*)d_out; p.ws = (unsigned char*)d_ws;
#if MK_PER_PHASE
    for (int k = 0; k < NPHASE; ++k) { p.ph_lo = k; p.ph_hi = k + 1; hipLaunchKernelGGL(mega_fwd, dim3(grid), dim3(NTHREADS), LDS_BYTES, stream, p); }
#else
    p.ph_lo = 0; p.ph_hi = NPHASE; hipLaunchKernelGGL(mega_fwd, dim3(grid), dim3(NTHREADS), LDS_BYTES, stream, p);
#endif
}
```
